# Optimizing an MI355X kernel written in HIP

```python
import jax, jax.numpy as jnp
from jax import lax
import numpy as np

D_MODEL = 2048
BATCH = 8
SEQ = 2048
DEPTH = 1

N_MEM = 256
NORM_EPS = 1e-6
NEG_INF = -1e30
A_HEADS = 12
A_KV_HEADS = 4
A_HEAD_DIM = 64
A_WIDTH = A_HEADS * A_HEAD_DIM
A_KV_WIDTH = A_KV_HEADS * A_HEAD_DIM
WINDOW = 128
BLOCK = 128
ROPE_THETA = 10000.0
R_HEADS = 12
R_HEAD_DIM = 64
R_WIDTH = R_HEADS * R_HEAD_DIM
DECAY_LORA = 64
ICLR_LORA = 64
N_DIR = 2
GN_EPS = 64e-5
R_SHIFT_WIDTH = 3 * R_WIDTH + N_DIR * DECAY_LORA + N_DIR * ICLR_LORA
X_HEADS = 4
X_HEAD_DIM = 128
X_WIDTH = X_HEADS * X_HEAD_DIM
N_BRANCH = 3
IN_WIDTH = (2 * A_WIDTH + 2 * A_KV_WIDTH + R_SHIFT_WIDTH + R_WIDTH
            + 2 * X_WIDTH + N_BRANCH * D_MODEL)

kernel_name = "hybrid_swa_rwkv7_memxattn_gated_encoder"


def _split(t, sizes):
    idx = np.cumsum(sizes)[:-1].tolist()
    return jnp.split(t, idx, axis=-1)


def rms_norm(t, g, eps=NORM_EPS):
    tf = t.astype(jnp.float32)
    y = tf * lax.rsqrt(jnp.mean(tf * tf, axis=-1, keepdims=True) + eps)
    return (y * g.astype(jnp.float32)).astype(t.dtype)


def rope(t, positions):
    half = t.shape[-1] // 2
    inv = ROPE_THETA ** (-jnp.arange(half, dtype=jnp.float32) / half)
    ang = positions.astype(jnp.float32)[:, None] * inv[None, :]
    cos = jnp.cos(ang)[None, :, None, :]
    sin = jnp.sin(ang)[None, :, None, :]
    t1 = t[..., :half].astype(jnp.float32)
    t2 = t[..., half:].astype(jnp.float32)
    return jnp.concatenate([t1 * cos - t2 * sin, t2 * cos + t1 * sin], axis=-1).astype(t.dtype)


def windowed_gqa(q, k, v, sink):
    B, S, Hq, D = q.shape
    nb = S // BLOCK
    G = Hq // A_KV_HEADS
    qb = q.reshape(B, nb, BLOCK, A_KV_HEADS, G, D)
    pad = ((0, 0), (BLOCK, BLOCK), (0, 0), (0, 0))
    kp = jnp.pad(k, pad).reshape(B, nb + 2, BLOCK, A_KV_HEADS, D)
    vp = jnp.pad(v, pad).reshape(B, nb + 2, BLOCK, A_KV_HEADS, D)
    kb = jnp.concatenate([kp[:, :-2], kp[:, 1:-1], kp[:, 2:]], axis=2)
    vb = jnp.concatenate([vp[:, :-2], vp[:, 1:-1], vp[:, 2:]], axis=2)
    s = jnp.einsum('bnqhgd,bnkhd->bnhgqk', qb, kb).astype(jnp.float32) * (D ** -0.5)
    blk = jnp.arange(nb)[:, None] * BLOCK
    qpos = blk + jnp.arange(BLOCK)[None, :]
    kpos = blk - BLOCK + jnp.arange(3 * BLOCK)[None, :]
    rel = kpos[:, None, :] - qpos[:, :, None]
    valid = (jnp.abs(rel) <= WINDOW) & (kpos[:, None, :] >= 0) & (kpos[:, None, :] < S)
    s = jnp.where(valid[None, :, None, None, :, :], s, NEG_INF)
    sink_l = sink.astype(jnp.float32).reshape(A_KV_HEADS, G)[None, None, :, :, None, None]
    sink_l = jnp.broadcast_to(sink_l, s.shape[:-1] + (1,))
    p = jax.nn.softmax(jnp.concatenate([s, sink_l], axis=-1), axis=-1)[..., :-1]
    o = jnp.einsum('bnhgqk,bnkhd->bnqhgd', p.astype(v.dtype), vb)
    return o.reshape(B, S, Hq * D)


def rwkv7_scan(r, w, k, v, kk, a):
    B, T, H, N = r.shape
    decay = jnp.exp(-jnp.exp(w))
    b = kk * a
    xs = tuple(t.swapaxes(0, 1) for t in (r, decay, k, v, kk, b))

    def step(S, inp):
        r_t, d_t, k_t, v_t, kk_t, b_t = inp
        sa = jnp.einsum('bhij,bhj->bhi', S, -kk_t)
        S = S * d_t[:, :, None, :] + sa[..., None] * b_t[:, :, None, :] + v_t[..., None] * k_t[:, :, None, :]
        return S, jnp.einsum('bhij,bhj->bhi', S, r_t)

    S0 = jnp.zeros((B, H, N, N), jnp.float32)
    _, y = lax.scan(step, S0, xs)
    return y.swapaxes(0, 1)


def rwkv7_branch(p_shift, mu, k_k, k_a, r_k, w0, w2, a0, a2, ln_w, ln_b):
    B, T, _ = p_shift.shape
    p = p_shift.astype(jnp.float32)
    prev = jnp.pad(p, ((0, 0), (1, 0), (0, 0)))[:, :-1]
    nxt = jnp.pad(p, ((0, 0), (0, 1), (0, 0)))[:, 1:]
    p = p + mu.astype(jnp.float32) * (0.5 * (prev + nxt) - p)
    r, k, v, wf, wb, af, ab = _split(p, (R_WIDTH, R_WIDTH, R_WIDTH, DECAY_LORA, DECAY_LORA,
                                         ICLR_LORA, ICLR_LORA))
    hs = (B, T, R_HEADS, R_HEAD_DIM)
    r4 = r.reshape(hs)
    v4 = v.reshape(hs)
    kk = (k * k_k.astype(jnp.float32)).reshape(hs)
    kk = kk / jnp.maximum(jnp.linalg.norm(kk, axis=-1, keepdims=True), 1e-12)
    w_in = (wf, wb)
    a_in = (af, ab)
    y_sum = jnp.zeros(hs, jnp.float32)
    bonus = jnp.zeros(hs, jnp.float32)
    r_k4 = r_k.astype(jnp.float32)[None, None]
    for d in range(N_DIR):
        wd = -jax.nn.softplus(-(w0[d].astype(jnp.float32)
                                + jnp.tanh(w_in[d]) @ w2[d].astype(jnp.float32))) - 0.5
        ad = jax.nn.sigmoid(a0[d].astype(jnp.float32) + a_in[d] @ a2[d].astype(jnp.float32))
        kd = k * (1.0 + (ad - 1.0) * k_a.astype(jnp.float32))
        wd4, ad4, kd4 = wd.reshape(hs), ad.reshape(hs), kd.reshape(hs)
        if d == 0:
            y_sum = y_sum + rwkv7_scan(r4, wd4, kd4, v4, kk, ad4)
        else:
            flip = lambda t: jnp.flip(t, axis=1)
            y_sum = y_sum + flip(rwkv7_scan(flip(r4), flip(wd4), flip(kd4), flip(v4), flip(kk), flip(ad4)))
        bonus = bonus + jnp.sum(r4 * kd4 * r_k4, axis=-1, keepdims=True) * v4
    mean = jnp.mean(y_sum, axis=-1, keepdims=True)
    var = jnp.mean(jnp.square(y_sum - mean), axis=-1, keepdims=True)
    y = ((y_sum - mean) * lax.rsqrt(var + GN_EPS)).reshape(B, T, R_WIDTH)
    y = y * ln_w.astype(jnp.float32) + ln_b.astype(jnp.float32)
    return y + bonus.reshape(B, T, R_WIDTH)


def memory_xattn(q, km, vm):
    s = jnp.einsum('bshd,bmhd->bhsm', q, km).astype(jnp.float32) * (X_HEAD_DIM ** -0.5)
    p = jax.nn.softmax(s, axis=-1)
    o = jnp.einsum('bhsm,bmhd->bshd', p.astype(vm.dtype), vm)
    return o.reshape(q.shape[0], q.shape[1], X_WIDTH)


def hybrid_layer(x, mem, norm_g, mem_norm_g, w_in, gate_b, attn_q_norm_g, attn_k_norm_g,
                 attn_sink, attn_w_o, rwkv_mu, rwkv_k_k, rwkv_k_a, rwkv_r_k, rwkv_w0, rwkv_w2,
                 rwkv_a0, rwkv_a2, rwkv_ln_w, rwkv_ln_b, rwkv_w_o, x_w_kv, x_q_norm_g,
                 x_k_norm_g, x_w_o, w_out):
    B, S, _ = x.shape
    positions = jnp.arange(S)
    h = rms_norm(x, norm_g)
    proj = h @ w_in
    aq, ak, av, ag, rs, rg, xq, xg, mg = _split(
        proj, (A_WIDTH, A_KV_WIDTH, A_KV_WIDTH, A_WIDTH, R_SHIFT_WIDTH, R_WIDTH,
               X_WIDTH, X_WIDTH, N_BRANCH * D_MODEL))

    q = rope(rms_norm(aq.reshape(B, S, A_HEADS, A_HEAD_DIM), attn_q_norm_g), positions)
    k = rope(rms_norm(ak.reshape(B, S, A_KV_HEADS, A_HEAD_DIM), attn_k_norm_g), positions)
    va = av.reshape(B, S, A_KV_HEADS, A_HEAD_DIM)
    y_a = windowed_gqa(q, k, va, attn_sink) * jax.nn.silu(ag)

    y_r = rwkv7_branch(rs, rwkv_mu, rwkv_k_k, rwkv_k_a, rwkv_r_k, rwkv_w0, rwkv_w2,
                       rwkv_a0, rwkv_a2, rwkv_ln_w, rwkv_ln_b)
    y_r = y_r.astype(x.dtype) * jax.nn.silu(rg)

    mkv = rms_norm(mem, mem_norm_g) @ x_w_kv
    km, vm = _split(mkv, (X_WIDTH, X_WIDTH))
    km = rms_norm(km.reshape(B, -1, X_HEADS, X_HEAD_DIM), x_k_norm_g)
    vm = vm.reshape(B, -1, X_HEADS, X_HEAD_DIM)
    qx = rms_norm(xq.reshape(B, S, X_HEADS, X_HEAD_DIM), x_q_norm_g)
    y_x = memory_xattn(qx, km, vm) * jax.nn.silu(xg)

    gates = jax.nn.sigmoid((mg + gate_b).astype(jnp.float32)).reshape(B, S, N_BRANCH, D_MODEL)
    gates = gates.astype(x.dtype)
    merged = (gates[:, :, 0] * (y_a @ attn_w_o)
              + gates[:, :, 1] * (y_r @ rwkv_w_o)
              + gates[:, :, 2] * (y_x @ x_w_o))
    return x + merged @ w_out


def setup_inputs(seed: int = 0) -> dict:
    key = jax.random.key(seed)
    ks = jax.random.split(key, 32)
    n = lambda i, shape, s=1.0: jax.random.normal(ks[i], shape, jnp.float32) * s
    L = DEPTH
    return {
        "x": n(0, (BATCH, SEQ, D_MODEL)),
        "mem": n(1, (BATCH, N_MEM, D_MODEL)),
        "norm_g": 1.0 + n(2, (L, D_MODEL), 0.02),
        "mem_norm_g": 1.0 + n(3, (L, D_MODEL), 0.02),
        "w_in": n(4, (L, D_MODEL, IN_WIDTH), D_MODEL ** -0.5),
        "gate_b": n(5, (L, N_BRANCH * D_MODEL), 0.1),
        "attn_q_norm_g": 1.0 + n(6, (L, A_HEAD_DIM), 0.02),
        "attn_k_norm_g": 1.0 + n(7, (L, A_HEAD_DIM), 0.02),
        "attn_sink": n(8, (L, A_HEADS), 0.5),
        "attn_w_o": n(9, (L, A_WIDTH, D_MODEL), A_WIDTH ** -0.5),
        "rwkv_mu": jax.random.uniform(ks[10], (L, R_SHIFT_WIDTH), jnp.float32, 0.0, 1.0),
        "rwkv_k_k": 0.85 + n(11, (L, R_WIDTH), 0.05),
        "rwkv_k_a": 1.0 + n(12, (L, R_WIDTH), 0.05),
        "rwkv_r_k": n(13, (L, R_HEADS, R_HEAD_DIM), 0.1),
        "rwkv_w0": jax.random.uniform(ks[14], (L, N_DIR, R_WIDTH), jnp.float32, -5.0, -1.0),
        "rwkv_w2": n(15, (L, N_DIR, DECAY_LORA, R_WIDTH), 0.1),
        "rwkv_a0": n(16, (L, N_DIR, R_WIDTH), 0.1),
        "rwkv_a2": n(17, (L, N_DIR, ICLR_LORA, R_WIDTH), 0.5 * ICLR_LORA ** -0.5),
        "rwkv_ln_w": 1.0 + n(18, (L, R_WIDTH), 0.02),
        "rwkv_ln_b": n(19, (L, R_WIDTH), 0.02),
        "rwkv_w_o": n(20, (L, R_WIDTH, D_MODEL), R_WIDTH ** -0.5),
        "x_w_kv": n(21, (L, D_MODEL, 2 * X_WIDTH), D_MODEL ** -0.5),
        "x_q_norm_g": 1.0 + n(22, (L, X_HEAD_DIM), 0.02),
        "x_k_norm_g": 1.0 + n(23, (L, X_HEAD_DIM), 0.02),
        "x_w_o": n(24, (L, X_WIDTH, D_MODEL), X_WIDTH ** -0.5),
        "w_out": n(25, (L, D_MODEL, D_MODEL), D_MODEL ** -0.5),
    }


def reference(x, mem, norm_g, mem_norm_g, w_in, gate_b, attn_q_norm_g, attn_k_norm_g,
              attn_sink, attn_w_o, rwkv_mu, rwkv_k_k, rwkv_k_a, rwkv_r_k, rwkv_w0, rwkv_w2,
              rwkv_a0, rwkv_a2, rwkv_ln_w, rwkv_ln_b, rwkv_w_o, x_w_kv, x_q_norm_g,
              x_k_norm_g, x_w_o, w_out):
    h = x
    for l in range(DEPTH):
        h = hybrid_layer(h, mem, norm_g[l], mem_norm_g[l], w_in[l], gate_b[l],
                         attn_q_norm_g[l], attn_k_norm_g[l], attn_sink[l], attn_w_o[l],
                         rwkv_mu[l], rwkv_k_k[l], rwkv_k_a[l], rwkv_r_k[l], rwkv_w0[l],
                         rwkv_w2[l], rwkv_a0[l], rwkv_a2[l], rwkv_ln_w[l], rwkv_ln_b[l],
                         rwkv_w_o[l], x_w_kv[l], x_q_norm_g[l], x_k_norm_g[l], x_w_o[l],
                         w_out[l])
    return h
```

```cpp
#include <hip/hip_runtime.h>
#include <hip/hip_cooperative_groups.h>
#include <cstdio>
#include <cstdint>
namespace cg = cooperative_groups;
namespace pg8 {
#define PG8_LAS __attribute__((address_space(3)))
typedef unsigned short bf16_t;
typedef short bf16x8 __attribute__((ext_vector_type(8)));
typedef float f32x4 __attribute__((ext_vector_type(4)));
typedef unsigned u32x4 __attribute__((ext_vector_type(4)));
constexpr int BM = 256, BK = 64, HALF = 128, HTB = HALF * BK * 2  , STAGE_BYTES = 8 * HTB, NXCD = 8, WGM = 8;

__host__ __device__ __forceinline__ int lds_byte(int r, int c) { const int st = (r >> 4) * 2 + (c >> 5), rr = r & 15, cc = c & 31, ob = rr * 64 + cc * 2; return st * 1024 + (ob ^ (((ob >> 9) & 1) << 5)); }
__host__ __device__ __forceinline__ void stage_rc(int b, int& R, int& C) { const int st = b / 1024, sb = b % 1024, swz = sb ^ (((sb >> 9) & 1) << 5); R = (st >> 1) * 16 + swz / 64; C = (st & 1) * 32 + (swz % 64) / 2; }
__host__ __device__ __forceinline__ int perm32(int rho) { const int n = rho >> 4, i = rho & 15; return 8 * (i >> 2) + 4 * n + (i & 3); }


constexpr int TIDTAB_OFF = 147200;
__device__ __forceinline__ int hw_slot() { return (int)(__builtin_amdgcn_s_getreg((5 << 11) | 4) & 63u); }
__device__ __forceinline__ int mk_tid(PG8_LAS unsigned char* lds) {
    const int lane = (int)__builtin_amdgcn_mbcnt_hi(~0u, __builtin_amdgcn_mbcnt_lo(~0u, 0u));
    const int w = __builtin_amdgcn_readfirstlane(*(volatile PG8_LAS int*)(lds + TIDTAB_OFF + 4 * hw_slot()));
    return w * 64 + lane;
}
struct Unit { int pm, pn; };
struct Gemm { const bf16_t* A; const bf16_t* Bt; int M, N, K; };

struct StaticOrder {
    int nM, nN, nwg, G, c;
    __host__ __device__ void init(int M, int N, int G_, int c_) { nM = M / BM; nN = N / BM; nwg = nM * nN; G = G_; c = c_; }
    __host__ __device__ bool next(int i, Unit& u) const {
        const long L = (long)i * G + c; if (L >= nwg) return false;
        int wgid = (int)L; { const int q = nwg / NXCD, r = nwg % NXCD, xcd = wgid % NXCD, off = wgid / NXCD; wgid = (xcd < r ? xcd * (q + 1) : r * (q + 1) + (xcd - r) * q) + off; }
        const int nig = WGM * nN, gid = wgid / nig, fm = gid * WGM, gsz = (nM - fm) < WGM ? (nM - fm) : WGM;
        u.pm = fm + ((wgid % nig) % gsz); u.pn = (wgid % nig) / gsz; return true;
    }
    __device__ __forceinline__ void a_ready(const Unit&) const {}
    __device__ __forceinline__ void done(const Unit&) const {}
};

__device__ __forceinline__ unsigned cvt_pk_bf16(float lo, float hi) { unsigned r; asm volatile("v_cvt_pk_bf16_f32 %0, %1, %2" : "=v"(r) : "v"(lo), "v"(hi)); return r; }
template <class Epi, class Sched, bool ALIGN_EPI = false, bool SP2 = false>
__device__ __forceinline__ void gemm_phase(PG8_LAS unsigned char* lds, const Gemm g, const Sched& S, const Epi& E) {
    const int tid = mk_tid(lds), wid = __builtin_amdgcn_readfirstlane(tid >> 6), lane = tid & 63, wr = wid >> 2, wc = wid & 3, fr = lane & 15, fq = lane >> 4;
    const int K = g.K, nt = K / BK;
    unsigned voffA[2], voffB[2];
#pragma unroll
    for (int i = 0; i < 2; ++i) { int R, C; stage_rc(tid * 16 + i * 8192, R, C); const int Rb = Epi::PERM ? ((R & ~31) + perm32(R & 31)) : R;
        voffA[i] = (unsigned)(R * K + C) * 2u; voffB[i] = (unsigned)(Rb * K + C) * 2u; }
    const size_t kstep = (size_t)(BK * 2);
    const size_t hstep = (size_t)HALF * K * 2;
    const size_t tstep = 2 * hstep;
    const unsigned ldsw = (unsigned)wid * 1024u;
    const int aoff = lds_byte(wr * 64 + fr, fq * 8), boff = lds_byte(wc * 32 + fr, fq * 8);
#define PG8_SA(b, h) (((b) * 2 + (h)) * HTB)
#define PG8_SB(b, h) ((4 + (b) * 2 + (h)) * HTB)
#define PG8_STAGE(bufoff, gbase, voff) do { _Pragma("unroll") for (int _i = 0; _i < 2; ++_i) \
        __builtin_amdgcn_global_load_lds((const unsigned*)((const char*)(gbase) + (voff)[_i]), (PG8_LAS unsigned*)(lds + (bufoff) + ldsw + _i * 8192), 16, 0, 0); } while (0)
#define PG8_LDA(dst, b, h) do { _Pragma("unroll") for (int m = 0; m < 4; ++m) _Pragma("unroll") for (int k = 0; k < 2; ++k) dst[m][k] = *(const PG8_LAS bf16x8*)(lds + PG8_SA(b, h) + aoff + m * 2048 + k * 1024); } while (0)
#define PG8_LDB(dst, b, h) do { _Pragma("unroll") for (int n = 0; n < 2; ++n) _Pragma("unroll") for (int k = 0; k < 2; ++k) dst[n][k] = *(const PG8_LAS bf16x8*)(lds + PG8_SB(b, h) + boff + n * 2048 + k * 1024); } while (0)
#define PG8_MMA(ai, bj, At, Bt) do { __builtin_amdgcn_s_setprio(1); _Pragma("unroll") for (int m = 0; m < 4; ++m) _Pragma("unroll") for (int n = 0; n < 2; ++n) _Pragma("unroll") for (int k = 0; k < 2; ++k) \
        acc[ai][bj][m][n] = __builtin_amdgcn_mfma_f32_16x16x32_bf16(Bt[n][k], At[m][k], acc[ai][bj][m][n], 0, 0, 0); __builtin_amdgcn_s_setprio(0); } while (0)
#define PG8_WAIT_V(n) asm volatile("s_waitcnt vmcnt(" #n ")" ::: "memory")
#define PG8_WAIT_L(n) asm volatile("s_waitcnt lgkmcnt(" #n ")" ::: "memory")
#define PG8_BAR __builtin_amdgcn_s_barrier()
#define PG8_SCHED __builtin_amdgcn_sched_barrier(0)
    Unit cur, nxt; int ui = 0;
    if (!S.next(0, cur)) return;
    f32x4 acc[2][2][4][2];
#pragma unroll
    for (int a = 0; a < 2; ++a)
#pragma unroll
        for (int b = 0; b < 2; ++b)
#pragma unroll
            for (int m = 0; m < 4; ++m)
#pragma unroll
                for (int n = 0; n < 2; ++n) acc[a][b][m][n] = (f32x4){0.f, 0.f, 0.f, 0.f};
    bf16x8 At[4][2], B0[2][2], B1[2][2];
    const char* cA = (const char*)g.A + (size_t)cur.pm * tstep; const char* cB = (const char*)g.Bt + (size_t)cur.pn * tstep;
    S.a_ready(cur);
    if constexpr (SP2) {
        PG8_STAGE(PG8_SB(0, 0), cB, voffB); PG8_STAGE(PG8_SB(0, 1), cB + hstep, voffB); PG8_STAGE(PG8_SA(0, 0), cA, voffA); PG8_STAGE(PG8_SA(0, 1), cA + hstep, voffA);
        if (wr == 1) PG8_BAR;
        PG8_WAIT_V(2); PG8_BAR;
        PG8_STAGE(PG8_SB(1, 0), cB + kstep, voffB); PG8_STAGE(PG8_SA(1, 0), cA + kstep, voffA); PG8_STAGE(PG8_SB(1, 1), cB + hstep + kstep, voffB);
        PG8_WAIT_V(6); PG8_BAR;
    } else {
        PG8_STAGE(PG8_SB(0, 0), cB, voffB); PG8_STAGE(PG8_SA(0, 0), cA, voffA); PG8_STAGE(PG8_SB(0, 1), cB + hstep, voffB); PG8_STAGE(PG8_SA(0, 1), cA + hstep, voffA);
        if (wr == 1) PG8_BAR;
        PG8_WAIT_V(4); PG8_BAR;
        PG8_STAGE(PG8_SB(1, 0), cB + kstep, voffB); PG8_STAGE(PG8_SA(1, 0), cA + kstep, voffA); PG8_STAGE(PG8_SB(1, 1), cB + hstep + kstep, voffB);
        PG8_WAIT_V(6); PG8_BAR;
    }
    for (;;) {
        const bool has_next = S.next(ui + 1, nxt);
        const char* nA = has_next ? (const char*)g.A + (size_t)nxt.pm * tstep : cA; const char* nB = has_next ? (const char*)g.Bt + (size_t)nxt.pn * tstep : cB;
        for (int t = 0; t < nt; t += 2) {
            if constexpr (Epi::KHOOK) { if (t == Epi::HK0 || t == Epi::HK1) E.khook(acc, cur, t, wr, wc, fr, fq); }
            const bool last = (t == nt - 2);
            const char* a1 = cA + (size_t)(t + 1) * kstep;
            const char* a2 = last ? nA : cA + (size_t)(t + 2) * kstep; const char* b2 = last ? nB : cB + (size_t)(t + 2) * kstep;
            const char* a3 = a2 + kstep; const char* b3 = b2 + kstep;
            if (last && has_next) S.a_ready(nxt);
            if constexpr (SP2) {
            PG8_LDB(B0, 0, 0); PG8_LDB(B1, 0, 1); PG8_SCHED; PG8_LDA(At, 0, 0); PG8_STAGE(PG8_SA(1, 1), a1 + hstep, voffA);
            PG8_WAIT_V(8); PG8_WAIT_L(0); PG8_BAR; PG8_MMA(0, 0, At, B0); PG8_MMA(0, 1, At, B1); PG8_BAR; PG8_SCHED;
            PG8_LDA(At, 0, 1); PG8_STAGE(PG8_SB(0, 0), b2, voffB); PG8_STAGE(PG8_SB(0, 1), b2 + hstep, voffB); PG8_STAGE(PG8_SA(0, 0), a2, voffA);
            PG8_WAIT_V(8); PG8_WAIT_L(0); PG8_BAR; PG8_MMA(1, 0, At, B0); PG8_MMA(1, 1, At, B1); PG8_BAR; PG8_SCHED;
            PG8_LDB(B0, 1, 0); PG8_LDB(B1, 1, 1); PG8_SCHED; PG8_LDA(At, 1, 0); PG8_STAGE(PG8_SA(0, 1), a2 + hstep, voffA);
            PG8_WAIT_V(8); PG8_WAIT_L(0); PG8_BAR; PG8_MMA(0, 0, At, B0); PG8_MMA(0, 1, At, B1); PG8_BAR; PG8_SCHED;
            PG8_LDA(At, 1, 1); PG8_STAGE(PG8_SB(1, 0), b3, voffB); PG8_STAGE(PG8_SB(1, 1), b3 + hstep, voffB); PG8_STAGE(PG8_SA(1, 0), a3, voffA);
            PG8_WAIT_V(8); PG8_WAIT_L(0); PG8_BAR; PG8_MMA(1, 0, At, B0); PG8_MMA(1, 1, At, B1); PG8_BAR; PG8_SCHED;
            } else {
            PG8_LDB(B0, 0, 0); PG8_SCHED; PG8_LDA(At, 0, 0); PG8_STAGE(PG8_SA(1, 1), a1 + hstep, voffA);
            PG8_WAIT_L(8); PG8_BAR; PG8_WAIT_L(0); PG8_MMA(0, 0, At, B0); PG8_BAR; PG8_SCHED;
            PG8_LDB(B1, 0, 1); PG8_STAGE(PG8_SB(0, 0), b2, voffB);
            PG8_BAR; PG8_WAIT_L(0); PG8_MMA(0, 1, At, B1); PG8_BAR;
            PG8_LDA(At, 0, 1); PG8_STAGE(PG8_SA(0, 0), a2, voffA);
            PG8_BAR; PG8_WAIT_L(0); PG8_MMA(1, 0, At, B0); PG8_BAR; PG8_SCHED;
            PG8_STAGE(PG8_SB(0, 1), b2 + hstep, voffB);
            PG8_WAIT_V(6); PG8_BAR; PG8_MMA(1, 1, At, B1); PG8_BAR;
            PG8_LDB(B0, 1, 0); PG8_SCHED; PG8_LDA(At, 1, 0); PG8_STAGE(PG8_SA(0, 1), a2 + hstep, voffA);
            PG8_WAIT_L(8); PG8_BAR; PG8_WAIT_L(0); PG8_MMA(0, 0, At, B0); PG8_BAR; PG8_SCHED;
            PG8_LDB(B1, 1, 1); PG8_STAGE(PG8_SB(1, 0), b3, voffB);
            PG8_BAR; PG8_WAIT_L(0); PG8_MMA(0, 1, At, B1); PG8_BAR;
            PG8_LDA(At, 1, 1); PG8_STAGE(PG8_SA(1, 0), a3, voffA);
            PG8_BAR; PG8_WAIT_L(0); PG8_MMA(1, 0, At, B0); PG8_BAR; PG8_SCHED;
            PG8_STAGE(PG8_SB(1, 1), b3 + hstep, voffB);
            PG8_WAIT_V(6); PG8_BAR; PG8_MMA(1, 1, At, B1); PG8_BAR;
            }
        }
        if constexpr (ALIGN_EPI) { if (wr == 0) PG8_BAR; }
        if constexpr (!Epi::AFTER_DRAIN) { E(acc, cur, wr, wc, fr, fq); S.done(cur); }
        if (!has_next) break;
#pragma unroll
        for (int a = 0; a < 2; ++a)
#pragma unroll
            for (int b = 0; b < 2; ++b)
#pragma unroll
                for (int m = 0; m < 4; ++m)
#pragma unroll
                    for (int n = 0; n < 2; ++n) acc[a][b][m][n] = (f32x4){0.f, 0.f, 0.f, 0.f};
        cur = nxt; cA = nA; cB = nB; ++ui;
        if constexpr (ALIGN_EPI) { if (wr == 1) PG8_BAR; }
    }
    PG8_WAIT_V(0);
    if constexpr (!ALIGN_EPI) { if (wr == 0) PG8_BAR; }
    PG8_BAR;
    if constexpr (Epi::AFTER_DRAIN) { E.fused(acc, cur, wr, wc, fr, fq, lds, wid, lane); S.done(cur); }
#undef PG8_SA
#undef PG8_SB
#undef PG8_STAGE
#undef PG8_LDA
#undef PG8_LDB
#undef PG8_MMA
#undef PG8_WAIT_V
#undef PG8_WAIT_L
#undef PG8_BAR
#undef PG8_SCHED
}
}

#define GAS __attribute__((address_space(1)))
#define LAS __attribute__((address_space(3)))
typedef unsigned short bf16;
typedef unsigned v4u __attribute__((ext_vector_type(4)));
typedef unsigned v2u __attribute__((ext_vector_type(2)));
typedef float f32x4 __attribute__((ext_vector_type(4)));
typedef float f32x2 __attribute__((ext_vector_type(2)));
typedef short bf16x8 __attribute__((ext_vector_type(8)));
typedef short s16x4 __attribute__((ext_vector_type(4)));

constexpr int NWAVES = 8, NTHREADS = 512;
constexpr int BATCH = 8, SEQ = 2048, DM = 2048, M_TOK = BATCH * SEQ;
constexpr int NPRE = 6400, NGATE = 6144, NIN = NPRE + NGATE;
constexpr int C_AQ = 0, C_AK = 768, C_AV = 1024, C_AG = 1280, C_RS = 2048, C_RR = 2048, C_RK = 2816, C_RV = 3584, C_LORA = 4352, C_RG = 4608, C_XQ = 5376, C_XG = 5888;
constexpr int NMEM = 256, MEMROWS = BATCH * NMEM;
constexpr int RW = 768, NLORA = 3072;
constexpr float NORM_EPS = 1e-6f, GN_EPS = 64e-5f;
constexpr int LDS_BYTES = 147456;

constexpr size_t MiB = 1u << 20;
constexpr size_t WS_PRE = 0, WS_MERGED = 0, WS_GATES = 200 * MiB, WS_YCAT = 392 * MiB;
constexpr size_t WS_WCAT = 456 * MiB, WS_WOUT = 464 * MiB, WS_WXKV = 472 * MiB, WS_MKV = 476 * MiB, WS_MEMN = 480 * MiB, WS_YB = 480 * MiB;
constexpr size_t WS_ROPE = 504 * MiB, WS_LORAB = 505 * MiB, WS_END = 512 * MiB;
constexpr size_t DO_H = 0, DO_WIN = 64 * MiB, DO_EA = 0, DO_LIN = 96 * MiB, DO_YF = 104 * MiB;

struct Params { const float* in[26]; float* out; unsigned char* ws; int ph_lo, ph_hi; };

__device__ __forceinline__ float bf_lo(unsigned w) { return __builtin_bit_cast(float, w << 16); }
__device__ __forceinline__ float bf_hi(unsigned w) { return __builtin_bit_cast(float, w & 0xffff0000u); }
__device__ __forceinline__ float bf1(bf16 h) { return __builtin_bit_cast(float, (unsigned)h << 16); }
__device__ __forceinline__ unsigned f2bf(float f) { unsigned u = __builtin_bit_cast(unsigned, f); return (u + 0x7fffu + ((u >> 16) & 1u)) >> 16; }
__device__ __forceinline__ unsigned pk2(float lo, float hi) { return pg8::cvt_pk_bf16(lo, hi); }
__device__ __forceinline__ float sigmoidf_(float z) { return __builtin_amdgcn_rcpf(1.f + __expf(-z)); }
__device__ __forceinline__ float siluf_(float z) { return z * sigmoidf_(z); }
__device__ __forceinline__ void unpack8(v4u w, float (&x)[8]) { x[0] = bf_lo(w.x); x[1] = bf_hi(w.x); x[2] = bf_lo(w.y); x[3] = bf_hi(w.y); x[4] = bf_lo(w.z); x[5] = bf_hi(w.z); x[6] = bf_lo(w.w); x[7] = bf_hi(w.w); }
__device__ __forceinline__ void unpack4(v2u w, float (&x)[4]) { x[0] = bf_lo(w.x); x[1] = bf_hi(w.x); x[2] = bf_lo(w.y); x[3] = bf_hi(w.y); }
template <int CTRL> __device__ __forceinline__ float dpp_add(float v) { return v + __builtin_bit_cast(float, __builtin_amdgcn_update_dpp(0, __builtin_bit_cast(int, v), CTRL, 0xF, 0xF, true)); }
__device__ __forceinline__ float red8(float v) { v = dpp_add<0xB1>(v); v = dpp_add<0x4E>(v); v = dpp_add<0x141>(v); return v; }

using pg8::Unit;
struct EpiProj {
    static constexpr bool PERM = true, AFTER_DRAIN = false, KHOOK = false; static constexpr int HK0 = -1, HK1 = -1;
    bf16* pre; bf16* gates; const float* gate_b;
    __device__ __forceinline__ void operator()(const f32x4 (&acc)[2][2][4][2], const Unit& u, int wr, int wc, int fr, int fq) const {
        int row0 = u.pm * 256 + wr * 64 + fr;
        asm volatile("" : "+v"(row0));
        const bool isg = u.pn >= 25;
        const int pn = isg ? u.pn - 25 : u.pn;
        bf16* base = isg ? gates : pre; const int ldc = isg ? NGATE : NPRE;
        const int act = isg ? 2 : (((pn >= 5 && pn <= 7) || (pn >= 18 && pn <= 20) || pn >= 23) ? 1 : 0);
        const int col0 = pn * 256 + wc * 32 + 8 * fq;
#pragma unroll
        for (int ai = 0; ai < 2; ++ai)
#pragma unroll
            for (int m = 0; m < 4; ++m) { bf16* rowp = base + (size_t)(row0 + ai * 128 + m * 16) * ldc + col0;
                __builtin_amdgcn_sched_barrier(0);
#pragma unroll
                for (int bj = 0; bj < 2; ++bj) { f32x4 v0 = acc[ai][bj][m][0], v1 = acc[ai][bj][m][1];
                    if (isg) { v0 += *(const f32x4*)(gate_b + col0 + bj * 128); v1 += *(const f32x4*)(gate_b + col0 + bj * 128 + 4); }
                    if (act == 1) {
#pragma unroll
                        for (int i = 0; i < 4; ++i) { v0[i] = siluf_(v0[i]); v1[i] = siluf_(v1[i]); }
                    } else if (act == 2) {
#pragma unroll
                        for (int i = 0; i < 4; ++i) { v0[i] = sigmoidf_(v0[i]); v1[i] = sigmoidf_(v1[i]); }
                    }
                    v4u w; w.x = pk2(v0[0], v0[1]); w.y = pk2(v0[2], v0[3]); w.z = pk2(v1[0], v1[1]); w.w = pk2(v1[2], v1[3]);
                    *(v4u*)(rowp + bj * 128) = w; } }
    }
};
struct EpiPlain {
    static constexpr bool PERM = true, AFTER_DRAIN = false, KHOOK = false; static constexpr int HK0 = -1, HK1 = -1;
    bf16* O; int ldc;
    __device__ __forceinline__ void operator()(const f32x4 (&acc)[2][2][4][2], const Unit& u, int wr, int wc, int fr, int fq) const {
        int row0 = u.pm * 256 + wr * 64 + fr, col0 = u.pn * 256 + wc * 32 + 8 * fq;
        asm volatile("" : "+v"(row0), "+v"(col0));
#pragma unroll
        for (int ai = 0; ai < 2; ++ai)
#pragma unroll
            for (int m = 0; m < 4; ++m) { bf16* rowp = O + (size_t)(row0 + ai * 128 + m * 16) * ldc + col0;
#pragma unroll
                for (int bj = 0; bj < 2; ++bj) { const f32x4 v0 = acc[ai][bj][m][0], v1 = acc[ai][bj][m][1];
                    v4u w; w.x = pk2(v0[0], v0[1]); w.y = pk2(v0[2], v0[3]); w.z = pk2(v1[0], v1[1]); w.w = pk2(v1[2], v1[3]);
                    *(v4u*)(rowp + bj * 128) = w; } }
    }
};
struct EpiLora {
    static constexpr bool PERM = true, AFTER_DRAIN = false, KHOOK = false; static constexpr int HK0 = -1, HK1 = -1;
    bf16* O; const float* w0; const float* a0;
    __device__ __forceinline__ void operator()(const f32x4 (&acc)[2][2][4][2], const Unit& u, int wr, int wc, int fr, int fq) const {
        int row0 = u.pm * 256 + wr * 64 + fr, col0 = u.pn * 256 + wc * 32 + 8 * fq;
        asm volatile("" : "+v"(row0), "+v"(col0));
        const bool isw = u.pn < 6; const float* bias = isw ? (w0 + col0) : (a0 + col0 - 1536); const float sc = isw ? 0.6065306597126334f : 1.f;
#pragma unroll
        for (int ai = 0; ai < 2; ++ai)
#pragma unroll
            for (int m = 0; m < 4; ++m) { bf16* rowp = O + (size_t)(row0 + ai * 128 + m * 16) * NLORA + col0;
                __builtin_amdgcn_sched_barrier(0);
#pragma unroll
                for (int bj = 0; bj < 2; ++bj) { f32x4 v0 = acc[ai][bj][m][0] + *(const f32x4*)(bias + bj * 128), v1 = acc[ai][bj][m][1] + *(const f32x4*)(bias + bj * 128 + 4);
#pragma unroll
                    for (int i = 0; i < 4; ++i) { v0[i] = sc * sigmoidf_(v0[i]); v1[i] = sc * sigmoidf_(v1[i]); }
                    v4u w; w.x = pk2(v0[0], v0[1]); w.y = pk2(v0[2], v0[3]); w.z = pk2(v1[0], v1[1]); w.w = pk2(v1[2], v1[3]);
                    *(v4u*)(rowp + bj * 128) = w; } }
    }
};
struct EpiMerged {
    static constexpr bool PERM = true, AFTER_DRAIN = false, KHOOK = true; static constexpr int HK0 = 12, HK1 = 24;
    bf16* O; const bf16* gates;
    __device__ __forceinline__ void khook(f32x4 (&acc)[2][2][4][2], const Unit& u, int t, int wr, int wc, int fr, int fq) const {
        int row0 = u.pm * 256 + wr * 64 + fr, col0 = u.pn * 256 + wc * 32 + 8 * fq;
        asm volatile("" : "+v"(row0), "+v"(col0));
        const int bo = (t == HK0) ? 0 : DM;
#pragma unroll
        for (int ai = 0; ai < 2; ++ai)
#pragma unroll
            for (int m = 0; m < 4; ++m) { const bf16* gp = gates + (size_t)(row0 + ai * 128 + m * 16) * NGATE + bo + col0;
                __builtin_amdgcn_sched_barrier(0);
#pragma unroll
                for (int bj = 0; bj < 2; ++bj) { const v4u a = *(const v4u*)(gp + bj * 128), b = *(const v4u*)(gp + DM + bj * 128);
                    float x[8], y[8]; unpack8(a, x); unpack8(b, y);
#pragma unroll
                    for (int i = 0; i < 4; ++i) { acc[ai][bj][m][0][i] *= x[i] * __builtin_amdgcn_rcpf(y[i]); acc[ai][bj][m][1][i] *= x[4 + i] * __builtin_amdgcn_rcpf(y[4 + i]); } } }
    }
    __device__ __forceinline__ void operator()(const f32x4 (&acc)[2][2][4][2], const Unit& u, int wr, int wc, int fr, int fq) const {
        int row0 = u.pm * 256 + wr * 64 + fr, col0 = u.pn * 256 + wc * 32 + 8 * fq;
        asm volatile("" : "+v"(row0), "+v"(col0));
#pragma unroll
        for (int ai = 0; ai < 2; ++ai)
#pragma unroll
            for (int m = 0; m < 4; ++m) { const size_t r = (size_t)(row0 + ai * 128 + m * 16);
                __builtin_amdgcn_sched_barrier(0);
#pragma unroll
                for (int bj = 0; bj < 2; ++bj) { const v4u g = *(const v4u*)(gates + r * NGATE + 2 * DM + col0 + bj * 128); float x[8]; unpack8(g, x);
                    const f32x4 v0 = acc[ai][bj][m][0], v1 = acc[ai][bj][m][1];
                    v4u w; w.x = pk2(v0[0] * x[0], v0[1] * x[1]); w.y = pk2(v0[2] * x[2], v0[3] * x[3]); w.z = pk2(v1[0] * x[4], v1[1] * x[5]); w.w = pk2(v1[2] * x[6], v1[3] * x[7]);
                    *(v4u*)(O + r * DM + col0 + bj * 128) = w; } }
    }
};
struct EpiOut {
    static constexpr bool PERM = true, AFTER_DRAIN = false, KHOOK = false; static constexpr int HK0 = -1, HK1 = -1;
    float* O; const float* X;
    __device__ __forceinline__ void operator()(const f32x4 (&acc)[2][2][4][2], const Unit& u, int wr, int wc, int fr, int fq) const {
        int row0 = u.pm * 256 + wr * 64 + fr, col0 = u.pn * 256 + wc * 32 + 8 * fq;
        asm volatile("" : "+v"(row0), "+v"(col0));
#pragma unroll
        for (int ai = 0; ai < 2; ++ai)
#pragma unroll
            for (int m = 0; m < 4; ++m) { const size_t o = (size_t)(row0 + ai * 128 + m * 16) * DM + col0;
                __builtin_amdgcn_sched_barrier(0);
#pragma unroll
                for (int bj = 0; bj < 2; ++bj) {
                    const f32x4 x0 = *(const f32x4*)(X + o + bj * 128), x1 = *(const f32x4*)(X + o + bj * 128 + 4);
                    *(f32x4*)(O + o + bj * 128) = x0 + acc[ai][bj][m][0]; *(f32x4*)(O + o + bj * 128 + 4) = x1 + acc[ai][bj][m][1]; } }
    }
};

__device__ __forceinline__ float wave_sum(float v) {
#pragma unroll
    for (int o = 1; o < 64; o <<= 1) v += __shfl_xor(v, o);
    return v;
}
__device__ __forceinline__ void transpose_item(const float* W, int N, bf16* WT, int ldt, int koff, LAS float* scr, int item, int lane) {
    const int nblk = N / 32, kb = item / nblk, nb = item % nblk, k0 = 64 * kb, n0 = 32 * nb;
#pragma unroll 8
    for (int i = 0; i < 32; ++i) { const int kk = 2 * i + (lane >> 5); scr[kk * 33 + (lane & 31)] = W[(size_t)(k0 + kk) * N + n0 + (lane & 31)]; }
    asm volatile("s_waitcnt lgkmcnt(0)" ::: "memory");
    const int c = lane & 7;
#pragma unroll
    for (int j = 0; j < 4; ++j) { const int n = (lane >> 3) + 8 * j; const LAS float* s = scr + (8 * c) * 33 + n;
        v4u o; o.x = pk2(s[0 * 33], s[1 * 33]); o.y = pk2(s[2 * 33], s[3 * 33]); o.z = pk2(s[4 * 33], s[5 * 33]); o.w = pk2(s[6 * 33], s[7 * 33]);
        *(v4u*)(WT + (size_t)(n0 + n) * ldt + koff + k0 + 8 * c) = o; }
    asm volatile("s_waitcnt lgkmcnt(0)" ::: "memory");
}
__device__ __forceinline__ void rms_row_to_bf16(const float* xrow, const float* g, bf16* orow, int lane) {
    const f32x4* xr = (const f32x4*)xrow + lane; const f32x4* gr = (const f32x4*)g + lane;
    f32x4 v[8]; float s = 0.f;
#pragma unroll
    for (int j = 0; j < 8; ++j) { v[j] = xr[64 * j]; s += (v[j].x * v[j].x + v[j].y * v[j].y) + (v[j].z * v[j].z + v[j].w * v[j].w); }
    const float rstd = 1.f / sqrtf(wave_sum(s) * (1.f / DM) + NORM_EPS);
    v2u* o8 = (v2u*)orow + lane;
#pragma unroll
    for (int j = 0; j < 8; ++j) { const f32x4 gg = gr[64 * j]; v2u o; o.x = pk2(v[j].x * rstd * gg.x, v[j].y * rstd * gg.y); o.y = pk2(v[j].z * rstd * gg.z, v[j].w * rstd * gg.w); o8[64 * j] = o; }
}
__device__ __forceinline__ void p0_prologue(const Params& P, LAS unsigned char* lds, float* dout_scratch) {
    const int tid = pg8::mk_tid(lds), lane = tid & 63, wave = tid >> 6, G = gridDim.x;
    LAS float* scr = (LAS float*)(lds + wave * 16384);
    const int gw = blockIdx.x * NWAVES + wave, NGW = G * NWAVES;
    unsigned char* ws = P.ws; unsigned char* dob = (unsigned char*)P.out;
    bf16* WIN_T = (bf16*)(dob + DO_WIN); bf16* WCAT_T = (bf16*)(ws + WS_WCAT); bf16* WOUT_T = (bf16*)(ws + WS_WOUT); bf16* WXKV_T = (bf16*)(ws + WS_WXKV);
    constexpr int I_IN = 32 * (NIN / 32), I_A = 12 * 64, I_R = 12 * 64, I_X = 8 * 64, I_O = 32 * 64, I_KV = 32 * 32;
    constexpr int NITEMS = I_IN + I_A + I_R + I_X + I_O + I_KV;
    for (int it = gw; it < NITEMS; it += NGW) {
        int r = it;
        if (r < I_IN) { transpose_item(P.in[4], NIN, WIN_T, DM, 0, scr, r, lane); continue; } r -= I_IN;
        if (r < I_A) { transpose_item(P.in[9], DM, WCAT_T, DM, 0, scr, r, lane); continue; } r -= I_A;
        if (r < I_R) { transpose_item(P.in[20], DM, WCAT_T, DM, 768, scr, r, lane); continue; } r -= I_R;
        if (r < I_X) { transpose_item(P.in[24], DM, WCAT_T, DM, 1536, scr, r, lane); continue; } r -= I_X;
        if (r < I_O) { transpose_item(P.in[25], DM, WOUT_T, DM, 0, scr, r, lane); continue; } r -= I_O;
        transpose_item(P.in[21], 1024, WXKV_T, DM, 0, scr, r, lane);
    }
    bf16* H = (bf16*)(dob + DO_H); bf16* MEMN = (bf16*)(ws + WS_MEMN);
    for (int m = gw; m < M_TOK + MEMROWS; m += NGW) {
        if (m < M_TOK) rms_row_to_bf16(P.in[0] + (size_t)m * DM, P.in[2], H + (size_t)m * DM, lane);
        else rms_row_to_bf16(P.in[1] + (size_t)(m - M_TOK) * DM, P.in[3], MEMN + (size_t)(m - M_TOK) * DM, lane);
    }
    bf16* LB = (bf16*)(ws + WS_LORAB);
    const int gt = blockIdx.x * NTHREADS + tid, NGT = G * NTHREADS;
    for (int idx = gt; idx < NLORA * 256; idx += NGT) {
        const int n = idx >> 8, k = idx & 255, d = n / RW, ch = n % RW, kb = k >> 6, kk = k & 63;
        float v = 0.f;
        if (kb == d) v = (d < 2) ? P.in[15][(size_t)(d * 64 + kk) * RW + ch] : P.in[17][(size_t)((d - 2) * 64 + kk) * RW + ch];
        LB[idx] = (bf16)f2bf(v);
    }
    float* RC = (float*)(ws + WS_ROPE); float* RS = RC + SEQ * 32;
    for (int idx = gt; idx < SEQ * 32; idx += NGT) {
        const int pos = idx >> 5, i = idx & 31;
        const float inv = __builtin_exp2f(-(float)i * (13.287712379549449f / 32.f));
        const float ang = (float)pos * inv;
        double rv = (double)ang * 0.15915494309189535; rv -= __builtin_floor(rv);
        const float r = (float)rv;
        RC[idx] = __builtin_amdgcn_cosf(r); RS[idx] = __builtin_amdgcn_sinf(r);
    }
}

__device__ __forceinline__ void p2_lora_in(const Params& P, LAS unsigned char* lds) {
    const bf16* PRE = (const bf16*)(P.ws + WS_PRE); bf16* LIN = (bf16*)((unsigned char*)P.out + DO_LIN); const float* mu = P.in[10];
    const int gt = blockIdx.x * NTHREADS + pg8::mk_tid(lds), NGT = gridDim.x * NTHREADS;
    for (int idx = gt; idx < M_TOK * 128; idx += NGT) {
        const int m = idx >> 7, j = (idx & 127) * 2, t = m & (SEQ - 1);
        const bf16* p = PRE + (size_t)m * NPRE + C_LORA + j;
        const unsigned c = *(const unsigned*)p;
        const unsigned pv = (t > 0) ? *(const unsigned*)(p - NPRE) : 0u;
        const unsigned nx = (t < SEQ - 1) ? *(const unsigned*)(p + NPRE) : 0u;
        const float m0 = mu[2304 + j], m1 = mu[2304 + j + 1];
        float s0 = bf_lo(c) + m0 * (0.5f * (bf_lo(pv) + bf_lo(nx)) - bf_lo(c));
        float s1 = bf_hi(c) + m1 * (0.5f * (bf_hi(pv) + bf_hi(nx)) - bf_hi(c));
        if (j < 128) { s0 = 1.f - 2.f * __builtin_amdgcn_rcpf(__expf(2.f * s0) + 1.f); s1 = 1.f - 2.f * __builtin_amdgcn_rcpf(__expf(2.f * s1) + 1.f); }
        *(unsigned*)(LIN + (size_t)m * 256 + j) = pk2(s0, s1);
    }
}

constexpr int SC_CH = 32, SC_REC = 1536, SC_BUF = SC_CH * SC_REC, SC_SCAL = 2 * SC_BUF;
__device__ __forceinline__ void scan_block(const Params& P, int sid, LAS unsigned char* lds) {
    const int tid = pg8::mk_tid(lds), lane = tid & 63, wave = __builtin_amdgcn_readfirstlane(tid >> 6);
    const int b = sid / 24, rem = sid % 24, h = rem >> 1, dir = rem & 1;
    const bf16* PRE = (const bf16*)(P.ws + WS_PRE); const bf16* EA = (const bf16*)((unsigned char*)P.out + DO_EA);
    bf16* YO = dir ? (bf16*)(P.ws + WS_YB) : (bf16*)((unsigned char*)P.out + DO_YF);
    constexpr int NCH = SEQ / SC_CH;
    if (wave >= 4) {
        const int pt = tid - 256, sl = pt >> 3, e = pt & 7, ch0 = h * 64 + 8 * e;
        float mur[8], muk[8], muv[8], kkc[8], kac[8];
#pragma unroll
        for (int i = 0; i < 8; ++i) { mur[i] = P.in[10][ch0 + i]; muk[i] = P.in[10][768 + ch0 + i]; muv[i] = P.in[10][1536 + ch0 + i]; kkc[i] = P.in[11][ch0 + i]; kac[i] = P.in[12][ch0 + i]; }
        for (int c = 0; c <= NCH; ++c) {
            if (c < NCH) {
                LAS unsigned char* buf = lds + (c & 1) * SC_BUF; LAS float* scal = (LAS float*)(lds + SC_SCAL) + (c & 1) * (SC_CH * 2);
                const int step = c * SC_CH + sl, t = dir ? (SEQ - 1 - step) : step; const size_t m = (size_t)b * SEQ + t;
                const bf16* rowp = PRE + m * NPRE + C_RS + ch0;
                const v4u z4 = (v4u){0u, 0u, 0u, 0u};
                const v4u rc = *(const v4u*)(rowp), kc = *(const v4u*)(rowp + 768), vc = *(const v4u*)(rowp + 1536);
                const v4u rp = (t > 0) ? *(const v4u*)(rowp - NPRE) : z4, kp = (t > 0) ? *(const v4u*)(rowp - NPRE + 768) : z4, vp = (t > 0) ? *(const v4u*)(rowp - NPRE + 1536) : z4;
                const v4u rn = (t < SEQ - 1) ? *(const v4u*)(rowp + NPRE) : z4, kn = (t < SEQ - 1) ? *(const v4u*)(rowp + NPRE + 768) : z4, vn = (t < SEQ - 1) ? *(const v4u*)(rowp + NPRE + 1536) : z4;
                const bf16* eap = EA + m * NLORA + dir * RW + ch0;
                const v4u e8 = *(const v4u*)(eap), a8 = *(const v4u*)(eap + 1536);
                float r[8], k[8], v[8], x0[8], x1[8], x2[8];
                unpack8(rc, x0); unpack8(rp, x1); unpack8(rn, x2);
#pragma unroll
                for (int i = 0; i < 8; ++i) r[i] = x0[i] + mur[i] * (0.5f * (x1[i] + x2[i]) - x0[i]);
                unpack8(kc, x0); unpack8(kp, x1); unpack8(kn, x2);
#pragma unroll
                for (int i = 0; i < 8; ++i) k[i] = x0[i] + muk[i] * (0.5f * (x1[i] + x2[i]) - x0[i]);
                unpack8(vc, x0); unpack8(vp, x1); unpack8(vn, x2);
#pragma unroll
                for (int i = 0; i < 8; ++i) v[i] = x0[i] + muv[i] * (0.5f * (x1[i] + x2[i]) - x0[i]);
                float ee[8], aa[8]; unpack8(e8, ee); unpack8(a8, aa);
                float kk[8], ss = 0.f;
#pragma unroll
                for (int i = 0; i < 8; ++i) { kk[i] = k[i] * kkc[i]; ss += kk[i] * kk[i]; }
                ss = red8(ss);
                const float inv = 1.f / fmaxf(sqrtf(ss), 1e-12f);
                float nkk[8], dd[8], dr[8], bb[8], kd[8], sbr = 0.f, skr = 0.f;
#pragma unroll
                for (int i = 0; i < 8; ++i) {
                    const float kki = kk[i] * inv; nkk[i] = -kki; dd[i] = __expf(-ee[i]); dr[i] = dd[i] * r[i];
                    bb[i] = kki * aa[i]; kd[i] = k[i] * (1.f + (aa[i] - 1.f) * kac[i]); sbr += bb[i] * r[i]; skr += kd[i] * r[i];
                }
                sbr = red8(sbr); skr = red8(skr);
                LAS float* rec = (LAS float*)(buf + sl * SC_REC) + 8 * e;
                *(LAS f32x4*)(rec) = (f32x4){nkk[0], nkk[1], nkk[2], nkk[3]}; *(LAS f32x4*)(rec + 4) = (f32x4){nkk[4], nkk[5], nkk[6], nkk[7]};
                *(LAS f32x4*)(rec + 64) = (f32x4){dr[0], dr[1], dr[2], dr[3]}; *(LAS f32x4*)(rec + 68) = (f32x4){dr[4], dr[5], dr[6], dr[7]};
                *(LAS f32x4*)(rec + 128) = (f32x4){dd[0], dd[1], dd[2], dd[3]}; *(LAS f32x4*)(rec + 132) = (f32x4){dd[4], dd[5], dd[6], dd[7]};
                *(LAS f32x4*)(rec + 192) = (f32x4){bb[0], bb[1], bb[2], bb[3]}; *(LAS f32x4*)(rec + 196) = (f32x4){bb[4], bb[5], bb[6], bb[7]};
                *(LAS f32x4*)(rec + 256) = (f32x4){kd[0], kd[1], kd[2], kd[3]}; *(LAS f32x4*)(rec + 260) = (f32x4){kd[4], kd[5], kd[6], kd[7]};
                *(LAS f32x4*)(rec + 320) = (f32x4){v[0], v[1], v[2], v[3]}; *(LAS f32x4*)(rec + 324) = (f32x4){v[4], v[5], v[6], v[7]};
                if (e == 0) *(LAS f32x2*)(scal + 2 * sl) = (f32x2){sbr, skr};
            }
            __syncthreads();
        }
    } else {
        const int rp = (wave * 64 + lane) >> 3, cgp = lane & 7;
        f32x2 s0[4], s1[4];
#pragma unroll
        for (int i = 0; i < 4; ++i) { s0[i] = (f32x2){0.f, 0.f}; s1[i] = (f32x2){0.f, 0.f}; }
        __syncthreads();
        for (int c = 0; c < NCH; ++c) {
            const LAS unsigned char* buf = lds + (c & 1) * SC_BUF; const LAS float* scal = (const LAS float*)(lds + SC_SCAL) + (c & 1) * (SC_CH * 2);
#pragma unroll 2
            for (int sl = 0; sl < SC_CH; ++sl) {
                const LAS float* rec = (const LAS float*)(buf + sl * SC_REC) + 8 * cgp;
                const f32x4 n0 = *(const LAS f32x4*)(rec), n1 = *(const LAS f32x4*)(rec + 4);
                const f32x4 q0 = *(const LAS f32x4*)(rec + 64), q1 = *(const LAS f32x4*)(rec + 68);
                const f32x4 d0 = *(const LAS f32x4*)(rec + 128), d1 = *(const LAS f32x4*)(rec + 132);
                const f32x4 b0 = *(const LAS f32x4*)(rec + 192), b1 = *(const LAS f32x4*)(rec + 196);
                const f32x4 k0 = *(const LAS f32x4*)(rec + 256), k1 = *(const LAS f32x4*)(rec + 260);
                const f32x2 vv = *(const LAS f32x2*)((const LAS float*)(buf + sl * SC_REC) + 320 + 2 * rp);
                const f32x2 sc = *(const LAS f32x2*)(scal + 2 * sl);
                const f32x2 nk[4] = {(f32x2){n0.x, n0.y}, (f32x2){n0.z, n0.w}, (f32x2){n1.x, n1.y}, (f32x2){n1.z, n1.w}};
                const f32x2 qq[4] = {(f32x2){q0.x, q0.y}, (f32x2){q0.z, q0.w}, (f32x2){q1.x, q1.y}, (f32x2){q1.z, q1.w}};
                const f32x2 dv[4] = {(f32x2){d0.x, d0.y}, (f32x2){d0.z, d0.w}, (f32x2){d1.x, d1.y}, (f32x2){d1.z, d1.w}};
                const f32x2 bv[4] = {(f32x2){b0.x, b0.y}, (f32x2){b0.z, b0.w}, (f32x2){b1.x, b1.y}, (f32x2){b1.z, b1.w}};
                const f32x2 kv[4] = {(f32x2){k0.x, k0.y}, (f32x2){k0.z, k0.w}, (f32x2){k1.x, k1.y}, (f32x2){k1.z, k1.w}};
                f32x2 a0 = s0[0] * nk[0], a1 = s1[0] * nk[0], y0 = s0[0] * qq[0], y1 = s1[0] * qq[0];
#pragma unroll
                for (int i = 1; i < 4; ++i) { a0 = s0[i] * nk[i] + a0; a1 = s1[i] * nk[i] + a1; y0 = s0[i] * qq[i] + y0; y1 = s1[i] * qq[i] + y1; }
                float sa0 = a0.x + a0.y, sa1 = a1.x + a1.y, yp0 = y0.x + y0.y, yp1 = y1.x + y1.y;
                sa0 = red8(sa0); sa1 = red8(sa1); yp0 = red8(yp0); yp1 = red8(yp1);
                const float yo0 = yp0 + sa0 * sc.x + vv.x * sc.y, yo1 = yp1 + sa1 * sc.x + vv.y * sc.y;
                const f32x2 sa0v = (f32x2){sa0, sa0}, sa1v = (f32x2){sa1, sa1}, v0v = (f32x2){vv.x, vv.x}, v1v = (f32x2){vv.y, vv.y};
#pragma unroll
                for (int i = 0; i < 4; ++i) {
                    f32x2 t0 = v0v * kv[i]; t0 = sa0v * bv[i] + t0; s0[i] = s0[i] * dv[i] + t0;
                    f32x2 t1 = v1v * kv[i]; t1 = sa1v * bv[i] + t1; s1[i] = s1[i] * dv[i] + t1;
                }
                if (cgp == 0) {
                    const int step = c * SC_CH + sl, t = dir ? (SEQ - 1 - step) : step;
                    *(unsigned*)(YO + ((size_t)b * SEQ + t) * RW + h * 64 + 2 * rp) = pk2(yo0, yo1);
                }
            }
            __syncthreads();
        }
    }
}

__device__ __forceinline__ bf16x8 pack8(const float (&x)[8]) {
    v4u w; w.x = pk2(x[0], x[1]); w.y = pk2(x[2], x[3]); w.z = pk2(x[4], x[5]); w.w = pk2(x[6], x[7]); return __builtin_bit_cast(bf16x8, w);
}
#define MFMA16(a, b, c) __builtin_amdgcn_mfma_f32_16x16x32_bf16((a), (b), (c), 0, 0, 0)
constexpr int KA_P = 72, VA_P = 392;
__device__ __forceinline__ void attnA_item(const Params& P, int item, LAS unsigned char* lds) {
    const int tid = pg8::mk_tid(lds), lane = tid & 63, wave = __builtin_amdgcn_readfirstlane(tid >> 6), l15 = lane & 15, q4 = lane >> 4;
    const int b = item >> 6, n = (item >> 2) & 15, hk = item & 3;
    const bf16* PRE = (const bf16*)(P.ws + WS_PRE); bf16* YC = (bf16*)(P.ws + WS_YCAT);
    const float* RC = (const float*)(P.ws + WS_ROPE); const float* RS = RC + SEQ * 32;
    LAS bf16* Ks = (LAS bf16*)lds; LAS bf16* Vt = Ks + 384 * KA_P;
    for (int it = tid; it < 3072; it += NTHREADS) {
        const int j = it >> 3, c = it & 7, kp = (n - 1) * 128 + j;
        v2u o0 = (v2u){0u, 0u}, o1 = (v2u){0u, 0u};
        if (kp >= 0 && kp < SEQ) {
            const bf16* src = PRE + ((size_t)b * SEQ + kp) * NPRE + C_AK + hk * 64;
            const v2u lo = *(const v2u*)(src + 4 * c), hi = *(const v2u*)(src + 32 + 4 * c);
            float x1[4], x2[4]; unpack4(lo, x1); unpack4(hi, x2);
            float ss = 0.f;
#pragma unroll
            for (int i = 0; i < 4; ++i) ss += x1[i] * x1[i] + x2[i] * x2[i];
            ss = red8(ss);
            const float rstd = 1.f / sqrtf(ss * (1.f / 64.f) + NORM_EPS);
            const f32x4 g1 = *(const f32x4*)(P.in[7] + 4 * c), g2 = *(const f32x4*)(P.in[7] + 32 + 4 * c);
            const f32x4 cs = *(const f32x4*)(RC + kp * 32 + 4 * c), sn = *(const f32x4*)(RS + kp * 32 + 4 * c);
            float r1[4], r2[4];
#pragma unroll
            for (int i = 0; i < 4; ++i) { const float y1 = x1[i] * rstd * g1[i], y2 = x2[i] * rstd * g2[i]; r1[i] = y1 * cs[i] - y2 * sn[i]; r2[i] = y2 * cs[i] + y1 * sn[i]; }
            o0.x = pk2(r1[0], r1[1]); o0.y = pk2(r1[2], r1[3]); o1.x = pk2(r2[0], r2[1]); o1.y = pk2(r2[2], r2[3]);
        }
        *(LAS v2u*)(Ks + j * KA_P + 4 * c) = o0; *(LAS v2u*)(Ks + j * KA_P + 32 + 4 * c) = o1;
    }
    for (int it = tid; it < 3072; it += NTHREADS) {
        const int j = it >> 3, c = it & 7, kp = (n - 1) * 128 + j;
        v4u w = (v4u){0u, 0u, 0u, 0u};
        if (kp >= 0 && kp < SEQ) w = *(const v4u*)(PRE + ((size_t)b * SEQ + kp) * NPRE + C_AV + hk * 64 + 8 * c);
        LAS bf16* d = Vt + (8 * c) * VA_P + j;
        d[0] = (bf16)(w.x & 0xffffu); d[VA_P] = (bf16)(w.x >> 16); d[2 * VA_P] = (bf16)(w.y & 0xffffu); d[3 * VA_P] = (bf16)(w.y >> 16);
        d[4 * VA_P] = (bf16)(w.z & 0xffffu); d[5 * VA_P] = (bf16)(w.z >> 16); d[6 * VA_P] = (bf16)(w.w & 0xffffu); d[7 * VA_P] = (bf16)(w.w >> 16);
    }
    __syncthreads();
    for (int mt = 0; mt < 3; ++mt) {
        const int R0 = wave * 48 + mt * 16, g = R0 >> 7, pos = (R0 & 127) + l15, qp = n * 128 + pos, hq = hk * 3 + g;
        const size_t m = (size_t)b * SEQ + qp;
        bf16x8 qf0, qf1;
        {
            const bf16* src = PRE + m * NPRE + C_AQ + hq * 64;
            const v4u lo = *(const v4u*)(src + 8 * q4), hi = *(const v4u*)(src + 32 + 8 * q4);
            float x1[8], x2[8]; unpack8(lo, x1); unpack8(hi, x2);
            float ss = 0.f;
#pragma unroll
            for (int i = 0; i < 8; ++i) ss += x1[i] * x1[i] + x2[i] * x2[i];
            ss += __shfl_xor(ss, 16); ss += __shfl_xor(ss, 32);
            const float rstd = 0.125f / sqrtf(ss * (1.f / 64.f) + NORM_EPS);
            float r1[8], r2[8];
#pragma unroll
            for (int i = 0; i < 8; ++i) {
                const float g1 = P.in[6][8 * q4 + i], g2 = P.in[6][32 + 8 * q4 + i], cs = RC[qp * 32 + 8 * q4 + i], sn = RS[qp * 32 + 8 * q4 + i];
                const float y1 = x1[i] * rstd * g1, y2 = x2[i] * rstd * g2; r1[i] = y1 * cs - y2 * sn; r2[i] = y2 * cs + y1 * sn;
            }
            qf0 = pack8(r1); qf1 = pack8(r2);
        }
        f32x4 acc[24];
#pragma unroll
        for (int kt = 0; kt < 24; ++kt) {
            const LAS bf16* kr = Ks + (kt * 16 + l15) * KA_P + 8 * q4;
            const bf16x8 k0 = *(const LAS bf16x8*)(kr), k1 = *(const LAS bf16x8*)(kr + 32);
            f32x4 a = (f32x4){0.f, 0.f, 0.f, 0.f};
            a = MFMA16(k0, qf0, a); a = MFMA16(k1, qf1, a); acc[kt] = a;
        }
        const float sink = P.in[8][hq];
        float mx = sink;
#pragma unroll
        for (int kt = 0; kt < 24; ++kt)
#pragma unroll
            for (int i = 0; i < 4; ++i) {
                const int j = kt * 16 + 4 * q4 + i, rel = j - 128 - pos, kp = (n - 1) * 128 + j;
                const bool valid = (rel >= -128) && (rel <= 128) && (kp >= 0) && (kp < SEQ);
                const float sv = valid ? acc[kt][i] : -1e30f; acc[kt][i] = sv; mx = fmaxf(mx, sv);
            }
        mx = fmaxf(mx, __shfl_xor(mx, 16)); mx = fmaxf(mx, __shfl_xor(mx, 32));
        float sum = 0.f;
#pragma unroll
        for (int kt = 0; kt < 24; ++kt)
#pragma unroll
            for (int i = 0; i < 4; ++i) { const float p = __expf(acc[kt][i] - mx); acc[kt][i] = p; sum += p; }
        sum += __shfl_xor(sum, 16); sum += __shfl_xor(sum, 32);
        const float inv = 1.f / (sum + __expf(sink - mx));
        f32x4 o[4];
#pragma unroll
        for (int dt = 0; dt < 4; ++dt) o[dt] = (f32x4){0.f, 0.f, 0.f, 0.f};
#pragma unroll
        for (int k2 = 0; k2 < 12; ++k2) {
            float pp[8] = {acc[2 * k2][0], acc[2 * k2][1], acc[2 * k2][2], acc[2 * k2][3], acc[2 * k2 + 1][0], acc[2 * k2 + 1][1], acc[2 * k2 + 1][2], acc[2 * k2 + 1][3]};
            const bf16x8 pf = pack8(pp);
#pragma unroll
            for (int dt = 0; dt < 4; ++dt) {
                const LAS bf16* vr = Vt + (dt * 16 + l15) * VA_P + k2 * 32 + 4 * q4;
                const v2u v0 = *(const LAS v2u*)(vr), v1 = *(const LAS v2u*)(vr + 16);
                const v4u vw = (v4u){v0.x, v0.y, v1.x, v1.y};
                o[dt] = MFMA16(__builtin_bit_cast(bf16x8, vw), pf, o[dt]);
            }
        }
#pragma unroll
        for (int dt = 0; dt < 4; ++dt) {
            const int ch = hq * 64 + dt * 16 + 4 * q4;
            const v2u gw = *(const v2u*)(PRE + m * NPRE + C_AG + ch); float gg[4]; unpack4(gw, gg);
            v2u w; w.x = pk2(o[dt][0] * inv * gg[0], o[dt][1] * inv * gg[1]); w.y = pk2(o[dt][2] * inv * gg[2], o[dt][3] * inv * gg[3]);
            *(v2u*)(YC + m * DM + ch) = w;
        }
    }
    __syncthreads();
}

constexpr int KC_P = 136, VC_P = 264;
__device__ __forceinline__ void attnC_item(const Params& P, int item, LAS unsigned char* lds) {
    const int tid = pg8::mk_tid(lds), lane = tid & 63, wave = __builtin_amdgcn_readfirstlane(tid >> 6), l15 = lane & 15, q4 = lane >> 4;
    const int b = item >> 6, qb = (item >> 2) & 15, hx = item & 3;
    const bf16* PRE = (const bf16*)(P.ws + WS_PRE); const bf16* MKV = (const bf16*)(P.ws + WS_MKV); bf16* YC = (bf16*)(P.ws + WS_YCAT);
    LAS bf16* Ks = (LAS bf16*)lds; LAS bf16* Vt = Ks + 256 * KC_P;
    for (int it = tid; it < 4096; it += NTHREADS) {
        const int j = it >> 4, c = it & 15;
        const v4u w = *(const v4u*)(MKV + ((size_t)b * NMEM + j) * 1024 + hx * 128 + 8 * c);
        float x[8]; unpack8(w, x);
        float ss = 0.f;
#pragma unroll
        for (int i = 0; i < 8; ++i) ss += x[i] * x[i];
        ss = red8(ss); ss += __shfl_xor(ss, 8);
        const float rstd = 1.f / sqrtf(ss * (1.f / 128.f) + NORM_EPS);
        const f32x4 g0 = *(const f32x4*)(P.in[23] + 8 * c), g1 = *(const f32x4*)(P.in[23] + 8 * c + 4);
        v4u o; o.x = pk2(x[0] * rstd * g0.x, x[1] * rstd * g0.y); o.y = pk2(x[2] * rstd * g0.z, x[3] * rstd * g0.w);
        o.z = pk2(x[4] * rstd * g1.x, x[5] * rstd * g1.y); o.w = pk2(x[6] * rstd * g1.z, x[7] * rstd * g1.w);
        *(LAS v4u*)(Ks + j * KC_P + 8 * c) = o;
    }
    for (int it = tid; it < 4096; it += NTHREADS) {
        const int j = it >> 4, c = it & 15;
        const v4u w = *(const v4u*)(MKV + ((size_t)b * NMEM + j) * 1024 + 512 + hx * 128 + 8 * c);
        LAS bf16* d = Vt + (8 * c) * VC_P + j;
        d[0] = (bf16)(w.x & 0xffffu); d[VC_P] = (bf16)(w.x >> 16); d[2 * VC_P] = (bf16)(w.y & 0xffffu); d[3 * VC_P] = (bf16)(w.y >> 16);
        d[4 * VC_P] = (bf16)(w.z & 0xffffu); d[5 * VC_P] = (bf16)(w.z >> 16); d[6 * VC_P] = (bf16)(w.w & 0xffffu); d[7 * VC_P] = (bf16)(w.w >> 16);
    }
    __syncthreads();
    {
        const int q = qb * 128 + wave * 16 + l15; const size_t m = (size_t)b * SEQ + q;
        bf16x8 qf[4];
        {
            const bf16* src = PRE + m * NPRE + C_XQ + hx * 128 + 8 * q4;
            float x[4][8]; float ss = 0.f;
#pragma unroll
            for (int ks = 0; ks < 4; ++ks) { const v4u w = *(const v4u*)(src + ks * 32); unpack8(w, x[ks]);
#pragma unroll
                for (int i = 0; i < 8; ++i) ss += x[ks][i] * x[ks][i]; }
            ss += __shfl_xor(ss, 16); ss += __shfl_xor(ss, 32);
            const float rstd = 0.08838834764831845f / sqrtf(ss * (1.f / 128.f) + NORM_EPS);
#pragma unroll
            for (int ks = 0; ks < 4; ++ks) { float y[8];
#pragma unroll
                for (int i = 0; i < 8; ++i) y[i] = x[ks][i] * rstd * P.in[22][ks * 32 + 8 * q4 + i];
                qf[ks] = pack8(y); }
        }
        f32x4 acc[16];
#pragma unroll
        for (int kt = 0; kt < 16; ++kt) {
            const LAS bf16* kr = Ks + (kt * 16 + l15) * KC_P + 8 * q4;
            f32x4 a = (f32x4){0.f, 0.f, 0.f, 0.f};
#pragma unroll
            for (int ks = 0; ks < 4; ++ks) a = MFMA16(*(const LAS bf16x8*)(kr + ks * 32), qf[ks], a);
            acc[kt] = a;
        }
        float mx = -1e30f;
#pragma unroll
        for (int kt = 0; kt < 16; ++kt)
#pragma unroll
            for (int i = 0; i < 4; ++i) mx = fmaxf(mx, acc[kt][i]);
        mx = fmaxf(mx, __shfl_xor(mx, 16)); mx = fmaxf(mx, __shfl_xor(mx, 32));
        float sum = 0.f;
#pragma unroll
        for (int kt = 0; kt < 16; ++kt)
#pragma unroll
            for (int i = 0; i < 4; ++i) { const float p = __expf(acc[kt][i] - mx); acc[kt][i] = p; sum += p; }
        sum += __shfl_xor(sum, 16); sum += __shfl_xor(sum, 32);
        const float inv = 1.f / sum;
        f32x4 o[8];
#pragma unroll
        for (int dt = 0; dt < 8; ++dt) o[dt] = (f32x4){0.f, 0.f, 0.f, 0.f};
#pragma unroll
        for (int k2 = 0; k2 < 8; ++k2) {
            float pp[8] = {acc[2 * k2][0], acc[2 * k2][1], acc[2 * k2][2], acc[2 * k2][3], acc[2 * k2 + 1][0], acc[2 * k2 + 1][1], acc[2 * k2 + 1][2], acc[2 * k2 + 1][3]};
            const bf16x8 pf = pack8(pp);
#pragma unroll
            for (int dt = 0; dt < 8; ++dt) {
                const LAS bf16* vr = Vt + (dt * 16 + l15) * VC_P + k2 * 32 + 4 * q4;
                const v2u v0 = *(const LAS v2u*)(vr), v1 = *(const LAS v2u*)(vr + 16);
                const v4u vw = (v4u){v0.x, v0.y, v1.x, v1.y};
                o[dt] = MFMA16(__builtin_bit_cast(bf16x8, vw), pf, o[dt]);
            }
        }
#pragma unroll
        for (int dt = 0; dt < 8; ++dt) {
            const int ch = hx * 128 + dt * 16 + 4 * q4;
            const v2u gw = *(const v2u*)(PRE + m * NPRE + C_XG + ch); float gg[4]; unpack4(gw, gg);
            v2u w; w.x = pk2(o[dt][0] * inv * gg[0], o[dt][1] * inv * gg[1]); w.y = pk2(o[dt][2] * inv * gg[2], o[dt][3] * inv * gg[3]);
            *(v2u*)(YC + m * DM + 1536 + ch) = w;
        }
    }
    __syncthreads();
}

__device__ __forceinline__ void p5_rwkv_post(const Params& P, LAS unsigned char* lds) {
    const int tid = pg8::mk_tid(lds), lane = tid & 63, wave = tid >> 6;
    const bf16* PRE = (const bf16*)(P.ws + WS_PRE); const bf16* EA = (const bf16*)((unsigned char*)P.out + DO_EA);
    const bf16* YF = (const bf16*)((unsigned char*)P.out + DO_YF); const bf16* YB = (const bf16*)(P.ws + WS_YB); bf16* YC = (bf16*)(P.ws + WS_YCAT);
    const float* mu = P.in[10];
    const int gw = blockIdx.x * NWAVES + wave, NGW = gridDim.x * NWAVES;
    for (int it = gw; it < M_TOK * 12; it += NGW) {
        const int m = it / 12, h = it % 12, t = m & (SEQ - 1), ch = h * 64 + lane;
        const bf16* p = PRE + (size_t)m * NPRE + C_RS + ch;
        const bool hp = t > 0, hn = t < SEQ - 1;
        const float rc = bf1(p[0]), kc = bf1(p[768]), vc = bf1(p[1536]);
        const float rp = hp ? bf1(p[-NPRE]) : 0.f, kp = hp ? bf1(p[-NPRE + 768]) : 0.f, vp = hp ? bf1(p[-NPRE + 1536]) : 0.f;
        const float rn = hn ? bf1(p[NPRE]) : 0.f, kn = hn ? bf1(p[NPRE + 768]) : 0.f, vn = hn ? bf1(p[NPRE + 1536]) : 0.f;
        const float r = rc + mu[ch] * (0.5f * (rp + rn) - rc), k = kc + mu[768 + ch] * (0.5f * (kp + kn) - kc), v = vc + mu[1536 + ch] * (0.5f * (vp + vn) - vc);
        const float af = bf1(EA[(size_t)m * NLORA + 1536 + ch]), ab = bf1(EA[(size_t)m * NLORA + 2304 + ch]);
        const float ka = P.in[12][ch];
        const float kds = k * (2.f + (af + ab - 2.f) * ka);
        const float bsum = wave_sum(r * kds * P.in[13][ch]);
        const float ys = bf1(YF[(size_t)m * RW + ch]) + bf1(YB[(size_t)m * RW + ch]);
        const float mean = wave_sum(ys) * (1.f / 64.f);
        const float dv = ys - mean;
        const float var = wave_sum(dv * dv) * (1.f / 64.f);
        float y = dv * (1.f / sqrtf(var + GN_EPS)) * P.in[18][ch] + P.in[19][ch];
        y = (y + bsum * v) * bf1(PRE[(size_t)m * NPRE + C_RG + ch]);
        YC[(size_t)m * DM + 768 + ch] = (bf16)f2bf(y);
    }
}

constexpr int N_PHASES = 8;
__global__ void __launch_bounds__(NTHREADS, 2) hybrid_fwd(Params P) {
    extern __shared__ __attribute__((aligned(16))) unsigned char lds_raw[];
    LAS unsigned char* lds = (LAS unsigned char*)lds_raw;
    cg::grid_group grid = cg::this_grid();
    const int lo = P.ph_lo, hi = P.ph_hi, G = gridDim.x;
    if ((threadIdx.x & 63) == 0) *(volatile LAS int*)(lds + pg8::TIDTAB_OFF + 4 * pg8::hw_slot()) = (int)(threadIdx.x >> 6);
    __syncthreads();
    unsigned char* ws = P.ws; unsigned char* dob = (unsigned char*)P.out;
#ifdef PHMASK
#define IN(k) (((PHMASK >> (k)) & 1) && lo <= (k) && (k) < hi)
#else
#define IN(k) (lo <= (k) && (k) < hi)
#endif
#define SEAM(k) do { if (IN(k) && IN((k) + 1)) grid.sync(); } while (0)
    if (IN(0)) { p0_prologue(P, lds, P.out); __syncthreads(); }
    SEAM(0);
    if (IN(1)) {
        { pg8::Gemm g{(const bf16*)(dob + DO_H), (const bf16*)(dob + DO_WIN), M_TOK, NIN, DM}; pg8::StaticOrder S; S.init(M_TOK, NIN, G, (int)blockIdx.x);
          EpiProj E{(bf16*)(ws + WS_PRE), (bf16*)(ws + WS_GATES), P.in[5]};
          pg8::gemm_phase<EpiProj, pg8::StaticOrder, true, true>(lds, g, S, E); }
        { pg8::Gemm g{(const bf16*)(ws + WS_MEMN), (const bf16*)(ws + WS_WXKV), MEMROWS, 1024, DM}; pg8::StaticOrder S; S.init(MEMROWS, 1024, G, (int)blockIdx.x);
          EpiPlain E{(bf16*)(ws + WS_MKV), 1024};
          pg8::gemm_phase<EpiPlain, pg8::StaticOrder, true, true>(lds, g, S, E); }
    }
    SEAM(1);
    if (IN(2)) p2_lora_in(P, lds);
    SEAM(2);
    if (IN(3)) {
        int klora = 256; asm volatile("" : "+s"(klora));
        pg8::Gemm g{(const bf16*)(dob + DO_LIN), (const bf16*)(ws + WS_LORAB), M_TOK, NLORA, klora}; pg8::StaticOrder S; S.init(M_TOK, NLORA, G, (int)blockIdx.x);
        EpiLora E{(bf16*)(dob + DO_EA), P.in[14], P.in[16]};
        pg8::gemm_phase<EpiLora, pg8::StaticOrder, true, true>(lds, g, S, E);
    }
    SEAM(3);
    if (IN(4)) {
        const int bid = blockIdx.x;
        if (bid < 192) scan_block(P, bid, lds);
        else {
            const int na = G - 192;
            for (int it = bid - 192; it < 1024; it += na) { if (it < 512) attnA_item(P, it, lds); else attnC_item(P, it - 512, lds); }
        }
    }
    SEAM(4);
    if (IN(5)) p5_rwkv_post(P, lds);
    SEAM(5);
    if (IN(6)) {
        pg8::Gemm g{(const bf16*)(ws + WS_YCAT), (const bf16*)(ws + WS_WCAT), M_TOK, DM, DM}; pg8::StaticOrder S; S.init(M_TOK, DM, G, (int)blockIdx.x);
        EpiMerged E{(bf16*)(ws + WS_MERGED), (const bf16*)(ws + WS_GATES)};
        pg8::gemm_phase<EpiMerged, pg8::StaticOrder, true, true>(lds, g, S, E);
    }
    SEAM(6);
    if (IN(7)) {
        pg8::Gemm g{(const bf16*)(ws + WS_MERGED), (const bf16*)(ws + WS_WOUT), M_TOK, DM, DM}; pg8::StaticOrder S; S.init(M_TOK, DM, G, (int)blockIdx.x);
        EpiOut E{P.out, P.in[0]};
        pg8::gemm_phase<EpiOut, pg8::StaticOrder, true, true>(lds, g, S, E);
    }
#undef IN
#undef SEAM
}

#ifndef ONE_LAUNCH
#define ONE_LAUNCH 1
#endif
extern "C" void kernel_launch(void* const* d_in, const int* in_sizes, int n_in, void* d_out, int out_size, void* d_ws, size_t ws_size, hipStream_t stream) {
    static int grid = 0;
    if (grid == 0) {
        if (n_in != 26 || out_size != M_TOK * DM || ws_size < WS_END) { fprintf(stderr, "kernel_launch: unexpected shapes (n_in %d, out %d, ws %zu); nothing launched\n", n_in, out_size, ws_size); grid = -1; return; }
        int dev = 0, cus = 0, per_cu = 0;
        hipGetDevice(&dev); hipDeviceGetAttribute(&cus, hipDeviceAttributeMultiprocessorCount, dev);
        if (hipFuncSetAttribute((const void*)hybrid_fwd, hipFuncAttributeMaxDynamicSharedMemorySize, LDS_BYTES) != hipSuccess) { fprintf(stderr, "kernel_launch: hipFuncSetAttribute failed\n"); grid = -1; return; }
        hipOccupancyMaxActiveBlocksPerMultiprocessor(&per_cu, (const void*)hybrid_fwd, NTHREADS, LDS_BYTES);
        (void)hipGetLastError();
        if (per_cu < 1) per_cu = 1;
        grid = cus * per_cu; if (grid > 256) grid = 256;
        if (grid < 200) { fprintf(stderr, "kernel_launch: grid %d too small for the scan/attention split\n", grid); grid = -1; return; }
    }
    if (grid < 0) return;
    Params p{};
    for (int i = 0; i < 26; ++i) p.in[i] = (const float*)d_in[i];
    p.out = (float*)d_out; p.ws = (unsigned char*)d_ws;
#if ONE_LAUNCH
    p.ph_lo = 0; p.ph_hi = N_PHASES;
    void* args[] = {&p};
    hipError_t e = hipLaunchCooperativeKernel((const void*)hybrid_fwd, dim3(grid), dim3(NTHREADS), args, LDS_BYTES, stream);
    if (e != hipSuccess) fprintf(stderr, "cooperative launch failed: %s (grid %d)\n", hipGetErrorString(e), grid);
#else
    for (int ph = 0; ph < N_PHASES; ++ph) {
        p.ph_lo = ph; p.ph_hi = ph + 1;
        hipLaunchKernelGGL(hybrid_fwd, dim3(grid), dim3(NTHREADS), LDS_BYTES, stream, p);
    }
#endif
}
```

```cpp
#include <hip/hip_runtime.h>
#include <hip/hip_cooperative_groups.h>
#include <cstdio>
#include <cstdint>
namespace cg = cooperative_groups;
namespace pg8 {
#define PG8_LAS __attribute__((address_space(3)))
typedef unsigned short bf16_t;
typedef short bf16x8 __attribute__((ext_vector_type(8)));
typedef float f32x4 __attribute__((ext_vector_type(4)));
typedef unsigned u32x4 __attribute__((ext_vector_type(4)));
constexpr int BM = 256, BK = 64, HALF = 128, HTB = HALF * BK * 2  , STAGE_BYTES = 8 * HTB, NXCD = 8, WGM = 8;

__host__ __device__ __forceinline__ int lds_byte(int r, int c) { const int st = (r >> 4) * 2 + (c >> 5), rr = r & 15, cc = c & 31, ob = rr * 64 + cc * 2; return st * 1024 + (ob ^ (((ob >> 9) & 1) << 5)); }
__host__ __device__ __forceinline__ void stage_rc(int b, int& R, int& C) { const int st = b / 1024, sb = b % 1024, swz = sb ^ (((sb >> 9) & 1) << 5); R = (st >> 1) * 16 + swz / 64; C = (st & 1) * 32 + (swz % 64) / 2; }
__host__ __device__ __forceinline__ int perm32(int rho) { const int n = rho >> 4, i = rho & 15; return 8 * (i >> 2) + 4 * n + (i & 3); }


constexpr int TIDTAB_OFF = 147200;
__device__ __forceinline__ int hw_slot() { return (int)(__builtin_amdgcn_s_getreg((5 << 11) | 4) & 63u); }
__device__ __forceinline__ int mk_tid(PG8_LAS unsigned char* lds) {
    const int lane = (int)__builtin_amdgcn_mbcnt_hi(~0u, __builtin_amdgcn_mbcnt_lo(~0u, 0u));
    const int w = __builtin_amdgcn_readfirstlane(*(volatile PG8_LAS int*)(lds + TIDTAB_OFF + 4 * hw_slot()));
    return w * 64 + lane;
}
struct Unit { int pm, pn; };
struct Gemm { const bf16_t* A; const bf16_t* Bt; int M, N, K; };

struct StaticOrder {
    int nM, nN, nwg, G, c;
    __host__ __device__ void init(int M, int N, int G_, int c_) { nM = M / BM; nN = N / BM; nwg = nM * nN; G = G_; c = c_; }
    __host__ __device__ bool next(int i, Unit& u) const {
        const long L = (long)i * G + c; if (L >= nwg) return false;
        int wgid = (int)L; { const int q = nwg / NXCD, r = nwg % NXCD, xcd = wgid % NXCD, off = wgid / NXCD; wgid = (xcd < r ? xcd * (q + 1) : r * (q + 1) + (xcd - r) * q) + off; }
        const int nig = WGM * nN, gid = wgid / nig, fm = gid * WGM, gsz = (nM - fm) < WGM ? (nM - fm) : WGM;
        u.pm = fm + ((wgid % nig) % gsz); u.pn = (wgid % nig) / gsz; return true;
    }
    __device__ __forceinline__ void a_ready(const Unit&) const {}
    __device__ __forceinline__ void done(const Unit&) const {}
};

__device__ __forceinline__ unsigned cvt_pk_bf16(float lo, float hi) { unsigned r; asm volatile("v_cvt_pk_bf16_f32 %0, %1, %2" : "=v"(r) : "v"(lo), "v"(hi)); return r; }
template <class Epi, class Sched, bool ALIGN_EPI = false, bool SP2 = false>
__device__ __forceinline__ void gemm_phase(PG8_LAS unsigned char* lds, const Gemm g, const Sched& S, const Epi& E) {
    const int tid = mk_tid(lds), wid = __builtin_amdgcn_readfirstlane(tid >> 6), lane = tid & 63, wr = wid >> 2, wc = wid & 3, fr = lane & 15, fq = lane >> 4;
    const int K = g.K, nt = K / BK;
    unsigned voffA[2], voffB[2];
#pragma unroll
    for (int i = 0; i < 2; ++i) { int R, C; stage_rc(tid * 16 + i * 8192, R, C); const int Rb = Epi::PERM ? ((R & ~31) + perm32(R & 31)) : R;
        voffA[i] = (unsigned)(R * K + C) * 2u; voffB[i] = (unsigned)(Rb * K + C) * 2u; }
    const size_t kstep = (size_t)(BK * 2);
    const size_t hstep = (size_t)HALF * K * 2;
    const size_t tstep = 2 * hstep;
    const unsigned ldsw = (unsigned)wid * 1024u;
    const int aoff = lds_byte(wr * 64 + fr, fq * 8), boff = lds_byte(wc * 32 + fr, fq * 8);
#define PG8_SA(b, h) (((b) * 2 + (h)) * HTB)
#define PG8_SB(b, h) ((4 + (b) * 2 + (h)) * HTB)
#define PG8_STAGE(bufoff, gbase, voff) do { _Pragma("unroll") for (int _i = 0; _i < 2; ++_i) \
        __builtin_amdgcn_global_load_lds((const unsigned*)((const char*)(gbase) + (voff)[_i]), (PG8_LAS unsigned*)(lds + (bufoff) + ldsw + _i * 8192), 16, 0, 0); } while (0)
#define PG8_LDA(dst, b, h) do { _Pragma("unroll") for (int m = 0; m < 4; ++m) _Pragma("unroll") for (int k = 0; k < 2; ++k) dst[m][k] = *(const PG8_LAS bf16x8*)(lds + PG8_SA(b, h) + aoff + m * 2048 + k * 1024); } while (0)
#define PG8_LDB(dst, b, h) do { _Pragma("unroll") for (int n = 0; n < 2; ++n) _Pragma("unroll") for (int k = 0; k < 2; ++k) dst[n][k] = *(const PG8_LAS bf16x8*)(lds + PG8_SB(b, h) + boff + n * 2048 + k * 1024); } while (0)
#define PG8_MMA(ai, bj, At, Bt) do { __builtin_amdgcn_s_setprio(1); _Pragma("unroll") for (int m = 0; m < 4; ++m) _Pragma("unroll") for (int n = 0; n < 2; ++n) _Pragma("unroll") for (int k = 0; k < 2; ++k) \
        acc[ai][bj][m][n] = __builtin_amdgcn_mfma_f32_16x16x32_bf16(Bt[n][k], At[m][k], acc[ai][bj][m][n], 0, 0, 0); __builtin_amdgcn_s_setprio(0); } while (0)
#define PG8_WAIT_V(n) asm volatile("s_waitcnt vmcnt(" #n ")" ::: "memory")
#define PG8_WAIT_L(n) asm volatile("s_waitcnt lgkmcnt(" #n ")" ::: "memory")
#define PG8_BAR __builtin_amdgcn_s_barrier()
#define PG8_SCHED __builtin_amdgcn_sched_barrier(0)
    Unit cur, nxt; int ui = 0;
    if (!S.next(0, cur)) return;
    f32x4 acc[2][2][4][2];
#pragma unroll
    for (int a = 0; a < 2; ++a)
#pragma unroll
        for (int b = 0; b < 2; ++b)
#pragma unroll
            for (int m = 0; m < 4; ++m)
#pragma unroll
                for (int n = 0; n < 2; ++n) acc[a][b][m][n] = (f32x4){0.f, 0.f, 0.f, 0.f};
    bf16x8 At[4][2], B0[2][2], B1[2][2];
    const char* cA = (const char*)g.A + (size_t)cur.pm * tstep; const char* cB = (const char*)g.Bt + (size_t)cur.pn * tstep;
    S.a_ready(cur);
    if constexpr (SP2) {
        PG8_STAGE(PG8_SB(0, 0), cB, voffB); PG8_STAGE(PG8_SB(0, 1), cB + hstep, voffB); PG8_STAGE(PG8_SA(0, 0), cA, voffA); PG8_STAGE(PG8_SA(0, 1), cA + hstep, voffA);
        if (wr == 1) PG8_BAR;
        PG8_WAIT_V(2); PG8_BAR;
        PG8_STAGE(PG8_SB(1, 0), cB + kstep, voffB); PG8_STAGE(PG8_SA(1, 0), cA + kstep, voffA); PG8_STAGE(PG8_SB(1, 1), cB + hstep + kstep, voffB);
        PG8_WAIT_V(6); PG8_BAR;
    } else {
        PG8_STAGE(PG8_SB(0, 0), cB, voffB); PG8_STAGE(PG8_SA(0, 0), cA, voffA); PG8_STAGE(PG8_SB(0, 1), cB + hstep, voffB); PG8_STAGE(PG8_SA(0, 1), cA + hstep, voffA);
        if (wr == 1) PG8_BAR;
        PG8_WAIT_V(4); PG8_BAR;
        PG8_STAGE(PG8_SB(1, 0), cB + kstep, voffB); PG8_STAGE(PG8_SA(1, 0), cA + kstep, voffA); PG8_STAGE(PG8_SB(1, 1), cB + hstep + kstep, voffB);
        PG8_WAIT_V(6); PG8_BAR;
    }
    for (;;) {
        const bool has_next = S.next(ui + 1, nxt);
        const char* nA = has_next ? (const char*)g.A + (size_t)nxt.pm * tstep : cA; const char* nB = has_next ? (const char*)g.Bt + (size_t)nxt.pn * tstep : cB;
        for (int t = 0; t < nt; t += 2) {
            if constexpr (Epi::KHOOK) { if (t == Epi::HK0 || t == Epi::HK1) E.khook(acc, cur, t, wr, wc, fr, fq); }
            const bool last = (t == nt - 2);
            const char* a1 = cA + (size_t)(t + 1) * kstep;
            const char* a2 = last ? nA : cA + (size_t)(t + 2) * kstep; const char* b2 = last ? nB : cB + (size_t)(t + 2) * kstep;
            const char* a3 = a2 + kstep; const char* b3 = b2 + kstep;
            if (last && has_next) S.a_ready(nxt);
            if constexpr (SP2) {
            PG8_LDB(B0, 0, 0); PG8_LDB(B1, 0, 1); PG8_SCHED; PG8_LDA(At, 0, 0); PG8_STAGE(PG8_SA(1, 1), a1 + hstep, voffA);
            PG8_WAIT_V(8); PG8_WAIT_L(0); PG8_BAR; PG8_MMA(0, 0, At, B0); PG8_MMA(0, 1, At, B1); PG8_BAR; PG8_SCHED;
            PG8_LDA(At, 0, 1); PG8_STAGE(PG8_SB(0, 0), b2, voffB); PG8_STAGE(PG8_SB(0, 1), b2 + hstep, voffB); PG8_STAGE(PG8_SA(0, 0), a2, voffA);
            PG8_WAIT_V(8); PG8_WAIT_L(0); PG8_BAR; PG8_MMA(1, 0, At, B0); PG8_MMA(1, 1, At, B1); PG8_BAR; PG8_SCHED;
            PG8_LDB(B0, 1, 0); PG8_LDB(B1, 1, 1); PG8_SCHED; PG8_LDA(At, 1, 0); PG8_STAGE(PG8_SA(0, 1), a2 + hstep, voffA);
            PG8_WAIT_V(8); PG8_WAIT_L(0); PG8_BAR; PG8_MMA(0, 0, At, B0); PG8_MMA(0, 1, At, B1); PG8_BAR; PG8_SCHED;
            PG8_LDA(At, 1, 1); PG8_STAGE(PG8_SB(1, 0), b3, voffB); PG8_STAGE(PG8_SB(1, 1), b3 + hstep, voffB); PG8_STAGE(PG8_SA(1, 0), a3, voffA);
            PG8_WAIT_V(8); PG8_WAIT_L(0); PG8_BAR; PG8_MMA(1, 0, At, B0); PG8_MMA(1, 1, At, B1); PG8_BAR; PG8_SCHED;
            } else {
            PG8_LDB(B0, 0, 0); PG8_SCHED; PG8_LDA(At, 0, 0); PG8_STAGE(PG8_SA(1, 1), a1 + hstep, voffA);
            PG8_WAIT_L(8); PG8_BAR; PG8_WAIT_L(0); PG8_MMA(0, 0, At, B0); PG8_BAR; PG8_SCHED;
            PG8_LDB(B1, 0, 1); PG8_STAGE(PG8_SB(0, 0), b2, voffB);
            PG8_BAR; PG8_WAIT_L(0); PG8_MMA(0, 1, At, B1); PG8_BAR;
            PG8_LDA(At, 0, 1); PG8_STAGE(PG8_SA(0, 0), a2, voffA);
            PG8_BAR; PG8_WAIT_L(0); PG8_MMA(1, 0, At, B0); PG8_BAR; PG8_SCHED;
            PG8_STAGE(PG8_SB(0, 1), b2 + hstep, voffB);
            PG8_WAIT_V(6); PG8_BAR; PG8_MMA(1, 1, At, B1); PG8_BAR;
            PG8_LDB(B0, 1, 0); PG8_SCHED; PG8_LDA(At, 1, 0); PG8_STAGE(PG8_SA(0, 1), a2 + hstep, voffA);
            PG8_WAIT_L(8); PG8_BAR; PG8_WAIT_L(0); PG8_MMA(0, 0, At, B0); PG8_BAR; PG8_SCHED;
            PG8_LDB(B1, 1, 1); PG8_STAGE(PG8_SB(1, 0), b3, voffB);
            PG8_BAR; PG8_WAIT_L(0); PG8_MMA(0, 1, At, B1); PG8_BAR;
            PG8_LDA(At, 1, 1); PG8_STAGE(PG8_SA(1, 0), a3, voffA);
            PG8_BAR; PG8_WAIT_L(0); PG8_MMA(1, 0, At, B0); PG8_BAR; PG8_SCHED;
            PG8_STAGE(PG8_SB(1, 1), b3 + hstep, voffB);
            PG8_WAIT_V(6); PG8_BAR; PG8_MMA(1, 1, At, B1); PG8_BAR;
            }
        }
        if constexpr (ALIGN_EPI) { if (wr == 0) PG8_BAR; }
        if constexpr (!Epi::AFTER_DRAIN) { E(acc, cur, wr, wc, fr, fq); S.done(cur); }
        if (!has_next) break;
#pragma unroll
        for (int a = 0; a < 2; ++a)
#pragma unroll
            for (int b = 0; b < 2; ++b)
#pragma unroll
                for (int m = 0; m < 4; ++m)
#pragma unroll
                    for (int n = 0; n < 2; ++n) acc[a][b][m][n] = (f32x4){0.f, 0.f, 0.f, 0.f};
        cur = nxt; cA = nA; cB = nB; ++ui;
        if constexpr (ALIGN_EPI) { if (wr == 1) PG8_BAR; }
    }
    PG8_WAIT_V(0);
    if constexpr (!ALIGN_EPI) { if (wr == 0) PG8_BAR; }
    PG8_BAR;
    if constexpr (Epi::AFTER_DRAIN) { E.fused(acc, cur, wr, wc, fr, fq, lds, wid, lane); S.done(cur); }
#undef PG8_SA
#undef PG8_SB
#undef PG8_STAGE
#undef PG8_LDA
#undef PG8_LDB
#undef PG8_MMA
#undef PG8_WAIT_V
#undef PG8_WAIT_L
#undef PG8_BAR
#undef PG8_SCHED
}
}

#define GAS __attribute__((address_space(1)))
#define LAS __attribute__((address_space(3)))
typedef unsigned short bf16;
typedef unsigned v4u __attribute__((ext_vector_type(4)));
typedef unsigned v2u __attribute__((ext_vector_type(2)));
typedef float f32x4 __attribute__((ext_vector_type(4)));
typedef float f32x2 __attribute__((ext_vector_type(2)));
typedef short bf16x8 __attribute__((ext_vector_type(8)));
typedef short s16x4 __attribute__((ext_vector_type(4)));

constexpr int NWAVES = 8, NTHREADS = 512;
constexpr int BATCH = 8, SEQ = 2048, DM = 2048, M_TOK = BATCH * SEQ;
constexpr int NPRE = 6400, NGATE = 6144, NIN = NPRE + NGATE;
constexpr int C_AQ = 0, C_AK = 768, C_AV = 1024, C_AG = 1280, C_RS = 2048, C_RR = 2048, C_RK = 2816, C_RV = 3584, C_LORA = 4352, C_RG = 4608, C_XQ = 5376, C_XG = 5888;
constexpr int NMEM = 256, MEMROWS = BATCH * NMEM;
constexpr int RW = 768, NLORA = 3072;
constexpr float NORM_EPS = 1e-6f, GN_EPS = 64e-5f;
constexpr int LDS_BYTES = 147456;

constexpr size_t MiB = 1u << 20;
constexpr size_t WS_PRE = 0, WS_MERGED = 0, WS_GATES = 200 * MiB, WS_YCAT = 392 * MiB;
constexpr size_t WS_WCAT = 456 * MiB, WS_WOUT = 464 * MiB, WS_WXKV = 472 * MiB, WS_MKV = 476 * MiB, WS_MEMN = 480 * MiB, WS_YB = 480 * MiB;
constexpr size_t WS_ROPE = 504 * MiB, WS_LORAB = 505 * MiB, WS_END = 512 * MiB;
constexpr size_t DO_H = 0, DO_WIN = 64 * MiB, DO_EA = 0, DO_LIN = 96 * MiB, DO_YF = 104 * MiB;

struct Params { const float* in[26]; float* out; unsigned char* ws; int ph_lo, ph_hi; };

__device__ __forceinline__ float bf_lo(unsigned w) { return __builtin_bit_cast(float, w << 16); }
__device__ __forceinline__ float bf_hi(unsigned w) { return __builtin_bit_cast(float, w & 0xffff0000u); }
__device__ __forceinline__ float bf1(bf16 h) { return __builtin_bit_cast(float, (unsigned)h << 16); }
__device__ __forceinline__ unsigned f2bf(float f) { unsigned u = __builtin_bit_cast(unsigned, f); return (u + 0x7fffu + ((u >> 16) & 1u)) >> 16; }
__device__ __forceinline__ unsigned pk2(float lo, float hi) { return pg8::cvt_pk_bf16(lo, hi); }
__device__ __forceinline__ float sigmoidf_(float z) { return __builtin_amdgcn_rcpf(1.f + __expf(-z)); }
__device__ __forceinline__ float siluf_(float z) { return z * sigmoidf_(z); }
__device__ __forceinline__ void unpack8(v4u w, float (&x)[8]) { x[0] = bf_lo(w.x); x[1] = bf_hi(w.x); x[2] = bf_lo(w.y); x[3] = bf_hi(w.y); x[4] = bf_lo(w.z); x[5] = bf_hi(w.z); x[6] = bf_lo(w.w); x[7] = bf_hi(w.w); }
__device__ __forceinline__ void unpack4(v2u w, float (&x)[4]) { x[0] = bf_lo(w.x); x[1] = bf_hi(w.x); x[2] = bf_lo(w.y); x[3] = bf_hi(w.y); }
template <int CTRL> __device__ __forceinline__ float dpp_add(float v) { return v + __builtin_bit_cast(float, __builtin_amdgcn_update_dpp(0, __builtin_bit_cast(int, v), CTRL, 0xF, 0xF, true)); }
__device__ __forceinline__ float red8(float v) { v = dpp_add<0xB1>(v); v = dpp_add<0x4E>(v); v = dpp_add<0x141>(v); return v; }

using pg8::Unit;
struct EpiProj {
    static constexpr bool PERM = true, AFTER_DRAIN = false, KHOOK = false; static constexpr int HK0 = -1, HK1 = -1;
    bf16* pre; bf16* gates; const float* gate_b;
    __device__ __forceinline__ void operator()(const f32x4 (&acc)[2][2][4][2], const Unit& u, int wr, int wc, int fr, int fq) const {
        int row0 = u.pm * 256 + wr * 64 + fr;
        asm volatile("" : "+v"(row0));
        const bool isg = u.pn >= 25;
        const int pn = isg ? u.pn - 25 : u.pn;
        bf16* base = isg ? gates : pre; const int ldc = isg ? NGATE : NPRE;
        const int act = isg ? 2 : (((pn >= 5 && pn <= 7) || (pn >= 18 && pn <= 20) || pn >= 23) ? 1 : 0);
        const int col0 = pn * 256 + wc * 32 + 8 * fq;
#pragma unroll
        for (int ai = 0; ai < 2; ++ai)
#pragma unroll
            for (int m = 0; m < 4; ++m) { bf16* rowp = base + (size_t)(row0 + ai * 128 + m * 16) * ldc + col0;
                __builtin_amdgcn_sched_barrier(0);
#pragma unroll
                for (int bj = 0; bj < 2; ++bj) { f32x4 v0 = acc[ai][bj][m][0], v1 = acc[ai][bj][m][1];
                    if (isg) { v0 += *(const f32x4*)(gate_b + col0 + bj * 128); v1 += *(const f32x4*)(gate_b + col0 + bj * 128 + 4); }
                    if (act == 1) {
#pragma unroll
                        for (int i = 0; i < 4; ++i) { v0[i] = siluf_(v0[i]); v1[i] = siluf_(v1[i]); }
                    } else if (act == 2) {
#pragma unroll
                        for (int i = 0; i < 4; ++i) { v0[i] = sigmoidf_(v0[i]); v1[i] = sigmoidf_(v1[i]); }
                    }
                    v4u w; w.x = pk2(v0[0], v0[1]); w.y = pk2(v0[2], v0[3]); w.z = pk2(v1[0], v1[1]); w.w = pk2(v1[2], v1[3]);
                    *(v4u*)(rowp + bj * 128) = w; } }
    }
};
struct EpiPlain {
    static constexpr bool PERM = true, AFTER_DRAIN = false, KHOOK = false; static constexpr int HK0 = -1, HK1 = -1;
    bf16* O; int ldc;
    __device__ __forceinline__ void operator()(const f32x4 (&acc)[2][2][4][2], const Unit& u, int wr, int wc, int fr, int fq) const {
        int row0 = u.pm * 256 + wr * 64 + fr, col0 = u.pn * 256 + wc * 32 + 8 * fq;
        asm volatile("" : "+v"(row0), "+v"(col0));
#pragma unroll
        for (int ai = 0; ai < 2; ++ai)
#pragma unroll
            for (int m = 0; m < 4; ++m) { bf16* rowp = O + (size_t)(row0 + ai * 128 + m * 16) * ldc + col0;
#pragma unroll
                for (int bj = 0; bj < 2; ++bj) { const f32x4 v0 = acc[ai][bj][m][0], v1 = acc[ai][bj][m][1];
                    v4u w; w.x = pk2(v0[0], v0[1]); w.y = pk2(v0[2], v0[3]); w.z = pk2(v1[0], v1[1]); w.w = pk2(v1[2], v1[3]);
                    *(v4u*)(rowp + bj * 128) = w; } }
    }
};
struct EpiLora {
    static constexpr bool PERM = true, AFTER_DRAIN = false, KHOOK = false; static constexpr int HK0 = -1, HK1 = -1;
    bf16* O; const float* w0; const float* a0;
    __device__ __forceinline__ void operator()(const f32x4 (&acc)[2][2][4][2], const Unit& u, int wr, int wc, int fr, int fq) const {
        int row0 = u.pm * 256 + wr * 64 + fr, col0 = u.pn * 256 + wc * 32 + 8 * fq;
        asm volatile("" : "+v"(row0), "+v"(col0));
        const bool isw = u.pn < 6; const float* bias = isw ? (w0 + col0) : (a0 + col0 - 1536); const float sc = isw ? 0.6065306597126334f : 1.f;
#pragma unroll
        for (int ai = 0; ai < 2; ++ai)
#pragma unroll
            for (int m = 0; m < 4; ++m) { bf16* rowp = O + (size_t)(row0 + ai * 128 + m * 16) * NLORA + col0;
                __builtin_amdgcn_sched_barrier(0);
#pragma unroll
                for (int bj = 0; bj < 2; ++bj) { f32x4 v0 = acc[ai][bj][m][0] + *(const f32x4*)(bias + bj * 128), v1 = acc[ai][bj][m][1] + *(const f32x4*)(bias + bj * 128 + 4);
#pragma unroll
                    for (int i = 0; i < 4; ++i) { v0[i] = sc * sigmoidf_(v0[i]); v1[i] = sc * sigmoidf_(v1[i]); }
                    v4u w; w.x = pk2(v0[0], v0[1]); w.y = pk2(v0[2], v0[3]); w.z = pk2(v1[0], v1[1]); w.w = pk2(v1[2], v1[3]);
                    *(v4u*)(rowp + bj * 128) = w; } }
    }
};
struct EpiMerged {
    static constexpr bool PERM = true, AFTER_DRAIN = false, KHOOK = true; static constexpr int HK0 = 12, HK1 = 24;
    bf16* O; const bf16* gates;
    __device__ __forceinline__ void khook(f32x4 (&acc)[2][2][4][2], const Unit& u, int t, int wr, int wc, int fr, int fq) const {
        int row0 = u.pm * 256 + wr * 64 + fr, col0 = u.pn * 256 + wc * 32 + 8 * fq;
        asm volatile("" : "+v"(row0), "+v"(col0));
        const int bo = (t == HK0) ? 0 : DM;
#pragma unroll
        for (int ai = 0; ai < 2; ++ai)
#pragma unroll
            for (int m = 0; m < 4; ++m) { const bf16* gp = gates + (size_t)(row0 + ai * 128 + m * 16) * NGATE + bo + col0;
                __builtin_amdgcn_sched_barrier(0);
#pragma unroll
                for (int bj = 0; bj < 2; ++bj) { const v4u a = *(const v4u*)(gp + bj * 128), b = *(const v4u*)(gp + DM + bj * 128);
                    float x[8], y[8]; unpack8(a, x); unpack8(b, y);
#pragma unroll
                    for (int i = 0; i < 4; ++i) { acc[ai][bj][m][0][i] *= x[i] * __builtin_amdgcn_rcpf(y[i]); acc[ai][bj][m][1][i] *= x[4 + i] * __builtin_amdgcn_rcpf(y[4 + i]); } } }
    }
    __device__ __forceinline__ void operator()(const f32x4 (&acc)[2][2][4][2], const Unit& u, int wr, int wc, int fr, int fq) const {
        int row0 = u.pm * 256 + wr * 64 + fr, col0 = u.pn * 256 + wc * 32 + 8 * fq;
        asm volatile("" : "+v"(row0), "+v"(col0));
#pragma unroll
        for (int ai = 0; ai < 2; ++ai)
#pragma unroll
            for (int m = 0; m < 4; ++m) { const size_t r = (size_t)(row0 + ai * 128 + m * 16);
                __builtin_amdgcn_sched_barrier(0);
#pragma unroll
                for (int bj = 0; bj < 2; ++bj) { const v4u g = *(const v4u*)(gates + r * NGATE + 2 * DM + col0 + bj * 128); float x[8]; unpack8(g, x);
                    const f32x4 v0 = acc[ai][bj][m][0], v1 = acc[ai][bj][m][1];
                    v4u w; w.x = pk2(v0[0] * x[0], v0[1] * x[1]); w.y = pk2(v0[2] * x[2], v0[3] * x[3]); w.z = pk2(v1[0] * x[4], v1[1] * x[5]); w.w = pk2(v1[2] * x[6], v1[3] * x[7]);
                    *(v4u*)(O + r * DM + col0 + bj * 128) = w; } }
    }
};
struct EpiOut {
    static constexpr bool PERM = true, AFTER_DRAIN = false, KHOOK = false; static constexpr int HK0 = -1, HK1 = -1;
    float* O; const float* X;
    __device__ __forceinline__ void operator()(const f32x4 (&acc)[2][2][4][2], const Unit& u, int wr, int wc, int fr, int fq) const {
        int row0 = u.pm * 256 + wr * 64 + fr, col0 = u.pn * 256 + wc * 32 + 8 * fq;
        asm volatile("" : "+v"(row0), "+v"(col0));
#pragma unroll
        for (int ai = 0; ai < 2; ++ai)
#pragma unroll
            for (int m = 0; m < 4; ++m) { const size_t o = (size_t)(row0 + ai * 128 + m * 16) * DM + col0;
                __builtin_amdgcn_sched_barrier(0);
#pragma unroll
                for (int bj = 0; bj < 2; ++bj) {
                    const f32x4 x0 = *(const f32x4*)(X + o + bj * 128), x1 = *(const f32x4*)(X + o + bj * 128 + 4);
                    *(f32x4*)(O + o + bj * 128) = x0 + acc[ai][bj][m][0]; *(f32x4*)(O + o + bj * 128 + 4) = x1 + acc[ai][bj][m][1]; } }
    }
};

__device__ __forceinline__ float wave_sum(float v) {
#pragma unroll
    for (int o = 1; o < 64; o <<= 1) v += __shfl_xor(v, o);
    return v;
}
__device__ __forceinline__ void transpose_item(const float* W, int N, bf16* WT, int ldt, int koff, LAS float* scr, int item, int lane) {
    const int nblk = N / 32, kb = item / nblk, nb = item % nblk, k0 = 64 * kb, n0 = 32 * nb;
    float tv[32];
#pragma unroll
    for (int i = 0; i < 32; ++i) { const int kk = 2 * i + (lane >> 5); tv[i] = W[(size_t)(k0 + kk) * N + n0 + (lane & 31)]; }
#pragma unroll
    for (int i = 0; i < 32; ++i) { const int kk = 2 * i + (lane >> 5); scr[kk * 33 + (lane & 31)] = tv[i]; }
    asm volatile("s_waitcnt lgkmcnt(0)" ::: "memory");
    const int c = lane & 7;
#pragma unroll
    for (int j = 0; j < 4; ++j) { const int n = (lane >> 3) + 8 * j; const LAS float* s = scr + (8 * c) * 33 + n;
        v4u o; o.x = pk2(s[0 * 33], s[1 * 33]); o.y = pk2(s[2 * 33], s[3 * 33]); o.z = pk2(s[4 * 33], s[5 * 33]); o.w = pk2(s[6 * 33], s[7 * 33]);
        *(v4u*)(WT + (size_t)(n0 + n) * ldt + koff + k0 + 8 * c) = o; }
    asm volatile("s_waitcnt lgkmcnt(0)" ::: "memory");
}
__device__ __forceinline__ void rms_row_to_bf16(const float* xrow, const float* g, bf16* orow, int lane) {
    const f32x4* xr = (const f32x4*)xrow + lane; const f32x4* gr = (const f32x4*)g + lane;
    f32x4 v[8]; float s = 0.f;
#pragma unroll
    for (int j = 0; j < 8; ++j) { v[j] = xr[64 * j]; s += (v[j].x * v[j].x + v[j].y * v[j].y) + (v[j].z * v[j].z + v[j].w * v[j].w); }
    const float rstd = 1.f / sqrtf(wave_sum(s) * (1.f / DM) + NORM_EPS);
    v2u* o8 = (v2u*)orow + lane;
#pragma unroll
    for (int j = 0; j < 8; ++j) { const f32x4 gg = gr[64 * j]; v2u o; o.x = pk2(v[j].x * rstd * gg.x, v[j].y * rstd * gg.y); o.y = pk2(v[j].z * rstd * gg.z, v[j].w * rstd * gg.w); o8[64 * j] = o; }
}
__device__ __forceinline__ void p0_prologue(const Params& P, LAS unsigned char* lds, float* dout_scratch) {
    const int tid = pg8::mk_tid(lds), lane = tid & 63, wave = tid >> 6, G = gridDim.x;
    LAS float* scr = (LAS float*)(lds + wave * 16384);
    const int gw = blockIdx.x * NWAVES + wave, NGW = G * NWAVES;
    unsigned char* ws = P.ws; unsigned char* dob = (unsigned char*)P.out;
    bf16* WIN_T = (bf16*)(dob + DO_WIN); bf16* WCAT_T = (bf16*)(ws + WS_WCAT); bf16* WOUT_T = (bf16*)(ws + WS_WOUT); bf16* WXKV_T = (bf16*)(ws + WS_WXKV);
    constexpr int I_IN = 32 * (NIN / 32), I_A = 12 * 64, I_R = 12 * 64, I_X = 8 * 64, I_O = 32 * 64, I_KV = 32 * 32;
    constexpr int NITEMS = I_IN + I_A + I_R + I_X + I_O + I_KV;
    for (int it = gw; it < NITEMS; it += NGW) {
        int r = it;
        if (r < I_IN) { transpose_item(P.in[4], NIN, WIN_T, DM, 0, scr, r, lane); continue; } r -= I_IN;
        if (r < I_A) { transpose_item(P.in[9], DM, WCAT_T, DM, 0, scr, r, lane); continue; } r -= I_A;
        if (r < I_R) { transpose_item(P.in[20], DM, WCAT_T, DM, 768, scr, r, lane); continue; } r -= I_R;
        if (r < I_X) { transpose_item(P.in[24], DM, WCAT_T, DM, 1536, scr, r, lane); continue; } r -= I_X;
        if (r < I_O) { transpose_item(P.in[25], DM, WOUT_T, DM, 0, scr, r, lane); continue; } r -= I_O;
        transpose_item(P.in[21], 1024, WXKV_T, DM, 0, scr, r, lane);
    }
    bf16* H = (bf16*)(dob + DO_H); bf16* MEMN = (bf16*)(ws + WS_MEMN);
    for (int m = gw; m < M_TOK + MEMROWS; m += NGW) {
        if (m < M_TOK) rms_row_to_bf16(P.in[0] + (size_t)m * DM, P.in[2], H + (size_t)m * DM, lane);
        else rms_row_to_bf16(P.in[1] + (size_t)(m - M_TOK) * DM, P.in[3], MEMN + (size_t)(m - M_TOK) * DM, lane);
    }
    bf16* LB = (bf16*)(ws + WS_LORAB);
    const int gt = blockIdx.x * NTHREADS + tid, NGT = G * NTHREADS;
    for (int idx = gt; idx < NLORA * 256; idx += NGT) {
        const int n = idx >> 8, k = idx & 255, d = n / RW, ch = n % RW, kb = k >> 6, kk = k & 63;
        float v = 0.f;
        if (kb == d) v = (d < 2) ? P.in[15][(size_t)(d * 64 + kk) * RW + ch] : P.in[17][(size_t)((d - 2) * 64 + kk) * RW + ch];
        LB[idx] = (bf16)f2bf(v);
    }
    float* RC = (float*)(ws + WS_ROPE); float* RS = RC + SEQ * 32;
    for (int idx = gt; idx < SEQ * 32; idx += NGT) {
        const int pos = idx >> 5, i = idx & 31;
        const float inv = __builtin_exp2f(-(float)i * (13.287712379549449f / 32.f));
        const float ang = (float)pos * inv;
        double rv = (double)ang * 0.15915494309189535; rv -= __builtin_floor(rv);
        const float r = (float)rv;
        RC[idx] = __builtin_amdgcn_cosf(r); RS[idx] = __builtin_amdgcn_sinf(r);
    }
}

__device__ __forceinline__ void p2_lora_in(const Params& P, LAS unsigned char* lds) {
    const bf16* PRE = (const bf16*)(P.ws + WS_PRE); bf16* LIN = (bf16*)((unsigned char*)P.out + DO_LIN); const float* mu = P.in[10];
    const int gt = blockIdx.x * NTHREADS + pg8::mk_tid(lds), NGT = gridDim.x * NTHREADS;
    for (int idx = gt; idx < M_TOK * 32; idx += NGT) {
        const int m = idx >> 5, j = (idx & 31) * 8, t = m & (SEQ - 1);
        const bf16* p = PRE + (size_t)m * NPRE + C_LORA + j;
        const v4u z4 = (v4u){0u, 0u, 0u, 0u};
        const v4u c = *(const v4u*)p, pv = (t > 0) ? *(const v4u*)(p - NPRE) : z4, nx = (t < SEQ - 1) ? *(const v4u*)(p + NPRE) : z4;
        const f32x4 m0 = *(const f32x4*)(mu + 2304 + j), m1 = *(const f32x4*)(mu + 2304 + j + 4);
        float xc[8], xp[8], xn[8], s[8]; unpack8(c, xc); unpack8(pv, xp); unpack8(nx, xn);
#pragma unroll
        for (int i = 0; i < 8; ++i) { const float mm = (i < 4) ? m0[i & 3] : m1[i & 3]; s[i] = xc[i] + mm * (0.5f * (xp[i] + xn[i]) - xc[i]);
            if (j < 128) s[i] = 1.f - 2.f * __builtin_amdgcn_rcpf(__expf(2.f * s[i]) + 1.f); }
        v4u o; o.x = pk2(s[0], s[1]); o.y = pk2(s[2], s[3]); o.z = pk2(s[4], s[5]); o.w = pk2(s[6], s[7]);
        *(v4u*)(LIN + (size_t)m * 256 + j) = o;
    }
}

constexpr int SC_CH = 32, SC_REC = 1536, SC_BUF = SC_CH * SC_REC, SC_SCAL = 2 * SC_BUF;
__device__ __forceinline__ void scan_block(const Params& P, int sid, LAS unsigned char* lds) {
    const int tid = pg8::mk_tid(lds), lane = tid & 63, wave = __builtin_amdgcn_readfirstlane(tid >> 6);
    const int b = sid / 24, rem = sid % 24, h = rem >> 1, dir = rem & 1;
    const bf16* PRE = (const bf16*)(P.ws + WS_PRE); const bf16* EA = (const bf16*)((unsigned char*)P.out + DO_EA);
    bf16* YO = dir ? (bf16*)(P.ws + WS_YB) : (bf16*)((unsigned char*)P.out + DO_YF);
    constexpr int NCH = SEQ / SC_CH;
    if (wave >= 4) {
        const int pt = tid - 256, sl = pt >> 3, e = pt & 7, ch0 = h * 64 + 8 * e;
        float mur[8], muk[8], muv[8], kkc[8], kac[8];
#pragma unroll
        for (int i = 0; i < 8; ++i) { mur[i] = P.in[10][ch0 + i]; muk[i] = P.in[10][768 + ch0 + i]; muv[i] = P.in[10][1536 + ch0 + i]; kkc[i] = P.in[11][ch0 + i]; kac[i] = P.in[12][ch0 + i]; }
        for (int c = 0; c <= NCH; ++c) {
            if (c < NCH) {
                LAS unsigned char* buf = lds + (c & 1) * SC_BUF; LAS float* scal = (LAS float*)(lds + SC_SCAL) + (c & 1) * (SC_CH * 2);
                const int step = c * SC_CH + sl, t = dir ? (SEQ - 1 - step) : step; const size_t m = (size_t)b * SEQ + t;
                const bf16* rowp = PRE + m * NPRE + C_RS + ch0;
                const v4u z4 = (v4u){0u, 0u, 0u, 0u};
                const v4u rc = *(const v4u*)(rowp), kc = *(const v4u*)(rowp + 768), vc = *(const v4u*)(rowp + 1536);
                const v4u rp = (t > 0) ? *(const v4u*)(rowp - NPRE) : z4, kp = (t > 0) ? *(const v4u*)(rowp - NPRE + 768) : z4, vp = (t > 0) ? *(const v4u*)(rowp - NPRE + 1536) : z4;
                const v4u rn = (t < SEQ - 1) ? *(const v4u*)(rowp + NPRE) : z4, kn = (t < SEQ - 1) ? *(const v4u*)(rowp + NPRE + 768) : z4, vn = (t < SEQ - 1) ? *(const v4u*)(rowp + NPRE + 1536) : z4;
                const bf16* eap = EA + m * NLORA + dir * RW + ch0;
                const v4u e8 = *(const v4u*)(eap), a8 = *(const v4u*)(eap + 1536);
                float r[8], k[8], v[8], x0[8], x1[8], x2[8];
                unpack8(rc, x0); unpack8(rp, x1); unpack8(rn, x2);
#pragma unroll
                for (int i = 0; i < 8; ++i) r[i] = x0[i] + mur[i] * (0.5f * (x1[i] + x2[i]) - x0[i]);
                unpack8(kc, x0); unpack8(kp, x1); unpack8(kn, x2);
#pragma unroll
                for (int i = 0; i < 8; ++i) k[i] = x0[i] + muk[i] * (0.5f * (x1[i] + x2[i]) - x0[i]);
                unpack8(vc, x0); unpack8(vp, x1); unpack8(vn, x2);
#pragma unroll
                for (int i = 0; i < 8; ++i) v[i] = x0[i] + muv[i] * (0.5f * (x1[i] + x2[i]) - x0[i]);
                float ee[8], aa[8]; unpack8(e8, ee); unpack8(a8, aa);
                float kk[8], ss = 0.f;
#pragma unroll
                for (int i = 0; i < 8; ++i) { kk[i] = k[i] * kkc[i]; ss += kk[i] * kk[i]; }
                ss = red8(ss);
                const float inv = 1.f / fmaxf(sqrtf(ss), 1e-12f);
                float nkk[8], dd[8], dr[8], bb[8], kd[8], sbr = 0.f, skr = 0.f;
#pragma unroll
                for (int i = 0; i < 8; ++i) {
                    const float kki = kk[i] * inv; nkk[i] = -kki; dd[i] = __expf(-ee[i]); dr[i] = dd[i] * r[i];
                    bb[i] = kki * aa[i]; kd[i] = k[i] * (1.f + (aa[i] - 1.f) * kac[i]); sbr += bb[i] * r[i]; skr += kd[i] * r[i];
                }
                sbr = red8(sbr); skr = red8(skr);
                LAS float* rec = (LAS float*)(buf + sl * SC_REC) + 8 * e;
                *(LAS f32x4*)(rec) = (f32x4){nkk[0], nkk[1], nkk[2], nkk[3]}; *(LAS f32x4*)(rec + 4) = (f32x4){nkk[4], nkk[5], nkk[6], nkk[7]};
                *(LAS f32x4*)(rec + 64) = (f32x4){dr[0], dr[1], dr[2], dr[3]}; *(LAS f32x4*)(rec + 68) = (f32x4){dr[4], dr[5], dr[6], dr[7]};
                *(LAS f32x4*)(rec + 128) = (f32x4){dd[0], dd[1], dd[2], dd[3]}; *(LAS f32x4*)(rec + 132) = (f32x4){dd[4], dd[5], dd[6], dd[7]};
                *(LAS f32x4*)(rec + 192) = (f32x4){bb[0], bb[1], bb[2], bb[3]}; *(LAS f32x4*)(rec + 196) = (f32x4){bb[4], bb[5], bb[6], bb[7]};
                *(LAS f32x4*)(rec + 256) = (f32x4){kd[0], kd[1], kd[2], kd[3]}; *(LAS f32x4*)(rec + 260) = (f32x4){kd[4], kd[5], kd[6], kd[7]};
                *(LAS f32x4*)(rec + 320) = (f32x4){v[0], v[1], v[2], v[3]}; *(LAS f32x4*)(rec + 324) = (f32x4){v[4], v[5], v[6], v[7]};
                if (e == 0) *(LAS f32x2*)(scal + 2 * sl) = (f32x2){sbr, skr};
            }
            __syncthreads();
        }
    } else {
        const int rp = (wave * 64 + lane) >> 3, cgp = lane & 7;
        f32x2 s0[4], s1[4];
#pragma unroll
        for (int i = 0; i < 4; ++i) { s0[i] = (f32x2){0.f, 0.f}; s1[i] = (f32x2){0.f, 0.f}; }
        bf16* yrow = YO + (size_t)b * SEQ * RW + h * 64 + 2 * rp;
        __syncthreads();
#define SC_LOAD(N0, N1, Q0, Q1, D0, D1, B0, B1, K0, K1, VV, SS, sl_) do { const LAS float* rec_ = (const LAS float*)(buf + (sl_) * SC_REC) + 8 * cgp; \
            N0 = *(const LAS f32x4*)(rec_); N1 = *(const LAS f32x4*)(rec_ + 4); Q0 = *(const LAS f32x4*)(rec_ + 64); Q1 = *(const LAS f32x4*)(rec_ + 68); \
            D0 = *(const LAS f32x4*)(rec_ + 128); D1 = *(const LAS f32x4*)(rec_ + 132); B0 = *(const LAS f32x4*)(rec_ + 192); B1 = *(const LAS f32x4*)(rec_ + 196); \
            K0 = *(const LAS f32x4*)(rec_ + 256); K1 = *(const LAS f32x4*)(rec_ + 260); \
            VV = *(const LAS f32x2*)((const LAS float*)(buf + (sl_) * SC_REC) + 320 + 2 * rp); SS = *(const LAS f32x2*)(scal + 2 * (sl_)); } while (0)
        for (int c = 0; c < NCH; ++c) {
            const LAS unsigned char* buf = lds + (c & 1) * SC_BUF; const LAS float* scal = (const LAS float*)(lds + SC_SCAL) + (c & 1) * (SC_CH * 2);
            f32x4 n0, n1, q0, q1, d0, d1, b0, b1, k0, k1; f32x2 vv, sc;
            SC_LOAD(n0, n1, q0, q1, d0, d1, b0, b1, k0, k1, vv, sc, 0);
#pragma unroll 2
            for (int sl = 0; sl < SC_CH; ++sl) {
                f32x4 xn0, xn1, xq0, xq1, xd0, xd1, xb0, xb1, xk0, xk1; f32x2 xvv, xsc;
                const int sn = (sl + 1 < SC_CH) ? sl + 1 : sl;
                SC_LOAD(xn0, xn1, xq0, xq1, xd0, xd1, xb0, xb1, xk0, xk1, xvv, xsc, sn);
                const f32x2 nk[4] = {(f32x2){n0.x, n0.y}, (f32x2){n0.z, n0.w}, (f32x2){n1.x, n1.y}, (f32x2){n1.z, n1.w}};
                const f32x2 qq[4] = {(f32x2){q0.x, q0.y}, (f32x2){q0.z, q0.w}, (f32x2){q1.x, q1.y}, (f32x2){q1.z, q1.w}};
                const f32x2 dv[4] = {(f32x2){d0.x, d0.y}, (f32x2){d0.z, d0.w}, (f32x2){d1.x, d1.y}, (f32x2){d1.z, d1.w}};
                const f32x2 bv[4] = {(f32x2){b0.x, b0.y}, (f32x2){b0.z, b0.w}, (f32x2){b1.x, b1.y}, (f32x2){b1.z, b1.w}};
                const f32x2 kv[4] = {(f32x2){k0.x, k0.y}, (f32x2){k0.z, k0.w}, (f32x2){k1.x, k1.y}, (f32x2){k1.z, k1.w}};
                f32x2 a0 = s0[0] * nk[0], a1 = s1[0] * nk[0], y0 = s0[0] * qq[0], y1 = s1[0] * qq[0];
#pragma unroll
                for (int i = 1; i < 4; ++i) { a0 = s0[i] * nk[i] + a0; a1 = s1[i] * nk[i] + a1; y0 = s0[i] * qq[i] + y0; y1 = s1[i] * qq[i] + y1; }
                float sa0 = a0.x + a0.y, sa1 = a1.x + a1.y, yp0 = y0.x + y0.y, yp1 = y1.x + y1.y;
                sa0 = red8(sa0); sa1 = red8(sa1); yp0 = red8(yp0); yp1 = red8(yp1);
                const float yo0 = yp0 + sa0 * sc.x + vv.x * sc.y, yo1 = yp1 + sa1 * sc.x + vv.y * sc.y;
                const f32x2 sa0v = (f32x2){sa0, sa0}, sa1v = (f32x2){sa1, sa1}, v0v = (f32x2){vv.x, vv.x}, v1v = (f32x2){vv.y, vv.y};
#pragma unroll
                for (int i = 0; i < 4; ++i) {
                    f32x2 t0 = v0v * kv[i]; t0 = sa0v * bv[i] + t0; s0[i] = s0[i] * dv[i] + t0;
                    f32x2 t1 = v1v * kv[i]; t1 = sa1v * bv[i] + t1; s1[i] = s1[i] * dv[i] + t1;
                }
                const int step = c * SC_CH + sl, t = dir ? (SEQ - 1 - step) : step;
                const unsigned yw = pk2(yo0, yo1);
                if (cgp == 0) *(unsigned*)(yrow + (size_t)t * RW) = yw;
                n0 = xn0; n1 = xn1; q0 = xq0; q1 = xq1; d0 = xd0; d1 = xd1; b0 = xb0; b1 = xb1; k0 = xk0; k1 = xk1; vv = xvv; sc = xsc;
            }
            __syncthreads();
        }
#undef SC_LOAD
    }
}

__device__ __forceinline__ bf16x8 pack8(const float (&x)[8]) {
    v4u w; w.x = pk2(x[0], x[1]); w.y = pk2(x[2], x[3]); w.z = pk2(x[4], x[5]); w.w = pk2(x[6], x[7]); return __builtin_bit_cast(bf16x8, w);
}
#define MFMA16(a, b, c) __builtin_amdgcn_mfma_f32_16x16x32_bf16((a), (b), (c), 0, 0, 0)
constexpr int KA_P = 72, VA_P = 392;
__device__ __forceinline__ void attnA_item(const Params& P, int item, LAS unsigned char* lds) {
    const int tid = pg8::mk_tid(lds), lane = tid & 63, wave = __builtin_amdgcn_readfirstlane(tid >> 6), l15 = lane & 15, q4 = lane >> 4;
    const int b = item >> 6, n = (item >> 2) & 15, hk = item & 3;
    const bf16* PRE = (const bf16*)(P.ws + WS_PRE); bf16* YC = (bf16*)(P.ws + WS_YCAT);
    const float* RC = (const float*)(P.ws + WS_ROPE); const float* RS = RC + SEQ * 32;
    LAS bf16* Ks = (LAS bf16*)lds; LAS bf16* Vt = Ks + 384 * KA_P;
    {
        v2u klo[6], khi[6]; f32x4 kcs[6], ksn[6]; v4u vw[6];
#pragma unroll
        for (int u = 0; u < 6; ++u) {
            const int it = tid + u * NTHREADS, j = it >> 3, c = it & 7, kp = (n - 1) * 128 + j;
            const bool ok = (kp >= 0 && kp < SEQ); const int kpc = ok ? kp : 0;
            const bf16* src = PRE + ((size_t)b * SEQ + kpc) * NPRE + C_AK + hk * 64;
            klo[u] = *(const v2u*)(src + 4 * c); khi[u] = *(const v2u*)(src + 32 + 4 * c);
            kcs[u] = *(const f32x4*)(RC + kpc * 32 + 4 * c); ksn[u] = *(const f32x4*)(RS + kpc * 32 + 4 * c);
            vw[u] = *(const v4u*)(PRE + ((size_t)b * SEQ + kpc) * NPRE + C_AV + hk * 64 + 8 * c);
        }
        const f32x4 g1 = *(const f32x4*)(P.in[7] + 4 * (tid & 7)), g2 = *(const f32x4*)(P.in[7] + 32 + 4 * (tid & 7));
#pragma unroll
        for (int u = 0; u < 6; ++u) {
            const int it = tid + u * NTHREADS, j = it >> 3, c = it & 7, kp = (n - 1) * 128 + j;
            const bool ok = (kp >= 0 && kp < SEQ);
            float x1[4], x2[4]; unpack4(klo[u], x1); unpack4(khi[u], x2);
            float ss = 0.f;
#pragma unroll
            for (int i = 0; i < 4; ++i) ss += x1[i] * x1[i] + x2[i] * x2[i];
            ss = red8(ss);
            const float rstd = ok ? 1.f / sqrtf(ss * (1.f / 64.f) + NORM_EPS) : 0.f;
            float r1[4], r2[4];
#pragma unroll
            for (int i = 0; i < 4; ++i) { const float y1 = x1[i] * rstd * g1[i], y2 = x2[i] * rstd * g2[i]; r1[i] = y1 * kcs[u][i] - y2 * ksn[u][i]; r2[i] = y2 * kcs[u][i] + y1 * ksn[u][i]; }
            v2u o0, o1; o0.x = pk2(r1[0], r1[1]); o0.y = pk2(r1[2], r1[3]); o1.x = pk2(r2[0], r2[1]); o1.y = pk2(r2[2], r2[3]);
            *(LAS v2u*)(Ks + j * KA_P + 4 * c) = o0; *(LAS v2u*)(Ks + j * KA_P + 32 + 4 * c) = o1;
            const v4u w = ok ? vw[u] : (v4u){0u, 0u, 0u, 0u};
            LAS bf16* d = Vt + (8 * c) * VA_P + j;
            d[0] = (bf16)(w.x & 0xffffu); d[VA_P] = (bf16)(w.x >> 16); d[2 * VA_P] = (bf16)(w.y & 0xffffu); d[3 * VA_P] = (bf16)(w.y >> 16);
            d[4 * VA_P] = (bf16)(w.z & 0xffffu); d[5 * VA_P] = (bf16)(w.z >> 16); d[6 * VA_P] = (bf16)(w.w & 0xffffu); d[7 * VA_P] = (bf16)(w.w >> 16);
        }
    }
    v4u qlo, qhi;
    {
        const int R0 = wave * 48, g = R0 >> 7, pos = (R0 & 127) + l15, qp = n * 128 + pos, hq = hk * 3 + g;
        const bf16* src = PRE + ((size_t)b * SEQ + qp) * NPRE + C_AQ + hq * 64;
        qlo = *(const v4u*)(src + 8 * q4); qhi = *(const v4u*)(src + 32 + 8 * q4);
    }
    __syncthreads();
#pragma unroll 1
    for (int mt = 0; mt < 3; ++mt) {
        const int R0 = wave * 48 + mt * 16, g = R0 >> 7, pos = (R0 & 127) + l15, qp = n * 128 + pos, hq = hk * 3 + g;
        const size_t m = (size_t)b * SEQ + qp;
        v2u gat[4];
#pragma unroll
        for (int dt = 0; dt < 4; ++dt) gat[dt] = *(const v2u*)(PRE + m * NPRE + C_AG + hq * 64 + dt * 16 + 4 * q4);
        const v4u cqlo = qlo, cqhi = qhi;
        {
            const int mn = (mt < 2) ? mt + 1 : 2, R1 = wave * 48 + mn * 16, g1_ = R1 >> 7, pos1 = (R1 & 127) + l15, qp1 = n * 128 + pos1, hq1 = hk * 3 + g1_;
            const bf16* src = PRE + ((size_t)b * SEQ + qp1) * NPRE + C_AQ + hq1 * 64;
            qlo = *(const v4u*)(src + 8 * q4); qhi = *(const v4u*)(src + 32 + 8 * q4);
        }
        bf16x8 qf0, qf1;
        {
            float x1[8], x2[8]; unpack8(cqlo, x1); unpack8(cqhi, x2);
            float ss = 0.f;
#pragma unroll
            for (int i = 0; i < 8; ++i) ss += x1[i] * x1[i] + x2[i] * x2[i];
            ss += __shfl_xor(ss, 16); ss += __shfl_xor(ss, 32);
            const float rstd = 0.125f / sqrtf(ss * (1.f / 64.f) + NORM_EPS);
            float r1[8], r2[8];
            const f32x4 ga = *(const f32x4*)(P.in[6] + 8 * q4), gb = *(const f32x4*)(P.in[6] + 8 * q4 + 4), gc = *(const f32x4*)(P.in[6] + 32 + 8 * q4), gd = *(const f32x4*)(P.in[6] + 36 + 8 * q4);
            const f32x4 ca = *(const f32x4*)(RC + qp * 32 + 8 * q4), cb = *(const f32x4*)(RC + qp * 32 + 8 * q4 + 4), sa_ = *(const f32x4*)(RS + qp * 32 + 8 * q4), sb_ = *(const f32x4*)(RS + qp * 32 + 8 * q4 + 4);
#pragma unroll
            for (int i = 0; i < 8; ++i) {
                const float g1 = (i < 4) ? ga[i & 3] : gb[i & 3], g2 = (i < 4) ? gc[i & 3] : gd[i & 3], cs = (i < 4) ? ca[i & 3] : cb[i & 3], sn = (i < 4) ? sa_[i & 3] : sb_[i & 3];
                const float y1 = x1[i] * rstd * g1, y2 = x2[i] * rstd * g2; r1[i] = y1 * cs - y2 * sn; r2[i] = y2 * cs + y1 * sn;
            }
            qf0 = pack8(r1); qf1 = pack8(r2);
        }
        f32x4 acc[24];
#pragma unroll
        for (int kt = 0; kt < 24; ++kt) {
            const LAS bf16* kr = Ks + (kt * 16 + l15) * KA_P + 8 * q4;
            const bf16x8 k0 = *(const LAS bf16x8*)(kr), k1 = *(const LAS bf16x8*)(kr + 32);
            f32x4 a = (f32x4){0.f, 0.f, 0.f, 0.f};
            a = MFMA16(k0, qf0, a); a = MFMA16(k1, qf1, a); acc[kt] = a;
        }
        const float sink = P.in[8][hq];
        float mx = sink;
#pragma unroll
        for (int kt = 0; kt < 24; ++kt)
#pragma unroll
            for (int i = 0; i < 4; ++i) {
                const int j = kt * 16 + 4 * q4 + i, rel = j - 128 - pos, kp = (n - 1) * 128 + j;
                const bool valid = (rel >= -128) && (rel <= 128) && (kp >= 0) && (kp < SEQ);
                const float sv = valid ? acc[kt][i] : -1e30f; acc[kt][i] = sv; mx = fmaxf(mx, sv);
            }
        mx = fmaxf(mx, __shfl_xor(mx, 16)); mx = fmaxf(mx, __shfl_xor(mx, 32));
        float sum = 0.f;
#pragma unroll
        for (int kt = 0; kt < 24; ++kt)
#pragma unroll
            for (int i = 0; i < 4; ++i) { const float p = __expf(acc[kt][i] - mx); acc[kt][i] = p; sum += p; }
        sum += __shfl_xor(sum, 16); sum += __shfl_xor(sum, 32);
        const float inv = 1.f / (sum + __expf(sink - mx));
        f32x4 o[4];
#pragma unroll
        for (int dt = 0; dt < 4; ++dt) o[dt] = (f32x4){0.f, 0.f, 0.f, 0.f};
#pragma unroll
        for (int k2 = 0; k2 < 12; ++k2) {
            float pp[8] = {acc[2 * k2][0], acc[2 * k2][1], acc[2 * k2][2], acc[2 * k2][3], acc[2 * k2 + 1][0], acc[2 * k2 + 1][1], acc[2 * k2 + 1][2], acc[2 * k2 + 1][3]};
            const bf16x8 pf = pack8(pp);
#pragma unroll
            for (int dt = 0; dt < 4; ++dt) {
                const LAS bf16* vr = Vt + (dt * 16 + l15) * VA_P + k2 * 32 + 4 * q4;
                const v2u v0 = *(const LAS v2u*)(vr), v1 = *(const LAS v2u*)(vr + 16);
                const v4u vw = (v4u){v0.x, v0.y, v1.x, v1.y};
                o[dt] = MFMA16(__builtin_bit_cast(bf16x8, vw), pf, o[dt]);
            }
        }
#pragma unroll
        for (int dt = 0; dt < 4; ++dt) {
            const int ch = hq * 64 + dt * 16 + 4 * q4;
            float gg[4]; unpack4(gat[dt], gg);
            v2u w; w.x = pk2(o[dt][0] * inv * gg[0], o[dt][1] * inv * gg[1]); w.y = pk2(o[dt][2] * inv * gg[2], o[dt][3] * inv * gg[3]);
            *(v2u*)(YC + m * DM + ch) = w;
        }
    }
    __syncthreads();
}

constexpr int KC_P = 136, VC_P = 264;
__device__ __forceinline__ void attnC_item(const Params& P, int item, LAS unsigned char* lds) {
    const int tid = pg8::mk_tid(lds), lane = tid & 63, wave = __builtin_amdgcn_readfirstlane(tid >> 6), l15 = lane & 15, q4 = lane >> 4;
    const int b = item >> 6, qb = (item >> 2) & 15, hx = item & 3;
    const bf16* PRE = (const bf16*)(P.ws + WS_PRE); const bf16* MKV = (const bf16*)(P.ws + WS_MKV); bf16* YC = (bf16*)(P.ws + WS_YCAT);
    LAS bf16* Ks = (LAS bf16*)lds; LAS bf16* Vt = Ks + 256 * KC_P;
    const int q = qb * 128 + wave * 16 + l15; const size_t m = (size_t)b * SEQ + q;
    {
        v4u kw[8], vw[8];
#pragma unroll
        for (int u = 0; u < 8; ++u) {
            const int it = tid + u * NTHREADS, j = it >> 4, c = it & 15;
            const bf16* src = MKV + ((size_t)b * NMEM + j) * 1024 + hx * 128 + 8 * c;
            kw[u] = *(const v4u*)(src); vw[u] = *(const v4u*)(src + 512);
        }
        const f32x4 g0 = *(const f32x4*)(P.in[23] + 8 * (tid & 15)), g1 = *(const f32x4*)(P.in[23] + 8 * (tid & 15) + 4);
#pragma unroll
        for (int u = 0; u < 8; ++u) {
            const int it = tid + u * NTHREADS, j = it >> 4, c = it & 15;
            float x[8]; unpack8(kw[u], x);
            float ss = 0.f;
#pragma unroll
            for (int i = 0; i < 8; ++i) ss += x[i] * x[i];
            ss = red8(ss); ss = dpp_add<0x140>(ss);
            const float rstd = 1.f / sqrtf(ss * (1.f / 128.f) + NORM_EPS);
            v4u o; o.x = pk2(x[0] * rstd * g0.x, x[1] * rstd * g0.y); o.y = pk2(x[2] * rstd * g0.z, x[3] * rstd * g0.w);
            o.z = pk2(x[4] * rstd * g1.x, x[5] * rstd * g1.y); o.w = pk2(x[6] * rstd * g1.z, x[7] * rstd * g1.w);
            *(LAS v4u*)(Ks + j * KC_P + 8 * c) = o;
            const v4u w = vw[u];
            LAS bf16* d = Vt + (8 * c) * VC_P + j;
            d[0] = (bf16)(w.x & 0xffffu); d[VC_P] = (bf16)(w.x >> 16); d[2 * VC_P] = (bf16)(w.y & 0xffffu); d[3 * VC_P] = (bf16)(w.y >> 16);
            d[4 * VC_P] = (bf16)(w.z & 0xffffu); d[5 * VC_P] = (bf16)(w.z >> 16); d[6 * VC_P] = (bf16)(w.w & 0xffffu); d[7 * VC_P] = (bf16)(w.w >> 16);
        }
    }
    v4u qraw[4]; v2u gat[8];
    {
        const bf16* src = PRE + m * NPRE + C_XQ + hx * 128 + 8 * q4;
#pragma unroll
        for (int ks = 0; ks < 4; ++ks) qraw[ks] = *(const v4u*)(src + ks * 32);
#pragma unroll
        for (int dt = 0; dt < 8; ++dt) gat[dt] = *(const v2u*)(PRE + m * NPRE + C_XG + hx * 128 + dt * 16 + 4 * q4);
    }
    __syncthreads();
    {
        bf16x8 qf[4];
        {
            float x[4][8]; float ss = 0.f;
#pragma unroll
            for (int ks = 0; ks < 4; ++ks) { unpack8(qraw[ks], x[ks]);
#pragma unroll
                for (int i = 0; i < 8; ++i) ss += x[ks][i] * x[ks][i]; }
            ss += __shfl_xor(ss, 16); ss += __shfl_xor(ss, 32);
            const float rstd = 0.08838834764831845f / sqrtf(ss * (1.f / 128.f) + NORM_EPS);
#pragma unroll
            for (int ks = 0; ks < 4; ++ks) { float y[8];
                const f32x4 ga = *(const f32x4*)(P.in[22] + ks * 32 + 8 * q4), gb = *(const f32x4*)(P.in[22] + ks * 32 + 8 * q4 + 4);
#pragma unroll
                for (int i = 0; i < 8; ++i) y[i] = x[ks][i] * rstd * ((i < 4) ? ga[i & 3] : gb[i & 3]);
                qf[ks] = pack8(y); }
        }
        f32x4 acc[16];
#pragma unroll
        for (int kt = 0; kt < 16; ++kt) {
            const LAS bf16* kr = Ks + (kt * 16 + l15) * KC_P + 8 * q4;
            f32x4 a = (f32x4){0.f, 0.f, 0.f, 0.f};
#pragma unroll
            for (int ks = 0; ks < 4; ++ks) a = MFMA16(*(const LAS bf16x8*)(kr + ks * 32), qf[ks], a);
            acc[kt] = a;
        }
        float mx = -1e30f;
#pragma unroll
        for (int kt = 0; kt < 16; ++kt)
#pragma unroll
            for (int i = 0; i < 4; ++i) mx = fmaxf(mx, acc[kt][i]);
        mx = fmaxf(mx, __shfl_xor(mx, 16)); mx = fmaxf(mx, __shfl_xor(mx, 32));
        float sum = 0.f;
#pragma unroll
        for (int kt = 0; kt < 16; ++kt)
#pragma unroll
            for (int i = 0; i < 4; ++i) { const float p = __expf(acc[kt][i] - mx); acc[kt][i] = p; sum += p; }
        sum += __shfl_xor(sum, 16); sum += __shfl_xor(sum, 32);
        const float inv = 1.f / sum;
        f32x4 o[8];
#pragma unroll
        for (int dt = 0; dt < 8; ++dt) o[dt] = (f32x4){0.f, 0.f, 0.f, 0.f};
#pragma unroll
        for (int k2 = 0; k2 < 8; ++k2) {
            float pp[8] = {acc[2 * k2][0], acc[2 * k2][1], acc[2 * k2][2], acc[2 * k2][3], acc[2 * k2 + 1][0], acc[2 * k2 + 1][1], acc[2 * k2 + 1][2], acc[2 * k2 + 1][3]};
            const bf16x8 pf = pack8(pp);
#pragma unroll
            for (int dt = 0; dt < 8; ++dt) {
                const LAS bf16* vr = Vt + (dt * 16 + l15) * VC_P + k2 * 32 + 4 * q4;
                const v2u v0 = *(const LAS v2u*)(vr), v1 = *(const LAS v2u*)(vr + 16);
                const v4u vw = (v4u){v0.x, v0.y, v1.x, v1.y};
                o[dt] = MFMA16(__builtin_bit_cast(bf16x8, vw), pf, o[dt]);
            }
        }
#pragma unroll
        for (int dt = 0; dt < 8; ++dt) {
            const int ch = hx * 128 + dt * 16 + 4 * q4;
            float gg[4]; unpack4(gat[dt], gg);
            v2u w; w.x = pk2(o[dt][0] * inv * gg[0], o[dt][1] * inv * gg[1]); w.y = pk2(o[dt][2] * inv * gg[2], o[dt][3] * inv * gg[3]);
            *(v2u*)(YC + m * DM + 1536 + ch) = w;
        }
    }
    __syncthreads();
}

__device__ __forceinline__ void p5_rwkv_post(const Params& P, LAS unsigned char* lds) {
    const bf16* PRE = (const bf16*)(P.ws + WS_PRE); const bf16* EA = (const bf16*)((unsigned char*)P.out + DO_EA);
    const bf16* YF = (const bf16*)((unsigned char*)P.out + DO_YF); const bf16* YB = (const bf16*)(P.ws + WS_YB); bf16* YC = (bf16*)(P.ws + WS_YCAT);
    const float* mu = P.in[10];
    const int gt = blockIdx.x * NTHREADS + pg8::mk_tid(lds), NGT = gridDim.x * NTHREADS;
    for (int idx = gt; idx < M_TOK * 96; idx += NGT) {
        const int m = idx / 96, he = idx - m * 96, ch0 = he * 8, t = m & (SEQ - 1);
        const bf16* p = PRE + (size_t)m * NPRE + C_RS + ch0;
        const v4u z4 = (v4u){0u, 0u, 0u, 0u};
        const bool hp = t > 0, hn = t < SEQ - 1;
        const v4u rc = *(const v4u*)(p), kc = *(const v4u*)(p + 768), vc = *(const v4u*)(p + 1536);
        const v4u rp = hp ? *(const v4u*)(p - NPRE) : z4, kp = hp ? *(const v4u*)(p - NPRE + 768) : z4, vp = hp ? *(const v4u*)(p - NPRE + 1536) : z4;
        const v4u rn = hn ? *(const v4u*)(p + NPRE) : z4, kn = hn ? *(const v4u*)(p + NPRE + 768) : z4, vn = hn ? *(const v4u*)(p + NPRE + 1536) : z4;
        const v4u af8 = *(const v4u*)(EA + (size_t)m * NLORA + 1536 + ch0), ab8 = *(const v4u*)(EA + (size_t)m * NLORA + 2304 + ch0);
        const v4u yf8 = *(const v4u*)(YF + (size_t)m * RW + ch0), yb8 = *(const v4u*)(YB + (size_t)m * RW + ch0);
        const v4u rg8 = *(const v4u*)(PRE + (size_t)m * NPRE + C_RG + ch0);
        float r[8], k[8], v[8], x0[8], x1[8], x2[8];
        unpack8(rc, x0); unpack8(rp, x1); unpack8(rn, x2);
#pragma unroll
        for (int i = 0; i < 8; ++i) r[i] = x0[i] + mu[ch0 + i] * (0.5f * (x1[i] + x2[i]) - x0[i]);
        unpack8(kc, x0); unpack8(kp, x1); unpack8(kn, x2);
#pragma unroll
        for (int i = 0; i < 8; ++i) k[i] = x0[i] + mu[768 + ch0 + i] * (0.5f * (x1[i] + x2[i]) - x0[i]);
        unpack8(vc, x0); unpack8(vp, x1); unpack8(vn, x2);
#pragma unroll
        for (int i = 0; i < 8; ++i) v[i] = x0[i] + mu[1536 + ch0 + i] * (0.5f * (x1[i] + x2[i]) - x0[i]);
        float af[8], ab[8], ys[8], yb[8], rg[8]; unpack8(af8, af); unpack8(ab8, ab); unpack8(yf8, ys); unpack8(yb8, yb); unpack8(rg8, rg);
        float bs = 0.f, sm = 0.f;
#pragma unroll
        for (int i = 0; i < 8; ++i) { const float kds = k[i] * (2.f + (af[i] + ab[i] - 2.f) * P.in[12][ch0 + i]); bs += r[i] * kds * P.in[13][ch0 + i]; ys[i] += yb[i]; sm += ys[i]; }
        bs = red8(bs); sm = red8(sm);
        const float mean = sm * (1.f / 64.f);
        float vs = 0.f;
#pragma unroll
        for (int i = 0; i < 8; ++i) { ys[i] -= mean; vs += ys[i] * ys[i]; }
        vs = red8(vs);
        const float rstd = 1.f / sqrtf(vs * (1.f / 64.f) + GN_EPS);
        float o[8];
#pragma unroll
        for (int i = 0; i < 8; ++i) o[i] = (ys[i] * rstd * P.in[18][ch0 + i] + P.in[19][ch0 + i] + bs * v[i]) * rg[i];
        v4u w; w.x = pk2(o[0], o[1]); w.y = pk2(o[2], o[3]); w.z = pk2(o[4], o[5]); w.w = pk2(o[6], o[7]);
        *(v4u*)(YC + (size_t)m * DM + 768 + ch0) = w;
    }
}

constexpr int N_PHASES = 8;
__global__ void __launch_bounds__(NTHREADS, 2) hybrid_fwd(Params P) {
    extern __shared__ __attribute__((aligned(16))) unsigned char lds_raw[];
    LAS unsigned char* lds = (LAS unsigned char*)lds_raw;
    cg::grid_group grid = cg::this_grid();
    const int lo = P.ph_lo, hi = P.ph_hi, G = gridDim.x;
    if ((threadIdx.x & 63) == 0) *(volatile LAS int*)(lds + pg8::TIDTAB_OFF + 4 * pg8::hw_slot()) = (int)(threadIdx.x >> 6);
    __syncthreads();
    unsigned char* ws = P.ws; unsigned char* dob = (unsigned char*)P.out;
#ifdef PHMASK
#define IN(k) (((PHMASK >> (k)) & 1) && lo <= (k) && (k) < hi)
#else
#define IN(k) (lo <= (k) && (k) < hi)
#endif
#define SEAM(k) do { if (IN(k) && IN((k) + 1)) grid.sync(); } while (0)
#ifndef REPEAT_MASK
#define REPEAT_MASK 0
#endif
#define REP(k) for (int rep_ = 0; rep_ < (((REPEAT_MASK >> (k)) & 1) ? 2 : 1); ++rep_)
#define REPSYNC() do { if (rep_) grid.sync(); } while (0)
    if (IN(0)) REP(0) { REPSYNC(); p0_prologue(P, lds, P.out); __syncthreads(); }
    SEAM(0);
    if (IN(1)) REP(1) { REPSYNC();
        { pg8::Gemm g{(const bf16*)(dob + DO_H), (const bf16*)(dob + DO_WIN), M_TOK, NIN, DM}; pg8::StaticOrder S; S.init(M_TOK, NIN, G, (int)blockIdx.x);
          EpiProj E{(bf16*)(ws + WS_PRE), (bf16*)(ws + WS_GATES), P.in[5]};
          pg8::gemm_phase<EpiProj, pg8::StaticOrder, true, true>(lds, g, S, E); }
        { pg8::Gemm g{(const bf16*)(ws + WS_MEMN), (const bf16*)(ws + WS_WXKV), MEMROWS, 1024, DM}; pg8::StaticOrder S; S.init(MEMROWS, 1024, G, (int)blockIdx.x);
          EpiPlain E{(bf16*)(ws + WS_MKV), 1024};
          pg8::gemm_phase<EpiPlain, pg8::StaticOrder, true, true>(lds, g, S, E); }
    }
    SEAM(1);
    if (IN(2)) REP(2) { REPSYNC(); p2_lora_in(P, lds); }
    SEAM(2);
    if (IN(3)) REP(3) { REPSYNC();
        int klora = 256; asm volatile("" : "+s"(klora));
        pg8::Gemm g{(const bf16*)(dob + DO_LIN), (const bf16*)(ws + WS_LORAB), M_TOK, NLORA, klora}; pg8::StaticOrder S; S.init(M_TOK, NLORA, G, (int)blockIdx.x);
        EpiLora E{(bf16*)(dob + DO_EA), P.in[14], P.in[16]};
        pg8::gemm_phase<EpiLora, pg8::StaticOrder, true, true>(lds, g, S, E);
    }
    SEAM(3);
    if (IN(4)) REP(4) { REPSYNC();
        const int bid = blockIdx.x;
        if (bid < 192) scan_block(P, bid, lds);
        else {
            const int na = G - 192;
#ifndef ATT_REP
#define ATT_REP 1
#endif
            for (int ar = 0; ar < ATT_REP; ++ar)
            for (int it = bid - 192; it < 1024; it += na) { if (it < 512) attnA_item(P, it, lds); else attnC_item(P, it - 512, lds); }
        }
    }
    SEAM(4);
    if (IN(5)) REP(5) { REPSYNC(); p5_rwkv_post(P, lds); }
    SEAM(5);
    if (IN(6)) REP(6) { REPSYNC();
        pg8::Gemm g{(const bf16*)(ws + WS_YCAT), (const bf16*)(ws + WS_WCAT), M_TOK, DM, DM}; pg8::StaticOrder S; S.init(M_TOK, DM, G, (int)blockIdx.x);
        EpiMerged E{(bf16*)(ws + WS_MERGED), (const bf16*)(ws + WS_GATES)};
        pg8::gemm_phase<EpiMerged, pg8::StaticOrder, true, true>(lds, g, S, E);
    }
    SEAM(6);
    if (IN(7)) REP(7) { REPSYNC();
        pg8::Gemm g{(const bf16*)(ws + WS_MERGED), (const bf16*)(ws + WS_WOUT), M_TOK, DM, DM}; pg8::StaticOrder S; S.init(M_TOK, DM, G, (int)blockIdx.x);
        EpiOut E{P.out, P.in[0]};
        pg8::gemm_phase<EpiOut, pg8::StaticOrder, true, true>(lds, g, S, E);
    }
#undef IN
#undef SEAM
}

#ifndef ONE_LAUNCH
#define ONE_LAUNCH 1
#endif
extern "C" void kernel_launch(void* const* d_in, const int* in_sizes, int n_in, void* d_out, int out_size, void* d_ws, size_t ws_size, hipStream_t stream) {
    static int grid = 0;
    if (grid == 0) {
        if (n_in != 26 || out_size != M_TOK * DM || ws_size < WS_END) { fprintf(stderr, "kernel_launch: unexpected shapes (n_in %d, out %d, ws %zu); nothing launched\n", n_in, out_size, ws_size); grid = -1; return; }
        int dev = 0, cus = 0, per_cu = 0;
        hipGetDevice(&dev); hipDeviceGetAttribute(&cus, hipDeviceAttributeMultiprocessorCount, dev);
        if (hipFuncSetAttribute((const void*)hybrid_fwd, hipFuncAttributeMaxDynamicSharedMemorySize, LDS_BYTES) != hipSuccess) { fprintf(stderr, "kernel_launch: hipFuncSetAttribute failed\n"); grid = -1; return; }
        hipOccupancyMaxActiveBlocksPerMultiprocessor(&per_cu, (const void*)hybrid_fwd, NTHREADS, LDS_BYTES);
        (void)hipGetLastError();
        if (per_cu < 1) per_cu = 1;
        grid = cus * per_cu; if (grid > 256) grid = 256;
        if (grid < 200) { fprintf(stderr, "kernel_launch: grid %d too small for the scan/attention split\n", grid); grid = -1; return; }
    }
    if (grid < 0) return;
    Params p{};
    for (int i = 0; i < 26; ++i) p.in[i] = (const float*)d_in[i];
    p.out = (float*)d_out; p.ws = (unsigned char*)d_ws;
#if ONE_LAUNCH
    p.ph_lo = 0; p.ph_hi = N_PHASES;
    void* args[] = {&p};
    hipError_t e = hipLaunchCooperativeKernel((const void*)hybrid_fwd, dim3(grid), dim3(NTHREADS), args, LDS_BYTES, stream);
    if (e != hipSuccess) fprintf(stderr, "cooperative launch failed: %s (grid %d)\n", hipGetErrorString(e), grid);
#else
    for (int ph = 0; ph < N_PHASES; ++ph) {
        p.ph_lo = ph; p.ph_hi = ph + 1;
        hipLaunchKernelGGL(hybrid_fwd, dim3(grid), dim3(NTHREADS), LDS_BYTES, stream, p);
    }
#endif
}
```

```cpp
#include <hip/hip_runtime.h>
#include <hip/hip_cooperative_groups.h>
#include <cstdio>
#include <cstdint>
namespace cg = cooperative_groups;
namespace pg8 {
#define PG8_LAS __attribute__((address_space(3)))
typedef unsigned short bf16_t;
typedef short bf16x8 __attribute__((ext_vector_type(8)));
typedef float f32x4 __attribute__((ext_vector_type(4)));
typedef unsigned u32x4 __attribute__((ext_vector_type(4)));
constexpr int BM = 256, BK = 64, HALF = 128, HTB = HALF * BK * 2  , STAGE_BYTES = 8 * HTB, NXCD = 8, WGM = 8;

__host__ __device__ __forceinline__ int lds_byte(int r, int c) { const int st = (r >> 4) * 2 + (c >> 5), rr = r & 15, cc = c & 31, ob = rr * 64 + cc * 2; return st * 1024 + (ob ^ (((ob >> 9) & 1) << 5)); }
__host__ __device__ __forceinline__ void stage_rc(int b, int& R, int& C) { const int st = b / 1024, sb = b % 1024, swz = sb ^ (((sb >> 9) & 1) << 5); R = (st >> 1) * 16 + swz / 64; C = (st & 1) * 32 + (swz % 64) / 2; }
__host__ __device__ __forceinline__ int perm32(int rho) { const int n = rho >> 4, i = rho & 15; return 8 * (i >> 2) + 4 * n + (i & 3); }


constexpr int TIDTAB_OFF = 147200;
__device__ __forceinline__ int hw_slot() { return (int)(__builtin_amdgcn_s_getreg((5 << 11) | 4) & 63u); }
__device__ __forceinline__ int mk_tid(PG8_LAS unsigned char* lds) {
    const int lane = (int)__builtin_amdgcn_mbcnt_hi(~0u, __builtin_amdgcn_mbcnt_lo(~0u, 0u));
    const int w = __builtin_amdgcn_readfirstlane(*(volatile PG8_LAS int*)(lds + TIDTAB_OFF + 4 * hw_slot()));
    return w * 64 + lane;
}
struct Unit { int pm, pn; };
struct Gemm { const bf16_t* A; const bf16_t* Bt; int M, N, K; };

struct StaticOrder {
    int nM, nN, nwg, G, c;
    __host__ __device__ void init(int M, int N, int G_, int c_) { nM = M / BM; nN = N / BM; nwg = nM * nN; G = G_; c = c_; }
    __host__ __device__ bool next(int i, Unit& u) const {
        const long L = (long)i * G + c; if (L >= nwg) return false;
        int wgid = (int)L; { const int q = nwg / NXCD, r = nwg % NXCD, xcd = wgid % NXCD, off = wgid / NXCD; wgid = (xcd < r ? xcd * (q + 1) : r * (q + 1) + (xcd - r) * q) + off; }
        const int nig = WGM * nN, gid = wgid / nig, fm = gid * WGM, gsz = (nM - fm) < WGM ? (nM - fm) : WGM;
        u.pm = fm + ((wgid % nig) % gsz); u.pn = (wgid % nig) / gsz; return true;
    }
    __device__ __forceinline__ void a_ready(const Unit&) const {}
    __device__ __forceinline__ void done(const Unit&) const {}
};

__device__ __forceinline__ unsigned cvt_pk_bf16(float lo, float hi) { unsigned r; asm volatile("v_cvt_pk_bf16_f32 %0, %1, %2" : "=v"(r) : "v"(lo), "v"(hi)); return r; }
template <class Epi, class Sched, bool ALIGN_EPI = false, bool SP2 = false>
__device__ __forceinline__ void gemm_phase(PG8_LAS unsigned char* lds, const Gemm g, const Sched& S, const Epi& E) {
    const int tid = mk_tid(lds), wid = __builtin_amdgcn_readfirstlane(tid >> 6), lane = tid & 63, wr = wid >> 2, wc = wid & 3, fr = lane & 15, fq = lane >> 4;
    const int K = g.K, nt = K / BK;
    unsigned voffA[2], voffB[2];
#pragma unroll
    for (int i = 0; i < 2; ++i) { int R, C; stage_rc(tid * 16 + i * 8192, R, C); const int Rb = Epi::PERM ? ((R & ~31) + perm32(R & 31)) : R;
        voffA[i] = (unsigned)(R * K + C) * 2u; voffB[i] = (unsigned)(Rb * K + C) * 2u; }
    const size_t kstep = (size_t)(BK * 2);
    const size_t hstep = (size_t)HALF * K * 2;
    const size_t tstep = 2 * hstep;
    const unsigned ldsw = (unsigned)wid * 1024u;
    const int aoff = lds_byte(wr * 64 + fr, fq * 8), boff = lds_byte(wc * 32 + fr, fq * 8);
#define PG8_SA(b, h) (((b) * 2 + (h)) * HTB)
#define PG8_SB(b, h) ((4 + (b) * 2 + (h)) * HTB)
#define PG8_STAGE(bufoff, gbase, voff) do { _Pragma("unroll") for (int _i = 0; _i < 2; ++_i) \
        __builtin_amdgcn_global_load_lds((const unsigned*)((const char*)(gbase) + (voff)[_i]), (PG8_LAS unsigned*)(lds + (bufoff) + ldsw + _i * 8192), 16, 0, 0); } while (0)
#define PG8_LDA(dst, b, h) do { _Pragma("unroll") for (int m = 0; m < 4; ++m) _Pragma("unroll") for (int k = 0; k < 2; ++k) dst[m][k] = *(const PG8_LAS bf16x8*)(lds + PG8_SA(b, h) + aoff + m * 2048 + k * 1024); } while (0)
#define PG8_LDB(dst, b, h) do { _Pragma("unroll") for (int n = 0; n < 2; ++n) _Pragma("unroll") for (int k = 0; k < 2; ++k) dst[n][k] = *(const PG8_LAS bf16x8*)(lds + PG8_SB(b, h) + boff + n * 2048 + k * 1024); } while (0)
#define PG8_MMA(ai, bj, At, Bt) do { __builtin_amdgcn_s_setprio(1); _Pragma("unroll") for (int m = 0; m < 4; ++m) _Pragma("unroll") for (int n = 0; n < 2; ++n) _Pragma("unroll") for (int k = 0; k < 2; ++k) \
        acc[ai][bj][m][n] = __builtin_amdgcn_mfma_f32_16x16x32_bf16(Bt[n][k], At[m][k], acc[ai][bj][m][n], 0, 0, 0); __builtin_amdgcn_s_setprio(0); } while (0)
#define PG8_WAIT_V(n) asm volatile("s_waitcnt vmcnt(" #n ")" ::: "memory")
#define PG8_WAIT_L(n) asm volatile("s_waitcnt lgkmcnt(" #n ")" ::: "memory")
#define PG8_BAR __builtin_amdgcn_s_barrier()
#define PG8_SCHED __builtin_amdgcn_sched_barrier(0)
    Unit cur, nxt; int ui = 0;
    if (!S.next(0, cur)) return;
    f32x4 acc[2][2][4][2];
#pragma unroll
    for (int a = 0; a < 2; ++a)
#pragma unroll
        for (int b = 0; b < 2; ++b)
#pragma unroll
            for (int m = 0; m < 4; ++m)
#pragma unroll
                for (int n = 0; n < 2; ++n) acc[a][b][m][n] = (f32x4){0.f, 0.f, 0.f, 0.f};
    bf16x8 At[4][2], B0[2][2], B1[2][2];
    const char* cA = (const char*)g.A + (size_t)cur.pm * tstep; const char* cB = (const char*)g.Bt + (size_t)cur.pn * tstep;
    S.a_ready(cur);
    if constexpr (SP2) {
        PG8_STAGE(PG8_SB(0, 0), cB, voffB); PG8_STAGE(PG8_SB(0, 1), cB + hstep, voffB); PG8_STAGE(PG8_SA(0, 0), cA, voffA); PG8_STAGE(PG8_SA(0, 1), cA + hstep, voffA);
        if (wr == 1) PG8_BAR;
        PG8_WAIT_V(2); PG8_BAR;
        PG8_STAGE(PG8_SB(1, 0), cB + kstep, voffB); PG8_STAGE(PG8_SA(1, 0), cA + kstep, voffA); PG8_STAGE(PG8_SB(1, 1), cB + hstep + kstep, voffB);
        PG8_WAIT_V(6); PG8_BAR;
    } else {
        PG8_STAGE(PG8_SB(0, 0), cB, voffB); PG8_STAGE(PG8_SA(0, 0), cA, voffA); PG8_STAGE(PG8_SB(0, 1), cB + hstep, voffB); PG8_STAGE(PG8_SA(0, 1), cA + hstep, voffA);
        if (wr == 1) PG8_BAR;
        PG8_WAIT_V(4); PG8_BAR;
        PG8_STAGE(PG8_SB(1, 0), cB + kstep, voffB); PG8_STAGE(PG8_SA(1, 0), cA + kstep, voffA); PG8_STAGE(PG8_SB(1, 1), cB + hstep + kstep, voffB);
        PG8_WAIT_V(6); PG8_BAR;
    }
    for (;;) {
        const bool has_next = S.next(ui + 1, nxt);
        const char* nA = has_next ? (const char*)g.A + (size_t)nxt.pm * tstep : cA; const char* nB = has_next ? (const char*)g.Bt + (size_t)nxt.pn * tstep : cB;
        for (int t = 0; t < nt; t += 2) {
            if constexpr (Epi::KHOOK) { if (t == Epi::HK0 || t == Epi::HK1) E.khook(acc, cur, t, wr, wc, fr, fq); }
            const bool last = (t == nt - 2);
            const char* a1 = cA + (size_t)(t + 1) * kstep;
            const char* a2 = last ? nA : cA + (size_t)(t + 2) * kstep; const char* b2 = last ? nB : cB + (size_t)(t + 2) * kstep;
            const char* a3 = a2 + kstep; const char* b3 = b2 + kstep;
            if (last && has_next) S.a_ready(nxt);
            if constexpr (SP2) {
            PG8_LDB(B0, 0, 0); PG8_LDB(B1, 0, 1); PG8_SCHED; PG8_LDA(At, 0, 0); PG8_STAGE(PG8_SA(1, 1), a1 + hstep, voffA);
            PG8_WAIT_V(8); PG8_WAIT_L(0); PG8_BAR; PG8_MMA(0, 0, At, B0); PG8_MMA(0, 1, At, B1); PG8_BAR; PG8_SCHED;
            PG8_LDA(At, 0, 1); PG8_STAGE(PG8_SB(0, 0), b2, voffB); PG8_STAGE(PG8_SB(0, 1), b2 + hstep, voffB); PG8_STAGE(PG8_SA(0, 0), a2, voffA);
            PG8_WAIT_V(8); PG8_WAIT_L(0); PG8_BAR; PG8_MMA(1, 0, At, B0); PG8_MMA(1, 1, At, B1); PG8_BAR; PG8_SCHED;
            PG8_LDB(B0, 1, 0); PG8_LDB(B1, 1, 1); PG8_SCHED; PG8_LDA(At, 1, 0); PG8_STAGE(PG8_SA(0, 1), a2 + hstep, voffA);
            PG8_WAIT_V(8); PG8_WAIT_L(0); PG8_BAR; PG8_MMA(0, 0, At, B0); PG8_MMA(0, 1, At, B1); PG8_BAR; PG8_SCHED;
            PG8_LDA(At, 1, 1); PG8_STAGE(PG8_SB(1, 0), b3, voffB); PG8_STAGE(PG8_SB(1, 1), b3 + hstep, voffB); PG8_STAGE(PG8_SA(1, 0), a3, voffA);
            PG8_WAIT_V(8); PG8_WAIT_L(0); PG8_BAR; PG8_MMA(1, 0, At, B0); PG8_MMA(1, 1, At, B1); PG8_BAR; PG8_SCHED;
            } else {
            PG8_LDB(B0, 0, 0); PG8_SCHED; PG8_LDA(At, 0, 0); PG8_STAGE(PG8_SA(1, 1), a1 + hstep, voffA);
            PG8_WAIT_L(8); PG8_BAR; PG8_WAIT_L(0); PG8_MMA(0, 0, At, B0); PG8_BAR; PG8_SCHED;
            PG8_LDB(B1, 0, 1); PG8_STAGE(PG8_SB(0, 0), b2, voffB);
            PG8_BAR; PG8_WAIT_L(0); PG8_MMA(0, 1, At, B1); PG8_BAR;
            PG8_LDA(At, 0, 1); PG8_STAGE(PG8_SA(0, 0), a2, voffA);
            PG8_BAR; PG8_WAIT_L(0); PG8_MMA(1, 0, At, B0); PG8_BAR; PG8_SCHED;
            PG8_STAGE(PG8_SB(0, 1), b2 + hstep, voffB);
            PG8_WAIT_V(6); PG8_BAR; PG8_MMA(1, 1, At, B1); PG8_BAR;
            PG8_LDB(B0, 1, 0); PG8_SCHED; PG8_LDA(At, 1, 0); PG8_STAGE(PG8_SA(0, 1), a2 + hstep, voffA);
            PG8_WAIT_L(8); PG8_BAR; PG8_WAIT_L(0); PG8_MMA(0, 0, At, B0); PG8_BAR; PG8_SCHED;
            PG8_LDB(B1, 1, 1); PG8_STAGE(PG8_SB(1, 0), b3, voffB);
            PG8_BAR; PG8_WAIT_L(0); PG8_MMA(0, 1, At, B1); PG8_BAR;
            PG8_LDA(At, 1, 1); PG8_STAGE(PG8_SA(1, 0), a3, voffA);
            PG8_BAR; PG8_WAIT_L(0); PG8_MMA(1, 0, At, B0); PG8_BAR; PG8_SCHED;
            PG8_STAGE(PG8_SB(1, 1), b3 + hstep, voffB);
            PG8_WAIT_V(6); PG8_BAR; PG8_MMA(1, 1, At, B1); PG8_BAR;
            }
        }
        if constexpr (ALIGN_EPI) { if (wr == 0) PG8_BAR; }
        if constexpr (!Epi::AFTER_DRAIN) { E(acc, cur, wr, wc, fr, fq); S.done(cur); }
        if (!has_next) break;
#pragma unroll
        for (int a = 0; a < 2; ++a)
#pragma unroll
            for (int b = 0; b < 2; ++b)
#pragma unroll
                for (int m = 0; m < 4; ++m)
#pragma unroll
                    for (int n = 0; n < 2; ++n) acc[a][b][m][n] = (f32x4){0.f, 0.f, 0.f, 0.f};
        cur = nxt; cA = nA; cB = nB; ++ui;
        if constexpr (ALIGN_EPI) { if (wr == 1) PG8_BAR; }
    }
    PG8_WAIT_V(0);
    if constexpr (!ALIGN_EPI) { if (wr == 0) PG8_BAR; }
    PG8_BAR;
    if constexpr (Epi::AFTER_DRAIN) { E.fused(acc, cur, wr, wc, fr, fq, lds, wid, lane); S.done(cur); }
#undef PG8_SA
#undef PG8_SB
#undef PG8_STAGE
#undef PG8_LDA
#undef PG8_LDB
#undef PG8_MMA
#undef PG8_WAIT_V
#undef PG8_WAIT_L
#undef PG8_BAR
#undef PG8_SCHED
}
}

#define GAS __attribute__((address_space(1)))
#define LAS __attribute__((address_space(3)))
typedef unsigned short bf16;
typedef unsigned v4u __attribute__((ext_vector_type(4)));
typedef unsigned v2u __attribute__((ext_vector_type(2)));
typedef float f32x4 __attribute__((ext_vector_type(4)));
typedef float f32x2 __attribute__((ext_vector_type(2)));
typedef short bf16x8 __attribute__((ext_vector_type(8)));
typedef short s16x4 __attribute__((ext_vector_type(4)));

constexpr int NWAVES = 8, NTHREADS = 512;
constexpr int BATCH = 8, SEQ = 2048, DM = 2048, M_TOK = BATCH * SEQ;
constexpr int NPRE = 6400, NGATE = 6144, NIN = NPRE + NGATE;
constexpr int C_AQ = 0, C_AK = 768, C_AV = 1024, C_AG = 1280, C_RS = 2048, C_RR = 2048, C_RK = 2816, C_RV = 3584, C_LORA = 4352, C_RG = 4608, C_XQ = 5376, C_XG = 5888;
constexpr int NMEM = 256, MEMROWS = BATCH * NMEM;
constexpr int RW = 768, NLORA = 3072;
constexpr float NORM_EPS = 1e-6f, GN_EPS = 64e-5f;
constexpr int LDS_BYTES = 147456;

constexpr size_t MiB = 1u << 20;
constexpr size_t WS_PRE = 0, WS_MERGED = 0, WS_GATES = 200 * MiB, WS_YCAT = 392 * MiB;
constexpr size_t WS_WCAT = 456 * MiB, WS_WOUT = 464 * MiB, WS_WXKV = 472 * MiB, WS_MKV = 476 * MiB, WS_MEMN = 480 * MiB, WS_YB = 480 * MiB;
constexpr size_t WS_ROPE = 504 * MiB, WS_LORAB = 505 * MiB, WS_END = 512 * MiB;
constexpr size_t DO_H = 0, DO_WIN = 64 * MiB, DO_EA = 0, DO_LIN = 96 * MiB, DO_YF = 104 * MiB;

struct Params { const float* in[26]; float* out; unsigned char* ws; int ph_lo, ph_hi; };

__device__ __forceinline__ float bf_lo(unsigned w) { return __builtin_bit_cast(float, w << 16); }
__device__ __forceinline__ float bf_hi(unsigned w) { return __builtin_bit_cast(float, w & 0xffff0000u); }
__device__ __forceinline__ float bf1(bf16 h) { return __builtin_bit_cast(float, (unsigned)h << 16); }
__device__ __forceinline__ unsigned f2bf(float f) { unsigned u = __builtin_bit_cast(unsigned, f); return (u + 0x7fffu + ((u >> 16) & 1u)) >> 16; }
__device__ __forceinline__ unsigned pk2(float lo, float hi) { return pg8::cvt_pk_bf16(lo, hi); }
__device__ __forceinline__ float sigmoidf_(float z) { return __builtin_amdgcn_rcpf(1.f + __expf(-z)); }
__device__ __forceinline__ float siluf_(float z) { return z * sigmoidf_(z); }
__device__ __forceinline__ void unpack8(v4u w, float (&x)[8]) { x[0] = bf_lo(w.x); x[1] = bf_hi(w.x); x[2] = bf_lo(w.y); x[3] = bf_hi(w.y); x[4] = bf_lo(w.z); x[5] = bf_hi(w.z); x[6] = bf_lo(w.w); x[7] = bf_hi(w.w); }
__device__ __forceinline__ void unpack4(v2u w, float (&x)[4]) { x[0] = bf_lo(w.x); x[1] = bf_hi(w.x); x[2] = bf_lo(w.y); x[3] = bf_hi(w.y); }
__device__ __forceinline__ float fma_s(float a, float b, float c) { float r; asm("v_fma_f32 %0, %1, %2, %3" : "=v"(r) : "v"(a), "v"(b), "v"(c)); return r; }
__device__ __forceinline__ float mul_s(float a, float b) { float r; asm("v_mul_f32_e32 %0, %1, %2" : "=v"(r) : "v"(a), "v"(b)); return r; }
__device__ __forceinline__ float add_s(float a, float b) { float r; asm("v_add_f32_e32 %0, %1, %2" : "=v"(r) : "v"(a), "v"(b)); return r; }
template <int CTRL> __device__ __forceinline__ float dpp_add(float v) { return v + __builtin_bit_cast(float, __builtin_amdgcn_update_dpp(0, __builtin_bit_cast(int, v), CTRL, 0xF, 0xF, true)); }
__device__ __forceinline__ float red8(float v) { v = dpp_add<0xB1>(v); v = dpp_add<0x4E>(v); v = dpp_add<0x141>(v); return v; }

using pg8::Unit;
struct EpiProj {
    static constexpr bool PERM = true, AFTER_DRAIN = false, KHOOK = false; static constexpr int HK0 = -1, HK1 = -1;
    bf16* pre; bf16* gates; const float* gate_b;
    __device__ __forceinline__ void operator()(const f32x4 (&acc)[2][2][4][2], const Unit& u, int wr, int wc, int fr, int fq) const {
        int row0 = u.pm * 256 + wr * 64 + fr;
        asm volatile("" : "+v"(row0));
        const bool isg = u.pn >= 25;
        const int pn = isg ? u.pn - 25 : u.pn;
        bf16* base = isg ? gates : pre; const int ldc = isg ? NGATE : NPRE;
        const int act = isg ? 2 : (((pn >= 5 && pn <= 7) || (pn >= 18 && pn <= 20) || pn >= 23) ? 1 : 0);
        const int col0 = pn * 256 + wc * 32 + 8 * fq;
#pragma unroll
        for (int ai = 0; ai < 2; ++ai)
#pragma unroll
            for (int m = 0; m < 4; ++m) { bf16* rowp = base + (size_t)(row0 + ai * 128 + m * 16) * ldc + col0;
                __builtin_amdgcn_sched_barrier(0);
#pragma unroll
                for (int bj = 0; bj < 2; ++bj) { f32x4 v0 = acc[ai][bj][m][0], v1 = acc[ai][bj][m][1];
                    if (isg) { v0 += *(const f32x4*)(gate_b + col0 + bj * 128); v1 += *(const f32x4*)(gate_b + col0 + bj * 128 + 4); }
                    if (act == 1) {
#pragma unroll
                        for (int i = 0; i < 4; ++i) { v0[i] = siluf_(v0[i]); v1[i] = siluf_(v1[i]); }
                    } else if (act == 2) {
#pragma unroll
                        for (int i = 0; i < 4; ++i) { v0[i] = sigmoidf_(v0[i]); v1[i] = sigmoidf_(v1[i]); }
                    }
                    v4u w; w.x = pk2(v0[0], v0[1]); w.y = pk2(v0[2], v0[3]); w.z = pk2(v1[0], v1[1]); w.w = pk2(v1[2], v1[3]);
                    *(v4u*)(rowp + bj * 128) = w; } }
    }
};
struct EpiPlain {
    static constexpr bool PERM = true, AFTER_DRAIN = false, KHOOK = false; static constexpr int HK0 = -1, HK1 = -1;
    bf16* O; int ldc;
    __device__ __forceinline__ void operator()(const f32x4 (&acc)[2][2][4][2], const Unit& u, int wr, int wc, int fr, int fq) const {
        int row0 = u.pm * 256 + wr * 64 + fr, col0 = u.pn * 256 + wc * 32 + 8 * fq;
        asm volatile("" : "+v"(row0), "+v"(col0));
#pragma unroll
        for (int ai = 0; ai < 2; ++ai)
#pragma unroll
            for (int m = 0; m < 4; ++m) { bf16* rowp = O + (size_t)(row0 + ai * 128 + m * 16) * ldc + col0;
#pragma unroll
                for (int bj = 0; bj < 2; ++bj) { const f32x4 v0 = acc[ai][bj][m][0], v1 = acc[ai][bj][m][1];
                    v4u w; w.x = pk2(v0[0], v0[1]); w.y = pk2(v0[2], v0[3]); w.z = pk2(v1[0], v1[1]); w.w = pk2(v1[2], v1[3]);
                    *(v4u*)(rowp + bj * 128) = w; } }
    }
};
struct EpiLora {
    static constexpr bool PERM = true, AFTER_DRAIN = false, KHOOK = false; static constexpr int HK0 = -1, HK1 = -1;
    bf16* O; const float* w0; const float* a0;
    __device__ __forceinline__ void operator()(const f32x4 (&acc)[2][2][4][2], const Unit& u, int wr, int wc, int fr, int fq) const {
        int row0 = u.pm * 256 + wr * 64 + fr, col0 = u.pn * 256 + wc * 32 + 8 * fq;
        asm volatile("" : "+v"(row0), "+v"(col0));
        const bool isw = u.pn < 6; const float* bias = isw ? (w0 + col0) : (a0 + col0 - 1536); const float sc = isw ? 0.6065306597126334f : 1.f;
#pragma unroll
        for (int ai = 0; ai < 2; ++ai)
#pragma unroll
            for (int m = 0; m < 4; ++m) { bf16* rowp = O + (size_t)(row0 + ai * 128 + m * 16) * NLORA + col0;
                __builtin_amdgcn_sched_barrier(0);
#pragma unroll
                for (int bj = 0; bj < 2; ++bj) { f32x4 v0 = acc[ai][bj][m][0] + *(const f32x4*)(bias + bj * 128), v1 = acc[ai][bj][m][1] + *(const f32x4*)(bias + bj * 128 + 4);
#pragma unroll
                    for (int i = 0; i < 4; ++i) { v0[i] = sc * sigmoidf_(v0[i]); v1[i] = sc * sigmoidf_(v1[i]); }
                    v4u w; w.x = pk2(v0[0], v0[1]); w.y = pk2(v0[2], v0[3]); w.z = pk2(v1[0], v1[1]); w.w = pk2(v1[2], v1[3]);
                    *(v4u*)(rowp + bj * 128) = w; } }
    }
};
struct EpiMerged {
    static constexpr bool PERM = true, AFTER_DRAIN = false, KHOOK = true; static constexpr int HK0 = 12, HK1 = 24;
    bf16* O; const bf16* gates;
    __device__ __forceinline__ void khook(f32x4 (&acc)[2][2][4][2], const Unit& u, int t, int wr, int wc, int fr, int fq) const {
        int row0 = u.pm * 256 + wr * 64 + fr, col0 = u.pn * 256 + wc * 32 + 8 * fq;
        asm volatile("" : "+v"(row0), "+v"(col0));
        const int bo = (t == HK0) ? 0 : DM;
#pragma unroll
        for (int ai = 0; ai < 2; ++ai)
#pragma unroll
            for (int m = 0; m < 4; ++m) { const bf16* gp = gates + (size_t)(row0 + ai * 128 + m * 16) * NGATE + bo + col0;
                __builtin_amdgcn_sched_barrier(0);
#pragma unroll
                for (int bj = 0; bj < 2; ++bj) { const v4u a = *(const v4u*)(gp + bj * 128), b = *(const v4u*)(gp + DM + bj * 128);
                    float x[8], y[8]; unpack8(a, x); unpack8(b, y);
#pragma unroll
                    for (int i = 0; i < 4; ++i) { acc[ai][bj][m][0][i] *= x[i] * __builtin_amdgcn_rcpf(y[i]); acc[ai][bj][m][1][i] *= x[4 + i] * __builtin_amdgcn_rcpf(y[4 + i]); } } }
    }
    __device__ __forceinline__ void operator()(const f32x4 (&acc)[2][2][4][2], const Unit& u, int wr, int wc, int fr, int fq) const {
        int row0 = u.pm * 256 + wr * 64 + fr, col0 = u.pn * 256 + wc * 32 + 8 * fq;
        asm volatile("" : "+v"(row0), "+v"(col0));
#pragma unroll
        for (int ai = 0; ai < 2; ++ai)
#pragma unroll
            for (int m = 0; m < 4; ++m) { const size_t r = (size_t)(row0 + ai * 128 + m * 16);
                __builtin_amdgcn_sched_barrier(0);
#pragma unroll
                for (int bj = 0; bj < 2; ++bj) { const v4u g = *(const v4u*)(gates + r * NGATE + 2 * DM + col0 + bj * 128); float x[8]; unpack8(g, x);
                    const f32x4 v0 = acc[ai][bj][m][0], v1 = acc[ai][bj][m][1];
                    v4u w; w.x = pk2(v0[0] * x[0], v0[1] * x[1]); w.y = pk2(v0[2] * x[2], v0[3] * x[3]); w.z = pk2(v1[0] * x[4], v1[1] * x[5]); w.w = pk2(v1[2] * x[6], v1[3] * x[7]);
                    *(v4u*)(O + r * DM + col0 + bj * 128) = w; } }
    }
};
struct EpiOut {
    static constexpr bool PERM = true, AFTER_DRAIN = false, KHOOK = false; static constexpr int HK0 = -1, HK1 = -1;
    float* O; const float* X;
    __device__ __forceinline__ void operator()(const f32x4 (&acc)[2][2][4][2], const Unit& u, int wr, int wc, int fr, int fq) const {
        int row0 = u.pm * 256 + wr * 64 + fr, col0 = u.pn * 256 + wc * 32 + 8 * fq;
        asm volatile("" : "+v"(row0), "+v"(col0));
#pragma unroll
        for (int ai = 0; ai < 2; ++ai)
#pragma unroll
            for (int m = 0; m < 4; ++m) { const size_t o = (size_t)(row0 + ai * 128 + m * 16) * DM + col0;
                __builtin_amdgcn_sched_barrier(0);
#pragma unroll
                for (int bj = 0; bj < 2; ++bj) {
                    const f32x4 x0 = *(const f32x4*)(X + o + bj * 128), x1 = *(const f32x4*)(X + o + bj * 128 + 4);
                    *(f32x4*)(O + o + bj * 128) = x0 + acc[ai][bj][m][0]; *(f32x4*)(O + o + bj * 128 + 4) = x1 + acc[ai][bj][m][1]; } }
    }
};

__device__ __forceinline__ float wave_sum(float v) {
#pragma unroll
    for (int o = 1; o < 64; o <<= 1) v += __shfl_xor(v, o);
    return v;
}
__device__ __forceinline__ void transpose_item(const float* W, int N, bf16* WT, int ldt, int koff, LAS float* scr, int item, int lane) {
    const int nblk = N / 32, kb = item / nblk, nb = item % nblk, k0 = 64 * kb, n0 = 32 * nb;
    float tv[32];
#pragma unroll
    for (int i = 0; i < 32; ++i) { const int kk = 2 * i + (lane >> 5); tv[i] = W[(size_t)(k0 + kk) * N + n0 + (lane & 31)]; }
#pragma unroll
    for (int i = 0; i < 32; ++i) { const int kk = 2 * i + (lane >> 5); scr[kk * 33 + (lane & 31)] = tv[i]; }
    asm volatile("s_waitcnt lgkmcnt(0)" ::: "memory");
    const int c = lane & 7;
#pragma unroll
    for (int j = 0; j < 4; ++j) { const int n = (lane >> 3) + 8 * j; const LAS float* s = scr + (8 * c) * 33 + n;
        v4u o; o.x = pk2(s[0 * 33], s[1 * 33]); o.y = pk2(s[2 * 33], s[3 * 33]); o.z = pk2(s[4 * 33], s[5 * 33]); o.w = pk2(s[6 * 33], s[7 * 33]);
        *(v4u*)(WT + (size_t)(n0 + n) * ldt + koff + k0 + 8 * c) = o; }
    asm volatile("s_waitcnt lgkmcnt(0)" ::: "memory");
}
__device__ __forceinline__ void rms_row_to_bf16(const float* xrow, const float* g, bf16* orow, int lane) {
    const f32x4* xr = (const f32x4*)xrow + lane; const f32x4* gr = (const f32x4*)g + lane;
    f32x4 v[8]; float s = 0.f;
#pragma unroll
    for (int j = 0; j < 8; ++j) { v[j] = xr[64 * j]; s += (v[j].x * v[j].x + v[j].y * v[j].y) + (v[j].z * v[j].z + v[j].w * v[j].w); }
    const float rstd = 1.f / sqrtf(wave_sum(s) * (1.f / DM) + NORM_EPS);
    v2u* o8 = (v2u*)orow + lane;
#pragma unroll
    for (int j = 0; j < 8; ++j) { const f32x4 gg = gr[64 * j]; v2u o; o.x = pk2(v[j].x * rstd * gg.x, v[j].y * rstd * gg.y); o.y = pk2(v[j].z * rstd * gg.z, v[j].w * rstd * gg.w); o8[64 * j] = o; }
}
__device__ __forceinline__ void p0_prologue(const Params& P, LAS unsigned char* lds, float* dout_scratch) {
    const int tid = pg8::mk_tid(lds), lane = tid & 63, wave = tid >> 6, G = gridDim.x;
    LAS float* scr = (LAS float*)(lds + wave * 16384);
    const int gw = blockIdx.x * NWAVES + wave, NGW = G * NWAVES;
    unsigned char* ws = P.ws; unsigned char* dob = (unsigned char*)P.out;
    bf16* WIN_T = (bf16*)(dob + DO_WIN); bf16* WCAT_T = (bf16*)(ws + WS_WCAT); bf16* WOUT_T = (bf16*)(ws + WS_WOUT); bf16* WXKV_T = (bf16*)(ws + WS_WXKV);
    constexpr int I_IN = 32 * (NIN / 32), I_A = 12 * 64, I_R = 12 * 64, I_X = 8 * 64, I_O = 32 * 64, I_KV = 32 * 32;
    constexpr int NITEMS = I_IN + I_A + I_R + I_X + I_O + I_KV;
    for (int it = gw; it < NITEMS; it += NGW) {
        int r = it;
        if (r < I_IN) { transpose_item(P.in[4], NIN, WIN_T, DM, 0, scr, r, lane); continue; } r -= I_IN;
        if (r < I_A) { transpose_item(P.in[9], DM, WCAT_T, DM, 0, scr, r, lane); continue; } r -= I_A;
        if (r < I_R) { transpose_item(P.in[20], DM, WCAT_T, DM, 768, scr, r, lane); continue; } r -= I_R;
        if (r < I_X) { transpose_item(P.in[24], DM, WCAT_T, DM, 1536, scr, r, lane); continue; } r -= I_X;
        if (r < I_O) { transpose_item(P.in[25], DM, WOUT_T, DM, 0, scr, r, lane); continue; } r -= I_O;
        transpose_item(P.in[21], 1024, WXKV_T, DM, 0, scr, r, lane);
    }
    bf16* H = (bf16*)(dob + DO_H); bf16* MEMN = (bf16*)(ws + WS_MEMN);
    for (int m = gw; m < M_TOK + MEMROWS; m += NGW) {
        if (m < M_TOK) rms_row_to_bf16(P.in[0] + (size_t)m * DM, P.in[2], H + (size_t)m * DM, lane);
        else rms_row_to_bf16(P.in[1] + (size_t)(m - M_TOK) * DM, P.in[3], MEMN + (size_t)(m - M_TOK) * DM, lane);
    }
    bf16* LB = (bf16*)(ws + WS_LORAB);
    const int gt = blockIdx.x * NTHREADS + tid, NGT = G * NTHREADS;
    for (int idx = gt; idx < NLORA * 256; idx += NGT) {
        const int n = idx >> 8, k = idx & 255, d = n / RW, ch = n % RW, kb = k >> 6, kk = k & 63;
        float v = 0.f;
        if (kb == d) v = (d < 2) ? P.in[15][(size_t)(d * 64 + kk) * RW + ch] : P.in[17][(size_t)((d - 2) * 64 + kk) * RW + ch];
        LB[idx] = (bf16)f2bf(v);
    }
    float* RC = (float*)(ws + WS_ROPE); float* RS = RC + SEQ * 32;
    for (int idx = gt; idx < SEQ * 32; idx += NGT) {
        const int pos = idx >> 5, i = idx & 31;
        const float inv = __builtin_exp2f(-(float)i * (13.287712379549449f / 32.f));
        const float ang = (float)pos * inv;
        double rv = (double)ang * 0.15915494309189535; rv -= __builtin_floor(rv);
        const float r = (float)rv;
        RC[idx] = __builtin_amdgcn_cosf(r); RS[idx] = __builtin_amdgcn_sinf(r);
    }
}

__device__ __forceinline__ void p2_lora_in(const Params& P, LAS unsigned char* lds) {
    const bf16* PRE = (const bf16*)(P.ws + WS_PRE); bf16* LIN = (bf16*)((unsigned char*)P.out + DO_LIN); const float* mu = P.in[10];
    const int gt = blockIdx.x * NTHREADS + pg8::mk_tid(lds), NGT = gridDim.x * NTHREADS;
    for (int idx = gt; idx < M_TOK * 32; idx += NGT) {
        const int m = idx >> 5, j = (idx & 31) * 8, t = m & (SEQ - 1);
        const bf16* p = PRE + (size_t)m * NPRE + C_LORA + j;
        const v4u z4 = (v4u){0u, 0u, 0u, 0u};
        const v4u c = *(const v4u*)p, pv = (t > 0) ? *(const v4u*)(p - NPRE) : z4, nx = (t < SEQ - 1) ? *(const v4u*)(p + NPRE) : z4;
        const f32x4 m0 = *(const f32x4*)(mu + 2304 + j), m1 = *(const f32x4*)(mu + 2304 + j + 4);
        float xc[8], xp[8], xn[8], s[8]; unpack8(c, xc); unpack8(pv, xp); unpack8(nx, xn);
#pragma unroll
        for (int i = 0; i < 8; ++i) { const float mm = (i < 4) ? m0[i & 3] : m1[i & 3]; s[i] = xc[i] + mm * (0.5f * (xp[i] + xn[i]) - xc[i]);
            if (j < 128) s[i] = 1.f - 2.f * __builtin_amdgcn_rcpf(__expf(2.f * s[i]) + 1.f); }
        v4u o; o.x = pk2(s[0], s[1]); o.y = pk2(s[2], s[3]); o.z = pk2(s[4], s[5]); o.w = pk2(s[6], s[7]);
        *(v4u*)(LIN + (size_t)m * 256 + j) = o;
    }
}

constexpr int SC_CH = 32, SC_REC = 1536, SC_BUF = SC_CH * SC_REC, SC_SCAL = 2 * SC_BUF;
template <int MODE> __device__ __forceinline__ void scan_block(const Params& P, int sid, LAS unsigned char* lds) {
    const int tid = pg8::mk_tid(lds), lane = tid & 63, wave = __builtin_amdgcn_readfirstlane(tid >> 6);
    const int b = sid / 24, rem = sid % 24, h = rem >> 1, dir = rem & 1;
    const bf16* PRE = (const bf16*)(P.ws + WS_PRE); const bf16* EA = (const bf16*)((unsigned char*)P.out + DO_EA);
    bf16* YO = dir ? (bf16*)(P.ws + WS_YB) : (bf16*)((unsigned char*)P.out + DO_YF);
    constexpr int NCH = SEQ / SC_CH;
#define SC_BAR() do { asm volatile("s_waitcnt lgkmcnt(0)" ::: "memory"); __builtin_amdgcn_s_barrier(); asm volatile("" ::: "memory"); } while (0)
    if (wave >= 4) {
        const int pt = tid - 256, sl = pt >> 3, e = pt & 7, ch0 = h * 64 + 8 * e;
        float mur[8], muk[8], muv[8], kkc[8], kac[8];
#pragma unroll
        for (int i = 0; i < 8; ++i) { mur[i] = P.in[10][ch0 + i]; muk[i] = P.in[10][768 + ch0 + i]; muv[i] = P.in[10][1536 + ch0 + i]; kkc[i] = P.in[11][ch0 + i]; kac[i] = P.in[12][ch0 + i]; }
        v4u rc, kc, vc, rp, kp, vp, rn, kn, vn, e8, a8;
        const v4u z4 = (v4u){0u, 0u, 0u, 0u};
#define SC_PLOAD(c_) do { const int step_ = (c_) * SC_CH + sl, t_ = dir ? (SEQ - 1 - step_) : step_; const size_t m_ = (size_t)b * SEQ + t_; \
            const bf16* rowp_ = PRE + m_ * NPRE + C_RS + ch0; \
            rc = *(const v4u*)(rowp_); kc = *(const v4u*)(rowp_ + 768); vc = *(const v4u*)(rowp_ + 1536); \
            rp = (t_ > 0) ? *(const v4u*)(rowp_ - NPRE) : z4; kp = (t_ > 0) ? *(const v4u*)(rowp_ - NPRE + 768) : z4; vp = (t_ > 0) ? *(const v4u*)(rowp_ - NPRE + 1536) : z4; \
            rn = (t_ < SEQ - 1) ? *(const v4u*)(rowp_ + NPRE) : z4; kn = (t_ < SEQ - 1) ? *(const v4u*)(rowp_ + NPRE + 768) : z4; vn = (t_ < SEQ - 1) ? *(const v4u*)(rowp_ + NPRE + 1536) : z4; \
            const bf16* eap_ = EA + m_ * NLORA + dir * RW + ch0; e8 = *(const v4u*)(eap_); a8 = *(const v4u*)(eap_ + 1536); } while (0)
#define SC_PWRITE(c_) do { LAS unsigned char* buf_ = lds + ((c_) & 1) * SC_BUF; LAS float* scal_ = (LAS float*)(lds + SC_SCAL) + ((c_) & 1) * (SC_CH * 2); \
            float r[8], k[8], v[8], x0[8], x1[8], x2[8]; \
            unpack8(rc, x0); unpack8(rp, x1); unpack8(rn, x2); \
            _Pragma("unroll") for (int i = 0; i < 8; ++i) r[i] = x0[i] + mur[i] * (0.5f * (x1[i] + x2[i]) - x0[i]); \
            unpack8(kc, x0); unpack8(kp, x1); unpack8(kn, x2); \
            _Pragma("unroll") for (int i = 0; i < 8; ++i) k[i] = x0[i] + muk[i] * (0.5f * (x1[i] + x2[i]) - x0[i]); \
            unpack8(vc, x0); unpack8(vp, x1); unpack8(vn, x2); \
            _Pragma("unroll") for (int i = 0; i < 8; ++i) v[i] = x0[i] + muv[i] * (0.5f * (x1[i] + x2[i]) - x0[i]); \
            float ee[8], aa[8]; unpack8(e8, ee); unpack8(a8, aa); \
            float kk[8], ss = 0.f; \
            _Pragma("unroll") for (int i = 0; i < 8; ++i) { kk[i] = k[i] * kkc[i]; ss += kk[i] * kk[i]; } \
            ss = red8(ss); \
            const float inv = 1.f / fmaxf(sqrtf(ss), 1e-12f); \
            float nkk[8], dd[8], dr[8], bb[8], kd[8], sbr = 0.f, skr = 0.f; \
            _Pragma("unroll") for (int i = 0; i < 8; ++i) { \
                const float kki = kk[i] * inv; nkk[i] = -kki; dd[i] = __expf(-ee[i]); dr[i] = dd[i] * r[i]; \
                bb[i] = kki * aa[i]; kd[i] = k[i] * (1.f + (aa[i] - 1.f) * kac[i]); sbr += bb[i] * r[i]; skr += kd[i] * r[i]; } \
            sbr = red8(sbr); skr = red8(skr); \
            LAS float* rec = (LAS float*)(buf_ + sl * SC_REC) + 8 * e; \
            *(LAS f32x4*)(rec) = (f32x4){nkk[0], nkk[1], nkk[2], nkk[3]}; *(LAS f32x4*)(rec + 4) = (f32x4){nkk[4], nkk[5], nkk[6], nkk[7]}; \
            *(LAS f32x4*)(rec + 64) = (f32x4){dr[0], dr[1], dr[2], dr[3]}; *(LAS f32x4*)(rec + 68) = (f32x4){dr[4], dr[5], dr[6], dr[7]}; \
            *(LAS f32x4*)(rec + 128) = (f32x4){dd[0], dd[1], dd[2], dd[3]}; *(LAS f32x4*)(rec + 132) = (f32x4){dd[4], dd[5], dd[6], dd[7]}; \
            *(LAS f32x4*)(rec + 192) = (f32x4){bb[0], bb[1], bb[2], bb[3]}; *(LAS f32x4*)(rec + 196) = (f32x4){bb[4], bb[5], bb[6], bb[7]}; \
            *(LAS f32x4*)(rec + 256) = (f32x4){kd[0], kd[1], kd[2], kd[3]}; *(LAS f32x4*)(rec + 260) = (f32x4){kd[4], kd[5], kd[6], kd[7]}; \
            *(LAS f32x4*)(rec + 320) = (f32x4){v[0], v[1], v[2], v[3]}; *(LAS f32x4*)(rec + 324) = (f32x4){v[4], v[5], v[6], v[7]}; \
            if (e == 0) *(LAS f32x2*)(scal_ + 2 * sl) = (f32x2){sbr, skr}; } while (0)
        if (!(MODE & 2)) { SC_PLOAD(0); SC_PWRITE(0); SC_PLOAD(1); }
        SC_BAR();
        for (int c = 0; c < NCH; ++c) {
            if (!(MODE & 2)) { if (c + 1 < NCH) SC_PWRITE(c + 1);
            if (c + 2 < NCH) SC_PLOAD(c + 2); }
            SC_BAR();
        }
#undef SC_PLOAD
#undef SC_PWRITE
    } else {
        const int rp = (wave * 64 + lane) >> 3, cgp = lane & 7;
        f32x2 s0[4], s1[4];
#pragma unroll
        for (int i = 0; i < 4; ++i) { s0[i] = (f32x2){0.f, 0.f}; s1[i] = (f32x2){0.f, 0.f}; }
        bf16* yrow = YO + (size_t)b * SEQ * RW + h * 64 + 2 * rp;
        SC_BAR();
#define SC_LOAD(N0, N1, Q0, Q1, D0, D1, B0, B1, K0, K1, VV, SS, sl_) do { const LAS float* rec_ = (const LAS float*)(buf + (sl_) * SC_REC) + 8 * cgp; \
            N0 = *(const LAS f32x4*)(rec_); N1 = *(const LAS f32x4*)(rec_ + 4); Q0 = *(const LAS f32x4*)(rec_ + 64); Q1 = *(const LAS f32x4*)(rec_ + 68); \
            D0 = *(const LAS f32x4*)(rec_ + 128); D1 = *(const LAS f32x4*)(rec_ + 132); B0 = *(const LAS f32x4*)(rec_ + 192); B1 = *(const LAS f32x4*)(rec_ + 196); \
            K0 = *(const LAS f32x4*)(rec_ + 256); K1 = *(const LAS f32x4*)(rec_ + 260); \
            VV = *(const LAS f32x2*)((const LAS float*)(buf + (sl_) * SC_REC) + 320 + 2 * rp); SS = *(const LAS f32x2*)(scal + 2 * (sl_)); } while (0)
        for (int c = 0; c < NCH; ++c) {
            const LAS unsigned char* buf = lds + (c & 1) * SC_BUF; const LAS float* scal = (const LAS float*)(lds + SC_SCAL) + (c & 1) * (SC_CH * 2);
            f32x4 n0, n1, q0, q1, d0, d1, b0, b1, k0, k1; f32x2 vv, sc;
            SC_LOAD(n0, n1, q0, q1, d0, d1, b0, b1, k0, k1, vv, sc, 0);
#pragma unroll 2
            for (int sl = 0; sl < SC_CH; ++sl) {
                f32x4 xn0, xn1, xq0, xq1, xd0, xd1, xb0, xb1, xk0, xk1; f32x2 xvv, xsc;
                const int sn = (sl + 1 < SC_CH) ? sl + 1 : sl;
                const f32x2 nk[4] = {(f32x2){n0.x, n0.y}, (f32x2){n0.z, n0.w}, (f32x2){n1.x, n1.y}, (f32x2){n1.z, n1.w}};
                const f32x2 qq[4] = {(f32x2){q0.x, q0.y}, (f32x2){q0.z, q0.w}, (f32x2){q1.x, q1.y}, (f32x2){q1.z, q1.w}};
                const f32x2 dv[4] = {(f32x2){d0.x, d0.y}, (f32x2){d0.z, d0.w}, (f32x2){d1.x, d1.y}, (f32x2){d1.z, d1.w}};
                const f32x2 bv[4] = {(f32x2){b0.x, b0.y}, (f32x2){b0.z, b0.w}, (f32x2){b1.x, b1.y}, (f32x2){b1.z, b1.w}};
                const f32x2 kv[4] = {(f32x2){k0.x, k0.y}, (f32x2){k0.z, k0.w}, (f32x2){k1.x, k1.y}, (f32x2){k1.z, k1.w}};
                f32x2 a0 = s0[0] * nk[0], a1 = s1[0] * nk[0], y0 = s0[0] * qq[0], y1 = s1[0] * qq[0];
#pragma unroll
                for (int i = 1; i < 4; ++i) { a0 = s0[i] * nk[i] + a0; a1 = s1[i] * nk[i] + a1; y0 = s0[i] * qq[i] + y0; y1 = s1[i] * qq[i] + y1; }
                float sa0 = a0.x + a0.y, sa1 = a1.x + a1.y, yp0 = y0.x + y0.y, yp1 = y1.x + y1.y;
                SC_LOAD(xn0, xn1, xq0, xq1, xd0, xd1, xb0, xb1, xk0, xk1, xvv, xsc, sn);
                sa0 = red8(sa0); sa1 = red8(sa1); yp0 = red8(yp0); yp1 = red8(yp1);
                const float yo0 = yp0 + sa0 * sc.x + vv.x * sc.y, yo1 = yp1 + sa1 * sc.x + vv.y * sc.y;
                const f32x2 sa0v = (f32x2){sa0, sa0}, sa1v = (f32x2){sa1, sa1}, v0v = (f32x2){vv.x, vv.x}, v1v = (f32x2){vv.y, vv.y};
#pragma unroll
                for (int i = 0; i < 4; ++i) {
                    f32x2 t0 = v0v * kv[i]; t0 = sa0v * bv[i] + t0; s0[i] = s0[i] * dv[i] + t0;
                    f32x2 t1 = v1v * kv[i]; t1 = sa1v * bv[i] + t1; s1[i] = s1[i] * dv[i] + t1;
                }
                const int step = c * SC_CH + sl, t = dir ? (SEQ - 1 - step) : step;
                const unsigned yw = pk2(yo0, yo1);
                if (!(MODE & 1)) { if (cgp == 0) *(unsigned*)(yrow + (size_t)t * RW) = yw; } else { asm volatile("" :: "v"(yw)); }
                n0 = xn0; n1 = xn1; q0 = xq0; q1 = xq1; d0 = xd0; d1 = xd1; b0 = xb0; b1 = xb1; k0 = xk0; k1 = xk1; vv = xvv; sc = xsc;
            }
            SC_BAR();
        }
#undef SC_LOAD
    }
#undef SC_BAR
    __syncthreads();
}

__device__ __forceinline__ bf16x8 pack8(const float (&x)[8]) {
    v4u w; w.x = pk2(x[0], x[1]); w.y = pk2(x[2], x[3]); w.z = pk2(x[4], x[5]); w.w = pk2(x[6], x[7]); return __builtin_bit_cast(bf16x8, w);
}
#define MFMA16(a, b, c) __builtin_amdgcn_mfma_f32_16x16x32_bf16((a), (b), (c), 0, 0, 0)
constexpr int KA_P = 72, VA_P = 392;
__device__ __forceinline__ void attnA_item(const Params& P, int item, LAS unsigned char* lds) {
    const int tid = pg8::mk_tid(lds), lane = tid & 63, wave = __builtin_amdgcn_readfirstlane(tid >> 6), l15 = lane & 15, q4 = lane >> 4;
    const int b = item >> 6, n = (item >> 2) & 15, hk = item & 3;
    const bf16* PRE = (const bf16*)(P.ws + WS_PRE); bf16* YC = (bf16*)(P.ws + WS_YCAT);
    const float* RC = (const float*)(P.ws + WS_ROPE); const float* RS = RC + SEQ * 32;
    LAS bf16* Ks = (LAS bf16*)lds; LAS bf16* Vt = Ks + 384 * KA_P;
    {
        v2u klo[6], khi[6]; f32x4 kcs[6], ksn[6]; v4u vw[6];
#pragma unroll
        for (int u = 0; u < 6; ++u) {
            const int it = tid + u * NTHREADS, j = it >> 3, c = it & 7, kp = (n - 1) * 128 + j;
            const bool ok = (kp >= 0 && kp < SEQ); const int kpc = ok ? kp : 0;
            const bf16* src = PRE + ((size_t)b * SEQ + kpc) * NPRE + C_AK + hk * 64;
            klo[u] = *(const v2u*)(src + 4 * c); khi[u] = *(const v2u*)(src + 32 + 4 * c);
            kcs[u] = *(const f32x4*)(RC + kpc * 32 + 4 * c); ksn[u] = *(const f32x4*)(RS + kpc * 32 + 4 * c);
            vw[u] = *(const v4u*)(PRE + ((size_t)b * SEQ + kpc) * NPRE + C_AV + hk * 64 + 8 * c);
        }
        const f32x4 g1 = *(const f32x4*)(P.in[7] + 4 * (tid & 7)), g2 = *(const f32x4*)(P.in[7] + 32 + 4 * (tid & 7));
#pragma unroll
        for (int u = 0; u < 6; ++u) {
            const int it = tid + u * NTHREADS, j = it >> 3, c = it & 7, kp = (n - 1) * 128 + j;
            const bool ok = (kp >= 0 && kp < SEQ);
            float x1[4], x2[4]; unpack4(klo[u], x1); unpack4(khi[u], x2);
            float ss = 0.f;
#pragma unroll
            for (int i = 0; i < 4; ++i) ss += x1[i] * x1[i] + x2[i] * x2[i];
            ss = red8(ss);
            const float rstd = ok ? 1.f / sqrtf(ss * (1.f / 64.f) + NORM_EPS) : 0.f;
            float r1[4], r2[4];
#pragma unroll
            for (int i = 0; i < 4; ++i) { const float y1 = x1[i] * rstd * g1[i], y2 = x2[i] * rstd * g2[i]; r1[i] = y1 * kcs[u][i] - y2 * ksn[u][i]; r2[i] = y2 * kcs[u][i] + y1 * ksn[u][i]; }
            v2u o0, o1; o0.x = pk2(r1[0], r1[1]); o0.y = pk2(r1[2], r1[3]); o1.x = pk2(r2[0], r2[1]); o1.y = pk2(r2[2], r2[3]);
            *(LAS v2u*)(Ks + j * KA_P + 4 * c) = o0; *(LAS v2u*)(Ks + j * KA_P + 32 + 4 * c) = o1;
            const v4u w = ok ? vw[u] : (v4u){0u, 0u, 0u, 0u};
            LAS bf16* d = Vt + (8 * c) * VA_P + j;
            d[0] = (bf16)(w.x & 0xffffu); d[VA_P] = (bf16)(w.x >> 16); d[2 * VA_P] = (bf16)(w.y & 0xffffu); d[3 * VA_P] = (bf16)(w.y >> 16);
            d[4 * VA_P] = (bf16)(w.z & 0xffffu); d[5 * VA_P] = (bf16)(w.z >> 16); d[6 * VA_P] = (bf16)(w.w & 0xffffu); d[7 * VA_P] = (bf16)(w.w >> 16);
        }
    }
    v4u qlo, qhi;
    {
        const int R0 = wave * 48, g = R0 >> 7, pos = (R0 & 127) + l15, qp = n * 128 + pos, hq = hk * 3 + g;
        const bf16* src = PRE + ((size_t)b * SEQ + qp) * NPRE + C_AQ + hq * 64;
        qlo = *(const v4u*)(src + 8 * q4); qhi = *(const v4u*)(src + 32 + 8 * q4);
    }
    __syncthreads();
#pragma unroll 1
    for (int mt = 0; mt < 3; ++mt) {
        const int R0 = wave * 48 + mt * 16, g = R0 >> 7, pos = (R0 & 127) + l15, qp = n * 128 + pos, hq = hk * 3 + g;
        const size_t m = (size_t)b * SEQ + qp;
        v2u gat[4];
#pragma unroll
        for (int dt = 0; dt < 4; ++dt) gat[dt] = *(const v2u*)(PRE + m * NPRE + C_AG + hq * 64 + dt * 16 + 4 * q4);
        const v4u cqlo = qlo, cqhi = qhi;
        {
            const int mn = (mt < 2) ? mt + 1 : 2, R1 = wave * 48 + mn * 16, g1_ = R1 >> 7, pos1 = (R1 & 127) + l15, qp1 = n * 128 + pos1, hq1 = hk * 3 + g1_;
            const bf16* src = PRE + ((size_t)b * SEQ + qp1) * NPRE + C_AQ + hq1 * 64;
            qlo = *(const v4u*)(src + 8 * q4); qhi = *(const v4u*)(src + 32 + 8 * q4);
        }
        bf16x8 qf0, qf1;
        {
            float x1[8], x2[8]; unpack8(cqlo, x1); unpack8(cqhi, x2);
            float ss = 0.f;
#pragma unroll
            for (int i = 0; i < 8; ++i) ss += x1[i] * x1[i] + x2[i] * x2[i];
            ss += __shfl_xor(ss, 16); ss += __shfl_xor(ss, 32);
            const float rstd = (0.125f * 1.4426950408889634f) / sqrtf(ss * (1.f / 64.f) + NORM_EPS);
            float r1[8], r2[8];
            const f32x4 ga = *(const f32x4*)(P.in[6] + 8 * q4), gb = *(const f32x4*)(P.in[6] + 8 * q4 + 4), gc = *(const f32x4*)(P.in[6] + 32 + 8 * q4), gd = *(const f32x4*)(P.in[6] + 36 + 8 * q4);
            const f32x4 ca = *(const f32x4*)(RC + qp * 32 + 8 * q4), cb = *(const f32x4*)(RC + qp * 32 + 8 * q4 + 4), sa_ = *(const f32x4*)(RS + qp * 32 + 8 * q4), sb_ = *(const f32x4*)(RS + qp * 32 + 8 * q4 + 4);
#pragma unroll
            for (int i = 0; i < 8; ++i) {
                const float g1 = (i < 4) ? ga[i & 3] : gb[i & 3], g2 = (i < 4) ? gc[i & 3] : gd[i & 3], cs = (i < 4) ? ca[i & 3] : cb[i & 3], sn = (i < 4) ? sa_[i & 3] : sb_[i & 3];
                const float y1 = x1[i] * rstd * g1, y2 = x2[i] * rstd * g2; r1[i] = y1 * cs - y2 * sn; r2[i] = y2 * cs + y1 * sn;
            }
            qf0 = pack8(r1); qf1 = pack8(r2);
        }
        const int kt0 = (R0 & 127) >> 4;
        const int seq_lo = (n == 0) ? 8 : 0, seq_hi = (n == 15) ? 15 : 23;
        f32x4 acc[18];
#pragma unroll
        for (int u = 0; u < 17; ++u) {
            const LAS bf16* kr = Ks + ((kt0 + u) * 16 + l15) * KA_P + 8 * q4;
            const bf16x8 k0 = *(const LAS bf16x8*)(kr), k1 = *(const LAS bf16x8*)(kr + 32);
            f32x4 a = (f32x4){0.f, 0.f, 0.f, 0.f};
            a = MFMA16(k0, qf0, a); a = MFMA16(k1, qf1, a); acc[u] = a;
        }
        acc[17] = (f32x4){-1e30f, -1e30f, -1e30f, -1e30f};
        const float sink = P.in[8][hq] * 1.4426950408889634f;
        float mx = sink;
#pragma unroll
        for (int u = 0; u < 17; ++u) {
            const bool tv = (kt0 + u >= seq_lo) && (kt0 + u <= seq_hi);
#pragma unroll
            for (int i = 0; i < 4; ++i) {
                bool valid = tv;
                if (u == 0) valid = valid && (4 * q4 + i >= l15);
                if (u == 16) valid = valid && (4 * q4 + i <= l15);
                const float sv = valid ? acc[u][i] : -1e30f; acc[u][i] = sv; mx = fmaxf(mx, sv);
            }
        }
        mx = fmaxf(mx, __shfl_xor(mx, 16)); mx = fmaxf(mx, __shfl_xor(mx, 32));
        float sum = 0.f;
#pragma unroll
        for (int u = 0; u < 17; ++u)
#pragma unroll
            for (int i = 0; i < 4; ++i) { const float p = __builtin_amdgcn_exp2f(acc[u][i] - mx); acc[u][i] = p; sum += p; }
        acc[17] = (f32x4){0.f, 0.f, 0.f, 0.f};
        sum += __shfl_xor(sum, 16); sum += __shfl_xor(sum, 32);
        const float inv = 1.f / (sum + __builtin_amdgcn_exp2f(sink - mx));
        f32x4 o[4];
#pragma unroll
        for (int dt = 0; dt < 4; ++dt) o[dt] = (f32x4){0.f, 0.f, 0.f, 0.f};
#pragma unroll
        for (int k2 = 0; k2 < 9; ++k2) {
            float pp[8] = {acc[2 * k2][0], acc[2 * k2][1], acc[2 * k2][2], acc[2 * k2][3], acc[2 * k2 + 1][0], acc[2 * k2 + 1][1], acc[2 * k2 + 1][2], acc[2 * k2 + 1][3]};
            const bf16x8 pf = pack8(pp);
#pragma unroll
            for (int dt = 0; dt < 4; ++dt) {
                const LAS bf16* vr = Vt + (dt * 16 + l15) * VA_P + kt0 * 16 + k2 * 32 + 4 * q4;
                const v2u v0 = *(const LAS v2u*)(vr);
                v2u v1 = (v2u){0u, 0u};
                if (k2 < 8) v1 = *(const LAS v2u*)(vr + 16);
                const v4u vw = (v4u){v0.x, v0.y, v1.x, v1.y};
                o[dt] = MFMA16(__builtin_bit_cast(bf16x8, vw), pf, o[dt]);
            }
        }
#pragma unroll
        for (int dt = 0; dt < 4; ++dt) {
            const int ch = hq * 64 + dt * 16 + 4 * q4;
            float gg[4]; unpack4(gat[dt], gg);
            v2u w; w.x = pk2(o[dt][0] * inv * gg[0], o[dt][1] * inv * gg[1]); w.y = pk2(o[dt][2] * inv * gg[2], o[dt][3] * inv * gg[3]);
            *(v2u*)(YC + m * DM + ch) = w;
        }
    }
    __syncthreads();
}

constexpr int KC_P = 136, VC_P = 264;
__device__ __forceinline__ void attnC_item(const Params& P, int item, LAS unsigned char* lds) {
    const int tid = pg8::mk_tid(lds), lane = tid & 63, wave = __builtin_amdgcn_readfirstlane(tid >> 6), l15 = lane & 15, q4 = lane >> 4;
    const int b = item >> 6, qb = (item >> 2) & 15, hx = item & 3;
    const bf16* PRE = (const bf16*)(P.ws + WS_PRE); const bf16* MKV = (const bf16*)(P.ws + WS_MKV); bf16* YC = (bf16*)(P.ws + WS_YCAT);
    LAS bf16* Ks = (LAS bf16*)lds; LAS bf16* Vt = Ks + 256 * KC_P;
    const int q = qb * 128 + wave * 16 + l15; const size_t m = (size_t)b * SEQ + q;
    {
        v4u kw[8], vw[8];
#pragma unroll
        for (int u = 0; u < 8; ++u) {
            const int it = tid + u * NTHREADS, j = it >> 4, c = it & 15;
            const bf16* src = MKV + ((size_t)b * NMEM + j) * 1024 + hx * 128 + 8 * c;
            kw[u] = *(const v4u*)(src); vw[u] = *(const v4u*)(src + 512);
        }
        const f32x4 g0 = *(const f32x4*)(P.in[23] + 8 * (tid & 15)), g1 = *(const f32x4*)(P.in[23] + 8 * (tid & 15) + 4);
#pragma unroll
        for (int u = 0; u < 8; ++u) {
            const int it = tid + u * NTHREADS, j = it >> 4, c = it & 15;
            float x[8]; unpack8(kw[u], x);
            float ss = 0.f;
#pragma unroll
            for (int i = 0; i < 8; ++i) ss += x[i] * x[i];
            ss = red8(ss); ss = dpp_add<0x140>(ss);
            const float rstd = 1.f / sqrtf(ss * (1.f / 128.f) + NORM_EPS);
            v4u o; o.x = pk2(x[0] * rstd * g0.x, x[1] * rstd * g0.y); o.y = pk2(x[2] * rstd * g0.z, x[3] * rstd * g0.w);
            o.z = pk2(x[4] * rstd * g1.x, x[5] * rstd * g1.y); o.w = pk2(x[6] * rstd * g1.z, x[7] * rstd * g1.w);
            *(LAS v4u*)(Ks + j * KC_P + 8 * c) = o;
            const v4u w = vw[u];
            LAS bf16* d = Vt + (8 * c) * VC_P + j;
            d[0] = (bf16)(w.x & 0xffffu); d[VC_P] = (bf16)(w.x >> 16); d[2 * VC_P] = (bf16)(w.y & 0xffffu); d[3 * VC_P] = (bf16)(w.y >> 16);
            d[4 * VC_P] = (bf16)(w.z & 0xffffu); d[5 * VC_P] = (bf16)(w.z >> 16); d[6 * VC_P] = (bf16)(w.w & 0xffffu); d[7 * VC_P] = (bf16)(w.w >> 16);
        }
    }
    v4u qraw[4]; v2u gat[8];
    {
        const bf16* src = PRE + m * NPRE + C_XQ + hx * 128 + 8 * q4;
#pragma unroll
        for (int ks = 0; ks < 4; ++ks) qraw[ks] = *(const v4u*)(src + ks * 32);
#pragma unroll
        for (int dt = 0; dt < 8; ++dt) gat[dt] = *(const v2u*)(PRE + m * NPRE + C_XG + hx * 128 + dt * 16 + 4 * q4);
    }
    __syncthreads();
    {
        bf16x8 qf[4];
        {
            float x[4][8]; float ss = 0.f;
#pragma unroll
            for (int ks = 0; ks < 4; ++ks) { unpack8(qraw[ks], x[ks]);
#pragma unroll
                for (int i = 0; i < 8; ++i) ss += x[ks][i] * x[ks][i]; }
            ss += __shfl_xor(ss, 16); ss += __shfl_xor(ss, 32);
            const float rstd = (0.08838834764831845f * 1.4426950408889634f) / sqrtf(ss * (1.f / 128.f) + NORM_EPS);
#pragma unroll
            for (int ks = 0; ks < 4; ++ks) { float y[8];
                const f32x4 ga = *(const f32x4*)(P.in[22] + ks * 32 + 8 * q4), gb = *(const f32x4*)(P.in[22] + ks * 32 + 8 * q4 + 4);
#pragma unroll
                for (int i = 0; i < 8; ++i) y[i] = x[ks][i] * rstd * ((i < 4) ? ga[i & 3] : gb[i & 3]);
                qf[ks] = pack8(y); }
        }
        f32x4 acc[16];
#pragma unroll
        for (int kt = 0; kt < 16; ++kt) {
            const LAS bf16* kr = Ks + (kt * 16 + l15) * KC_P + 8 * q4;
            f32x4 a = (f32x4){0.f, 0.f, 0.f, 0.f};
#pragma unroll
            for (int ks = 0; ks < 4; ++ks) a = MFMA16(*(const LAS bf16x8*)(kr + ks * 32), qf[ks], a);
            acc[kt] = a;
        }
        float mx = -1e30f;
#pragma unroll
        for (int kt = 0; kt < 16; ++kt)
#pragma unroll
            for (int i = 0; i < 4; ++i) mx = fmaxf(mx, acc[kt][i]);
        mx = fmaxf(mx, __shfl_xor(mx, 16)); mx = fmaxf(mx, __shfl_xor(mx, 32));
        float sum = 0.f;
#pragma unroll
        for (int kt = 0; kt < 16; ++kt)
#pragma unroll
            for (int i = 0; i < 4; ++i) { const float p = __builtin_amdgcn_exp2f(acc[kt][i] - mx); acc[kt][i] = p; sum += p; }
        sum += __shfl_xor(sum, 16); sum += __shfl_xor(sum, 32);
        const float inv = 1.f / sum;
        f32x4 o[8];
#pragma unroll
        for (int dt = 0; dt < 8; ++dt) o[dt] = (f32x4){0.f, 0.f, 0.f, 0.f};
#pragma unroll
        for (int k2 = 0; k2 < 8; ++k2) {
            float pp[8] = {acc[2 * k2][0], acc[2 * k2][1], acc[2 * k2][2], acc[2 * k2][3], acc[2 * k2 + 1][0], acc[2 * k2 + 1][1], acc[2 * k2 + 1][2], acc[2 * k2 + 1][3]};
            const bf16x8 pf = pack8(pp);
#pragma unroll
            for (int dt = 0; dt < 8; ++dt) {
                const LAS bf16* vr = Vt + (dt * 16 + l15) * VC_P + k2 * 32 + 4 * q4;
                const v2u v0 = *(const LAS v2u*)(vr), v1 = *(const LAS v2u*)(vr + 16);
                const v4u vw = (v4u){v0.x, v0.y, v1.x, v1.y};
                o[dt] = MFMA16(__builtin_bit_cast(bf16x8, vw), pf, o[dt]);
            }
        }
#pragma unroll
        for (int dt = 0; dt < 8; ++dt) {
            const int ch = hx * 128 + dt * 16 + 4 * q4;
            float gg[4]; unpack4(gat[dt], gg);
            v2u w; w.x = pk2(o[dt][0] * inv * gg[0], o[dt][1] * inv * gg[1]); w.y = pk2(o[dt][2] * inv * gg[2], o[dt][3] * inv * gg[3]);
            *(v2u*)(YC + m * DM + 1536 + ch) = w;
        }
    }
    __syncthreads();
}

__device__ __forceinline__ void p5_rwkv_post(const Params& P, LAS unsigned char* lds) {
    const bf16* PRE = (const bf16*)(P.ws + WS_PRE); const bf16* EA = (const bf16*)((unsigned char*)P.out + DO_EA);
    const bf16* YF = (const bf16*)((unsigned char*)P.out + DO_YF); const bf16* YB = (const bf16*)(P.ws + WS_YB); bf16* YC = (bf16*)(P.ws + WS_YCAT);
    const float* mu = P.in[10];
    const int gt = blockIdx.x * NTHREADS + pg8::mk_tid(lds), NGT = gridDim.x * NTHREADS;
    for (int idx = gt; idx < M_TOK * 96; idx += NGT) {
        const int m = idx / 96, he = idx - m * 96, ch0 = he * 8, t = m & (SEQ - 1);
        const bf16* p = PRE + (size_t)m * NPRE + C_RS + ch0;
        const v4u z4 = (v4u){0u, 0u, 0u, 0u};
        const bool hp = t > 0, hn = t < SEQ - 1;
        const v4u rc = *(const v4u*)(p), kc = *(const v4u*)(p + 768), vc = *(const v4u*)(p + 1536);
        const v4u rp = hp ? *(const v4u*)(p - NPRE) : z4, kp = hp ? *(const v4u*)(p - NPRE + 768) : z4, vp = hp ? *(const v4u*)(p - NPRE + 1536) : z4;
        const v4u rn = hn ? *(const v4u*)(p + NPRE) : z4, kn = hn ? *(const v4u*)(p + NPRE + 768) : z4, vn = hn ? *(const v4u*)(p + NPRE + 1536) : z4;
        const v4u af8 = *(const v4u*)(EA + (size_t)m * NLORA + 1536 + ch0), ab8 = *(const v4u*)(EA + (size_t)m * NLORA + 2304 + ch0);
        const v4u yf8 = *(const v4u*)(YF + (size_t)m * RW + ch0), yb8 = *(const v4u*)(YB + (size_t)m * RW + ch0);
        const v4u rg8 = *(const v4u*)(PRE + (size_t)m * NPRE + C_RG + ch0);
        float r[8], k[8], v[8], x0[8], x1[8], x2[8];
        unpack8(rc, x0); unpack8(rp, x1); unpack8(rn, x2);
#pragma unroll
        for (int i = 0; i < 8; ++i) r[i] = x0[i] + mu[ch0 + i] * (0.5f * (x1[i] + x2[i]) - x0[i]);
        unpack8(kc, x0); unpack8(kp, x1); unpack8(kn, x2);
#pragma unroll
        for (int i = 0; i < 8; ++i) k[i] = x0[i] + mu[768 + ch0 + i] * (0.5f * (x1[i] + x2[i]) - x0[i]);
        unpack8(vc, x0); unpack8(vp, x1); unpack8(vn, x2);
#pragma unroll
        for (int i = 0; i < 8; ++i) v[i] = x0[i] + mu[1536 + ch0 + i] * (0.5f * (x1[i] + x2[i]) - x0[i]);
        float af[8], ab[8], ys[8], yb[8], rg[8]; unpack8(af8, af); unpack8(ab8, ab); unpack8(yf8, ys); unpack8(yb8, yb); unpack8(rg8, rg);
        float bs = 0.f, sm = 0.f;
#pragma unroll
        for (int i = 0; i < 8; ++i) { const float kds = k[i] * (2.f + (af[i] + ab[i] - 2.f) * P.in[12][ch0 + i]); bs += r[i] * kds * P.in[13][ch0 + i]; ys[i] += yb[i]; sm += ys[i]; }
        bs = red8(bs); sm = red8(sm);
        const float mean = sm * (1.f / 64.f);
        float vs = 0.f;
#pragma unroll
        for (int i = 0; i < 8; ++i) { ys[i] -= mean; vs += ys[i] * ys[i]; }
        vs = red8(vs);
        const float rstd = 1.f / sqrtf(vs * (1.f / 64.f) + GN_EPS);
        float o[8];
#pragma unroll
        for (int i = 0; i < 8; ++i) o[i] = (ys[i] * rstd * P.in[18][ch0 + i] + P.in[19][ch0 + i] + bs * v[i]) * rg[i];
        v4u w; w.x = pk2(o[0], o[1]); w.y = pk2(o[2], o[3]); w.z = pk2(o[4], o[5]); w.w = pk2(o[6], o[7]);
        *(v4u*)(YC + (size_t)m * DM + 768 + ch0) = w;
    }
}

constexpr int N_PHASES = 8;
__global__ void __launch_bounds__(NTHREADS, 2) hybrid_fwd(Params P) {
    extern __shared__ __attribute__((aligned(16))) unsigned char lds_raw[];
    LAS unsigned char* lds = (LAS unsigned char*)lds_raw;
    cg::grid_group grid = cg::this_grid();
    const int lo = P.ph_lo, hi = P.ph_hi, G = gridDim.x;
    if ((threadIdx.x & 63) == 0) *(volatile LAS int*)(lds + pg8::TIDTAB_OFF + 4 * pg8::hw_slot()) = (int)(threadIdx.x >> 6);
    __syncthreads();
    unsigned char* ws = P.ws; unsigned char* dob = (unsigned char*)P.out;
#ifdef PHMASK
#define IN(k) (((PHMASK >> (k)) & 1) && lo <= (k) && (k) < hi)
#else
#define IN(k) (lo <= (k) && (k) < hi)
#endif
#define SEAM(k) do { if (IN(k) && IN((k) + 1)) grid.sync(); } while (0)
#ifndef REPEAT_MASK
#define REPEAT_MASK 0
#endif
#define REP(k) for (int rep_ = 0; rep_ < (((REPEAT_MASK >> (k)) & 1) ? 2 : 1); ++rep_)
#define REPSYNC() do { if (rep_) grid.sync(); } while (0)
    if (IN(0)) REP(0) { REPSYNC(); p0_prologue(P, lds, P.out); __syncthreads(); }
    SEAM(0);
    if (IN(1)) REP(1) { REPSYNC();
        { pg8::Gemm g{(const bf16*)(dob + DO_H), (const bf16*)(dob + DO_WIN), M_TOK, NIN, DM}; pg8::StaticOrder S; S.init(M_TOK, NIN, G, (int)blockIdx.x);
          EpiProj E{(bf16*)(ws + WS_PRE), (bf16*)(ws + WS_GATES), P.in[5]};
          pg8::gemm_phase<EpiProj, pg8::StaticOrder, true, true>(lds, g, S, E); }
        { pg8::Gemm g{(const bf16*)(ws + WS_MEMN), (const bf16*)(ws + WS_WXKV), MEMROWS, 1024, DM}; pg8::StaticOrder S; S.init(MEMROWS, 1024, G, (int)((blockIdx.x + G - 64) % G));
          EpiPlain E{(bf16*)(ws + WS_MKV), 1024};
          pg8::gemm_phase<EpiPlain, pg8::StaticOrder, true, true>(lds, g, S, E); }
    }
    SEAM(1);
    if (IN(2)) REP(2) { REPSYNC(); p2_lora_in(P, lds); }
    SEAM(2);
    if (IN(3)) REP(3) { REPSYNC();
        int klora = 256; asm volatile("" : "+s"(klora));
        pg8::Gemm g{(const bf16*)(dob + DO_LIN), (const bf16*)(ws + WS_LORAB), M_TOK, NLORA, klora}; pg8::StaticOrder S; S.init(M_TOK, NLORA, G, (int)blockIdx.x);
        EpiLora E{(bf16*)(dob + DO_EA), P.in[14], P.in[16]};
        pg8::gemm_phase<EpiLora, pg8::StaticOrder, true, true>(lds, g, S, E);
    }
    SEAM(3);
    if (IN(4)) REP(4) { REPSYNC();
        const int bid = blockIdx.x;
#ifndef SCAN_REP
#define SCAN_REP 1
#endif
#ifndef SCAN_MODE2
#define SCAN_MODE2 0
#endif
        if (bid < 192) { scan_block<0>(P, bid, lds); if (SCAN_REP > 1) scan_block<SCAN_MODE2>(P, bid, lds); }
        else {
            const int na = G - 192;
#ifndef ATT_REP
#define ATT_REP 1
#endif
            for (int ar = 0; ar < ATT_REP; ++ar)
            for (int it = bid - 192; it < 1024; it += na) { if (it < 512) attnA_item(P, it, lds); else attnC_item(P, it - 512, lds); }
        }
    }
    SEAM(4);
    if (IN(5)) REP(5) { REPSYNC(); p5_rwkv_post(P, lds); }
    SEAM(5);
    if (IN(6)) REP(6) { REPSYNC();
        pg8::Gemm g{(const bf16*)(ws + WS_YCAT), (const bf16*)(ws + WS_WCAT), M_TOK, DM, DM}; pg8::StaticOrder S; S.init(M_TOK, DM, G, (int)blockIdx.x);
        EpiMerged E{(bf16*)(ws + WS_MERGED), (const bf16*)(ws + WS_GATES)};
        pg8::gemm_phase<EpiMerged, pg8::StaticOrder, true, true>(lds, g, S, E);
    }
    SEAM(6);
    if (IN(7)) REP(7) { REPSYNC();
        pg8::Gemm g{(const bf16*)(ws + WS_MERGED), (const bf16*)(ws + WS_WOUT), M_TOK, DM, DM}; pg8::StaticOrder S; S.init(M_TOK, DM, G, (int)blockIdx.x);
        EpiOut E{P.out, P.in[0]};
        pg8::gemm_phase<EpiOut, pg8::StaticOrder, true, true>(lds, g, S, E);
    }
#undef IN
#undef SEAM
}

#ifndef ONE_LAUNCH
#define ONE_LAUNCH 1
#endif
extern "C" void kernel_launch(void* const* d_in, const int* in_sizes, int n_in, void* d_out, int out_size, void* d_ws, size_t ws_size, hipStream_t stream) {
    static int grid = 0;
    if (grid == 0) {
        if (n_in != 26 || out_size != M_TOK * DM || ws_size < WS_END) { fprintf(stderr, "kernel_launch: unexpected shapes (n_in %d, out %d, ws %zu); nothing launched\n", n_in, out_size, ws_size); grid = -1; return; }
        int dev = 0, cus = 0, per_cu = 0;
        hipGetDevice(&dev); hipDeviceGetAttribute(&cus, hipDeviceAttributeMultiprocessorCount, dev);
        if (hipFuncSetAttribute((const void*)hybrid_fwd, hipFuncAttributeMaxDynamicSharedMemorySize, LDS_BYTES) != hipSuccess) { fprintf(stderr, "kernel_launch: hipFuncSetAttribute failed\n"); grid = -1; return; }
        hipOccupancyMaxActiveBlocksPerMultiprocessor(&per_cu, (const void*)hybrid_fwd, NTHREADS, LDS_BYTES);
        (void)hipGetLastError();
        if (per_cu < 1) per_cu = 1;
        grid = cus * per_cu; if (grid > 256) grid = 256;
        if (grid < 200) { fprintf(stderr, "kernel_launch: grid %d too small for the scan/attention split\n", grid); grid = -1; return; }
    }
    if (grid < 0) return;
    Params p{};
    for (int i = 0; i < 26; ++i) p.in[i] = (const float*)d_in[i];
    p.out = (float*)d_out; p.ws = (unsigned char*)d_ws;
#if ONE_LAUNCH
    p.ph_lo = 0; p.ph_hi = N_PHASES;
    void* args[] = {&p};
    hipError_t e = hipLaunchCooperativeKernel((const void*)hybrid_fwd, dim3(grid), dim3(NTHREADS), args, LDS_BYTES, stream);
    if (e != hipSuccess) fprintf(stderr, "cooperative launch failed: %s (grid %d)\n", hipGetErrorString(e), grid);
#else
    for (int ph = 0; ph < N_PHASES; ++ph) {
        p.ph_lo = ph; p.ph_hi = ph + 1;
        hipLaunchKernelGGL(hybrid_fwd, dim3(grid), dim3(NTHREADS), LDS_BYTES, stream, p);
    }
#endif
}
```

```cpp
#include <hip/hip_runtime.h>
#include <hip/hip_cooperative_groups.h>
#include <cstdio>
#include <cstdint>
namespace cg = cooperative_groups;
namespace pg8 {
#define PG8_LAS __attribute__((address_space(3)))
typedef unsigned short bf16_t;
typedef short bf16x8 __attribute__((ext_vector_type(8)));
typedef float f32x4 __attribute__((ext_vector_type(4)));
typedef unsigned u32x4 __attribute__((ext_vector_type(4)));
constexpr int BM = 256, BK = 64, HALF = 128, HTB = HALF * BK * 2  , STAGE_BYTES = 8 * HTB, NXCD = 8, WGM = 8;

__host__ __device__ __forceinline__ int lds_byte(int r, int c) { const int st = (r >> 4) * 2 + (c >> 5), rr = r & 15, cc = c & 31, ob = rr * 64 + cc * 2; return st * 1024 + (ob ^ (((ob >> 9) & 1) << 5)); }
__host__ __device__ __forceinline__ void stage_rc(int b, int& R, int& C) { const int st = b / 1024, sb = b % 1024, swz = sb ^ (((sb >> 9) & 1) << 5); R = (st >> 1) * 16 + swz / 64; C = (st & 1) * 32 + (swz % 64) / 2; }
__host__ __device__ __forceinline__ int perm32(int rho) { const int n = rho >> 4, i = rho & 15; return 8 * (i >> 2) + 4 * n + (i & 3); }


constexpr int TIDTAB_OFF = 147200;
__device__ __forceinline__ int hw_slot() { return (int)(__builtin_amdgcn_s_getreg((5 << 11) | 4) & 63u); }
__device__ __forceinline__ int mk_tid(PG8_LAS unsigned char* lds) {
    const int lane = (int)__builtin_amdgcn_mbcnt_hi(~0u, __builtin_amdgcn_mbcnt_lo(~0u, 0u));
    const int w = __builtin_amdgcn_readfirstlane(*(volatile PG8_LAS int*)(lds + TIDTAB_OFF + 4 * hw_slot()));
    return w * 64 + lane;
}
struct Unit { int pm, pn; };
struct Gemm { const bf16_t* A; const bf16_t* Bt; int M, N, K; };

struct StaticOrder {
    int nM, nN, nwg, G, c;
    __host__ __device__ void init(int M, int N, int G_, int c_) { nM = M / BM; nN = N / BM; nwg = nM * nN; G = G_; c = c_; }
    __host__ __device__ bool next(int i, Unit& u) const {
        const long L = (long)i * G + c; if (L >= nwg) return false;
        int wgid = (int)L; { const int q = nwg / NXCD, r = nwg % NXCD, xcd = wgid % NXCD, off = wgid / NXCD; wgid = (xcd < r ? xcd * (q + 1) : r * (q + 1) + (xcd - r) * q) + off; }
        const int nig = WGM * nN, gid = wgid / nig, fm = gid * WGM, gsz = (nM - fm) < WGM ? (nM - fm) : WGM;
        u.pm = fm + ((wgid % nig) % gsz); u.pn = (wgid % nig) / gsz; return true;
    }
    __device__ __forceinline__ void a_ready(const Unit&) const {}
    __device__ __forceinline__ void done(const Unit&) const {}
};

__device__ __forceinline__ unsigned cvt_pk_bf16(float lo, float hi) { unsigned r; asm volatile("v_cvt_pk_bf16_f32 %0, %1, %2" : "=v"(r) : "v"(lo), "v"(hi)); return r; }
template <class Epi, class Sched, bool ALIGN_EPI = false, bool SP2 = false>
__device__ __forceinline__ void gemm_phase(PG8_LAS unsigned char* lds, const Gemm g, const Sched& S, const Epi& E) {
    const int tid = mk_tid(lds), wid = __builtin_amdgcn_readfirstlane(tid >> 6), lane = tid & 63, wr = wid >> 2, wc = wid & 3, fr = lane & 15, fq = lane >> 4;
    const int K = g.K, nt = K / BK;
    unsigned voffA[2], voffB[2];
#pragma unroll
    for (int i = 0; i < 2; ++i) { int R, C; stage_rc(tid * 16 + i * 8192, R, C); const int Rb = Epi::PERM ? ((R & ~31) + perm32(R & 31)) : R;
        voffA[i] = (unsigned)(R * K + C) * 2u; voffB[i] = (unsigned)(Rb * K + C) * 2u; }
    const size_t kstep = (size_t)(BK * 2);
    const size_t hstep = (size_t)HALF * K * 2;
    const size_t tstep = 2 * hstep;
    const unsigned ldsw = (unsigned)wid * 1024u;
    const int aoff = lds_byte(wr * 64 + fr, fq * 8), boff = lds_byte(wc * 32 + fr, fq * 8);
#define PG8_SA(b, h) (((b) * 2 + (h)) * HTB)
#define PG8_SB(b, h) ((4 + (b) * 2 + (h)) * HTB)
#define PG8_STAGE(bufoff, gbase, voff) do { _Pragma("unroll") for (int _i = 0; _i < 2; ++_i) \
        __builtin_amdgcn_global_load_lds((const unsigned*)((const char*)(gbase) + (voff)[_i]), (PG8_LAS unsigned*)(lds + (bufoff) + ldsw + _i * 8192), 16, 0, 0); } while (0)
#define PG8_LDA(dst, b, h) do { _Pragma("unroll") for (int m = 0; m < 4; ++m) _Pragma("unroll") for (int k = 0; k < 2; ++k) dst[m][k] = *(const PG8_LAS bf16x8*)(lds + PG8_SA(b, h) + aoff + m * 2048 + k * 1024); } while (0)
#define PG8_LDB(dst, b, h) do { _Pragma("unroll") for (int n = 0; n < 2; ++n) _Pragma("unroll") for (int k = 0; k < 2; ++k) dst[n][k] = *(const PG8_LAS bf16x8*)(lds + PG8_SB(b, h) + boff + n * 2048 + k * 1024); } while (0)
#define PG8_MMA(ai, bj, At, Bt) do { __builtin_amdgcn_s_setprio(1); _Pragma("unroll") for (int m = 0; m < 4; ++m) _Pragma("unroll") for (int n = 0; n < 2; ++n) _Pragma("unroll") for (int k = 0; k < 2; ++k) \
        acc[ai][bj][m][n] = __builtin_amdgcn_mfma_f32_16x16x32_bf16(Bt[n][k], At[m][k], acc[ai][bj][m][n], 0, 0, 0); __builtin_amdgcn_s_setprio(0); } while (0)
#define PG8_WAIT_V(n) asm volatile("s_waitcnt vmcnt(" #n ")" ::: "memory")
#define PG8_WAIT_L(n) asm volatile("s_waitcnt lgkmcnt(" #n ")" ::: "memory")
#define PG8_BAR __builtin_amdgcn_s_barrier()
#define PG8_SCHED __builtin_amdgcn_sched_barrier(0)
    Unit cur, nxt; int ui = 0;
    if (!S.next(0, cur)) return;
    f32x4 acc[2][2][4][2];
#pragma unroll
    for (int a = 0; a < 2; ++a)
#pragma unroll
        for (int b = 0; b < 2; ++b)
#pragma unroll
            for (int m = 0; m < 4; ++m)
#pragma unroll
                for (int n = 0; n < 2; ++n) acc[a][b][m][n] = (f32x4){0.f, 0.f, 0.f, 0.f};
    bf16x8 At[4][2], B0[2][2], B1[2][2];
    const char* cA = (const char*)g.A + (size_t)cur.pm * tstep; const char* cB = (const char*)g.Bt + (size_t)cur.pn * tstep;
    S.a_ready(cur);
    if constexpr (SP2) {
        PG8_STAGE(PG8_SB(0, 0), cB, voffB); PG8_STAGE(PG8_SB(0, 1), cB + hstep, voffB); PG8_STAGE(PG8_SA(0, 0), cA, voffA); PG8_STAGE(PG8_SA(0, 1), cA + hstep, voffA);
        if (wr == 1) PG8_BAR;
        PG8_WAIT_V(2); PG8_BAR;
        PG8_STAGE(PG8_SB(1, 0), cB + kstep, voffB); PG8_STAGE(PG8_SA(1, 0), cA + kstep, voffA); PG8_STAGE(PG8_SB(1, 1), cB + hstep + kstep, voffB);
        PG8_WAIT_V(6); PG8_BAR;
    } else {
        PG8_STAGE(PG8_SB(0, 0), cB, voffB); PG8_STAGE(PG8_SA(0, 0), cA, voffA); PG8_STAGE(PG8_SB(0, 1), cB + hstep, voffB); PG8_STAGE(PG8_SA(0, 1), cA + hstep, voffA);
        if (wr == 1) PG8_BAR;
        PG8_WAIT_V(4); PG8_BAR;
        PG8_STAGE(PG8_SB(1, 0), cB + kstep, voffB); PG8_STAGE(PG8_SA(1, 0), cA + kstep, voffA); PG8_STAGE(PG8_SB(1, 1), cB + hstep + kstep, voffB);
        PG8_WAIT_V(6); PG8_BAR;
    }
    for (;;) {
        const bool has_next = S.next(ui + 1, nxt);
        const char* nA = has_next ? (const char*)g.A + (size_t)nxt.pm * tstep : cA; const char* nB = has_next ? (const char*)g.Bt + (size_t)nxt.pn * tstep : cB;
        for (int t = 0; t < nt; t += 2) {
            if constexpr (Epi::KHOOK) { if (t == Epi::HK0 || t == Epi::HK1) E.khook(acc, cur, t, wr, wc, fr, fq); }
            const bool last = (t == nt - 2);
            const char* a1 = cA + (size_t)(t + 1) * kstep;
            const char* a2 = last ? nA : cA + (size_t)(t + 2) * kstep; const char* b2 = last ? nB : cB + (size_t)(t + 2) * kstep;
            const char* a3 = a2 + kstep; const char* b3 = b2 + kstep;
            if (last && has_next) S.a_ready(nxt);
            if constexpr (SP2) {
            PG8_LDB(B0, 0, 0); PG8_LDB(B1, 0, 1); PG8_SCHED; PG8_LDA(At, 0, 0); PG8_STAGE(PG8_SA(1, 1), a1 + hstep, voffA);
            PG8_WAIT_V(8); PG8_WAIT_L(0); PG8_BAR; PG8_MMA(0, 0, At, B0); PG8_MMA(0, 1, At, B1); PG8_BAR; PG8_SCHED;
            PG8_LDA(At, 0, 1); PG8_STAGE(PG8_SB(0, 0), b2, voffB); PG8_STAGE(PG8_SB(0, 1), b2 + hstep, voffB); PG8_STAGE(PG8_SA(0, 0), a2, voffA);
            PG8_WAIT_V(8); PG8_WAIT_L(0); PG8_BAR; PG8_MMA(1, 0, At, B0); PG8_MMA(1, 1, At, B1); PG8_BAR; PG8_SCHED;
            PG8_LDB(B0, 1, 0); PG8_LDB(B1, 1, 1); PG8_SCHED; PG8_LDA(At, 1, 0); PG8_STAGE(PG8_SA(0, 1), a2 + hstep, voffA);
            PG8_WAIT_V(8); PG8_WAIT_L(0); PG8_BAR; PG8_MMA(0, 0, At, B0); PG8_MMA(0, 1, At, B1); PG8_BAR; PG8_SCHED;
            PG8_LDA(At, 1, 1); PG8_STAGE(PG8_SB(1, 0), b3, voffB); PG8_STAGE(PG8_SB(1, 1), b3 + hstep, voffB); PG8_STAGE(PG8_SA(1, 0), a3, voffA);
            PG8_WAIT_V(8); PG8_WAIT_L(0); PG8_BAR; PG8_MMA(1, 0, At, B0); PG8_MMA(1, 1, At, B1); PG8_BAR; PG8_SCHED;
            } else {
            PG8_LDB(B0, 0, 0); PG8_SCHED; PG8_LDA(At, 0, 0); PG8_STAGE(PG8_SA(1, 1), a1 + hstep, voffA);
            PG8_WAIT_L(8); PG8_BAR; PG8_WAIT_L(0); PG8_MMA(0, 0, At, B0); PG8_BAR; PG8_SCHED;
            PG8_LDB(B1, 0, 1); PG8_STAGE(PG8_SB(0, 0), b2, voffB);
            PG8_BAR; PG8_WAIT_L(0); PG8_MMA(0, 1, At, B1); PG8_BAR;
            PG8_LDA(At, 0, 1); PG8_STAGE(PG8_SA(0, 0), a2, voffA);
            PG8_BAR; PG8_WAIT_L(0); PG8_MMA(1, 0, At, B0); PG8_BAR; PG8_SCHED;
            PG8_STAGE(PG8_SB(0, 1), b2 + hstep, voffB);
            PG8_WAIT_V(6); PG8_BAR; PG8_MMA(1, 1, At, B1); PG8_BAR;
            PG8_LDB(B0, 1, 0); PG8_SCHED; PG8_LDA(At, 1, 0); PG8_STAGE(PG8_SA(0, 1), a2 + hstep, voffA);
            PG8_WAIT_L(8); PG8_BAR; PG8_WAIT_L(0); PG8_MMA(0, 0, At, B0); PG8_BAR; PG8_SCHED;
            PG8_LDB(B1, 1, 1); PG8_STAGE(PG8_SB(1, 0), b3, voffB);
            PG8_BAR; PG8_WAIT_L(0); PG8_MMA(0, 1, At, B1); PG8_BAR;
            PG8_LDA(At, 1, 1); PG8_STAGE(PG8_SA(1, 0), a3, voffA);
            PG8_BAR; PG8_WAIT_L(0); PG8_MMA(1, 0, At, B0); PG8_BAR; PG8_SCHED;
            PG8_STAGE(PG8_SB(1, 1), b3 + hstep, voffB);
            PG8_WAIT_V(6); PG8_BAR; PG8_MMA(1, 1, At, B1); PG8_BAR;
            }
        }
        if constexpr (ALIGN_EPI) { if (wr == 0) PG8_BAR; }
        if constexpr (!Epi::AFTER_DRAIN) { E(acc, cur, wr, wc, fr, fq); S.done(cur); }
        if (!has_next) break;
#pragma unroll
        for (int a = 0; a < 2; ++a)
#pragma unroll
            for (int b = 0; b < 2; ++b)
#pragma unroll
                for (int m = 0; m < 4; ++m)
#pragma unroll
                    for (int n = 0; n < 2; ++n) acc[a][b][m][n] = (f32x4){0.f, 0.f, 0.f, 0.f};
        cur = nxt; cA = nA; cB = nB; ++ui;
        if constexpr (ALIGN_EPI) { if (wr == 1) PG8_BAR; }
    }
    PG8_WAIT_V(0);
    if constexpr (!ALIGN_EPI) { if (wr == 0) PG8_BAR; }
    PG8_BAR;
    if constexpr (Epi::AFTER_DRAIN) { E.fused(acc, cur, wr, wc, fr, fq, lds, wid, lane); S.done(cur); }
#undef PG8_SA
#undef PG8_SB
#undef PG8_STAGE
#undef PG8_LDA
#undef PG8_LDB
#undef PG8_MMA
#undef PG8_WAIT_V
#undef PG8_WAIT_L
#undef PG8_BAR
#undef PG8_SCHED
}
}

#define GAS __attribute__((address_space(1)))
#define LAS __attribute__((address_space(3)))
typedef unsigned short bf16;
typedef unsigned v4u __attribute__((ext_vector_type(4)));
typedef unsigned v2u __attribute__((ext_vector_type(2)));
typedef float f32x4 __attribute__((ext_vector_type(4)));
typedef float f32x2 __attribute__((ext_vector_type(2)));
typedef short bf16x8 __attribute__((ext_vector_type(8)));
typedef short s16x4 __attribute__((ext_vector_type(4)));

constexpr int NWAVES = 8, NTHREADS = 512;
constexpr int BATCH = 8, SEQ = 2048, DM = 2048, M_TOK = BATCH * SEQ;
constexpr int NPRE = 6400, NGATE = 6144, NIN = NPRE + NGATE;
constexpr int C_AQ = 0, C_AK = 768, C_AV = 1024, C_AG = 1280, C_RS = 2048, C_RR = 2048, C_RK = 2816, C_RV = 3584, C_LORA = 4352, C_RG = 4608, C_XQ = 5376, C_XG = 5888;
constexpr int NMEM = 256, MEMROWS = BATCH * NMEM;
constexpr int RW = 768, NLORA = 3072;
constexpr float NORM_EPS = 1e-6f, GN_EPS = 64e-5f;
constexpr int LDS_BYTES = 147456;

constexpr size_t MiB = 1u << 20;
constexpr size_t WS_PRE = 0, WS_MERGED = 0, WS_GATES = 200 * MiB, WS_YCAT = 392 * MiB;
constexpr size_t WS_WCAT = 456 * MiB, WS_WOUT = 464 * MiB, WS_WXKV = 472 * MiB, WS_MKV = 476 * MiB, WS_MEMN = 480 * MiB, WS_YB = 480 * MiB;
constexpr size_t WS_ROPE = 504 * MiB, WS_LORAB = 505 * MiB, WS_END = 512 * MiB;
constexpr size_t WS_CTR = 504 * MiB + 768 * 1024;
constexpr size_t DO_H = 0, DO_WIN = 64 * MiB, DO_EA = 0, DO_LIN = 96 * MiB, DO_YF = 104 * MiB;

struct Params { const float* in[26]; float* out; unsigned char* ws; int ph_lo, ph_hi; };

__device__ __forceinline__ float bf_lo(unsigned w) { return __builtin_bit_cast(float, w << 16); }
__device__ __forceinline__ float bf_hi(unsigned w) { return __builtin_bit_cast(float, w & 0xffff0000u); }
__device__ __forceinline__ float bf1(bf16 h) { return __builtin_bit_cast(float, (unsigned)h << 16); }
__device__ __forceinline__ unsigned f2bf(float f) { unsigned u = __builtin_bit_cast(unsigned, f); return (u + 0x7fffu + ((u >> 16) & 1u)) >> 16; }
typedef __bf16 bf16x2_t __attribute__((ext_vector_type(2)));
__device__ __forceinline__ unsigned pk2(float lo, float hi) { const f32x2 v = {lo, hi}; const bf16x2_t b = __builtin_convertvector(v, bf16x2_t); return __builtin_bit_cast(unsigned, b); }
__device__ __forceinline__ float sigmoidf_(float z) { return __builtin_amdgcn_rcpf(1.f + __expf(-z)); }
__device__ __forceinline__ float siluf_(float z) { return z * sigmoidf_(z); }
__device__ __forceinline__ void unpack8(v4u w, float (&x)[8]) { x[0] = bf_lo(w.x); x[1] = bf_hi(w.x); x[2] = bf_lo(w.y); x[3] = bf_hi(w.y); x[4] = bf_lo(w.z); x[5] = bf_hi(w.z); x[6] = bf_lo(w.w); x[7] = bf_hi(w.w); }
__device__ __forceinline__ void unpack4(v2u w, float (&x)[4]) { x[0] = bf_lo(w.x); x[1] = bf_hi(w.x); x[2] = bf_lo(w.y); x[3] = bf_hi(w.y); }
__device__ __forceinline__ float fma_s(float a, float b, float c) { float r; asm("v_fma_f32 %0, %1, %2, %3" : "=v"(r) : "v"(a), "v"(b), "v"(c)); return r; }
__device__ __forceinline__ float mul_s(float a, float b) { float r; asm("v_mul_f32_e32 %0, %1, %2" : "=v"(r) : "v"(a), "v"(b)); return r; }
__device__ __forceinline__ float add_s(float a, float b) { float r; asm("v_add_f32_e32 %0, %1, %2" : "=v"(r) : "v"(a), "v"(b)); return r; }
template <int CTRL> __device__ __forceinline__ float dpp_add(float v) { return v + __builtin_bit_cast(float, __builtin_amdgcn_update_dpp(0, __builtin_bit_cast(int, v), CTRL, 0xF, 0xF, true)); }
__device__ __forceinline__ float red8(float v) { v = dpp_add<0xB1>(v); v = dpp_add<0x4E>(v); v = dpp_add<0x141>(v); return v; }

using pg8::Unit;
struct EpiProj {
    static constexpr bool PERM = true, AFTER_DRAIN = false, KHOOK = false; static constexpr int HK0 = -1, HK1 = -1;
    bf16* pre; bf16* gates; const float* gate_b;
    __device__ __forceinline__ void operator()(const f32x4 (&acc)[2][2][4][2], const Unit& u, int wr, int wc, int fr, int fq) const {
        int row0 = u.pm * 256 + wr * 64 + fr;
        asm volatile("" : "+v"(row0));
        const bool isg = u.pn >= 25;
        const int pn = isg ? u.pn - 25 : u.pn;
        bf16* base = isg ? gates : pre; const int ldc = isg ? NGATE : NPRE;
        const int act = isg ? 2 : (((pn >= 5 && pn <= 7) || (pn >= 18 && pn <= 20) || pn >= 23) ? 1 : 0);
        const int col0 = pn * 256 + wc * 32 + 8 * fq;
#pragma unroll
        for (int ai = 0; ai < 2; ++ai)
#pragma unroll
            for (int m = 0; m < 4; ++m) { bf16* rowp = base + (size_t)(row0 + ai * 128 + m * 16) * ldc + col0;
                __builtin_amdgcn_sched_barrier(0);
#pragma unroll
                for (int bj = 0; bj < 2; ++bj) { f32x4 v0 = acc[ai][bj][m][0], v1 = acc[ai][bj][m][1];
                    if (isg) { v0 += *(const f32x4*)(gate_b + col0 + bj * 128); v1 += *(const f32x4*)(gate_b + col0 + bj * 128 + 4); }
                    if (act == 1) {
#pragma unroll
                        for (int i = 0; i < 4; ++i) { v0[i] = siluf_(v0[i]); v1[i] = siluf_(v1[i]); }
                    } else if (act == 2) {
#pragma unroll
                        for (int i = 0; i < 4; ++i) { v0[i] = sigmoidf_(v0[i]); v1[i] = sigmoidf_(v1[i]); }
                    }
                    v4u w; w.x = pk2(v0[0], v0[1]); w.y = pk2(v0[2], v0[3]); w.z = pk2(v1[0], v1[1]); w.w = pk2(v1[2], v1[3]);
                    *(v4u*)(rowp + bj * 128) = w; } }
    }
};
struct EpiPlain {
    static constexpr bool PERM = true, AFTER_DRAIN = false, KHOOK = false; static constexpr int HK0 = -1, HK1 = -1;
    bf16* O; int ldc;
    __device__ __forceinline__ void operator()(const f32x4 (&acc)[2][2][4][2], const Unit& u, int wr, int wc, int fr, int fq) const {
        int row0 = u.pm * 256 + wr * 64 + fr, col0 = u.pn * 256 + wc * 32 + 8 * fq;
        asm volatile("" : "+v"(row0), "+v"(col0));
#pragma unroll
        for (int ai = 0; ai < 2; ++ai)
#pragma unroll
            for (int m = 0; m < 4; ++m) { bf16* rowp = O + (size_t)(row0 + ai * 128 + m * 16) * ldc + col0;
#pragma unroll
                for (int bj = 0; bj < 2; ++bj) { const f32x4 v0 = acc[ai][bj][m][0], v1 = acc[ai][bj][m][1];
                    v4u w; w.x = pk2(v0[0], v0[1]); w.y = pk2(v0[2], v0[3]); w.z = pk2(v1[0], v1[1]); w.w = pk2(v1[2], v1[3]);
                    *(v4u*)(rowp + bj * 128) = w; } }
    }
};
struct EpiLora {
    static constexpr bool PERM = true, AFTER_DRAIN = false, KHOOK = false; static constexpr int HK0 = -1, HK1 = -1;
    bf16* O; const float* w0; const float* a0;
    __device__ __forceinline__ void operator()(const f32x4 (&acc)[2][2][4][2], const Unit& u, int wr, int wc, int fr, int fq) const {
        int row0 = u.pm * 256 + wr * 64 + fr, col0 = u.pn * 256 + wc * 32 + 8 * fq;
        asm volatile("" : "+v"(row0), "+v"(col0));
        const bool isw = u.pn < 6; const float* bias = isw ? (w0 + col0) : (a0 + col0 - 1536); const float sc = isw ? 0.6065306597126334f : 1.f;
#pragma unroll
        for (int ai = 0; ai < 2; ++ai)
#pragma unroll
            for (int m = 0; m < 4; ++m) { bf16* rowp = O + (size_t)(row0 + ai * 128 + m * 16) * NLORA + col0;
                __builtin_amdgcn_sched_barrier(0);
#pragma unroll
                for (int bj = 0; bj < 2; ++bj) { f32x4 v0 = acc[ai][bj][m][0] + *(const f32x4*)(bias + bj * 128), v1 = acc[ai][bj][m][1] + *(const f32x4*)(bias + bj * 128 + 4);
#pragma unroll
                    for (int i = 0; i < 4; ++i) { v0[i] = sc * sigmoidf_(v0[i]); v1[i] = sc * sigmoidf_(v1[i]); }
                    v4u w; w.x = pk2(v0[0], v0[1]); w.y = pk2(v0[2], v0[3]); w.z = pk2(v1[0], v1[1]); w.w = pk2(v1[2], v1[3]);
                    *(v4u*)(rowp + bj * 128) = w; } }
    }
};
struct EpiMerged {
    static constexpr bool PERM = true, AFTER_DRAIN = false, KHOOK = true; static constexpr int HK0 = 12, HK1 = 24;
    bf16* O; const bf16* gates;
    __device__ __forceinline__ void khook(f32x4 (&acc)[2][2][4][2], const Unit& u, int t, int wr, int wc, int fr, int fq) const {
        int row0 = u.pm * 256 + wr * 64 + fr, col0 = u.pn * 256 + wc * 32 + 8 * fq;
        asm volatile("" : "+v"(row0), "+v"(col0));
        const int bo = (t == HK0) ? 0 : DM;
#pragma unroll
        for (int ai = 0; ai < 2; ++ai)
#pragma unroll
            for (int m = 0; m < 4; ++m) { const bf16* gp = gates + (size_t)(row0 + ai * 128 + m * 16) * NGATE + bo + col0;
                __builtin_amdgcn_sched_barrier(0);
#pragma unroll
                for (int bj = 0; bj < 2; ++bj) { const v4u a = *(const v4u*)(gp + bj * 128), b = *(const v4u*)(gp + DM + bj * 128);
                    float x[8], y[8]; unpack8(a, x); unpack8(b, y);
#pragma unroll
                    for (int i = 0; i < 4; ++i) { acc[ai][bj][m][0][i] *= x[i] * __builtin_amdgcn_rcpf(y[i]); acc[ai][bj][m][1][i] *= x[4 + i] * __builtin_amdgcn_rcpf(y[4 + i]); } } }
    }
    __device__ __forceinline__ void operator()(const f32x4 (&acc)[2][2][4][2], const Unit& u, int wr, int wc, int fr, int fq) const {
        int row0 = u.pm * 256 + wr * 64 + fr, col0 = u.pn * 256 + wc * 32 + 8 * fq;
        asm volatile("" : "+v"(row0), "+v"(col0));
#pragma unroll
        for (int ai = 0; ai < 2; ++ai)
#pragma unroll
            for (int m = 0; m < 4; ++m) { const size_t r = (size_t)(row0 + ai * 128 + m * 16);
                __builtin_amdgcn_sched_barrier(0);
#pragma unroll
                for (int bj = 0; bj < 2; ++bj) { const v4u g = *(const v4u*)(gates + r * NGATE + 2 * DM + col0 + bj * 128); float x[8]; unpack8(g, x);
                    const f32x4 v0 = acc[ai][bj][m][0], v1 = acc[ai][bj][m][1];
                    v4u w; w.x = pk2(v0[0] * x[0], v0[1] * x[1]); w.y = pk2(v0[2] * x[2], v0[3] * x[3]); w.z = pk2(v1[0] * x[4], v1[1] * x[5]); w.w = pk2(v1[2] * x[6], v1[3] * x[7]);
                    *(v4u*)(O + r * DM + col0 + bj * 128) = w; } }
    }
};
struct EpiOut {
    static constexpr bool PERM = true, AFTER_DRAIN = false, KHOOK = false; static constexpr int HK0 = -1, HK1 = -1;
    float* O; const float* X;
    __device__ __forceinline__ void operator()(const f32x4 (&acc)[2][2][4][2], const Unit& u, int wr, int wc, int fr, int fq) const {
        int row0 = u.pm * 256 + wr * 64 + fr, col0 = u.pn * 256 + wc * 32 + 8 * fq;
        asm volatile("" : "+v"(row0), "+v"(col0));
#pragma unroll
        for (int ai = 0; ai < 2; ++ai)
#pragma unroll
            for (int m = 0; m < 4; ++m) { const size_t o = (size_t)(row0 + ai * 128 + m * 16) * DM + col0;
                __builtin_amdgcn_sched_barrier(0);
#pragma unroll
                for (int bj = 0; bj < 2; ++bj) {
                    const f32x4 x0 = *(const f32x4*)(X + o + bj * 128), x1 = *(const f32x4*)(X + o + bj * 128 + 4);
                    *(f32x4*)(O + o + bj * 128) = x0 + acc[ai][bj][m][0]; *(f32x4*)(O + o + bj * 128 + 4) = x1 + acc[ai][bj][m][1]; } }
    }
};

__device__ __forceinline__ float wave_sum(float v) {
#pragma unroll
    for (int o = 1; o < 64; o <<= 1) v += __shfl_xor(v, o);
    return v;
}
__device__ __forceinline__ void transpose_item(const float* W, int N, bf16* WT, int ldt, int koff, LAS float* scr, int item, int lane) {
    const int nblk = N / 32, kb = item / nblk, nb = item % nblk, k0 = 64 * kb, n0 = 32 * nb;
    float tv[32];
#pragma unroll
    for (int i = 0; i < 32; ++i) { const int kk = 2 * i + (lane >> 5); tv[i] = W[(size_t)(k0 + kk) * N + n0 + (lane & 31)]; }
#pragma unroll
    for (int i = 0; i < 32; ++i) { const int kk = 2 * i + (lane >> 5); scr[kk * 33 + (lane & 31)] = tv[i]; }
    asm volatile("s_waitcnt lgkmcnt(0)" ::: "memory");
    const int c = lane & 7;
#pragma unroll
    for (int j = 0; j < 4; ++j) { const int n = (lane >> 3) + 8 * j; const LAS float* s = scr + (8 * c) * 33 + n;
        v4u o; o.x = pk2(s[0 * 33], s[1 * 33]); o.y = pk2(s[2 * 33], s[3 * 33]); o.z = pk2(s[4 * 33], s[5 * 33]); o.w = pk2(s[6 * 33], s[7 * 33]);
        *(v4u*)(WT + (size_t)(n0 + n) * ldt + koff + k0 + 8 * c) = o; }
    asm volatile("s_waitcnt lgkmcnt(0)" ::: "memory");
}
__device__ __forceinline__ void rms_row_to_bf16(const float* xrow, const float* g, bf16* orow, int lane) {
    const f32x4* xr = (const f32x4*)xrow + lane; const f32x4* gr = (const f32x4*)g + lane;
    f32x4 v[8]; float s = 0.f;
#pragma unroll
    for (int j = 0; j < 8; ++j) { v[j] = xr[64 * j]; s += (v[j].x * v[j].x + v[j].y * v[j].y) + (v[j].z * v[j].z + v[j].w * v[j].w); }
    const float rstd = 1.f / sqrtf(wave_sum(s) * (1.f / DM) + NORM_EPS);
    v2u* o8 = (v2u*)orow + lane;
#pragma unroll
    for (int j = 0; j < 8; ++j) { const f32x4 gg = gr[64 * j]; v2u o; o.x = pk2(v[j].x * rstd * gg.x, v[j].y * rstd * gg.y); o.y = pk2(v[j].z * rstd * gg.z, v[j].w * rstd * gg.w); o8[64 * j] = o; }
}
__device__ __forceinline__ void p0_prologue(const Params& P, LAS unsigned char* lds, float* dout_scratch) {
    const int tid = pg8::mk_tid(lds), lane = tid & 63, wave = tid >> 6, G = gridDim.x;
    LAS float* scr = (LAS float*)(lds + wave * 16384);
    const int gw = blockIdx.x * NWAVES + wave, NGW = G * NWAVES;
    unsigned char* ws = P.ws; unsigned char* dob = (unsigned char*)P.out;
    bf16* WIN_T = (bf16*)(dob + DO_WIN); bf16* WCAT_T = (bf16*)(ws + WS_WCAT); bf16* WOUT_T = (bf16*)(ws + WS_WOUT); bf16* WXKV_T = (bf16*)(ws + WS_WXKV);
    constexpr int I_IN = 32 * (NIN / 32), I_A = 12 * 64, I_R = 12 * 64, I_X = 8 * 64, I_O = 32 * 64, I_KV = 32 * 32;
    constexpr int NITEMS = I_IN + I_A + I_R + I_X + I_O + I_KV;
    for (int it = gw; it < NITEMS; it += NGW) {
        int r = it;
        if (r < I_IN) { transpose_item(P.in[4], NIN, WIN_T, DM, 0, scr, r, lane); continue; } r -= I_IN;
        if (r < I_A) { transpose_item(P.in[9], DM, WCAT_T, DM, 0, scr, r, lane); continue; } r -= I_A;
        if (r < I_R) { transpose_item(P.in[20], DM, WCAT_T, DM, 768, scr, r, lane); continue; } r -= I_R;
        if (r < I_X) { transpose_item(P.in[24], DM, WCAT_T, DM, 1536, scr, r, lane); continue; } r -= I_X;
        if (r < I_O) { transpose_item(P.in[25], DM, WOUT_T, DM, 0, scr, r, lane); continue; } r -= I_O;
        transpose_item(P.in[21], 1024, WXKV_T, DM, 0, scr, r, lane);
    }
    bf16* H = (bf16*)(dob + DO_H); bf16* MEMN = (bf16*)(ws + WS_MEMN);
    for (int m = gw; m < M_TOK + MEMROWS; m += NGW) {
        if (m < M_TOK) rms_row_to_bf16(P.in[0] + (size_t)m * DM, P.in[2], H + (size_t)m * DM, lane);
        else rms_row_to_bf16(P.in[1] + (size_t)(m - M_TOK) * DM, P.in[3], MEMN + (size_t)(m - M_TOK) * DM, lane);
    }
    if (blockIdx.x == 0 && tid == 0) __hip_atomic_store((unsigned*)(ws + WS_CTR), 0u, __ATOMIC_RELAXED, __HIP_MEMORY_SCOPE_AGENT);
    bf16* LB = (bf16*)(ws + WS_LORAB);
    const int gt = blockIdx.x * NTHREADS + tid, NGT = G * NTHREADS;
    for (int idx = gt; idx < NLORA * 256; idx += NGT) {
        const int n = idx >> 8, k = idx & 255, d = n / RW, ch = n % RW, kb = k >> 6, kk = k & 63;
        float v = 0.f;
        if (kb == d) v = (d < 2) ? P.in[15][(size_t)(d * 64 + kk) * RW + ch] : P.in[17][(size_t)((d - 2) * 64 + kk) * RW + ch];
        LB[idx] = (bf16)f2bf(v);
    }
    float* RC = (float*)(ws + WS_ROPE); float* RS = RC + SEQ * 32;
    for (int idx = gt; idx < SEQ * 32; idx += NGT) {
        const int pos = idx >> 5, i = idx & 31;
        const float inv = __builtin_exp2f(-(float)i * (13.287712379549449f / 32.f));
        const float ang = (float)pos * inv;
        double rv = (double)ang * 0.15915494309189535; rv -= __builtin_floor(rv);
        const float r = (float)rv;
        RC[idx] = __builtin_amdgcn_cosf(r); RS[idx] = __builtin_amdgcn_sinf(r);
    }
}

__device__ __forceinline__ void p2_lora_in(const Params& P, LAS unsigned char* lds) {
    const bf16* PRE = (const bf16*)(P.ws + WS_PRE); bf16* LIN = (bf16*)((unsigned char*)P.out + DO_LIN); const float* mu = P.in[10];
    const int gt = blockIdx.x * NTHREADS + pg8::mk_tid(lds), NGT = gridDim.x * NTHREADS;
    for (int idx = gt; idx < M_TOK * 32; idx += NGT) {
        const int m = idx >> 5, j = (idx & 31) * 8, t = m & (SEQ - 1);
        const bf16* p = PRE + (size_t)m * NPRE + C_LORA + j;
        const v4u z4 = (v4u){0u, 0u, 0u, 0u};
        const v4u c = *(const v4u*)p, pv = (t > 0) ? *(const v4u*)(p - NPRE) : z4, nx = (t < SEQ - 1) ? *(const v4u*)(p + NPRE) : z4;
        const f32x4 m0 = *(const f32x4*)(mu + 2304 + j), m1 = *(const f32x4*)(mu + 2304 + j + 4);
        float xc[8], xp[8], xn[8], s[8]; unpack8(c, xc); unpack8(pv, xp); unpack8(nx, xn);
#pragma unroll
        for (int i = 0; i < 8; ++i) { const float mm = (i < 4) ? m0[i & 3] : m1[i & 3]; s[i] = xc[i] + mm * (0.5f * (xp[i] + xn[i]) - xc[i]);
            if (j < 128) s[i] = 1.f - 2.f * __builtin_amdgcn_rcpf(__expf(2.f * s[i]) + 1.f); }
        v4u o; o.x = pk2(s[0], s[1]); o.y = pk2(s[2], s[3]); o.z = pk2(s[4], s[5]); o.w = pk2(s[6], s[7]);
        *(v4u*)(LIN + (size_t)m * 256 + j) = o;
    }
}

constexpr int SC_CH = 32, SC_REC = 1536, SC_BUF = SC_CH * SC_REC, SC_SCAL = 2 * SC_BUF;
template <int MODE> __device__ __forceinline__ void scan_block(const Params& P, int sid, LAS unsigned char* lds) {
    const int tid = pg8::mk_tid(lds), lane = tid & 63, wave = __builtin_amdgcn_readfirstlane(tid >> 6);
    const int b = sid / 24, rem = sid % 24, h = rem >> 1, dir = rem & 1;
    const bf16* PRE = (const bf16*)(P.ws + WS_PRE); const bf16* EA = (const bf16*)((unsigned char*)P.out + DO_EA);
    bf16* YO = dir ? (bf16*)(P.ws + WS_YB) : (bf16*)((unsigned char*)P.out + DO_YF);
    constexpr int NCH = SEQ / SC_CH;
#define SC_BAR() do { asm volatile("s_waitcnt lgkmcnt(0)" ::: "memory"); __builtin_amdgcn_s_barrier(); asm volatile("" ::: "memory"); } while (0)
    if (wave >= 4) {
        const int pt = tid - 256, sl = pt >> 3, e = pt & 7, ch0 = h * 64 + 8 * e;
        float mur[8], muk[8], muv[8], kkc[8], kac[8];
#pragma unroll
        for (int i = 0; i < 8; ++i) { mur[i] = P.in[10][ch0 + i]; muk[i] = P.in[10][768 + ch0 + i]; muv[i] = P.in[10][1536 + ch0 + i]; kkc[i] = P.in[11][ch0 + i]; kac[i] = P.in[12][ch0 + i]; }
        v4u rc, kc, vc, rp, kp, vp, rn, kn, vn, e8, a8;
        const v4u z4 = (v4u){0u, 0u, 0u, 0u};
#define SC_PLOAD(c_) do { const int step_ = (c_) * SC_CH + sl, t_ = dir ? (SEQ - 1 - step_) : step_; const size_t m_ = (size_t)b * SEQ + t_; \
            const bf16* rowp_ = PRE + m_ * NPRE + C_RS + ch0; \
            rc = *(const v4u*)(rowp_); kc = *(const v4u*)(rowp_ + 768); vc = *(const v4u*)(rowp_ + 1536); \
            rp = (t_ > 0) ? *(const v4u*)(rowp_ - NPRE) : z4; kp = (t_ > 0) ? *(const v4u*)(rowp_ - NPRE + 768) : z4; vp = (t_ > 0) ? *(const v4u*)(rowp_ - NPRE + 1536) : z4; \
            rn = (t_ < SEQ - 1) ? *(const v4u*)(rowp_ + NPRE) : z4; kn = (t_ < SEQ - 1) ? *(const v4u*)(rowp_ + NPRE + 768) : z4; vn = (t_ < SEQ - 1) ? *(const v4u*)(rowp_ + NPRE + 1536) : z4; \
            const bf16* eap_ = EA + m_ * NLORA + dir * RW + ch0; e8 = *(const v4u*)(eap_); a8 = *(const v4u*)(eap_ + 1536); } while (0)
#define SC_PWRITE(c_) do { LAS unsigned char* buf_ = lds + ((c_) & 1) * SC_BUF; LAS float* scal_ = (LAS float*)(lds + SC_SCAL) + ((c_) & 1) * (SC_CH * 2); \
            float r[8], k[8], v[8], x0[8], x1[8], x2[8]; \
            unpack8(rc, x0); unpack8(rp, x1); unpack8(rn, x2); \
            _Pragma("unroll") for (int i = 0; i < 8; ++i) r[i] = x0[i] + mur[i] * (0.5f * (x1[i] + x2[i]) - x0[i]); \
            unpack8(kc, x0); unpack8(kp, x1); unpack8(kn, x2); \
            _Pragma("unroll") for (int i = 0; i < 8; ++i) k[i] = x0[i] + muk[i] * (0.5f * (x1[i] + x2[i]) - x0[i]); \
            unpack8(vc, x0); unpack8(vp, x1); unpack8(vn, x2); \
            _Pragma("unroll") for (int i = 0; i < 8; ++i) v[i] = x0[i] + muv[i] * (0.5f * (x1[i] + x2[i]) - x0[i]); \
            float ee[8], aa[8]; unpack8(e8, ee); unpack8(a8, aa); \
            float kk[8], ss = 0.f; \
            _Pragma("unroll") for (int i = 0; i < 8; ++i) { kk[i] = k[i] * kkc[i]; ss += kk[i] * kk[i]; } \
            ss = red8(ss); \
            const float inv = 1.f / fmaxf(sqrtf(ss), 1e-12f); \
            float nkk[8], dd[8], dr[8], bb[8], kd[8], sbr = 0.f, skr = 0.f; \
            _Pragma("unroll") for (int i = 0; i < 8; ++i) { \
                const float kki = kk[i] * inv; nkk[i] = -kki; dd[i] = __expf(-ee[i]); dr[i] = dd[i] * r[i]; \
                bb[i] = kki * aa[i]; kd[i] = k[i] * (1.f + (aa[i] - 1.f) * kac[i]); sbr += bb[i] * r[i]; skr += kd[i] * r[i]; } \
            sbr = red8(sbr); skr = red8(skr); \
            LAS float* rec = (LAS float*)(buf_ + sl * SC_REC) + 8 * e; \
            *(LAS f32x4*)(rec) = (f32x4){nkk[0], nkk[1], nkk[2], nkk[3]}; *(LAS f32x4*)(rec + 4) = (f32x4){nkk[4], nkk[5], nkk[6], nkk[7]}; \
            *(LAS f32x4*)(rec + 64) = (f32x4){dr[0], dr[1], dr[2], dr[3]}; *(LAS f32x4*)(rec + 68) = (f32x4){dr[4], dr[5], dr[6], dr[7]}; \
            *(LAS f32x4*)(rec + 128) = (f32x4){dd[0], dd[1], dd[2], dd[3]}; *(LAS f32x4*)(rec + 132) = (f32x4){dd[4], dd[5], dd[6], dd[7]}; \
            *(LAS f32x4*)(rec + 192) = (f32x4){bb[0], bb[1], bb[2], bb[3]}; *(LAS f32x4*)(rec + 196) = (f32x4){bb[4], bb[5], bb[6], bb[7]}; \
            *(LAS f32x4*)(rec + 256) = (f32x4){kd[0], kd[1], kd[2], kd[3]}; *(LAS f32x4*)(rec + 260) = (f32x4){kd[4], kd[5], kd[6], kd[7]}; \
            *(LAS f32x4*)(rec + 320) = (f32x4){v[0], v[1], v[2], v[3]}; *(LAS f32x4*)(rec + 324) = (f32x4){v[4], v[5], v[6], v[7]}; \
            if (e == 0) *(LAS f32x2*)(scal_ + 2 * sl) = (f32x2){sbr, skr}; } while (0)
        if (!(MODE & 2)) { SC_PLOAD(0); SC_PWRITE(0); SC_PLOAD(1); }
        SC_BAR();
        for (int c = 0; c < NCH; ++c) {
            if (!(MODE & 2)) { if (c + 1 < NCH) SC_PWRITE(c + 1);
            if (c + 2 < NCH) SC_PLOAD(c + 2); }
            SC_BAR();
        }
#undef SC_PLOAD
#undef SC_PWRITE
    } else {
        const int rp = (wave * 64 + lane) >> 3, cgp = lane & 7;
        f32x2 s0[4], s1[4];
#pragma unroll
        for (int i = 0; i < 4; ++i) { s0[i] = (f32x2){0.f, 0.f}; s1[i] = (f32x2){0.f, 0.f}; }
        bf16* yrow = YO + (size_t)b * SEQ * RW + h * 64 + 2 * rp;
        SC_BAR();
#define SC_LOAD(N0, N1, Q0, Q1, D0, D1, B0, B1, K0, K1, VV, SS, sl_) do { const LAS float* rec_ = (const LAS float*)(buf + (sl_) * SC_REC) + 8 * cgp; \
            N0 = *(const LAS f32x4*)(rec_); N1 = *(const LAS f32x4*)(rec_ + 4); Q0 = *(const LAS f32x4*)(rec_ + 64); Q1 = *(const LAS f32x4*)(rec_ + 68); \
            D0 = *(const LAS f32x4*)(rec_ + 128); D1 = *(const LAS f32x4*)(rec_ + 132); B0 = *(const LAS f32x4*)(rec_ + 192); B1 = *(const LAS f32x4*)(rec_ + 196); \
            K0 = *(const LAS f32x4*)(rec_ + 256); K1 = *(const LAS f32x4*)(rec_ + 260); \
            VV = *(const LAS f32x2*)((const LAS float*)(buf + (sl_) * SC_REC) + 320 + 2 * rp); SS = *(const LAS f32x2*)(scal + 2 * (sl_)); } while (0)
        for (int c = 0; c < NCH; ++c) {
            const LAS unsigned char* buf = lds + (c & 1) * SC_BUF; const LAS float* scal = (const LAS float*)(lds + SC_SCAL) + (c & 1) * (SC_CH * 2);
            f32x4 n0, n1, q0, q1, d0, d1, b0, b1, k0, k1; f32x2 vv, sc;
            SC_LOAD(n0, n1, q0, q1, d0, d1, b0, b1, k0, k1, vv, sc, 0);
#pragma unroll 2
            for (int sl = 0; sl < SC_CH; ++sl) {
                f32x4 xn0, xn1, xq0, xq1, xd0, xd1, xb0, xb1, xk0, xk1; f32x2 xvv, xsc;
                const int sn = (sl + 1 < SC_CH) ? sl + 1 : sl;
                const f32x2 nk[4] = {(f32x2){n0.x, n0.y}, (f32x2){n0.z, n0.w}, (f32x2){n1.x, n1.y}, (f32x2){n1.z, n1.w}};
                const f32x2 qq[4] = {(f32x2){q0.x, q0.y}, (f32x2){q0.z, q0.w}, (f32x2){q1.x, q1.y}, (f32x2){q1.z, q1.w}};
                const f32x2 dv[4] = {(f32x2){d0.x, d0.y}, (f32x2){d0.z, d0.w}, (f32x2){d1.x, d1.y}, (f32x2){d1.z, d1.w}};
                const f32x2 bv[4] = {(f32x2){b0.x, b0.y}, (f32x2){b0.z, b0.w}, (f32x2){b1.x, b1.y}, (f32x2){b1.z, b1.w}};
                const f32x2 kv[4] = {(f32x2){k0.x, k0.y}, (f32x2){k0.z, k0.w}, (f32x2){k1.x, k1.y}, (f32x2){k1.z, k1.w}};
                f32x2 a0 = s0[0] * nk[0], a1 = s1[0] * nk[0], y0 = s0[0] * qq[0], y1 = s1[0] * qq[0];
#pragma unroll
                for (int i = 1; i < 4; ++i) { a0 = s0[i] * nk[i] + a0; a1 = s1[i] * nk[i] + a1; y0 = s0[i] * qq[i] + y0; y1 = s1[i] * qq[i] + y1; }
                float sa0 = a0.x + a0.y, sa1 = a1.x + a1.y, yp0 = y0.x + y0.y, yp1 = y1.x + y1.y;
                SC_LOAD(xn0, xn1, xq0, xq1, xd0, xd1, xb0, xb1, xk0, xk1, xvv, xsc, sn);
                sa0 = red8(sa0); sa1 = red8(sa1); yp0 = red8(yp0); yp1 = red8(yp1);
                const float yo0 = yp0 + sa0 * sc.x + vv.x * sc.y, yo1 = yp1 + sa1 * sc.x + vv.y * sc.y;
                const f32x2 sa0v = (f32x2){sa0, sa0}, sa1v = (f32x2){sa1, sa1}, v0v = (f32x2){vv.x, vv.x}, v1v = (f32x2){vv.y, vv.y};
#pragma unroll
                for (int i = 0; i < 4; ++i) {
                    f32x2 t0 = v0v * kv[i]; t0 = sa0v * bv[i] + t0; s0[i] = s0[i] * dv[i] + t0;
                    f32x2 t1 = v1v * kv[i]; t1 = sa1v * bv[i] + t1; s1[i] = s1[i] * dv[i] + t1;
                }
                const int step = c * SC_CH + sl, t = dir ? (SEQ - 1 - step) : step;
                const unsigned yw = pk2(yo0, yo1);
                if (!(MODE & 1)) { if (cgp == 0) *(unsigned*)(yrow + (size_t)t * RW) = yw; } else { asm volatile("" :: "v"(yw)); }
                n0 = xn0; n1 = xn1; q0 = xq0; q1 = xq1; d0 = xd0; d1 = xd1; b0 = xb0; b1 = xb1; k0 = xk0; k1 = xk1; vv = xvv; sc = xsc;
            }
            SC_BAR();
        }
#undef SC_LOAD
    }
#undef SC_BAR
    __syncthreads();
}

__device__ __forceinline__ bf16x8 pack8(const float (&x)[8]) {
    v4u w; w.x = pk2(x[0], x[1]); w.y = pk2(x[2], x[3]); w.z = pk2(x[4], x[5]); w.w = pk2(x[6], x[7]); return __builtin_bit_cast(bf16x8, w);
}
#define MFMA16(a, b, c) __builtin_amdgcn_mfma_f32_16x16x32_bf16((a), (b), (c), 0, 0, 0)
constexpr int CK = 16, NCK = SEQ / CK;
constexpr int L_QK = 0, L_PR = 4608, L_QKT = 9216, L_VT = 14336, L_VF = 19456, L_GC = 23552, L_OPSZ = 23808;
constexpr int L_E = 2 * L_OPSZ, L_G = L_E + 4096, L_GSZ = 5120, L_W0 = L_G + 2 * L_GSZ, L_VG = L_W0 + 4096, L_SB = L_VG + 2 * 4096, L_CEND = L_SB + 9216;
static_assert(L_CEND + 1280 <= 131072, "chunked scan LDS map");
#ifdef CBAR_FULL
#define CBAR() __syncthreads()
#else
#define CBAR() do { asm volatile("s_waitcnt lgkmcnt(0)" ::: "memory"); __builtin_amdgcn_s_barrier(); asm volatile("" ::: "memory"); } while (0)
#endif
__device__ __forceinline__ void scan_chunked(const Params& P, int sid, LAS unsigned char* lds) {
    const int tid = pg8::mk_tid(lds), lane = tid & 63, wave = __builtin_amdgcn_readfirstlane(tid >> 6), l15 = lane & 15, q4 = lane >> 4;
    const int b = sid / 24, rem = sid % 24, h = rem >> 1, dir = rem & 1;
    const bf16* PRE = (const bf16*)(P.ws + WS_PRE); const bf16* EA = (const bf16*)((unsigned char*)P.out + DO_EA);
    bf16* YO = dir ? (bf16*)(P.ws + WS_YB) : (bf16*)((unsigned char*)P.out + DO_YF);
#ifdef YZERO
    for (int it = tid; it < SEQ * 8; it += NTHREADS) *(v4u*)(YO + ((size_t)b * SEQ + (it >> 3)) * RW + h * 64 + (it & 7) * 8) = (v4u){0u, 0u, 0u, 0u};
#endif
    for (int i = tid; i < 9216 / 4; i += NTHREADS) ((LAS unsigned*)(lds + L_SB))[i] = 0u;
    for (int i = tid; i < L_SB / 4; i += NTHREADS) ((LAS unsigned*)(lds))[i] = 0u;
    if (tid < 320) { const int vsel = tid >> 6, chn = h * 64 + (tid & 63);
        ((LAS float*)(lds + L_CEND))[tid] = (vsel < 3) ? P.in[10][vsel * 768 + chn] : ((vsel == 3) ? P.in[11][chn] : P.in[12][chn]); }
    CBAR();
    if (wave >= 6) {
        const int pt = tid - 384, t = pt >> 3, e = pt & 7, ch0 = h * 64 + 8 * e;
        const LAS float* cst = (const LAS float*)(lds + L_CEND) + 8 * e;
#define CK_CST(dst, sel) do { const f32x4 c0_ = *(const LAS f32x4*)(cst + (sel) * 64), c1_ = *(const LAS f32x4*)(cst + (sel) * 64 + 4); \
            dst[0] = c0_.x; dst[1] = c0_.y; dst[2] = c0_.z; dst[3] = c0_.w; dst[4] = c1_.x; dst[5] = c1_.y; dst[6] = c1_.z; dst[7] = c1_.w; } while (0)
        v4u rcA, kcA, vcA, rpA, kpA, vpA, rnA, knA, vnA, e8A, a8A, rcB, kcB, vcB, rpB, kpB, vpB, rnB, knB, vnB, e8B, a8B;
        const v4u z4 = (v4u){0u, 0u, 0u, 0u};
#define CK_PLOAD(X, c_) do { const int step_ = (c_) * CK + t, t_ = dir ? (SEQ - 1 - step_) : step_; const size_t m_ = (size_t)b * SEQ + t_; \
            const bf16* rowp_ = PRE + m_ * NPRE + C_RS + ch0; \
            rc##X = *(const v4u*)(rowp_); kc##X = *(const v4u*)(rowp_ + 768); vc##X = *(const v4u*)(rowp_ + 1536); \
            rp##X = (t_ > 0) ? *(const v4u*)(rowp_ - NPRE) : z4; kp##X = (t_ > 0) ? *(const v4u*)(rowp_ - NPRE + 768) : z4; vp##X = (t_ > 0) ? *(const v4u*)(rowp_ - NPRE + 1536) : z4; \
            rn##X = (t_ < SEQ - 1) ? *(const v4u*)(rowp_ + NPRE) : z4; kn##X = (t_ < SEQ - 1) ? *(const v4u*)(rowp_ + NPRE + 768) : z4; vn##X = (t_ < SEQ - 1) ? *(const v4u*)(rowp_ + NPRE + 1536) : z4; \
            const bf16* eap_ = EA + m_ * NLORA + dir * RW + ch0; e8##X = *(const v4u*)(eap_); a8##X = *(const v4u*)(eap_ + 1536); } while (0)
        CK_PLOAD(A, 0); CK_PLOAD(B, 1);
        float r[8], k[8], v[8], kk[8], aa[8], ee[8];
#define CK_PBODY(X, c_) do { const int c = (c_); const int pb = (c & 1) * L_OPSZ; \
            if (c < NCK) { \
                float x0[8], x1[8], x2[8], cc[8]; \
                unpack8(rc##X, x0); unpack8(rp##X, x1); unpack8(rn##X, x2); CK_CST(cc, 0); \
                _Pragma("unroll") for (int i = 0; i < 8; ++i) r[i] = x0[i] + cc[i] * (0.5f * (x1[i] + x2[i]) - x0[i]); \
                unpack8(kc##X, x0); unpack8(kp##X, x1); unpack8(kn##X, x2); CK_CST(cc, 1); \
                _Pragma("unroll") for (int i = 0; i < 8; ++i) k[i] = x0[i] + cc[i] * (0.5f * (x1[i] + x2[i]) - x0[i]); \
                unpack8(vc##X, x0); unpack8(vp##X, x1); unpack8(vn##X, x2); CK_CST(cc, 2); \
                _Pragma("unroll") for (int i = 0; i < 8; ++i) v[i] = x0[i] + cc[i] * (0.5f * (x1[i] + x2[i]) - x0[i]); \
                unpack8(e8##X, ee); unpack8(a8##X, aa); CK_CST(cc, 3); \
                float ss = 0.f; \
                _Pragma("unroll") for (int i = 0; i < 8; ++i) { kk[i] = k[i] * cc[i]; ss += kk[i] * kk[i]; } \
                ss = red8(ss); \
                const float inv = 1.f / fmaxf(sqrtf(ss), 1e-12f); \
                _Pragma("unroll") for (int i = 0; i < 8; ++i) kk[i] *= inv; \
                LAS float* ep = (LAS float*)(lds + L_E) + t * 64 + 8 * e; \
                *(LAS f32x4*)(ep) = (f32x4){ee[0], ee[1], ee[2], ee[3]}; *(LAS f32x4*)(ep + 4) = (f32x4){ee[4], ee[5], ee[6], ee[7]}; \
                if (c + 2 < NCK) CK_PLOAD(X, c + 2); \
            } \
            CBAR(); \
            if (c < NCK) { \
                float gs[8]; \
                _Pragma("unroll") for (int i = 0; i < 8; ++i) gs[i] = 0.f; \
                _Pragma("unroll") for (int u = 0; u < CK; ++u) { \
                    const LAS float* ep = (const LAS float*)(lds + L_E) + u * 64 + 8 * e; \
                    const f32x4 ea = *(const LAS f32x4*)(ep), eb = *(const LAS f32x4*)(ep + 4); \
                    const float m = (u <= t) ? 1.f : 0.f; \
                    gs[0] += m * ea.x; gs[1] += m * ea.y; gs[2] += m * ea.z; gs[3] += m * ea.w; gs[4] += m * eb.x; gs[5] += m * eb.y; gs[6] += m * eb.z; gs[7] += m * eb.w; \
                } \
                float qv[8], kt[8], pv[8], rt[8], gin[8], kac[8]; CK_CST(kac, 4); \
                _Pragma("unroll") for (int i = 0; i < 8; ++i) { \
                    gin[i] = __expf(-gs[i]); const float gex = __expf(ee[i] - gs[i]), ginv = __expf(gs[i]); \
                    const float kd = k[i] * (1.f + (aa[i] - 1.f) * kac[i]); \
                    qv[i] = kk[i] * aa[i] * ginv; kt[i] = kd * ginv; pv[i] = kk[i] * gex; rt[i] = r[i] * gin[i]; \
                } \
                LAS unsigned char* ob = lds + pb; \
                *(LAS bf16x8*)(ob + L_QK + (t * 72 + 8 * e) * 2) = pack8(qv); *(LAS bf16x8*)(ob + L_QK + ((16 + t) * 72 + 8 * e) * 2) = pack8(kt); \
                *(LAS bf16x8*)(ob + L_PR + (t * 72 + 8 * e) * 2) = pack8(pv); *(LAS bf16x8*)(ob + L_PR + ((16 + t) * 72 + 8 * e) * 2) = pack8(rt); \
                _Pragma("unroll") for (int i = 0; i < 8; ++i) { \
                    *(LAS bf16*)(ob + L_QKT + ((8 * e + i) * 40 + t) * 2) = (bf16)f2bf(qv[i]); *(LAS bf16*)(ob + L_QKT + ((8 * e + i) * 40 + 16 + t) * 2) = (bf16)f2bf(kt[i]); \
                    *(LAS bf16*)(ob + L_VT + ((8 * e + i) * 40 + 16 + t) * 2) = (bf16)f2bf(v[i]); \
                } \
                LAS float* vf = (LAS float*)(ob + L_VF) + t * 64 + 8 * e; \
                *(LAS f32x4*)(vf) = (f32x4){v[0], v[1], v[2], v[3]}; *(LAS f32x4*)(vf + 4) = (f32x4){v[4], v[5], v[6], v[7]}; \
                if (t == CK - 1) { LAS float* gc = (LAS float*)(ob + L_GC) + 8 * e; *(LAS f32x4*)(gc) = (f32x4){gin[0], gin[1], gin[2], gin[3]}; *(LAS f32x4*)(gc + 4) = (f32x4){gin[4], gin[5], gin[6], gin[7]}; } \
            } \
            CBAR(); \
            CBAR(); } while (0)
        static_assert((NCK + 2) % 2 == 0, "producer loop is unrolled by two");
        for (int c2 = 0; c2 <= NCK + 1; c2 += 2) { CK_PBODY(A, c2); CK_PBODY(B, c2 + 1); }
#undef CK_PBODY
#undef CK_CST
#undef CK_PLOAD
    } else if (wave == 4) {
        for (int c0 = 0; c0 <= NCK + 1; ++c0) {
            const int c = c0 - 1;
            if (c >= 0 && c < NCK) {
                const int pb = (c & 1) * L_OPSZ, gb = L_G + (c & 1) * L_GSZ;
#pragma unroll
                for (int x = 0; x < 4; ++x) {
                    const int a = x >> 1, bc = x & 1;
                    f32x4 g = (f32x4){0.f, 0.f, 0.f, 0.f};
#pragma unroll
                    for (int ks = 0; ks < 2; ++ks) {
                        const bf16x8 A = *(const LAS bf16x8*)(lds + pb + L_QK + ((a * 16 + l15) * 72 + ks * 32 + 8 * q4) * 2);
                        const bf16x8 Bm = *(const LAS bf16x8*)(lds + pb + L_PR + ((bc * 16 + l15) * 72 + ks * 32 + 8 * q4) * 2);
                        g = MFMA16(A, Bm, g);
                    }
                    *(LAS f32x4*)(lds + gb + x * 1280 + (l15 * 20 + 4 * q4) * 4) = g;
                }
                asm volatile("s_waitcnt lgkmcnt(0)" ::: "memory");
                float bw[8];
                {
                    const f32x4 ga = *(const LAS f32x4*)(lds + gb + 2 * 1280 + (l15 * 20 + 8 * (q4 & 1)) * 4), gb2 = *(const LAS f32x4*)(lds + gb + 2 * 1280 + (l15 * 20 + 8 * (q4 & 1) + 4) * 4);
#pragma unroll
                    for (int ii = 0; ii < 8; ++ii) { const int s = 8 * (q4 & 1) + ii; const float gv = (ii < 4) ? ga[ii & 3] : gb2[ii & 3]; bw[ii] = (q4 >= 2 && s < l15) ? gv : 0.f; }
                }
                const bf16x8 Bf = pack8(bw);
#pragma unroll
                for (int mt = 0; mt < 4; ++mt) {
                    const bf16x8 Av = *(const LAS bf16x8*)(lds + pb + L_VT + ((mt * 16 + l15) * 40 + 8 * q4) * 2);
                    f32x4 r = (f32x4){0.f, 0.f, 0.f, 0.f};
                    r = MFMA16(Av, Bf, r);
                    *(LAS f32x4*)(lds + L_VG + (c & 1) * 4096 + (l15 * 64 + mt * 16 + 4 * q4) * 4) = r;
                }
            }
            CBAR();
            CBAR();
            CBAR();
        }
    } else if (wave < 4) {
        const int w = wave;
        f32x4 acc[4];
#pragma unroll
        for (int nt = 0; nt < 4; ++nt) acc[nt] = (f32x4){0.f, 0.f, 0.f, 0.f};
        bf16* ybase = YO + (size_t)b * SEQ * RW + h * 64 + 16 * w + 4 * q4;
        for (int c = 0; c <= NCK + 1; ++c) {
            const int ck = c - 1; const bool valid = (ck >= 0 && ck < NCK);
            const int pb = (ck & 1) * L_OPSZ, gb = L_G + (ck & 1) * L_GSZ;
            f32x4 r1 = (f32x4){0.f, 0.f, 0.f, 0.f};
            if (valid) {
                f32x4 r0 = (f32x4){0.f, 0.f, 0.f, 0.f};
#pragma unroll
                for (int ks = 0; ks < 2; ++ks) {
                    const bf16x8 S = *(const LAS bf16x8*)(lds + L_SB + ((16 * w + l15) * 72 + ks * 32 + 8 * q4) * 2);
                    const bf16x8 Bp = *(const LAS bf16x8*)(lds + pb + L_PR + ((l15) * 72 + ks * 32 + 8 * q4) * 2);
                    const bf16x8 Br = *(const LAS bf16x8*)(lds + pb + L_PR + ((16 + l15) * 72 + ks * 32 + 8 * q4) * 2);
                    r0 = MFMA16(S, Bp, r0); r1 = MFMA16(S, Br, r1);
                }
                *(LAS f32x4*)(lds + L_W0 + (l15 * 64 + 16 * w + 4 * q4) * 4) = r0;
            }
            CBAR();
            if (valid && w == 0) {
                const int i = lane;
                float u[16];
#pragma unroll
                for (int s = 0; s < 16; ++s) u[s] = *(const LAS float*)(lds + L_W0 + (s * 64 + i) * 4) + *(const LAS float*)(lds + L_VG + (ck & 1) * 4096 + (s * 64 + i) * 4);
#pragma unroll
                for (int blk = 0; blk < 4; ++blk) {
                    f32x4 gq[4][4];
#pragma unroll
                    for (int tt = 0; tt < 4; ++tt)
#pragma unroll
                        for (int s4 = 0; s4 <= blk; ++s4) gq[tt][s4] = *(const LAS f32x4*)(lds + gb + 0 * 1280 + ((4 * blk + tt) * 20 + 4 * s4) * 4);
#pragma unroll
                    for (int s = 0; s < 4 * blk; ++s)
#pragma unroll
                        for (int tt = 0; tt < 4; ++tt) u[4 * blk + tt] -= gq[tt][s >> 2][s & 3] * u[s];
#pragma unroll
                    for (int tt = 1; tt < 4; ++tt)
#pragma unroll
                        for (int sp = 0; sp < tt; ++sp) u[4 * blk + tt] -= gq[tt][blk][sp] * u[4 * blk + sp];
                    __builtin_amdgcn_sched_barrier(0);
                }
                float n0[8], n1[8];
#pragma unroll
                for (int s = 0; s < 8; ++s) { n0[s] = -u[s]; n1[s] = -u[8 + s]; }
                *(LAS bf16x8*)(lds + pb + L_VT + (i * 40) * 2) = pack8(n0); *(LAS bf16x8*)(lds + pb + L_VT + (i * 40 + 8) * 2) = pack8(n1);
            }
            CBAR();
            if (valid) {
                const bf16x8 Bv = *(const LAS bf16x8*)(lds + pb + L_VT + ((16 * w + l15) * 40 + 8 * q4) * 2);
                {
                    const int xo = (q4 < 2) ? 1 : 3;
                    const f32x4 ga = *(const LAS f32x4*)(lds + gb + xo * 1280 + (l15 * 20 + 8 * (q4 & 1)) * 4), gb2 = *(const LAS f32x4*)(lds + gb + xo * 1280 + (l15 * 20 + 8 * (q4 & 1) + 4) * 4);
                    float bw[8];
#pragma unroll
                    for (int ii = 0; ii < 8; ++ii) { const int s = 8 * (q4 & 1) + ii; const float gv = (ii < 4) ? ga[ii & 3] : gb2[ii & 3]; bw[ii] = (s <= l15) ? gv : 0.f; }
                    const f32x4 y = MFMA16(Bv, pack8(bw), r1);
                    const int step = ck * CK + l15, tt = dir ? (SEQ - 1 - step) : step;
                    v2u o; o.x = pk2(y[0], y[1]); o.y = pk2(y[2], y[3]);
                    *(v2u*)(ybase + (size_t)tt * RW) = o;
                }
#pragma unroll
                for (int nt = 0; nt < 4; ++nt) {
                    const bf16x8 Aq = *(const LAS bf16x8*)(lds + pb + L_QKT + ((nt * 16 + l15) * 40 + 8 * q4) * 2);
                    acc[nt] = MFMA16(Aq, Bv, acc[nt]);
                    const f32x4 gc = *(const LAS f32x4*)(lds + pb + L_GC + (nt * 16 + 4 * q4) * 4);
                    acc[nt] = acc[nt] * gc;
                    v2u o; o.x = pk2(acc[nt][0], acc[nt][1]); o.y = pk2(acc[nt][2], acc[nt][3]);
                    *(LAS v2u*)(lds + L_SB + ((16 * w + l15) * 72 + nt * 16 + 4 * q4) * 2) = o;
                }
            }
            CBAR();
        }
    } else {
        for (int c = 0; c <= NCK + 1; ++c) { CBAR(); CBAR(); CBAR(); }
    }
    __syncthreads();
}
#undef CBAR

constexpr int KA_P = 72, VA_P = 392;
__device__ __forceinline__ void attnA_item(const Params& P, int item, LAS unsigned char* lds) {
    const int tid = pg8::mk_tid(lds), lane = tid & 63, wave = __builtin_amdgcn_readfirstlane(tid >> 6), l15 = lane & 15, q4 = lane >> 4;
    const int b = item >> 6, n = (item >> 2) & 15, hk = item & 3;
    const bf16* PRE = (const bf16*)(P.ws + WS_PRE); bf16* YC = (bf16*)(P.ws + WS_YCAT);
    const float* RC = (const float*)(P.ws + WS_ROPE); const float* RS = RC + SEQ * 32;
    LAS bf16* Ks = (LAS bf16*)lds; LAS bf16* Vt = Ks + 384 * KA_P;
    {
        v2u klo[6], khi[6]; f32x4 kcs[6], ksn[6]; v4u vw[6];
#pragma unroll
        for (int u = 0; u < 6; ++u) {
            const int it = tid + u * NTHREADS, j = it >> 3, c = it & 7, kp = (n - 1) * 128 + j;
            const bool ok = (kp >= 0 && kp < SEQ); const int kpc = ok ? kp : 0;
            const bf16* src = PRE + ((size_t)b * SEQ + kpc) * NPRE + C_AK + hk * 64;
            klo[u] = *(const v2u*)(src + 4 * c); khi[u] = *(const v2u*)(src + 32 + 4 * c);
            kcs[u] = *(const f32x4*)(RC + kpc * 32 + 4 * c); ksn[u] = *(const f32x4*)(RS + kpc * 32 + 4 * c);
            vw[u] = *(const v4u*)(PRE + ((size_t)b * SEQ + kpc) * NPRE + C_AV + hk * 64 + 8 * c);
        }
        const f32x4 g1 = *(const f32x4*)(P.in[7] + 4 * (tid & 7)), g2 = *(const f32x4*)(P.in[7] + 32 + 4 * (tid & 7));
#pragma unroll
        for (int u = 0; u < 6; ++u) {
            const int it = tid + u * NTHREADS, j = it >> 3, c = it & 7, kp = (n - 1) * 128 + j;
            const bool ok = (kp >= 0 && kp < SEQ);
            float x1[4], x2[4]; unpack4(klo[u], x1); unpack4(khi[u], x2);
            float ss = 0.f;
#pragma unroll
            for (int i = 0; i < 4; ++i) ss += x1[i] * x1[i] + x2[i] * x2[i];
            ss = red8(ss);
            const float rstd = ok ? 1.f / sqrtf(ss * (1.f / 64.f) + NORM_EPS) : 0.f;
            float r1[4], r2[4];
#pragma unroll
            for (int i = 0; i < 4; ++i) { const float y1 = x1[i] * rstd * g1[i], y2 = x2[i] * rstd * g2[i]; r1[i] = y1 * kcs[u][i] - y2 * ksn[u][i]; r2[i] = y2 * kcs[u][i] + y1 * ksn[u][i]; }
            v2u o0, o1; o0.x = pk2(r1[0], r1[1]); o0.y = pk2(r1[2], r1[3]); o1.x = pk2(r2[0], r2[1]); o1.y = pk2(r2[2], r2[3]);
            *(LAS v2u*)(Ks + j * KA_P + 4 * c) = o0; *(LAS v2u*)(Ks + j * KA_P + 32 + 4 * c) = o1;
            const v4u w = ok ? vw[u] : (v4u){0u, 0u, 0u, 0u};
            LAS bf16* d = Vt + (8 * c) * VA_P + j;
            d[0] = (bf16)(w.x & 0xffffu); d[VA_P] = (bf16)(w.x >> 16); d[2 * VA_P] = (bf16)(w.y & 0xffffu); d[3 * VA_P] = (bf16)(w.y >> 16);
            d[4 * VA_P] = (bf16)(w.z & 0xffffu); d[5 * VA_P] = (bf16)(w.z >> 16); d[6 * VA_P] = (bf16)(w.w & 0xffffu); d[7 * VA_P] = (bf16)(w.w >> 16);
        }
    }
    v4u qlo, qhi;
    {
        const int R0 = wave * 48, g = R0 >> 7, pos = (R0 & 127) + l15, qp = n * 128 + pos, hq = hk * 3 + g;
        const bf16* src = PRE + ((size_t)b * SEQ + qp) * NPRE + C_AQ + hq * 64;
        qlo = *(const v4u*)(src + 8 * q4); qhi = *(const v4u*)(src + 32 + 8 * q4);
    }
    __syncthreads();
#pragma unroll 1
    for (int mt = 0; mt < 3; ++mt) {
        const int R0 = wave * 48 + mt * 16, g = R0 >> 7, pos = (R0 & 127) + l15, qp = n * 128 + pos, hq = hk * 3 + g;
        const size_t m = (size_t)b * SEQ + qp;
        v2u gat[4];
#pragma unroll
        for (int dt = 0; dt < 4; ++dt) gat[dt] = *(const v2u*)(PRE + m * NPRE + C_AG + hq * 64 + dt * 16 + 4 * q4);
        const v4u cqlo = qlo, cqhi = qhi;
        {
            const int mn = (mt < 2) ? mt + 1 : 2, R1 = wave * 48 + mn * 16, g1_ = R1 >> 7, pos1 = (R1 & 127) + l15, qp1 = n * 128 + pos1, hq1 = hk * 3 + g1_;
            const bf16* src = PRE + ((size_t)b * SEQ + qp1) * NPRE + C_AQ + hq1 * 64;
            qlo = *(const v4u*)(src + 8 * q4); qhi = *(const v4u*)(src + 32 + 8 * q4);
        }
        bf16x8 qf0, qf1;
        {
            float x1[8], x2[8]; unpack8(cqlo, x1); unpack8(cqhi, x2);
            float ss = 0.f;
#pragma unroll
            for (int i = 0; i < 8; ++i) ss += x1[i] * x1[i] + x2[i] * x2[i];
            ss += __shfl_xor(ss, 16); ss += __shfl_xor(ss, 32);
            const float rstd = (0.125f * 1.4426950408889634f) / sqrtf(ss * (1.f / 64.f) + NORM_EPS);
            float r1[8], r2[8];
            const f32x4 ga = *(const f32x4*)(P.in[6] + 8 * q4), gb = *(const f32x4*)(P.in[6] + 8 * q4 + 4), gc = *(const f32x4*)(P.in[6] + 32 + 8 * q4), gd = *(const f32x4*)(P.in[6] + 36 + 8 * q4);
            const f32x4 ca = *(const f32x4*)(RC + qp * 32 + 8 * q4), cb = *(const f32x4*)(RC + qp * 32 + 8 * q4 + 4), sa_ = *(const f32x4*)(RS + qp * 32 + 8 * q4), sb_ = *(const f32x4*)(RS + qp * 32 + 8 * q4 + 4);
#pragma unroll
            for (int i = 0; i < 8; ++i) {
                const float g1 = (i < 4) ? ga[i & 3] : gb[i & 3], g2 = (i < 4) ? gc[i & 3] : gd[i & 3], cs = (i < 4) ? ca[i & 3] : cb[i & 3], sn = (i < 4) ? sa_[i & 3] : sb_[i & 3];
                const float y1 = x1[i] * rstd * g1, y2 = x2[i] * rstd * g2; r1[i] = y1 * cs - y2 * sn; r2[i] = y2 * cs + y1 * sn;
            }
            qf0 = pack8(r1); qf1 = pack8(r2);
        }
        const int kt0 = (R0 & 127) >> 4;
        const int seq_lo = (n == 0) ? 8 : 0, seq_hi = (n == 15) ? 15 : 23;
        f32x4 acc[18];
#pragma unroll
        for (int u = 0; u < 17; ++u) {
            const LAS bf16* kr = Ks + ((kt0 + u) * 16 + l15) * KA_P + 8 * q4;
            const bf16x8 k0 = *(const LAS bf16x8*)(kr), k1 = *(const LAS bf16x8*)(kr + 32);
            f32x4 a = (f32x4){0.f, 0.f, 0.f, 0.f};
            a = MFMA16(k0, qf0, a); a = MFMA16(k1, qf1, a); acc[u] = a;
        }
        acc[17] = (f32x4){-1e30f, -1e30f, -1e30f, -1e30f};
        const float sink = P.in[8][hq] * 1.4426950408889634f;
        float mx = sink;
#pragma unroll
        for (int u = 0; u < 17; ++u) {
            const bool tv = (kt0 + u >= seq_lo) && (kt0 + u <= seq_hi);
#pragma unroll
            for (int i = 0; i < 4; ++i) {
                bool valid = tv;
                if (u == 0) valid = valid && (4 * q4 + i >= l15);
                if (u == 16) valid = valid && (4 * q4 + i <= l15);
                const float sv = valid ? acc[u][i] : -1e30f; acc[u][i] = sv; mx = fmaxf(mx, sv);
            }
        }
        mx = fmaxf(mx, __shfl_xor(mx, 16)); mx = fmaxf(mx, __shfl_xor(mx, 32));
        float sum = 0.f;
#pragma unroll
        for (int u = 0; u < 17; ++u)
#pragma unroll
            for (int i = 0; i < 4; ++i) { const float p = __builtin_amdgcn_exp2f(acc[u][i] - mx); acc[u][i] = p; sum += p; }
        acc[17] = (f32x4){0.f, 0.f, 0.f, 0.f};
        sum += __shfl_xor(sum, 16); sum += __shfl_xor(sum, 32);
        const float inv = 1.f / (sum + __builtin_amdgcn_exp2f(sink - mx));
        f32x4 o[4];
#pragma unroll
        for (int dt = 0; dt < 4; ++dt) o[dt] = (f32x4){0.f, 0.f, 0.f, 0.f};
#pragma unroll
        for (int k2 = 0; k2 < 9; ++k2) {
            float pp[8] = {acc[2 * k2][0], acc[2 * k2][1], acc[2 * k2][2], acc[2 * k2][3], acc[2 * k2 + 1][0], acc[2 * k2 + 1][1], acc[2 * k2 + 1][2], acc[2 * k2 + 1][3]};
            const bf16x8 pf = pack8(pp);
#pragma unroll
            for (int dt = 0; dt < 4; ++dt) {
                const LAS bf16* vr = Vt + (dt * 16 + l15) * VA_P + kt0 * 16 + k2 * 32 + 4 * q4;
                const v2u v0 = *(const LAS v2u*)(vr);
                v2u v1 = (v2u){0u, 0u};
                if (k2 < 8) v1 = *(const LAS v2u*)(vr + 16);
                const v4u vw = (v4u){v0.x, v0.y, v1.x, v1.y};
                o[dt] = MFMA16(__builtin_bit_cast(bf16x8, vw), pf, o[dt]);
            }
        }
#pragma unroll
        for (int dt = 0; dt < 4; ++dt) {
            const int ch = hq * 64 + dt * 16 + 4 * q4;
            float gg[4]; unpack4(gat[dt], gg);
            v2u w; w.x = pk2(o[dt][0] * inv * gg[0], o[dt][1] * inv * gg[1]); w.y = pk2(o[dt][2] * inv * gg[2], o[dt][3] * inv * gg[3]);
            *(v2u*)(YC + m * DM + ch) = w;
        }
    }
    __syncthreads();
}

constexpr int KC_P = 136, VC_P = 264;
__device__ __forceinline__ void attnC_item(const Params& P, int item, LAS unsigned char* lds) {
    const int tid = pg8::mk_tid(lds), lane = tid & 63, wave = __builtin_amdgcn_readfirstlane(tid >> 6), l15 = lane & 15, q4 = lane >> 4;
    const int b = item >> 6, qb = (item >> 2) & 15, hx = item & 3;
    const bf16* PRE = (const bf16*)(P.ws + WS_PRE); const bf16* MKV = (const bf16*)(P.ws + WS_MKV); bf16* YC = (bf16*)(P.ws + WS_YCAT);
    LAS bf16* Ks = (LAS bf16*)lds; LAS bf16* Vt = Ks + 256 * KC_P;
    const int q = qb * 128 + wave * 16 + l15; const size_t m = (size_t)b * SEQ + q;
    {
        v4u kw[8], vw[8];
#pragma unroll
        for (int u = 0; u < 8; ++u) {
            const int it = tid + u * NTHREADS, j = it >> 4, c = it & 15;
            const bf16* src = MKV + ((size_t)b * NMEM + j) * 1024 + hx * 128 + 8 * c;
            kw[u] = *(const v4u*)(src); vw[u] = *(const v4u*)(src + 512);
        }
        const f32x4 g0 = *(const f32x4*)(P.in[23] + 8 * (tid & 15)), g1 = *(const f32x4*)(P.in[23] + 8 * (tid & 15) + 4);
#pragma unroll
        for (int u = 0; u < 8; ++u) {
            const int it = tid + u * NTHREADS, j = it >> 4, c = it & 15;
            float x[8]; unpack8(kw[u], x);
            float ss = 0.f;
#pragma unroll
            for (int i = 0; i < 8; ++i) ss += x[i] * x[i];
            ss = red8(ss); ss = dpp_add<0x140>(ss);
            const float rstd = 1.f / sqrtf(ss * (1.f / 128.f) + NORM_EPS);
            v4u o; o.x = pk2(x[0] * rstd * g0.x, x[1] * rstd * g0.y); o.y = pk2(x[2] * rstd * g0.z, x[3] * rstd * g0.w);
            o.z = pk2(x[4] * rstd * g1.x, x[5] * rstd * g1.y); o.w = pk2(x[6] * rstd * g1.z, x[7] * rstd * g1.w);
            *(LAS v4u*)(Ks + j * KC_P + 8 * c) = o;
            const v4u w = vw[u];
            LAS bf16* d = Vt + (8 * c) * VC_P + j;
            d[0] = (bf16)(w.x & 0xffffu); d[VC_P] = (bf16)(w.x >> 16); d[2 * VC_P] = (bf16)(w.y & 0xffffu); d[3 * VC_P] = (bf16)(w.y >> 16);
            d[4 * VC_P] = (bf16)(w.z & 0xffffu); d[5 * VC_P] = (bf16)(w.z >> 16); d[6 * VC_P] = (bf16)(w.w & 0xffffu); d[7 * VC_P] = (bf16)(w.w >> 16);
        }
    }
    v4u qraw[4]; v2u gat[8];
    {
        const bf16* src = PRE + m * NPRE + C_XQ + hx * 128 + 8 * q4;
#pragma unroll
        for (int ks = 0; ks < 4; ++ks) qraw[ks] = *(const v4u*)(src + ks * 32);
#pragma unroll
        for (int dt = 0; dt < 8; ++dt) gat[dt] = *(const v2u*)(PRE + m * NPRE + C_XG + hx * 128 + dt * 16 + 4 * q4);
    }
    __syncthreads();
    {
        bf16x8 qf[4];
        {
            float x[4][8]; float ss = 0.f;
#pragma unroll
            for (int ks = 0; ks < 4; ++ks) { unpack8(qraw[ks], x[ks]);
#pragma unroll
                for (int i = 0; i < 8; ++i) ss += x[ks][i] * x[ks][i]; }
            ss += __shfl_xor(ss, 16); ss += __shfl_xor(ss, 32);
            const float rstd = (0.08838834764831845f * 1.4426950408889634f) / sqrtf(ss * (1.f / 128.f) + NORM_EPS);
#pragma unroll
            for (int ks = 0; ks < 4; ++ks) { float y[8];
                const f32x4 ga = *(const f32x4*)(P.in[22] + ks * 32 + 8 * q4), gb = *(const f32x4*)(P.in[22] + ks * 32 + 8 * q4 + 4);
#pragma unroll
                for (int i = 0; i < 8; ++i) y[i] = x[ks][i] * rstd * ((i < 4) ? ga[i & 3] : gb[i & 3]);
                qf[ks] = pack8(y); }
        }
        f32x4 acc[16];
#pragma unroll
        for (int kt = 0; kt < 16; ++kt) {
            const LAS bf16* kr = Ks + (kt * 16 + l15) * KC_P + 8 * q4;
            f32x4 a = (f32x4){0.f, 0.f, 0.f, 0.f};
#pragma unroll
            for (int ks = 0; ks < 4; ++ks) a = MFMA16(*(const LAS bf16x8*)(kr + ks * 32), qf[ks], a);
            acc[kt] = a;
        }
        float mx = -1e30f;
#pragma unroll
        for (int kt = 0; kt < 16; ++kt)
#pragma unroll
            for (int i = 0; i < 4; ++i) mx = fmaxf(mx, acc[kt][i]);
        mx = fmaxf(mx, __shfl_xor(mx, 16)); mx = fmaxf(mx, __shfl_xor(mx, 32));
        float sum = 0.f;
#pragma unroll
        for (int kt = 0; kt < 16; ++kt)
#pragma unroll
            for (int i = 0; i < 4; ++i) { const float p = __builtin_amdgcn_exp2f(acc[kt][i] - mx); acc[kt][i] = p; sum += p; }
        sum += __shfl_xor(sum, 16); sum += __shfl_xor(sum, 32);
        const float inv = 1.f / sum;
        f32x4 o[8];
#pragma unroll
        for (int dt = 0; dt < 8; ++dt) o[dt] = (f32x4){0.f, 0.f, 0.f, 0.f};
#pragma unroll
        for (int k2 = 0; k2 < 8; ++k2) {
            float pp[8] = {acc[2 * k2][0], acc[2 * k2][1], acc[2 * k2][2], acc[2 * k2][3], acc[2 * k2 + 1][0], acc[2 * k2 + 1][1], acc[2 * k2 + 1][2], acc[2 * k2 + 1][3]};
            const bf16x8 pf = pack8(pp);
#pragma unroll
            for (int dt = 0; dt < 8; ++dt) {
                const LAS bf16* vr = Vt + (dt * 16 + l15) * VC_P + k2 * 32 + 4 * q4;
                const v2u v0 = *(const LAS v2u*)(vr), v1 = *(const LAS v2u*)(vr + 16);
                const v4u vw = (v4u){v0.x, v0.y, v1.x, v1.y};
                o[dt] = MFMA16(__builtin_bit_cast(bf16x8, vw), pf, o[dt]);
            }
        }
#pragma unroll
        for (int dt = 0; dt < 8; ++dt) {
            const int ch = hx * 128 + dt * 16 + 4 * q4;
            float gg[4]; unpack4(gat[dt], gg);
            v2u w; w.x = pk2(o[dt][0] * inv * gg[0], o[dt][1] * inv * gg[1]); w.y = pk2(o[dt][2] * inv * gg[2], o[dt][3] * inv * gg[3]);
            *(v2u*)(YC + m * DM + 1536 + ch) = w;
        }
    }
    __syncthreads();
}

__device__ __forceinline__ void p5_rwkv_post(const Params& P, LAS unsigned char* lds) {
    const bf16* PRE = (const bf16*)(P.ws + WS_PRE); const bf16* EA = (const bf16*)((unsigned char*)P.out + DO_EA);
    const bf16* YF = (const bf16*)((unsigned char*)P.out + DO_YF); const bf16* YB = (const bf16*)(P.ws + WS_YB); bf16* YC = (bf16*)(P.ws + WS_YCAT);
    const float* mu = P.in[10];
    const int gt = blockIdx.x * NTHREADS + pg8::mk_tid(lds), NGT = gridDim.x * NTHREADS;
    for (int idx = gt; idx < M_TOK * 96; idx += NGT) {
        const int m = idx / 96, he = idx - m * 96, ch0 = he * 8, t = m & (SEQ - 1);
        const bf16* p = PRE + (size_t)m * NPRE + C_RS + ch0;
        const v4u z4 = (v4u){0u, 0u, 0u, 0u};
        const bool hp = t > 0, hn = t < SEQ - 1;
        const v4u rc = *(const v4u*)(p), kc = *(const v4u*)(p + 768), vc = *(const v4u*)(p + 1536);
        const v4u rp = hp ? *(const v4u*)(p - NPRE) : z4, kp = hp ? *(const v4u*)(p - NPRE + 768) : z4, vp = hp ? *(const v4u*)(p - NPRE + 1536) : z4;
        const v4u rn = hn ? *(const v4u*)(p + NPRE) : z4, kn = hn ? *(const v4u*)(p + NPRE + 768) : z4, vn = hn ? *(const v4u*)(p + NPRE + 1536) : z4;
        const v4u af8 = *(const v4u*)(EA + (size_t)m * NLORA + 1536 + ch0), ab8 = *(const v4u*)(EA + (size_t)m * NLORA + 2304 + ch0);
        const v4u yf8 = *(const v4u*)(YF + (size_t)m * RW + ch0), yb8 = *(const v4u*)(YB + (size_t)m * RW + ch0);
        const v4u rg8 = *(const v4u*)(PRE + (size_t)m * NPRE + C_RG + ch0);
        float r[8], k[8], v[8], x0[8], x1[8], x2[8];
        unpack8(rc, x0); unpack8(rp, x1); unpack8(rn, x2);
#pragma unroll
        for (int i = 0; i < 8; ++i) r[i] = x0[i] + mu[ch0 + i] * (0.5f * (x1[i] + x2[i]) - x0[i]);
        unpack8(kc, x0); unpack8(kp, x1); unpack8(kn, x2);
#pragma unroll
        for (int i = 0; i < 8; ++i) k[i] = x0[i] + mu[768 + ch0 + i] * (0.5f * (x1[i] + x2[i]) - x0[i]);
        unpack8(vc, x0); unpack8(vp, x1); unpack8(vn, x2);
#pragma unroll
        for (int i = 0; i < 8; ++i) v[i] = x0[i] + mu[1536 + ch0 + i] * (0.5f * (x1[i] + x2[i]) - x0[i]);
        float af[8], ab[8], ys[8], yb[8], rg[8]; unpack8(af8, af); unpack8(ab8, ab); unpack8(yf8, ys); unpack8(yb8, yb); unpack8(rg8, rg);
        float bs = 0.f, sm = 0.f;
#pragma unroll
        for (int i = 0; i < 8; ++i) { const float kds = k[i] * (2.f + (af[i] + ab[i] - 2.f) * P.in[12][ch0 + i]); bs += r[i] * kds * P.in[13][ch0 + i]; ys[i] += yb[i]; sm += ys[i]; }
        bs = red8(bs); sm = red8(sm);
        const float mean = sm * (1.f / 64.f);
        float vs = 0.f;
#pragma unroll
        for (int i = 0; i < 8; ++i) { ys[i] -= mean; vs += ys[i] * ys[i]; }
        vs = red8(vs);
        const float rstd = 1.f / sqrtf(vs * (1.f / 64.f) + GN_EPS);
        float o[8];
#pragma unroll
        for (int i = 0; i < 8; ++i) o[i] = (ys[i] * rstd * P.in[18][ch0 + i] + P.in[19][ch0 + i] + bs * v[i]) * rg[i];
        v4u w; w.x = pk2(o[0], o[1]); w.y = pk2(o[2], o[3]); w.z = pk2(o[4], o[5]); w.w = pk2(o[6], o[7]);
        *(v4u*)(YC + (size_t)m * DM + 768 + ch0) = w;
    }
}

constexpr int N_PHASES = 8;
__global__ void __launch_bounds__(NTHREADS, 2) hybrid_fwd(Params P) {
    extern __shared__ __attribute__((aligned(16))) unsigned char lds_raw[];
    LAS unsigned char* lds = (LAS unsigned char*)lds_raw;
    cg::grid_group grid = cg::this_grid();
    const int lo = P.ph_lo, hi = P.ph_hi, G = gridDim.x;
    if ((threadIdx.x & 63) == 0) *(volatile LAS int*)(lds + pg8::TIDTAB_OFF + 4 * pg8::hw_slot()) = (int)(threadIdx.x >> 6);
    __syncthreads();
    unsigned char* ws = P.ws; unsigned char* dob = (unsigned char*)P.out;
#ifdef PHMASK
#define IN(k) (((PHMASK >> (k)) & 1) && lo <= (k) && (k) < hi)
#else
#define IN(k) (lo <= (k) && (k) < hi)
#endif
#define SEAM(k) do { if (IN(k) && IN((k) + 1)) grid.sync(); } while (0)
#ifndef REPEAT_MASK
#define REPEAT_MASK 0
#endif
#define REP(k) for (int rep_ = 0; rep_ < (((REPEAT_MASK >> (k)) & 1) ? 2 : 1); ++rep_)
#define REPSYNC() do { if (rep_) grid.sync(); } while (0)
    if (IN(0)) REP(0) { REPSYNC(); p0_prologue(P, lds, P.out); __syncthreads(); }
    SEAM(0);
    if (IN(1)) REP(1) { REPSYNC();
        { pg8::Gemm g{(const bf16*)(dob + DO_H), (const bf16*)(dob + DO_WIN), M_TOK, NIN, DM}; pg8::StaticOrder S; S.init(M_TOK, NIN, G, (int)blockIdx.x);
          EpiProj E{(bf16*)(ws + WS_PRE), (bf16*)(ws + WS_GATES), P.in[5]};
          pg8::gemm_phase<EpiProj, pg8::StaticOrder, true, true>(lds, g, S, E); }
        { pg8::Gemm g{(const bf16*)(ws + WS_MEMN), (const bf16*)(ws + WS_WXKV), MEMROWS, 1024, DM}; pg8::StaticOrder S; S.init(MEMROWS, 1024, G, (int)((blockIdx.x + G - 64) % G));
          EpiPlain E{(bf16*)(ws + WS_MKV), 1024};
          pg8::gemm_phase<EpiPlain, pg8::StaticOrder, true, true>(lds, g, S, E); }
    }
    SEAM(1);
    if (IN(2)) REP(2) { REPSYNC(); p2_lora_in(P, lds); }
    SEAM(2);
    if (IN(3)) REP(3) { REPSYNC();
        int klora = 256; asm volatile("" : "+s"(klora));
        pg8::Gemm g{(const bf16*)(dob + DO_LIN), (const bf16*)(ws + WS_LORAB), M_TOK, NLORA, klora}; pg8::StaticOrder S; S.init(M_TOK, NLORA, G, (int)blockIdx.x);
        EpiLora E{(bf16*)(dob + DO_EA), P.in[14], P.in[16]};
        pg8::gemm_phase<EpiLora, pg8::StaticOrder, true, true>(lds, g, S, E);
    }
    SEAM(3);
    if (IN(4)) REP(4) { REPSYNC();
        const int bid = blockIdx.x;
#ifndef STATIC_ATT
#define STATIC_ATT 0
#endif
        if (bid < 192) scan_chunked(P, bid, lds);
        if (STATIC_ATT) {
            if (bid >= 192) { for (int it = bid - 192; it < 1024; it += G - 192) { if (it < 512) attnA_item(P, it, lds); else attnC_item(P, it - 512, lds); } }
        } else {
            volatile LAS int* slot = (volatile LAS int*)(lds + pg8::TIDTAB_OFF - 64);
            const int tid4 = pg8::mk_tid(lds);
            for (;;) {
                if (tid4 == 0) *slot = (int)__hip_atomic_fetch_add((unsigned*)(ws + WS_CTR), 1u, __ATOMIC_RELAXED, __HIP_MEMORY_SCOPE_AGENT);
                __syncthreads();
                const int it = *slot;
                __syncthreads();
                if (it >= 1024) break;
                if (it < 512) attnA_item(P, it, lds); else attnC_item(P, it - 512, lds);
            }
        }
    }
    SEAM(4);
    if (IN(5)) REP(5) { REPSYNC(); p5_rwkv_post(P, lds); }
    SEAM(5);
    if (IN(6)) REP(6) { REPSYNC();
        pg8::Gemm g{(const bf16*)(ws + WS_YCAT), (const bf16*)(ws + WS_WCAT), M_TOK, DM, DM}; pg8::StaticOrder S; S.init(M_TOK, DM, G, (int)blockIdx.x);
        EpiMerged E{(bf16*)(ws + WS_MERGED), (const bf16*)(ws + WS_GATES)};
        pg8::gemm_phase<EpiMerged, pg8::StaticOrder, true, true>(lds, g, S, E);
    }
    SEAM(6);
    if (IN(7)) REP(7) { REPSYNC();
        pg8::Gemm g{(const bf16*)(ws + WS_MERGED), (const bf16*)(ws + WS_WOUT), M_TOK, DM, DM}; pg8::StaticOrder S; S.init(M_TOK, DM, G, (int)blockIdx.x);
        EpiOut E{P.out, P.in[0]};
        pg8::gemm_phase<EpiOut, pg8::StaticOrder, true, true>(lds, g, S, E);
    }
#undef IN
#undef SEAM
}

#ifndef ONE_LAUNCH
#define ONE_LAUNCH 1
#endif
extern "C" void kernel_launch(void* const* d_in, const int* in_sizes, int n_in, void* d_out, int out_size, void* d_ws, size_t ws_size, hipStream_t stream) {
    static int grid = 0;
    if (grid == 0) {
        if (n_in != 26 || out_size != M_TOK * DM || ws_size < WS_END) { fprintf(stderr, "kernel_launch: unexpected shapes (n_in %d, out %d, ws %zu); nothing launched\n", n_in, out_size, ws_size); grid = -1; return; }
        int dev = 0, cus = 0, per_cu = 0;
        hipGetDevice(&dev); hipDeviceGetAttribute(&cus, hipDeviceAttributeMultiprocessorCount, dev);
        if (hipFuncSetAttribute((const void*)hybrid_fwd, hipFuncAttributeMaxDynamicSharedMemorySize, LDS_BYTES) != hipSuccess) { fprintf(stderr, "kernel_launch: hipFuncSetAttribute failed\n"); grid = -1; return; }
        hipOccupancyMaxActiveBlocksPerMultiprocessor(&per_cu, (const void*)hybrid_fwd, NTHREADS, LDS_BYTES);
        (void)hipGetLastError();
        if (per_cu < 1) per_cu = 1;
        grid = cus * per_cu; if (grid > 256) grid = 256;
        if (grid < 200) { fprintf(stderr, "kernel_launch: grid %d too small for the scan/attention split\n", grid); grid = -1; return; }
    }
    if (grid < 0) return;
    Params p{};
    for (int i = 0; i < 26; ++i) p.in[i] = (const float*)d_in[i];
    p.out = (float*)d_out; p.ws = (unsigned char*)d_ws;
#if ONE_LAUNCH
    p.ph_lo = 0; p.ph_hi = N_PHASES;
    void* args[] = {&p};
    hipError_t e = hipLaunchCooperativeKernel((const void*)hybrid_fwd, dim3(grid), dim3(NTHREADS), args, LDS_BYTES, stream);
    if (e != hipSuccess) fprintf(stderr, "cooperative launch failed: %s (grid %d)\n", hipGetErrorString(e), grid);
#else
    for (int ph = 0; ph < N_PHASES; ++ph) {
        p.ph_lo = ph; p.ph_hi = ph + 1;
        hipLaunchKernelGGL(hybrid_fwd, dim3(grid), dim3(NTHREADS), LDS_BYTES, stream, p);
    }
#endif
}
```

```cpp
#include <hip/hip_runtime.h>
#include <hip/hip_cooperative_groups.h>
#include <cstdio>
#include <cstdint>
namespace cg = cooperative_groups;
namespace pg8 {
#define PG8_LAS __attribute__((address_space(3)))
typedef unsigned short bf16_t;
typedef short bf16x8 __attribute__((ext_vector_type(8)));
typedef float f32x4 __attribute__((ext_vector_type(4)));
typedef unsigned u32x4 __attribute__((ext_vector_type(4)));
constexpr int BM = 256, BK = 64, HALF = 128, HTB = HALF * BK * 2  , STAGE_BYTES = 8 * HTB, NXCD = 8, WGM = 8;

__host__ __device__ __forceinline__ int lds_byte(int r, int c) { const int st = (r >> 4) * 2 + (c >> 5), rr = r & 15, cc = c & 31, ob = rr * 64 + cc * 2; return st * 1024 + (ob ^ (((ob >> 9) & 1) << 5)); }
__host__ __device__ __forceinline__ void stage_rc(int b, int& R, int& C) { const int st = b / 1024, sb = b % 1024, swz = sb ^ (((sb >> 9) & 1) << 5); R = (st >> 1) * 16 + swz / 64; C = (st & 1) * 32 + (swz % 64) / 2; }
__host__ __device__ __forceinline__ int perm32(int rho) { const int n = rho >> 4, i = rho & 15; return 8 * (i >> 2) + 4 * n + (i & 3); }


constexpr int TIDTAB_OFF = 147200;
__device__ __forceinline__ int hw_slot() { return (int)(__builtin_amdgcn_s_getreg((5 << 11) | 4) & 63u); }
__device__ __forceinline__ int mk_tid(PG8_LAS unsigned char* lds) {
    const int lane = (int)__builtin_amdgcn_mbcnt_hi(~0u, __builtin_amdgcn_mbcnt_lo(~0u, 0u));
    const int w = __builtin_amdgcn_readfirstlane(*(volatile PG8_LAS int*)(lds + TIDTAB_OFF + 4 * hw_slot()));
    return w * 64 + lane;
}
struct Unit { int pm, pn; };
struct Gemm { const bf16_t* A; const bf16_t* Bt; int M, N, K; };

struct StaticOrder {
    int nM, nN, nwg, G, c;
    __host__ __device__ void init(int M, int N, int G_, int c_) { nM = M / BM; nN = N / BM; nwg = nM * nN; G = G_; c = c_; }
    __host__ __device__ bool next(int i, Unit& u) const {
        const long L = (long)i * G + c; if (L >= nwg) return false;
        int wgid = (int)L; { const int q = nwg / NXCD, r = nwg % NXCD, xcd = wgid % NXCD, off = wgid / NXCD; wgid = (xcd < r ? xcd * (q + 1) : r * (q + 1) + (xcd - r) * q) + off; }
        const int nig = WGM * nN, gid = wgid / nig, fm = gid * WGM, gsz = (nM - fm) < WGM ? (nM - fm) : WGM;
        u.pm = fm + ((wgid % nig) % gsz); u.pn = (wgid % nig) / gsz; return true;
    }
    __device__ __forceinline__ void a_ready(const Unit&) const {}
    __device__ __forceinline__ void done(const Unit&) const {}
};

__device__ __forceinline__ unsigned cvt_pk_bf16(float lo, float hi) { unsigned r; asm volatile("v_cvt_pk_bf16_f32 %0, %1, %2" : "=v"(r) : "v"(lo), "v"(hi)); return r; }
template <class Epi, class Sched, bool ALIGN_EPI = false, bool SP2 = false>
__device__ __forceinline__ void gemm_phase(PG8_LAS unsigned char* lds, const Gemm g, const Sched& S, const Epi& E) {
    const int tid = mk_tid(lds), wid = __builtin_amdgcn_readfirstlane(tid >> 6), lane = tid & 63, wr = wid >> 2, wc = wid & 3, fr = lane & 15, fq = lane >> 4;
    const int K = g.K, nt = K / BK;
    unsigned voffA[2], voffB[2];
#pragma unroll
    for (int i = 0; i < 2; ++i) { int R, C; stage_rc(tid * 16 + i * 8192, R, C); const int Rb = Epi::PERM ? ((R & ~31) + perm32(R & 31)) : R;
        voffA[i] = (unsigned)(R * K + C) * 2u; voffB[i] = (unsigned)(Rb * K + C) * 2u; }
    const size_t kstep = (size_t)(BK * 2);
    const size_t hstep = (size_t)HALF * K * 2;
    const size_t tstep = 2 * hstep;
    const unsigned ldsw = (unsigned)wid * 1024u;
    const int aoff = lds_byte(wr * 64 + fr, fq * 8), boff = lds_byte(wc * 32 + fr, fq * 8);
#define PG8_SA(b, h) (((b) * 2 + (h)) * HTB)
#define PG8_SB(b, h) ((4 + (b) * 2 + (h)) * HTB)
#define PG8_STAGE(bufoff, gbase, voff) do { _Pragma("unroll") for (int _i = 0; _i < 2; ++_i) \
        __builtin_amdgcn_global_load_lds((const unsigned*)((const char*)(gbase) + (voff)[_i]), (PG8_LAS unsigned*)(lds + (bufoff) + ldsw + _i * 8192), 16, 0, 0); } while (0)
#define PG8_LDA(dst, b, h) do { _Pragma("unroll") for (int m = 0; m < 4; ++m) _Pragma("unroll") for (int k = 0; k < 2; ++k) dst[m][k] = *(const PG8_LAS bf16x8*)(lds + PG8_SA(b, h) + aoff + m * 2048 + k * 1024); } while (0)
#define PG8_LDB(dst, b, h) do { _Pragma("unroll") for (int n = 0; n < 2; ++n) _Pragma("unroll") for (int k = 0; k < 2; ++k) dst[n][k] = *(const PG8_LAS bf16x8*)(lds + PG8_SB(b, h) + boff + n * 2048 + k * 1024); } while (0)
#define PG8_MMA(ai, bj, At, Bt) do { __builtin_amdgcn_s_setprio(1); _Pragma("unroll") for (int m = 0; m < 4; ++m) _Pragma("unroll") for (int n = 0; n < 2; ++n) _Pragma("unroll") for (int k = 0; k < 2; ++k) \
        acc[ai][bj][m][n] = __builtin_amdgcn_mfma_f32_16x16x32_bf16(Bt[n][k], At[m][k], acc[ai][bj][m][n], 0, 0, 0); __builtin_amdgcn_s_setprio(0); } while (0)
#define PG8_WAIT_V(n) asm volatile("s_waitcnt vmcnt(" #n ")" ::: "memory")
#define PG8_WAIT_L(n) asm volatile("s_waitcnt lgkmcnt(" #n ")" ::: "memory")
#define PG8_BAR __builtin_amdgcn_s_barrier()
#define PG8_SCHED __builtin_amdgcn_sched_barrier(0)
    Unit cur, nxt; int ui = 0;
    if (!S.next(0, cur)) return;
    f32x4 acc[2][2][4][2];
#pragma unroll
    for (int a = 0; a < 2; ++a)
#pragma unroll
        for (int b = 0; b < 2; ++b)
#pragma unroll
            for (int m = 0; m < 4; ++m)
#pragma unroll
                for (int n = 0; n < 2; ++n) acc[a][b][m][n] = (f32x4){0.f, 0.f, 0.f, 0.f};
    bf16x8 At[4][2], B0[2][2], B1[2][2];
    const char* cA = (const char*)g.A + (size_t)cur.pm * tstep; const char* cB = (const char*)g.Bt + (size_t)cur.pn * tstep;
    S.a_ready(cur);
    if constexpr (SP2) {
        PG8_STAGE(PG8_SB(0, 0), cB, voffB); PG8_STAGE(PG8_SB(0, 1), cB + hstep, voffB); PG8_STAGE(PG8_SA(0, 0), cA, voffA); PG8_STAGE(PG8_SA(0, 1), cA + hstep, voffA);
        if (wr == 1) PG8_BAR;
        PG8_WAIT_V(2); PG8_BAR;
        PG8_STAGE(PG8_SB(1, 0), cB + kstep, voffB); PG8_STAGE(PG8_SA(1, 0), cA + kstep, voffA); PG8_STAGE(PG8_SB(1, 1), cB + hstep + kstep, voffB);
        PG8_WAIT_V(6); PG8_BAR;
    } else {
        PG8_STAGE(PG8_SB(0, 0), cB, voffB); PG8_STAGE(PG8_SA(0, 0), cA, voffA); PG8_STAGE(PG8_SB(0, 1), cB + hstep, voffB); PG8_STAGE(PG8_SA(0, 1), cA + hstep, voffA);
        if (wr == 1) PG8_BAR;
        PG8_WAIT_V(4); PG8_BAR;
        PG8_STAGE(PG8_SB(1, 0), cB + kstep, voffB); PG8_STAGE(PG8_SA(1, 0), cA + kstep, voffA); PG8_STAGE(PG8_SB(1, 1), cB + hstep + kstep, voffB);
        PG8_WAIT_V(6); PG8_BAR;
    }
    for (;;) {
        const bool has_next = S.next(ui + 1, nxt);
        const char* nA = has_next ? (const char*)g.A + (size_t)nxt.pm * tstep : cA; const char* nB = has_next ? (const char*)g.Bt + (size_t)nxt.pn * tstep : cB;
        for (int t = 0; t < nt; t += 2) {
            if constexpr (Epi::KHOOK) { if (t == Epi::HK0 || t == Epi::HK1) E.khook(acc, cur, t, wr, wc, fr, fq); }
            const bool last = (t == nt - 2);
            const char* a1 = cA + (size_t)(t + 1) * kstep;
            const char* a2 = last ? nA : cA + (size_t)(t + 2) * kstep; const char* b2 = last ? nB : cB + (size_t)(t + 2) * kstep;
            const char* a3 = a2 + kstep; const char* b3 = b2 + kstep;
            if (last && has_next) S.a_ready(nxt);
            if constexpr (SP2) {
            PG8_LDB(B0, 0, 0); PG8_LDB(B1, 0, 1); PG8_SCHED; PG8_LDA(At, 0, 0); PG8_STAGE(PG8_SA(1, 1), a1 + hstep, voffA);
            PG8_WAIT_V(8); PG8_WAIT_L(0); PG8_BAR; PG8_MMA(0, 0, At, B0); PG8_MMA(0, 1, At, B1); PG8_BAR; PG8_SCHED;
            PG8_LDA(At, 0, 1); PG8_STAGE(PG8_SB(0, 0), b2, voffB); PG8_STAGE(PG8_SB(0, 1), b2 + hstep, voffB); PG8_STAGE(PG8_SA(0, 0), a2, voffA);
            PG8_WAIT_V(8); PG8_WAIT_L(0); PG8_BAR; PG8_MMA(1, 0, At, B0); PG8_MMA(1, 1, At, B1); PG8_BAR; PG8_SCHED;
            PG8_LDB(B0, 1, 0); PG8_LDB(B1, 1, 1); PG8_SCHED; PG8_LDA(At, 1, 0); PG8_STAGE(PG8_SA(0, 1), a2 + hstep, voffA);
            PG8_WAIT_V(8); PG8_WAIT_L(0); PG8_BAR; PG8_MMA(0, 0, At, B0); PG8_MMA(0, 1, At, B1); PG8_BAR; PG8_SCHED;
            PG8_LDA(At, 1, 1); PG8_STAGE(PG8_SB(1, 0), b3, voffB); PG8_STAGE(PG8_SB(1, 1), b3 + hstep, voffB); PG8_STAGE(PG8_SA(1, 0), a3, voffA);
            PG8_WAIT_V(8); PG8_WAIT_L(0); PG8_BAR; PG8_MMA(1, 0, At, B0); PG8_MMA(1, 1, At, B1); PG8_BAR; PG8_SCHED;
            } else {
            PG8_LDB(B0, 0, 0); PG8_SCHED; PG8_LDA(At, 0, 0); PG8_STAGE(PG8_SA(1, 1), a1 + hstep, voffA);
            PG8_WAIT_L(8); PG8_BAR; PG8_WAIT_L(0); PG8_MMA(0, 0, At, B0); PG8_BAR; PG8_SCHED;
            PG8_LDB(B1, 0, 1); PG8_STAGE(PG8_SB(0, 0), b2, voffB);
            PG8_BAR; PG8_WAIT_L(0); PG8_MMA(0, 1, At, B1); PG8_BAR;
            PG8_LDA(At, 0, 1); PG8_STAGE(PG8_SA(0, 0), a2, voffA);
            PG8_BAR; PG8_WAIT_L(0); PG8_MMA(1, 0, At, B0); PG8_BAR; PG8_SCHED;
            PG8_STAGE(PG8_SB(0, 1), b2 + hstep, voffB);
            PG8_WAIT_V(6); PG8_BAR; PG8_MMA(1, 1, At, B1); PG8_BAR;
            PG8_LDB(B0, 1, 0); PG8_SCHED; PG8_LDA(At, 1, 0); PG8_STAGE(PG8_SA(0, 1), a2 + hstep, voffA);
            PG8_WAIT_L(8); PG8_BAR; PG8_WAIT_L(0); PG8_MMA(0, 0, At, B0); PG8_BAR; PG8_SCHED;
            PG8_LDB(B1, 1, 1); PG8_STAGE(PG8_SB(1, 0), b3, voffB);
            PG8_BAR; PG8_WAIT_L(0); PG8_MMA(0, 1, At, B1); PG8_BAR;
            PG8_LDA(At, 1, 1); PG8_STAGE(PG8_SA(1, 0), a3, voffA);
            PG8_BAR; PG8_WAIT_L(0); PG8_MMA(1, 0, At, B0); PG8_BAR; PG8_SCHED;
            PG8_STAGE(PG8_SB(1, 1), b3 + hstep, voffB);
            PG8_WAIT_V(6); PG8_BAR; PG8_MMA(1, 1, At, B1); PG8_BAR;
            }
        }
        if constexpr (ALIGN_EPI) { if (wr == 0) PG8_BAR; }
        if constexpr (!Epi::AFTER_DRAIN) { E(acc, cur, wr, wc, fr, fq); S.done(cur); }
        if (!has_next) break;
#pragma unroll
        for (int a = 0; a < 2; ++a)
#pragma unroll
            for (int b = 0; b < 2; ++b)
#pragma unroll
                for (int m = 0; m < 4; ++m)
#pragma unroll
                    for (int n = 0; n < 2; ++n) acc[a][b][m][n] = (f32x4){0.f, 0.f, 0.f, 0.f};
        cur = nxt; cA = nA; cB = nB; ++ui;
        if constexpr (ALIGN_EPI) { if (wr == 1) PG8_BAR; }
    }
    PG8_WAIT_V(0);
    if constexpr (!ALIGN_EPI) { if (wr == 0) PG8_BAR; }
    PG8_BAR;
    if constexpr (Epi::AFTER_DRAIN) { E.fused(acc, cur, wr, wc, fr, fq, lds, wid, lane); S.done(cur); }
#undef PG8_SA
#undef PG8_SB
#undef PG8_STAGE
#undef PG8_LDA
#undef PG8_LDB
#undef PG8_MMA
#undef PG8_WAIT_V
#undef PG8_WAIT_L
#undef PG8_BAR
#undef PG8_SCHED
}
}

#define GAS __attribute__((address_space(1)))
#define LAS __attribute__((address_space(3)))
typedef unsigned short bf16;
typedef unsigned v4u __attribute__((ext_vector_type(4)));
typedef unsigned v2u __attribute__((ext_vector_type(2)));
typedef float f32x4 __attribute__((ext_vector_type(4)));
typedef float f32x2 __attribute__((ext_vector_type(2)));
typedef short bf16x8 __attribute__((ext_vector_type(8)));
typedef short s16x4 __attribute__((ext_vector_type(4)));

constexpr int NWAVES = 8, NTHREADS = 512;
constexpr int BATCH = 8, SEQ = 2048, DM = 2048, M_TOK = BATCH * SEQ;
constexpr int NPRE = 6400, NGATE = 6144, NIN = NPRE + NGATE;
constexpr int C_AQ = 0, C_AK = 768, C_AV = 1024, C_AG = 1280, C_RS = 2048, C_RR = 2048, C_RK = 2816, C_RV = 3584, C_LORA = 4352, C_RG = 4608, C_XQ = 5376, C_XG = 5888;
constexpr int NMEM = 256, MEMROWS = BATCH * NMEM;
constexpr int RW = 768, NLORA = 3072;
constexpr float NORM_EPS = 1e-6f, GN_EPS = 64e-5f;
constexpr int LDS_BYTES = 147456;

constexpr size_t MiB = 1u << 20;
constexpr size_t WS_PRE = 0, WS_MERGED = 0, WS_GATES = 200 * MiB, WS_YCAT = 392 * MiB;
constexpr size_t WS_WCAT = 456 * MiB, WS_WOUT = 464 * MiB, WS_WXKV = 472 * MiB, WS_MKV = 476 * MiB, WS_MEMN = 480 * MiB, WS_YB = 480 * MiB;
constexpr size_t WS_ROPE = 504 * MiB, WS_LORAB = 505 * MiB, WS_END = 512 * MiB;
constexpr size_t WS_CTR = 504 * MiB + 768 * 1024;
constexpr size_t DO_H = 0, DO_WIN = 64 * MiB, DO_EA = 0, DO_LIN = 96 * MiB, DO_YF = 104 * MiB;

struct Params { const float* in[26]; float* out; unsigned char* ws; int ph_lo, ph_hi; };

__device__ __forceinline__ float bf_lo(unsigned w) { return __builtin_bit_cast(float, w << 16); }
__device__ __forceinline__ float bf_hi(unsigned w) { return __builtin_bit_cast(float, w & 0xffff0000u); }
__device__ __forceinline__ float bf1(bf16 h) { return __builtin_bit_cast(float, (unsigned)h << 16); }
__device__ __forceinline__ unsigned f2bf(float f) { unsigned u = __builtin_bit_cast(unsigned, f); return (u + 0x7fffu + ((u >> 16) & 1u)) >> 16; }
typedef __bf16 bf16x2_t __attribute__((ext_vector_type(2)));
__device__ __forceinline__ unsigned pk2(float lo, float hi) { const f32x2 v = {lo, hi}; const bf16x2_t b = __builtin_convertvector(v, bf16x2_t); return __builtin_bit_cast(unsigned, b); }
__device__ __forceinline__ float sigmoidf_(float z) { return __builtin_amdgcn_rcpf(1.f + __expf(-z)); }
__device__ __forceinline__ float siluf_(float z) { return z * sigmoidf_(z); }
__device__ __forceinline__ void unpack8(v4u w, float (&x)[8]) { x[0] = bf_lo(w.x); x[1] = bf_hi(w.x); x[2] = bf_lo(w.y); x[3] = bf_hi(w.y); x[4] = bf_lo(w.z); x[5] = bf_hi(w.z); x[6] = bf_lo(w.w); x[7] = bf_hi(w.w); }
__device__ __forceinline__ void unpack4(v2u w, float (&x)[4]) { x[0] = bf_lo(w.x); x[1] = bf_hi(w.x); x[2] = bf_lo(w.y); x[3] = bf_hi(w.y); }
__device__ __forceinline__ float fma_s(float a, float b, float c) { float r; asm("v_fma_f32 %0, %1, %2, %3" : "=v"(r) : "v"(a), "v"(b), "v"(c)); return r; }
__device__ __forceinline__ float mul_s(float a, float b) { float r; asm("v_mul_f32_e32 %0, %1, %2" : "=v"(r) : "v"(a), "v"(b)); return r; }
__device__ __forceinline__ float add_s(float a, float b) { float r; asm("v_add_f32_e32 %0, %1, %2" : "=v"(r) : "v"(a), "v"(b)); return r; }
template <int CTRL> __device__ __forceinline__ float dpp_add(float v) { return v + __builtin_bit_cast(float, __builtin_amdgcn_update_dpp(0, __builtin_bit_cast(int, v), CTRL, 0xF, 0xF, true)); }
__device__ __forceinline__ float red8(float v) { v = dpp_add<0xB1>(v); v = dpp_add<0x4E>(v); v = dpp_add<0x141>(v); return v; }

using pg8::Unit;
struct EpiProj {
    static constexpr bool PERM = true, AFTER_DRAIN = false, KHOOK = false; static constexpr int HK0 = -1, HK1 = -1;
    bf16* pre; bf16* gates; const float* gate_b;
    __device__ __forceinline__ void operator()(const f32x4 (&acc)[2][2][4][2], const Unit& u, int wr, int wc, int fr, int fq) const {
        int row0 = u.pm * 256 + wr * 64 + fr;
        asm volatile("" : "+v"(row0));
        const bool isg = u.pn >= 25;
        const int pn = isg ? u.pn - 25 : u.pn;
        bf16* base = isg ? gates : pre; const int ldc = isg ? NGATE : NPRE;
        const int act = isg ? 2 : (((pn >= 5 && pn <= 7) || (pn >= 18 && pn <= 20) || pn >= 23) ? 1 : 0);
        const int col0 = pn * 256 + wc * 32 + 8 * fq;
        f32x4 bv[2][2];
#pragma unroll
        for (int bj = 0; bj < 2; ++bj) { bv[bj][0] = isg ? *(const f32x4*)(gate_b + col0 + bj * 128) : (f32x4){0.f, 0.f, 0.f, 0.f}; bv[bj][1] = isg ? *(const f32x4*)(gate_b + col0 + bj * 128 + 4) : (f32x4){0.f, 0.f, 0.f, 0.f}; }
#pragma unroll
        for (int ai = 0; ai < 2; ++ai)
#pragma unroll
            for (int m = 0; m < 4; ++m) { bf16* rowp = base + (size_t)(row0 + ai * 128 + m * 16) * ldc + col0;
                __builtin_amdgcn_sched_barrier(0);
#pragma unroll
                for (int bj = 0; bj < 2; ++bj) { f32x4 v0 = acc[ai][bj][m][0] + bv[bj][0], v1 = acc[ai][bj][m][1] + bv[bj][1];
                    if (act == 1) {
#pragma unroll
                        for (int i = 0; i < 4; ++i) { v0[i] = siluf_(v0[i]); v1[i] = siluf_(v1[i]); }
                    } else if (act == 2) {
#pragma unroll
                        for (int i = 0; i < 4; ++i) { v0[i] = sigmoidf_(v0[i]); v1[i] = sigmoidf_(v1[i]); }
                    }
                    v4u w; w.x = pk2(v0[0], v0[1]); w.y = pk2(v0[2], v0[3]); w.z = pk2(v1[0], v1[1]); w.w = pk2(v1[2], v1[3]);
                    *(v4u*)(rowp + bj * 128) = w; } }
    }
};
struct EpiPlain {
    static constexpr bool PERM = true, AFTER_DRAIN = false, KHOOK = false; static constexpr int HK0 = -1, HK1 = -1;
    bf16* O; int ldc;
    __device__ __forceinline__ void operator()(const f32x4 (&acc)[2][2][4][2], const Unit& u, int wr, int wc, int fr, int fq) const {
        int row0 = u.pm * 256 + wr * 64 + fr, col0 = u.pn * 256 + wc * 32 + 8 * fq;
        asm volatile("" : "+v"(row0), "+v"(col0));
#pragma unroll
        for (int ai = 0; ai < 2; ++ai)
#pragma unroll
            for (int m = 0; m < 4; ++m) { bf16* rowp = O + (size_t)(row0 + ai * 128 + m * 16) * ldc + col0;
#pragma unroll
                for (int bj = 0; bj < 2; ++bj) { const f32x4 v0 = acc[ai][bj][m][0], v1 = acc[ai][bj][m][1];
                    v4u w; w.x = pk2(v0[0], v0[1]); w.y = pk2(v0[2], v0[3]); w.z = pk2(v1[0], v1[1]); w.w = pk2(v1[2], v1[3]);
                    *(v4u*)(rowp + bj * 128) = w; } }
    }
};
struct EpiLora {
    static constexpr bool PERM = true, AFTER_DRAIN = false, KHOOK = false; static constexpr int HK0 = -1, HK1 = -1;
    bf16* O; const float* w0; const float* a0;
    __device__ __forceinline__ void operator()(const f32x4 (&acc)[2][2][4][2], const Unit& u, int wr, int wc, int fr, int fq) const {
        int row0 = u.pm * 256 + wr * 64 + fr, col0 = u.pn * 256 + wc * 32 + 8 * fq;
        asm volatile("" : "+v"(row0), "+v"(col0));
        const bool isw = u.pn < 6; const float* bias = isw ? (w0 + col0) : (a0 + col0 - 1536); const float sc = isw ? 0.6065306597126334f : 1.f;
        f32x4 bv[2][2];
#pragma unroll
        for (int bj = 0; bj < 2; ++bj) { bv[bj][0] = *(const f32x4*)(bias + bj * 128); bv[bj][1] = *(const f32x4*)(bias + bj * 128 + 4); }
#pragma unroll
        for (int ai = 0; ai < 2; ++ai)
#pragma unroll
            for (int m = 0; m < 4; ++m) { bf16* rowp = O + (size_t)(row0 + ai * 128 + m * 16) * NLORA + col0;
                __builtin_amdgcn_sched_barrier(0);
#pragma unroll
                for (int bj = 0; bj < 2; ++bj) { f32x4 v0 = acc[ai][bj][m][0] + bv[bj][0], v1 = acc[ai][bj][m][1] + bv[bj][1];
#pragma unroll
                    for (int i = 0; i < 4; ++i) { v0[i] = sc * sigmoidf_(v0[i]); v1[i] = sc * sigmoidf_(v1[i]); }
                    v4u w; w.x = pk2(v0[0], v0[1]); w.y = pk2(v0[2], v0[3]); w.z = pk2(v1[0], v1[1]); w.w = pk2(v1[2], v1[3]);
                    *(v4u*)(rowp + bj * 128) = w; } }
    }
};
struct EpiMerged {
    static constexpr bool PERM = true, AFTER_DRAIN = false, KHOOK = true; static constexpr int HK0 = 12, HK1 = 24;
    bf16* O; const bf16* gates;
    __device__ __forceinline__ void khook(f32x4 (&acc)[2][2][4][2], const Unit& u, int t, int wr, int wc, int fr, int fq) const {
        int row0 = u.pm * 256 + wr * 64 + fr, col0 = u.pn * 256 + wc * 32 + 8 * fq;
        asm volatile("" : "+v"(row0), "+v"(col0));
        const int bo = (t == HK0) ? 0 : DM;
#pragma unroll
        for (int ai = 0; ai < 2; ++ai) {
            v4u ga[4][2], gb[4][2];
#pragma unroll
            for (int m = 0; m < 4; ++m) { const bf16* gp = gates + (size_t)(row0 + ai * 128 + m * 16) * NGATE + bo + col0;
#pragma unroll
                for (int bj = 0; bj < 2; ++bj) { ga[m][bj] = *(const v4u*)(gp + bj * 128); gb[m][bj] = *(const v4u*)(gp + DM + bj * 128); } }
#pragma unroll
            for (int m = 0; m < 4; ++m)
#pragma unroll
                for (int bj = 0; bj < 2; ++bj) { float x[8], y[8]; unpack8(ga[m][bj], x); unpack8(gb[m][bj], y);
#pragma unroll
                    for (int i = 0; i < 4; ++i) { acc[ai][bj][m][0][i] *= x[i] * __builtin_amdgcn_rcpf(y[i]); acc[ai][bj][m][1][i] *= x[4 + i] * __builtin_amdgcn_rcpf(y[4 + i]); } }
            __builtin_amdgcn_sched_barrier(0);
        }
    }
    __device__ __forceinline__ void operator()(const f32x4 (&acc)[2][2][4][2], const Unit& u, int wr, int wc, int fr, int fq) const {
        int row0 = u.pm * 256 + wr * 64 + fr, col0 = u.pn * 256 + wc * 32 + 8 * fq;
        asm volatile("" : "+v"(row0), "+v"(col0));
#pragma unroll
        for (int ai = 0; ai < 2; ++ai) {
            v4u gg[4][2];
#pragma unroll
            for (int m = 0; m < 4; ++m)
#pragma unroll
                for (int bj = 0; bj < 2; ++bj) gg[m][bj] = *(const v4u*)(gates + (size_t)(row0 + ai * 128 + m * 16) * NGATE + 2 * DM + col0 + bj * 128);
#pragma unroll
            for (int m = 0; m < 4; ++m) { const size_t r = (size_t)(row0 + ai * 128 + m * 16);
#pragma unroll
                for (int bj = 0; bj < 2; ++bj) { const v4u g = gg[m][bj]; float x[8]; unpack8(g, x);
                    const f32x4 v0 = acc[ai][bj][m][0], v1 = acc[ai][bj][m][1];
                    v4u w; w.x = pk2(v0[0] * x[0], v0[1] * x[1]); w.y = pk2(v0[2] * x[2], v0[3] * x[3]); w.z = pk2(v1[0] * x[4], v1[1] * x[5]); w.w = pk2(v1[2] * x[6], v1[3] * x[7]);
                    *(v4u*)(O + r * DM + col0 + bj * 128) = w; } }
            __builtin_amdgcn_sched_barrier(0);
        }
    }
};
struct EpiOut {
    static constexpr bool PERM = true, AFTER_DRAIN = false, KHOOK = false; static constexpr int HK0 = -1, HK1 = -1;
    float* O; const float* X;
    __device__ __forceinline__ void operator()(const f32x4 (&acc)[2][2][4][2], const Unit& u, int wr, int wc, int fr, int fq) const {
        int row0 = u.pm * 256 + wr * 64 + fr, col0 = u.pn * 256 + wc * 32 + 8 * fq;
        asm volatile("" : "+v"(row0), "+v"(col0));
#pragma unroll
        for (int ai = 0; ai < 2; ++ai) {
            f32x4 xa[4][2], xb[4][2];
#pragma unroll
            for (int m = 0; m < 4; ++m) { const size_t o = (size_t)(row0 + ai * 128 + m * 16) * DM + col0;
#pragma unroll
                for (int bj = 0; bj < 2; ++bj) { xa[m][bj] = *(const f32x4*)(X + o + bj * 128); xb[m][bj] = *(const f32x4*)(X + o + bj * 128 + 4); } }
#pragma unroll
            for (int m = 0; m < 4; ++m) { const size_t o = (size_t)(row0 + ai * 128 + m * 16) * DM + col0;
#pragma unroll
                for (int bj = 0; bj < 2; ++bj) { *(f32x4*)(O + o + bj * 128) = xa[m][bj] + acc[ai][bj][m][0]; *(f32x4*)(O + o + bj * 128 + 4) = xb[m][bj] + acc[ai][bj][m][1]; } }
            __builtin_amdgcn_sched_barrier(0);
        }
    }
};

__device__ __forceinline__ float wave_sum(float v) {
#pragma unroll
    for (int o = 1; o < 64; o <<= 1) v += __shfl_xor(v, o);
    return v;
}
__device__ __forceinline__ void transpose_item(const float* W, int N, bf16* WT, int ldt, int koff, LAS float* scr, int item, int lane) {
    const int nblk = N / 32, kb = item / nblk, nb = item % nblk, k0 = 64 * kb, n0 = 32 * nb;
    float tv[32];
#pragma unroll
    for (int i = 0; i < 32; ++i) { const int kk = 2 * i + (lane >> 5); tv[i] = W[(size_t)(k0 + kk) * N + n0 + (lane & 31)]; }
#pragma unroll
    for (int i = 0; i < 32; ++i) { const int kk = 2 * i + (lane >> 5); scr[kk * 33 + (lane & 31)] = tv[i]; }
    asm volatile("s_waitcnt lgkmcnt(0)" ::: "memory");
    const int c = lane & 7;
#pragma unroll
    for (int j = 0; j < 4; ++j) { const int n = (lane >> 3) + 8 * j; const LAS float* s = scr + (8 * c) * 33 + n;
        v4u o; o.x = pk2(s[0 * 33], s[1 * 33]); o.y = pk2(s[2 * 33], s[3 * 33]); o.z = pk2(s[4 * 33], s[5 * 33]); o.w = pk2(s[6 * 33], s[7 * 33]);
        *(v4u*)(WT + (size_t)(n0 + n) * ldt + koff + k0 + 8 * c) = o; }
    asm volatile("s_waitcnt lgkmcnt(0)" ::: "memory");
}
__device__ __forceinline__ void rms_row_to_bf16(const float* xrow, const float* g, bf16* orow, int lane) {
    const f32x4* xr = (const f32x4*)xrow + lane; const f32x4* gr = (const f32x4*)g + lane;
    f32x4 v[8]; float s = 0.f;
#pragma unroll
    for (int j = 0; j < 8; ++j) { v[j] = xr[64 * j]; s += (v[j].x * v[j].x + v[j].y * v[j].y) + (v[j].z * v[j].z + v[j].w * v[j].w); }
    const float rstd = 1.f / sqrtf(wave_sum(s) * (1.f / DM) + NORM_EPS);
    v2u* o8 = (v2u*)orow + lane;
#pragma unroll
    for (int j = 0; j < 8; ++j) { const f32x4 gg = gr[64 * j]; v2u o; o.x = pk2(v[j].x * rstd * gg.x, v[j].y * rstd * gg.y); o.y = pk2(v[j].z * rstd * gg.z, v[j].w * rstd * gg.w); o8[64 * j] = o; }
}
__device__ __forceinline__ void p0_prologue(const Params& P, LAS unsigned char* lds, float* dout_scratch) {
    const int tid = pg8::mk_tid(lds), lane = tid & 63, wave = tid >> 6, G = gridDim.x;
    LAS float* scr = (LAS float*)(lds + wave * 16384);
    const int gw = blockIdx.x * NWAVES + wave, NGW = G * NWAVES;
    unsigned char* ws = P.ws; unsigned char* dob = (unsigned char*)P.out;
    bf16* WIN_T = (bf16*)(dob + DO_WIN); bf16* WCAT_T = (bf16*)(ws + WS_WCAT); bf16* WOUT_T = (bf16*)(ws + WS_WOUT); bf16* WXKV_T = (bf16*)(ws + WS_WXKV);
    constexpr int I_IN = 32 * (NIN / 32), I_A = 12 * 64, I_R = 12 * 64, I_X = 8 * 64, I_O = 32 * 64, I_KV = 32 * 32;
    constexpr int NITEMS = I_IN + I_A + I_R + I_X + I_O + I_KV;
    for (int it = gw; it < NITEMS; it += NGW) {
        int r = it;
        if (r < I_IN) { transpose_item(P.in[4], NIN, WIN_T, DM, 0, scr, r, lane); continue; } r -= I_IN;
        if (r < I_A) { transpose_item(P.in[9], DM, WCAT_T, DM, 0, scr, r, lane); continue; } r -= I_A;
        if (r < I_R) { transpose_item(P.in[20], DM, WCAT_T, DM, 768, scr, r, lane); continue; } r -= I_R;
        if (r < I_X) { transpose_item(P.in[24], DM, WCAT_T, DM, 1536, scr, r, lane); continue; } r -= I_X;
        if (r < I_O) { transpose_item(P.in[25], DM, WOUT_T, DM, 0, scr, r, lane); continue; } r -= I_O;
        transpose_item(P.in[21], 1024, WXKV_T, DM, 0, scr, r, lane);
    }
    bf16* H = (bf16*)(dob + DO_H); bf16* MEMN = (bf16*)(ws + WS_MEMN);
    for (int m = gw; m < M_TOK + MEMROWS; m += NGW) {
        if (m < M_TOK) rms_row_to_bf16(P.in[0] + (size_t)m * DM, P.in[2], H + (size_t)m * DM, lane);
        else rms_row_to_bf16(P.in[1] + (size_t)(m - M_TOK) * DM, P.in[3], MEMN + (size_t)(m - M_TOK) * DM, lane);
    }
    if (blockIdx.x == 0 && tid == 0) __hip_atomic_store((unsigned*)(ws + WS_CTR), 0u, __ATOMIC_RELAXED, __HIP_MEMORY_SCOPE_AGENT);
    bf16* LB = (bf16*)(ws + WS_LORAB);
    const int gt = blockIdx.x * NTHREADS + tid, NGT = G * NTHREADS;
    for (int idx = gt; idx < NLORA * 256; idx += NGT) {
        const int n = idx >> 8, k = idx & 255, d = n / RW, ch = n % RW, kb = k >> 6, kk = k & 63;
        float v = 0.f;
        if (kb == d) v = (d < 2) ? P.in[15][(size_t)(d * 64 + kk) * RW + ch] : P.in[17][(size_t)((d - 2) * 64 + kk) * RW + ch];
        LB[idx] = (bf16)f2bf(v);
    }
    float* RC = (float*)(ws + WS_ROPE); float* RS = RC + SEQ * 32;
    for (int idx = gt; idx < SEQ * 32; idx += NGT) {
        const int pos = idx >> 5, i = idx & 31;
        const float inv = __builtin_exp2f(-(float)i * (13.287712379549449f / 32.f));
        const float ang = (float)pos * inv;
        double rv = (double)ang * 0.15915494309189535; rv -= __builtin_floor(rv);
        const float r = (float)rv;
        RC[idx] = __builtin_amdgcn_cosf(r); RS[idx] = __builtin_amdgcn_sinf(r);
    }
}

__device__ __forceinline__ void p2_lora_in(const Params& P, LAS unsigned char* lds) {
    const bf16* PRE = (const bf16*)(P.ws + WS_PRE); bf16* LIN = (bf16*)((unsigned char*)P.out + DO_LIN); const float* mu = P.in[10];
    const int gt = blockIdx.x * NTHREADS + pg8::mk_tid(lds), NGT = gridDim.x * NTHREADS;
    for (int idx = gt; idx < M_TOK * 32; idx += NGT) {
        const int m = idx >> 5, j = (idx & 31) * 8, t = m & (SEQ - 1);
        const bf16* p = PRE + (size_t)m * NPRE + C_LORA + j;
        const v4u z4 = (v4u){0u, 0u, 0u, 0u};
        const v4u c = *(const v4u*)p, pv = (t > 0) ? *(const v4u*)(p - NPRE) : z4, nx = (t < SEQ - 1) ? *(const v4u*)(p + NPRE) : z4;
        const f32x4 m0 = *(const f32x4*)(mu + 2304 + j), m1 = *(const f32x4*)(mu + 2304 + j + 4);
        float xc[8], xp[8], xn[8], s[8]; unpack8(c, xc); unpack8(pv, xp); unpack8(nx, xn);
#pragma unroll
        for (int i = 0; i < 8; ++i) { const float mm = (i < 4) ? m0[i & 3] : m1[i & 3]; s[i] = xc[i] + mm * (0.5f * (xp[i] + xn[i]) - xc[i]);
            if (j < 128) s[i] = 1.f - 2.f * __builtin_amdgcn_rcpf(__expf(2.f * s[i]) + 1.f); }
        v4u o; o.x = pk2(s[0], s[1]); o.y = pk2(s[2], s[3]); o.z = pk2(s[4], s[5]); o.w = pk2(s[6], s[7]);
        *(v4u*)(LIN + (size_t)m * 256 + j) = o;
    }
}

constexpr int SC_CH = 32, SC_REC = 1536, SC_BUF = SC_CH * SC_REC, SC_SCAL = 2 * SC_BUF;
template <int MODE> __device__ __forceinline__ void scan_block(const Params& P, int sid, LAS unsigned char* lds) {
    const int tid = pg8::mk_tid(lds), lane = tid & 63, wave = __builtin_amdgcn_readfirstlane(tid >> 6);
    const int b = sid / 24, rem = sid % 24, h = rem >> 1, dir = rem & 1;
    const bf16* PRE = (const bf16*)(P.ws + WS_PRE); const bf16* EA = (const bf16*)((unsigned char*)P.out + DO_EA);
    bf16* YO = dir ? (bf16*)(P.ws + WS_YB) : (bf16*)((unsigned char*)P.out + DO_YF);
    constexpr int NCH = SEQ / SC_CH;
#define SC_BAR() do { asm volatile("s_waitcnt lgkmcnt(0)" ::: "memory"); __builtin_amdgcn_s_barrier(); asm volatile("" ::: "memory"); } while (0)
    if (wave >= 4) {
        const int pt = tid - 256, sl = pt >> 3, e = pt & 7, ch0 = h * 64 + 8 * e;
        float mur[8], muk[8], muv[8], kkc[8], kac[8];
#pragma unroll
        for (int i = 0; i < 8; ++i) { mur[i] = P.in[10][ch0 + i]; muk[i] = P.in[10][768 + ch0 + i]; muv[i] = P.in[10][1536 + ch0 + i]; kkc[i] = P.in[11][ch0 + i]; kac[i] = P.in[12][ch0 + i]; }
        v4u rc, kc, vc, rp, kp, vp, rn, kn, vn, e8, a8;
        const v4u z4 = (v4u){0u, 0u, 0u, 0u};
#define SC_PLOAD(c_) do { const int step_ = (c_) * SC_CH + sl, t_ = dir ? (SEQ - 1 - step_) : step_; const size_t m_ = (size_t)b * SEQ + t_; \
            const bf16* rowp_ = PRE + m_ * NPRE + C_RS + ch0; \
            rc = *(const v4u*)(rowp_); kc = *(const v4u*)(rowp_ + 768); vc = *(const v4u*)(rowp_ + 1536); \
            rp = (t_ > 0) ? *(const v4u*)(rowp_ - NPRE) : z4; kp = (t_ > 0) ? *(const v4u*)(rowp_ - NPRE + 768) : z4; vp = (t_ > 0) ? *(const v4u*)(rowp_ - NPRE + 1536) : z4; \
            rn = (t_ < SEQ - 1) ? *(const v4u*)(rowp_ + NPRE) : z4; kn = (t_ < SEQ - 1) ? *(const v4u*)(rowp_ + NPRE + 768) : z4; vn = (t_ < SEQ - 1) ? *(const v4u*)(rowp_ + NPRE + 1536) : z4; \
            const bf16* eap_ = EA + m_ * NLORA + dir * RW + ch0; e8 = *(const v4u*)(eap_); a8 = *(const v4u*)(eap_ + 1536); } while (0)
#define SC_PWRITE(c_) do { LAS unsigned char* buf_ = lds + ((c_) & 1) * SC_BUF; LAS float* scal_ = (LAS float*)(lds + SC_SCAL) + ((c_) & 1) * (SC_CH * 2); \
            float r[8], k[8], v[8], x0[8], x1[8], x2[8]; \
            unpack8(rc, x0); unpack8(rp, x1); unpack8(rn, x2); \
            _Pragma("unroll") for (int i = 0; i < 8; ++i) r[i] = x0[i] + mur[i] * (0.5f * (x1[i] + x2[i]) - x0[i]); \
            unpack8(kc, x0); unpack8(kp, x1); unpack8(kn, x2); \
            _Pragma("unroll") for (int i = 0; i < 8; ++i) k[i] = x0[i] + muk[i] * (0.5f * (x1[i] + x2[i]) - x0[i]); \
            unpack8(vc, x0); unpack8(vp, x1); unpack8(vn, x2); \
            _Pragma("unroll") for (int i = 0; i < 8; ++i) v[i] = x0[i] + muv[i] * (0.5f * (x1[i] + x2[i]) - x0[i]); \
            float ee[8], aa[8]; unpack8(e8, ee); unpack8(a8, aa); \
            float kk[8], ss = 0.f; \
            _Pragma("unroll") for (int i = 0; i < 8; ++i) { kk[i] = k[i] * kkc[i]; ss += kk[i] * kk[i]; } \
            ss = red8(ss); \
            const float inv = 1.f / fmaxf(sqrtf(ss), 1e-12f); \
            float nkk[8], dd[8], dr[8], bb[8], kd[8], sbr = 0.f, skr = 0.f; \
            _Pragma("unroll") for (int i = 0; i < 8; ++i) { \
                const float kki = kk[i] * inv; nkk[i] = -kki; dd[i] = __expf(-ee[i]); dr[i] = dd[i] * r[i]; \
                bb[i] = kki * aa[i]; kd[i] = k[i] * (1.f + (aa[i] - 1.f) * kac[i]); sbr += bb[i] * r[i]; skr += kd[i] * r[i]; } \
            sbr = red8(sbr); skr = red8(skr); \
            LAS float* rec = (LAS float*)(buf_ + sl * SC_REC) + 8 * e; \
            *(LAS f32x4*)(rec) = (f32x4){nkk[0], nkk[1], nkk[2], nkk[3]}; *(LAS f32x4*)(rec + 4) = (f32x4){nkk[4], nkk[5], nkk[6], nkk[7]}; \
            *(LAS f32x4*)(rec + 64) = (f32x4){dr[0], dr[1], dr[2], dr[3]}; *(LAS f32x4*)(rec + 68) = (f32x4){dr[4], dr[5], dr[6], dr[7]}; \
            *(LAS f32x4*)(rec + 128) = (f32x4){dd[0], dd[1], dd[2], dd[3]}; *(LAS f32x4*)(rec + 132) = (f32x4){dd[4], dd[5], dd[6], dd[7]}; \
            *(LAS f32x4*)(rec + 192) = (f32x4){bb[0], bb[1], bb[2], bb[3]}; *(LAS f32x4*)(rec + 196) = (f32x4){bb[4], bb[5], bb[6], bb[7]}; \
            *(LAS f32x4*)(rec + 256) = (f32x4){kd[0], kd[1], kd[2], kd[3]}; *(LAS f32x4*)(rec + 260) = (f32x4){kd[4], kd[5], kd[6], kd[7]}; \
            *(LAS f32x4*)(rec + 320) = (f32x4){v[0], v[1], v[2], v[3]}; *(LAS f32x4*)(rec + 324) = (f32x4){v[4], v[5], v[6], v[7]}; \
            if (e == 0) *(LAS f32x2*)(scal_ + 2 * sl) = (f32x2){sbr, skr}; } while (0)
        if (!(MODE & 2)) { SC_PLOAD(0); SC_PWRITE(0); SC_PLOAD(1); }
        SC_BAR();
        for (int c = 0; c < NCH; ++c) {
            if (!(MODE & 2)) { if (c + 1 < NCH) SC_PWRITE(c + 1);
            if (c + 2 < NCH) SC_PLOAD(c + 2); }
            SC_BAR();
        }
#undef SC_PLOAD
#undef SC_PWRITE
    } else {
        const int rp = (wave * 64 + lane) >> 3, cgp = lane & 7;
        f32x2 s0[4], s1[4];
#pragma unroll
        for (int i = 0; i < 4; ++i) { s0[i] = (f32x2){0.f, 0.f}; s1[i] = (f32x2){0.f, 0.f}; }
        bf16* yrow = YO + (size_t)b * SEQ * RW + h * 64 + 2 * rp;
        SC_BAR();
#define SC_LOAD(N0, N1, Q0, Q1, D0, D1, B0, B1, K0, K1, VV, SS, sl_) do { const LAS float* rec_ = (const LAS float*)(buf + (sl_) * SC_REC) + 8 * cgp; \
            N0 = *(const LAS f32x4*)(rec_); N1 = *(const LAS f32x4*)(rec_ + 4); Q0 = *(const LAS f32x4*)(rec_ + 64); Q1 = *(const LAS f32x4*)(rec_ + 68); \
            D0 = *(const LAS f32x4*)(rec_ + 128); D1 = *(const LAS f32x4*)(rec_ + 132); B0 = *(const LAS f32x4*)(rec_ + 192); B1 = *(const LAS f32x4*)(rec_ + 196); \
            K0 = *(const LAS f32x4*)(rec_ + 256); K1 = *(const LAS f32x4*)(rec_ + 260); \
            VV = *(const LAS f32x2*)((const LAS float*)(buf + (sl_) * SC_REC) + 320 + 2 * rp); SS = *(const LAS f32x2*)(scal + 2 * (sl_)); } while (0)
        for (int c = 0; c < NCH; ++c) {
            const LAS unsigned char* buf = lds + (c & 1) * SC_BUF; const LAS float* scal = (const LAS float*)(lds + SC_SCAL) + (c & 1) * (SC_CH * 2);
            f32x4 n0, n1, q0, q1, d0, d1, b0, b1, k0, k1; f32x2 vv, sc;
            SC_LOAD(n0, n1, q0, q1, d0, d1, b0, b1, k0, k1, vv, sc, 0);
#pragma unroll 2
            for (int sl = 0; sl < SC_CH; ++sl) {
                f32x4 xn0, xn1, xq0, xq1, xd0, xd1, xb0, xb1, xk0, xk1; f32x2 xvv, xsc;
                const int sn = (sl + 1 < SC_CH) ? sl + 1 : sl;
                const f32x2 nk[4] = {(f32x2){n0.x, n0.y}, (f32x2){n0.z, n0.w}, (f32x2){n1.x, n1.y}, (f32x2){n1.z, n1.w}};
                const f32x2 qq[4] = {(f32x2){q0.x, q0.y}, (f32x2){q0.z, q0.w}, (f32x2){q1.x, q1.y}, (f32x2){q1.z, q1.w}};
                const f32x2 dv[4] = {(f32x2){d0.x, d0.y}, (f32x2){d0.z, d0.w}, (f32x2){d1.x, d1.y}, (f32x2){d1.z, d1.w}};
                const f32x2 bv[4] = {(f32x2){b0.x, b0.y}, (f32x2){b0.z, b0.w}, (f32x2){b1.x, b1.y}, (f32x2){b1.z, b1.w}};
                const f32x2 kv[4] = {(f32x2){k0.x, k0.y}, (f32x2){k0.z, k0.w}, (f32x2){k1.x, k1.y}, (f32x2){k1.z, k1.w}};
                f32x2 a0 = s0[0] * nk[0], a1 = s1[0] * nk[0], y0 = s0[0] * qq[0], y1 = s1[0] * qq[0];
#pragma unroll
                for (int i = 1; i < 4; ++i) { a0 = s0[i] * nk[i] + a0; a1 = s1[i] * nk[i] + a1; y0 = s0[i] * qq[i] + y0; y1 = s1[i] * qq[i] + y1; }
                float sa0 = a0.x + a0.y, sa1 = a1.x + a1.y, yp0 = y0.x + y0.y, yp1 = y1.x + y1.y;
                SC_LOAD(xn0, xn1, xq0, xq1, xd0, xd1, xb0, xb1, xk0, xk1, xvv, xsc, sn);
                sa0 = red8(sa0); sa1 = red8(sa1); yp0 = red8(yp0); yp1 = red8(yp1);
                const float yo0 = yp0 + sa0 * sc.x + vv.x * sc.y, yo1 = yp1 + sa1 * sc.x + vv.y * sc.y;
                const f32x2 sa0v = (f32x2){sa0, sa0}, sa1v = (f32x2){sa1, sa1}, v0v = (f32x2){vv.x, vv.x}, v1v = (f32x2){vv.y, vv.y};
#pragma unroll
                for (int i = 0; i < 4; ++i) {
                    f32x2 t0 = v0v * kv[i]; t0 = sa0v * bv[i] + t0; s0[i] = s0[i] * dv[i] + t0;
                    f32x2 t1 = v1v * kv[i]; t1 = sa1v * bv[i] + t1; s1[i] = s1[i] * dv[i] + t1;
                }
                const int step = c * SC_CH + sl, t = dir ? (SEQ - 1 - step) : step;
                const unsigned yw = pk2(yo0, yo1);
                if (!(MODE & 1)) { if (cgp == 0) *(unsigned*)(yrow + (size_t)t * RW) = yw; } else { asm volatile("" :: "v"(yw)); }
                n0 = xn0; n1 = xn1; q0 = xq0; q1 = xq1; d0 = xd0; d1 = xd1; b0 = xb0; b1 = xb1; k0 = xk0; k1 = xk1; vv = xvv; sc = xsc;
            }
            SC_BAR();
        }
#undef SC_LOAD
    }
#undef SC_BAR
    __syncthreads();
}

__device__ __forceinline__ bf16x8 pack8(const float (&x)[8]) {
    v4u w; w.x = pk2(x[0], x[1]); w.y = pk2(x[2], x[3]); w.z = pk2(x[4], x[5]); w.w = pk2(x[6], x[7]); return __builtin_bit_cast(bf16x8, w);
}
#define MFMA16(a, b, c) __builtin_amdgcn_mfma_f32_16x16x32_bf16((a), (b), (c), 0, 0, 0)
constexpr int CK = 16, NCK = SEQ / CK;
constexpr int L_QK = 0, L_PR = 4608, L_QKT = 9216, L_VT = 14336, L_VF = 19456, L_GC = 23552, L_OPSZ = 23808;
constexpr int L_E = 2 * L_OPSZ, L_G = L_E + 4096, L_GSZ = 5120, L_W0 = L_G + 2 * L_GSZ, L_VG = L_W0 + 4096, L_SB = L_VG + 2 * 4096, L_CEND = L_SB + 9216;
static_assert(L_CEND + 1280 <= 131072, "chunked scan LDS map");
#ifdef CBAR_FULL
#define CBAR() __syncthreads()
#else
#define CBAR() do { asm volatile("s_waitcnt lgkmcnt(0)" ::: "memory"); __builtin_amdgcn_s_barrier(); asm volatile("" ::: "memory"); } while (0)
#endif
__device__ __forceinline__ void scan_chunked(const Params& P, int sid, LAS unsigned char* lds) {
    const int tid = pg8::mk_tid(lds), lane = tid & 63, wave = __builtin_amdgcn_readfirstlane(tid >> 6), l15 = lane & 15, q4 = lane >> 4;
    const int b = sid / 24, rem = sid % 24, h = rem >> 1, dir = rem & 1;
    const bf16* PRE = (const bf16*)(P.ws + WS_PRE); const bf16* EA = (const bf16*)((unsigned char*)P.out + DO_EA);
    bf16* YO = dir ? (bf16*)(P.ws + WS_YB) : (bf16*)((unsigned char*)P.out + DO_YF);
#ifdef YZERO
    for (int it = tid; it < SEQ * 8; it += NTHREADS) *(v4u*)(YO + ((size_t)b * SEQ + (it >> 3)) * RW + h * 64 + (it & 7) * 8) = (v4u){0u, 0u, 0u, 0u};
#endif
    for (int i = tid; i < 9216 / 4; i += NTHREADS) ((LAS unsigned*)(lds + L_SB))[i] = 0u;
    for (int i = tid; i < L_SB / 4; i += NTHREADS) ((LAS unsigned*)(lds))[i] = 0u;
    if (tid < 320) { const int vsel = tid >> 6, chn = h * 64 + (tid & 63);
        ((LAS float*)(lds + L_CEND))[tid] = (vsel < 3) ? P.in[10][vsel * 768 + chn] : ((vsel == 3) ? P.in[11][chn] : P.in[12][chn]); }
    CBAR();
    if (wave >= 4) {
        const int pt = tid - 256, t = pt >> 4, e = pt & 15, ch0 = h * 64 + 4 * e, gsw = 8 * ((e >> 1) & 3);
        const LAS float* cst = (const LAS float*)(lds + L_CEND) + 4 * e;
        v2u rcA, kcA, vcA, rpA, kpA, vpA, rnA, knA, vnA, e8A, a8A, rcB, kcB, vcB, rpB, kpB, vpB, rnB, knB, vnB, e8B, a8B;
        const v2u z2 = (v2u){0u, 0u};
#define CK_PLOAD(X, c_) do { const int step_ = (c_) * CK + t, t_ = dir ? (SEQ - 1 - step_) : step_; const size_t m_ = (size_t)b * SEQ + t_; \
            const bf16* rowp_ = PRE + m_ * NPRE + C_RS + ch0; \
            rc##X = *(const v2u*)(rowp_); kc##X = *(const v2u*)(rowp_ + 768); vc##X = *(const v2u*)(rowp_ + 1536); \
            rp##X = (t_ > 0) ? *(const v2u*)(rowp_ - NPRE) : z2; kp##X = (t_ > 0) ? *(const v2u*)(rowp_ - NPRE + 768) : z2; vp##X = (t_ > 0) ? *(const v2u*)(rowp_ - NPRE + 1536) : z2; \
            rn##X = (t_ < SEQ - 1) ? *(const v2u*)(rowp_ + NPRE) : z2; kn##X = (t_ < SEQ - 1) ? *(const v2u*)(rowp_ + NPRE + 768) : z2; vn##X = (t_ < SEQ - 1) ? *(const v2u*)(rowp_ + NPRE + 1536) : z2; \
            const bf16* eap_ = EA + m_ * NLORA + dir * RW + ch0; e8##X = *(const v2u*)(eap_); a8##X = *(const v2u*)(eap_ + 1536); } while (0)
        CK_PLOAD(A, 0); CK_PLOAD(B, 1);
        float r[4], k[4], v[4], kk[4], aa[4], ee[4];
#define CK_PBODY(X, c_) do { const int c = (c_); const int pb = (c & 1) * L_OPSZ; \
            if (c < NCK) { \
                float x0[4], x1[4], x2[4]; f32x4 cc; \
                unpack4(rc##X, x0); unpack4(rp##X, x1); unpack4(rn##X, x2); cc = *(const LAS f32x4*)(cst); \
                _Pragma("unroll") for (int i = 0; i < 4; ++i) r[i] = x0[i] + cc[i] * (0.5f * (x1[i] + x2[i]) - x0[i]); \
                unpack4(kc##X, x0); unpack4(kp##X, x1); unpack4(kn##X, x2); cc = *(const LAS f32x4*)(cst + 64); \
                _Pragma("unroll") for (int i = 0; i < 4; ++i) k[i] = x0[i] + cc[i] * (0.5f * (x1[i] + x2[i]) - x0[i]); \
                unpack4(vc##X, x0); unpack4(vp##X, x1); unpack4(vn##X, x2); cc = *(const LAS f32x4*)(cst + 128); \
                _Pragma("unroll") for (int i = 0; i < 4; ++i) v[i] = x0[i] + cc[i] * (0.5f * (x1[i] + x2[i]) - x0[i]); \
                unpack4(e8##X, ee); unpack4(a8##X, aa); cc = *(const LAS f32x4*)(cst + 192); \
                float ss = 0.f; \
                _Pragma("unroll") for (int i = 0; i < 4; ++i) { kk[i] = k[i] * cc[i]; ss += kk[i] * kk[i]; } \
                ss = red8(ss); ss = dpp_add<0x140>(ss); \
                const float inv = __builtin_amdgcn_rcpf(fmaxf(__builtin_amdgcn_sqrtf(ss), 1e-12f)); \
                _Pragma("unroll") for (int i = 0; i < 4; ++i) kk[i] *= inv; \
                *(LAS f32x4*)((LAS float*)(lds + L_E) + t * 64 + 4 * e) = (f32x4){ee[0], ee[1], ee[2], ee[3]}; \
                if (c + 2 < NCK) CK_PLOAD(X, c + 2); \
            } \
            CBAR(); \
            if (c < NCK) { \
                f32x4 gs = (f32x4){0.f, 0.f, 0.f, 0.f}; \
                _Pragma("unroll") for (int u = 0; u < CK; ++u) { \
                    const f32x4 ea = *(const LAS f32x4*)((const LAS float*)(lds + L_E) + u * 64 + 4 * e); \
                    const float m = (u <= t) ? 1.f : 0.f; gs += m * ea; } \
                const f32x4 kac = *(const LAS f32x4*)(cst + 256); \
                float qv[4], kt[4], pv[4], rt[4], gin[4]; \
                _Pragma("unroll") for (int i = 0; i < 4; ++i) { \
                    gin[i] = __expf(-gs[i]); const float gex = __expf(ee[i] - gs[i]), ginv = __expf(gs[i]); \
                    const float kd = k[i] * (1.f + (aa[i] - 1.f) * kac[i]); \
                    qv[i] = kk[i] * aa[i] * ginv; kt[i] = kd * ginv; pv[i] = kk[i] * gex; rt[i] = r[i] * gin[i]; \
                } \
                LAS unsigned char* ob = lds + pb; \
                unsigned wq[4]; v2u o; \
                _Pragma("unroll") for (int i = 0; i < 4; ++i) wq[i] = pk2(qv[i], kt[i]);                        \
                o.x = (wq[0] & 0xffffu) | (wq[1] << 16); o.y = (wq[2] & 0xffffu) | (wq[3] << 16); *(LAS v2u*)(ob + L_QK + (t * 72 + 4 * e) * 2) = o; \
                o.x = (wq[0] >> 16) | (wq[1] & 0xffff0000u); o.y = (wq[2] >> 16) | (wq[3] & 0xffff0000u); *(LAS v2u*)(ob + L_QK + ((16 + t) * 72 + 4 * e) * 2) = o; \
                o.x = pk2(pv[0], pv[1]); o.y = pk2(pv[2], pv[3]); *(LAS v2u*)(ob + L_PR + (t * 72 + 4 * e) * 2) = o; \
                o.x = pk2(rt[0], rt[1]); o.y = pk2(rt[2], rt[3]); *(LAS v2u*)(ob + L_PR + ((16 + t) * 72 + 4 * e) * 2) = o; \
                const unsigned wv01 = pk2(v[0], v[1]), wv23 = pk2(v[2], v[3]); \
                _Pragma("unroll") for (int i = 0; i < 4; ++i) { \
                    *(LAS bf16*)(ob + L_QKT + ((4 * e + i) * 40 + (t ^ gsw)) * 2) = (bf16)(wq[i] & 0xffffu); *(LAS bf16*)(ob + L_QKT + ((4 * e + i) * 40 + ((16 + t) ^ gsw)) * 2) = (bf16)(wq[i] >> 16); \
                    const unsigned wv = (i < 2) ? wv01 : wv23; \
                    *(LAS bf16*)(ob + L_VT + ((4 * e + i) * 40 + ((16 + t) ^ gsw)) * 2) = (bf16)((i & 1) ? (wv >> 16) : (wv & 0xffffu)); \
                } \
                if (t == CK - 1) *(LAS f32x4*)((LAS float*)(ob + L_GC) + 4 * e) = (f32x4){gin[0], gin[1], gin[2], gin[3]}; \
            } \
            CBAR(); \
            CBAR(); } while (0)
        static_assert((NCK + 2) % 2 == 0, "producer loop is unrolled by two");
        for (int c2 = 0; c2 <= NCK + 1; c2 += 2) { CK_PBODY(A, c2); CK_PBODY(B, c2 + 1); }
#undef CK_PBODY
#undef CK_PLOAD
    } else {
        const int w = wave;
        f32x4 acc[4];
#pragma unroll
        for (int nt = 0; nt < 4; ++nt) acc[nt] = (f32x4){0.f, 0.f, 0.f, 0.f};
        bf16* ybase = YO + (size_t)b * SEQ * RW + h * 64 + 16 * w + 4 * q4;
        for (int c = 0; c <= NCK + 1; ++c) {
            const int ck = c - 1; const bool valid = (ck >= 0 && ck < NCK);
            const int pb = (ck & 1) * L_OPSZ, gb = L_G + (ck & 1) * L_GSZ;
            f32x4 r1 = (f32x4){0.f, 0.f, 0.f, 0.f};
            if (valid) {
                f32x4 r0 = (f32x4){0.f, 0.f, 0.f, 0.f};
#pragma unroll
                for (int ks = 0; ks < 2; ++ks) {
                    const bf16x8 S = *(const LAS bf16x8*)(lds + L_SB + ((16 * w + l15) * 72 + ks * 32 + 8 * q4) * 2);
                    const bf16x8 Bp = *(const LAS bf16x8*)(lds + pb + L_PR + ((l15) * 72 + ks * 32 + 8 * q4) * 2);
                    const bf16x8 Br = *(const LAS bf16x8*)(lds + pb + L_PR + ((16 + l15) * 72 + ks * 32 + 8 * q4) * 2);
                    r0 = MFMA16(S, Bp, r0); r1 = MFMA16(S, Br, r1);
                }
                *(LAS f32x4*)(lds + L_W0 + (l15 * 64 + 16 * w + 4 * q4) * 4) = r0;
            }
            if (valid && w == 1) {
#pragma unroll
                for (int x = 0; x < 4; ++x) {
                    const int a = x >> 1, bc = x & 1;
                    f32x4 g = (f32x4){0.f, 0.f, 0.f, 0.f};
#pragma unroll
                    for (int ks = 0; ks < 2; ++ks) {
                        const bf16x8 A = *(const LAS bf16x8*)(lds + pb + L_QK + ((a * 16 + l15) * 72 + ks * 32 + 8 * q4) * 2);
                        const bf16x8 Bm = *(const LAS bf16x8*)(lds + pb + L_PR + ((bc * 16 + l15) * 72 + ks * 32 + 8 * q4) * 2);
                        g = MFMA16(A, Bm, g);
                    }
                    *(LAS f32x4*)(lds + gb + x * 1280 + (l15 * 20 + 4 * q4) * 4) = g;
                }
                asm volatile("s_waitcnt lgkmcnt(0)" ::: "memory");
                float bw[8];
                {
                    const f32x4 ga = *(const LAS f32x4*)(lds + gb + 2 * 1280 + (l15 * 20 + 8 * (q4 & 1)) * 4), gb2 = *(const LAS f32x4*)(lds + gb + 2 * 1280 + (l15 * 20 + 8 * (q4 & 1) + 4) * 4);
#pragma unroll
                    for (int ii = 0; ii < 8; ++ii) { const int s = 8 * (q4 & 1) + ii; const float gv = (ii < 4) ? ga[ii & 3] : gb2[ii & 3]; bw[ii] = (q4 >= 2 && s < l15) ? gv : 0.f; }
                }
                const bf16x8 Bf = pack8(bw);
#pragma unroll
                for (int mt = 0; mt < 4; ++mt) {
                    const bf16x8 Av = *(const LAS bf16x8*)(lds + pb + L_VT + ((mt * 16 + l15) * 40 + 8 * (q4 ^ (((mt * 16 + l15) >> 3) & 3))) * 2);
                    f32x4 r = (f32x4){0.f, 0.f, 0.f, 0.f};
                    r = MFMA16(Av, Bf, r);
                    *(LAS f32x4*)(lds + L_VG + (ck & 1) * 4096 + (l15 * 64 + mt * 16 + 4 * q4) * 4) = r;
                }
            }
            CBAR();
            if (valid && w == 0) {
                const int i = lane;
                float u[16];
#pragma unroll
                for (int s = 0; s < 16; ++s) u[s] = *(const LAS float*)(lds + L_W0 + (s * 64 + i) * 4) + *(const LAS float*)(lds + L_VG + (ck & 1) * 4096 + (s * 64 + i) * 4);
#pragma unroll
                for (int blk = 0; blk < 4; ++blk) {
                    f32x4 gq[4][4];
#pragma unroll
                    for (int tt = 0; tt < 4; ++tt)
#pragma unroll
                        for (int s4 = 0; s4 <= blk; ++s4) gq[tt][s4] = *(const LAS f32x4*)(lds + gb + 0 * 1280 + ((4 * blk + tt) * 20 + 4 * s4) * 4);
#pragma unroll
                    for (int s = 0; s < 4 * blk; ++s)
#pragma unroll
                        for (int tt = 0; tt < 4; ++tt) u[4 * blk + tt] -= gq[tt][s >> 2][s & 3] * u[s];
#pragma unroll
                    for (int tt = 1; tt < 4; ++tt)
#pragma unroll
                        for (int sp = 0; sp < tt; ++sp) u[4 * blk + tt] -= gq[tt][blk][sp] * u[4 * blk + sp];
                    __builtin_amdgcn_sched_barrier(0);
                }
                float n0[8], n1[8];
#pragma unroll
                for (int s = 0; s < 8; ++s) { n0[s] = -u[s]; n1[s] = -u[8 + s]; }
                *(LAS bf16x8*)(lds + pb + L_VT + (i * 40 + 8 * (0 ^ ((i >> 3) & 3))) * 2) = pack8(n0); *(LAS bf16x8*)(lds + pb + L_VT + (i * 40 + 8 * (1 ^ ((i >> 3) & 3))) * 2) = pack8(n1);
            }
            CBAR();
            if (valid) {
                const bf16x8 Bv = *(const LAS bf16x8*)(lds + pb + L_VT + ((16 * w + l15) * 40 + 8 * (q4 ^ (((16 * w + l15) >> 3) & 3))) * 2);
                {
                    const int xo = (q4 < 2) ? 1 : 3;
                    const f32x4 ga = *(const LAS f32x4*)(lds + gb + xo * 1280 + (l15 * 20 + 8 * (q4 & 1)) * 4), gb2 = *(const LAS f32x4*)(lds + gb + xo * 1280 + (l15 * 20 + 8 * (q4 & 1) + 4) * 4);
                    float bw[8];
#pragma unroll
                    for (int ii = 0; ii < 8; ++ii) { const int s = 8 * (q4 & 1) + ii; const float gv = (ii < 4) ? ga[ii & 3] : gb2[ii & 3]; bw[ii] = (s <= l15) ? gv : 0.f; }
                    const f32x4 y = MFMA16(Bv, pack8(bw), r1);
                    const int step = ck * CK + l15, tt = dir ? (SEQ - 1 - step) : step;
                    v2u o; o.x = pk2(y[0], y[1]); o.y = pk2(y[2], y[3]);
                    *(v2u*)(ybase + (size_t)tt * RW) = o;
                }
#pragma unroll
                for (int nt = 0; nt < 4; ++nt) {
                    const bf16x8 Aq = *(const LAS bf16x8*)(lds + pb + L_QKT + ((nt * 16 + l15) * 40 + 8 * (q4 ^ (((nt * 16 + l15) >> 3) & 3))) * 2);
                    acc[nt] = MFMA16(Aq, Bv, acc[nt]);
                    const f32x4 gc = *(const LAS f32x4*)(lds + pb + L_GC + (nt * 16 + 4 * q4) * 4);
                    acc[nt] = acc[nt] * gc;
                    v2u o; o.x = pk2(acc[nt][0], acc[nt][1]); o.y = pk2(acc[nt][2], acc[nt][3]);
                    *(LAS v2u*)(lds + L_SB + ((16 * w + l15) * 72 + nt * 16 + 4 * q4) * 2) = o;
                }
            }
            CBAR();
        }
    }
    __syncthreads();
}
#undef CBAR

constexpr int KA_P = 72, VA_P = 392;
__device__ __forceinline__ void attnA_item(const Params& P, int item, LAS unsigned char* lds) {
    const int tid = pg8::mk_tid(lds), lane = tid & 63, wave = __builtin_amdgcn_readfirstlane(tid >> 6), l15 = lane & 15, q4 = lane >> 4;
    const int b = item >> 6, n = (item >> 2) & 15, hk = item & 3;
    const bf16* PRE = (const bf16*)(P.ws + WS_PRE); bf16* YC = (bf16*)(P.ws + WS_YCAT);
    const float* RC = (const float*)(P.ws + WS_ROPE); const float* RS = RC + SEQ * 32;
    LAS bf16* Ks = (LAS bf16*)lds; LAS bf16* Vt = Ks + 384 * KA_P;
    {
        v2u klo[6], khi[6]; f32x4 kcs[6], ksn[6]; v4u vw[6];
#pragma unroll
        for (int u = 0; u < 6; ++u) {
            const int it = tid + u * NTHREADS, j = it >> 3, c = it & 7, kp = (n - 1) * 128 + j;
            const bool ok = (kp >= 0 && kp < SEQ); const int kpc = ok ? kp : 0;
            const bf16* src = PRE + ((size_t)b * SEQ + kpc) * NPRE + C_AK + hk * 64;
            klo[u] = *(const v2u*)(src + 4 * c); khi[u] = *(const v2u*)(src + 32 + 4 * c);
            kcs[u] = *(const f32x4*)(RC + kpc * 32 + 4 * c); ksn[u] = *(const f32x4*)(RS + kpc * 32 + 4 * c);
            vw[u] = *(const v4u*)(PRE + ((size_t)b * SEQ + kpc) * NPRE + C_AV + hk * 64 + 8 * c);
        }
        const f32x4 g1 = *(const f32x4*)(P.in[7] + 4 * (tid & 7)), g2 = *(const f32x4*)(P.in[7] + 32 + 4 * (tid & 7));
#pragma unroll
        for (int u = 0; u < 6; ++u) {
            const int it = tid + u * NTHREADS, j = it >> 3, c = it & 7, kp = (n - 1) * 128 + j;
            const bool ok = (kp >= 0 && kp < SEQ);
            float x1[4], x2[4]; unpack4(klo[u], x1); unpack4(khi[u], x2);
            float ss = 0.f;
#pragma unroll
            for (int i = 0; i < 4; ++i) ss += x1[i] * x1[i] + x2[i] * x2[i];
            ss = red8(ss);
            const float rstd = ok ? 1.f / sqrtf(ss * (1.f / 64.f) + NORM_EPS) : 0.f;
            float r1[4], r2[4];
#pragma unroll
            for (int i = 0; i < 4; ++i) { const float y1 = x1[i] * rstd * g1[i], y2 = x2[i] * rstd * g2[i]; r1[i] = y1 * kcs[u][i] - y2 * ksn[u][i]; r2[i] = y2 * kcs[u][i] + y1 * ksn[u][i]; }
            v2u o0, o1; o0.x = pk2(r1[0], r1[1]); o0.y = pk2(r1[2], r1[3]); o1.x = pk2(r2[0], r2[1]); o1.y = pk2(r2[2], r2[3]);
            *(LAS v2u*)(Ks + j * KA_P + 4 * c) = o0; *(LAS v2u*)(Ks + j * KA_P + 32 + 4 * c) = o1;
            const v4u w = ok ? vw[u] : (v4u){0u, 0u, 0u, 0u};
            LAS bf16* d = Vt + (8 * c) * VA_P + j;
            d[0] = (bf16)(w.x & 0xffffu); d[VA_P] = (bf16)(w.x >> 16); d[2 * VA_P] = (bf16)(w.y & 0xffffu); d[3 * VA_P] = (bf16)(w.y >> 16);
            d[4 * VA_P] = (bf16)(w.z & 0xffffu); d[5 * VA_P] = (bf16)(w.z >> 16); d[6 * VA_P] = (bf16)(w.w & 0xffffu); d[7 * VA_P] = (bf16)(w.w >> 16);
        }
    }
    v4u qlo, qhi;
    {
        const int R0 = wave * 48, g = R0 >> 7, pos = (R0 & 127) + l15, qp = n * 128 + pos, hq = hk * 3 + g;
        const bf16* src = PRE + ((size_t)b * SEQ + qp) * NPRE + C_AQ + hq * 64;
        qlo = *(const v4u*)(src + 8 * q4); qhi = *(const v4u*)(src + 32 + 8 * q4);
    }
    __syncthreads();
#pragma unroll 1
    for (int mt = 0; mt < 3; ++mt) {
        const int R0 = wave * 48 + mt * 16, g = R0 >> 7, pos = (R0 & 127) + l15, qp = n * 128 + pos, hq = hk * 3 + g;
        const size_t m = (size_t)b * SEQ + qp;
        v2u gat[4];
#pragma unroll
        for (int dt = 0; dt < 4; ++dt) gat[dt] = *(const v2u*)(PRE + m * NPRE + C_AG + hq * 64 + dt * 16 + 4 * q4);
        const v4u cqlo = qlo, cqhi = qhi;
        {
            const int mn = (mt < 2) ? mt + 1 : 2, R1 = wave * 48 + mn * 16, g1_ = R1 >> 7, pos1 = (R1 & 127) + l15, qp1 = n * 128 + pos1, hq1 = hk * 3 + g1_;
            const bf16* src = PRE + ((size_t)b * SEQ + qp1) * NPRE + C_AQ + hq1 * 64;
            qlo = *(const v4u*)(src + 8 * q4); qhi = *(const v4u*)(src + 32 + 8 * q4);
        }
        bf16x8 qf0, qf1;
        {
            float x1[8], x2[8]; unpack8(cqlo, x1); unpack8(cqhi, x2);
            float ss = 0.f;
#pragma unroll
            for (int i = 0; i < 8; ++i) ss += x1[i] * x1[i] + x2[i] * x2[i];
            ss += __shfl_xor(ss, 16); ss += __shfl_xor(ss, 32);
            const float rstd = (0.125f * 1.4426950408889634f) / sqrtf(ss * (1.f / 64.f) + NORM_EPS);
            float r1[8], r2[8];
            const f32x4 ga = *(const f32x4*)(P.in[6] + 8 * q4), gb = *(const f32x4*)(P.in[6] + 8 * q4 + 4), gc = *(const f32x4*)(P.in[6] + 32 + 8 * q4), gd = *(const f32x4*)(P.in[6] + 36 + 8 * q4);
            const f32x4 ca = *(const f32x4*)(RC + qp * 32 + 8 * q4), cb = *(const f32x4*)(RC + qp * 32 + 8 * q4 + 4), sa_ = *(const f32x4*)(RS + qp * 32 + 8 * q4), sb_ = *(const f32x4*)(RS + qp * 32 + 8 * q4 + 4);
#pragma unroll
            for (int i = 0; i < 8; ++i) {
                const float g1 = (i < 4) ? ga[i & 3] : gb[i & 3], g2 = (i < 4) ? gc[i & 3] : gd[i & 3], cs = (i < 4) ? ca[i & 3] : cb[i & 3], sn = (i < 4) ? sa_[i & 3] : sb_[i & 3];
                const float y1 = x1[i] * rstd * g1, y2 = x2[i] * rstd * g2; r1[i] = y1 * cs - y2 * sn; r2[i] = y2 * cs + y1 * sn;
            }
            qf0 = pack8(r1); qf1 = pack8(r2);
        }
        const int kt0 = (R0 & 127) >> 4;
        const int seq_lo = (n == 0) ? 8 : 0, seq_hi = (n == 15) ? 15 : 23;
        f32x4 acc[18];
#pragma unroll
        for (int u = 0; u < 17; ++u) {
            const LAS bf16* kr = Ks + ((kt0 + u) * 16 + l15) * KA_P + 8 * q4;
            const bf16x8 k0 = *(const LAS bf16x8*)(kr), k1 = *(const LAS bf16x8*)(kr + 32);
            f32x4 a = (f32x4){0.f, 0.f, 0.f, 0.f};
            a = MFMA16(k0, qf0, a); a = MFMA16(k1, qf1, a); acc[u] = a;
        }
        acc[17] = (f32x4){-1e30f, -1e30f, -1e30f, -1e30f};
        const float sink = P.in[8][hq] * 1.4426950408889634f;
        float mx = sink;
#pragma unroll
        for (int u = 0; u < 17; ++u) {
            const bool tv = (kt0 + u >= seq_lo) && (kt0 + u <= seq_hi);
#pragma unroll
            for (int i = 0; i < 4; ++i) {
                bool valid = tv;
                if (u == 0) valid = valid && (4 * q4 + i >= l15);
                if (u == 16) valid = valid && (4 * q4 + i <= l15);
                const float sv = valid ? acc[u][i] : -1e30f; acc[u][i] = sv; mx = fmaxf(mx, sv);
            }
        }
        mx = fmaxf(mx, __shfl_xor(mx, 16)); mx = fmaxf(mx, __shfl_xor(mx, 32));
        float sum = 0.f;
#pragma unroll
        for (int u = 0; u < 17; ++u)
#pragma unroll
            for (int i = 0; i < 4; ++i) { const float p = __builtin_amdgcn_exp2f(acc[u][i] - mx); acc[u][i] = p; sum += p; }
        acc[17] = (f32x4){0.f, 0.f, 0.f, 0.f};
        sum += __shfl_xor(sum, 16); sum += __shfl_xor(sum, 32);
        const float inv = 1.f / (sum + __builtin_amdgcn_exp2f(sink - mx));
        f32x4 o[4];
#pragma unroll
        for (int dt = 0; dt < 4; ++dt) o[dt] = (f32x4){0.f, 0.f, 0.f, 0.f};
#pragma unroll
        for (int k2 = 0; k2 < 9; ++k2) {
            float pp[8] = {acc[2 * k2][0], acc[2 * k2][1], acc[2 * k2][2], acc[2 * k2][3], acc[2 * k2 + 1][0], acc[2 * k2 + 1][1], acc[2 * k2 + 1][2], acc[2 * k2 + 1][3]};
            const bf16x8 pf = pack8(pp);
#pragma unroll
            for (int dt = 0; dt < 4; ++dt) {
                const LAS bf16* vr = Vt + (dt * 16 + l15) * VA_P + kt0 * 16 + k2 * 32 + 4 * q4;
                const v2u v0 = *(const LAS v2u*)(vr);
                v2u v1 = (v2u){0u, 0u};
                if (k2 < 8) v1 = *(const LAS v2u*)(vr + 16);
                const v4u vw = (v4u){v0.x, v0.y, v1.x, v1.y};
                o[dt] = MFMA16(__builtin_bit_cast(bf16x8, vw), pf, o[dt]);
            }
        }
#pragma unroll
        for (int dt = 0; dt < 4; ++dt) {
            const int ch = hq * 64 + dt * 16 + 4 * q4;
            float gg[4]; unpack4(gat[dt], gg);
            v2u w; w.x = pk2(o[dt][0] * inv * gg[0], o[dt][1] * inv * gg[1]); w.y = pk2(o[dt][2] * inv * gg[2], o[dt][3] * inv * gg[3]);
            *(v2u*)(YC + m * DM + ch) = w;
        }
    }
    __syncthreads();
}

constexpr int KC_P = 136, VC_P = 264;
__device__ __forceinline__ void attnC_item(const Params& P, int item, LAS unsigned char* lds) {
    const int tid = pg8::mk_tid(lds), lane = tid & 63, wave = __builtin_amdgcn_readfirstlane(tid >> 6), l15 = lane & 15, q4 = lane >> 4;
    const int b = item >> 6, qb = (item >> 2) & 15, hx = item & 3;
    const bf16* PRE = (const bf16*)(P.ws + WS_PRE); const bf16* MKV = (const bf16*)(P.ws + WS_MKV); bf16* YC = (bf16*)(P.ws + WS_YCAT);
    LAS bf16* Ks = (LAS bf16*)lds; LAS bf16* Vt = Ks + 256 * KC_P;
    const int q = qb * 128 + wave * 16 + l15; const size_t m = (size_t)b * SEQ + q;
    {
        v4u kw[8], vw[8];
#pragma unroll
        for (int u = 0; u < 8; ++u) {
            const int it = tid + u * NTHREADS, j = it >> 4, c = it & 15;
            const bf16* src = MKV + ((size_t)b * NMEM + j) * 1024 + hx * 128 + 8 * c;
            kw[u] = *(const v4u*)(src); vw[u] = *(const v4u*)(src + 512);
        }
        const f32x4 g0 = *(const f32x4*)(P.in[23] + 8 * (tid & 15)), g1 = *(const f32x4*)(P.in[23] + 8 * (tid & 15) + 4);
#pragma unroll
        for (int u = 0; u < 8; ++u) {
            const int it = tid + u * NTHREADS, j = it >> 4, c = it & 15;
            float x[8]; unpack8(kw[u], x);
            float ss = 0.f;
#pragma unroll
            for (int i = 0; i < 8; ++i) ss += x[i] * x[i];
            ss = red8(ss); ss = dpp_add<0x140>(ss);
            const float rstd = 1.f / sqrtf(ss * (1.f / 128.f) + NORM_EPS);
            v4u o; o.x = pk2(x[0] * rstd * g0.x, x[1] * rstd * g0.y); o.y = pk2(x[2] * rstd * g0.z, x[3] * rstd * g0.w);
            o.z = pk2(x[4] * rstd * g1.x, x[5] * rstd * g1.y); o.w = pk2(x[6] * rstd * g1.z, x[7] * rstd * g1.w);
            *(LAS v4u*)(Ks + j * KC_P + 8 * c) = o;
            const v4u w = vw[u];
            LAS bf16* d = Vt + (8 * c) * VC_P + j;
            d[0] = (bf16)(w.x & 0xffffu); d[VC_P] = (bf16)(w.x >> 16); d[2 * VC_P] = (bf16)(w.y & 0xffffu); d[3 * VC_P] = (bf16)(w.y >> 16);
            d[4 * VC_P] = (bf16)(w.z & 0xffffu); d[5 * VC_P] = (bf16)(w.z >> 16); d[6 * VC_P] = (bf16)(w.w & 0xffffu); d[7 * VC_P] = (bf16)(w.w >> 16);
        }
    }
    v4u qraw[4]; v2u gat[8];
    {
        const bf16* src = PRE + m * NPRE + C_XQ + hx * 128 + 8 * q4;
#pragma unroll
        for (int ks = 0; ks < 4; ++ks) qraw[ks] = *(const v4u*)(src + ks * 32);
#pragma unroll
        for (int dt = 0; dt < 8; ++dt) gat[dt] = *(const v2u*)(PRE + m * NPRE + C_XG + hx * 128 + dt * 16 + 4 * q4);
    }
    __syncthreads();
    {
        bf16x8 qf[4];
        {
            float x[4][8]; float ss = 0.f;
#pragma unroll
            for (int ks = 0; ks < 4; ++ks) { unpack8(qraw[ks], x[ks]);
#pragma unroll
                for (int i = 0; i < 8; ++i) ss += x[ks][i] * x[ks][i]; }
            ss += __shfl_xor(ss, 16); ss += __shfl_xor(ss, 32);
            const float rstd = (0.08838834764831845f * 1.4426950408889634f) / sqrtf(ss * (1.f / 128.f) + NORM_EPS);
#pragma unroll
            for (int ks = 0; ks < 4; ++ks) { float y[8];
                const f32x4 ga = *(const f32x4*)(P.in[22] + ks * 32 + 8 * q4), gb = *(const f32x4*)(P.in[22] + ks * 32 + 8 * q4 + 4);
#pragma unroll
                for (int i = 0; i < 8; ++i) y[i] = x[ks][i] * rstd * ((i < 4) ? ga[i & 3] : gb[i & 3]);
                qf[ks] = pack8(y); }
        }
        f32x4 acc[16];
#pragma unroll
        for (int kt = 0; kt < 16; ++kt) {
            const LAS bf16* kr = Ks + (kt * 16 + l15) * KC_P + 8 * q4;
            f32x4 a = (f32x4){0.f, 0.f, 0.f, 0.f};
#pragma unroll
            for (int ks = 0; ks < 4; ++ks) a = MFMA16(*(const LAS bf16x8*)(kr + ks * 32), qf[ks], a);
            acc[kt] = a;
        }
        float mx = -1e30f;
#pragma unroll
        for (int kt = 0; kt < 16; ++kt)
#pragma unroll
            for (int i = 0; i < 4; ++i) mx = fmaxf(mx, acc[kt][i]);
        mx = fmaxf(mx, __shfl_xor(mx, 16)); mx = fmaxf(mx, __shfl_xor(mx, 32));
        float sum = 0.f;
#pragma unroll
        for (int kt = 0; kt < 16; ++kt)
#pragma unroll
            for (int i = 0; i < 4; ++i) { const float p = __builtin_amdgcn_exp2f(acc[kt][i] - mx); acc[kt][i] = p; sum += p; }
        sum += __shfl_xor(sum, 16); sum += __shfl_xor(sum, 32);
        const float inv = 1.f / sum;
        f32x4 o[8];
#pragma unroll
        for (int dt = 0; dt < 8; ++dt) o[dt] = (f32x4){0.f, 0.f, 0.f, 0.f};
#pragma unroll
        for (int k2 = 0; k2 < 8; ++k2) {
            float pp[8] = {acc[2 * k2][0], acc[2 * k2][1], acc[2 * k2][2], acc[2 * k2][3], acc[2 * k2 + 1][0], acc[2 * k2 + 1][1], acc[2 * k2 + 1][2], acc[2 * k2 + 1][3]};
            const bf16x8 pf = pack8(pp);
#pragma unroll
            for (int dt = 0; dt < 8; ++dt) {
                const LAS bf16* vr = Vt + (dt * 16 + l15) * VC_P + k2 * 32 + 4 * q4;
                const v2u v0 = *(const LAS v2u*)(vr), v1 = *(const LAS v2u*)(vr + 16);
                const v4u vw = (v4u){v0.x, v0.y, v1.x, v1.y};
                o[dt] = MFMA16(__builtin_bit_cast(bf16x8, vw), pf, o[dt]);
            }
        }
#pragma unroll
        for (int dt = 0; dt < 8; ++dt) {
            const int ch = hx * 128 + dt * 16 + 4 * q4;
            float gg[4]; unpack4(gat[dt], gg);
            v2u w; w.x = pk2(o[dt][0] * inv * gg[0], o[dt][1] * inv * gg[1]); w.y = pk2(o[dt][2] * inv * gg[2], o[dt][3] * inv * gg[3]);
            *(v2u*)(YC + m * DM + 1536 + ch) = w;
        }
    }
    __syncthreads();
}

__device__ __forceinline__ void p5_rwkv_post(const Params& P, LAS unsigned char* lds) {
    const bf16* PRE = (const bf16*)(P.ws + WS_PRE); const bf16* EA = (const bf16*)((unsigned char*)P.out + DO_EA);
    const bf16* YF = (const bf16*)((unsigned char*)P.out + DO_YF); const bf16* YB = (const bf16*)(P.ws + WS_YB); bf16* YC = (bf16*)(P.ws + WS_YCAT);
    const float* mu = P.in[10];
    const int gt = blockIdx.x * NTHREADS + pg8::mk_tid(lds), NGT = gridDim.x * NTHREADS;
    for (int idx = gt; idx < M_TOK * 96; idx += NGT) {
        const int m = idx / 96, he = idx - m * 96, ch0 = he * 8, t = m & (SEQ - 1);
        const bf16* p = PRE + (size_t)m * NPRE + C_RS + ch0;
        const v4u z4 = (v4u){0u, 0u, 0u, 0u};
        const bool hp = t > 0, hn = t < SEQ - 1;
        const v4u rc = *(const v4u*)(p), kc = *(const v4u*)(p + 768), vc = *(const v4u*)(p + 1536);
        const v4u rp = hp ? *(const v4u*)(p - NPRE) : z4, kp = hp ? *(const v4u*)(p - NPRE + 768) : z4, vp = hp ? *(const v4u*)(p - NPRE + 1536) : z4;
        const v4u rn = hn ? *(const v4u*)(p + NPRE) : z4, kn = hn ? *(const v4u*)(p + NPRE + 768) : z4, vn = hn ? *(const v4u*)(p + NPRE + 1536) : z4;
        const v4u af8 = *(const v4u*)(EA + (size_t)m * NLORA + 1536 + ch0), ab8 = *(const v4u*)(EA + (size_t)m * NLORA + 2304 + ch0);
        const v4u yf8 = *(const v4u*)(YF + (size_t)m * RW + ch0), yb8 = *(const v4u*)(YB + (size_t)m * RW + ch0);
        const v4u rg8 = *(const v4u*)(PRE + (size_t)m * NPRE + C_RG + ch0);
        float r[8], k[8], v[8], x0[8], x1[8], x2[8];
        unpack8(rc, x0); unpack8(rp, x1); unpack8(rn, x2);
#pragma unroll
        for (int i = 0; i < 8; ++i) r[i] = x0[i] + mu[ch0 + i] * (0.5f * (x1[i] + x2[i]) - x0[i]);
        unpack8(kc, x0); unpack8(kp, x1); unpack8(kn, x2);
#pragma unroll
        for (int i = 0; i < 8; ++i) k[i] = x0[i] + mu[768 + ch0 + i] * (0.5f * (x1[i] + x2[i]) - x0[i]);
        unpack8(vc, x0); unpack8(vp, x1); unpack8(vn, x2);
#pragma unroll
        for (int i = 0; i < 8; ++i) v[i] = x0[i] + mu[1536 + ch0 + i] * (0.5f * (x1[i] + x2[i]) - x0[i]);
        float af[8], ab[8], ys[8], yb[8], rg[8]; unpack8(af8, af); unpack8(ab8, ab); unpack8(yf8, ys); unpack8(yb8, yb); unpack8(rg8, rg);
        float bs = 0.f, sm = 0.f;
#pragma unroll
        for (int i = 0; i < 8; ++i) { const float kds = k[i] * (2.f + (af[i] + ab[i] - 2.f) * P.in[12][ch0 + i]); bs += r[i] * kds * P.in[13][ch0 + i]; ys[i] += yb[i]; sm += ys[i]; }
        bs = red8(bs); sm = red8(sm);
        const float mean = sm * (1.f / 64.f);
        float vs = 0.f;
#pragma unroll
        for (int i = 0; i < 8; ++i) { ys[i] -= mean; vs += ys[i] * ys[i]; }
        vs = red8(vs);
        const float rstd = 1.f / sqrtf(vs * (1.f / 64.f) + GN_EPS);
        float o[8];
#pragma unroll
        for (int i = 0; i < 8; ++i) o[i] = (ys[i] * rstd * P.in[18][ch0 + i] + P.in[19][ch0 + i] + bs * v[i]) * rg[i];
        v4u w; w.x = pk2(o[0], o[1]); w.y = pk2(o[2], o[3]); w.z = pk2(o[4], o[5]); w.w = pk2(o[6], o[7]);
        *(v4u*)(YC + (size_t)m * DM + 768 + ch0) = w;
    }
}

constexpr int N_PHASES = 8;
__global__ void __launch_bounds__(NTHREADS, 2) hybrid_fwd(Params P) {
    extern __shared__ __attribute__((aligned(16))) unsigned char lds_raw[];
    LAS unsigned char* lds = (LAS unsigned char*)lds_raw;
    cg::grid_group grid = cg::this_grid();
    const int lo = P.ph_lo, hi = P.ph_hi, G = gridDim.x;
    if ((threadIdx.x & 63) == 0) *(volatile LAS int*)(lds + pg8::TIDTAB_OFF + 4 * pg8::hw_slot()) = (int)(threadIdx.x >> 6);
    __syncthreads();
    unsigned char* ws = P.ws; unsigned char* dob = (unsigned char*)P.out;
#ifdef PHMASK
#define IN(k) (((PHMASK >> (k)) & 1) && lo <= (k) && (k) < hi)
#else
#define IN(k) (lo <= (k) && (k) < hi)
#endif
#define SEAM(k) do { if (IN(k) && IN((k) + 1)) grid.sync(); } while (0)
#ifndef REPEAT_MASK
#define REPEAT_MASK 0
#endif
#define REP(k) for (int rep_ = 0; rep_ < (((REPEAT_MASK >> (k)) & 1) ? 2 : 1); ++rep_)
#define REPSYNC() do { if (rep_) grid.sync(); } while (0)
    if (IN(0)) REP(0) { REPSYNC(); p0_prologue(P, lds, P.out); __syncthreads(); }
    SEAM(0);
    if (IN(1)) REP(1) { REPSYNC();
        { pg8::Gemm g{(const bf16*)(dob + DO_H), (const bf16*)(dob + DO_WIN), M_TOK, NIN, DM}; pg8::StaticOrder S; S.init(M_TOK, NIN, G, (int)blockIdx.x);
          EpiProj E{(bf16*)(ws + WS_PRE), (bf16*)(ws + WS_GATES), P.in[5]};
          pg8::gemm_phase<EpiProj, pg8::StaticOrder, true, true>(lds, g, S, E); }
        { pg8::Gemm g{(const bf16*)(ws + WS_MEMN), (const bf16*)(ws + WS_WXKV), MEMROWS, 1024, DM}; pg8::StaticOrder S; S.init(MEMROWS, 1024, G, (int)((blockIdx.x + G - 64) % G));
          EpiPlain E{(bf16*)(ws + WS_MKV), 1024};
          pg8::gemm_phase<EpiPlain, pg8::StaticOrder, true, true>(lds, g, S, E); }
    }
    SEAM(1);
    if (IN(2)) REP(2) { REPSYNC(); p2_lora_in(P, lds); }
    SEAM(2);
    if (IN(3)) REP(3) { REPSYNC();
        int klora = 256; asm volatile("" : "+s"(klora));
        pg8::Gemm g{(const bf16*)(dob + DO_LIN), (const bf16*)(ws + WS_LORAB), M_TOK, NLORA, klora}; pg8::StaticOrder S; S.init(M_TOK, NLORA, G, (int)blockIdx.x);
        EpiLora E{(bf16*)(dob + DO_EA), P.in[14], P.in[16]};
        pg8::gemm_phase<EpiLora, pg8::StaticOrder, true, true>(lds, g, S, E);
    }
    SEAM(3);
    if (IN(4)) REP(4) { REPSYNC();
        const int bid = blockIdx.x;
#ifndef STATIC_ATT
#define STATIC_ATT 0
#endif
#ifndef SCAN2
#define SCAN2 1
#endif
        if (bid < 192) scan_chunked(P, bid, lds);
        if (STATIC_ATT) {
            if (bid >= 192) { for (int it = bid - 192; it < 1024; it += G - 192) { if (it < 512) attnA_item(P, it, lds); else attnC_item(P, it - 512, lds); } }
        } else {
            volatile LAS int* slot = (volatile LAS int*)(lds + pg8::TIDTAB_OFF - 64);
            const int tid4 = pg8::mk_tid(lds);
            for (;;) {
                if (tid4 == 0) *slot = (int)__hip_atomic_fetch_add((unsigned*)(ws + WS_CTR), 1u, __ATOMIC_RELAXED, __HIP_MEMORY_SCOPE_AGENT);
                __syncthreads();
                const int it = *slot;
                __syncthreads();
                if (it >= 1024) break;
                if (it < 512) attnA_item(P, it, lds); else attnC_item(P, it - 512, lds);
            }
        }
    }
    SEAM(4);
    if (IN(5)) REP(5) { REPSYNC(); p5_rwkv_post(P, lds); }
    SEAM(5);
    if (IN(6)) REP(6) { REPSYNC();
        pg8::Gemm g{(const bf16*)(ws + WS_YCAT), (const bf16*)(ws + WS_WCAT), M_TOK, DM, DM}; pg8::StaticOrder S; S.init(M_TOK, DM, G, (int)blockIdx.x);
        EpiMerged E{(bf16*)(ws + WS_MERGED), (const bf16*)(ws + WS_GATES)};
        pg8::gemm_phase<EpiMerged, pg8::StaticOrder, true, true>(lds, g, S, E);
    }
    SEAM(6);
    if (IN(7)) REP(7) { REPSYNC();
        pg8::Gemm g{(const bf16*)(ws + WS_MERGED), (const bf16*)(ws + WS_WOUT), M_TOK, DM, DM}; pg8::StaticOrder S; S.init(M_TOK, DM, G, (int)blockIdx.x);
        EpiOut E{P.out, P.in[0]};
        pg8::gemm_phase<EpiOut, pg8::StaticOrder, true, true>(lds, g, S, E);
    }
#undef IN
#undef SEAM
}

#ifndef ONE_LAUNCH
#define ONE_LAUNCH 1
#endif
extern "C" void kernel_launch(void* const* d_in, const int* in_sizes, int n_in, void* d_out, int out_size, void* d_ws, size_t ws_size, hipStream_t stream) {
    static int grid = 0;
    if (grid == 0) {
        if (n_in != 26 || out_size != M_TOK * DM || ws_size < WS_END) { fprintf(stderr, "kernel_launch: unexpected shapes (n_in %d, out %d, ws %zu); nothing launched\n", n_in, out_size, ws_size); grid = -1; return; }
        int dev = 0, cus = 0, per_cu = 0;
        hipGetDevice(&dev); hipDeviceGetAttribute(&cus, hipDeviceAttributeMultiprocessorCount, dev);
        if (hipFuncSetAttribute((const void*)hybrid_fwd, hipFuncAttributeMaxDynamicSharedMemorySize, LDS_BYTES) != hipSuccess) { fprintf(stderr, "kernel_launch: hipFuncSetAttribute failed\n"); grid = -1; return; }
        hipOccupancyMaxActiveBlocksPerMultiprocessor(&per_cu, (const void*)hybrid_fwd, NTHREADS, LDS_BYTES);
        (void)hipGetLastError();
        if (per_cu < 1) per_cu = 1;
        grid = cus * per_cu; if (grid > 256) grid = 256;
        if (grid < 200) { fprintf(stderr, "kernel_launch: grid %d too small for the scan/attention split\n", grid); grid = -1; return; }
    }
    if (grid < 0) return;
    Params p{};
    for (int i = 0; i < 26; ++i) p.in[i] = (const float*)d_in[i];
    p.out = (float*)d_out; p.ws = (unsigned char*)d_ws;
#if ONE_LAUNCH
    p.ph_lo = 0; p.ph_hi = N_PHASES;
    void* args[] = {&p};
    hipError_t e = hipLaunchCooperativeKernel((const void*)hybrid_fwd, dim3(grid), dim3(NTHREADS), args, LDS_BYTES, stream);
    if (e != hipSuccess) fprintf(stderr, "cooperative launch failed: %s (grid %d)\n", hipGetErrorString(e), grid);
#else
    for (int ph = 0; ph < N_PHASES; ++ph) {
        p.ph_lo = ph; p.ph_hi = ph + 1;
        hipLaunchKernelGGL(hybrid_fwd, dim3(grid), dim3(NTHREADS), LDS_BYTES, stream, p);
    }
#endif
}
```

```cpp
#include <hip/hip_runtime.h>
#include <hip/hip_cooperative_groups.h>
#include <cstdio>
#include <cstdint>
namespace cg = cooperative_groups;
namespace pg8 {
#define PG8_LAS __attribute__((address_space(3)))
typedef unsigned short bf16_t;
typedef short bf16x8 __attribute__((ext_vector_type(8)));
typedef float f32x4 __attribute__((ext_vector_type(4)));
typedef unsigned u32x4 __attribute__((ext_vector_type(4)));
constexpr int BM = 256, BK = 64, HALF = 128, HTB = HALF * BK * 2  , STAGE_BYTES = 8 * HTB, NXCD = 8, WGM = 8;

__host__ __device__ __forceinline__ int lds_byte(int r, int c) { const int st = (r >> 4) * 2 + (c >> 5), rr = r & 15, cc = c & 31, ob = rr * 64 + cc * 2; return st * 1024 + (ob ^ (((ob >> 9) & 1) << 5)); }
__host__ __device__ __forceinline__ void stage_rc(int b, int& R, int& C) { const int st = b / 1024, sb = b % 1024, swz = sb ^ (((sb >> 9) & 1) << 5); R = (st >> 1) * 16 + swz / 64; C = (st & 1) * 32 + (swz % 64) / 2; }
__host__ __device__ __forceinline__ int perm32(int rho) { const int n = rho >> 4, i = rho & 15; return 8 * (i >> 2) + 4 * n + (i & 3); }


constexpr int TIDTAB_OFF = 147200;
__device__ __forceinline__ int hw_slot() { return (int)(__builtin_amdgcn_s_getreg((5 << 11) | 4) & 63u); }
__device__ __forceinline__ int mk_tid(PG8_LAS unsigned char* lds) {
    const int lane = (int)__builtin_amdgcn_mbcnt_hi(~0u, __builtin_amdgcn_mbcnt_lo(~0u, 0u));
    const int w = __builtin_amdgcn_readfirstlane(*(volatile PG8_LAS int*)(lds + TIDTAB_OFF + 4 * hw_slot()));
    return w * 64 + lane;
}
struct Unit { int pm, pn; };
struct Gemm { const bf16_t* A; const bf16_t* Bt; int M, N, K; };

struct StaticOrder {
    int nM, nN, nwg, G, c;
    __host__ __device__ void init(int M, int N, int G_, int c_) { nM = M / BM; nN = N / BM; nwg = nM * nN; G = G_; c = c_; }
    __host__ __device__ bool next(int i, Unit& u) const {
        const long L = (long)i * G + c; if (L >= nwg) return false;
        int wgid = (int)L; { const int q = nwg / NXCD, r = nwg % NXCD, xcd = wgid % NXCD, off = wgid / NXCD; wgid = (xcd < r ? xcd * (q + 1) : r * (q + 1) + (xcd - r) * q) + off; }
        const int nig = WGM * nN, gid = wgid / nig, fm = gid * WGM, gsz = (nM - fm) < WGM ? (nM - fm) : WGM;
        u.pm = fm + ((wgid % nig) % gsz); u.pn = (wgid % nig) / gsz; return true;
    }
    __device__ __forceinline__ void a_ready(const Unit&) const {}
    __device__ __forceinline__ void done(const Unit&) const {}
};

__device__ __forceinline__ unsigned cvt_pk_bf16(float lo, float hi) { unsigned r; asm volatile("v_cvt_pk_bf16_f32 %0, %1, %2" : "=v"(r) : "v"(lo), "v"(hi)); return r; }
template <class Epi, class Sched, bool ALIGN_EPI = false, bool SP2 = false>
__device__ __forceinline__ void gemm_phase(PG8_LAS unsigned char* lds, const Gemm g, const Sched& S, const Epi& E) {
    const int tid = mk_tid(lds), wid = __builtin_amdgcn_readfirstlane(tid >> 6), lane = tid & 63, wr = wid >> 2, wc = wid & 3, fr = lane & 15, fq = lane >> 4;
    const int K = g.K, nt = K / BK;
    unsigned voffA[2], voffB[2];
#pragma unroll
    for (int i = 0; i < 2; ++i) { int R, C; stage_rc(tid * 16 + i * 8192, R, C); const int Rb = Epi::PERM ? ((R & ~31) + perm32(R & 31)) : R;
        voffA[i] = (unsigned)(R * K + C) * 2u; voffB[i] = (unsigned)(Rb * K + C) * 2u; }
    const size_t kstep = (size_t)(BK * 2);
    const size_t hstep = (size_t)HALF * K * 2;
    const size_t tstep = 2 * hstep;
    const unsigned ldsw = (unsigned)wid * 1024u;
    const int aoff = lds_byte(wr * 64 + fr, fq * 8), boff = lds_byte(wc * 32 + fr, fq * 8);
#define PG8_SA(b, h) (((b) * 2 + (h)) * HTB)
#define PG8_SB(b, h) ((4 + (b) * 2 + (h)) * HTB)
#define PG8_STAGE(bufoff, gbase, voff) do { _Pragma("unroll") for (int _i = 0; _i < 2; ++_i) \
        __builtin_amdgcn_global_load_lds((const unsigned*)((const char*)(gbase) + (voff)[_i]), (PG8_LAS unsigned*)(lds + (bufoff) + ldsw + _i * 8192), 16, 0, 0); } while (0)
#define PG8_LDA(dst, b, h) do { _Pragma("unroll") for (int m = 0; m < 4; ++m) _Pragma("unroll") for (int k = 0; k < 2; ++k) dst[m][k] = *(const PG8_LAS bf16x8*)(lds + PG8_SA(b, h) + aoff + m * 2048 + k * 1024); } while (0)
#define PG8_LDB(dst, b, h) do { _Pragma("unroll") for (int n = 0; n < 2; ++n) _Pragma("unroll") for (int k = 0; k < 2; ++k) dst[n][k] = *(const PG8_LAS bf16x8*)(lds + PG8_SB(b, h) + boff + n * 2048 + k * 1024); } while (0)
#define PG8_MMA(ai, bj, At, Bt) do { __builtin_amdgcn_s_setprio(1); _Pragma("unroll") for (int m = 0; m < 4; ++m) _Pragma("unroll") for (int n = 0; n < 2; ++n) _Pragma("unroll") for (int k = 0; k < 2; ++k) \
        acc[ai][bj][m][n] = __builtin_amdgcn_mfma_f32_16x16x32_bf16(Bt[n][k], At[m][k], acc[ai][bj][m][n], 0, 0, 0); __builtin_amdgcn_s_setprio(0); } while (0)
#define PG8_WAIT_V(n) asm volatile("s_waitcnt vmcnt(" #n ")" ::: "memory")
#define PG8_WAIT_L(n) asm volatile("s_waitcnt lgkmcnt(" #n ")" ::: "memory")
#define PG8_BAR __builtin_amdgcn_s_barrier()
#define PG8_SCHED __builtin_amdgcn_sched_barrier(0)
    Unit cur, nxt; int ui = 0;
    if (!S.next(0, cur)) return;
    f32x4 acc[2][2][4][2];
#pragma unroll
    for (int a = 0; a < 2; ++a)
#pragma unroll
        for (int b = 0; b < 2; ++b)
#pragma unroll
            for (int m = 0; m < 4; ++m)
#pragma unroll
                for (int n = 0; n < 2; ++n) acc[a][b][m][n] = (f32x4){0.f, 0.f, 0.f, 0.f};
    bf16x8 At[4][2], B0[2][2], B1[2][2];
    const char* cA = (const char*)g.A + (size_t)cur.pm * tstep; const char* cB = (const char*)g.Bt + (size_t)cur.pn * tstep;
    S.a_ready(cur);
    if constexpr (SP2) {
        PG8_STAGE(PG8_SB(0, 0), cB, voffB); PG8_STAGE(PG8_SB(0, 1), cB + hstep, voffB); PG8_STAGE(PG8_SA(0, 0), cA, voffA); PG8_STAGE(PG8_SA(0, 1), cA + hstep, voffA);
        if (wr == 1) PG8_BAR;
        PG8_WAIT_V(2); PG8_BAR;
        PG8_STAGE(PG8_SB(1, 0), cB + kstep, voffB); PG8_STAGE(PG8_SA(1, 0), cA + kstep, voffA); PG8_STAGE(PG8_SB(1, 1), cB + hstep + kstep, voffB);
        PG8_WAIT_V(6); PG8_BAR;
    } else {
        PG8_STAGE(PG8_SB(0, 0), cB, voffB); PG8_STAGE(PG8_SA(0, 0), cA, voffA); PG8_STAGE(PG8_SB(0, 1), cB + hstep, voffB); PG8_STAGE(PG8_SA(0, 1), cA + hstep, voffA);
        if (wr == 1) PG8_BAR;
        PG8_WAIT_V(4); PG8_BAR;
        PG8_STAGE(PG8_SB(1, 0), cB + kstep, voffB); PG8_STAGE(PG8_SA(1, 0), cA + kstep, voffA); PG8_STAGE(PG8_SB(1, 1), cB + hstep + kstep, voffB);
        PG8_WAIT_V(6); PG8_BAR;
    }
    for (;;) {
        const bool has_next = S.next(ui + 1, nxt);
        const char* nA = has_next ? (const char*)g.A + (size_t)nxt.pm * tstep : cA; const char* nB = has_next ? (const char*)g.Bt + (size_t)nxt.pn * tstep : cB;
        for (int t = 0; t < nt; t += 2) {
            if constexpr (Epi::KHOOK) { if (t == Epi::HK0 || t == Epi::HK1) E.khook(acc, cur, t, wr, wc, fr, fq); }
            const bool last = (t == nt - 2);
            const char* a1 = cA + (size_t)(t + 1) * kstep;
            const char* a2 = last ? nA : cA + (size_t)(t + 2) * kstep; const char* b2 = last ? nB : cB + (size_t)(t + 2) * kstep;
            const char* a3 = a2 + kstep; const char* b3 = b2 + kstep;
            if (last && has_next) S.a_ready(nxt);
            if constexpr (SP2) {
            PG8_LDB(B0, 0, 0); PG8_LDB(B1, 0, 1); PG8_SCHED; PG8_LDA(At, 0, 0); PG8_STAGE(PG8_SA(1, 1), a1 + hstep, voffA);
            PG8_WAIT_V(8); PG8_WAIT_L(0); PG8_BAR; PG8_MMA(0, 0, At, B0); PG8_MMA(0, 1, At, B1); PG8_BAR; PG8_SCHED;
            PG8_LDA(At, 0, 1); PG8_STAGE(PG8_SB(0, 0), b2, voffB); PG8_STAGE(PG8_SB(0, 1), b2 + hstep, voffB); PG8_STAGE(PG8_SA(0, 0), a2, voffA);
            PG8_WAIT_V(8); PG8_WAIT_L(0); PG8_BAR; PG8_MMA(1, 0, At, B0); PG8_MMA(1, 1, At, B1); PG8_BAR; PG8_SCHED;
            PG8_LDB(B0, 1, 0); PG8_LDB(B1, 1, 1); PG8_SCHED; PG8_LDA(At, 1, 0); PG8_STAGE(PG8_SA(0, 1), a2 + hstep, voffA);
            PG8_WAIT_V(8); PG8_WAIT_L(0); PG8_BAR; PG8_MMA(0, 0, At, B0); PG8_MMA(0, 1, At, B1); PG8_BAR; PG8_SCHED;
            PG8_LDA(At, 1, 1); PG8_STAGE(PG8_SB(1, 0), b3, voffB); PG8_STAGE(PG8_SB(1, 1), b3 + hstep, voffB); PG8_STAGE(PG8_SA(1, 0), a3, voffA);
            PG8_WAIT_V(8); PG8_WAIT_L(0); PG8_BAR; PG8_MMA(1, 0, At, B0); PG8_MMA(1, 1, At, B1); PG8_BAR; PG8_SCHED;
            } else {
            PG8_LDB(B0, 0, 0); PG8_SCHED; PG8_LDA(At, 0, 0); PG8_STAGE(PG8_SA(1, 1), a1 + hstep, voffA);
            PG8_WAIT_L(8); PG8_BAR; PG8_WAIT_L(0); PG8_MMA(0, 0, At, B0); PG8_BAR; PG8_SCHED;
            PG8_LDB(B1, 0, 1); PG8_STAGE(PG8_SB(0, 0), b2, voffB);
            PG8_BAR; PG8_WAIT_L(0); PG8_MMA(0, 1, At, B1); PG8_BAR;
            PG8_LDA(At, 0, 1); PG8_STAGE(PG8_SA(0, 0), a2, voffA);
            PG8_BAR; PG8_WAIT_L(0); PG8_MMA(1, 0, At, B0); PG8_BAR; PG8_SCHED;
            PG8_STAGE(PG8_SB(0, 1), b2 + hstep, voffB);
            PG8_WAIT_V(6); PG8_BAR; PG8_MMA(1, 1, At, B1); PG8_BAR;
            PG8_LDB(B0, 1, 0); PG8_SCHED; PG8_LDA(At, 1, 0); PG8_STAGE(PG8_SA(0, 1), a2 + hstep, voffA);
            PG8_WAIT_L(8); PG8_BAR; PG8_WAIT_L(0); PG8_MMA(0, 0, At, B0); PG8_BAR; PG8_SCHED;
            PG8_LDB(B1, 1, 1); PG8_STAGE(PG8_SB(1, 0), b3, voffB);
            PG8_BAR; PG8_WAIT_L(0); PG8_MMA(0, 1, At, B1); PG8_BAR;
            PG8_LDA(At, 1, 1); PG8_STAGE(PG8_SA(1, 0), a3, voffA);
            PG8_BAR; PG8_WAIT_L(0); PG8_MMA(1, 0, At, B0); PG8_BAR; PG8_SCHED;
            PG8_STAGE(PG8_SB(1, 1), b3 + hstep, voffB);
            PG8_WAIT_V(6); PG8_BAR; PG8_MMA(1, 1, At, B1); PG8_BAR;
            }
        }
        if constexpr (ALIGN_EPI) { if (wr == 0) PG8_BAR; }
        if constexpr (!Epi::AFTER_DRAIN) { E(acc, cur, wr, wc, fr, fq); S.done(cur); }
        if (!has_next) break;
#pragma unroll
        for (int a = 0; a < 2; ++a)
#pragma unroll
            for (int b = 0; b < 2; ++b)
#pragma unroll
                for (int m = 0; m < 4; ++m)
#pragma unroll
                    for (int n = 0; n < 2; ++n) acc[a][b][m][n] = (f32x4){0.f, 0.f, 0.f, 0.f};
        cur = nxt; cA = nA; cB = nB; ++ui;
        if constexpr (ALIGN_EPI) { if (wr == 1) PG8_BAR; }
    }
    PG8_WAIT_V(0);
    if constexpr (!ALIGN_EPI) { if (wr == 0) PG8_BAR; }
    PG8_BAR;
    if constexpr (Epi::AFTER_DRAIN) { E.fused(acc, cur, wr, wc, fr, fq, lds, wid, lane); S.done(cur); }
#undef PG8_SA
#undef PG8_SB
#undef PG8_STAGE
#undef PG8_LDA
#undef PG8_LDB
#undef PG8_MMA
#undef PG8_WAIT_V
#undef PG8_WAIT_L
#undef PG8_BAR
#undef PG8_SCHED
}
}

#define GAS __attribute__((address_space(1)))
#define LAS __attribute__((address_space(3)))
typedef unsigned short bf16;
typedef unsigned v4u __attribute__((ext_vector_type(4)));
typedef unsigned v2u __attribute__((ext_vector_type(2)));
typedef float f32x4 __attribute__((ext_vector_type(4)));
typedef float f32x2 __attribute__((ext_vector_type(2)));
typedef short bf16x8 __attribute__((ext_vector_type(8)));
typedef short s16x4 __attribute__((ext_vector_type(4)));

constexpr int NWAVES = 8, NTHREADS = 512;
constexpr int BATCH = 8, SEQ = 2048, DM = 2048, M_TOK = BATCH * SEQ;
constexpr int NPRE = 6400, NGATE = 6144, NIN = NPRE + NGATE;
constexpr int C_AQ = 0, C_AK = 768, C_AV = 1024, C_AG = 1280, C_RS = 2048, C_RR = 2048, C_RK = 2816, C_RV = 3584, C_LORA = 4352, C_RG = 4608, C_XQ = 5376, C_XG = 5888;
constexpr int NMEM = 256, MEMROWS = BATCH * NMEM;
constexpr int RW = 768, NLORA = 3072;
constexpr float NORM_EPS = 1e-6f, GN_EPS = 64e-5f;
constexpr int LDS_BYTES = 147456;

constexpr size_t MiB = 1u << 20;
constexpr size_t WS_PRE = 0, WS_MERGED = 0, WS_GATES = 200 * MiB, WS_YCAT = 392 * MiB;
constexpr size_t WS_WCAT = 456 * MiB, WS_WOUT = 464 * MiB, WS_WXKV = 472 * MiB, WS_MKV = 476 * MiB, WS_MEMN = 480 * MiB, WS_YB = 480 * MiB;
constexpr size_t WS_ROPE = 504 * MiB, WS_LORAB = 505 * MiB, WS_END = 512 * MiB;
constexpr size_t WS_CTR = 504 * MiB + 768 * 1024;
constexpr size_t DO_H = 0, DO_WIN = 64 * MiB, DO_EA = 0, DO_LIN = 96 * MiB, DO_YF = 104 * MiB;

struct Params { const float* in[26]; float* out; unsigned char* ws; int ph_lo, ph_hi; };

__device__ __forceinline__ float bf_lo(unsigned w) { return __builtin_bit_cast(float, w << 16); }
__device__ __forceinline__ float bf_hi(unsigned w) { return __builtin_bit_cast(float, w & 0xffff0000u); }
__device__ __forceinline__ float bf1(bf16 h) { return __builtin_bit_cast(float, (unsigned)h << 16); }
__device__ __forceinline__ unsigned f2bf(float f) { unsigned u = __builtin_bit_cast(unsigned, f); return (u + 0x7fffu + ((u >> 16) & 1u)) >> 16; }
typedef __bf16 bf16x2_t __attribute__((ext_vector_type(2)));
__device__ __forceinline__ unsigned pk2(float lo, float hi) { const f32x2 v = {lo, hi}; const bf16x2_t b = __builtin_convertvector(v, bf16x2_t); return __builtin_bit_cast(unsigned, b); }
__device__ __forceinline__ float sigmoidf_(float z) { return __builtin_amdgcn_rcpf(1.f + __expf(-z)); }
__device__ __forceinline__ float siluf_(float z) { return z * sigmoidf_(z); }
__device__ __forceinline__ void unpack8(v4u w, float (&x)[8]) { x[0] = bf_lo(w.x); x[1] = bf_hi(w.x); x[2] = bf_lo(w.y); x[3] = bf_hi(w.y); x[4] = bf_lo(w.z); x[5] = bf_hi(w.z); x[6] = bf_lo(w.w); x[7] = bf_hi(w.w); }
__device__ __forceinline__ void unpack4(v2u w, float (&x)[4]) { x[0] = bf_lo(w.x); x[1] = bf_hi(w.x); x[2] = bf_lo(w.y); x[3] = bf_hi(w.y); }
__device__ __forceinline__ float fma_s(float a, float b, float c) { float r; asm("v_fma_f32 %0, %1, %2, %3" : "=v"(r) : "v"(a), "v"(b), "v"(c)); return r; }
__device__ __forceinline__ float mul_s(float a, float b) { float r; asm("v_mul_f32_e32 %0, %1, %2" : "=v"(r) : "v"(a), "v"(b)); return r; }
__device__ __forceinline__ float add_s(float a, float b) { float r; asm("v_add_f32_e32 %0, %1, %2" : "=v"(r) : "v"(a), "v"(b)); return r; }
template <int CTRL> __device__ __forceinline__ float dpp_add(float v) { return v + __builtin_bit_cast(float, __builtin_amdgcn_update_dpp(0, __builtin_bit_cast(int, v), CTRL, 0xF, 0xF, true)); }
__device__ __forceinline__ float red8(float v) { v = dpp_add<0xB1>(v); v = dpp_add<0x4E>(v); v = dpp_add<0x141>(v); return v; }

using pg8::Unit;
struct EpiProj {
    static constexpr bool PERM = true, AFTER_DRAIN = false, KHOOK = false; static constexpr int HK0 = -1, HK1 = -1;
    bf16* pre; bf16* gates; const float* gate_b;
    __device__ __forceinline__ void operator()(const f32x4 (&acc)[2][2][4][2], const Unit& u, int wr, int wc, int fr, int fq) const {
        int row0 = u.pm * 256 + wr * 64 + fr;
        asm volatile("" : "+v"(row0));
        const bool isg = u.pn >= 25;
        const int pn = isg ? u.pn - 25 : u.pn;
        bf16* base = isg ? gates : pre; const int ldc = isg ? NGATE : NPRE;
        const int act = isg ? 2 : (((pn >= 5 && pn <= 7) || (pn >= 18 && pn <= 20) || pn >= 23) ? 1 : 0);
        const int col0 = pn * 256 + wc * 32 + 8 * fq;
        f32x4 bv[2][2];
#pragma unroll
        for (int bj = 0; bj < 2; ++bj) { bv[bj][0] = isg ? *(const f32x4*)(gate_b + col0 + bj * 128) : (f32x4){0.f, 0.f, 0.f, 0.f}; bv[bj][1] = isg ? *(const f32x4*)(gate_b + col0 + bj * 128 + 4) : (f32x4){0.f, 0.f, 0.f, 0.f}; }
#pragma unroll
        for (int ai = 0; ai < 2; ++ai)
#pragma unroll
            for (int m = 0; m < 4; ++m) { bf16* rowp = base + (size_t)(row0 + ai * 128 + m * 16) * ldc + col0;
                __builtin_amdgcn_sched_barrier(0);
#pragma unroll
                for (int bj = 0; bj < 2; ++bj) { f32x4 v0 = acc[ai][bj][m][0] + bv[bj][0], v1 = acc[ai][bj][m][1] + bv[bj][1];
                    if (act == 1) {
#pragma unroll
                        for (int i = 0; i < 4; ++i) { v0[i] = siluf_(v0[i]); v1[i] = siluf_(v1[i]); }
                    } else if (act == 2) {
#pragma unroll
                        for (int i = 0; i < 4; ++i) { v0[i] = sigmoidf_(v0[i]); v1[i] = sigmoidf_(v1[i]); }
                    }
                    v4u w; w.x = pk2(v0[0], v0[1]); w.y = pk2(v0[2], v0[3]); w.z = pk2(v1[0], v1[1]); w.w = pk2(v1[2], v1[3]);
                    *(v4u*)(rowp + bj * 128) = w; } }
    }
};
struct EpiPlain {
    static constexpr bool PERM = true, AFTER_DRAIN = false, KHOOK = false; static constexpr int HK0 = -1, HK1 = -1;
    bf16* O; int ldc;
    __device__ __forceinline__ void operator()(const f32x4 (&acc)[2][2][4][2], const Unit& u, int wr, int wc, int fr, int fq) const {
        int row0 = u.pm * 256 + wr * 64 + fr, col0 = u.pn * 256 + wc * 32 + 8 * fq;
        asm volatile("" : "+v"(row0), "+v"(col0));
#pragma unroll
        for (int ai = 0; ai < 2; ++ai)
#pragma unroll
            for (int m = 0; m < 4; ++m) { bf16* rowp = O + (size_t)(row0 + ai * 128 + m * 16) * ldc + col0;
#pragma unroll
                for (int bj = 0; bj < 2; ++bj) { const f32x4 v0 = acc[ai][bj][m][0], v1 = acc[ai][bj][m][1];
                    v4u w; w.x = pk2(v0[0], v0[1]); w.y = pk2(v0[2], v0[3]); w.z = pk2(v1[0], v1[1]); w.w = pk2(v1[2], v1[3]);
                    *(v4u*)(rowp + bj * 128) = w; } }
    }
};
struct EpiLora {
    static constexpr bool PERM = true, AFTER_DRAIN = false, KHOOK = false; static constexpr int HK0 = -1, HK1 = -1;
    bf16* O; const float* w0; const float* a0;
    __device__ __forceinline__ void operator()(const f32x4 (&acc)[2][2][4][2], const Unit& u, int wr, int wc, int fr, int fq) const {
        int row0 = u.pm * 256 + wr * 64 + fr, col0 = u.pn * 256 + wc * 32 + 8 * fq;
        asm volatile("" : "+v"(row0), "+v"(col0));
        const bool isw = u.pn < 6; const float* bias = isw ? (w0 + col0) : (a0 + col0 - 1536); const float sc = isw ? 0.6065306597126334f : 1.f;
        f32x4 bv[2][2];
#pragma unroll
        for (int bj = 0; bj < 2; ++bj) { bv[bj][0] = *(const f32x4*)(bias + bj * 128); bv[bj][1] = *(const f32x4*)(bias + bj * 128 + 4); }
#pragma unroll
        for (int ai = 0; ai < 2; ++ai)
#pragma unroll
            for (int m = 0; m < 4; ++m) { bf16* rowp = O + (size_t)(row0 + ai * 128 + m * 16) * NLORA + col0;
                __builtin_amdgcn_sched_barrier(0);
#pragma unroll
                for (int bj = 0; bj < 2; ++bj) { f32x4 v0 = acc[ai][bj][m][0] + bv[bj][0], v1 = acc[ai][bj][m][1] + bv[bj][1];
#pragma unroll
                    for (int i = 0; i < 4; ++i) { v0[i] = sc * sigmoidf_(v0[i]); v1[i] = sc * sigmoidf_(v1[i]); }
                    v4u w; w.x = pk2(v0[0], v0[1]); w.y = pk2(v0[2], v0[3]); w.z = pk2(v1[0], v1[1]); w.w = pk2(v1[2], v1[3]);
                    *(v4u*)(rowp + bj * 128) = w; } }
    }
};
struct EpiMerged {
    static constexpr bool PERM = true, AFTER_DRAIN = false, KHOOK = true; static constexpr int HK0 = 12, HK1 = 24;
    bf16* O; const bf16* gates;
    __device__ __forceinline__ void khook(f32x4 (&acc)[2][2][4][2], const Unit& u, int t, int wr, int wc, int fr, int fq) const {
        int row0 = u.pm * 256 + wr * 64 + fr, col0 = u.pn * 256 + wc * 32 + 8 * fq;
        asm volatile("" : "+v"(row0), "+v"(col0));
        const int bo = (t == HK0) ? 0 : DM;
#pragma unroll
        for (int ai = 0; ai < 2; ++ai) {
            v4u ga[4][2], gb[4][2];
#pragma unroll
            for (int m = 0; m < 4; ++m) { const bf16* gp = gates + (size_t)(row0 + ai * 128 + m * 16) * NGATE + bo + col0;
#pragma unroll
                for (int bj = 0; bj < 2; ++bj) { ga[m][bj] = *(const v4u*)(gp + bj * 128); gb[m][bj] = *(const v4u*)(gp + DM + bj * 128); } }
#pragma unroll
            for (int m = 0; m < 4; ++m)
#pragma unroll
                for (int bj = 0; bj < 2; ++bj) { float x[8], y[8]; unpack8(ga[m][bj], x); unpack8(gb[m][bj], y);
#pragma unroll
                    for (int i = 0; i < 4; ++i) { acc[ai][bj][m][0][i] *= x[i] * __builtin_amdgcn_rcpf(y[i]); acc[ai][bj][m][1][i] *= x[4 + i] * __builtin_amdgcn_rcpf(y[4 + i]); } }
            __builtin_amdgcn_sched_barrier(0);
        }
    }
    __device__ __forceinline__ void operator()(const f32x4 (&acc)[2][2][4][2], const Unit& u, int wr, int wc, int fr, int fq) const {
        int row0 = u.pm * 256 + wr * 64 + fr, col0 = u.pn * 256 + wc * 32 + 8 * fq;
        asm volatile("" : "+v"(row0), "+v"(col0));
#pragma unroll
        for (int ai = 0; ai < 2; ++ai) {
            v4u gg[4][2];
#pragma unroll
            for (int m = 0; m < 4; ++m)
#pragma unroll
                for (int bj = 0; bj < 2; ++bj) gg[m][bj] = *(const v4u*)(gates + (size_t)(row0 + ai * 128 + m * 16) * NGATE + 2 * DM + col0 + bj * 128);
#pragma unroll
            for (int m = 0; m < 4; ++m) { const size_t r = (size_t)(row0 + ai * 128 + m * 16);
#pragma unroll
                for (int bj = 0; bj < 2; ++bj) { const v4u g = gg[m][bj]; float x[8]; unpack8(g, x);
                    const f32x4 v0 = acc[ai][bj][m][0], v1 = acc[ai][bj][m][1];
                    v4u w; w.x = pk2(v0[0] * x[0], v0[1] * x[1]); w.y = pk2(v0[2] * x[2], v0[3] * x[3]); w.z = pk2(v1[0] * x[4], v1[1] * x[5]); w.w = pk2(v1[2] * x[6], v1[3] * x[7]);
                    *(v4u*)(O + r * DM + col0 + bj * 128) = w; } }
            __builtin_amdgcn_sched_barrier(0);
        }
    }
};
struct EpiOut {
    static constexpr bool PERM = true, AFTER_DRAIN = false, KHOOK = false; static constexpr int HK0 = -1, HK1 = -1;
    float* O; const float* X;
    __device__ __forceinline__ void operator()(const f32x4 (&acc)[2][2][4][2], const Unit& u, int wr, int wc, int fr, int fq) const {
        int row0 = u.pm * 256 + wr * 64 + fr, col0 = u.pn * 256 + wc * 32 + 8 * fq;
        asm volatile("" : "+v"(row0), "+v"(col0));
#pragma unroll
        for (int ai = 0; ai < 2; ++ai) {
            f32x4 xa[4][2], xb[4][2];
#pragma unroll
            for (int m = 0; m < 4; ++m) { const size_t o = (size_t)(row0 + ai * 128 + m * 16) * DM + col0;
#pragma unroll
                for (int bj = 0; bj < 2; ++bj) { xa[m][bj] = *(const f32x4*)(X + o + bj * 128); xb[m][bj] = *(const f32x4*)(X + o + bj * 128 + 4); } }
#pragma unroll
            for (int m = 0; m < 4; ++m) { const size_t o = (size_t)(row0 + ai * 128 + m * 16) * DM + col0;
#pragma unroll
                for (int bj = 0; bj < 2; ++bj) { *(f32x4*)(O + o + bj * 128) = xa[m][bj] + acc[ai][bj][m][0]; *(f32x4*)(O + o + bj * 128 + 4) = xb[m][bj] + acc[ai][bj][m][1]; } }
            __builtin_amdgcn_sched_barrier(0);
        }
    }
};

__device__ __forceinline__ float wave_sum(float v) {
#pragma unroll
    for (int o = 1; o < 64; o <<= 1) v += __shfl_xor(v, o);
    return v;
}
__device__ __forceinline__ void transpose_item(const float* W, int N, bf16* WT, int ldt, int koff, LAS float* scr, int item, int lane) {
    const int nblk = N / 32, kb = item / nblk, nb = item % nblk, k0 = 64 * kb, n0 = 32 * nb;
    float tv[32];
#pragma unroll
    for (int i = 0; i < 32; ++i) { const int kk = 2 * i + (lane >> 5); tv[i] = W[(size_t)(k0 + kk) * N + n0 + (lane & 31)]; }
#pragma unroll
    for (int i = 0; i < 32; ++i) { const int kk = 2 * i + (lane >> 5); scr[kk * 33 + (lane & 31)] = tv[i]; }
    asm volatile("s_waitcnt lgkmcnt(0)" ::: "memory");
    const int c = lane & 7;
#pragma unroll
    for (int j = 0; j < 4; ++j) { const int n = (lane >> 3) + 8 * j; const LAS float* s = scr + (8 * c) * 33 + n;
        v4u o; o.x = pk2(s[0 * 33], s[1 * 33]); o.y = pk2(s[2 * 33], s[3 * 33]); o.z = pk2(s[4 * 33], s[5 * 33]); o.w = pk2(s[6 * 33], s[7 * 33]);
        *(v4u*)(WT + (size_t)(n0 + n) * ldt + koff + k0 + 8 * c) = o; }
    asm volatile("s_waitcnt lgkmcnt(0)" ::: "memory");
}
__device__ __forceinline__ void rms_row_to_bf16(const float* xrow, const float* g, bf16* orow, int lane) {
    const f32x4* xr = (const f32x4*)xrow + lane; const f32x4* gr = (const f32x4*)g + lane;
    f32x4 v[8]; float s = 0.f;
#pragma unroll
    for (int j = 0; j < 8; ++j) { v[j] = xr[64 * j]; s += (v[j].x * v[j].x + v[j].y * v[j].y) + (v[j].z * v[j].z + v[j].w * v[j].w); }
    const float rstd = 1.f / sqrtf(wave_sum(s) * (1.f / DM) + NORM_EPS);
    v2u* o8 = (v2u*)orow + lane;
#pragma unroll
    for (int j = 0; j < 8; ++j) { const f32x4 gg = gr[64 * j]; v2u o; o.x = pk2(v[j].x * rstd * gg.x, v[j].y * rstd * gg.y); o.y = pk2(v[j].z * rstd * gg.z, v[j].w * rstd * gg.w); o8[64 * j] = o; }
}
__device__ __forceinline__ void p0_prologue(const Params& P, LAS unsigned char* lds, float* dout_scratch) {
    const int tid = pg8::mk_tid(lds), lane = tid & 63, wave = tid >> 6, G = gridDim.x;
    LAS float* scr = (LAS float*)(lds + wave * 16384);
    const int gw = blockIdx.x * NWAVES + wave, NGW = G * NWAVES;
    unsigned char* ws = P.ws; unsigned char* dob = (unsigned char*)P.out;
    bf16* WIN_T = (bf16*)(dob + DO_WIN); bf16* WCAT_T = (bf16*)(ws + WS_WCAT); bf16* WOUT_T = (bf16*)(ws + WS_WOUT); bf16* WXKV_T = (bf16*)(ws + WS_WXKV);
    constexpr int I_IN = 32 * (NIN / 32), I_A = 12 * 64, I_R = 12 * 64, I_X = 8 * 64, I_O = 32 * 64, I_KV = 32 * 32;
    constexpr int NITEMS = I_IN + I_A + I_R + I_X + I_O + I_KV;
    for (int it = gw; it < NITEMS; it += NGW) {
        int r = it;
        if (r < I_IN) { transpose_item(P.in[4], NIN, WIN_T, DM, 0, scr, r, lane); continue; } r -= I_IN;
        if (r < I_A) { transpose_item(P.in[9], DM, WCAT_T, DM, 0, scr, r, lane); continue; } r -= I_A;
        if (r < I_R) { transpose_item(P.in[20], DM, WCAT_T, DM, 768, scr, r, lane); continue; } r -= I_R;
        if (r < I_X) { transpose_item(P.in[24], DM, WCAT_T, DM, 1536, scr, r, lane); continue; } r -= I_X;
        if (r < I_O) { transpose_item(P.in[25], DM, WOUT_T, DM, 0, scr, r, lane); continue; } r -= I_O;
        transpose_item(P.in[21], 1024, WXKV_T, DM, 0, scr, r, lane);
    }
    bf16* H = (bf16*)(dob + DO_H); bf16* MEMN = (bf16*)(ws + WS_MEMN);
    for (int m = gw; m < M_TOK + MEMROWS; m += NGW) {
        if (m < M_TOK) rms_row_to_bf16(P.in[0] + (size_t)m * DM, P.in[2], H + (size_t)m * DM, lane);
        else rms_row_to_bf16(P.in[1] + (size_t)(m - M_TOK) * DM, P.in[3], MEMN + (size_t)(m - M_TOK) * DM, lane);
    }
    if (blockIdx.x == 0 && tid == 0) __hip_atomic_store((unsigned*)(ws + WS_CTR), 0u, __ATOMIC_RELAXED, __HIP_MEMORY_SCOPE_AGENT);
    bf16* LB = (bf16*)(ws + WS_LORAB);
    const int gt = blockIdx.x * NTHREADS + tid, NGT = G * NTHREADS;
    for (int idx = gt; idx < NLORA * 256; idx += NGT) {
        const int n = idx >> 8, k = idx & 255, d = n / RW, ch = n % RW, kb = k >> 6, kk = k & 63;
        float v = 0.f;
        if (kb == d) v = (d < 2) ? P.in[15][(size_t)(d * 64 + kk) * RW + ch] : P.in[17][(size_t)((d - 2) * 64 + kk) * RW + ch];
        LB[idx] = (bf16)f2bf(v);
    }
    float* RC = (float*)(ws + WS_ROPE); float* RS = RC + SEQ * 32;
    for (int idx = gt; idx < SEQ * 32; idx += NGT) {
        const int pos = idx >> 5, i = idx & 31;
        const float inv = __builtin_exp2f(-(float)i * (13.287712379549449f / 32.f));
        const float ang = (float)pos * inv;
        double rv = (double)ang * 0.15915494309189535; rv -= __builtin_floor(rv);
        const float r = (float)rv;
        RC[idx] = __builtin_amdgcn_cosf(r); RS[idx] = __builtin_amdgcn_sinf(r);
    }
}

__device__ __forceinline__ void p2_lora_in(const Params& P, LAS unsigned char* lds) {
    const bf16* PRE = (const bf16*)(P.ws + WS_PRE); bf16* LIN = (bf16*)((unsigned char*)P.out + DO_LIN); const float* mu = P.in[10];
    const int gt = blockIdx.x * NTHREADS + pg8::mk_tid(lds), NGT = gridDim.x * NTHREADS;
    for (int idx = gt; idx < M_TOK * 32; idx += NGT) {
        const int m = idx >> 5, j = (idx & 31) * 8, t = m & (SEQ - 1);
        const bf16* p = PRE + (size_t)m * NPRE + C_LORA + j;
        const v4u z4 = (v4u){0u, 0u, 0u, 0u};
        const v4u c = *(const v4u*)p, pv = (t > 0) ? *(const v4u*)(p - NPRE) : z4, nx = (t < SEQ - 1) ? *(const v4u*)(p + NPRE) : z4;
        const f32x4 m0 = *(const f32x4*)(mu + 2304 + j), m1 = *(const f32x4*)(mu + 2304 + j + 4);
        float xc[8], xp[8], xn[8], s[8]; unpack8(c, xc); unpack8(pv, xp); unpack8(nx, xn);
#pragma unroll
        for (int i = 0; i < 8; ++i) { const float mm = (i < 4) ? m0[i & 3] : m1[i & 3]; s[i] = xc[i] + mm * (0.5f * (xp[i] + xn[i]) - xc[i]);
            if (j < 128) s[i] = 1.f - 2.f * __builtin_amdgcn_rcpf(__expf(2.f * s[i]) + 1.f); }
        v4u o; o.x = pk2(s[0], s[1]); o.y = pk2(s[2], s[3]); o.z = pk2(s[4], s[5]); o.w = pk2(s[6], s[7]);
        *(v4u*)(LIN + (size_t)m * 256 + j) = o;
    }
}

constexpr int SC_CH = 32, SC_REC = 1536, SC_BUF = SC_CH * SC_REC, SC_SCAL = 2 * SC_BUF;
template <int MODE> __device__ __forceinline__ void scan_block(const Params& P, int sid, LAS unsigned char* lds) {
    const int tid = pg8::mk_tid(lds), lane = tid & 63, wave = __builtin_amdgcn_readfirstlane(tid >> 6);
    const int b = sid / 24, rem = sid % 24, h = rem >> 1, dir = rem & 1;
    const bf16* PRE = (const bf16*)(P.ws + WS_PRE); const bf16* EA = (const bf16*)((unsigned char*)P.out + DO_EA);
    bf16* YO = dir ? (bf16*)(P.ws + WS_YB) : (bf16*)((unsigned char*)P.out + DO_YF);
    constexpr int NCH = SEQ / SC_CH;
#define SC_BAR() do { asm volatile("s_waitcnt lgkmcnt(0)" ::: "memory"); __builtin_amdgcn_s_barrier(); asm volatile("" ::: "memory"); } while (0)
    if (wave >= 4) {
        const int pt = tid - 256, sl = pt >> 3, e = pt & 7, ch0 = h * 64 + 8 * e;
        float mur[8], muk[8], muv[8], kkc[8], kac[8];
#pragma unroll
        for (int i = 0; i < 8; ++i) { mur[i] = P.in[10][ch0 + i]; muk[i] = P.in[10][768 + ch0 + i]; muv[i] = P.in[10][1536 + ch0 + i]; kkc[i] = P.in[11][ch0 + i]; kac[i] = P.in[12][ch0 + i]; }
        v4u rc, kc, vc, rp, kp, vp, rn, kn, vn, e8, a8;
        const v4u z4 = (v4u){0u, 0u, 0u, 0u};
#define SC_PLOAD(c_) do { const int step_ = (c_) * SC_CH + sl, t_ = dir ? (SEQ - 1 - step_) : step_; const size_t m_ = (size_t)b * SEQ + t_; \
            const bf16* rowp_ = PRE + m_ * NPRE + C_RS + ch0; \
            rc = *(const v4u*)(rowp_); kc = *(const v4u*)(rowp_ + 768); vc = *(const v4u*)(rowp_ + 1536); \
            rp = (t_ > 0) ? *(const v4u*)(rowp_ - NPRE) : z4; kp = (t_ > 0) ? *(const v4u*)(rowp_ - NPRE + 768) : z4; vp = (t_ > 0) ? *(const v4u*)(rowp_ - NPRE + 1536) : z4; \
            rn = (t_ < SEQ - 1) ? *(const v4u*)(rowp_ + NPRE) : z4; kn = (t_ < SEQ - 1) ? *(const v4u*)(rowp_ + NPRE + 768) : z4; vn = (t_ < SEQ - 1) ? *(const v4u*)(rowp_ + NPRE + 1536) : z4; \
            const bf16* eap_ = EA + m_ * NLORA + dir * RW + ch0; e8 = *(const v4u*)(eap_); a8 = *(const v4u*)(eap_ + 1536); } while (0)
#define SC_PWRITE(c_) do { LAS unsigned char* buf_ = lds + ((c_) & 1) * SC_BUF; LAS float* scal_ = (LAS float*)(lds + SC_SCAL) + ((c_) & 1) * (SC_CH * 2); \
            float r[8], k[8], v[8], x0[8], x1[8], x2[8]; \
            unpack8(rc, x0); unpack8(rp, x1); unpack8(rn, x2); \
            _Pragma("unroll") for (int i = 0; i < 8; ++i) r[i] = x0[i] + mur[i] * (0.5f * (x1[i] + x2[i]) - x0[i]); \
            unpack8(kc, x0); unpack8(kp, x1); unpack8(kn, x2); \
            _Pragma("unroll") for (int i = 0; i < 8; ++i) k[i] = x0[i] + muk[i] * (0.5f * (x1[i] + x2[i]) - x0[i]); \
            unpack8(vc, x0); unpack8(vp, x1); unpack8(vn, x2); \
            _Pragma("unroll") for (int i = 0; i < 8; ++i) v[i] = x0[i] + muv[i] * (0.5f * (x1[i] + x2[i]) - x0[i]); \
            float ee[8], aa[8]; unpack8(e8, ee); unpack8(a8, aa); \
            float kk[8], ss = 0.f; \
            _Pragma("unroll") for (int i = 0; i < 8; ++i) { kk[i] = k[i] * kkc[i]; ss += kk[i] * kk[i]; } \
            ss = red8(ss); \
            const float inv = 1.f / fmaxf(sqrtf(ss), 1e-12f); \
            float nkk[8], dd[8], dr[8], bb[8], kd[8], sbr = 0.f, skr = 0.f; \
            _Pragma("unroll") for (int i = 0; i < 8; ++i) { \
                const float kki = kk[i] * inv; nkk[i] = -kki; dd[i] = __expf(-ee[i]); dr[i] = dd[i] * r[i]; \
                bb[i] = kki * aa[i]; kd[i] = k[i] * (1.f + (aa[i] - 1.f) * kac[i]); sbr += bb[i] * r[i]; skr += kd[i] * r[i]; } \
            sbr = red8(sbr); skr = red8(skr); \
            LAS float* rec = (LAS float*)(buf_ + sl * SC_REC) + 8 * e; \
            *(LAS f32x4*)(rec) = (f32x4){nkk[0], nkk[1], nkk[2], nkk[3]}; *(LAS f32x4*)(rec + 4) = (f32x4){nkk[4], nkk[5], nkk[6], nkk[7]}; \
            *(LAS f32x4*)(rec + 64) = (f32x4){dr[0], dr[1], dr[2], dr[3]}; *(LAS f32x4*)(rec + 68) = (f32x4){dr[4], dr[5], dr[6], dr[7]}; \
            *(LAS f32x4*)(rec + 128) = (f32x4){dd[0], dd[1], dd[2], dd[3]}; *(LAS f32x4*)(rec + 132) = (f32x4){dd[4], dd[5], dd[6], dd[7]}; \
            *(LAS f32x4*)(rec + 192) = (f32x4){bb[0], bb[1], bb[2], bb[3]}; *(LAS f32x4*)(rec + 196) = (f32x4){bb[4], bb[5], bb[6], bb[7]}; \
            *(LAS f32x4*)(rec + 256) = (f32x4){kd[0], kd[1], kd[2], kd[3]}; *(LAS f32x4*)(rec + 260) = (f32x4){kd[4], kd[5], kd[6], kd[7]}; \
            *(LAS f32x4*)(rec + 320) = (f32x4){v[0], v[1], v[2], v[3]}; *(LAS f32x4*)(rec + 324) = (f32x4){v[4], v[5], v[6], v[7]}; \
            if (e == 0) *(LAS f32x2*)(scal_ + 2 * sl) = (f32x2){sbr, skr}; } while (0)
        if (!(MODE & 2)) { SC_PLOAD(0); SC_PWRITE(0); SC_PLOAD(1); }
        SC_BAR();
        for (int c = 0; c < NCH; ++c) {
            if (!(MODE & 2)) { if (c + 1 < NCH) SC_PWRITE(c + 1);
            if (c + 2 < NCH) SC_PLOAD(c + 2); }
            SC_BAR();
        }
#undef SC_PLOAD
#undef SC_PWRITE
    } else {
        const int rp = (wave * 64 + lane) >> 3, cgp = lane & 7;
        f32x2 s0[4], s1[4];
#pragma unroll
        for (int i = 0; i < 4; ++i) { s0[i] = (f32x2){0.f, 0.f}; s1[i] = (f32x2){0.f, 0.f}; }
        bf16* yrow = YO + (size_t)b * SEQ * RW + h * 64 + 2 * rp;
        SC_BAR();
#define SC_LOAD(N0, N1, Q0, Q1, D0, D1, B0, B1, K0, K1, VV, SS, sl_) do { const LAS float* rec_ = (const LAS float*)(buf + (sl_) * SC_REC) + 8 * cgp; \
            N0 = *(const LAS f32x4*)(rec_); N1 = *(const LAS f32x4*)(rec_ + 4); Q0 = *(const LAS f32x4*)(rec_ + 64); Q1 = *(const LAS f32x4*)(rec_ + 68); \
            D0 = *(const LAS f32x4*)(rec_ + 128); D1 = *(const LAS f32x4*)(rec_ + 132); B0 = *(const LAS f32x4*)(rec_ + 192); B1 = *(const LAS f32x4*)(rec_ + 196); \
            K0 = *(const LAS f32x4*)(rec_ + 256); K1 = *(const LAS f32x4*)(rec_ + 260); \
            VV = *(const LAS f32x2*)((const LAS float*)(buf + (sl_) * SC_REC) + 320 + 2 * rp); SS = *(const LAS f32x2*)(scal + 2 * (sl_)); } while (0)
        for (int c = 0; c < NCH; ++c) {
            const LAS unsigned char* buf = lds + (c & 1) * SC_BUF; const LAS float* scal = (const LAS float*)(lds + SC_SCAL) + (c & 1) * (SC_CH * 2);
            f32x4 n0, n1, q0, q1, d0, d1, b0, b1, k0, k1; f32x2 vv, sc;
            SC_LOAD(n0, n1, q0, q1, d0, d1, b0, b1, k0, k1, vv, sc, 0);
#pragma unroll 2
            for (int sl = 0; sl < SC_CH; ++sl) {
                f32x4 xn0, xn1, xq0, xq1, xd0, xd1, xb0, xb1, xk0, xk1; f32x2 xvv, xsc;
                const int sn = (sl + 1 < SC_CH) ? sl + 1 : sl;
                const f32x2 nk[4] = {(f32x2){n0.x, n0.y}, (f32x2){n0.z, n0.w}, (f32x2){n1.x, n1.y}, (f32x2){n1.z, n1.w}};
                const f32x2 qq[4] = {(f32x2){q0.x, q0.y}, (f32x2){q0.z, q0.w}, (f32x2){q1.x, q1.y}, (f32x2){q1.z, q1.w}};
                const f32x2 dv[4] = {(f32x2){d0.x, d0.y}, (f32x2){d0.z, d0.w}, (f32x2){d1.x, d1.y}, (f32x2){d1.z, d1.w}};
                const f32x2 bv[4] = {(f32x2){b0.x, b0.y}, (f32x2){b0.z, b0.w}, (f32x2){b1.x, b1.y}, (f32x2){b1.z, b1.w}};
                const f32x2 kv[4] = {(f32x2){k0.x, k0.y}, (f32x2){k0.z, k0.w}, (f32x2){k1.x, k1.y}, (f32x2){k1.z, k1.w}};
                f32x2 a0 = s0[0] * nk[0], a1 = s1[0] * nk[0], y0 = s0[0] * qq[0], y1 = s1[0] * qq[0];
#pragma unroll
                for (int i = 1; i < 4; ++i) { a0 = s0[i] * nk[i] + a0; a1 = s1[i] * nk[i] + a1; y0 = s0[i] * qq[i] + y0; y1 = s1[i] * qq[i] + y1; }
                float sa0 = a0.x + a0.y, sa1 = a1.x + a1.y, yp0 = y0.x + y0.y, yp1 = y1.x + y1.y;
                SC_LOAD(xn0, xn1, xq0, xq1, xd0, xd1, xb0, xb1, xk0, xk1, xvv, xsc, sn);
                sa0 = red8(sa0); sa1 = red8(sa1); yp0 = red8(yp0); yp1 = red8(yp1);
                const float yo0 = yp0 + sa0 * sc.x + vv.x * sc.y, yo1 = yp1 + sa1 * sc.x + vv.y * sc.y;
                const f32x2 sa0v = (f32x2){sa0, sa0}, sa1v = (f32x2){sa1, sa1}, v0v = (f32x2){vv.x, vv.x}, v1v = (f32x2){vv.y, vv.y};
#pragma unroll
                for (int i = 0; i < 4; ++i) {
                    f32x2 t0 = v0v * kv[i]; t0 = sa0v * bv[i] + t0; s0[i] = s0[i] * dv[i] + t0;
                    f32x2 t1 = v1v * kv[i]; t1 = sa1v * bv[i] + t1; s1[i] = s1[i] * dv[i] + t1;
                }
                const int step = c * SC_CH + sl, t = dir ? (SEQ - 1 - step) : step;
                const unsigned yw = pk2(yo0, yo1);
                if (!(MODE & 1)) { if (cgp == 0) *(unsigned*)(yrow + (size_t)t * RW) = yw; } else { asm volatile("" :: "v"(yw)); }
                n0 = xn0; n1 = xn1; q0 = xq0; q1 = xq1; d0 = xd0; d1 = xd1; b0 = xb0; b1 = xb1; k0 = xk0; k1 = xk1; vv = xvv; sc = xsc;
            }
            SC_BAR();
        }
#undef SC_LOAD
    }
#undef SC_BAR
    __syncthreads();
}

__device__ __forceinline__ bf16x8 pack8(const float (&x)[8]) {
    v4u w; w.x = pk2(x[0], x[1]); w.y = pk2(x[2], x[3]); w.z = pk2(x[4], x[5]); w.w = pk2(x[6], x[7]); return __builtin_bit_cast(bf16x8, w);
}
#define MFMA16(a, b, c) __builtin_amdgcn_mfma_f32_16x16x32_bf16((a), (b), (c), 0, 0, 0)
constexpr int CK = 16, NCK = SEQ / CK;
constexpr int L_QK = 0, L_PR = 4608, L_QKT = 9216, L_VT = 14336, L_VF = 19456, L_GC = 23552, L_OPSZ = 23808;
constexpr int L_E = 2 * L_OPSZ, L_G = L_E + 4096, L_GSZ = 5120, L_W0 = L_G + 2 * L_GSZ, L_VG = L_W0 + 4096, L_SB = L_VG + 2 * 4096, L_CEND = L_SB + 9216;
static_assert(L_CEND + 1280 <= 131072, "chunked scan LDS map");
#ifdef CBAR_FULL
#define CBAR() __syncthreads()
#else
#define CBAR() do { __builtin_amdgcn_s_waitcnt(0xC07F); __builtin_amdgcn_s_barrier(); } while (0)
#endif
__device__ __forceinline__ void scan_chunked(const Params& P, int sid, LAS unsigned char* lds) {
    const int tid = pg8::mk_tid(lds), lane = tid & 63, wave = __builtin_amdgcn_readfirstlane(tid >> 6), l15 = lane & 15, q4 = lane >> 4;
    const int b = sid / 24, rem = sid % 24, h = rem >> 1, dir = rem & 1;
    const bf16* PRE = (const bf16*)(P.ws + WS_PRE); const bf16* EA = (const bf16*)((unsigned char*)P.out + DO_EA);
    bf16* YO = dir ? (bf16*)(P.ws + WS_YB) : (bf16*)((unsigned char*)P.out + DO_YF);
#ifdef YZERO
    for (int it = tid; it < SEQ * 8; it += NTHREADS) *(v4u*)(YO + ((size_t)b * SEQ + (it >> 3)) * RW + h * 64 + (it & 7) * 8) = (v4u){0u, 0u, 0u, 0u};
#endif
    for (int i = tid; i < 9216 / 4; i += NTHREADS) ((LAS unsigned*)(lds + L_SB))[i] = 0u;
    for (int i = tid; i < L_SB / 4; i += NTHREADS) ((LAS unsigned*)(lds))[i] = 0u;
    if (tid < 320) { const int vsel = tid >> 6, chn = h * 64 + (tid & 63);
        ((LAS float*)(lds + L_CEND))[tid] = (vsel < 3) ? P.in[10][vsel * 768 + chn] : ((vsel == 3) ? P.in[11][chn] : P.in[12][chn]); }
    CBAR();
    if (wave >= 4) {
        const int pt = tid - 256, t = pt >> 4, e = pt & 15, ch0 = h * 64 + 4 * e, gsw = 8 * ((e >> 1) & 3);
        const LAS float* cst = (const LAS float*)(lds + L_CEND) + 4 * e;
        v2u rcA, kcA, vcA, rpA, kpA, vpA, rnA, knA, vnA, e8A, a8A, rcB, kcB, vcB, rpB, kpB, vpB, rnB, knB, vnB, e8B, a8B;
        const v2u z2 = (v2u){0u, 0u};
#define CK_PLOAD(X, c_) do { const int step_ = (c_) * CK + t, t_ = dir ? (SEQ - 1 - step_) : step_; const size_t m_ = (size_t)b * SEQ + t_; \
            const bf16* rowp_ = PRE + m_ * NPRE + C_RS + ch0; \
            const bf16* rowq_ = (t_ > 0) ? rowp_ - NPRE : rowp_; const bf16* rown_ = (t_ < SEQ - 1) ? rowp_ + NPRE : rowp_;     \
            rc##X = *(const v2u*)(rowp_); kc##X = *(const v2u*)(rowp_ + 768); vc##X = *(const v2u*)(rowp_ + 1536); \
            rp##X = *(const v2u*)(rowq_); kp##X = *(const v2u*)(rowq_ + 768); vp##X = *(const v2u*)(rowq_ + 1536); \
            rn##X = *(const v2u*)(rown_); kn##X = *(const v2u*)(rown_ + 768); vn##X = *(const v2u*)(rown_ + 1536); \
            const bf16* eap_ = EA + m_ * NLORA + dir * RW + ch0; e8##X = *(const v2u*)(eap_); a8##X = *(const v2u*)(eap_ + 1536); } while (0)
        CK_PLOAD(A, 0); CK_PLOAD(B, 1);
        float r[4], k[4], v[4], kk[4], aa[4], ee[4];
#define CK_PBODY(X, c_) do { const int c = (c_); const int pb = (c & 1) * L_OPSZ; \
            {   \
                float x0[4], x1[4], x2[4]; f32x4 cc; \
                const int stepc_ = ((c < NCK) ? c : NCK - 1) * CK + t, tc_ = dir ? (SEQ - 1 - stepc_) : stepc_; const float fp_ = (tc_ > 0) ? 1.f : 0.f, fn_ = (tc_ < SEQ - 1) ? 1.f : 0.f; \
                unpack4(rc##X, x0); unpack4(rp##X, x1); unpack4(rn##X, x2); cc = *(const LAS f32x4*)(cst); \
                _Pragma("unroll") for (int i = 0; i < 4; ++i) r[i] = x0[i] + cc[i] * (0.5f * (fp_ * x1[i] + fn_ * x2[i]) - x0[i]); \
                unpack4(kc##X, x0); unpack4(kp##X, x1); unpack4(kn##X, x2); cc = *(const LAS f32x4*)(cst + 64); \
                _Pragma("unroll") for (int i = 0; i < 4; ++i) k[i] = x0[i] + cc[i] * (0.5f * (fp_ * x1[i] + fn_ * x2[i]) - x0[i]); \
                unpack4(vc##X, x0); unpack4(vp##X, x1); unpack4(vn##X, x2); cc = *(const LAS f32x4*)(cst + 128); \
                _Pragma("unroll") for (int i = 0; i < 4; ++i) v[i] = x0[i] + cc[i] * (0.5f * (fp_ * x1[i] + fn_ * x2[i]) - x0[i]); \
                unpack4(e8##X, ee); unpack4(a8##X, aa); cc = *(const LAS f32x4*)(cst + 192); \
                float ss = 0.f; \
                _Pragma("unroll") for (int i = 0; i < 4; ++i) { kk[i] = k[i] * cc[i]; ss += kk[i] * kk[i]; } \
                ss = red8(ss); ss = dpp_add<0x140>(ss); \
                const float inv = __builtin_amdgcn_rcpf(fmaxf(__builtin_amdgcn_sqrtf(ss), 1e-12f)); \
                _Pragma("unroll") for (int i = 0; i < 4; ++i) kk[i] *= inv; \
                *(LAS f32x4*)((LAS float*)(lds + L_E) + t * 64 + 4 * e) = (f32x4){ee[0], ee[1], ee[2], ee[3]}; \
                CK_PLOAD(X, (c + 2 < NCK) ? c + 2 : NCK - 1); \
            } \
            CBAR(); \
            { \
                f32x4 gs = (f32x4){0.f, 0.f, 0.f, 0.f}; \
                _Pragma("unroll") for (int u = 0; u < CK; ++u) { \
                    const f32x4 ea = *(const LAS f32x4*)((const LAS float*)(lds + L_E) + u * 64 + 4 * e); \
                    const float m = (u <= t) ? 1.f : 0.f; gs += m * ea; } \
                const f32x4 kac = *(const LAS f32x4*)(cst + 256); \
                float qv[4], kt[4], pv[4], rt[4], gin[4]; \
                _Pragma("unroll") for (int i = 0; i < 4; ++i) { \
                    gin[i] = __expf(-gs[i]); const float gex = __expf(ee[i] - gs[i]), ginv = __expf(gs[i]); \
                    const float kd = k[i] * (1.f + (aa[i] - 1.f) * kac[i]); \
                    qv[i] = kk[i] * aa[i] * ginv; kt[i] = kd * ginv; pv[i] = kk[i] * gex; rt[i] = r[i] * gin[i]; \
                } \
                LAS unsigned char* ob = lds + pb; \
                unsigned wq[4]; v2u o; \
                _Pragma("unroll") for (int i = 0; i < 4; ++i) wq[i] = pk2(qv[i], kt[i]);                        \
                o.x = (wq[0] & 0xffffu) | (wq[1] << 16); o.y = (wq[2] & 0xffffu) | (wq[3] << 16); *(LAS v2u*)(ob + L_QK + (t * 72 + 4 * e) * 2) = o; \
                o.x = (wq[0] >> 16) | (wq[1] & 0xffff0000u); o.y = (wq[2] >> 16) | (wq[3] & 0xffff0000u); *(LAS v2u*)(ob + L_QK + ((16 + t) * 72 + 4 * e) * 2) = o; \
                o.x = pk2(pv[0], pv[1]); o.y = pk2(pv[2], pv[3]); *(LAS v2u*)(ob + L_PR + (t * 72 + 4 * e) * 2) = o; \
                o.x = pk2(rt[0], rt[1]); o.y = pk2(rt[2], rt[3]); *(LAS v2u*)(ob + L_PR + ((16 + t) * 72 + 4 * e) * 2) = o; \
                const unsigned wv01 = pk2(v[0], v[1]), wv23 = pk2(v[2], v[3]); \
                _Pragma("unroll") for (int i = 0; i < 4; ++i) { \
                    *(LAS bf16*)(ob + L_QKT + ((4 * e + i) * 40 + (t ^ gsw)) * 2) = (bf16)(wq[i] & 0xffffu); *(LAS bf16*)(ob + L_QKT + ((4 * e + i) * 40 + ((16 + t) ^ gsw)) * 2) = (bf16)(wq[i] >> 16); \
                    const unsigned wv = (i < 2) ? wv01 : wv23; \
                    *(LAS bf16*)(ob + L_VT + ((4 * e + i) * 40 + ((16 + t) ^ gsw)) * 2) = (bf16)((i & 1) ? (wv >> 16) : (wv & 0xffffu)); \
                } \
                if (t == CK - 1) *(LAS f32x4*)((LAS float*)(ob + L_GC) + 4 * e) = (f32x4){gin[0], gin[1], gin[2], gin[3]}; \
            } \
            CBAR(); \
            CBAR(); } while (0)
        static_assert((NCK + 2) % 2 == 0, "producer loop is unrolled by two");
        for (int c2 = 0; c2 <= NCK + 1; c2 += 2) { CK_PBODY(A, c2); CK_PBODY(B, c2 + 1); }
#undef CK_PBODY
#undef CK_PLOAD
    } else {
        const int w = wave;
        f32x4 acc[4];
#pragma unroll
        for (int nt = 0; nt < 4; ++nt) acc[nt] = (f32x4){0.f, 0.f, 0.f, 0.f};
        bf16* ybase = YO + (size_t)b * SEQ * RW + h * 64 + 16 * w + 4 * q4;
        for (int c = 0; c <= NCK + 1; ++c) {
            const int ck = c - 1; const bool valid = (ck >= 0 && ck < NCK);
            const int pb = (ck & 1) * L_OPSZ, gb = L_G + (ck & 1) * L_GSZ;
            f32x4 r1 = (f32x4){0.f, 0.f, 0.f, 0.f};
            if (valid) {
                f32x4 r0 = (f32x4){0.f, 0.f, 0.f, 0.f};
#pragma unroll
                for (int ks = 0; ks < 2; ++ks) {
                    const bf16x8 S = *(const LAS bf16x8*)(lds + L_SB + ((16 * w + l15) * 72 + ks * 32 + 8 * q4) * 2);
                    const bf16x8 Bp = *(const LAS bf16x8*)(lds + pb + L_PR + ((l15) * 72 + ks * 32 + 8 * q4) * 2);
                    const bf16x8 Br = *(const LAS bf16x8*)(lds + pb + L_PR + ((16 + l15) * 72 + ks * 32 + 8 * q4) * 2);
                    r0 = MFMA16(S, Bp, r0); r1 = MFMA16(S, Br, r1);
                }
                *(LAS f32x4*)(lds + L_W0 + (l15 * 64 + 16 * w + 4 * q4) * 4) = r0;
            }
            if (valid && w == 1) {
#pragma unroll
                for (int x = 0; x < 4; ++x) {
                    const int a = x >> 1, bc = x & 1;
                    f32x4 g = (f32x4){0.f, 0.f, 0.f, 0.f};
#pragma unroll
                    for (int ks = 0; ks < 2; ++ks) {
                        const bf16x8 A = *(const LAS bf16x8*)(lds + pb + L_QK + ((a * 16 + l15) * 72 + ks * 32 + 8 * q4) * 2);
                        const bf16x8 Bm = *(const LAS bf16x8*)(lds + pb + L_PR + ((bc * 16 + l15) * 72 + ks * 32 + 8 * q4) * 2);
                        g = MFMA16(A, Bm, g);
                    }
                    *(LAS f32x4*)(lds + gb + x * 1280 + (l15 * 20 + 4 * q4) * 4) = g;
                }
                __builtin_amdgcn_s_waitcnt(0xC07F);
                float bw[8];
                {
                    const f32x4 ga = *(const LAS f32x4*)(lds + gb + 2 * 1280 + (l15 * 20 + 8 * (q4 & 1)) * 4), gb2 = *(const LAS f32x4*)(lds + gb + 2 * 1280 + (l15 * 20 + 8 * (q4 & 1) + 4) * 4);
#pragma unroll
                    for (int ii = 0; ii < 8; ++ii) { const int s = 8 * (q4 & 1) + ii; const float gv = (ii < 4) ? ga[ii & 3] : gb2[ii & 3]; bw[ii] = (q4 >= 2 && s < l15) ? gv : 0.f; }
                }
                const bf16x8 Bf = pack8(bw);
#pragma unroll
                for (int mt = 0; mt < 4; ++mt) {
                    const bf16x8 Av = *(const LAS bf16x8*)(lds + pb + L_VT + ((mt * 16 + l15) * 40 + 8 * (q4 ^ (((mt * 16 + l15) >> 3) & 3))) * 2);
                    f32x4 r = (f32x4){0.f, 0.f, 0.f, 0.f};
                    r = MFMA16(Av, Bf, r);
                    *(LAS f32x4*)(lds + L_VG + (ck & 1) * 4096 + (l15 * 64 + mt * 16 + 4 * q4) * 4) = r;
                }
            }
            CBAR();
            if (valid && w == 0) {
                const int i = lane;
                float u[16];
#pragma unroll
                for (int s = 0; s < 16; ++s) u[s] = *(const LAS float*)(lds + L_W0 + (s * 64 + i) * 4) + *(const LAS float*)(lds + L_VG + (ck & 1) * 4096 + (s * 64 + i) * 4);
#pragma unroll
                for (int blk = 0; blk < 4; ++blk) {
                    f32x4 gq[4][4];
#pragma unroll
                    for (int tt = 0; tt < 4; ++tt)
#pragma unroll
                        for (int s4 = 0; s4 <= blk; ++s4) gq[tt][s4] = *(const LAS f32x4*)(lds + gb + 0 * 1280 + ((4 * blk + tt) * 20 + 4 * s4) * 4);
#pragma unroll
                    for (int s = 0; s < 4 * blk; ++s)
#pragma unroll
                        for (int tt = 0; tt < 4; ++tt) u[4 * blk + tt] -= gq[tt][s >> 2][s & 3] * u[s];
#pragma unroll
                    for (int tt = 1; tt < 4; ++tt)
#pragma unroll
                        for (int sp = 0; sp < tt; ++sp) u[4 * blk + tt] -= gq[tt][blk][sp] * u[4 * blk + sp];
                    __builtin_amdgcn_sched_barrier(0);
                }
                float n0[8], n1[8];
#pragma unroll
                for (int s = 0; s < 8; ++s) { n0[s] = -u[s]; n1[s] = -u[8 + s]; }
                *(LAS bf16x8*)(lds + pb + L_VT + (i * 40 + 8 * (0 ^ ((i >> 3) & 3))) * 2) = pack8(n0); *(LAS bf16x8*)(lds + pb + L_VT + (i * 40 + 8 * (1 ^ ((i >> 3) & 3))) * 2) = pack8(n1);
            }
            CBAR();
            if (valid) {
                const bf16x8 Bv = *(const LAS bf16x8*)(lds + pb + L_VT + ((16 * w + l15) * 40 + 8 * (q4 ^ (((16 * w + l15) >> 3) & 3))) * 2);
                {
                    const int xo = (q4 < 2) ? 1 : 3;
                    const f32x4 ga = *(const LAS f32x4*)(lds + gb + xo * 1280 + (l15 * 20 + 8 * (q4 & 1)) * 4), gb2 = *(const LAS f32x4*)(lds + gb + xo * 1280 + (l15 * 20 + 8 * (q4 & 1) + 4) * 4);
                    float bw[8];
#pragma unroll
                    for (int ii = 0; ii < 8; ++ii) { const int s = 8 * (q4 & 1) + ii; const float gv = (ii < 4) ? ga[ii & 3] : gb2[ii & 3]; bw[ii] = (s <= l15) ? gv : 0.f; }
                    const f32x4 y = MFMA16(Bv, pack8(bw), r1);
                    const int step = ck * CK + l15, tt = dir ? (SEQ - 1 - step) : step;
                    v2u o; o.x = pk2(y[0], y[1]); o.y = pk2(y[2], y[3]);
                    *(v2u*)(ybase + (size_t)tt * RW) = o;
                }
#pragma unroll
                for (int nt = 0; nt < 4; ++nt) {
                    const bf16x8 Aq = *(const LAS bf16x8*)(lds + pb + L_QKT + ((nt * 16 + l15) * 40 + 8 * (q4 ^ (((nt * 16 + l15) >> 3) & 3))) * 2);
                    acc[nt] = MFMA16(Aq, Bv, acc[nt]);
                    const f32x4 gc = *(const LAS f32x4*)(lds + pb + L_GC + (nt * 16 + 4 * q4) * 4);
                    acc[nt] = acc[nt] * gc;
                    v2u o; o.x = pk2(acc[nt][0], acc[nt][1]); o.y = pk2(acc[nt][2], acc[nt][3]);
                    *(LAS v2u*)(lds + L_SB + ((16 * w + l15) * 72 + nt * 16 + 4 * q4) * 2) = o;
                }
            }
            CBAR();
        }
    }
    __syncthreads();
}
#undef CBAR

constexpr int KA_P = 72, VA_P = 392;
__device__ __forceinline__ void attnA_item(const Params& P, int item, LAS unsigned char* lds) {
    const int tid = pg8::mk_tid(lds), lane = tid & 63, wave = __builtin_amdgcn_readfirstlane(tid >> 6), l15 = lane & 15, q4 = lane >> 4;
    const int b = item >> 6, n = (item >> 2) & 15, hk = item & 3;
    const bf16* PRE = (const bf16*)(P.ws + WS_PRE); bf16* YC = (bf16*)(P.ws + WS_YCAT);
    const float* RC = (const float*)(P.ws + WS_ROPE); const float* RS = RC + SEQ * 32;
    LAS bf16* Ks = (LAS bf16*)lds; LAS bf16* Vt = Ks + 384 * KA_P;
    {
        v2u klo[6], khi[6]; f32x4 kcs[6], ksn[6]; v4u vw[6];
#pragma unroll
        for (int u = 0; u < 6; ++u) {
            const int it = tid + u * NTHREADS, j = it >> 3, c = it & 7, kp = (n - 1) * 128 + j;
            const bool ok = (kp >= 0 && kp < SEQ); const int kpc = ok ? kp : 0;
            const bf16* src = PRE + ((size_t)b * SEQ + kpc) * NPRE + C_AK + hk * 64;
            klo[u] = *(const v2u*)(src + 4 * c); khi[u] = *(const v2u*)(src + 32 + 4 * c);
            kcs[u] = *(const f32x4*)(RC + kpc * 32 + 4 * c); ksn[u] = *(const f32x4*)(RS + kpc * 32 + 4 * c);
            vw[u] = *(const v4u*)(PRE + ((size_t)b * SEQ + kpc) * NPRE + C_AV + hk * 64 + 8 * c);
        }
        const f32x4 g1 = *(const f32x4*)(P.in[7] + 4 * (tid & 7)), g2 = *(const f32x4*)(P.in[7] + 32 + 4 * (tid & 7));
#pragma unroll
        for (int u = 0; u < 6; ++u) {
            const int it = tid + u * NTHREADS, j = it >> 3, c = it & 7, kp = (n - 1) * 128 + j;
            const bool ok = (kp >= 0 && kp < SEQ);
            float x1[4], x2[4]; unpack4(klo[u], x1); unpack4(khi[u], x2);
            float ss = 0.f;
#pragma unroll
            for (int i = 0; i < 4; ++i) ss += x1[i] * x1[i] + x2[i] * x2[i];
            ss = red8(ss);
            const float rstd = ok ? 1.f / sqrtf(ss * (1.f / 64.f) + NORM_EPS) : 0.f;
            float r1[4], r2[4];
#pragma unroll
            for (int i = 0; i < 4; ++i) { const float y1 = x1[i] * rstd * g1[i], y2 = x2[i] * rstd * g2[i]; r1[i] = y1 * kcs[u][i] - y2 * ksn[u][i]; r2[i] = y2 * kcs[u][i] + y1 * ksn[u][i]; }
            v2u o0, o1; o0.x = pk2(r1[0], r1[1]); o0.y = pk2(r1[2], r1[3]); o1.x = pk2(r2[0], r2[1]); o1.y = pk2(r2[2], r2[3]);
            *(LAS v2u*)(Ks + j * KA_P + 4 * c) = o0; *(LAS v2u*)(Ks + j * KA_P + 32 + 4 * c) = o1;
            const v4u w = ok ? vw[u] : (v4u){0u, 0u, 0u, 0u};
            LAS bf16* d = Vt + (8 * c) * VA_P + j;
            d[0] = (bf16)(w.x & 0xffffu); d[VA_P] = (bf16)(w.x >> 16); d[2 * VA_P] = (bf16)(w.y & 0xffffu); d[3 * VA_P] = (bf16)(w.y >> 16);
            d[4 * VA_P] = (bf16)(w.z & 0xffffu); d[5 * VA_P] = (bf16)(w.z >> 16); d[6 * VA_P] = (bf16)(w.w & 0xffffu); d[7 * VA_P] = (bf16)(w.w >> 16);
        }
    }
    v4u qlo, qhi;
    {
        const int R0 = wave * 48, g = R0 >> 7, pos = (R0 & 127) + l15, qp = n * 128 + pos, hq = hk * 3 + g;
        const bf16* src = PRE + ((size_t)b * SEQ + qp) * NPRE + C_AQ + hq * 64;
        qlo = *(const v4u*)(src + 8 * q4); qhi = *(const v4u*)(src + 32 + 8 * q4);
    }
    __syncthreads();
#pragma unroll 1
    for (int mt = 0; mt < 3; ++mt) {
        const int R0 = wave * 48 + mt * 16, g = R0 >> 7, pos = (R0 & 127) + l15, qp = n * 128 + pos, hq = hk * 3 + g;
        const size_t m = (size_t)b * SEQ + qp;
        v2u gat[4];
#pragma unroll
        for (int dt = 0; dt < 4; ++dt) gat[dt] = *(const v2u*)(PRE + m * NPRE + C_AG + hq * 64 + dt * 16 + 4 * q4);
        const v4u cqlo = qlo, cqhi = qhi;
        {
            const int mn = (mt < 2) ? mt + 1 : 2, R1 = wave * 48 + mn * 16, g1_ = R1 >> 7, pos1 = (R1 & 127) + l15, qp1 = n * 128 + pos1, hq1 = hk * 3 + g1_;
            const bf16* src = PRE + ((size_t)b * SEQ + qp1) * NPRE + C_AQ + hq1 * 64;
            qlo = *(const v4u*)(src + 8 * q4); qhi = *(const v4u*)(src + 32 + 8 * q4);
        }
        bf16x8 qf0, qf1;
        {
            float x1[8], x2[8]; unpack8(cqlo, x1); unpack8(cqhi, x2);
            float ss = 0.f;
#pragma unroll
            for (int i = 0; i < 8; ++i) ss += x1[i] * x1[i] + x2[i] * x2[i];
            ss += __shfl_xor(ss, 16); ss += __shfl_xor(ss, 32);
            const float rstd = (0.125f * 1.4426950408889634f) / sqrtf(ss * (1.f / 64.f) + NORM_EPS);
            float r1[8], r2[8];
            const f32x4 ga = *(const f32x4*)(P.in[6] + 8 * q4), gb = *(const f32x4*)(P.in[6] + 8 * q4 + 4), gc = *(const f32x4*)(P.in[6] + 32 + 8 * q4), gd = *(const f32x4*)(P.in[6] + 36 + 8 * q4);
            const f32x4 ca = *(const f32x4*)(RC + qp * 32 + 8 * q4), cb = *(const f32x4*)(RC + qp * 32 + 8 * q4 + 4), sa_ = *(const f32x4*)(RS + qp * 32 + 8 * q4), sb_ = *(const f32x4*)(RS + qp * 32 + 8 * q4 + 4);
#pragma unroll
            for (int i = 0; i < 8; ++i) {
                const float g1 = (i < 4) ? ga[i & 3] : gb[i & 3], g2 = (i < 4) ? gc[i & 3] : gd[i & 3], cs = (i < 4) ? ca[i & 3] : cb[i & 3], sn = (i < 4) ? sa_[i & 3] : sb_[i & 3];
                const float y1 = x1[i] * rstd * g1, y2 = x2[i] * rstd * g2; r1[i] = y1 * cs - y2 * sn; r2[i] = y2 * cs + y1 * sn;
            }
            qf0 = pack8(r1); qf1 = pack8(r2);
        }
        const int kt0 = (R0 & 127) >> 4;
        const int seq_lo = (n == 0) ? 8 : 0, seq_hi = (n == 15) ? 15 : 23;
        f32x4 acc[18];
#pragma unroll
        for (int u = 0; u < 17; ++u) {
            const LAS bf16* kr = Ks + ((kt0 + u) * 16 + l15) * KA_P + 8 * q4;
            const bf16x8 k0 = *(const LAS bf16x8*)(kr), k1 = *(const LAS bf16x8*)(kr + 32);
            f32x4 a = (f32x4){0.f, 0.f, 0.f, 0.f};
            a = MFMA16(k0, qf0, a); a = MFMA16(k1, qf1, a); acc[u] = a;
        }
        acc[17] = (f32x4){-1e30f, -1e30f, -1e30f, -1e30f};
        const float sink = P.in[8][hq] * 1.4426950408889634f;
        float mx = sink;
#pragma unroll
        for (int u = 0; u < 17; ++u) {
            const bool tv = (kt0 + u >= seq_lo) && (kt0 + u <= seq_hi);
#pragma unroll
            for (int i = 0; i < 4; ++i) {
                bool valid = tv;
                if (u == 0) valid = valid && (4 * q4 + i >= l15);
                if (u == 16) valid = valid && (4 * q4 + i <= l15);
                const float sv = valid ? acc[u][i] : -1e30f; acc[u][i] = sv; mx = fmaxf(mx, sv);
            }
        }
        mx = fmaxf(mx, __shfl_xor(mx, 16)); mx = fmaxf(mx, __shfl_xor(mx, 32));
        float sum = 0.f;
#pragma unroll
        for (int u = 0; u < 17; ++u)
#pragma unroll
            for (int i = 0; i < 4; ++i) { const float p = __builtin_amdgcn_exp2f(acc[u][i] - mx); acc[u][i] = p; sum += p; }
        acc[17] = (f32x4){0.f, 0.f, 0.f, 0.f};
        sum += __shfl_xor(sum, 16); sum += __shfl_xor(sum, 32);
        const float inv = 1.f / (sum + __builtin_amdgcn_exp2f(sink - mx));
        f32x4 o[4];
#pragma unroll
        for (int dt = 0; dt < 4; ++dt) o[dt] = (f32x4){0.f, 0.f, 0.f, 0.f};
#pragma unroll
        for (int k2 = 0; k2 < 9; ++k2) {
            float pp[8] = {acc[2 * k2][0], acc[2 * k2][1], acc[2 * k2][2], acc[2 * k2][3], acc[2 * k2 + 1][0], acc[2 * k2 + 1][1], acc[2 * k2 + 1][2], acc[2 * k2 + 1][3]};
            const bf16x8 pf = pack8(pp);
#pragma unroll
            for (int dt = 0; dt < 4; ++dt) {
                const LAS bf16* vr = Vt + (dt * 16 + l15) * VA_P + kt0 * 16 + k2 * 32 + 4 * q4;
                const v2u v0 = *(const LAS v2u*)(vr);
                v2u v1 = (v2u){0u, 0u};
                if (k2 < 8) v1 = *(const LAS v2u*)(vr + 16);
                const v4u vw = (v4u){v0.x, v0.y, v1.x, v1.y};
                o[dt] = MFMA16(__builtin_bit_cast(bf16x8, vw), pf, o[dt]);
            }
        }
#pragma unroll
        for (int dt = 0; dt < 4; ++dt) {
            const int ch = hq * 64 + dt * 16 + 4 * q4;
            float gg[4]; unpack4(gat[dt], gg);
            v2u w; w.x = pk2(o[dt][0] * inv * gg[0], o[dt][1] * inv * gg[1]); w.y = pk2(o[dt][2] * inv * gg[2], o[dt][3] * inv * gg[3]);
            *(v2u*)(YC + m * DM + ch) = w;
        }
    }
    __syncthreads();
}

constexpr int KC_P = 136, VC_P = 264;
__device__ __forceinline__ void attnC_qblock(const Params& P, const LAS bf16* Ks, const LAS bf16* Vt, bf16* YC, const v4u (&qraw)[4], const v2u (&gat)[8], size_t m, int hx, int l15, int q4) {
    {
        bf16x8 qf[4];
        {
            float x[4][8]; float ss = 0.f;
#pragma unroll
            for (int ks = 0; ks < 4; ++ks) { unpack8(qraw[ks], x[ks]);
#pragma unroll
                for (int i = 0; i < 8; ++i) ss += x[ks][i] * x[ks][i]; }
            ss += __shfl_xor(ss, 16); ss += __shfl_xor(ss, 32);
            const float rstd = (0.08838834764831845f * 1.4426950408889634f) / sqrtf(ss * (1.f / 128.f) + NORM_EPS);
#pragma unroll
            for (int ks = 0; ks < 4; ++ks) { float y[8];
                const f32x4 ga = *(const f32x4*)(P.in[22] + ks * 32 + 8 * q4), gb = *(const f32x4*)(P.in[22] + ks * 32 + 8 * q4 + 4);
#pragma unroll
                for (int i = 0; i < 8; ++i) y[i] = x[ks][i] * rstd * ((i < 4) ? ga[i & 3] : gb[i & 3]);
                qf[ks] = pack8(y); }
        }
        f32x4 acc[16];
#pragma unroll
        for (int kt = 0; kt < 16; ++kt) {
            const LAS bf16* kr = Ks + (kt * 16 + l15) * KC_P + 8 * q4;
            f32x4 a = (f32x4){0.f, 0.f, 0.f, 0.f};
#pragma unroll
            for (int ks = 0; ks < 4; ++ks) a = MFMA16(*(const LAS bf16x8*)(kr + ks * 32), qf[ks], a);
            acc[kt] = a;
        }
        float mx = -1e30f;
#pragma unroll
        for (int kt = 0; kt < 16; ++kt)
#pragma unroll
            for (int i = 0; i < 4; ++i) mx = fmaxf(mx, acc[kt][i]);
        mx = fmaxf(mx, __shfl_xor(mx, 16)); mx = fmaxf(mx, __shfl_xor(mx, 32));
        float sum = 0.f;
#pragma unroll
        for (int kt = 0; kt < 16; ++kt)
#pragma unroll
            for (int i = 0; i < 4; ++i) { const float p = __builtin_amdgcn_exp2f(acc[kt][i] - mx); acc[kt][i] = p; sum += p; }
        sum += __shfl_xor(sum, 16); sum += __shfl_xor(sum, 32);
        const float inv = 1.f / sum;
        f32x4 o[8];
#pragma unroll
        for (int dt = 0; dt < 8; ++dt) o[dt] = (f32x4){0.f, 0.f, 0.f, 0.f};
#pragma unroll
        for (int k2 = 0; k2 < 8; ++k2) {
            float pp[8] = {acc[2 * k2][0], acc[2 * k2][1], acc[2 * k2][2], acc[2 * k2][3], acc[2 * k2 + 1][0], acc[2 * k2 + 1][1], acc[2 * k2 + 1][2], acc[2 * k2 + 1][3]};
            const bf16x8 pf = pack8(pp);
#pragma unroll
            for (int dt = 0; dt < 8; ++dt) {
                const LAS bf16* vr = Vt + (dt * 16 + l15) * VC_P + k2 * 32 + 4 * q4;
                const v2u v0 = *(const LAS v2u*)(vr), v1 = *(const LAS v2u*)(vr + 16);
                const v4u vw = (v4u){v0.x, v0.y, v1.x, v1.y};
                o[dt] = MFMA16(__builtin_bit_cast(bf16x8, vw), pf, o[dt]);
            }
        }
#pragma unroll
        for (int dt = 0; dt < 8; ++dt) {
            const int ch = hx * 128 + dt * 16 + 4 * q4;
            float gg[4]; unpack4(gat[dt], gg);
            v2u w; w.x = pk2(o[dt][0] * inv * gg[0], o[dt][1] * inv * gg[1]); w.y = pk2(o[dt][2] * inv * gg[2], o[dt][3] * inv * gg[3]);
            *(v2u*)(YC + m * DM + 1536 + ch) = w;
        }
    }
}
__device__ __forceinline__ void attnC_item(const Params& P, int item, LAS unsigned char* lds) {
    const int tid = pg8::mk_tid(lds), lane = tid & 63, wave = __builtin_amdgcn_readfirstlane(tid >> 6), l15 = lane & 15, q4 = lane >> 4;
    const int b = item >> 5, qb0 = 2 * ((item >> 2) & 7), hx = item & 3;
    const bf16* PRE = (const bf16*)(P.ws + WS_PRE); const bf16* MKV = (const bf16*)(P.ws + WS_MKV); bf16* YC = (bf16*)(P.ws + WS_YCAT);
    LAS bf16* Ks = (LAS bf16*)lds; LAS bf16* Vt = Ks + 256 * KC_P;
    const size_t m = (size_t)b * SEQ + qb0 * 128 + wave * 16 + l15;
    {
        v4u kw[8], vw[8];
#pragma unroll
        for (int u = 0; u < 8; ++u) {
            const int it = tid + u * NTHREADS, j = it >> 4, c = it & 15;
            const bf16* src = MKV + ((size_t)b * NMEM + j) * 1024 + hx * 128 + 8 * c;
            kw[u] = *(const v4u*)(src); vw[u] = *(const v4u*)(src + 512);
        }
        const f32x4 g0 = *(const f32x4*)(P.in[23] + 8 * (tid & 15)), g1 = *(const f32x4*)(P.in[23] + 8 * (tid & 15) + 4);
#pragma unroll
        for (int u = 0; u < 8; ++u) {
            const int it = tid + u * NTHREADS, j = it >> 4, c = it & 15;
            float x[8]; unpack8(kw[u], x);
            float ss = 0.f;
#pragma unroll
            for (int i = 0; i < 8; ++i) ss += x[i] * x[i];
            ss = red8(ss); ss = dpp_add<0x140>(ss);
            const float rstd = 1.f / sqrtf(ss * (1.f / 128.f) + NORM_EPS);
            v4u o; o.x = pk2(x[0] * rstd * g0.x, x[1] * rstd * g0.y); o.y = pk2(x[2] * rstd * g0.z, x[3] * rstd * g0.w);
            o.z = pk2(x[4] * rstd * g1.x, x[5] * rstd * g1.y); o.w = pk2(x[6] * rstd * g1.z, x[7] * rstd * g1.w);
            *(LAS v4u*)(Ks + j * KC_P + 8 * c) = o;
            const v4u w = vw[u];
            LAS bf16* d = Vt + (8 * c) * VC_P + j;
            d[0] = (bf16)(w.x & 0xffffu); d[VC_P] = (bf16)(w.x >> 16); d[2 * VC_P] = (bf16)(w.y & 0xffffu); d[3 * VC_P] = (bf16)(w.y >> 16);
            d[4 * VC_P] = (bf16)(w.z & 0xffffu); d[5 * VC_P] = (bf16)(w.z >> 16); d[6 * VC_P] = (bf16)(w.w & 0xffffu); d[7 * VC_P] = (bf16)(w.w >> 16);
        }
    }
    v4u qraw[4]; v2u gat[8];
    {
        const bf16* src = PRE + m * NPRE + C_XQ + hx * 128 + 8 * q4;
#pragma unroll
        for (int ks = 0; ks < 4; ++ks) qraw[ks] = *(const v4u*)(src + ks * 32);
#pragma unroll
        for (int dt = 0; dt < 8; ++dt) gat[dt] = *(const v2u*)(PRE + m * NPRE + C_XG + hx * 128 + dt * 16 + 4 * q4);
    }
    __syncthreads();
    v4u qraw2[4]; v2u gat2[8];
    {
        const size_t m2 = m + 128; const bf16* src = PRE + m2 * NPRE + C_XQ + hx * 128 + 8 * q4;
#pragma unroll
        for (int ks = 0; ks < 4; ++ks) qraw2[ks] = *(const v4u*)(src + ks * 32);
#pragma unroll
        for (int dt = 0; dt < 8; ++dt) gat2[dt] = *(const v2u*)(PRE + m2 * NPRE + C_XG + hx * 128 + dt * 16 + 4 * q4);
    }
    attnC_qblock(P, Ks, Vt, YC, qraw, gat, m, hx, l15, q4);
    __builtin_amdgcn_sched_barrier(0);
    attnC_qblock(P, Ks, Vt, YC, qraw2, gat2, m + 128, hx, l15, q4);
    __syncthreads();
}

__device__ __forceinline__ void p5_rwkv_post(const Params& P, LAS unsigned char* lds) {
    const bf16* PRE = (const bf16*)(P.ws + WS_PRE); const bf16* EA = (const bf16*)((unsigned char*)P.out + DO_EA);
    const bf16* YF = (const bf16*)((unsigned char*)P.out + DO_YF); const bf16* YB = (const bf16*)(P.ws + WS_YB); bf16* YC = (bf16*)(P.ws + WS_YCAT);
    const float* mu = P.in[10];
    const int gt = blockIdx.x * NTHREADS + pg8::mk_tid(lds), NGT = gridDim.x * NTHREADS;
    for (int idx = gt; idx < M_TOK * 96; idx += NGT) {
        const int m = idx / 96, he = idx - m * 96, ch0 = he * 8, t = m & (SEQ - 1);
        const bf16* p = PRE + (size_t)m * NPRE + C_RS + ch0;
        const v4u z4 = (v4u){0u, 0u, 0u, 0u};
        const bool hp = t > 0, hn = t < SEQ - 1;
        const v4u rc = *(const v4u*)(p), kc = *(const v4u*)(p + 768), vc = *(const v4u*)(p + 1536);
        const v4u rp = hp ? *(const v4u*)(p - NPRE) : z4, kp = hp ? *(const v4u*)(p - NPRE + 768) : z4, vp = hp ? *(const v4u*)(p - NPRE + 1536) : z4;
        const v4u rn = hn ? *(const v4u*)(p + NPRE) : z4, kn = hn ? *(const v4u*)(p + NPRE + 768) : z4, vn = hn ? *(const v4u*)(p + NPRE + 1536) : z4;
        const v4u af8 = *(const v4u*)(EA + (size_t)m * NLORA + 1536 + ch0), ab8 = *(const v4u*)(EA + (size_t)m * NLORA + 2304 + ch0);
        const v4u yf8 = *(const v4u*)(YF + (size_t)m * RW + ch0), yb8 = *(const v4u*)(YB + (size_t)m * RW + ch0);
        const v4u rg8 = *(const v4u*)(PRE + (size_t)m * NPRE + C_RG + ch0);
        float r[8], k[8], v[8], x0[8], x1[8], x2[8];
        unpack8(rc, x0); unpack8(rp, x1); unpack8(rn, x2);
#pragma unroll
        for (int i = 0; i < 8; ++i) r[i] = x0[i] + mu[ch0 + i] * (0.5f * (x1[i] + x2[i]) - x0[i]);
        unpack8(kc, x0); unpack8(kp, x1); unpack8(kn, x2);
#pragma unroll
        for (int i = 0; i < 8; ++i) k[i] = x0[i] + mu[768 + ch0 + i] * (0.5f * (x1[i] + x2[i]) - x0[i]);
        unpack8(vc, x0); unpack8(vp, x1); unpack8(vn, x2);
#pragma unroll
        for (int i = 0; i < 8; ++i) v[i] = x0[i] + mu[1536 + ch0 + i] * (0.5f * (x1[i] + x2[i]) - x0[i]);
        float af[8], ab[8], ys[8], yb[8], rg[8]; unpack8(af8, af); unpack8(ab8, ab); unpack8(yf8, ys); unpack8(yb8, yb); unpack8(rg8, rg);
        float bs = 0.f, sm = 0.f;
#pragma unroll
        for (int i = 0; i < 8; ++i) { const float kds = k[i] * (2.f + (af[i] + ab[i] - 2.f) * P.in[12][ch0 + i]); bs += r[i] * kds * P.in[13][ch0 + i]; ys[i] += yb[i]; sm += ys[i]; }
        bs = red8(bs); sm = red8(sm);
        const float mean = sm * (1.f / 64.f);
        float vs = 0.f;
#pragma unroll
        for (int i = 0; i < 8; ++i) { ys[i] -= mean; vs += ys[i] * ys[i]; }
        vs = red8(vs);
        const float rstd = 1.f / sqrtf(vs * (1.f / 64.f) + GN_EPS);
        float o[8];
#pragma unroll
        for (int i = 0; i < 8; ++i) o[i] = (ys[i] * rstd * P.in[18][ch0 + i] + P.in[19][ch0 + i] + bs * v[i]) * rg[i];
        v4u w; w.x = pk2(o[0], o[1]); w.y = pk2(o[2], o[3]); w.z = pk2(o[4], o[5]); w.w = pk2(o[6], o[7]);
        *(v4u*)(YC + (size_t)m * DM + 768 + ch0) = w;
    }
}

constexpr int N_PHASES = 8;
__global__ void __launch_bounds__(NTHREADS, 2) hybrid_fwd(Params P) {
    extern __shared__ __attribute__((aligned(16))) unsigned char lds_raw[];
    LAS unsigned char* lds = (LAS unsigned char*)lds_raw;
    cg::grid_group grid = cg::this_grid();
    const int lo = P.ph_lo, hi = P.ph_hi, G = gridDim.x;
    if ((threadIdx.x & 63) == 0) *(volatile LAS int*)(lds + pg8::TIDTAB_OFF + 4 * pg8::hw_slot()) = (int)(threadIdx.x >> 6);
    __syncthreads();
    unsigned char* ws = P.ws; unsigned char* dob = (unsigned char*)P.out;
#ifdef PHMASK
#define IN(k) (((PHMASK >> (k)) & 1) && lo <= (k) && (k) < hi)
#else
#define IN(k) (lo <= (k) && (k) < hi)
#endif
#define SEAM(k) do { if (IN(k) && IN((k) + 1)) grid.sync(); } while (0)
#ifndef REPEAT_MASK
#define REPEAT_MASK 0
#endif
#define REP(k) for (int rep_ = 0; rep_ < (((REPEAT_MASK >> (k)) & 1) ? 2 : 1); ++rep_)
#define REPSYNC() do { if (rep_) grid.sync(); } while (0)
    if (IN(0)) REP(0) { REPSYNC(); p0_prologue(P, lds, P.out); __syncthreads(); }
    SEAM(0);
    if (IN(1)) REP(1) { REPSYNC();
        { pg8::Gemm g{(const bf16*)(dob + DO_H), (const bf16*)(dob + DO_WIN), M_TOK, NIN, DM}; pg8::StaticOrder S; S.init(M_TOK, NIN, G, (int)blockIdx.x);
          EpiProj E{(bf16*)(ws + WS_PRE), (bf16*)(ws + WS_GATES), P.in[5]};
          pg8::gemm_phase<EpiProj, pg8::StaticOrder, true, true>(lds, g, S, E); }
        { pg8::Gemm g{(const bf16*)(ws + WS_MEMN), (const bf16*)(ws + WS_WXKV), MEMROWS, 1024, DM}; pg8::StaticOrder S; S.init(MEMROWS, 1024, G, (int)((blockIdx.x + G - 64) % G));
          EpiPlain E{(bf16*)(ws + WS_MKV), 1024};
          pg8::gemm_phase<EpiPlain, pg8::StaticOrder, true, true>(lds, g, S, E); }
    }
    SEAM(1);
    if (IN(2)) REP(2) { REPSYNC(); p2_lora_in(P, lds); }
    SEAM(2);
    if (IN(3)) REP(3) { REPSYNC();
        int klora = 256; asm volatile("" : "+s"(klora));
        pg8::Gemm g{(const bf16*)(dob + DO_LIN), (const bf16*)(ws + WS_LORAB), M_TOK, NLORA, klora}; pg8::StaticOrder S; S.init(M_TOK, NLORA, G, (int)blockIdx.x);
        EpiLora E{(bf16*)(dob + DO_EA), P.in[14], P.in[16]};
        pg8::gemm_phase<EpiLora, pg8::StaticOrder, true, true>(lds, g, S, E);
    }
    SEAM(3);
    if (IN(4)) REP(4) { REPSYNC();
        const int bid = blockIdx.x;
#ifndef STATIC_ATT
#define STATIC_ATT 0
#endif
#ifndef SCAN2
#define SCAN2 1
#endif
        if (bid < 192) scan_chunked(P, bid, lds);
        if (STATIC_ATT) {
            if (bid >= 192) { for (int it = bid - 192; it < 768; it += G - 192) { if (it < 512) attnA_item(P, it, lds); else attnC_item(P, it - 512, lds); } }
        } else {
            volatile LAS int* slot = (volatile LAS int*)(lds + pg8::TIDTAB_OFF - 64);
            const int tid4 = pg8::mk_tid(lds);
            for (;;) {
                if (tid4 == 0) *slot = (int)__hip_atomic_fetch_add((unsigned*)(ws + WS_CTR), 1u, __ATOMIC_RELAXED, __HIP_MEMORY_SCOPE_AGENT);
                __syncthreads();
                const int it = *slot;
                __syncthreads();
                if (it >= 768) break;
                if (it < 512) attnA_item(P, it, lds); else attnC_item(P, it - 512, lds);
            }
        }
    }
    SEAM(4);
    if (IN(5)) REP(5) { REPSYNC(); p5_rwkv_post(P, lds); }
    SEAM(5);
    if (IN(6)) REP(6) { REPSYNC();
        pg8::Gemm g{(const bf16*)(ws + WS_YCAT), (const bf16*)(ws + WS_WCAT), M_TOK, DM, DM}; pg8::StaticOrder S; S.init(M_TOK, DM, G, (int)blockIdx.x);
        EpiMerged E{(bf16*)(ws + WS_MERGED), (const bf16*)(ws + WS_GATES)};
        pg8::gemm_phase<EpiMerged, pg8::StaticOrder, true, true>(lds, g, S, E);
    }
    SEAM(6);
    if (IN(7)) REP(7) { REPSYNC();
        pg8::Gemm g{(const bf16*)(ws + WS_MERGED), (const bf16*)(ws + WS_WOUT), M_TOK, DM, DM}; pg8::StaticOrder S; S.init(M_TOK, DM, G, (int)blockIdx.x);
        EpiOut E{P.out, P.in[0]};
        pg8::gemm_phase<EpiOut, pg8::StaticOrder, true, true>(lds, g, S, E);
    }
#undef IN
#undef SEAM
}

#ifndef ONE_LAUNCH
#define ONE_LAUNCH 1
#endif
extern "C" void kernel_launch(void* const* d_in, const int* in_sizes, int n_in, void* d_out, int out_size, void* d_ws, size_t ws_size, hipStream_t stream) {
    static int grid = 0;
    if (grid == 0) {
        if (n_in != 26 || out_size != M_TOK * DM || ws_size < WS_END) { fprintf(stderr, "kernel_launch: unexpected shapes (n_in %d, out %d, ws %zu); nothing launched\n", n_in, out_size, ws_size); grid = -1; return; }
        int dev = 0, cus = 0, per_cu = 0;
        hipGetDevice(&dev); hipDeviceGetAttribute(&cus, hipDeviceAttributeMultiprocessorCount, dev);
        if (hipFuncSetAttribute((const void*)hybrid_fwd, hipFuncAttributeMaxDynamicSharedMemorySize, LDS_BYTES) != hipSuccess) { fprintf(stderr, "kernel_launch: hipFuncSetAttribute failed\n"); grid = -1; return; }
        hipOccupancyMaxActiveBlocksPerMultiprocessor(&per_cu, (const void*)hybrid_fwd, NTHREADS, LDS_BYTES);
        (void)hipGetLastError();
        if (per_cu < 1) per_cu = 1;
        grid = cus * per_cu; if (grid > 256) grid = 256;
        if (grid < 200) { fprintf(stderr, "kernel_launch: grid %d too small for the scan/attention split\n", grid); grid = -1; return; }
    }
    if (grid < 0) return;
    Params p{};
    for (int i = 0; i < 26; ++i) p.in[i] = (const float*)d_in[i];
    p.out = (float*)d_out; p.ws = (unsigned char*)d_ws;
#if ONE_LAUNCH
    p.ph_lo = 0; p.ph_hi = N_PHASES;
    void* args[] = {&p};
    hipError_t e = hipLaunchCooperativeKernel((const void*)hybrid_fwd, dim3(grid), dim3(NTHREADS), args, LDS_BYTES, stream);
    if (e != hipSuccess) fprintf(stderr, "cooperative launch failed: %s (grid %d)\n", hipGetErrorString(e), grid);
#else
    for (int ph = 0; ph < N_PHASES; ++ph) {
        p.ph_lo = ph; p.ph_hi = ph + 1;
        hipLaunchKernelGGL(hybrid_fwd, dim3(grid), dim3(NTHREADS), LDS_BYTES, stream, p);
    }
#endif
}
```

```cpp
#include <hip/hip_runtime.h>
#include <hip/hip_cooperative_groups.h>
#include <cstdio>
#include <cstdint>
namespace cg = cooperative_groups;
namespace pg8 {
#define PG8_LAS __attribute__((address_space(3)))
typedef unsigned short bf16_t;
typedef short bf16x8 __attribute__((ext_vector_type(8)));
typedef float f32x4 __attribute__((ext_vector_type(4)));
typedef unsigned u32x4 __attribute__((ext_vector_type(4)));
constexpr int BM = 256, BK = 64, HALF = 128, HTB = HALF * BK * 2  , STAGE_BYTES = 8 * HTB, NXCD = 8, WGM = 8;

__host__ __device__ __forceinline__ int lds_byte(int r, int c) { const int st = (r >> 4) * 2 + (c >> 5), rr = r & 15, cc = c & 31, ob = rr * 64 + cc * 2; return st * 1024 + (ob ^ (((ob >> 9) & 1) << 5)); }
__host__ __device__ __forceinline__ void stage_rc(int b, int& R, int& C) { const int st = b / 1024, sb = b % 1024, swz = sb ^ (((sb >> 9) & 1) << 5); R = (st >> 1) * 16 + swz / 64; C = (st & 1) * 32 + (swz % 64) / 2; }
__host__ __device__ __forceinline__ int perm32(int rho) { const int n = rho >> 4, i = rho & 15; return 8 * (i >> 2) + 4 * n + (i & 3); }


constexpr int TIDTAB_OFF = 147200;
__device__ __forceinline__ int hw_slot() { return (int)(__builtin_amdgcn_s_getreg((5 << 11) | 4) & 63u); }
__device__ __forceinline__ int mk_tid(PG8_LAS unsigned char* lds) {
    const int lane = (int)__builtin_amdgcn_mbcnt_hi(~0u, __builtin_amdgcn_mbcnt_lo(~0u, 0u));
    const int w = __builtin_amdgcn_readfirstlane(*(volatile PG8_LAS int*)(lds + TIDTAB_OFF + 4 * hw_slot()));
    return w * 64 + lane;
}
struct Unit { int pm, pn; };
struct Gemm { const bf16_t* A; const bf16_t* Bt; int M, N, K; };

struct StaticOrder {
    int nM, nN, nwg, G, c;
    __host__ __device__ void init(int M, int N, int G_, int c_) { nM = M / BM; nN = N / BM; nwg = nM * nN; G = G_; c = c_; }
    __host__ __device__ bool next(int i, Unit& u) const {
        const long L = (long)i * G + c; if (L >= nwg) return false;
        int wgid = (int)L; { const int q = nwg / NXCD, r = nwg % NXCD, xcd = wgid % NXCD, off = wgid / NXCD; wgid = (xcd < r ? xcd * (q + 1) : r * (q + 1) + (xcd - r) * q) + off; }
        const int nig = WGM * nN, gid = wgid / nig, fm = gid * WGM, gsz = (nM - fm) < WGM ? (nM - fm) : WGM;
        u.pm = fm + ((wgid % nig) % gsz); u.pn = (wgid % nig) / gsz; return true;
    }
    __device__ __forceinline__ void a_ready(const Unit&) const {}
    __device__ __forceinline__ void done(const Unit&) const {}
};

__device__ __forceinline__ unsigned cvt_pk_bf16(float lo, float hi) { unsigned r; asm volatile("v_cvt_pk_bf16_f32 %0, %1, %2" : "=v"(r) : "v"(lo), "v"(hi)); return r; }
template <class Epi, class Sched, bool ALIGN_EPI = false, bool SP2 = false>
__device__ __forceinline__ void gemm_phase(PG8_LAS unsigned char* lds, const Gemm g, const Sched& S, const Epi& E) {
    const int tid = mk_tid(lds), wid = __builtin_amdgcn_readfirstlane(tid >> 6), lane = tid & 63, wr = wid >> 2, wc = wid & 3, fr = lane & 15, fq = lane >> 4;
    const int K = g.K, nt = K / BK;
    unsigned voffA[2], voffB[2];
#pragma unroll
    for (int i = 0; i < 2; ++i) { int R, C; stage_rc(tid * 16 + i * 8192, R, C); const int Rb = Epi::PERM ? ((R & ~31) + perm32(R & 31)) : R;
        voffA[i] = (unsigned)(R * K + C) * 2u; voffB[i] = (unsigned)(Rb * K + C) * 2u; }
    const size_t kstep = (size_t)(BK * 2);
    const size_t hstep = (size_t)HALF * K * 2;
    const size_t tstep = 2 * hstep;
    const unsigned ldsw = (unsigned)wid * 1024u;
    const int aoff = lds_byte(wr * 64 + fr, fq * 8), boff = lds_byte(wc * 32 + fr, fq * 8);
#define PG8_SA(b, h) (((b) * 2 + (h)) * HTB)
#define PG8_SB(b, h) ((4 + (b) * 2 + (h)) * HTB)
#define PG8_STAGE(bufoff, gbase, voff) do { _Pragma("unroll") for (int _i = 0; _i < 2; ++_i) \
        __builtin_amdgcn_global_load_lds((const unsigned*)((const char*)(gbase) + (voff)[_i]), (PG8_LAS unsigned*)(lds + (bufoff) + ldsw + _i * 8192), 16, 0, 0); } while (0)
#define PG8_LDA(dst, b, h) do { _Pragma("unroll") for (int m = 0; m < 4; ++m) _Pragma("unroll") for (int k = 0; k < 2; ++k) dst[m][k] = *(const PG8_LAS bf16x8*)(lds + PG8_SA(b, h) + aoff + m * 2048 + k * 1024); } while (0)
#define PG8_LDB(dst, b, h) do { _Pragma("unroll") for (int n = 0; n < 2; ++n) _Pragma("unroll") for (int k = 0; k < 2; ++k) dst[n][k] = *(const PG8_LAS bf16x8*)(lds + PG8_SB(b, h) + boff + n * 2048 + k * 1024); } while (0)
#define PG8_MMA(ai, bj, At, Bt) do { __builtin_amdgcn_s_setprio(1); _Pragma("unroll") for (int m = 0; m < 4; ++m) _Pragma("unroll") for (int n = 0; n < 2; ++n) _Pragma("unroll") for (int k = 0; k < 2; ++k) \
        acc[ai][bj][m][n] = __builtin_amdgcn_mfma_f32_16x16x32_bf16(Bt[n][k], At[m][k], acc[ai][bj][m][n], 0, 0, 0); __builtin_amdgcn_s_setprio(0); } while (0)
#define PG8_WAIT_V(n) asm volatile("s_waitcnt vmcnt(" #n ")" ::: "memory")
#define PG8_WAIT_L(n) asm volatile("s_waitcnt lgkmcnt(" #n ")" ::: "memory")
#define PG8_BAR __builtin_amdgcn_s_barrier()
#define PG8_SCHED __builtin_amdgcn_sched_barrier(0)
    Unit cur, nxt; int ui = 0;
    if (!S.next(0, cur)) return;
    f32x4 acc[2][2][4][2];
#pragma unroll
    for (int a = 0; a < 2; ++a)
#pragma unroll
        for (int b = 0; b < 2; ++b)
#pragma unroll
            for (int m = 0; m < 4; ++m)
#pragma unroll
                for (int n = 0; n < 2; ++n) acc[a][b][m][n] = (f32x4){0.f, 0.f, 0.f, 0.f};
    bf16x8 At[4][2], B0[2][2], B1[2][2];
    const char* cA = (const char*)g.A + (size_t)cur.pm * tstep; const char* cB = (const char*)g.Bt + (size_t)cur.pn * tstep;
    S.a_ready(cur);
    if constexpr (SP2) {
        PG8_STAGE(PG8_SB(0, 0), cB, voffB); PG8_STAGE(PG8_SB(0, 1), cB + hstep, voffB); PG8_STAGE(PG8_SA(0, 0), cA, voffA); PG8_STAGE(PG8_SA(0, 1), cA + hstep, voffA);
        if (wr == 1) PG8_BAR;
        PG8_WAIT_V(2); PG8_BAR;
        PG8_STAGE(PG8_SB(1, 0), cB + kstep, voffB); PG8_STAGE(PG8_SA(1, 0), cA + kstep, voffA); PG8_STAGE(PG8_SB(1, 1), cB + hstep + kstep, voffB);
        PG8_WAIT_V(6); PG8_BAR;
    } else {
        PG8_STAGE(PG8_SB(0, 0), cB, voffB); PG8_STAGE(PG8_SA(0, 0), cA, voffA); PG8_STAGE(PG8_SB(0, 1), cB + hstep, voffB); PG8_STAGE(PG8_SA(0, 1), cA + hstep, voffA);
        if (wr == 1) PG8_BAR;
        PG8_WAIT_V(4); PG8_BAR;
        PG8_STAGE(PG8_SB(1, 0), cB + kstep, voffB); PG8_STAGE(PG8_SA(1, 0), cA + kstep, voffA); PG8_STAGE(PG8_SB(1, 1), cB + hstep + kstep, voffB);
        PG8_WAIT_V(6); PG8_BAR;
    }
    for (;;) {
        const bool has_next = S.next(ui + 1, nxt);
        const char* nA = has_next ? (const char*)g.A + (size_t)nxt.pm * tstep : cA; const char* nB = has_next ? (const char*)g.Bt + (size_t)nxt.pn * tstep : cB;
        for (int t = 0; t < nt; t += 2) {
            if constexpr (Epi::KHOOK) { if (t == Epi::HK0 || t == Epi::HK1) E.khook(acc, cur, t, wr, wc, fr, fq); }
            const bool last = (t == nt - 2);
            const char* a1 = cA + (size_t)(t + 1) * kstep;
            const char* a2 = last ? nA : cA + (size_t)(t + 2) * kstep; const char* b2 = last ? nB : cB + (size_t)(t + 2) * kstep;
            const char* a3 = a2 + kstep; const char* b3 = b2 + kstep;
            if (last && has_next) S.a_ready(nxt);
            if constexpr (SP2) {
            PG8_LDB(B0, 0, 0); PG8_LDB(B1, 0, 1); PG8_SCHED; PG8_LDA(At, 0, 0); PG8_STAGE(PG8_SA(1, 1), a1 + hstep, voffA);
            PG8_WAIT_V(8); PG8_WAIT_L(0); PG8_BAR; PG8_MMA(0, 0, At, B0); PG8_MMA(0, 1, At, B1); PG8_BAR; PG8_SCHED;
            PG8_LDA(At, 0, 1); PG8_STAGE(PG8_SB(0, 0), b2, voffB); PG8_STAGE(PG8_SB(0, 1), b2 + hstep, voffB); PG8_STAGE(PG8_SA(0, 0), a2, voffA);
            PG8_WAIT_V(8); PG8_WAIT_L(0); PG8_BAR; PG8_MMA(1, 0, At, B0); PG8_MMA(1, 1, At, B1); PG8_BAR; PG8_SCHED;
            PG8_LDB(B0, 1, 0); PG8_LDB(B1, 1, 1); PG8_SCHED; PG8_LDA(At, 1, 0); PG8_STAGE(PG8_SA(0, 1), a2 + hstep, voffA);
            PG8_WAIT_V(8); PG8_WAIT_L(0); PG8_BAR; PG8_MMA(0, 0, At, B0); PG8_MMA(0, 1, At, B1); PG8_BAR; PG8_SCHED;
            PG8_LDA(At, 1, 1); PG8_STAGE(PG8_SB(1, 0), b3, voffB); PG8_STAGE(PG8_SB(1, 1), b3 + hstep, voffB); PG8_STAGE(PG8_SA(1, 0), a3, voffA);
            PG8_WAIT_V(8); PG8_WAIT_L(0); PG8_BAR; PG8_MMA(1, 0, At, B0); PG8_MMA(1, 1, At, B1); PG8_BAR; PG8_SCHED;
            } else {
            PG8_LDB(B0, 0, 0); PG8_SCHED; PG8_LDA(At, 0, 0); PG8_STAGE(PG8_SA(1, 1), a1 + hstep, voffA);
            PG8_WAIT_L(8); PG8_BAR; PG8_WAIT_L(0); PG8_MMA(0, 0, At, B0); PG8_BAR; PG8_SCHED;
            PG8_LDB(B1, 0, 1); PG8_STAGE(PG8_SB(0, 0), b2, voffB);
            PG8_BAR; PG8_WAIT_L(0); PG8_MMA(0, 1, At, B1); PG8_BAR;
            PG8_LDA(At, 0, 1); PG8_STAGE(PG8_SA(0, 0), a2, voffA);
            PG8_BAR; PG8_WAIT_L(0); PG8_MMA(1, 0, At, B0); PG8_BAR; PG8_SCHED;
            PG8_STAGE(PG8_SB(0, 1), b2 + hstep, voffB);
            PG8_WAIT_V(6); PG8_BAR; PG8_MMA(1, 1, At, B1); PG8_BAR;
            PG8_LDB(B0, 1, 0); PG8_SCHED; PG8_LDA(At, 1, 0); PG8_STAGE(PG8_SA(0, 1), a2 + hstep, voffA);
            PG8_WAIT_L(8); PG8_BAR; PG8_WAIT_L(0); PG8_MMA(0, 0, At, B0); PG8_BAR; PG8_SCHED;
            PG8_LDB(B1, 1, 1); PG8_STAGE(PG8_SB(1, 0), b3, voffB);
            PG8_BAR; PG8_WAIT_L(0); PG8_MMA(0, 1, At, B1); PG8_BAR;
            PG8_LDA(At, 1, 1); PG8_STAGE(PG8_SA(1, 0), a3, voffA);
            PG8_BAR; PG8_WAIT_L(0); PG8_MMA(1, 0, At, B0); PG8_BAR; PG8_SCHED;
            PG8_STAGE(PG8_SB(1, 1), b3 + hstep, voffB);
            PG8_WAIT_V(6); PG8_BAR; PG8_MMA(1, 1, At, B1); PG8_BAR;
            }
        }
        if constexpr (ALIGN_EPI) { if (wr == 0) PG8_BAR; }
        if constexpr (!Epi::AFTER_DRAIN) { E(acc, cur, wr, wc, fr, fq); S.done(cur); }
        if (!has_next) break;
#pragma unroll
        for (int a = 0; a < 2; ++a)
#pragma unroll
            for (int b = 0; b < 2; ++b)
#pragma unroll
                for (int m = 0; m < 4; ++m)
#pragma unroll
                    for (int n = 0; n < 2; ++n) acc[a][b][m][n] = (f32x4){0.f, 0.f, 0.f, 0.f};
        cur = nxt; cA = nA; cB = nB; ++ui;
        if constexpr (ALIGN_EPI) { if (wr == 1) PG8_BAR; }
    }
    PG8_WAIT_V(0);
    if constexpr (!ALIGN_EPI) { if (wr == 0) PG8_BAR; }
    PG8_BAR;
    if constexpr (Epi::AFTER_DRAIN) { E.fused(acc, cur, wr, wc, fr, fq, lds, wid, lane); S.done(cur); }
#undef PG8_SA
#undef PG8_SB
#undef PG8_STAGE
#undef PG8_LDA
#undef PG8_LDB
#undef PG8_MMA
#undef PG8_WAIT_V
#undef PG8_WAIT_L
#undef PG8_BAR
#undef PG8_SCHED
}
}

#define GAS __attribute__((address_space(1)))
#define LAS __attribute__((address_space(3)))
typedef unsigned short bf16;
typedef unsigned v4u __attribute__((ext_vector_type(4)));
typedef unsigned v2u __attribute__((ext_vector_type(2)));
typedef float f32x4 __attribute__((ext_vector_type(4)));
typedef float f32x2 __attribute__((ext_vector_type(2)));
typedef short bf16x8 __attribute__((ext_vector_type(8)));
typedef short s16x4 __attribute__((ext_vector_type(4)));

constexpr int NWAVES = 8, NTHREADS = 512;
constexpr int BATCH = 8, SEQ = 2048, DM = 2048, M_TOK = BATCH * SEQ;
constexpr int NPRE = 6400, NGATE = 6144, NIN = NPRE + NGATE;
constexpr int C_AQ = 0, C_AK = 768, C_AV = 1024, C_AG = 1280, C_RS = 2048, C_RR = 2048, C_RK = 2816, C_RV = 3584, C_LORA = 4352, C_RG = 4608, C_XQ = 5376, C_XG = 5888;
constexpr int NMEM = 256, MEMROWS = BATCH * NMEM;
constexpr int RW = 768, NLORA = 3072;
constexpr float NORM_EPS = 1e-6f, GN_EPS = 64e-5f;
constexpr int LDS_BYTES = 147456;

constexpr size_t MiB = 1u << 20;
constexpr size_t WS_PRE = 0, WS_MERGED = 0, WS_GATES = 200 * MiB, WS_YCAT = 392 * MiB;
constexpr size_t WS_WCAT = 456 * MiB, WS_WOUT = 464 * MiB, WS_WXKV = 472 * MiB, WS_MKV = 476 * MiB, WS_MEMN = 480 * MiB, WS_YB = 480 * MiB;
constexpr size_t WS_ROPE = 504 * MiB, WS_LORAB = 505 * MiB, WS_END = 512 * MiB;
constexpr size_t WS_CTR = 504 * MiB + 768 * 1024;
constexpr size_t DO_H = 0, DO_WIN = 64 * MiB, DO_EA = 0, DO_LIN = 96 * MiB, DO_YF = 104 * MiB;

struct Params { const float* in[26]; float* out; unsigned char* ws; int ph_lo, ph_hi; };

__device__ __forceinline__ float bf_lo(unsigned w) { return __builtin_bit_cast(float, w << 16); }
__device__ __forceinline__ float bf_hi(unsigned w) { return __builtin_bit_cast(float, w & 0xffff0000u); }
__device__ __forceinline__ float bf1(bf16 h) { return __builtin_bit_cast(float, (unsigned)h << 16); }
__device__ __forceinline__ unsigned f2bf(float f) { unsigned u = __builtin_bit_cast(unsigned, f); return (u + 0x7fffu + ((u >> 16) & 1u)) >> 16; }
typedef __bf16 bf16x2_t __attribute__((ext_vector_type(2)));
__device__ __forceinline__ unsigned pk2(float lo, float hi) { const f32x2 v = {lo, hi}; const bf16x2_t b = __builtin_convertvector(v, bf16x2_t); return __builtin_bit_cast(unsigned, b); }
__device__ __forceinline__ float sigmoidf_(float z) { return __builtin_amdgcn_rcpf(1.f + __expf(-z)); }
__device__ __forceinline__ float siluf_(float z) { return z * sigmoidf_(z); }
__device__ __forceinline__ void unpack8(v4u w, float (&x)[8]) { x[0] = bf_lo(w.x); x[1] = bf_hi(w.x); x[2] = bf_lo(w.y); x[3] = bf_hi(w.y); x[4] = bf_lo(w.z); x[5] = bf_hi(w.z); x[6] = bf_lo(w.w); x[7] = bf_hi(w.w); }
__device__ __forceinline__ void unpack4(v2u w, float (&x)[4]) { x[0] = bf_lo(w.x); x[1] = bf_hi(w.x); x[2] = bf_lo(w.y); x[3] = bf_hi(w.y); }
__device__ __forceinline__ float fma_s(float a, float b, float c) { float r; asm("v_fma_f32 %0, %1, %2, %3" : "=v"(r) : "v"(a), "v"(b), "v"(c)); return r; }
__device__ __forceinline__ float mul_s(float a, float b) { float r; asm("v_mul_f32_e32 %0, %1, %2" : "=v"(r) : "v"(a), "v"(b)); return r; }
__device__ __forceinline__ float add_s(float a, float b) { float r; asm("v_add_f32_e32 %0, %1, %2" : "=v"(r) : "v"(a), "v"(b)); return r; }
template <int CTRL> __device__ __forceinline__ float dpp_add(float v) { return v + __builtin_bit_cast(float, __builtin_amdgcn_update_dpp(0, __builtin_bit_cast(int, v), CTRL, 0xF, 0xF, true)); }
__device__ __forceinline__ float red8(float v) { v = dpp_add<0xB1>(v); v = dpp_add<0x4E>(v); v = dpp_add<0x141>(v); return v; }

using pg8::Unit;
struct EpiProj {
    static constexpr bool PERM = true, AFTER_DRAIN = false, KHOOK = false; static constexpr int HK0 = -1, HK1 = -1;
    bf16* pre; bf16* gates; const float* gate_b;
    __device__ __forceinline__ void operator()(const f32x4 (&acc)[2][2][4][2], const Unit& u, int wr, int wc, int fr, int fq) const {
        int row0 = u.pm * 256 + wr * 64 + fr;
        asm volatile("" : "+v"(row0));
        const bool isg = u.pn >= 25;
        const int pn = isg ? u.pn - 25 : u.pn;
        bf16* base = isg ? gates : pre; const int ldc = isg ? NGATE : NPRE;
        const int act = isg ? 2 : (((pn >= 5 && pn <= 7) || (pn >= 18 && pn <= 20) || pn >= 23) ? 1 : 0);
        const int col0 = pn * 256 + wc * 32 + 8 * fq;
        f32x4 bv[2][2];
#pragma unroll
        for (int bj = 0; bj < 2; ++bj) { bv[bj][0] = isg ? *(const f32x4*)(gate_b + col0 + bj * 128) : (f32x4){0.f, 0.f, 0.f, 0.f}; bv[bj][1] = isg ? *(const f32x4*)(gate_b + col0 + bj * 128 + 4) : (f32x4){0.f, 0.f, 0.f, 0.f}; }
#pragma unroll
        for (int ai = 0; ai < 2; ++ai)
#pragma unroll
            for (int m = 0; m < 4; ++m) { bf16* rowp = base + (size_t)(row0 + ai * 128 + m * 16) * ldc + col0;
                __builtin_amdgcn_sched_barrier(0);
#pragma unroll
                for (int bj = 0; bj < 2; ++bj) { f32x4 v0 = acc[ai][bj][m][0] + bv[bj][0], v1 = acc[ai][bj][m][1] + bv[bj][1];
                    if (act == 1) {
#pragma unroll
                        for (int i = 0; i < 4; ++i) { v0[i] = siluf_(v0[i]); v1[i] = siluf_(v1[i]); }
                    } else if (act == 2) {
#pragma unroll
                        for (int i = 0; i < 4; ++i) { v0[i] = sigmoidf_(v0[i]); v1[i] = sigmoidf_(v1[i]); }
                    }
                    v4u w; w.x = pk2(v0[0], v0[1]); w.y = pk2(v0[2], v0[3]); w.z = pk2(v1[0], v1[1]); w.w = pk2(v1[2], v1[3]);
                    *(v4u*)(rowp + bj * 128) = w; } }
    }
};
struct EpiPlain {
    static constexpr bool PERM = true, AFTER_DRAIN = false, KHOOK = false; static constexpr int HK0 = -1, HK1 = -1;
    bf16* O; int ldc;
    __device__ __forceinline__ void operator()(const f32x4 (&acc)[2][2][4][2], const Unit& u, int wr, int wc, int fr, int fq) const {
        int row0 = u.pm * 256 + wr * 64 + fr, col0 = u.pn * 256 + wc * 32 + 8 * fq;
        asm volatile("" : "+v"(row0), "+v"(col0));
#pragma unroll
        for (int ai = 0; ai < 2; ++ai)
#pragma unroll
            for (int m = 0; m < 4; ++m) { bf16* rowp = O + (size_t)(row0 + ai * 128 + m * 16) * ldc + col0;
#pragma unroll
                for (int bj = 0; bj < 2; ++bj) { const f32x4 v0 = acc[ai][bj][m][0], v1 = acc[ai][bj][m][1];
                    v4u w; w.x = pk2(v0[0], v0[1]); w.y = pk2(v0[2], v0[3]); w.z = pk2(v1[0], v1[1]); w.w = pk2(v1[2], v1[3]);
                    *(v4u*)(rowp + bj * 128) = w; } }
    }
};
struct EpiLora {
    static constexpr bool PERM = true, AFTER_DRAIN = false, KHOOK = false; static constexpr int HK0 = -1, HK1 = -1;
    bf16* O; const float* w0; const float* a0;
    __device__ __forceinline__ void operator()(const f32x4 (&acc)[2][2][4][2], const Unit& u, int wr, int wc, int fr, int fq) const {
        int row0 = u.pm * 256 + wr * 64 + fr, col0 = u.pn * 256 + wc * 32 + 8 * fq;
        asm volatile("" : "+v"(row0), "+v"(col0));
        const bool isw = u.pn < 6; const float* bias = isw ? (w0 + col0) : (a0 + col0 - 1536); const float sc = isw ? 0.6065306597126334f : 1.f;
        f32x4 bv[2][2];
#pragma unroll
        for (int bj = 0; bj < 2; ++bj) { bv[bj][0] = *(const f32x4*)(bias + bj * 128); bv[bj][1] = *(const f32x4*)(bias + bj * 128 + 4); }
#pragma unroll
        for (int ai = 0; ai < 2; ++ai)
#pragma unroll
            for (int m = 0; m < 4; ++m) { bf16* rowp = O + (size_t)(row0 + ai * 128 + m * 16) * NLORA + col0;
                __builtin_amdgcn_sched_barrier(0);
#pragma unroll
                for (int bj = 0; bj < 2; ++bj) { f32x4 v0 = acc[ai][bj][m][0] + bv[bj][0], v1 = acc[ai][bj][m][1] + bv[bj][1];
#pragma unroll
                    for (int i = 0; i < 4; ++i) { v0[i] = sc * sigmoidf_(v0[i]); v1[i] = sc * sigmoidf_(v1[i]); }
                    v4u w; w.x = pk2(v0[0], v0[1]); w.y = pk2(v0[2], v0[3]); w.z = pk2(v1[0], v1[1]); w.w = pk2(v1[2], v1[3]);
                    *(v4u*)(rowp + bj * 128) = w; } }
    }
};
struct EpiMerged {
    static constexpr bool PERM = true, AFTER_DRAIN = false, KHOOK = true; static constexpr int HK0 = 12, HK1 = 24;
    bf16* O; const bf16* gates;
    __device__ __forceinline__ void khook(f32x4 (&acc)[2][2][4][2], const Unit& u, int t, int wr, int wc, int fr, int fq) const {
        int row0 = u.pm * 256 + wr * 64 + fr, col0 = u.pn * 256 + wc * 32 + 8 * fq;
        asm volatile("" : "+v"(row0), "+v"(col0));
        const int bo = (t == HK0) ? 0 : DM;
#pragma unroll
        for (int ai = 0; ai < 2; ++ai) {
            v4u ga[4][2], gb[4][2];
#pragma unroll
            for (int m = 0; m < 4; ++m) { const bf16* gp = gates + (size_t)(row0 + ai * 128 + m * 16) * NGATE + bo + col0;
#pragma unroll
                for (int bj = 0; bj < 2; ++bj) { ga[m][bj] = *(const v4u*)(gp + bj * 128); gb[m][bj] = *(const v4u*)(gp + DM + bj * 128); } }
#pragma unroll
            for (int m = 0; m < 4; ++m)
#pragma unroll
                for (int bj = 0; bj < 2; ++bj) { float x[8], y[8]; unpack8(ga[m][bj], x); unpack8(gb[m][bj], y);
#pragma unroll
                    for (int i = 0; i < 4; ++i) { acc[ai][bj][m][0][i] *= x[i] * __builtin_amdgcn_rcpf(y[i]); acc[ai][bj][m][1][i] *= x[4 + i] * __builtin_amdgcn_rcpf(y[4 + i]); } }
            __builtin_amdgcn_sched_barrier(0);
        }
    }
    __device__ __forceinline__ void operator()(const f32x4 (&acc)[2][2][4][2], const Unit& u, int wr, int wc, int fr, int fq) const {
        int row0 = u.pm * 256 + wr * 64 + fr, col0 = u.pn * 256 + wc * 32 + 8 * fq;
        asm volatile("" : "+v"(row0), "+v"(col0));
#pragma unroll
        for (int ai = 0; ai < 2; ++ai) {
            v4u gg[4][2];
#pragma unroll
            for (int m = 0; m < 4; ++m)
#pragma unroll
                for (int bj = 0; bj < 2; ++bj) gg[m][bj] = *(const v4u*)(gates + (size_t)(row0 + ai * 128 + m * 16) * NGATE + 2 * DM + col0 + bj * 128);
#pragma unroll
            for (int m = 0; m < 4; ++m) { const size_t r = (size_t)(row0 + ai * 128 + m * 16);
#pragma unroll
                for (int bj = 0; bj < 2; ++bj) { const v4u g = gg[m][bj]; float x[8]; unpack8(g, x);
                    const f32x4 v0 = acc[ai][bj][m][0], v1 = acc[ai][bj][m][1];
                    v4u w; w.x = pk2(v0[0] * x[0], v0[1] * x[1]); w.y = pk2(v0[2] * x[2], v0[3] * x[3]); w.z = pk2(v1[0] * x[4], v1[1] * x[5]); w.w = pk2(v1[2] * x[6], v1[3] * x[7]);
                    *(v4u*)(O + r * DM + col0 + bj * 128) = w; } }
            __builtin_amdgcn_sched_barrier(0);
        }
    }
};
struct EpiOut {
    static constexpr bool PERM = true, AFTER_DRAIN = false, KHOOK = false; static constexpr int HK0 = -1, HK1 = -1;
    float* O; const float* X;
    __device__ __forceinline__ void operator()(const f32x4 (&acc)[2][2][4][2], const Unit& u, int wr, int wc, int fr, int fq) const {
        int row0 = u.pm * 256 + wr * 64 + fr, col0 = u.pn * 256 + wc * 32 + 8 * fq;
        asm volatile("" : "+v"(row0), "+v"(col0));
#pragma unroll
        for (int ai = 0; ai < 2; ++ai) {
            f32x4 xa[4][2], xb[4][2];
#pragma unroll
            for (int m = 0; m < 4; ++m) { const size_t o = (size_t)(row0 + ai * 128 + m * 16) * DM + col0;
#pragma unroll
                for (int bj = 0; bj < 2; ++bj) { xa[m][bj] = *(const f32x4*)(X + o + bj * 128); xb[m][bj] = *(const f32x4*)(X + o + bj * 128 + 4); } }
#pragma unroll
            for (int m = 0; m < 4; ++m) { const size_t o = (size_t)(row0 + ai * 128 + m * 16) * DM + col0;
#pragma unroll
                for (int bj = 0; bj < 2; ++bj) { *(f32x4*)(O + o + bj * 128) = xa[m][bj] + acc[ai][bj][m][0]; *(f32x4*)(O + o + bj * 128 + 4) = xb[m][bj] + acc[ai][bj][m][1]; } }
            __builtin_amdgcn_sched_barrier(0);
        }
    }
};

__device__ __forceinline__ float wave_sum(float v) {
#pragma unroll
    for (int o = 1; o < 64; o <<= 1) v += __shfl_xor(v, o);
    return v;
}
__device__ __forceinline__ void transpose_item(const float* W, int N, bf16* WT, int ldt, int koff, LAS float* scr, int item, int lane) {
    const int nblk = N / 32, kb = item / nblk, nb = item % nblk, k0 = 64 * kb, n0 = 32 * nb;
    float tv[32];
#pragma unroll
    for (int i = 0; i < 32; ++i) { const int kk = 2 * i + (lane >> 5); tv[i] = W[(size_t)(k0 + kk) * N + n0 + (lane & 31)]; }
#pragma unroll
    for (int i = 0; i < 32; ++i) { const int kk = 2 * i + (lane >> 5); scr[kk * 33 + (lane & 31)] = tv[i]; }
    asm volatile("s_waitcnt lgkmcnt(0)" ::: "memory");
    const int c = lane & 7;
#pragma unroll
    for (int j = 0; j < 4; ++j) { const int n = (lane >> 3) + 8 * j; const LAS float* s = scr + (8 * c) * 33 + n;
        v4u o; o.x = pk2(s[0 * 33], s[1 * 33]); o.y = pk2(s[2 * 33], s[3 * 33]); o.z = pk2(s[4 * 33], s[5 * 33]); o.w = pk2(s[6 * 33], s[7 * 33]);
        *(v4u*)(WT + (size_t)(n0 + n) * ldt + koff + k0 + 8 * c) = o; }
    asm volatile("s_waitcnt lgkmcnt(0)" ::: "memory");
}
__device__ __forceinline__ void rms_row_to_bf16(const float* xrow, const float* g, bf16* orow, int lane) {
    const f32x4* xr = (const f32x4*)xrow + lane; const f32x4* gr = (const f32x4*)g + lane;
    f32x4 v[8]; float s = 0.f;
#pragma unroll
    for (int j = 0; j < 8; ++j) { v[j] = xr[64 * j]; s += (v[j].x * v[j].x + v[j].y * v[j].y) + (v[j].z * v[j].z + v[j].w * v[j].w); }
    const float rstd = 1.f / sqrtf(wave_sum(s) * (1.f / DM) + NORM_EPS);
    v2u* o8 = (v2u*)orow + lane;
#pragma unroll
    for (int j = 0; j < 8; ++j) { const f32x4 gg = gr[64 * j]; v2u o; o.x = pk2(v[j].x * rstd * gg.x, v[j].y * rstd * gg.y); o.y = pk2(v[j].z * rstd * gg.z, v[j].w * rstd * gg.w); o8[64 * j] = o; }
}
__device__ __forceinline__ void p0_prologue(const Params& P, LAS unsigned char* lds, float* dout_scratch) {
    const int tid = pg8::mk_tid(lds), lane = tid & 63, wave = tid >> 6, G = gridDim.x;
    LAS float* scr = (LAS float*)(lds + wave * 16384);
    const int gw = blockIdx.x * NWAVES + wave, NGW = G * NWAVES;
    unsigned char* ws = P.ws; unsigned char* dob = (unsigned char*)P.out;
    bf16* WIN_T = (bf16*)(dob + DO_WIN); bf16* WCAT_T = (bf16*)(ws + WS_WCAT); bf16* WOUT_T = (bf16*)(ws + WS_WOUT); bf16* WXKV_T = (bf16*)(ws + WS_WXKV);
    constexpr int I_IN = 32 * (NIN / 32), I_A = 12 * 64, I_R = 12 * 64, I_X = 8 * 64, I_O = 32 * 64, I_KV = 32 * 32;
    constexpr int NITEMS = I_IN + I_A + I_R + I_X + I_O + I_KV;
    for (int it = gw; it < NITEMS; it += NGW) {
        int r = it;
        if (r < I_IN) { transpose_item(P.in[4], NIN, WIN_T, DM, 0, scr, r, lane); continue; } r -= I_IN;
        if (r < I_A) { transpose_item(P.in[9], DM, WCAT_T, DM, 0, scr, r, lane); continue; } r -= I_A;
        if (r < I_R) { transpose_item(P.in[20], DM, WCAT_T, DM, 768, scr, r, lane); continue; } r -= I_R;
        if (r < I_X) { transpose_item(P.in[24], DM, WCAT_T, DM, 1536, scr, r, lane); continue; } r -= I_X;
        if (r < I_O) { transpose_item(P.in[25], DM, WOUT_T, DM, 0, scr, r, lane); continue; } r -= I_O;
        transpose_item(P.in[21], 1024, WXKV_T, DM, 0, scr, r, lane);
    }
    bf16* H = (bf16*)(dob + DO_H); bf16* MEMN = (bf16*)(ws + WS_MEMN);
    for (int m = gw; m < M_TOK + MEMROWS; m += NGW) {
        if (m < M_TOK) rms_row_to_bf16(P.in[0] + (size_t)m * DM, P.in[2], H + (size_t)m * DM, lane);
        else rms_row_to_bf16(P.in[1] + (size_t)(m - M_TOK) * DM, P.in[3], MEMN + (size_t)(m - M_TOK) * DM, lane);
    }
    if (blockIdx.x == 0 && tid == 0) __hip_atomic_store((unsigned*)(ws + WS_CTR), 0u, __ATOMIC_RELAXED, __HIP_MEMORY_SCOPE_AGENT);
    bf16* LB = (bf16*)(ws + WS_LORAB);
    const int gt = blockIdx.x * NTHREADS + tid, NGT = G * NTHREADS;
    for (int idx = gt; idx < NLORA * 256; idx += NGT) {
        const int n = idx >> 8, k = idx & 255, d = n / RW, ch = n % RW, kb = k >> 6, kk = k & 63;
        float v = 0.f;
        if (kb == d) v = (d < 2) ? P.in[15][(size_t)(d * 64 + kk) * RW + ch] : P.in[17][(size_t)((d - 2) * 64 + kk) * RW + ch];
        LB[idx] = (bf16)f2bf(v);
    }
    float* RC = (float*)(ws + WS_ROPE); float* RS = RC + SEQ * 32;
    for (int idx = gt; idx < SEQ * 32; idx += NGT) {
        const int pos = idx >> 5, i = idx & 31;
        const float inv = __builtin_exp2f(-(float)i * (13.287712379549449f / 32.f));
        const float ang = (float)pos * inv;
        double rv = (double)ang * 0.15915494309189535; rv -= __builtin_floor(rv);
        const float r = (float)rv;
        RC[idx] = __builtin_amdgcn_cosf(r); RS[idx] = __builtin_amdgcn_sinf(r);
    }
}

__device__ __forceinline__ void p2_lora_in(const Params& P, LAS unsigned char* lds) {
    const bf16* PRE = (const bf16*)(P.ws + WS_PRE); bf16* LIN = (bf16*)((unsigned char*)P.out + DO_LIN); const float* mu = P.in[10];
    const int gt = blockIdx.x * NTHREADS + pg8::mk_tid(lds), NGT = gridDim.x * NTHREADS;
    for (int idx = gt; idx < M_TOK * 32; idx += NGT) {
        const int m = idx >> 5, j = (idx & 31) * 8, t = m & (SEQ - 1);
        const bf16* p = PRE + (size_t)m * NPRE + C_LORA + j;
        const v4u z4 = (v4u){0u, 0u, 0u, 0u};
        const v4u c = *(const v4u*)p, pv = (t > 0) ? *(const v4u*)(p - NPRE) : z4, nx = (t < SEQ - 1) ? *(const v4u*)(p + NPRE) : z4;
        const f32x4 m0 = *(const f32x4*)(mu + 2304 + j), m1 = *(const f32x4*)(mu + 2304 + j + 4);
        float xc[8], xp[8], xn[8], s[8]; unpack8(c, xc); unpack8(pv, xp); unpack8(nx, xn);
#pragma unroll
        for (int i = 0; i < 8; ++i) { const float mm = (i < 4) ? m0[i & 3] : m1[i & 3]; s[i] = xc[i] + mm * (0.5f * (xp[i] + xn[i]) - xc[i]);
            if (j < 128) s[i] = 1.f - 2.f * __builtin_amdgcn_rcpf(__expf(2.f * s[i]) + 1.f); }
        v4u o; o.x = pk2(s[0], s[1]); o.y = pk2(s[2], s[3]); o.z = pk2(s[4], s[5]); o.w = pk2(s[6], s[7]);
        *(v4u*)(LIN + (size_t)m * 256 + j) = o;
    }
}

constexpr int SC_CH = 32, SC_REC = 1536, SC_BUF = SC_CH * SC_REC, SC_SCAL = 2 * SC_BUF;
template <int MODE> __device__ __forceinline__ void scan_block(const Params& P, int sid, LAS unsigned char* lds) {
    const int tid = pg8::mk_tid(lds), lane = tid & 63, wave = __builtin_amdgcn_readfirstlane(tid >> 6);
    const int b = sid / 24, rem = sid % 24, h = rem >> 1, dir = rem & 1;
    const bf16* PRE = (const bf16*)(P.ws + WS_PRE); const bf16* EA = (const bf16*)((unsigned char*)P.out + DO_EA);
    bf16* YO = dir ? (bf16*)(P.ws + WS_YB) : (bf16*)((unsigned char*)P.out + DO_YF);
    constexpr int NCH = SEQ / SC_CH;
#define SC_BAR() do { asm volatile("s_waitcnt lgkmcnt(0)" ::: "memory"); __builtin_amdgcn_s_barrier(); asm volatile("" ::: "memory"); } while (0)
    if (wave >= 4) {
        const int pt = tid - 256, sl = pt >> 3, e = pt & 7, ch0 = h * 64 + 8 * e;
        float mur[8], muk[8], muv[8], kkc[8], kac[8];
#pragma unroll
        for (int i = 0; i < 8; ++i) { mur[i] = P.in[10][ch0 + i]; muk[i] = P.in[10][768 + ch0 + i]; muv[i] = P.in[10][1536 + ch0 + i]; kkc[i] = P.in[11][ch0 + i]; kac[i] = P.in[12][ch0 + i]; }
        v4u rc, kc, vc, rp, kp, vp, rn, kn, vn, e8, a8;
        const v4u z4 = (v4u){0u, 0u, 0u, 0u};
#define SC_PLOAD(c_) do { const int step_ = (c_) * SC_CH + sl, t_ = dir ? (SEQ - 1 - step_) : step_; const size_t m_ = (size_t)b * SEQ + t_; \
            const bf16* rowp_ = PRE + m_ * NPRE + C_RS + ch0; \
            rc = *(const v4u*)(rowp_); kc = *(const v4u*)(rowp_ + 768); vc = *(const v4u*)(rowp_ + 1536); \
            rp = (t_ > 0) ? *(const v4u*)(rowp_ - NPRE) : z4; kp = (t_ > 0) ? *(const v4u*)(rowp_ - NPRE + 768) : z4; vp = (t_ > 0) ? *(const v4u*)(rowp_ - NPRE + 1536) : z4; \
            rn = (t_ < SEQ - 1) ? *(const v4u*)(rowp_ + NPRE) : z4; kn = (t_ < SEQ - 1) ? *(const v4u*)(rowp_ + NPRE + 768) : z4; vn = (t_ < SEQ - 1) ? *(const v4u*)(rowp_ + NPRE + 1536) : z4; \
            const bf16* eap_ = EA + m_ * NLORA + dir * RW + ch0; e8 = *(const v4u*)(eap_); a8 = *(const v4u*)(eap_ + 1536); } while (0)
#define SC_PWRITE(c_) do { LAS unsigned char* buf_ = lds + ((c_) & 1) * SC_BUF; LAS float* scal_ = (LAS float*)(lds + SC_SCAL) + ((c_) & 1) * (SC_CH * 2); \
            float r[8], k[8], v[8], x0[8], x1[8], x2[8]; \
            unpack8(rc, x0); unpack8(rp, x1); unpack8(rn, x2); \
            _Pragma("unroll") for (int i = 0; i < 8; ++i) r[i] = x0[i] + mur[i] * (0.5f * (x1[i] + x2[i]) - x0[i]); \
            unpack8(kc, x0); unpack8(kp, x1); unpack8(kn, x2); \
            _Pragma("unroll") for (int i = 0; i < 8; ++i) k[i] = x0[i] + muk[i] * (0.5f * (x1[i] + x2[i]) - x0[i]); \
            unpack8(vc, x0); unpack8(vp, x1); unpack8(vn, x2); \
            _Pragma("unroll") for (int i = 0; i < 8; ++i) v[i] = x0[i] + muv[i] * (0.5f * (x1[i] + x2[i]) - x0[i]); \
            float ee[8], aa[8]; unpack8(e8, ee); unpack8(a8, aa); \
            float kk[8], ss = 0.f; \
            _Pragma("unroll") for (int i = 0; i < 8; ++i) { kk[i] = k[i] * kkc[i]; ss += kk[i] * kk[i]; } \
            ss = red8(ss); \
            const float inv = 1.f / fmaxf(sqrtf(ss), 1e-12f); \
            float nkk[8], dd[8], dr[8], bb[8], kd[8], sbr = 0.f, skr = 0.f; \
            _Pragma("unroll") for (int i = 0; i < 8; ++i) { \
                const float kki = kk[i] * inv; nkk[i] = -kki; dd[i] = __expf(-ee[i]); dr[i] = dd[i] * r[i]; \
                bb[i] = kki * aa[i]; kd[i] = k[i] * (1.f + (aa[i] - 1.f) * kac[i]); sbr += bb[i] * r[i]; skr += kd[i] * r[i]; } \
            sbr = red8(sbr); skr = red8(skr); \
            LAS float* rec = (LAS float*)(buf_ + sl * SC_REC) + 8 * e; \
            *(LAS f32x4*)(rec) = (f32x4){nkk[0], nkk[1], nkk[2], nkk[3]}; *(LAS f32x4*)(rec + 4) = (f32x4){nkk[4], nkk[5], nkk[6], nkk[7]}; \
            *(LAS f32x4*)(rec + 64) = (f32x4){dr[0], dr[1], dr[2], dr[3]}; *(LAS f32x4*)(rec + 68) = (f32x4){dr[4], dr[5], dr[6], dr[7]}; \
            *(LAS f32x4*)(rec + 128) = (f32x4){dd[0], dd[1], dd[2], dd[3]}; *(LAS f32x4*)(rec + 132) = (f32x4){dd[4], dd[5], dd[6], dd[7]}; \
            *(LAS f32x4*)(rec + 192) = (f32x4){bb[0], bb[1], bb[2], bb[3]}; *(LAS f32x4*)(rec + 196) = (f32x4){bb[4], bb[5], bb[6], bb[7]}; \
            *(LAS f32x4*)(rec + 256) = (f32x4){kd[0], kd[1], kd[2], kd[3]}; *(LAS f32x4*)(rec + 260) = (f32x4){kd[4], kd[5], kd[6], kd[7]}; \
            *(LAS f32x4*)(rec + 320) = (f32x4){v[0], v[1], v[2], v[3]}; *(LAS f32x4*)(rec + 324) = (f32x4){v[4], v[5], v[6], v[7]}; \
            if (e == 0) *(LAS f32x2*)(scal_ + 2 * sl) = (f32x2){sbr, skr}; } while (0)
        if (!(MODE & 2)) { SC_PLOAD(0); SC_PWRITE(0); SC_PLOAD(1); }
        SC_BAR();
        for (int c = 0; c < NCH; ++c) {
            if (!(MODE & 2)) { if (c + 1 < NCH) SC_PWRITE(c + 1);
            if (c + 2 < NCH) SC_PLOAD(c + 2); }
            SC_BAR();
        }
#undef SC_PLOAD
#undef SC_PWRITE
    } else {
        const int rp = (wave * 64 + lane) >> 3, cgp = lane & 7;
        f32x2 s0[4], s1[4];
#pragma unroll
        for (int i = 0; i < 4; ++i) { s0[i] = (f32x2){0.f, 0.f}; s1[i] = (f32x2){0.f, 0.f}; }
        bf16* yrow = YO + (size_t)b * SEQ * RW + h * 64 + 2 * rp;
        SC_BAR();
#define SC_LOAD(N0, N1, Q0, Q1, D0, D1, B0, B1, K0, K1, VV, SS, sl_) do { const LAS float* rec_ = (const LAS float*)(buf + (sl_) * SC_REC) + 8 * cgp; \
            N0 = *(const LAS f32x4*)(rec_); N1 = *(const LAS f32x4*)(rec_ + 4); Q0 = *(const LAS f32x4*)(rec_ + 64); Q1 = *(const LAS f32x4*)(rec_ + 68); \
            D0 = *(const LAS f32x4*)(rec_ + 128); D1 = *(const LAS f32x4*)(rec_ + 132); B0 = *(const LAS f32x4*)(rec_ + 192); B1 = *(const LAS f32x4*)(rec_ + 196); \
            K0 = *(const LAS f32x4*)(rec_ + 256); K1 = *(const LAS f32x4*)(rec_ + 260); \
            VV = *(const LAS f32x2*)((const LAS float*)(buf + (sl_) * SC_REC) + 320 + 2 * rp); SS = *(const LAS f32x2*)(scal + 2 * (sl_)); } while (0)
        for (int c = 0; c < NCH; ++c) {
            const LAS unsigned char* buf = lds + (c & 1) * SC_BUF; const LAS float* scal = (const LAS float*)(lds + SC_SCAL) + (c & 1) * (SC_CH * 2);
            f32x4 n0, n1, q0, q1, d0, d1, b0, b1, k0, k1; f32x2 vv, sc;
            SC_LOAD(n0, n1, q0, q1, d0, d1, b0, b1, k0, k1, vv, sc, 0);
#pragma unroll 2
            for (int sl = 0; sl < SC_CH; ++sl) {
                f32x4 xn0, xn1, xq0, xq1, xd0, xd1, xb0, xb1, xk0, xk1; f32x2 xvv, xsc;
                const int sn = (sl + 1 < SC_CH) ? sl + 1 : sl;
                const f32x2 nk[4] = {(f32x2){n0.x, n0.y}, (f32x2){n0.z, n0.w}, (f32x2){n1.x, n1.y}, (f32x2){n1.z, n1.w}};
                const f32x2 qq[4] = {(f32x2){q0.x, q0.y}, (f32x2){q0.z, q0.w}, (f32x2){q1.x, q1.y}, (f32x2){q1.z, q1.w}};
                const f32x2 dv[4] = {(f32x2){d0.x, d0.y}, (f32x2){d0.z, d0.w}, (f32x2){d1.x, d1.y}, (f32x2){d1.z, d1.w}};
                const f32x2 bv[4] = {(f32x2){b0.x, b0.y}, (f32x2){b0.z, b0.w}, (f32x2){b1.x, b1.y}, (f32x2){b1.z, b1.w}};
                const f32x2 kv[4] = {(f32x2){k0.x, k0.y}, (f32x2){k0.z, k0.w}, (f32x2){k1.x, k1.y}, (f32x2){k1.z, k1.w}};
                f32x2 a0 = s0[0] * nk[0], a1 = s1[0] * nk[0], y0 = s0[0] * qq[0], y1 = s1[0] * qq[0];
#pragma unroll
                for (int i = 1; i < 4; ++i) { a0 = s0[i] * nk[i] + a0; a1 = s1[i] * nk[i] + a1; y0 = s0[i] * qq[i] + y0; y1 = s1[i] * qq[i] + y1; }
                float sa0 = a0.x + a0.y, sa1 = a1.x + a1.y, yp0 = y0.x + y0.y, yp1 = y1.x + y1.y;
                SC_LOAD(xn0, xn1, xq0, xq1, xd0, xd1, xb0, xb1, xk0, xk1, xvv, xsc, sn);
                sa0 = red8(sa0); sa1 = red8(sa1); yp0 = red8(yp0); yp1 = red8(yp1);
                const float yo0 = yp0 + sa0 * sc.x + vv.x * sc.y, yo1 = yp1 + sa1 * sc.x + vv.y * sc.y;
                const f32x2 sa0v = (f32x2){sa0, sa0}, sa1v = (f32x2){sa1, sa1}, v0v = (f32x2){vv.x, vv.x}, v1v = (f32x2){vv.y, vv.y};
#pragma unroll
                for (int i = 0; i < 4; ++i) {
                    f32x2 t0 = v0v * kv[i]; t0 = sa0v * bv[i] + t0; s0[i] = s0[i] * dv[i] + t0;
                    f32x2 t1 = v1v * kv[i]; t1 = sa1v * bv[i] + t1; s1[i] = s1[i] * dv[i] + t1;
                }
                const int step = c * SC_CH + sl, t = dir ? (SEQ - 1 - step) : step;
                const unsigned yw = pk2(yo0, yo1);
                if (!(MODE & 1)) { if (cgp == 0) *(unsigned*)(yrow + (size_t)t * RW) = yw; } else { asm volatile("" :: "v"(yw)); }
                n0 = xn0; n1 = xn1; q0 = xq0; q1 = xq1; d0 = xd0; d1 = xd1; b0 = xb0; b1 = xb1; k0 = xk0; k1 = xk1; vv = xvv; sc = xsc;
            }
            SC_BAR();
        }
#undef SC_LOAD
    }
#undef SC_BAR
    __syncthreads();
}

__device__ __forceinline__ bf16x8 pack8(const float (&x)[8]) {
    v4u w; w.x = pk2(x[0], x[1]); w.y = pk2(x[2], x[3]); w.z = pk2(x[4], x[5]); w.w = pk2(x[6], x[7]); return __builtin_bit_cast(bf16x8, w);
}
#define MFMA16(a, b, c) __builtin_amdgcn_mfma_f32_16x16x32_bf16((a), (b), (c), 0, 0, 0)
constexpr int CK = 16, NCK = SEQ / CK;
constexpr int L_QK = 0, L_PR = 4608, L_QKT = 9216, L_VT = 14336, L_VF = 19456, L_GC = 23552, L_OPSZ = 23808;
constexpr int L_E = 2 * L_OPSZ, L_G = L_E + 4096, L_GSZ = 5120, L_W0 = L_G + 2 * L_GSZ, L_VG = L_W0 + 4096, L_SB = L_VG + 2 * 4096, L_CEND = L_SB + 9216;
static_assert(L_CEND + 1280 <= 131072, "chunked scan LDS map");
#ifdef CBAR_FULL
#define CBAR() __syncthreads()
#else
#define CBAR() do { __builtin_amdgcn_s_waitcnt(0xC07F); __builtin_amdgcn_s_barrier(); } while (0)
#endif
__device__ __forceinline__ void scan_chunked(const Params& P, int sid, LAS unsigned char* lds) {
    const int tid = pg8::mk_tid(lds), lane = tid & 63, wave = __builtin_amdgcn_readfirstlane(tid >> 6), l15 = lane & 15, q4 = lane >> 4;
    const int b = sid / 24, rem = sid % 24, h = rem >> 1, dir = rem & 1;
    const bf16* PRE = (const bf16*)(P.ws + WS_PRE); const bf16* EA = (const bf16*)((unsigned char*)P.out + DO_EA);
    bf16* YO = dir ? (bf16*)(P.ws + WS_YB) : (bf16*)((unsigned char*)P.out + DO_YF);
#ifdef YZERO
    for (int it = tid; it < SEQ * 8; it += NTHREADS) *(v4u*)(YO + ((size_t)b * SEQ + (it >> 3)) * RW + h * 64 + (it & 7) * 8) = (v4u){0u, 0u, 0u, 0u};
#endif
    for (int i = tid; i < 9216 / 4; i += NTHREADS) ((LAS unsigned*)(lds + L_SB))[i] = 0u;
    for (int i = tid; i < L_SB / 4; i += NTHREADS) ((LAS unsigned*)(lds))[i] = 0u;
    if (tid < 320) { const int vsel = tid >> 6, chn = h * 64 + (tid & 63);
        ((LAS float*)(lds + L_CEND))[tid] = (vsel < 3) ? P.in[10][vsel * 768 + chn] : ((vsel == 3) ? P.in[11][chn] : P.in[12][chn]); }
    CBAR();
    if (wave >= 4) {
        const int pt = tid - 256, t = pt >> 4, e = pt & 15, ch0 = h * 64 + 4 * e, gsw = 8 * ((e >> 1) & 3);
        const LAS float* cst = (const LAS float*)(lds + L_CEND) + 4 * e;
        v2u rcA, kcA, vcA, rpA, kpA, vpA, rnA, knA, vnA, e8A, a8A, rcB, kcB, vcB, rpB, kpB, vpB, rnB, knB, vnB, e8B, a8B;
        const v2u z2 = (v2u){0u, 0u};
#define CK_PLOAD(X, c_) do { const int step_ = (c_) * CK + t, t_ = dir ? (SEQ - 1 - step_) : step_; const size_t m_ = (size_t)b * SEQ + t_; \
            const bf16* rowp_ = PRE + m_ * NPRE + C_RS + ch0; \
            const bf16* rowq_ = (t_ > 0) ? rowp_ - NPRE : rowp_; const bf16* rown_ = (t_ < SEQ - 1) ? rowp_ + NPRE : rowp_;     \
            rc##X = *(const v2u*)(rowp_); kc##X = *(const v2u*)(rowp_ + 768); vc##X = *(const v2u*)(rowp_ + 1536); \
            rp##X = *(const v2u*)(rowq_); kp##X = *(const v2u*)(rowq_ + 768); vp##X = *(const v2u*)(rowq_ + 1536); \
            rn##X = *(const v2u*)(rown_); kn##X = *(const v2u*)(rown_ + 768); vn##X = *(const v2u*)(rown_ + 1536); \
            const bf16* eap_ = EA + m_ * NLORA + dir * RW + ch0; e8##X = *(const v2u*)(eap_); a8##X = *(const v2u*)(eap_ + 1536); } while (0)
        CK_PLOAD(A, 0); CK_PLOAD(B, 1);
        float r[4], k[4], v[4], kk[4], aa[4], ee[4];
#define CK_PBODY(X, c_) do { const int c = (c_); const int pb = (c & 1) * L_OPSZ; \
            {   \
                float x0[4], x1[4], x2[4]; f32x4 cc; \
                const int stepc_ = ((c < NCK) ? c : NCK - 1) * CK + t, tc_ = dir ? (SEQ - 1 - stepc_) : stepc_; const float fp_ = (tc_ > 0) ? 1.f : 0.f, fn_ = (tc_ < SEQ - 1) ? 1.f : 0.f; \
                unpack4(rc##X, x0); unpack4(rp##X, x1); unpack4(rn##X, x2); cc = *(const LAS f32x4*)(cst); \
                _Pragma("unroll") for (int i = 0; i < 4; ++i) r[i] = x0[i] + cc[i] * (0.5f * (fp_ * x1[i] + fn_ * x2[i]) - x0[i]); \
                unpack4(kc##X, x0); unpack4(kp##X, x1); unpack4(kn##X, x2); cc = *(const LAS f32x4*)(cst + 64); \
                _Pragma("unroll") for (int i = 0; i < 4; ++i) k[i] = x0[i] + cc[i] * (0.5f * (fp_ * x1[i] + fn_ * x2[i]) - x0[i]); \
                unpack4(vc##X, x0); unpack4(vp##X, x1); unpack4(vn##X, x2); cc = *(const LAS f32x4*)(cst + 128); \
                _Pragma("unroll") for (int i = 0; i < 4; ++i) v[i] = x0[i] + cc[i] * (0.5f * (fp_ * x1[i] + fn_ * x2[i]) - x0[i]); \
                unpack4(e8##X, ee); unpack4(a8##X, aa); cc = *(const LAS f32x4*)(cst + 192); \
                float ss = 0.f; \
                _Pragma("unroll") for (int i = 0; i < 4; ++i) { kk[i] = k[i] * cc[i]; ss += kk[i] * kk[i]; } \
                ss = red8(ss); ss = dpp_add<0x140>(ss); \
                const float inv = __builtin_amdgcn_rcpf(fmaxf(__builtin_amdgcn_sqrtf(ss), 1e-12f)); \
                _Pragma("unroll") for (int i = 0; i < 4; ++i) kk[i] *= inv; \
                *(LAS f32x4*)((LAS float*)(lds + L_E) + t * 64 + 4 * e) = (f32x4){ee[0], ee[1], ee[2], ee[3]}; \
                CK_PLOAD(X, (c + 2 < NCK) ? c + 2 : NCK - 1); \
            } \
            CBAR(); \
            { \
                f32x4 gs = (f32x4){0.f, 0.f, 0.f, 0.f}; \
                _Pragma("unroll") for (int u = 0; u < CK; ++u) { \
                    const f32x4 ea = *(const LAS f32x4*)((const LAS float*)(lds + L_E) + u * 64 + 4 * e); \
                    const float m = (u <= t) ? 1.f : 0.f; gs += m * ea; } \
                const f32x4 kac = *(const LAS f32x4*)(cst + 256); \
                float qv[4], kt[4], pv[4], rt[4], gin[4]; \
                _Pragma("unroll") for (int i = 0; i < 4; ++i) { \
                    gin[i] = __expf(-gs[i]); const float gex = __expf(ee[i] - gs[i]), ginv = __expf(gs[i]); \
                    const float kd = k[i] * (1.f + (aa[i] - 1.f) * kac[i]); \
                    qv[i] = kk[i] * aa[i] * ginv; kt[i] = kd * ginv; pv[i] = kk[i] * gex; rt[i] = r[i] * gin[i]; \
                } \
                LAS unsigned char* ob = lds + pb; \
                unsigned wq[4]; v2u o; \
                _Pragma("unroll") for (int i = 0; i < 4; ++i) wq[i] = pk2(qv[i], kt[i]);                        \
                o.x = (wq[0] & 0xffffu) | (wq[1] << 16); o.y = (wq[2] & 0xffffu) | (wq[3] << 16); *(LAS v2u*)(ob + L_QK + (t * 72 + 4 * e) * 2) = o; \
                o.x = (wq[0] >> 16) | (wq[1] & 0xffff0000u); o.y = (wq[2] >> 16) | (wq[3] & 0xffff0000u); *(LAS v2u*)(ob + L_QK + ((16 + t) * 72 + 4 * e) * 2) = o; \
                o.x = pk2(pv[0], pv[1]); o.y = pk2(pv[2], pv[3]); *(LAS v2u*)(ob + L_PR + (t * 72 + 4 * e) * 2) = o; \
                o.x = pk2(rt[0], rt[1]); o.y = pk2(rt[2], rt[3]); *(LAS v2u*)(ob + L_PR + ((16 + t) * 72 + 4 * e) * 2) = o; \
                const unsigned wv01 = pk2(v[0], v[1]), wv23 = pk2(v[2], v[3]); \
                _Pragma("unroll") for (int i = 0; i < 4; ++i) { \
                    *(LAS bf16*)(ob + L_QKT + ((4 * e + i) * 40 + (t ^ gsw)) * 2) = (bf16)(wq[i] & 0xffffu); *(LAS bf16*)(ob + L_QKT + ((4 * e + i) * 40 + ((16 + t) ^ gsw)) * 2) = (bf16)(wq[i] >> 16); \
                    const unsigned wv = (i < 2) ? wv01 : wv23; \
                    *(LAS bf16*)(ob + L_VT + ((4 * e + i) * 40 + ((16 + t) ^ gsw)) * 2) = (bf16)((i & 1) ? (wv >> 16) : (wv & 0xffffu)); \
                } \
                if (t == CK - 1) *(LAS f32x4*)((LAS float*)(ob + L_GC) + 4 * e) = (f32x4){gin[0], gin[1], gin[2], gin[3]}; \
            } \
            CBAR(); \
            CBAR(); } while (0)
        static_assert((NCK + 2) % 2 == 0, "producer loop is unrolled by two");
        for (int c2 = 0; c2 <= NCK + 1; c2 += 2) { CK_PBODY(A, c2); CK_PBODY(B, c2 + 1); }
#undef CK_PBODY
#undef CK_PLOAD
    } else {
        const int w = wave;
        f32x4 acc[4];
#pragma unroll
        for (int nt = 0; nt < 4; ++nt) acc[nt] = (f32x4){0.f, 0.f, 0.f, 0.f};
        bf16* ybase = YO + (size_t)b * SEQ * RW + h * 64 + 16 * w + 4 * q4;
        for (int c = 0; c <= NCK + 1; ++c) {
            const int ck = c - 1; const bool valid = (ck >= 0 && ck < NCK);
            const int pb = (ck & 1) * L_OPSZ, gb = L_G + (ck & 1) * L_GSZ;
            f32x4 r1 = (f32x4){0.f, 0.f, 0.f, 0.f};
            if (valid) {
                f32x4 r0 = (f32x4){0.f, 0.f, 0.f, 0.f};
#pragma unroll
                for (int ks = 0; ks < 2; ++ks) {
                    const bf16x8 S = *(const LAS bf16x8*)(lds + L_SB + ((16 * w + l15) * 72 + ks * 32 + 8 * q4) * 2);
                    const bf16x8 Bp = *(const LAS bf16x8*)(lds + pb + L_PR + ((l15) * 72 + ks * 32 + 8 * q4) * 2);
                    const bf16x8 Br = *(const LAS bf16x8*)(lds + pb + L_PR + ((16 + l15) * 72 + ks * 32 + 8 * q4) * 2);
                    r0 = MFMA16(S, Bp, r0); r1 = MFMA16(S, Br, r1);
                }
                *(LAS f32x4*)(lds + L_W0 + (l15 * 64 + 16 * w + 4 * q4) * 4) = r0;
            }
            if (valid && w == 1) {
#pragma unroll
                for (int x = 0; x < 4; ++x) {
                    const int a = x >> 1, bc = x & 1;
                    f32x4 g = (f32x4){0.f, 0.f, 0.f, 0.f};
#pragma unroll
                    for (int ks = 0; ks < 2; ++ks) {
                        const bf16x8 A = *(const LAS bf16x8*)(lds + pb + L_QK + ((a * 16 + l15) * 72 + ks * 32 + 8 * q4) * 2);
                        const bf16x8 Bm = *(const LAS bf16x8*)(lds + pb + L_PR + ((bc * 16 + l15) * 72 + ks * 32 + 8 * q4) * 2);
                        g = MFMA16(A, Bm, g);
                    }
                    *(LAS f32x4*)(lds + gb + x * 1280 + (l15 * 20 + 4 * q4) * 4) = g;
                }
                __builtin_amdgcn_s_waitcnt(0xC07F);
                float bw[8];
                {
                    const f32x4 ga = *(const LAS f32x4*)(lds + gb + 2 * 1280 + (l15 * 20 + 8 * (q4 & 1)) * 4), gb2 = *(const LAS f32x4*)(lds + gb + 2 * 1280 + (l15 * 20 + 8 * (q4 & 1) + 4) * 4);
#pragma unroll
                    for (int ii = 0; ii < 8; ++ii) { const int s = 8 * (q4 & 1) + ii; const float gv = (ii < 4) ? ga[ii & 3] : gb2[ii & 3]; bw[ii] = (q4 >= 2 && s < l15) ? gv : 0.f; }
                }
                const bf16x8 Bf = pack8(bw);
#pragma unroll
                for (int mt = 0; mt < 4; ++mt) {
                    const bf16x8 Av = *(const LAS bf16x8*)(lds + pb + L_VT + ((mt * 16 + l15) * 40 + 8 * (q4 ^ (((mt * 16 + l15) >> 3) & 3))) * 2);
                    f32x4 r = (f32x4){0.f, 0.f, 0.f, 0.f};
                    r = MFMA16(Av, Bf, r);
                    *(LAS f32x4*)(lds + L_VG + (ck & 1) * 4096 + (l15 * 64 + mt * 16 + 4 * q4) * 4) = r;
                }
            }
            CBAR();
            if (valid && w == 0) {
                const int i = lane;
                float u[16];
#pragma unroll
                for (int s = 0; s < 16; ++s) u[s] = *(const LAS float*)(lds + L_W0 + (s * 64 + i) * 4) + *(const LAS float*)(lds + L_VG + (ck & 1) * 4096 + (s * 64 + i) * 4);
#pragma unroll
                for (int blk = 0; blk < 4; ++blk) {
                    f32x4 gq[4][4];
#pragma unroll
                    for (int tt = 0; tt < 4; ++tt)
#pragma unroll
                        for (int s4 = 0; s4 <= blk; ++s4) gq[tt][s4] = *(const LAS f32x4*)(lds + gb + 0 * 1280 + ((4 * blk + tt) * 20 + 4 * s4) * 4);
#pragma unroll
                    for (int s = 0; s < 4 * blk; ++s)
#pragma unroll
                        for (int tt = 0; tt < 4; ++tt) u[4 * blk + tt] -= gq[tt][s >> 2][s & 3] * u[s];
#pragma unroll
                    for (int tt = 1; tt < 4; ++tt)
#pragma unroll
                        for (int sp = 0; sp < tt; ++sp) u[4 * blk + tt] -= gq[tt][blk][sp] * u[4 * blk + sp];
                    __builtin_amdgcn_sched_barrier(0);
                }
                float n0[8], n1[8];
#pragma unroll
                for (int s = 0; s < 8; ++s) { n0[s] = -u[s]; n1[s] = -u[8 + s]; }
                *(LAS bf16x8*)(lds + pb + L_VT + (i * 40 + 8 * (0 ^ ((i >> 3) & 3))) * 2) = pack8(n0); *(LAS bf16x8*)(lds + pb + L_VT + (i * 40 + 8 * (1 ^ ((i >> 3) & 3))) * 2) = pack8(n1);
            }
            CBAR();
            if (valid) {
                const bf16x8 Bv = *(const LAS bf16x8*)(lds + pb + L_VT + ((16 * w + l15) * 40 + 8 * (q4 ^ (((16 * w + l15) >> 3) & 3))) * 2);
                {
                    const int xo = (q4 < 2) ? 1 : 3;
                    const f32x4 ga = *(const LAS f32x4*)(lds + gb + xo * 1280 + (l15 * 20 + 8 * (q4 & 1)) * 4), gb2 = *(const LAS f32x4*)(lds + gb + xo * 1280 + (l15 * 20 + 8 * (q4 & 1) + 4) * 4);
                    float bw[8];
#pragma unroll
                    for (int ii = 0; ii < 8; ++ii) { const int s = 8 * (q4 & 1) + ii; const float gv = (ii < 4) ? ga[ii & 3] : gb2[ii & 3]; bw[ii] = (s <= l15) ? gv : 0.f; }
                    const f32x4 y = MFMA16(Bv, pack8(bw), r1);
                    const int step = ck * CK + l15, tt = dir ? (SEQ - 1 - step) : step;
                    v2u o; o.x = pk2(y[0], y[1]); o.y = pk2(y[2], y[3]);
                    *(v2u*)(ybase + (size_t)tt * RW) = o;
                }
#pragma unroll
                for (int nt = 0; nt < 4; ++nt) {
                    const bf16x8 Aq = *(const LAS bf16x8*)(lds + pb + L_QKT + ((nt * 16 + l15) * 40 + 8 * (q4 ^ (((nt * 16 + l15) >> 3) & 3))) * 2);
                    acc[nt] = MFMA16(Aq, Bv, acc[nt]);
                    const f32x4 gc = *(const LAS f32x4*)(lds + pb + L_GC + (nt * 16 + 4 * q4) * 4);
                    acc[nt] = acc[nt] * gc;
                    v2u o; o.x = pk2(acc[nt][0], acc[nt][1]); o.y = pk2(acc[nt][2], acc[nt][3]);
                    *(LAS v2u*)(lds + L_SB + ((16 * w + l15) * 72 + nt * 16 + 4 * q4) * 2) = o;
                }
            }
            CBAR();
        }
    }
    __syncthreads();
}
#undef CBAR

constexpr int KA_P = 72, VA_P = 392;
__device__ __forceinline__ void attnA_item(const Params& P, int item, LAS unsigned char* lds) {
    const int tid = pg8::mk_tid(lds), lane = tid & 63, wave = __builtin_amdgcn_readfirstlane(tid >> 6), l15 = lane & 15, q4 = lane >> 4;
    const int b = item >> 6, n = (item >> 2) & 15, hk = item & 3;
    const bf16* PRE = (const bf16*)(P.ws + WS_PRE); bf16* YC = (bf16*)(P.ws + WS_YCAT);
    const float* RC = (const float*)(P.ws + WS_ROPE); const float* RS = RC + SEQ * 32;
    LAS bf16* Ks = (LAS bf16*)lds; LAS bf16* Vt = Ks + 384 * KA_P;
    {
        v2u klo[6], khi[6]; f32x4 kcs[6], ksn[6]; v4u vw[6];
#pragma unroll
        for (int u = 0; u < 6; ++u) {
            const int it = tid + u * NTHREADS, j = it >> 3, c = it & 7, kp = (n - 1) * 128 + j;
            const bool ok = (kp >= 0 && kp < SEQ); const int kpc = ok ? kp : 0;
            const bf16* src = PRE + ((size_t)b * SEQ + kpc) * NPRE + C_AK + hk * 64;
            klo[u] = *(const v2u*)(src + 4 * c); khi[u] = *(const v2u*)(src + 32 + 4 * c);
            kcs[u] = *(const f32x4*)(RC + kpc * 32 + 4 * c); ksn[u] = *(const f32x4*)(RS + kpc * 32 + 4 * c);
            vw[u] = *(const v4u*)(PRE + ((size_t)b * SEQ + kpc) * NPRE + C_AV + hk * 64 + 8 * c);
        }
        const f32x4 g1 = *(const f32x4*)(P.in[7] + 4 * (tid & 7)), g2 = *(const f32x4*)(P.in[7] + 32 + 4 * (tid & 7));
#pragma unroll
        for (int u = 0; u < 6; ++u) {
            const int it = tid + u * NTHREADS, j = it >> 3, c = it & 7, kp = (n - 1) * 128 + j;
            const bool ok = (kp >= 0 && kp < SEQ);
            float x1[4], x2[4]; unpack4(klo[u], x1); unpack4(khi[u], x2);
            float ss = 0.f;
#pragma unroll
            for (int i = 0; i < 4; ++i) ss += x1[i] * x1[i] + x2[i] * x2[i];
            ss = red8(ss);
            const float rstd = ok ? 1.f / sqrtf(ss * (1.f / 64.f) + NORM_EPS) : 0.f;
            float r1[4], r2[4];
#pragma unroll
            for (int i = 0; i < 4; ++i) { const float y1 = x1[i] * rstd * g1[i], y2 = x2[i] * rstd * g2[i]; r1[i] = y1 * kcs[u][i] - y2 * ksn[u][i]; r2[i] = y2 * kcs[u][i] + y1 * ksn[u][i]; }
            v2u o0, o1; o0.x = pk2(r1[0], r1[1]); o0.y = pk2(r1[2], r1[3]); o1.x = pk2(r2[0], r2[1]); o1.y = pk2(r2[2], r2[3]);
            *(LAS v2u*)(Ks + j * KA_P + 4 * c) = o0; *(LAS v2u*)(Ks + j * KA_P + 32 + 4 * c) = o1;
            const v4u w = ok ? vw[u] : (v4u){0u, 0u, 0u, 0u};
            LAS bf16* d = Vt + (8 * c) * VA_P + j;
            d[0] = (bf16)(w.x & 0xffffu); d[VA_P] = (bf16)(w.x >> 16); d[2 * VA_P] = (bf16)(w.y & 0xffffu); d[3 * VA_P] = (bf16)(w.y >> 16);
            d[4 * VA_P] = (bf16)(w.z & 0xffffu); d[5 * VA_P] = (bf16)(w.z >> 16); d[6 * VA_P] = (bf16)(w.w & 0xffffu); d[7 * VA_P] = (bf16)(w.w >> 16);
        }
    }
    v4u qlo, qhi;
    {
        const int R0 = wave * 48, g = R0 >> 7, pos = (R0 & 127) + l15, qp = n * 128 + pos, hq = hk * 3 + g;
        const bf16* src = PRE + ((size_t)b * SEQ + qp) * NPRE + C_AQ + hq * 64;
        qlo = *(const v4u*)(src + 8 * q4); qhi = *(const v4u*)(src + 32 + 8 * q4);
    }
    __syncthreads();
#pragma unroll 1
    for (int mt = 0; mt < 3; ++mt) {
        const int R0 = wave * 48 + mt * 16, g = R0 >> 7, pos = (R0 & 127) + l15, qp = n * 128 + pos, hq = hk * 3 + g;
        const size_t m = (size_t)b * SEQ + qp;
        v2u gat[4];
#pragma unroll
        for (int dt = 0; dt < 4; ++dt) gat[dt] = *(const v2u*)(PRE + m * NPRE + C_AG + hq * 64 + dt * 16 + 4 * q4);
        const v4u cqlo = qlo, cqhi = qhi;
        {
            const int mn = (mt < 2) ? mt + 1 : 2, R1 = wave * 48 + mn * 16, g1_ = R1 >> 7, pos1 = (R1 & 127) + l15, qp1 = n * 128 + pos1, hq1 = hk * 3 + g1_;
            const bf16* src = PRE + ((size_t)b * SEQ + qp1) * NPRE + C_AQ + hq1 * 64;
            qlo = *(const v4u*)(src + 8 * q4); qhi = *(const v4u*)(src + 32 + 8 * q4);
        }
        bf16x8 qf0, qf1;
        {
            float x1[8], x2[8]; unpack8(cqlo, x1); unpack8(cqhi, x2);
            float ss = 0.f;
#pragma unroll
            for (int i = 0; i < 8; ++i) ss += x1[i] * x1[i] + x2[i] * x2[i];
            ss += __shfl_xor(ss, 16); ss += __shfl_xor(ss, 32);
            const float rstd = (0.125f * 1.4426950408889634f) / sqrtf(ss * (1.f / 64.f) + NORM_EPS);
            float r1[8], r2[8];
            const f32x4 ga = *(const f32x4*)(P.in[6] + 8 * q4), gb = *(const f32x4*)(P.in[6] + 8 * q4 + 4), gc = *(const f32x4*)(P.in[6] + 32 + 8 * q4), gd = *(const f32x4*)(P.in[6] + 36 + 8 * q4);
            const f32x4 ca = *(const f32x4*)(RC + qp * 32 + 8 * q4), cb = *(const f32x4*)(RC + qp * 32 + 8 * q4 + 4), sa_ = *(const f32x4*)(RS + qp * 32 + 8 * q4), sb_ = *(const f32x4*)(RS + qp * 32 + 8 * q4 + 4);
#pragma unroll
            for (int i = 0; i < 8; ++i) {
                const float g1 = (i < 4) ? ga[i & 3] : gb[i & 3], g2 = (i < 4) ? gc[i & 3] : gd[i & 3], cs = (i < 4) ? ca[i & 3] : cb[i & 3], sn = (i < 4) ? sa_[i & 3] : sb_[i & 3];
                const float y1 = x1[i] * rstd * g1, y2 = x2[i] * rstd * g2; r1[i] = y1 * cs - y2 * sn; r2[i] = y2 * cs + y1 * sn;
            }
            qf0 = pack8(r1); qf1 = pack8(r2);
        }
        const int kt0 = (R0 & 127) >> 4;
        const int seq_lo = (n == 0) ? 8 : 0, seq_hi = (n == 15) ? 15 : 23;
        f32x4 acc[18];
#pragma unroll
        for (int u = 0; u < 17; ++u) {
            const LAS bf16* kr = Ks + ((kt0 + u) * 16 + l15) * KA_P + 8 * q4;
            const bf16x8 k0 = *(const LAS bf16x8*)(kr), k1 = *(const LAS bf16x8*)(kr + 32);
            f32x4 a = (f32x4){0.f, 0.f, 0.f, 0.f};
            a = MFMA16(k0, qf0, a); a = MFMA16(k1, qf1, a); acc[u] = a;
        }
        acc[17] = (f32x4){-1e30f, -1e30f, -1e30f, -1e30f};
        const float sink = P.in[8][hq] * 1.4426950408889634f;
        float mx = sink;
#pragma unroll
        for (int u = 0; u < 17; ++u) {
            const bool tv = (kt0 + u >= seq_lo) && (kt0 + u <= seq_hi);
#pragma unroll
            for (int i = 0; i < 4; ++i) {
                bool valid = tv;
                if (u == 0) valid = valid && (4 * q4 + i >= l15);
                if (u == 16) valid = valid && (4 * q4 + i <= l15);
                const float sv = valid ? acc[u][i] : -1e30f; acc[u][i] = sv; mx = fmaxf(mx, sv);
            }
        }
        mx = fmaxf(mx, __shfl_xor(mx, 16)); mx = fmaxf(mx, __shfl_xor(mx, 32));
        float sum = 0.f;
#pragma unroll
        for (int u = 0; u < 17; ++u)
#pragma unroll
            for (int i = 0; i < 4; ++i) { const float p = __builtin_amdgcn_exp2f(acc[u][i] - mx); acc[u][i] = p; sum += p; }
        acc[17] = (f32x4){0.f, 0.f, 0.f, 0.f};
        sum += __shfl_xor(sum, 16); sum += __shfl_xor(sum, 32);
        const float inv = 1.f / (sum + __builtin_amdgcn_exp2f(sink - mx));
        f32x4 o[4];
#pragma unroll
        for (int dt = 0; dt < 4; ++dt) o[dt] = (f32x4){0.f, 0.f, 0.f, 0.f};
#pragma unroll
        for (int k2 = 0; k2 < 9; ++k2) {
            float pp[8] = {acc[2 * k2][0], acc[2 * k2][1], acc[2 * k2][2], acc[2 * k2][3], acc[2 * k2 + 1][0], acc[2 * k2 + 1][1], acc[2 * k2 + 1][2], acc[2 * k2 + 1][3]};
            const bf16x8 pf = pack8(pp);
#pragma unroll
            for (int dt = 0; dt < 4; ++dt) {
                const LAS bf16* vr = Vt + (dt * 16 + l15) * VA_P + kt0 * 16 + k2 * 32 + 4 * q4;
                const v2u v0 = *(const LAS v2u*)(vr);
                v2u v1 = (v2u){0u, 0u};
                if (k2 < 8) v1 = *(const LAS v2u*)(vr + 16);
                const v4u vw = (v4u){v0.x, v0.y, v1.x, v1.y};
                o[dt] = MFMA16(__builtin_bit_cast(bf16x8, vw), pf, o[dt]);
            }
        }
#pragma unroll
        for (int dt = 0; dt < 4; ++dt) {
            const int ch = hq * 64 + dt * 16 + 4 * q4;
            float gg[4]; unpack4(gat[dt], gg);
            v2u w; w.x = pk2(o[dt][0] * inv * gg[0], o[dt][1] * inv * gg[1]); w.y = pk2(o[dt][2] * inv * gg[2], o[dt][3] * inv * gg[3]);
            *(v2u*)(YC + m * DM + ch) = w;
        }
    }
    __syncthreads();
}

constexpr int KC_P = 136, VC_P = 264;
__device__ __forceinline__ void attnC_qblock(const Params& P, const LAS bf16* Ks, const LAS bf16* Vt, bf16* YC, const v4u (&qraw)[4], const v2u (&gat)[8], size_t m, int hx, int l15, int q4) {
    {
        bf16x8 qf[4];
        {
            float x[4][8]; float ss = 0.f;
#pragma unroll
            for (int ks = 0; ks < 4; ++ks) { unpack8(qraw[ks], x[ks]);
#pragma unroll
                for (int i = 0; i < 8; ++i) ss += x[ks][i] * x[ks][i]; }
            ss += __shfl_xor(ss, 16); ss += __shfl_xor(ss, 32);
            const float rstd = (0.08838834764831845f * 1.4426950408889634f) / sqrtf(ss * (1.f / 128.f) + NORM_EPS);
#pragma unroll
            for (int ks = 0; ks < 4; ++ks) { float y[8];
                const f32x4 ga = *(const f32x4*)(P.in[22] + ks * 32 + 8 * q4), gb = *(const f32x4*)(P.in[22] + ks * 32 + 8 * q4 + 4);
#pragma unroll
                for (int i = 0; i < 8; ++i) y[i] = x[ks][i] * rstd * ((i < 4) ? ga[i & 3] : gb[i & 3]);
                qf[ks] = pack8(y); }
        }
        f32x4 acc[16];
#pragma unroll
        for (int kt = 0; kt < 16; ++kt) {
            const LAS bf16* kr = Ks + (kt * 16 + l15) * KC_P + 8 * q4;
            f32x4 a = (f32x4){0.f, 0.f, 0.f, 0.f};
#pragma unroll
            for (int ks = 0; ks < 4; ++ks) a = MFMA16(*(const LAS bf16x8*)(kr + ks * 32), qf[ks], a);
            acc[kt] = a;
        }
        float mx = -1e30f;
#pragma unroll
        for (int kt = 0; kt < 16; ++kt)
#pragma unroll
            for (int i = 0; i < 4; ++i) mx = fmaxf(mx, acc[kt][i]);
        mx = fmaxf(mx, __shfl_xor(mx, 16)); mx = fmaxf(mx, __shfl_xor(mx, 32));
        float sum = 0.f;
#pragma unroll
        for (int kt = 0; kt < 16; ++kt)
#pragma unroll
            for (int i = 0; i < 4; ++i) { const float p = __builtin_amdgcn_exp2f(acc[kt][i] - mx); acc[kt][i] = p; sum += p; }
        sum += __shfl_xor(sum, 16); sum += __shfl_xor(sum, 32);
        const float inv = 1.f / sum;
        f32x4 o[8];
#pragma unroll
        for (int dt = 0; dt < 8; ++dt) o[dt] = (f32x4){0.f, 0.f, 0.f, 0.f};
#pragma unroll
        for (int k2 = 0; k2 < 8; ++k2) {
            float pp[8] = {acc[2 * k2][0], acc[2 * k2][1], acc[2 * k2][2], acc[2 * k2][3], acc[2 * k2 + 1][0], acc[2 * k2 + 1][1], acc[2 * k2 + 1][2], acc[2 * k2 + 1][3]};
            const bf16x8 pf = pack8(pp);
#pragma unroll
            for (int dt = 0; dt < 8; ++dt) {
                const LAS bf16* vr = Vt + (dt * 16 + l15) * VC_P + k2 * 32 + 4 * q4;
                const v2u v0 = *(const LAS v2u*)(vr), v1 = *(const LAS v2u*)(vr + 16);
                const v4u vw = (v4u){v0.x, v0.y, v1.x, v1.y};
                o[dt] = MFMA16(__builtin_bit_cast(bf16x8, vw), pf, o[dt]);
            }
        }
#pragma unroll
        for (int dt = 0; dt < 8; ++dt) {
            const int ch = hx * 128 + dt * 16 + 4 * q4;
            float gg[4]; unpack4(gat[dt], gg);
            v2u w; w.x = pk2(o[dt][0] * inv * gg[0], o[dt][1] * inv * gg[1]); w.y = pk2(o[dt][2] * inv * gg[2], o[dt][3] * inv * gg[3]);
            *(v2u*)(YC + m * DM + 1536 + ch) = w;
        }
    }
}
__device__ __forceinline__ void attnC_item(const Params& P, int item, LAS unsigned char* lds) {
    const int tid = pg8::mk_tid(lds), lane = tid & 63, wave = __builtin_amdgcn_readfirstlane(tid >> 6), l15 = lane & 15, q4 = lane >> 4;
    const int b = item >> 5, qb0 = 2 * ((item >> 2) & 7), hx = item & 3;
    const bf16* PRE = (const bf16*)(P.ws + WS_PRE); const bf16* MKV = (const bf16*)(P.ws + WS_MKV); bf16* YC = (bf16*)(P.ws + WS_YCAT);
    LAS bf16* Ks = (LAS bf16*)lds; LAS bf16* Vt = Ks + 256 * KC_P;
    const size_t m = (size_t)b * SEQ + qb0 * 128 + wave * 16 + l15;
    {
        v4u kw[8], vw[8];
#pragma unroll
        for (int u = 0; u < 8; ++u) {
            const int it = tid + u * NTHREADS, j = it >> 4, c = it & 15;
            const bf16* src = MKV + ((size_t)b * NMEM + j) * 1024 + hx * 128 + 8 * c;
            kw[u] = *(const v4u*)(src); vw[u] = *(const v4u*)(src + 512);
        }
        const f32x4 g0 = *(const f32x4*)(P.in[23] + 8 * (tid & 15)), g1 = *(const f32x4*)(P.in[23] + 8 * (tid & 15) + 4);
#pragma unroll
        for (int u = 0; u < 8; ++u) {
            const int it = tid + u * NTHREADS, j = it >> 4, c = it & 15;
            float x[8]; unpack8(kw[u], x);
            float ss = 0.f;
#pragma unroll
            for (int i = 0; i < 8; ++i) ss += x[i] * x[i];
            ss = red8(ss); ss = dpp_add<0x140>(ss);
            const float rstd = 1.f / sqrtf(ss * (1.f / 128.f) + NORM_EPS);
            v4u o; o.x = pk2(x[0] * rstd * g0.x, x[1] * rstd * g0.y); o.y = pk2(x[2] * rstd * g0.z, x[3] * rstd * g0.w);
            o.z = pk2(x[4] * rstd * g1.x, x[5] * rstd * g1.y); o.w = pk2(x[6] * rstd * g1.z, x[7] * rstd * g1.w);
            *(LAS v4u*)(Ks + j * KC_P + 8 * c) = o;
            const v4u w = vw[u];
            LAS bf16* d = Vt + (8 * c) * VC_P + j;
            d[0] = (bf16)(w.x & 0xffffu); d[VC_P] = (bf16)(w.x >> 16); d[2 * VC_P] = (bf16)(w.y & 0xffffu); d[3 * VC_P] = (bf16)(w.y >> 16);
            d[4 * VC_P] = (bf16)(w.z & 0xffffu); d[5 * VC_P] = (bf16)(w.z >> 16); d[6 * VC_P] = (bf16)(w.w & 0xffffu); d[7 * VC_P] = (bf16)(w.w >> 16);
        }
    }
    v4u qraw[4]; v2u gat[8];
    {
        const bf16* src = PRE + m * NPRE + C_XQ + hx * 128 + 8 * q4;
#pragma unroll
        for (int ks = 0; ks < 4; ++ks) qraw[ks] = *(const v4u*)(src + ks * 32);
#pragma unroll
        for (int dt = 0; dt < 8; ++dt) gat[dt] = *(const v2u*)(PRE + m * NPRE + C_XG + hx * 128 + dt * 16 + 4 * q4);
    }
    __syncthreads();
    v4u qraw2[4]; v2u gat2[8];
    {
        const size_t m2 = m + 128; const bf16* src = PRE + m2 * NPRE + C_XQ + hx * 128 + 8 * q4;
#pragma unroll
        for (int ks = 0; ks < 4; ++ks) qraw2[ks] = *(const v4u*)(src + ks * 32);
#pragma unroll
        for (int dt = 0; dt < 8; ++dt) gat2[dt] = *(const v2u*)(PRE + m2 * NPRE + C_XG + hx * 128 + dt * 16 + 4 * q4);
    }
    attnC_qblock(P, Ks, Vt, YC, qraw, gat, m, hx, l15, q4);
    __builtin_amdgcn_sched_barrier(0);
    attnC_qblock(P, Ks, Vt, YC, qraw2, gat2, m + 128, hx, l15, q4);
    __syncthreads();
}

__device__ __forceinline__ void p5_rwkv_post(const Params& P, LAS unsigned char* lds) {
    const bf16* PRE = (const bf16*)(P.ws + WS_PRE); const bf16* EA = (const bf16*)((unsigned char*)P.out + DO_EA);
    const bf16* YF = (const bf16*)((unsigned char*)P.out + DO_YF); const bf16* YB = (const bf16*)(P.ws + WS_YB); bf16* YC = (bf16*)(P.ws + WS_YCAT);
    const float* mu = P.in[10];
    const int gt = blockIdx.x * NTHREADS + pg8::mk_tid(lds), NGT = gridDim.x * NTHREADS;
    for (int idx = gt; idx < M_TOK * 96; idx += NGT) {
        const int m = idx / 96, he = idx - m * 96, ch0 = he * 8, t = m & (SEQ - 1);
        const bf16* p = PRE + (size_t)m * NPRE + C_RS + ch0;
        const v4u z4 = (v4u){0u, 0u, 0u, 0u};
        const bool hp = t > 0, hn = t < SEQ - 1;
        const v4u rc = *(const v4u*)(p), kc = *(const v4u*)(p + 768), vc = *(const v4u*)(p + 1536);
        const v4u rp = hp ? *(const v4u*)(p - NPRE) : z4, kp = hp ? *(const v4u*)(p - NPRE + 768) : z4, vp = hp ? *(const v4u*)(p - NPRE + 1536) : z4;
        const v4u rn = hn ? *(const v4u*)(p + NPRE) : z4, kn = hn ? *(const v4u*)(p + NPRE + 768) : z4, vn = hn ? *(const v4u*)(p + NPRE + 1536) : z4;
        const v4u af8 = *(const v4u*)(EA + (size_t)m * NLORA + 1536 + ch0), ab8 = *(const v4u*)(EA + (size_t)m * NLORA + 2304 + ch0);
        const v4u yf8 = *(const v4u*)(YF + (size_t)m * RW + ch0), yb8 = *(const v4u*)(YB + (size_t)m * RW + ch0);
        const v4u rg8 = *(const v4u*)(PRE + (size_t)m * NPRE + C_RG + ch0);
        float r[8], k[8], v[8], x0[8], x1[8], x2[8];
        unpack8(rc, x0); unpack8(rp, x1); unpack8(rn, x2);
#pragma unroll
        for (int i = 0; i < 8; ++i) r[i] = x0[i] + mu[ch0 + i] * (0.5f * (x1[i] + x2[i]) - x0[i]);
        unpack8(kc, x0); unpack8(kp, x1); unpack8(kn, x2);
#pragma unroll
        for (int i = 0; i < 8; ++i) k[i] = x0[i] + mu[768 + ch0 + i] * (0.5f * (x1[i] + x2[i]) - x0[i]);
        unpack8(vc, x0); unpack8(vp, x1); unpack8(vn, x2);
#pragma unroll
        for (int i = 0; i < 8; ++i) v[i] = x0[i] + mu[1536 + ch0 + i] * (0.5f * (x1[i] + x2[i]) - x0[i]);
        float af[8], ab[8], ys[8], yb[8], rg[8]; unpack8(af8, af); unpack8(ab8, ab); unpack8(yf8, ys); unpack8(yb8, yb); unpack8(rg8, rg);
        float bs = 0.f, sm = 0.f;
#pragma unroll
        for (int i = 0; i < 8; ++i) { const float kds = k[i] * (2.f + (af[i] + ab[i] - 2.f) * P.in[12][ch0 + i]); bs += r[i] * kds * P.in[13][ch0 + i]; ys[i] += yb[i]; sm += ys[i]; }
        bs = red8(bs); sm = red8(sm);
        const float mean = sm * (1.f / 64.f);
        float vs = 0.f;
#pragma unroll
        for (int i = 0; i < 8; ++i) { ys[i] -= mean; vs += ys[i] * ys[i]; }
        vs = red8(vs);
        const float rstd = 1.f / sqrtf(vs * (1.f / 64.f) + GN_EPS);
        float o[8];
#pragma unroll
        for (int i = 0; i < 8; ++i) o[i] = (ys[i] * rstd * P.in[18][ch0 + i] + P.in[19][ch0 + i] + bs * v[i]) * rg[i];
        v4u w; w.x = pk2(o[0], o[1]); w.y = pk2(o[2], o[3]); w.z = pk2(o[4], o[5]); w.w = pk2(o[6], o[7]);
        *(v4u*)(YC + (size_t)m * DM + 768 + ch0) = w;
    }
}


constexpr size_t WS_XBAR = 504 * MiB + 832 * 1024;
#define XB_TMO      128
#define XB_XCNT(j)  (256  + 64 * (j))
#define XB_XSUB(j)  (1280 + 64 * (j))
#define XB_XGEN(j)  (2304 + 64 * (j))
#define XB_TOP      3328
#define XB_TOPGEN   3392
#define XCD_BAR_WORDS 3456
#define XB_SPIN_CAP (1u << 18)
__device__ __forceinline__ unsigned xb_ld(unsigned* p)              { return __hip_atomic_load(p, __ATOMIC_RELAXED, __HIP_MEMORY_SCOPE_AGENT); }
__device__ __forceinline__ unsigned xb_add(unsigned* p, unsigned v) { return __hip_atomic_fetch_add(p, v, __ATOMIC_RELAXED, __HIP_MEMORY_SCOPE_AGENT); }
__device__ __forceinline__ unsigned xb_xcc_id() { return (unsigned)__builtin_amdgcn_s_getreg((3 << 11) | 20) & 0xFu; }
#define XB_SPIN(cond, bar) do { unsigned _sp = 0; while (cond) { __builtin_amdgcn_s_sleep(1); \
    if ((++_sp & 255u) == 0u) { if (xb_ld(&(bar)[XB_TMO])) break; if (_sp > XB_SPIN_CAP) { atomicAdd(&(bar)[XB_TMO], 1u); break; } } } } while (0)
__device__ __forceinline__ void xcd_barrier_complete(unsigned* bar, unsigned x, unsigned& nloc, unsigned& nx) {
    const unsigned G = gridDim.x * gridDim.y * gridDim.z;
    unsigned sum, cnt, mine, sp = 0u;
    for (;;) {
        sum = 0u; cnt = 0u; mine = 0u;
#pragma unroll
        for (unsigned j = 0; j < 16; ++j) { const unsigned c = xb_ld(&bar[XB_XCNT(j)]); sum += c; cnt += (c > 0u) ? 1u : 0u; mine = (j == x) ? c : mine; }
        if (sum == G) break;
        __builtin_amdgcn_s_sleep(1);
        if ((++sp & 255u) == 0u) { if (xb_ld(&bar[XB_TMO])) break; if (sp > XB_SPIN_CAP) { atomicAdd(&bar[XB_TMO], 1u); break; } }
    }
    nloc = mine > 0u ? mine : 1u; nx = cnt > 0u ? cnt : 1u;
}
__device__ __forceinline__ void xcd_barrier(unsigned* bar, volatile LAS unsigned* st, LAS unsigned char* lds) {
    asm volatile("s_waitcnt vmcnt(0)" ::: "memory");
    __syncthreads();
    if (pg8::mk_tid(lds) == 0) {
        const unsigned x = xb_xcc_id();
        __builtin_amdgcn_s_waitcnt(0);
        unsigned nloc = st[0], nx = st[1];
        if (nloc == 0u) { xcd_barrier_complete(bar, x, nloc, nx); st[0] = nloc; st[1] = nx; }
        const unsigned old = xb_add(&bar[XB_XSUB(x)], 1u);
        const unsigned gen = old / nloc;
        if (old + 1u == (gen + 1u) * nloc) {
            __builtin_amdgcn_fence(__ATOMIC_RELEASE, "agent");
            asm volatile("s_waitcnt vmcnt(0)" ::: "memory");
            const unsigned og = xb_add(&bar[XB_TOP], 1u);
            const unsigned tg = og / nx;
            if (og + 1u == (tg + 1u) * nx) xb_add(&bar[XB_TOPGEN], 1u);
            else XB_SPIN(xb_ld(&bar[XB_TOPGEN]) == tg, bar);
            __builtin_amdgcn_fence(__ATOMIC_ACQUIRE, "agent");
            xb_add(&bar[XB_XGEN(x)], 1u);
            asm volatile("s_waitcnt vmcnt(0)" ::: "memory");
        } else {
            XB_SPIN(xb_ld(&bar[XB_XGEN(x)]) == gen, bar);
            __builtin_amdgcn_fence(__ATOMIC_ACQUIRE, "agent");
            asm volatile("s_waitcnt vmcnt(0)" ::: "memory");
        }
    }
    __syncthreads();
}

constexpr int N_PHASES = 8;
__global__ void __launch_bounds__(NTHREADS, 2) hybrid_fwd(Params P) {
    extern __shared__ __attribute__((aligned(16))) unsigned char lds_raw[];
    LAS unsigned char* lds = (LAS unsigned char*)lds_raw;
    cg::grid_group grid = cg::this_grid();
    const int lo = P.ph_lo, hi = P.ph_hi, G = gridDim.x;
    if ((threadIdx.x & 63) == 0) *(volatile LAS int*)(lds + pg8::TIDTAB_OFF + 4 * pg8::hw_slot()) = (int)(threadIdx.x >> 6);
    volatile LAS unsigned* xbst = (volatile LAS unsigned*)(lds + pg8::TIDTAB_OFF - 128);
    unsigned* xbar = (unsigned*)(P.ws + WS_XBAR);
    if (threadIdx.x == 0) { xbst[0] = 0u; xbst[1] = 0u; (void)xb_add(&xbar[XB_XCNT(xb_xcc_id())], 1u); }
    __syncthreads();
    unsigned char* ws = P.ws; unsigned char* dob = (unsigned char*)P.out;
#ifdef PHMASK
#define IN(k) (((PHMASK >> (k)) & 1) && lo <= (k) && (k) < hi)
#else
#define IN(k) (lo <= (k) && (k) < hi)
#endif
#define SEAM(k) do { if (IN(k) && IN((k) + 1)) { if ((k) == 0) grid.sync(); else xcd_barrier(xbar, xbst, lds); } } while (0)
#ifndef REPEAT_MASK
#define REPEAT_MASK 0
#endif
#define REP(k) for (int rep_ = 0; rep_ < (((REPEAT_MASK >> (k)) & 1) ? 2 : 1); ++rep_)
#define REPSYNC() do { if (rep_) grid.sync(); } while (0)
    if (IN(0)) REP(0) { REPSYNC(); p0_prologue(P, lds, P.out); __syncthreads(); }
    SEAM(0);
    if (IN(1)) REP(1) { REPSYNC();
        { pg8::Gemm g{(const bf16*)(dob + DO_H), (const bf16*)(dob + DO_WIN), M_TOK, NIN, DM}; pg8::StaticOrder S; S.init(M_TOK, NIN, G, (int)blockIdx.x);
          EpiProj E{(bf16*)(ws + WS_PRE), (bf16*)(ws + WS_GATES), P.in[5]};
          pg8::gemm_phase<EpiProj, pg8::StaticOrder, true, true>(lds, g, S, E); }
        { pg8::Gemm g{(const bf16*)(ws + WS_MEMN), (const bf16*)(ws + WS_WXKV), MEMROWS, 1024, DM}; pg8::StaticOrder S; S.init(MEMROWS, 1024, G, (int)((blockIdx.x + G - 64) % G));
          EpiPlain E{(bf16*)(ws + WS_MKV), 1024};
          pg8::gemm_phase<EpiPlain, pg8::StaticOrder, true, true>(lds, g, S, E); }
    }
    SEAM(1);
    if (IN(2)) REP(2) { REPSYNC(); p2_lora_in(P, lds); }
    SEAM(2);
    if (IN(3)) REP(3) { REPSYNC();
        int klora = 256; asm volatile("" : "+s"(klora));
        pg8::Gemm g{(const bf16*)(dob + DO_LIN), (const bf16*)(ws + WS_LORAB), M_TOK, NLORA, klora}; pg8::StaticOrder S; S.init(M_TOK, NLORA, G, (int)blockIdx.x);
        EpiLora E{(bf16*)(dob + DO_EA), P.in[14], P.in[16]};
        pg8::gemm_phase<EpiLora, pg8::StaticOrder, true, true>(lds, g, S, E);
    }
    SEAM(3);
    if (IN(4)) REP(4) { REPSYNC();
        const int bid = blockIdx.x;
#ifndef STATIC_ATT
#define STATIC_ATT 0
#endif
#ifndef SCAN2
#define SCAN2 1
#endif
        if (bid < 192) scan_chunked(P, bid, lds);
        if (STATIC_ATT) {
            if (bid >= 192) { for (int it = bid - 192; it < 768; it += G - 192) { if (it < 512) attnA_item(P, it, lds); else attnC_item(P, it - 512, lds); } }
        } else {
            volatile LAS int* slot = (volatile LAS int*)(lds + pg8::TIDTAB_OFF - 64);
            const int tid4 = pg8::mk_tid(lds);
            for (;;) {
                if (tid4 == 0) *slot = (int)__hip_atomic_fetch_add((unsigned*)(ws + WS_CTR), 1u, __ATOMIC_RELAXED, __HIP_MEMORY_SCOPE_AGENT);
                __syncthreads();
                const int it = *slot;
                __syncthreads();
                if (it >= 768) break;
                if (it < 512) attnA_item(P, it, lds); else attnC_item(P, it - 512, lds);
            }
        }
    }
    SEAM(4);
    if (IN(5)) REP(5) { REPSYNC(); p5_rwkv_post(P, lds); }
    SEAM(5);
    if (IN(6)) REP(6) { REPSYNC();
        pg8::Gemm g{(const bf16*)(ws + WS_YCAT), (const bf16*)(ws + WS_WCAT), M_TOK, DM, DM}; pg8::StaticOrder S; S.init(M_TOK, DM, G, (int)blockIdx.x);
        EpiMerged E{(bf16*)(ws + WS_MERGED), (const bf16*)(ws + WS_GATES)};
        pg8::gemm_phase<EpiMerged, pg8::StaticOrder, true, true>(lds, g, S, E);
    }
    SEAM(6);
    if (IN(7)) REP(7) { REPSYNC();
        pg8::Gemm g{(const bf16*)(ws + WS_MERGED), (const bf16*)(ws + WS_WOUT), M_TOK, DM, DM}; pg8::StaticOrder S; S.init(M_TOK, DM, G, (int)blockIdx.x);
        EpiOut E{P.out, P.in[0]};
        pg8::gemm_phase<EpiOut, pg8::StaticOrder, true, true>(lds, g, S, E);
    }
#undef IN
#undef SEAM
}

#ifndef ONE_LAUNCH
#define ONE_LAUNCH 1
#endif
extern "C" void kernel_launch(void* const* d_in, const int* in_sizes, int n_in, void* d_out, int out_size, void* d_ws, size_t ws_size, hipStream_t stream) {
    static int grid = 0;
    if (grid == 0) {
        if (n_in != 26 || out_size != M_TOK * DM || ws_size < WS_END) { fprintf(stderr, "kernel_launch: unexpected shapes (n_in %d, out %d, ws %zu); nothing launched\n", n_in, out_size, ws_size); grid = -1; return; }
        int dev = 0, cus = 0, per_cu = 0;
        hipGetDevice(&dev); hipDeviceGetAttribute(&cus, hipDeviceAttributeMultiprocessorCount, dev);
        if (hipFuncSetAttribute((const void*)hybrid_fwd, hipFuncAttributeMaxDynamicSharedMemorySize, LDS_BYTES) != hipSuccess) { fprintf(stderr, "kernel_launch: hipFuncSetAttribute failed\n"); grid = -1; return; }
        hipOccupancyMaxActiveBlocksPerMultiprocessor(&per_cu, (const void*)hybrid_fwd, NTHREADS, LDS_BYTES);
        (void)hipGetLastError();
        if (per_cu < 1) per_cu = 1;
        grid = cus * per_cu; if (grid > 256) grid = 256;
        if (grid < 200) { fprintf(stderr, "kernel_launch: grid %d too small for the scan/attention split\n", grid); grid = -1; return; }
    }
    if (grid < 0) return;
    Params p{};
    for (int i = 0; i < 26; ++i) p.in[i] = (const float*)d_in[i];
    p.out = (float*)d_out; p.ws = (unsigned char*)d_ws;
#if ONE_LAUNCH
    (void)hipMemsetAsync((unsigned char*)d_ws + WS_XBAR, 0, XCD_BAR_WORDS * 4, stream);
    p.ph_lo = 0; p.ph_hi = N_PHASES;
    void* args[] = {&p};
    hipError_t e = hipLaunchCooperativeKernel((const void*)hybrid_fwd, dim3(grid), dim3(NTHREADS), args, LDS_BYTES, stream);
    if (e != hipSuccess) fprintf(stderr, "cooperative launch failed: %s (grid %d)\n", hipGetErrorString(e), grid);
#else
    for (int ph = 0; ph < N_PHASES; ++ph) {
        p.ph_lo = ph; p.ph_hi = ph + 1;
        hipLaunchKernelGGL(hybrid_fwd, dim3(grid), dim3(NTHREADS), LDS_BYTES, stream, p);
    }
#endif
}
```

```cpp
#include <hip/hip_runtime.h>
#include <hip/hip_cooperative_groups.h>
#include <cstdio>
#include <cstdint>
namespace cg = cooperative_groups;
namespace pg8 {
#define PG8_LAS __attribute__((address_space(3)))
typedef unsigned short bf16_t;
typedef short bf16x8 __attribute__((ext_vector_type(8)));
typedef float f32x4 __attribute__((ext_vector_type(4)));
typedef unsigned u32x4 __attribute__((ext_vector_type(4)));
constexpr int BM = 256, BK = 64, HALF = 128, HTB = HALF * BK * 2  , STAGE_BYTES = 8 * HTB, NXCD = 8, WGM = 8;

__host__ __device__ __forceinline__ int lds_byte(int r, int c) { const int st = (r >> 4) * 2 + (c >> 5), rr = r & 15, cc = c & 31, ob = rr * 64 + cc * 2; return st * 1024 + (ob ^ (((ob >> 9) & 1) << 5)); }
__host__ __device__ __forceinline__ void stage_rc(int b, int& R, int& C) { const int st = b / 1024, sb = b % 1024, swz = sb ^ (((sb >> 9) & 1) << 5); R = (st >> 1) * 16 + swz / 64; C = (st & 1) * 32 + (swz % 64) / 2; }
__host__ __device__ __forceinline__ int perm32(int rho) { const int n = rho >> 4, i = rho & 15; return 8 * (i >> 2) + 4 * n + (i & 3); }


constexpr int TIDTAB_OFF = 147200;
__device__ __forceinline__ int hw_slot() { return (int)(__builtin_amdgcn_s_getreg((5 << 11) | 4) & 63u); }
__device__ __forceinline__ int mk_tid(PG8_LAS unsigned char* lds) {
    const int lane = (int)__builtin_amdgcn_mbcnt_hi(~0u, __builtin_amdgcn_mbcnt_lo(~0u, 0u));
    const int w = __builtin_amdgcn_readfirstlane(*(volatile PG8_LAS int*)(lds + TIDTAB_OFF + 4 * hw_slot()));
    return w * 64 + lane;
}
struct Unit { int pm, pn; };
struct Gemm { const bf16_t* A; const bf16_t* Bt; int M, N, K; };

struct StaticOrder {
    int nM, nN, nwg, G, c;
    __host__ __device__ void init(int M, int N, int G_, int c_) { nM = M / BM; nN = N / BM; nwg = nM * nN; G = G_; c = c_; }
    __host__ __device__ bool next(int i, Unit& u) const {
        const long L = (long)i * G + c; if (L >= nwg) return false;
        int wgid = (int)L; { const int q = nwg / NXCD, r = nwg % NXCD, xcd = wgid % NXCD, off = wgid / NXCD; wgid = (xcd < r ? xcd * (q + 1) : r * (q + 1) + (xcd - r) * q) + off; }
        const int nig = WGM * nN, gid = wgid / nig, fm = gid * WGM, gsz = (nM - fm) < WGM ? (nM - fm) : WGM;
        u.pm = fm + ((wgid % nig) % gsz); u.pn = (wgid % nig) / gsz; return true;
    }
    __device__ __forceinline__ void a_ready(const Unit&) const {}
    __device__ __forceinline__ void done(const Unit&) const {}
};

__device__ __forceinline__ unsigned cvt_pk_bf16(float lo, float hi) { unsigned r; asm volatile("v_cvt_pk_bf16_f32 %0, %1, %2" : "=v"(r) : "v"(lo), "v"(hi)); return r; }
template <class Epi, class Sched, bool ALIGN_EPI = false, bool SP2 = false>
__device__ __forceinline__ void gemm_phase(PG8_LAS unsigned char* lds, const Gemm g, const Sched& S, const Epi& E) {
    const int tid = mk_tid(lds), wid = __builtin_amdgcn_readfirstlane(tid >> 6), lane = tid & 63, wr = wid >> 2, wc = wid & 3, fr = lane & 15, fq = lane >> 4;
    const int K = g.K, nt = K / BK;
    unsigned voffA[2], voffB[2];
#pragma unroll
    for (int i = 0; i < 2; ++i) { int R, C; stage_rc(tid * 16 + i * 8192, R, C); const int Rb = Epi::PERM ? ((R & ~31) + perm32(R & 31)) : R;
        voffA[i] = (unsigned)(R * K + C) * 2u; voffB[i] = (unsigned)(Rb * K + C) * 2u; }
    const size_t kstep = (size_t)(BK * 2);
    const size_t hstep = (size_t)HALF * K * 2;
    const size_t tstep = 2 * hstep;
    const unsigned ldsw = (unsigned)wid * 1024u;
    const int aoff = lds_byte(wr * 64 + fr, fq * 8), boff = lds_byte(wc * 32 + fr, fq * 8);
#define PG8_SA(b, h) (((b) * 2 + (h)) * HTB)
#define PG8_SB(b, h) ((4 + (b) * 2 + (h)) * HTB)
#define PG8_STAGE(bufoff, gbase, voff) do { _Pragma("unroll") for (int _i = 0; _i < 2; ++_i) \
        __builtin_amdgcn_global_load_lds((const unsigned*)((const char*)(gbase) + (voff)[_i]), (PG8_LAS unsigned*)(lds + (bufoff) + ldsw + _i * 8192), 16, 0, 0); } while (0)
#define PG8_LDA(dst, b, h) do { _Pragma("unroll") for (int m = 0; m < 4; ++m) _Pragma("unroll") for (int k = 0; k < 2; ++k) dst[m][k] = *(const PG8_LAS bf16x8*)(lds + PG8_SA(b, h) + aoff + m * 2048 + k * 1024); } while (0)
#define PG8_LDB(dst, b, h) do { _Pragma("unroll") for (int n = 0; n < 2; ++n) _Pragma("unroll") for (int k = 0; k < 2; ++k) dst[n][k] = *(const PG8_LAS bf16x8*)(lds + PG8_SB(b, h) + boff + n * 2048 + k * 1024); } while (0)
#define PG8_MMA(ai, bj, At, Bt) do { __builtin_amdgcn_s_setprio(1); _Pragma("unroll") for (int m = 0; m < 4; ++m) _Pragma("unroll") for (int n = 0; n < 2; ++n) _Pragma("unroll") for (int k = 0; k < 2; ++k) \
        acc[ai][bj][m][n] = __builtin_amdgcn_mfma_f32_16x16x32_bf16(Bt[n][k], At[m][k], acc[ai][bj][m][n], 0, 0, 0); __builtin_amdgcn_s_setprio(0); } while (0)
#define PG8_WAIT_V(n) asm volatile("s_waitcnt vmcnt(" #n ")" ::: "memory")
#define PG8_WAIT_L(n) asm volatile("s_waitcnt lgkmcnt(" #n ")" ::: "memory")
#define PG8_BAR __builtin_amdgcn_s_barrier()
#define PG8_SCHED __builtin_amdgcn_sched_barrier(0)
    Unit cur, nxt; int ui = 0;
    if (!S.next(0, cur)) return;
    f32x4 acc[2][2][4][2];
#pragma unroll
    for (int a = 0; a < 2; ++a)
#pragma unroll
        for (int b = 0; b < 2; ++b)
#pragma unroll
            for (int m = 0; m < 4; ++m)
#pragma unroll
                for (int n = 0; n < 2; ++n) acc[a][b][m][n] = (f32x4){0.f, 0.f, 0.f, 0.f};
    bf16x8 At[4][2], B0[2][2], B1[2][2];
    const char* cA = (const char*)g.A + (size_t)cur.pm * tstep; const char* cB = (const char*)g.Bt + (size_t)cur.pn * tstep;
    S.a_ready(cur);
    if constexpr (SP2) {
        PG8_STAGE(PG8_SB(0, 0), cB, voffB); PG8_STAGE(PG8_SB(0, 1), cB + hstep, voffB); PG8_STAGE(PG8_SA(0, 0), cA, voffA); PG8_STAGE(PG8_SA(0, 1), cA + hstep, voffA);
        if (wr == 1) PG8_BAR;
        PG8_WAIT_V(2); PG8_BAR;
        PG8_STAGE(PG8_SB(1, 0), cB + kstep, voffB); PG8_STAGE(PG8_SA(1, 0), cA + kstep, voffA); PG8_STAGE(PG8_SB(1, 1), cB + hstep + kstep, voffB);
        PG8_WAIT_V(6); PG8_BAR;
    } else {
        PG8_STAGE(PG8_SB(0, 0), cB, voffB); PG8_STAGE(PG8_SA(0, 0), cA, voffA); PG8_STAGE(PG8_SB(0, 1), cB + hstep, voffB); PG8_STAGE(PG8_SA(0, 1), cA + hstep, voffA);
        if (wr == 1) PG8_BAR;
        PG8_WAIT_V(4); PG8_BAR;
        PG8_STAGE(PG8_SB(1, 0), cB + kstep, voffB); PG8_STAGE(PG8_SA(1, 0), cA + kstep, voffA); PG8_STAGE(PG8_SB(1, 1), cB + hstep + kstep, voffB);
        PG8_WAIT_V(6); PG8_BAR;
    }
    for (;;) {
        const bool has_next = S.next(ui + 1, nxt);
        const char* nA = has_next ? (const char*)g.A + (size_t)nxt.pm * tstep : cA; const char* nB = has_next ? (const char*)g.Bt + (size_t)nxt.pn * tstep : cB;
        for (int t = 0; t < nt; t += 2) {
            if constexpr (Epi::KHOOK) { if (t == Epi::HK0 || t == Epi::HK1) E.khook(acc, cur, t, wr, wc, fr, fq); }
            const bool last = (t == nt - 2);
            const char* a1 = cA + (size_t)(t + 1) * kstep;
            const char* a2 = last ? nA : cA + (size_t)(t + 2) * kstep; const char* b2 = last ? nB : cB + (size_t)(t + 2) * kstep;
            const char* a3 = a2 + kstep; const char* b3 = b2 + kstep;
            if (last && has_next) S.a_ready(nxt);
            if constexpr (SP2) {
            PG8_LDB(B0, 0, 0); PG8_LDB(B1, 0, 1); PG8_SCHED; PG8_LDA(At, 0, 0); PG8_STAGE(PG8_SA(1, 1), a1 + hstep, voffA);
            PG8_WAIT_V(8); PG8_WAIT_L(0); PG8_BAR; PG8_MMA(0, 0, At, B0); PG8_MMA(0, 1, At, B1); PG8_BAR; PG8_SCHED;
            PG8_LDA(At, 0, 1); PG8_STAGE(PG8_SB(0, 0), b2, voffB); PG8_STAGE(PG8_SB(0, 1), b2 + hstep, voffB); PG8_STAGE(PG8_SA(0, 0), a2, voffA);
            PG8_WAIT_V(8); PG8_WAIT_L(0); PG8_BAR; PG8_MMA(1, 0, At, B0); PG8_MMA(1, 1, At, B1); PG8_BAR; PG8_SCHED;
            PG8_LDB(B0, 1, 0); PG8_LDB(B1, 1, 1); PG8_SCHED; PG8_LDA(At, 1, 0); PG8_STAGE(PG8_SA(0, 1), a2 + hstep, voffA);
            PG8_WAIT_V(8); PG8_WAIT_L(0); PG8_BAR; PG8_MMA(0, 0, At, B0); PG8_MMA(0, 1, At, B1); PG8_BAR; PG8_SCHED;
            PG8_LDA(At, 1, 1); PG8_STAGE(PG8_SB(1, 0), b3, voffB); PG8_STAGE(PG8_SB(1, 1), b3 + hstep, voffB); PG8_STAGE(PG8_SA(1, 0), a3, voffA);
            PG8_WAIT_V(8); PG8_WAIT_L(0); PG8_BAR; PG8_MMA(1, 0, At, B0); PG8_MMA(1, 1, At, B1); PG8_BAR; PG8_SCHED;
            } else {
            PG8_LDB(B0, 0, 0); PG8_SCHED; PG8_LDA(At, 0, 0); PG8_STAGE(PG8_SA(1, 1), a1 + hstep, voffA);
            PG8_WAIT_L(8); PG8_BAR; PG8_WAIT_L(0); PG8_MMA(0, 0, At, B0); PG8_BAR; PG8_SCHED;
            PG8_LDB(B1, 0, 1); PG8_STAGE(PG8_SB(0, 0), b2, voffB);
            PG8_BAR; PG8_WAIT_L(0); PG8_MMA(0, 1, At, B1); PG8_BAR;
            PG8_LDA(At, 0, 1); PG8_STAGE(PG8_SA(0, 0), a2, voffA);
            PG8_BAR; PG8_WAIT_L(0); PG8_MMA(1, 0, At, B0); PG8_BAR; PG8_SCHED;
            PG8_STAGE(PG8_SB(0, 1), b2 + hstep, voffB);
            PG8_WAIT_V(6); PG8_BAR; PG8_MMA(1, 1, At, B1); PG8_BAR;
            PG8_LDB(B0, 1, 0); PG8_SCHED; PG8_LDA(At, 1, 0); PG8_STAGE(PG8_SA(0, 1), a2 + hstep, voffA);
            PG8_WAIT_L(8); PG8_BAR; PG8_WAIT_L(0); PG8_MMA(0, 0, At, B0); PG8_BAR; PG8_SCHED;
            PG8_LDB(B1, 1, 1); PG8_STAGE(PG8_SB(1, 0), b3, voffB);
            PG8_BAR; PG8_WAIT_L(0); PG8_MMA(0, 1, At, B1); PG8_BAR;
            PG8_LDA(At, 1, 1); PG8_STAGE(PG8_SA(1, 0), a3, voffA);
            PG8_BAR; PG8_WAIT_L(0); PG8_MMA(1, 0, At, B0); PG8_BAR; PG8_SCHED;
            PG8_STAGE(PG8_SB(1, 1), b3 + hstep, voffB);
            PG8_WAIT_V(6); PG8_BAR; PG8_MMA(1, 1, At, B1); PG8_BAR;
            }
        }
        if constexpr (ALIGN_EPI) { if (wr == 0) PG8_BAR; }
        if constexpr (!Epi::AFTER_DRAIN) { E(acc, cur, wr, wc, fr, fq); S.done(cur); }
        if (!has_next) break;
#pragma unroll
        for (int a = 0; a < 2; ++a)
#pragma unroll
            for (int b = 0; b < 2; ++b)
#pragma unroll
                for (int m = 0; m < 4; ++m)
#pragma unroll
                    for (int n = 0; n < 2; ++n) acc[a][b][m][n] = (f32x4){0.f, 0.f, 0.f, 0.f};
        cur = nxt; cA = nA; cB = nB; ++ui;
        if constexpr (ALIGN_EPI) { if (wr == 1) PG8_BAR; }
    }
    PG8_WAIT_V(0);
    if constexpr (!ALIGN_EPI) { if (wr == 0) PG8_BAR; }
    PG8_BAR;
    if constexpr (Epi::AFTER_DRAIN) { E.fused(acc, cur, wr, wc, fr, fq, lds, wid, lane); S.done(cur); }
#undef PG8_SA
#undef PG8_SB
#undef PG8_STAGE
#undef PG8_LDA
#undef PG8_LDB
#undef PG8_MMA
#undef PG8_WAIT_V
#undef PG8_WAIT_L
#undef PG8_BAR
#undef PG8_SCHED
}
}

#define GAS __attribute__((address_space(1)))
#define LAS __attribute__((address_space(3)))
typedef unsigned short bf16;
typedef unsigned v4u __attribute__((ext_vector_type(4)));
typedef unsigned v2u __attribute__((ext_vector_type(2)));
typedef float f32x4 __attribute__((ext_vector_type(4)));
typedef float f32x2 __attribute__((ext_vector_type(2)));
typedef short bf16x8 __attribute__((ext_vector_type(8)));
typedef short s16x4 __attribute__((ext_vector_type(4)));

constexpr int NWAVES = 8, NTHREADS = 512;
constexpr int BATCH = 8, SEQ = 2048, DM = 2048, M_TOK = BATCH * SEQ;
constexpr int NPRE = 6400, NGATE = 6144, NIN = NPRE + NGATE;
constexpr int C_AQ = 0, C_AK = 768, C_AV = 1024, C_AG = 1280, C_RS = 2048, C_RR = 2048, C_RK = 2816, C_RV = 3584, C_LORA = 4352, C_RG = 4608, C_XQ = 5376, C_XG = 5888;
constexpr int NMEM = 256, MEMROWS = BATCH * NMEM;
constexpr int RW = 768, NLORA = 3072;
constexpr float NORM_EPS = 1e-6f, GN_EPS = 64e-5f;
constexpr int LDS_BYTES = 147456;

constexpr size_t MiB = 1u << 20;
constexpr size_t WS_PRE = 0, WS_MERGED = 0, WS_GATES = 200 * MiB, WS_YCAT = 392 * MiB;
constexpr size_t WS_WCAT = 456 * MiB, WS_WOUT = 464 * MiB, WS_WXKV = 472 * MiB, WS_MKV = 476 * MiB, WS_MEMN = 480 * MiB, WS_YB = 480 * MiB;
constexpr size_t WS_ROPE = 504 * MiB, WS_LORAB = 505 * MiB, WS_END = 512 * MiB;
constexpr size_t WS_CTR = 504 * MiB + 768 * 1024;
constexpr size_t DO_H = 0, DO_WIN = 64 * MiB, DO_EA = 0, DO_LIN = 96 * MiB, DO_YF = 104 * MiB;

struct Params { const float* in[26]; float* out; unsigned char* ws; int ph_lo, ph_hi; };

__device__ __forceinline__ float bf_lo(unsigned w) { return __builtin_bit_cast(float, w << 16); }
__device__ __forceinline__ float bf_hi(unsigned w) { return __builtin_bit_cast(float, w & 0xffff0000u); }
__device__ __forceinline__ float bf1(bf16 h) { return __builtin_bit_cast(float, (unsigned)h << 16); }
__device__ __forceinline__ unsigned f2bf(float f) { unsigned u = __builtin_bit_cast(unsigned, f); return (u + 0x7fffu + ((u >> 16) & 1u)) >> 16; }
typedef __bf16 bf16x2_t __attribute__((ext_vector_type(2)));
__device__ __forceinline__ unsigned pk2(float lo, float hi) { const f32x2 v = {lo, hi}; const bf16x2_t b = __builtin_convertvector(v, bf16x2_t); return __builtin_bit_cast(unsigned, b); }
__device__ __forceinline__ float sigmoidf_(float z) { return __builtin_amdgcn_rcpf(1.f + __expf(-z)); }
__device__ __forceinline__ float siluf_(float z) { return z * sigmoidf_(z); }
__device__ __forceinline__ void unpack8(v4u w, float (&x)[8]) { x[0] = bf_lo(w.x); x[1] = bf_hi(w.x); x[2] = bf_lo(w.y); x[3] = bf_hi(w.y); x[4] = bf_lo(w.z); x[5] = bf_hi(w.z); x[6] = bf_lo(w.w); x[7] = bf_hi(w.w); }
__device__ __forceinline__ void unpack4(v2u w, float (&x)[4]) { x[0] = bf_lo(w.x); x[1] = bf_hi(w.x); x[2] = bf_lo(w.y); x[3] = bf_hi(w.y); }
__device__ __forceinline__ float fma_s(float a, float b, float c) { float r; asm("v_fma_f32 %0, %1, %2, %3" : "=v"(r) : "v"(a), "v"(b), "v"(c)); return r; }
__device__ __forceinline__ float mul_s(float a, float b) { float r; asm("v_mul_f32_e32 %0, %1, %2" : "=v"(r) : "v"(a), "v"(b)); return r; }
__device__ __forceinline__ float add_s(float a, float b) { float r; asm("v_add_f32_e32 %0, %1, %2" : "=v"(r) : "v"(a), "v"(b)); return r; }
template <int CTRL> __device__ __forceinline__ float dpp_add(float v) { return v + __builtin_bit_cast(float, __builtin_amdgcn_update_dpp(0, __builtin_bit_cast(int, v), CTRL, 0xF, 0xF, true)); }
__device__ __forceinline__ float red8(float v) { v = dpp_add<0xB1>(v); v = dpp_add<0x4E>(v); v = dpp_add<0x141>(v); return v; }

using pg8::Unit;
struct EpiProj {
    static constexpr bool PERM = true, AFTER_DRAIN = false, KHOOK = false; static constexpr int HK0 = -1, HK1 = -1;
    bf16* pre; bf16* gates; const float* gate_b;
    __device__ __forceinline__ void operator()(const f32x4 (&acc)[2][2][4][2], const Unit& u, int wr, int wc, int fr, int fq) const {
        int row0 = u.pm * 256 + wr * 64 + fr;
        asm volatile("" : "+v"(row0));
        const bool isg = u.pn >= 25;
        const int pn = isg ? u.pn - 25 : u.pn;
        bf16* base = isg ? gates : pre; const int ldc = isg ? NGATE : NPRE;
        const int act = isg ? 2 : (((pn >= 5 && pn <= 7) || (pn >= 18 && pn <= 20) || pn >= 23) ? 1 : 0);
        const int col0 = pn * 256 + wc * 32 + 8 * fq;
        f32x4 bv[2][2];
#pragma unroll
        for (int bj = 0; bj < 2; ++bj) { bv[bj][0] = isg ? *(const f32x4*)(gate_b + col0 + bj * 128) : (f32x4){0.f, 0.f, 0.f, 0.f}; bv[bj][1] = isg ? *(const f32x4*)(gate_b + col0 + bj * 128 + 4) : (f32x4){0.f, 0.f, 0.f, 0.f}; }
#pragma unroll
        for (int ai = 0; ai < 2; ++ai)
#pragma unroll
            for (int m = 0; m < 4; ++m) { bf16* rowp = base + (size_t)(row0 + ai * 128 + m * 16) * ldc + col0;
                __builtin_amdgcn_sched_barrier(0);
#pragma unroll
                for (int bj = 0; bj < 2; ++bj) { f32x4 v0 = acc[ai][bj][m][0] + bv[bj][0], v1 = acc[ai][bj][m][1] + bv[bj][1];
                    if (act == 1) {
#pragma unroll
                        for (int i = 0; i < 4; ++i) { v0[i] = siluf_(v0[i]); v1[i] = siluf_(v1[i]); }
                    } else if (act == 2) {
#pragma unroll
                        for (int i = 0; i < 4; ++i) { v0[i] = sigmoidf_(v0[i]); v1[i] = sigmoidf_(v1[i]); }
                    }
                    v4u w; w.x = pk2(v0[0], v0[1]); w.y = pk2(v0[2], v0[3]); w.z = pk2(v1[0], v1[1]); w.w = pk2(v1[2], v1[3]);
                    *(v4u*)(rowp + bj * 128) = w; } }
    }
};
struct EpiPlain {
    static constexpr bool PERM = true, AFTER_DRAIN = false, KHOOK = false; static constexpr int HK0 = -1, HK1 = -1;
    bf16* O; int ldc;
    __device__ __forceinline__ void operator()(const f32x4 (&acc)[2][2][4][2], const Unit& u, int wr, int wc, int fr, int fq) const {
        int row0 = u.pm * 256 + wr * 64 + fr, col0 = u.pn * 256 + wc * 32 + 8 * fq;
        asm volatile("" : "+v"(row0), "+v"(col0));
#pragma unroll
        for (int ai = 0; ai < 2; ++ai)
#pragma unroll
            for (int m = 0; m < 4; ++m) { bf16* rowp = O + (size_t)(row0 + ai * 128 + m * 16) * ldc + col0;
#pragma unroll
                for (int bj = 0; bj < 2; ++bj) { const f32x4 v0 = acc[ai][bj][m][0], v1 = acc[ai][bj][m][1];
                    v4u w; w.x = pk2(v0[0], v0[1]); w.y = pk2(v0[2], v0[3]); w.z = pk2(v1[0], v1[1]); w.w = pk2(v1[2], v1[3]);
                    *(v4u*)(rowp + bj * 128) = w; } }
    }
};
struct EpiLora {
    static constexpr bool PERM = true, AFTER_DRAIN = false, KHOOK = false; static constexpr int HK0 = -1, HK1 = -1;
    bf16* O; const float* w0; const float* a0;
    __device__ __forceinline__ void operator()(const f32x4 (&acc)[2][2][4][2], const Unit& u, int wr, int wc, int fr, int fq) const {
        int row0 = u.pm * 256 + wr * 64 + fr, col0 = u.pn * 256 + wc * 32 + 8 * fq;
        asm volatile("" : "+v"(row0), "+v"(col0));
        const bool isw = u.pn < 6; const float* bias = isw ? (w0 + col0) : (a0 + col0 - 1536); const float sc = isw ? 0.6065306597126334f : 1.f;
        f32x4 bv[2][2];
#pragma unroll
        for (int bj = 0; bj < 2; ++bj) { bv[bj][0] = *(const f32x4*)(bias + bj * 128); bv[bj][1] = *(const f32x4*)(bias + bj * 128 + 4); }
#pragma unroll
        for (int ai = 0; ai < 2; ++ai)
#pragma unroll
            for (int m = 0; m < 4; ++m) { bf16* rowp = O + (size_t)(row0 + ai * 128 + m * 16) * NLORA + col0;
                __builtin_amdgcn_sched_barrier(0);
#pragma unroll
                for (int bj = 0; bj < 2; ++bj) { f32x4 v0 = acc[ai][bj][m][0] + bv[bj][0], v1 = acc[ai][bj][m][1] + bv[bj][1];
#pragma unroll
                    for (int i = 0; i < 4; ++i) { v0[i] = sc * sigmoidf_(v0[i]); v1[i] = sc * sigmoidf_(v1[i]); }
                    v4u w; w.x = pk2(v0[0], v0[1]); w.y = pk2(v0[2], v0[3]); w.z = pk2(v1[0], v1[1]); w.w = pk2(v1[2], v1[3]);
                    *(v4u*)(rowp + bj * 128) = w; } }
    }
};
struct EpiMerged {
    static constexpr bool PERM = true, AFTER_DRAIN = false, KHOOK = true; static constexpr int HK0 = 12, HK1 = 24;
    bf16* O; const bf16* gates;
    __device__ __forceinline__ void khook(f32x4 (&acc)[2][2][4][2], const Unit& u, int t, int wr, int wc, int fr, int fq) const {
        int row0 = u.pm * 256 + wr * 64 + fr, col0 = u.pn * 256 + wc * 32 + 8 * fq;
        asm volatile("" : "+v"(row0), "+v"(col0));
        const int bo = (t == HK0) ? 0 : DM;
#pragma unroll
        for (int ai = 0; ai < 2; ++ai) {
            v4u ga[4][2], gb[4][2];
#pragma unroll
            for (int m = 0; m < 4; ++m) { const bf16* gp = gates + (size_t)(row0 + ai * 128 + m * 16) * NGATE + bo + col0;
#pragma unroll
                for (int bj = 0; bj < 2; ++bj) { ga[m][bj] = *(const v4u*)(gp + bj * 128); gb[m][bj] = *(const v4u*)(gp + DM + bj * 128); } }
#pragma unroll
            for (int m = 0; m < 4; ++m)
#pragma unroll
                for (int bj = 0; bj < 2; ++bj) { float x[8], y[8]; unpack8(ga[m][bj], x); unpack8(gb[m][bj], y);
#pragma unroll
                    for (int i = 0; i < 4; ++i) { acc[ai][bj][m][0][i] *= x[i] * __builtin_amdgcn_rcpf(y[i]); acc[ai][bj][m][1][i] *= x[4 + i] * __builtin_amdgcn_rcpf(y[4 + i]); } }
            __builtin_amdgcn_sched_barrier(0);
        }
    }
    __device__ __forceinline__ void operator()(const f32x4 (&acc)[2][2][4][2], const Unit& u, int wr, int wc, int fr, int fq) const {
        int row0 = u.pm * 256 + wr * 64 + fr, col0 = u.pn * 256 + wc * 32 + 8 * fq;
        asm volatile("" : "+v"(row0), "+v"(col0));
#pragma unroll
        for (int ai = 0; ai < 2; ++ai) {
            v4u gg[4][2];
#pragma unroll
            for (int m = 0; m < 4; ++m)
#pragma unroll
                for (int bj = 0; bj < 2; ++bj) gg[m][bj] = *(const v4u*)(gates + (size_t)(row0 + ai * 128 + m * 16) * NGATE + 2 * DM + col0 + bj * 128);
#pragma unroll
            for (int m = 0; m < 4; ++m) { const size_t r = (size_t)(row0 + ai * 128 + m * 16);
#pragma unroll
                for (int bj = 0; bj < 2; ++bj) { const v4u g = gg[m][bj]; float x[8]; unpack8(g, x);
                    const f32x4 v0 = acc[ai][bj][m][0], v1 = acc[ai][bj][m][1];
                    v4u w; w.x = pk2(v0[0] * x[0], v0[1] * x[1]); w.y = pk2(v0[2] * x[2], v0[3] * x[3]); w.z = pk2(v1[0] * x[4], v1[1] * x[5]); w.w = pk2(v1[2] * x[6], v1[3] * x[7]);
                    *(v4u*)(O + r * DM + col0 + bj * 128) = w; } }
            __builtin_amdgcn_sched_barrier(0);
        }
    }
};
struct EpiOut {
    static constexpr bool PERM = true, AFTER_DRAIN = false, KHOOK = false; static constexpr int HK0 = -1, HK1 = -1;
    float* O; const float* X;
    __device__ __forceinline__ void operator()(const f32x4 (&acc)[2][2][4][2], const Unit& u, int wr, int wc, int fr, int fq) const {
        int row0 = u.pm * 256 + wr * 64 + fr, col0 = u.pn * 256 + wc * 32 + 8 * fq;
        asm volatile("" : "+v"(row0), "+v"(col0));
#pragma unroll
        for (int ai = 0; ai < 2; ++ai) {
            f32x4 xa[4][2], xb[4][2];
#pragma unroll
            for (int m = 0; m < 4; ++m) { const size_t o = (size_t)(row0 + ai * 128 + m * 16) * DM + col0;
#pragma unroll
                for (int bj = 0; bj < 2; ++bj) { xa[m][bj] = *(const f32x4*)(X + o + bj * 128); xb[m][bj] = *(const f32x4*)(X + o + bj * 128 + 4); } }
#pragma unroll
            for (int m = 0; m < 4; ++m) { const size_t o = (size_t)(row0 + ai * 128 + m * 16) * DM + col0;
#pragma unroll
                for (int bj = 0; bj < 2; ++bj) { *(f32x4*)(O + o + bj * 128) = xa[m][bj] + acc[ai][bj][m][0]; *(f32x4*)(O + o + bj * 128 + 4) = xb[m][bj] + acc[ai][bj][m][1]; } }
            __builtin_amdgcn_sched_barrier(0);
        }
    }
};

__device__ __forceinline__ float wave_sum(float v) {
#pragma unroll
    for (int o = 1; o < 64; o <<= 1) v += __shfl_xor(v, o);
    return v;
}
__device__ __forceinline__ void transpose_item(const float* W, int N, bf16* WT, int ldt, int koff, LAS float* scr, int item, int lane) {
    const int nblk = N / 32, kb = item / nblk, nb = item % nblk, k0 = 64 * kb, n0 = 32 * nb;
    float tv[32];
#pragma unroll
    for (int i = 0; i < 32; ++i) { const int kk = 2 * i + (lane >> 5); tv[i] = W[(size_t)(k0 + kk) * N + n0 + (lane & 31)]; }
#pragma unroll
    for (int i = 0; i < 32; ++i) { const int kk = 2 * i + (lane >> 5); scr[kk * 33 + (lane & 31)] = tv[i]; }
    asm volatile("s_waitcnt lgkmcnt(0)" ::: "memory");
    const int c = lane & 7;
#pragma unroll
    for (int j = 0; j < 4; ++j) { const int n = (lane >> 3) + 8 * j; const LAS float* s = scr + (8 * c) * 33 + n;
        v4u o; o.x = pk2(s[0 * 33], s[1 * 33]); o.y = pk2(s[2 * 33], s[3 * 33]); o.z = pk2(s[4 * 33], s[5 * 33]); o.w = pk2(s[6 * 33], s[7 * 33]);
        *(v4u*)(WT + (size_t)(n0 + n) * ldt + koff + k0 + 8 * c) = o; }
    asm volatile("s_waitcnt lgkmcnt(0)" ::: "memory");
}
__device__ __forceinline__ void rms_row_to_bf16(const float* xrow, const float* g, bf16* orow, int lane) {
    const f32x4* xr = (const f32x4*)xrow + lane; const f32x4* gr = (const f32x4*)g + lane;
    f32x4 v[8]; float s = 0.f;
#pragma unroll
    for (int j = 0; j < 8; ++j) { v[j] = xr[64 * j]; s += (v[j].x * v[j].x + v[j].y * v[j].y) + (v[j].z * v[j].z + v[j].w * v[j].w); }
    const float rstd = 1.f / sqrtf(wave_sum(s) * (1.f / DM) + NORM_EPS);
    v2u* o8 = (v2u*)orow + lane;
#pragma unroll
    for (int j = 0; j < 8; ++j) { const f32x4 gg = gr[64 * j]; v2u o; o.x = pk2(v[j].x * rstd * gg.x, v[j].y * rstd * gg.y); o.y = pk2(v[j].z * rstd * gg.z, v[j].w * rstd * gg.w); o8[64 * j] = o; }
}
__device__ __forceinline__ void p0_prologue(const Params& P, LAS unsigned char* lds, float* dout_scratch) {
    const int tid = pg8::mk_tid(lds), lane = tid & 63, wave = tid >> 6, G = gridDim.x;
    LAS float* scr = (LAS float*)(lds + wave * 16384);
    const int gw = blockIdx.x * NWAVES + wave, NGW = G * NWAVES;
    unsigned char* ws = P.ws; unsigned char* dob = (unsigned char*)P.out;
    bf16* WIN_T = (bf16*)(dob + DO_WIN); bf16* WCAT_T = (bf16*)(ws + WS_WCAT); bf16* WOUT_T = (bf16*)(ws + WS_WOUT); bf16* WXKV_T = (bf16*)(ws + WS_WXKV);
    constexpr int I_IN = 32 * (NIN / 32), I_A = 12 * 64, I_R = 12 * 64, I_X = 8 * 64, I_O = 32 * 64, I_KV = 32 * 32;
    constexpr int NITEMS = I_IN + I_A + I_R + I_X + I_O + I_KV;
    for (int it = gw; it < NITEMS; it += NGW) {
        int r = it;
        if (r < I_IN) { transpose_item(P.in[4], NIN, WIN_T, DM, 0, scr, r, lane); continue; } r -= I_IN;
        if (r < I_A) { transpose_item(P.in[9], DM, WCAT_T, DM, 0, scr, r, lane); continue; } r -= I_A;
        if (r < I_R) { transpose_item(P.in[20], DM, WCAT_T, DM, 768, scr, r, lane); continue; } r -= I_R;
        if (r < I_X) { transpose_item(P.in[24], DM, WCAT_T, DM, 1536, scr, r, lane); continue; } r -= I_X;
        if (r < I_O) { transpose_item(P.in[25], DM, WOUT_T, DM, 0, scr, r, lane); continue; } r -= I_O;
        transpose_item(P.in[21], 1024, WXKV_T, DM, 0, scr, r, lane);
    }
    bf16* H = (bf16*)(dob + DO_H); bf16* MEMN = (bf16*)(ws + WS_MEMN);
    for (int m = gw; m < M_TOK + MEMROWS; m += NGW) {
        if (m < M_TOK) rms_row_to_bf16(P.in[0] + (size_t)m * DM, P.in[2], H + (size_t)m * DM, lane);
        else rms_row_to_bf16(P.in[1] + (size_t)(m - M_TOK) * DM, P.in[3], MEMN + (size_t)(m - M_TOK) * DM, lane);
    }
    if (blockIdx.x == 0 && tid == 0) __hip_atomic_store((unsigned*)(ws + WS_CTR), 0u, __ATOMIC_RELAXED, __HIP_MEMORY_SCOPE_AGENT);
    bf16* LB = (bf16*)(ws + WS_LORAB);
    const int gt = blockIdx.x * NTHREADS + tid, NGT = G * NTHREADS;
    for (int idx = gt; idx < NLORA * 256; idx += NGT) {
        const int n = idx >> 8, k = idx & 255, d = n / RW, ch = n % RW, kb = k >> 6, kk = k & 63;
        float v = 0.f;
        if (kb == d) v = (d < 2) ? P.in[15][(size_t)(d * 64 + kk) * RW + ch] : P.in[17][(size_t)((d - 2) * 64 + kk) * RW + ch];
        LB[idx] = (bf16)f2bf(v);
    }
    float* RC = (float*)(ws + WS_ROPE); float* RS = RC + SEQ * 32;
    for (int idx = gt; idx < SEQ * 32; idx += NGT) {
        const int pos = idx >> 5, i = idx & 31;
        const float inv = __builtin_exp2f(-(float)i * (13.287712379549449f / 32.f));
        const float ang = (float)pos * inv;
        double rv = (double)ang * 0.15915494309189535; rv -= __builtin_floor(rv);
        const float r = (float)rv;
        RC[idx] = __builtin_amdgcn_cosf(r); RS[idx] = __builtin_amdgcn_sinf(r);
    }
}

__device__ __forceinline__ void p2_lora_in(const Params& P, LAS unsigned char* lds) {
    const bf16* PRE = (const bf16*)(P.ws + WS_PRE); bf16* LIN = (bf16*)((unsigned char*)P.out + DO_LIN); const float* mu = P.in[10];
    const int gt = blockIdx.x * NTHREADS + pg8::mk_tid(lds), NGT = gridDim.x * NTHREADS;
    for (int idx = gt; idx < M_TOK * 32; idx += NGT) {
        const int m = idx >> 5, j = (idx & 31) * 8, t = m & (SEQ - 1);
        const bf16* p = PRE + (size_t)m * NPRE + C_LORA + j;
        const v4u z4 = (v4u){0u, 0u, 0u, 0u};
        const v4u c = *(const v4u*)p, pv = (t > 0) ? *(const v4u*)(p - NPRE) : z4, nx = (t < SEQ - 1) ? *(const v4u*)(p + NPRE) : z4;
        const f32x4 m0 = *(const f32x4*)(mu + 2304 + j), m1 = *(const f32x4*)(mu + 2304 + j + 4);
        float xc[8], xp[8], xn[8], s[8]; unpack8(c, xc); unpack8(pv, xp); unpack8(nx, xn);
#pragma unroll
        for (int i = 0; i < 8; ++i) { const float mm = (i < 4) ? m0[i & 3] : m1[i & 3]; s[i] = xc[i] + mm * (0.5f * (xp[i] + xn[i]) - xc[i]);
            if (j < 128) s[i] = 1.f - 2.f * __builtin_amdgcn_rcpf(__expf(2.f * s[i]) + 1.f); }
        v4u o; o.x = pk2(s[0], s[1]); o.y = pk2(s[2], s[3]); o.z = pk2(s[4], s[5]); o.w = pk2(s[6], s[7]);
        *(v4u*)(LIN + (size_t)m * 256 + j) = o;
    }
}

constexpr int SC_CH = 32, SC_REC = 1536, SC_BUF = SC_CH * SC_REC, SC_SCAL = 2 * SC_BUF;
template <int MODE> __device__ __forceinline__ void scan_block(const Params& P, int sid, LAS unsigned char* lds) {
    const int tid = pg8::mk_tid(lds), lane = tid & 63, wave = __builtin_amdgcn_readfirstlane(tid >> 6);
    const int b = sid / 24, rem = sid % 24, h = rem >> 1, dir = rem & 1;
    const bf16* PRE = (const bf16*)(P.ws + WS_PRE); const bf16* EA = (const bf16*)((unsigned char*)P.out + DO_EA);
    bf16* YO = dir ? (bf16*)(P.ws + WS_YB) : (bf16*)((unsigned char*)P.out + DO_YF);
    constexpr int NCH = SEQ / SC_CH;
#define SC_BAR() do { asm volatile("s_waitcnt lgkmcnt(0)" ::: "memory"); __builtin_amdgcn_s_barrier(); asm volatile("" ::: "memory"); } while (0)
    if (wave >= 4) {
        const int pt = tid - 256, sl = pt >> 3, e = pt & 7, ch0 = h * 64 + 8 * e;
        float mur[8], muk[8], muv[8], kkc[8], kac[8];
#pragma unroll
        for (int i = 0; i < 8; ++i) { mur[i] = P.in[10][ch0 + i]; muk[i] = P.in[10][768 + ch0 + i]; muv[i] = P.in[10][1536 + ch0 + i]; kkc[i] = P.in[11][ch0 + i]; kac[i] = P.in[12][ch0 + i]; }
        v4u rc, kc, vc, rp, kp, vp, rn, kn, vn, e8, a8;
        const v4u z4 = (v4u){0u, 0u, 0u, 0u};
#define SC_PLOAD(c_) do { const int step_ = (c_) * SC_CH + sl, t_ = dir ? (SEQ - 1 - step_) : step_; const size_t m_ = (size_t)b * SEQ + t_; \
            const bf16* rowp_ = PRE + m_ * NPRE + C_RS + ch0; \
            rc = *(const v4u*)(rowp_); kc = *(const v4u*)(rowp_ + 768); vc = *(const v4u*)(rowp_ + 1536); \
            rp = (t_ > 0) ? *(const v4u*)(rowp_ - NPRE) : z4; kp = (t_ > 0) ? *(const v4u*)(rowp_ - NPRE + 768) : z4; vp = (t_ > 0) ? *(const v4u*)(rowp_ - NPRE + 1536) : z4; \
            rn = (t_ < SEQ - 1) ? *(const v4u*)(rowp_ + NPRE) : z4; kn = (t_ < SEQ - 1) ? *(const v4u*)(rowp_ + NPRE + 768) : z4; vn = (t_ < SEQ - 1) ? *(const v4u*)(rowp_ + NPRE + 1536) : z4; \
            const bf16* eap_ = EA + m_ * NLORA + dir * RW + ch0; e8 = *(const v4u*)(eap_); a8 = *(const v4u*)(eap_ + 1536); } while (0)
#define SC_PWRITE(c_) do { LAS unsigned char* buf_ = lds + ((c_) & 1) * SC_BUF; LAS float* scal_ = (LAS float*)(lds + SC_SCAL) + ((c_) & 1) * (SC_CH * 2); \
            float r[8], k[8], v[8], x0[8], x1[8], x2[8]; \
            unpack8(rc, x0); unpack8(rp, x1); unpack8(rn, x2); \
            _Pragma("unroll") for (int i = 0; i < 8; ++i) r[i] = x0[i] + mur[i] * (0.5f * (x1[i] + x2[i]) - x0[i]); \
            unpack8(kc, x0); unpack8(kp, x1); unpack8(kn, x2); \
            _Pragma("unroll") for (int i = 0; i < 8; ++i) k[i] = x0[i] + muk[i] * (0.5f * (x1[i] + x2[i]) - x0[i]); \
            unpack8(vc, x0); unpack8(vp, x1); unpack8(vn, x2); \
            _Pragma("unroll") for (int i = 0; i < 8; ++i) v[i] = x0[i] + muv[i] * (0.5f * (x1[i] + x2[i]) - x0[i]); \
            float ee[8], aa[8]; unpack8(e8, ee); unpack8(a8, aa); \
            float kk[8], ss = 0.f; \
            _Pragma("unroll") for (int i = 0; i < 8; ++i) { kk[i] = k[i] * kkc[i]; ss += kk[i] * kk[i]; } \
            ss = red8(ss); \
            const float inv = 1.f / fmaxf(sqrtf(ss), 1e-12f); \
            float nkk[8], dd[8], dr[8], bb[8], kd[8], sbr = 0.f, skr = 0.f; \
            _Pragma("unroll") for (int i = 0; i < 8; ++i) { \
                const float kki = kk[i] * inv; nkk[i] = -kki; dd[i] = __expf(-ee[i]); dr[i] = dd[i] * r[i]; \
                bb[i] = kki * aa[i]; kd[i] = k[i] * (1.f + (aa[i] - 1.f) * kac[i]); sbr += bb[i] * r[i]; skr += kd[i] * r[i]; } \
            sbr = red8(sbr); skr = red8(skr); \
            LAS float* rec = (LAS float*)(buf_ + sl * SC_REC) + 8 * e; \
            *(LAS f32x4*)(rec) = (f32x4){nkk[0], nkk[1], nkk[2], nkk[3]}; *(LAS f32x4*)(rec + 4) = (f32x4){nkk[4], nkk[5], nkk[6], nkk[7]}; \
            *(LAS f32x4*)(rec + 64) = (f32x4){dr[0], dr[1], dr[2], dr[3]}; *(LAS f32x4*)(rec + 68) = (f32x4){dr[4], dr[5], dr[6], dr[7]}; \
            *(LAS f32x4*)(rec + 128) = (f32x4){dd[0], dd[1], dd[2], dd[3]}; *(LAS f32x4*)(rec + 132) = (f32x4){dd[4], dd[5], dd[6], dd[7]}; \
            *(LAS f32x4*)(rec + 192) = (f32x4){bb[0], bb[1], bb[2], bb[3]}; *(LAS f32x4*)(rec + 196) = (f32x4){bb[4], bb[5], bb[6], bb[7]}; \
            *(LAS f32x4*)(rec + 256) = (f32x4){kd[0], kd[1], kd[2], kd[3]}; *(LAS f32x4*)(rec + 260) = (f32x4){kd[4], kd[5], kd[6], kd[7]}; \
            *(LAS f32x4*)(rec + 320) = (f32x4){v[0], v[1], v[2], v[3]}; *(LAS f32x4*)(rec + 324) = (f32x4){v[4], v[5], v[6], v[7]}; \
            if (e == 0) *(LAS f32x2*)(scal_ + 2 * sl) = (f32x2){sbr, skr}; } while (0)
        if (!(MODE & 2)) { SC_PLOAD(0); SC_PWRITE(0); SC_PLOAD(1); }
        SC_BAR();
        for (int c = 0; c < NCH; ++c) {
            if (!(MODE & 2)) { if (c + 1 < NCH) SC_PWRITE(c + 1);
            if (c + 2 < NCH) SC_PLOAD(c + 2); }
            SC_BAR();
        }
#undef SC_PLOAD
#undef SC_PWRITE
    } else {
        const int rp = (wave * 64 + lane) >> 3, cgp = lane & 7;
        f32x2 s0[4], s1[4];
#pragma unroll
        for (int i = 0; i < 4; ++i) { s0[i] = (f32x2){0.f, 0.f}; s1[i] = (f32x2){0.f, 0.f}; }
        bf16* yrow = YO + (size_t)b * SEQ * RW + h * 64 + 2 * rp;
        SC_BAR();
#define SC_LOAD(N0, N1, Q0, Q1, D0, D1, B0, B1, K0, K1, VV, SS, sl_) do { const LAS float* rec_ = (const LAS float*)(buf + (sl_) * SC_REC) + 8 * cgp; \
            N0 = *(const LAS f32x4*)(rec_); N1 = *(const LAS f32x4*)(rec_ + 4); Q0 = *(const LAS f32x4*)(rec_ + 64); Q1 = *(const LAS f32x4*)(rec_ + 68); \
            D0 = *(const LAS f32x4*)(rec_ + 128); D1 = *(const LAS f32x4*)(rec_ + 132); B0 = *(const LAS f32x4*)(rec_ + 192); B1 = *(const LAS f32x4*)(rec_ + 196); \
            K0 = *(const LAS f32x4*)(rec_ + 256); K1 = *(const LAS f32x4*)(rec_ + 260); \
            VV = *(const LAS f32x2*)((const LAS float*)(buf + (sl_) * SC_REC) + 320 + 2 * rp); SS = *(const LAS f32x2*)(scal + 2 * (sl_)); } while (0)
        for (int c = 0; c < NCH; ++c) {
            const LAS unsigned char* buf = lds + (c & 1) * SC_BUF; const LAS float* scal = (const LAS float*)(lds + SC_SCAL) + (c & 1) * (SC_CH * 2);
            f32x4 n0, n1, q0, q1, d0, d1, b0, b1, k0, k1; f32x2 vv, sc;
            SC_LOAD(n0, n1, q0, q1, d0, d1, b0, b1, k0, k1, vv, sc, 0);
#pragma unroll 2
            for (int sl = 0; sl < SC_CH; ++sl) {
                f32x4 xn0, xn1, xq0, xq1, xd0, xd1, xb0, xb1, xk0, xk1; f32x2 xvv, xsc;
                const int sn = (sl + 1 < SC_CH) ? sl + 1 : sl;
                const f32x2 nk[4] = {(f32x2){n0.x, n0.y}, (f32x2){n0.z, n0.w}, (f32x2){n1.x, n1.y}, (f32x2){n1.z, n1.w}};
                const f32x2 qq[4] = {(f32x2){q0.x, q0.y}, (f32x2){q0.z, q0.w}, (f32x2){q1.x, q1.y}, (f32x2){q1.z, q1.w}};
                const f32x2 dv[4] = {(f32x2){d0.x, d0.y}, (f32x2){d0.z, d0.w}, (f32x2){d1.x, d1.y}, (f32x2){d1.z, d1.w}};
                const f32x2 bv[4] = {(f32x2){b0.x, b0.y}, (f32x2){b0.z, b0.w}, (f32x2){b1.x, b1.y}, (f32x2){b1.z, b1.w}};
                const f32x2 kv[4] = {(f32x2){k0.x, k0.y}, (f32x2){k0.z, k0.w}, (f32x2){k1.x, k1.y}, (f32x2){k1.z, k1.w}};
                f32x2 a0 = s0[0] * nk[0], a1 = s1[0] * nk[0], y0 = s0[0] * qq[0], y1 = s1[0] * qq[0];
#pragma unroll
                for (int i = 1; i < 4; ++i) { a0 = s0[i] * nk[i] + a0; a1 = s1[i] * nk[i] + a1; y0 = s0[i] * qq[i] + y0; y1 = s1[i] * qq[i] + y1; }
                float sa0 = a0.x + a0.y, sa1 = a1.x + a1.y, yp0 = y0.x + y0.y, yp1 = y1.x + y1.y;
                SC_LOAD(xn0, xn1, xq0, xq1, xd0, xd1, xb0, xb1, xk0, xk1, xvv, xsc, sn);
                sa0 = red8(sa0); sa1 = red8(sa1); yp0 = red8(yp0); yp1 = red8(yp1);
                const float yo0 = yp0 + sa0 * sc.x + vv.x * sc.y, yo1 = yp1 + sa1 * sc.x + vv.y * sc.y;
                const f32x2 sa0v = (f32x2){sa0, sa0}, sa1v = (f32x2){sa1, sa1}, v0v = (f32x2){vv.x, vv.x}, v1v = (f32x2){vv.y, vv.y};
#pragma unroll
                for (int i = 0; i < 4; ++i) {
                    f32x2 t0 = v0v * kv[i]; t0 = sa0v * bv[i] + t0; s0[i] = s0[i] * dv[i] + t0;
                    f32x2 t1 = v1v * kv[i]; t1 = sa1v * bv[i] + t1; s1[i] = s1[i] * dv[i] + t1;
                }
                const int step = c * SC_CH + sl, t = dir ? (SEQ - 1 - step) : step;
                const unsigned yw = pk2(yo0, yo1);
                if (!(MODE & 1)) { if (cgp == 0) *(unsigned*)(yrow + (size_t)t * RW) = yw; } else { asm volatile("" :: "v"(yw)); }
                n0 = xn0; n1 = xn1; q0 = xq0; q1 = xq1; d0 = xd0; d1 = xd1; b0 = xb0; b1 = xb1; k0 = xk0; k1 = xk1; vv = xvv; sc = xsc;
            }
            SC_BAR();
        }
#undef SC_LOAD
    }
#undef SC_BAR
    __syncthreads();
}

__device__ __forceinline__ bf16x8 pack8(const float (&x)[8]) {
    v4u w; w.x = pk2(x[0], x[1]); w.y = pk2(x[2], x[3]); w.z = pk2(x[4], x[5]); w.w = pk2(x[6], x[7]); return __builtin_bit_cast(bf16x8, w);
}
#define MFMA16(a, b, c) __builtin_amdgcn_mfma_f32_16x16x32_bf16((a), (b), (c), 0, 0, 0)
constexpr int CK = 16, NCK = SEQ / CK;
constexpr int L_QK = 0, L_PR = 4608, L_QKT = 9216, L_VT = 14336, L_VF = 19456, L_GC = 23552, L_OPSZ = 23808;
constexpr int L_E = 2 * L_OPSZ, L_G = L_E + 4096, L_GSZ = 5120, L_W0 = L_G + 2 * L_GSZ, L_VG = L_W0 + 4096, L_SB = L_VG + 2 * 4096, L_CEND = L_SB + 9216;
static_assert(L_CEND + 1280 <= 131072, "chunked scan LDS map");
#ifdef CBAR_FULL
#define CBAR() __syncthreads()
#else
#define CBAR() do { __builtin_amdgcn_s_waitcnt(0xC07F); __builtin_amdgcn_s_barrier(); } while (0)
#endif
__device__ __forceinline__ void scan_chunked(const Params& P, int sid, LAS unsigned char* lds) {
    const int tid = pg8::mk_tid(lds), lane = tid & 63, wave = __builtin_amdgcn_readfirstlane(tid >> 6), l15 = lane & 15, q4 = lane >> 4;
    const int b = sid / 24, rem = sid % 24, h = rem >> 1, dir = rem & 1;
    const bf16* PRE = (const bf16*)(P.ws + WS_PRE); const bf16* EA = (const bf16*)((unsigned char*)P.out + DO_EA);
    bf16* YO = dir ? (bf16*)(P.ws + WS_YB) : (bf16*)((unsigned char*)P.out + DO_YF);
#ifdef YZERO
    for (int it = tid; it < SEQ * 8; it += NTHREADS) *(v4u*)(YO + ((size_t)b * SEQ + (it >> 3)) * RW + h * 64 + (it & 7) * 8) = (v4u){0u, 0u, 0u, 0u};
#endif
    for (int i = tid; i < 9216 / 4; i += NTHREADS) ((LAS unsigned*)(lds + L_SB))[i] = 0u;
    for (int i = tid; i < L_SB / 4; i += NTHREADS) ((LAS unsigned*)(lds))[i] = 0u;
    if (tid < 320) { const int vsel = tid >> 6, chn = h * 64 + (tid & 63);
        ((LAS float*)(lds + L_CEND))[tid] = (vsel < 3) ? P.in[10][vsel * 768 + chn] : ((vsel == 3) ? P.in[11][chn] : P.in[12][chn]); }
    CBAR();
    if (wave >= 4) {
        const int pt = tid - 256, t = pt >> 4, e = pt & 15, ch0 = h * 64 + 4 * e, gsw = 8 * ((e >> 1) & 3);
        const LAS float* cst = (const LAS float*)(lds + L_CEND) + 4 * e;
        v2u rcA, kcA, vcA, rpA, kpA, vpA, rnA, knA, vnA, e8A, a8A, rcB, kcB, vcB, rpB, kpB, vpB, rnB, knB, vnB, e8B, a8B;
        const v2u z2 = (v2u){0u, 0u};
#define CK_PLOAD(X, c_) do { const int step_ = (c_) * CK + t, t_ = dir ? (SEQ - 1 - step_) : step_; const size_t m_ = (size_t)b * SEQ + t_; \
            const bf16* rowp_ = PRE + m_ * NPRE + C_RS + ch0; \
            const bf16* rowq_ = (t_ > 0) ? rowp_ - NPRE : rowp_; const bf16* rown_ = (t_ < SEQ - 1) ? rowp_ + NPRE : rowp_;     \
            rc##X = *(const v2u*)(rowp_); kc##X = *(const v2u*)(rowp_ + 768); vc##X = *(const v2u*)(rowp_ + 1536); \
            rp##X = *(const v2u*)(rowq_); kp##X = *(const v2u*)(rowq_ + 768); vp##X = *(const v2u*)(rowq_ + 1536); \
            rn##X = *(const v2u*)(rown_); kn##X = *(const v2u*)(rown_ + 768); vn##X = *(const v2u*)(rown_ + 1536); \
            const bf16* eap_ = EA + m_ * NLORA + dir * RW + ch0; e8##X = *(const v2u*)(eap_); a8##X = *(const v2u*)(eap_ + 1536); } while (0)
        CK_PLOAD(A, 0); CK_PLOAD(B, 1);
        float r[4], k[4], v[4], kk[4], aa[4], ee[4];
#define CK_PBODY(X, c_) do { const int c = (c_); const int pb = (c & 1) * L_OPSZ; \
            {   \
                float x0[4], x1[4], x2[4]; f32x4 cc; \
                const int stepc_ = ((c < NCK) ? c : NCK - 1) * CK + t, tc_ = dir ? (SEQ - 1 - stepc_) : stepc_; const float fp_ = (tc_ > 0) ? 1.f : 0.f, fn_ = (tc_ < SEQ - 1) ? 1.f : 0.f; \
                unpack4(rc##X, x0); unpack4(rp##X, x1); unpack4(rn##X, x2); cc = *(const LAS f32x4*)(cst); \
                _Pragma("unroll") for (int i = 0; i < 4; ++i) r[i] = x0[i] + cc[i] * (0.5f * (fp_ * x1[i] + fn_ * x2[i]) - x0[i]); \
                unpack4(kc##X, x0); unpack4(kp##X, x1); unpack4(kn##X, x2); cc = *(const LAS f32x4*)(cst + 64); \
                _Pragma("unroll") for (int i = 0; i < 4; ++i) k[i] = x0[i] + cc[i] * (0.5f * (fp_ * x1[i] + fn_ * x2[i]) - x0[i]); \
                unpack4(vc##X, x0); unpack4(vp##X, x1); unpack4(vn##X, x2); cc = *(const LAS f32x4*)(cst + 128); \
                _Pragma("unroll") for (int i = 0; i < 4; ++i) v[i] = x0[i] + cc[i] * (0.5f * (fp_ * x1[i] + fn_ * x2[i]) - x0[i]); \
                unpack4(e8##X, ee); unpack4(a8##X, aa); cc = *(const LAS f32x4*)(cst + 192); \
                float ss = 0.f; \
                _Pragma("unroll") for (int i = 0; i < 4; ++i) { kk[i] = k[i] * cc[i]; ss += kk[i] * kk[i]; } \
                ss = red8(ss); ss = dpp_add<0x140>(ss); \
                const float inv = __builtin_amdgcn_rcpf(fmaxf(__builtin_amdgcn_sqrtf(ss), 1e-12f)); \
                _Pragma("unroll") for (int i = 0; i < 4; ++i) kk[i] *= inv; \
                *(LAS f32x4*)((LAS float*)(lds + L_E) + t * 64 + 4 * e) = (f32x4){ee[0], ee[1], ee[2], ee[3]}; \
                CK_PLOAD(X, (c + 2 < NCK) ? c + 2 : NCK - 1); \
            } \
            CBAR(); \
            { \
                f32x4 gs = (f32x4){0.f, 0.f, 0.f, 0.f}; \
                _Pragma("unroll") for (int u = 0; u < CK; ++u) { \
                    const f32x4 ea = *(const LAS f32x4*)((const LAS float*)(lds + L_E) + u * 64 + 4 * e); \
                    const float m = (u <= t) ? 1.f : 0.f; gs += m * ea; } \
                const f32x4 kac = *(const LAS f32x4*)(cst + 256); \
                float qv[4], kt[4], pv[4], rt[4], gin[4]; \
                _Pragma("unroll") for (int i = 0; i < 4; ++i) { \
                    gin[i] = __expf(-gs[i]); const float gex = __expf(ee[i] - gs[i]), ginv = __expf(gs[i]); \
                    const float kd = k[i] * (1.f + (aa[i] - 1.f) * kac[i]); \
                    qv[i] = kk[i] * aa[i] * ginv; kt[i] = kd * ginv; pv[i] = kk[i] * gex; rt[i] = r[i] * gin[i]; \
                } \
                LAS unsigned char* ob = lds + pb; \
                unsigned wq[4]; v2u o; \
                _Pragma("unroll") for (int i = 0; i < 4; ++i) wq[i] = pk2(qv[i], kt[i]);                        \
                o.x = (wq[0] & 0xffffu) | (wq[1] << 16); o.y = (wq[2] & 0xffffu) | (wq[3] << 16); *(LAS v2u*)(ob + L_QK + (t * 72 + 4 * e) * 2) = o; \
                o.x = (wq[0] >> 16) | (wq[1] & 0xffff0000u); o.y = (wq[2] >> 16) | (wq[3] & 0xffff0000u); *(LAS v2u*)(ob + L_QK + ((16 + t) * 72 + 4 * e) * 2) = o; \
                o.x = pk2(pv[0], pv[1]); o.y = pk2(pv[2], pv[3]); *(LAS v2u*)(ob + L_PR + (t * 72 + 4 * e) * 2) = o; \
                o.x = pk2(rt[0], rt[1]); o.y = pk2(rt[2], rt[3]); *(LAS v2u*)(ob + L_PR + ((16 + t) * 72 + 4 * e) * 2) = o; \
                const unsigned wv01 = pk2(v[0], v[1]), wv23 = pk2(v[2], v[3]); \
                _Pragma("unroll") for (int i = 0; i < 4; ++i) { \
                    *(LAS bf16*)(ob + L_QKT + ((4 * e + i) * 40 + (t ^ gsw)) * 2) = (bf16)(wq[i] & 0xffffu); *(LAS bf16*)(ob + L_QKT + ((4 * e + i) * 40 + ((16 + t) ^ gsw)) * 2) = (bf16)(wq[i] >> 16); \
                    const unsigned wv = (i < 2) ? wv01 : wv23; \
                    *(LAS bf16*)(ob + L_VT + ((4 * e + i) * 40 + ((16 + t) ^ gsw)) * 2) = (bf16)((i & 1) ? (wv >> 16) : (wv & 0xffffu)); \
                } \
                if (t == CK - 1) *(LAS f32x4*)((LAS float*)(ob + L_GC) + 4 * e) = (f32x4){gin[0], gin[1], gin[2], gin[3]}; \
            } \
            CBAR(); \
            CBAR(); } while (0)
        static_assert((NCK + 2) % 2 == 0, "producer loop is unrolled by two");
        for (int c2 = 0; c2 <= NCK + 1; c2 += 2) { CK_PBODY(A, c2); CK_PBODY(B, c2 + 1); }
#undef CK_PBODY
#undef CK_PLOAD
    } else {
        const int w = wave;
        f32x4 acc[4];
#pragma unroll
        for (int nt = 0; nt < 4; ++nt) acc[nt] = (f32x4){0.f, 0.f, 0.f, 0.f};
        bf16* ybase = YO + (size_t)b * SEQ * RW + h * 64 + 16 * w + 4 * q4;
        for (int c = 0; c <= NCK + 1; ++c) {
            const int ck = c - 1; const bool valid = (ck >= 0 && ck < NCK);
            const int pb = (ck & 1) * L_OPSZ, gb = L_G + (ck & 1) * L_GSZ;
            f32x4 r1 = (f32x4){0.f, 0.f, 0.f, 0.f};
            if (valid) {
                f32x4 r0 = (f32x4){0.f, 0.f, 0.f, 0.f};
#pragma unroll
                for (int ks = 0; ks < 2; ++ks) {
                    const bf16x8 S = *(const LAS bf16x8*)(lds + L_SB + ((16 * w + l15) * 72 + ks * 32 + 8 * q4) * 2);
                    const bf16x8 Bp = *(const LAS bf16x8*)(lds + pb + L_PR + ((l15) * 72 + ks * 32 + 8 * q4) * 2);
                    const bf16x8 Br = *(const LAS bf16x8*)(lds + pb + L_PR + ((16 + l15) * 72 + ks * 32 + 8 * q4) * 2);
                    r0 = MFMA16(S, Bp, r0); r1 = MFMA16(S, Br, r1);
                }
                *(LAS f32x4*)(lds + L_W0 + (l15 * 64 + 16 * w + 4 * q4) * 4) = r0;
            }
            if (valid && w == 1) {
#pragma unroll
                for (int x = 0; x < 4; ++x) {
                    const int a = x >> 1, bc = x & 1;
                    f32x4 g = (f32x4){0.f, 0.f, 0.f, 0.f};
#pragma unroll
                    for (int ks = 0; ks < 2; ++ks) {
                        const bf16x8 A = *(const LAS bf16x8*)(lds + pb + L_QK + ((a * 16 + l15) * 72 + ks * 32 + 8 * q4) * 2);
                        const bf16x8 Bm = *(const LAS bf16x8*)(lds + pb + L_PR + ((bc * 16 + l15) * 72 + ks * 32 + 8 * q4) * 2);
                        g = MFMA16(A, Bm, g);
                    }
                    *(LAS f32x4*)(lds + gb + x * 1280 + (l15 * 20 + 4 * q4) * 4) = g;
                }
                __builtin_amdgcn_s_waitcnt(0xC07F);
                float bw[8];
                {
                    const f32x4 ga = *(const LAS f32x4*)(lds + gb + 2 * 1280 + (l15 * 20 + 8 * (q4 & 1)) * 4), gb2 = *(const LAS f32x4*)(lds + gb + 2 * 1280 + (l15 * 20 + 8 * (q4 & 1) + 4) * 4);
#pragma unroll
                    for (int ii = 0; ii < 8; ++ii) { const int s = 8 * (q4 & 1) + ii; const float gv = (ii < 4) ? ga[ii & 3] : gb2[ii & 3]; bw[ii] = (q4 >= 2 && s < l15) ? gv : 0.f; }
                }
                const bf16x8 Bf = pack8(bw);
#pragma unroll
                for (int mt = 0; mt < 4; ++mt) {
                    const bf16x8 Av = *(const LAS bf16x8*)(lds + pb + L_VT + ((mt * 16 + l15) * 40 + 8 * (q4 ^ (((mt * 16 + l15) >> 3) & 3))) * 2);
                    f32x4 r = (f32x4){0.f, 0.f, 0.f, 0.f};
                    r = MFMA16(Av, Bf, r);
                    *(LAS f32x4*)(lds + L_VG + (ck & 1) * 4096 + (l15 * 64 + mt * 16 + 4 * q4) * 4) = r;
                }
            }
            CBAR();
            if (valid && w == 0) {
                const int i = lane;
                float u[16];
#pragma unroll
                for (int s = 0; s < 16; ++s) u[s] = *(const LAS float*)(lds + L_W0 + (s * 64 + i) * 4) + *(const LAS float*)(lds + L_VG + (ck & 1) * 4096 + (s * 64 + i) * 4);
#pragma unroll
                for (int blk = 0; blk < 4; ++blk) {
                    f32x4 gq[4][4];
#pragma unroll
                    for (int tt = 0; tt < 4; ++tt)
#pragma unroll
                        for (int s4 = 0; s4 <= blk; ++s4) gq[tt][s4] = *(const LAS f32x4*)(lds + gb + 0 * 1280 + ((4 * blk + tt) * 20 + 4 * s4) * 4);
#pragma unroll
                    for (int s = 0; s < 4 * blk; ++s)
#pragma unroll
                        for (int tt = 0; tt < 4; ++tt) u[4 * blk + tt] -= gq[tt][s >> 2][s & 3] * u[s];
#pragma unroll
                    for (int tt = 1; tt < 4; ++tt)
#pragma unroll
                        for (int sp = 0; sp < tt; ++sp) u[4 * blk + tt] -= gq[tt][blk][sp] * u[4 * blk + sp];
                    __builtin_amdgcn_sched_barrier(0);
                }
                float n0[8], n1[8];
#pragma unroll
                for (int s = 0; s < 8; ++s) { n0[s] = -u[s]; n1[s] = -u[8 + s]; }
                *(LAS bf16x8*)(lds + pb + L_VT + (i * 40 + 8 * (0 ^ ((i >> 3) & 3))) * 2) = pack8(n0); *(LAS bf16x8*)(lds + pb + L_VT + (i * 40 + 8 * (1 ^ ((i >> 3) & 3))) * 2) = pack8(n1);
            }
            CBAR();
            if (valid) {
                const bf16x8 Bv = *(const LAS bf16x8*)(lds + pb + L_VT + ((16 * w + l15) * 40 + 8 * (q4 ^ (((16 * w + l15) >> 3) & 3))) * 2);
                {
                    const int xo = (q4 < 2) ? 1 : 3;
                    const f32x4 ga = *(const LAS f32x4*)(lds + gb + xo * 1280 + (l15 * 20 + 8 * (q4 & 1)) * 4), gb2 = *(const LAS f32x4*)(lds + gb + xo * 1280 + (l15 * 20 + 8 * (q4 & 1) + 4) * 4);
                    float bw[8];
#pragma unroll
                    for (int ii = 0; ii < 8; ++ii) { const int s = 8 * (q4 & 1) + ii; const float gv = (ii < 4) ? ga[ii & 3] : gb2[ii & 3]; bw[ii] = (s <= l15) ? gv : 0.f; }
                    const f32x4 y = MFMA16(Bv, pack8(bw), r1);
                    const int step = ck * CK + l15, tt = dir ? (SEQ - 1 - step) : step;
                    v2u o; o.x = pk2(y[0], y[1]); o.y = pk2(y[2], y[3]);
                    *(v2u*)(ybase + (size_t)tt * RW) = o;
                }
#pragma unroll
                for (int nt = 0; nt < 4; ++nt) {
                    const bf16x8 Aq = *(const LAS bf16x8*)(lds + pb + L_QKT + ((nt * 16 + l15) * 40 + 8 * (q4 ^ (((nt * 16 + l15) >> 3) & 3))) * 2);
                    acc[nt] = MFMA16(Aq, Bv, acc[nt]);
                    const f32x4 gc = *(const LAS f32x4*)(lds + pb + L_GC + (nt * 16 + 4 * q4) * 4);
                    acc[nt] = acc[nt] * gc;
                    v2u o; o.x = pk2(acc[nt][0], acc[nt][1]); o.y = pk2(acc[nt][2], acc[nt][3]);
                    *(LAS v2u*)(lds + L_SB + ((16 * w + l15) * 72 + nt * 16 + 4 * q4) * 2) = o;
                }
            }
            CBAR();
        }
    }
    __syncthreads();
}
#undef CBAR

constexpr int KA_P = 72, VA_P = 392;
__device__ __forceinline__ void attnA_item(const Params& P, int item, LAS unsigned char* lds) {
    const int tid = pg8::mk_tid(lds), lane = tid & 63, wave = __builtin_amdgcn_readfirstlane(tid >> 6), l15 = lane & 15, q4 = lane >> 4;
    const int b = item >> 6, n = (item >> 2) & 15, hk = item & 3;
    const bf16* PRE = (const bf16*)(P.ws + WS_PRE); bf16* YC = (bf16*)(P.ws + WS_YCAT);
    const float* RC = (const float*)(P.ws + WS_ROPE); const float* RS = RC + SEQ * 32;
    LAS bf16* Ks = (LAS bf16*)lds; LAS bf16* Vt = Ks + 384 * KA_P;
    {
        v2u klo[6], khi[6]; f32x4 kcs[6], ksn[6]; v4u vw[6];
#pragma unroll
        for (int u = 0; u < 6; ++u) {
            const int it = tid + u * NTHREADS, j = it >> 3, c = it & 7, kp = (n - 1) * 128 + j;
            const bool ok = (kp >= 0 && kp < SEQ); const int kpc = ok ? kp : 0;
            const bf16* src = PRE + ((size_t)b * SEQ + kpc) * NPRE + C_AK + hk * 64;
            klo[u] = *(const v2u*)(src + 4 * c); khi[u] = *(const v2u*)(src + 32 + 4 * c);
            kcs[u] = *(const f32x4*)(RC + kpc * 32 + 4 * c); ksn[u] = *(const f32x4*)(RS + kpc * 32 + 4 * c);
            vw[u] = *(const v4u*)(PRE + ((size_t)b * SEQ + kpc) * NPRE + C_AV + hk * 64 + 8 * c);
        }
        const f32x4 g1 = *(const f32x4*)(P.in[7] + 4 * (tid & 7)), g2 = *(const f32x4*)(P.in[7] + 32 + 4 * (tid & 7));
#pragma unroll
        for (int u = 0; u < 6; ++u) {
            const int it = tid + u * NTHREADS, j = it >> 3, c = it & 7, kp = (n - 1) * 128 + j;
            const bool ok = (kp >= 0 && kp < SEQ);
            float x1[4], x2[4]; unpack4(klo[u], x1); unpack4(khi[u], x2);
            float ss = 0.f;
#pragma unroll
            for (int i = 0; i < 4; ++i) ss += x1[i] * x1[i] + x2[i] * x2[i];
            ss = red8(ss);
            const float rstd = ok ? 1.f / sqrtf(ss * (1.f / 64.f) + NORM_EPS) : 0.f;
            float r1[4], r2[4];
#pragma unroll
            for (int i = 0; i < 4; ++i) { const float y1 = x1[i] * rstd * g1[i], y2 = x2[i] * rstd * g2[i]; r1[i] = y1 * kcs[u][i] - y2 * ksn[u][i]; r2[i] = y2 * kcs[u][i] + y1 * ksn[u][i]; }
            v2u o0, o1; o0.x = pk2(r1[0], r1[1]); o0.y = pk2(r1[2], r1[3]); o1.x = pk2(r2[0], r2[1]); o1.y = pk2(r2[2], r2[3]);
            *(LAS v2u*)(Ks + j * KA_P + 4 * c) = o0; *(LAS v2u*)(Ks + j * KA_P + 32 + 4 * c) = o1;
            const v4u w = ok ? vw[u] : (v4u){0u, 0u, 0u, 0u};
            LAS bf16* d = Vt + (8 * c) * VA_P + j;
            d[0] = (bf16)(w.x & 0xffffu); d[VA_P] = (bf16)(w.x >> 16); d[2 * VA_P] = (bf16)(w.y & 0xffffu); d[3 * VA_P] = (bf16)(w.y >> 16);
            d[4 * VA_P] = (bf16)(w.z & 0xffffu); d[5 * VA_P] = (bf16)(w.z >> 16); d[6 * VA_P] = (bf16)(w.w & 0xffffu); d[7 * VA_P] = (bf16)(w.w >> 16);
        }
    }
    v4u qlo, qhi;
    {
        const int R0 = wave * 48, g = R0 >> 7, pos = (R0 & 127) + l15, qp = n * 128 + pos, hq = hk * 3 + g;
        const bf16* src = PRE + ((size_t)b * SEQ + qp) * NPRE + C_AQ + hq * 64;
        qlo = *(const v4u*)(src + 8 * q4); qhi = *(const v4u*)(src + 32 + 8 * q4);
    }
    __syncthreads();
#pragma unroll 1
    for (int mt = 0; mt < 3; ++mt) {
        const int R0 = wave * 48 + mt * 16, g = R0 >> 7, pos = (R0 & 127) + l15, qp = n * 128 + pos, hq = hk * 3 + g;
        const size_t m = (size_t)b * SEQ + qp;
        v2u gat[4];
#pragma unroll
        for (int dt = 0; dt < 4; ++dt) gat[dt] = *(const v2u*)(PRE + m * NPRE + C_AG + hq * 64 + dt * 16 + 4 * q4);
        const v4u cqlo = qlo, cqhi = qhi;
        {
            const int mn = (mt < 2) ? mt + 1 : 2, R1 = wave * 48 + mn * 16, g1_ = R1 >> 7, pos1 = (R1 & 127) + l15, qp1 = n * 128 + pos1, hq1 = hk * 3 + g1_;
            const bf16* src = PRE + ((size_t)b * SEQ + qp1) * NPRE + C_AQ + hq1 * 64;
            qlo = *(const v4u*)(src + 8 * q4); qhi = *(const v4u*)(src + 32 + 8 * q4);
        }
        bf16x8 qf0, qf1;
        {
            float x1[8], x2[8]; unpack8(cqlo, x1); unpack8(cqhi, x2);
            float ss = 0.f;
#pragma unroll
            for (int i = 0; i < 8; ++i) ss += x1[i] * x1[i] + x2[i] * x2[i];
            ss += __shfl_xor(ss, 16); ss += __shfl_xor(ss, 32);
            const float rstd = (0.125f * 1.4426950408889634f) / sqrtf(ss * (1.f / 64.f) + NORM_EPS);
            float r1[8], r2[8];
            const f32x4 ga = *(const f32x4*)(P.in[6] + 8 * q4), gb = *(const f32x4*)(P.in[6] + 8 * q4 + 4), gc = *(const f32x4*)(P.in[6] + 32 + 8 * q4), gd = *(const f32x4*)(P.in[6] + 36 + 8 * q4);
            const f32x4 ca = *(const f32x4*)(RC + qp * 32 + 8 * q4), cb = *(const f32x4*)(RC + qp * 32 + 8 * q4 + 4), sa_ = *(const f32x4*)(RS + qp * 32 + 8 * q4), sb_ = *(const f32x4*)(RS + qp * 32 + 8 * q4 + 4);
#pragma unroll
            for (int i = 0; i < 8; ++i) {
                const float g1 = (i < 4) ? ga[i & 3] : gb[i & 3], g2 = (i < 4) ? gc[i & 3] : gd[i & 3], cs = (i < 4) ? ca[i & 3] : cb[i & 3], sn = (i < 4) ? sa_[i & 3] : sb_[i & 3];
                const float y1 = x1[i] * rstd * g1, y2 = x2[i] * rstd * g2; r1[i] = y1 * cs - y2 * sn; r2[i] = y2 * cs + y1 * sn;
            }
            qf0 = pack8(r1); qf1 = pack8(r2);
        }
        const int kt0 = (R0 & 127) >> 4;
        const int seq_lo = (n == 0) ? 8 : 0, seq_hi = (n == 15) ? 15 : 23;
        f32x4 acc[18];
#pragma unroll
        for (int u = 0; u < 17; ++u) {
            const LAS bf16* kr = Ks + ((kt0 + u) * 16 + l15) * KA_P + 8 * q4;
            const bf16x8 k0 = *(const LAS bf16x8*)(kr), k1 = *(const LAS bf16x8*)(kr + 32);
            f32x4 a = (f32x4){0.f, 0.f, 0.f, 0.f};
            a = MFMA16(k0, qf0, a); a = MFMA16(k1, qf1, a); acc[u] = a;
        }
        acc[17] = (f32x4){-1e30f, -1e30f, -1e30f, -1e30f};
        const float sink = P.in[8][hq] * 1.4426950408889634f;
        float mx = sink;
#pragma unroll
        for (int u = 0; u < 17; ++u) {
            const bool tv = (kt0 + u >= seq_lo) && (kt0 + u <= seq_hi);
#pragma unroll
            for (int i = 0; i < 4; ++i) {
                bool valid = tv;
                if (u == 0) valid = valid && (4 * q4 + i >= l15);
                if (u == 16) valid = valid && (4 * q4 + i <= l15);
                const float sv = valid ? acc[u][i] : -1e30f; acc[u][i] = sv; mx = fmaxf(mx, sv);
            }
        }
        mx = fmaxf(mx, __shfl_xor(mx, 16)); mx = fmaxf(mx, __shfl_xor(mx, 32));
        float sum = 0.f;
#pragma unroll
        for (int u = 0; u < 17; ++u)
#pragma unroll
            for (int i = 0; i < 4; ++i) { const float p = __builtin_amdgcn_exp2f(acc[u][i] - mx); acc[u][i] = p; sum += p; }
        acc[17] = (f32x4){0.f, 0.f, 0.f, 0.f};
        sum += __shfl_xor(sum, 16); sum += __shfl_xor(sum, 32);
        const float inv = 1.f / (sum + __builtin_amdgcn_exp2f(sink - mx));
        f32x4 o[4];
#pragma unroll
        for (int dt = 0; dt < 4; ++dt) o[dt] = (f32x4){0.f, 0.f, 0.f, 0.f};
#pragma unroll
        for (int k2 = 0; k2 < 9; ++k2) {
            float pp[8] = {acc[2 * k2][0], acc[2 * k2][1], acc[2 * k2][2], acc[2 * k2][3], acc[2 * k2 + 1][0], acc[2 * k2 + 1][1], acc[2 * k2 + 1][2], acc[2 * k2 + 1][3]};
            const bf16x8 pf = pack8(pp);
#pragma unroll
            for (int dt = 0; dt < 4; ++dt) {
                const LAS bf16* vr = Vt + (dt * 16 + l15) * VA_P + kt0 * 16 + k2 * 32 + 4 * q4;
                const v2u v0 = *(const LAS v2u*)(vr);
                v2u v1 = (v2u){0u, 0u};
                if (k2 < 8) v1 = *(const LAS v2u*)(vr + 16);
                const v4u vw = (v4u){v0.x, v0.y, v1.x, v1.y};
                o[dt] = MFMA16(__builtin_bit_cast(bf16x8, vw), pf, o[dt]);
            }
        }
#pragma unroll
        for (int dt = 0; dt < 4; ++dt) {
            const int ch = hq * 64 + dt * 16 + 4 * q4;
            float gg[4]; unpack4(gat[dt], gg);
            v2u w; w.x = pk2(o[dt][0] * inv * gg[0], o[dt][1] * inv * gg[1]); w.y = pk2(o[dt][2] * inv * gg[2], o[dt][3] * inv * gg[3]);
            *(v2u*)(YC + m * DM + ch) = w;
        }
    }
    __syncthreads();
}

constexpr int KC_P = 136, VC_P = 264;
__device__ __forceinline__ void attnC_qblock(const Params& P, const LAS bf16* Ks, const LAS bf16* Vt, bf16* YC, const v4u (&qraw)[4], const v2u (&gat)[8], size_t m, int hx, int l15, int q4) {
    {
        bf16x8 qf[4];
        {
            float x[4][8]; float ss = 0.f;
#pragma unroll
            for (int ks = 0; ks < 4; ++ks) { unpack8(qraw[ks], x[ks]);
#pragma unroll
                for (int i = 0; i < 8; ++i) ss += x[ks][i] * x[ks][i]; }
            ss += __shfl_xor(ss, 16); ss += __shfl_xor(ss, 32);
            const float rstd = (0.08838834764831845f * 1.4426950408889634f) / sqrtf(ss * (1.f / 128.f) + NORM_EPS);
#pragma unroll
            for (int ks = 0; ks < 4; ++ks) { float y[8];
                const f32x4 ga = *(const f32x4*)(P.in[22] + ks * 32 + 8 * q4), gb = *(const f32x4*)(P.in[22] + ks * 32 + 8 * q4 + 4);
#pragma unroll
                for (int i = 0; i < 8; ++i) y[i] = x[ks][i] * rstd * ((i < 4) ? ga[i & 3] : gb[i & 3]);
                qf[ks] = pack8(y); }
        }
        f32x4 acc[16];
#pragma unroll
        for (int kt = 0; kt < 16; ++kt) {
            const LAS bf16* kr = Ks + (kt * 16 + l15) * KC_P + 8 * q4;
            f32x4 a = (f32x4){0.f, 0.f, 0.f, 0.f};
#pragma unroll
            for (int ks = 0; ks < 4; ++ks) a = MFMA16(*(const LAS bf16x8*)(kr + ks * 32), qf[ks], a);
            acc[kt] = a;
        }
        float mx = -1e30f;
#pragma unroll
        for (int kt = 0; kt < 16; ++kt)
#pragma unroll
            for (int i = 0; i < 4; ++i) mx = fmaxf(mx, acc[kt][i]);
        mx = fmaxf(mx, __shfl_xor(mx, 16)); mx = fmaxf(mx, __shfl_xor(mx, 32));
        float sum = 0.f;
#pragma unroll
        for (int kt = 0; kt < 16; ++kt)
#pragma unroll
            for (int i = 0; i < 4; ++i) { const float p = __builtin_amdgcn_exp2f(acc[kt][i] - mx); acc[kt][i] = p; sum += p; }
        sum += __shfl_xor(sum, 16); sum += __shfl_xor(sum, 32);
        const float inv = 1.f / sum;
        f32x4 o[8];
#pragma unroll
        for (int dt = 0; dt < 8; ++dt) o[dt] = (f32x4){0.f, 0.f, 0.f, 0.f};
#pragma unroll
        for (int k2 = 0; k2 < 8; ++k2) {
            float pp[8] = {acc[2 * k2][0], acc[2 * k2][1], acc[2 * k2][2], acc[2 * k2][3], acc[2 * k2 + 1][0], acc[2 * k2 + 1][1], acc[2 * k2 + 1][2], acc[2 * k2 + 1][3]};
            const bf16x8 pf = pack8(pp);
#pragma unroll
            for (int dt = 0; dt < 8; ++dt) {
                const LAS bf16* vr = Vt + (dt * 16 + l15) * VC_P + k2 * 32 + 4 * q4;
                const v2u v0 = *(const LAS v2u*)(vr), v1 = *(const LAS v2u*)(vr + 16);
                const v4u vw = (v4u){v0.x, v0.y, v1.x, v1.y};
                o[dt] = MFMA16(__builtin_bit_cast(bf16x8, vw), pf, o[dt]);
            }
        }
#pragma unroll
        for (int dt = 0; dt < 8; ++dt) {
            const int ch = hx * 128 + dt * 16 + 4 * q4;
            float gg[4]; unpack4(gat[dt], gg);
            v2u w; w.x = pk2(o[dt][0] * inv * gg[0], o[dt][1] * inv * gg[1]); w.y = pk2(o[dt][2] * inv * gg[2], o[dt][3] * inv * gg[3]);
            *(v2u*)(YC + m * DM + 1536 + ch) = w;
        }
    }
}
__device__ __forceinline__ void attnC_item(const Params& P, int item, LAS unsigned char* lds) {
    const int tid = pg8::mk_tid(lds), lane = tid & 63, wave = __builtin_amdgcn_readfirstlane(tid >> 6), l15 = lane & 15, q4 = lane >> 4;
    const int b = item >> 5, qb0 = 2 * ((item >> 2) & 7), hx = item & 3;
    const bf16* PRE = (const bf16*)(P.ws + WS_PRE); const bf16* MKV = (const bf16*)(P.ws + WS_MKV); bf16* YC = (bf16*)(P.ws + WS_YCAT);
    LAS bf16* Ks = (LAS bf16*)lds; LAS bf16* Vt = Ks + 256 * KC_P;
    const size_t m = (size_t)b * SEQ + qb0 * 128 + wave * 16 + l15;
    {
        v4u kw[8], vw[8];
#pragma unroll
        for (int u = 0; u < 8; ++u) {
            const int it = tid + u * NTHREADS, j = it >> 4, c = it & 15;
            const bf16* src = MKV + ((size_t)b * NMEM + j) * 1024 + hx * 128 + 8 * c;
            kw[u] = *(const v4u*)(src); vw[u] = *(const v4u*)(src + 512);
        }
        const f32x4 g0 = *(const f32x4*)(P.in[23] + 8 * (tid & 15)), g1 = *(const f32x4*)(P.in[23] + 8 * (tid & 15) + 4);
#pragma unroll
        for (int u = 0; u < 8; ++u) {
            const int it = tid + u * NTHREADS, j = it >> 4, c = it & 15;
            float x[8]; unpack8(kw[u], x);
            float ss = 0.f;
#pragma unroll
            for (int i = 0; i < 8; ++i) ss += x[i] * x[i];
            ss = red8(ss); ss = dpp_add<0x140>(ss);
            const float rstd = 1.f / sqrtf(ss * (1.f / 128.f) + NORM_EPS);
            v4u o; o.x = pk2(x[0] * rstd * g0.x, x[1] * rstd * g0.y); o.y = pk2(x[2] * rstd * g0.z, x[3] * rstd * g0.w);
            o.z = pk2(x[4] * rstd * g1.x, x[5] * rstd * g1.y); o.w = pk2(x[6] * rstd * g1.z, x[7] * rstd * g1.w);
            *(LAS v4u*)(Ks + j * KC_P + 8 * c) = o;
            const v4u w = vw[u];
            LAS bf16* d = Vt + (8 * c) * VC_P + j;
            d[0] = (bf16)(w.x & 0xffffu); d[VC_P] = (bf16)(w.x >> 16); d[2 * VC_P] = (bf16)(w.y & 0xffffu); d[3 * VC_P] = (bf16)(w.y >> 16);
            d[4 * VC_P] = (bf16)(w.z & 0xffffu); d[5 * VC_P] = (bf16)(w.z >> 16); d[6 * VC_P] = (bf16)(w.w & 0xffffu); d[7 * VC_P] = (bf16)(w.w >> 16);
        }
    }
    v4u qraw[4]; v2u gat[8];
    {
        const bf16* src = PRE + m * NPRE + C_XQ + hx * 128 + 8 * q4;
#pragma unroll
        for (int ks = 0; ks < 4; ++ks) qraw[ks] = *(const v4u*)(src + ks * 32);
#pragma unroll
        for (int dt = 0; dt < 8; ++dt) gat[dt] = *(const v2u*)(PRE + m * NPRE + C_XG + hx * 128 + dt * 16 + 4 * q4);
    }
    __syncthreads();
    v4u qraw2[4]; v2u gat2[8];
    {
        const size_t m2 = m + 128; const bf16* src = PRE + m2 * NPRE + C_XQ + hx * 128 + 8 * q4;
#pragma unroll
        for (int ks = 0; ks < 4; ++ks) qraw2[ks] = *(const v4u*)(src + ks * 32);
#pragma unroll
        for (int dt = 0; dt < 8; ++dt) gat2[dt] = *(const v2u*)(PRE + m2 * NPRE + C_XG + hx * 128 + dt * 16 + 4 * q4);
    }
    attnC_qblock(P, Ks, Vt, YC, qraw, gat, m, hx, l15, q4);
    __builtin_amdgcn_sched_barrier(0);
    attnC_qblock(P, Ks, Vt, YC, qraw2, gat2, m + 128, hx, l15, q4);
    __syncthreads();
}

__device__ __forceinline__ void p5_rwkv_post(const Params& P, LAS unsigned char* lds) {
    const bf16* PRE = (const bf16*)(P.ws + WS_PRE); const bf16* EA = (const bf16*)((unsigned char*)P.out + DO_EA);
    const bf16* YF = (const bf16*)((unsigned char*)P.out + DO_YF); const bf16* YB = (const bf16*)(P.ws + WS_YB); bf16* YC = (bf16*)(P.ws + WS_YCAT);
    const float* mu = P.in[10];
    const int gt = blockIdx.x * NTHREADS + pg8::mk_tid(lds), NGT = gridDim.x * NTHREADS;
    for (int idx = gt; idx < M_TOK * 96; idx += NGT) {
        const int m = idx / 96, he = idx - m * 96, ch0 = he * 8, t = m & (SEQ - 1);
        const bf16* p = PRE + (size_t)m * NPRE + C_RS + ch0;
        const v4u z4 = (v4u){0u, 0u, 0u, 0u};
        const bool hp = t > 0, hn = t < SEQ - 1;
        const v4u rc = *(const v4u*)(p), kc = *(const v4u*)(p + 768), vc = *(const v4u*)(p + 1536);
        const v4u rp = hp ? *(const v4u*)(p - NPRE) : z4, kp = hp ? *(const v4u*)(p - NPRE + 768) : z4, vp = hp ? *(const v4u*)(p - NPRE + 1536) : z4;
        const v4u rn = hn ? *(const v4u*)(p + NPRE) : z4, kn = hn ? *(const v4u*)(p + NPRE + 768) : z4, vn = hn ? *(const v4u*)(p + NPRE + 1536) : z4;
        const v4u af8 = *(const v4u*)(EA + (size_t)m * NLORA + 1536 + ch0), ab8 = *(const v4u*)(EA + (size_t)m * NLORA + 2304 + ch0);
        const v4u yf8 = *(const v4u*)(YF + (size_t)m * RW + ch0), yb8 = *(const v4u*)(YB + (size_t)m * RW + ch0);
        const v4u rg8 = *(const v4u*)(PRE + (size_t)m * NPRE + C_RG + ch0);
        float r[8], k[8], v[8], x0[8], x1[8], x2[8];
        unpack8(rc, x0); unpack8(rp, x1); unpack8(rn, x2);
#pragma unroll
        for (int i = 0; i < 8; ++i) r[i] = x0[i] + mu[ch0 + i] * (0.5f * (x1[i] + x2[i]) - x0[i]);
        unpack8(kc, x0); unpack8(kp, x1); unpack8(kn, x2);
#pragma unroll
        for (int i = 0; i < 8; ++i) k[i] = x0[i] + mu[768 + ch0 + i] * (0.5f * (x1[i] + x2[i]) - x0[i]);
        unpack8(vc, x0); unpack8(vp, x1); unpack8(vn, x2);
#pragma unroll
        for (int i = 0; i < 8; ++i) v[i] = x0[i] + mu[1536 + ch0 + i] * (0.5f * (x1[i] + x2[i]) - x0[i]);
        float af[8], ab[8], ys[8], yb[8], rg[8]; unpack8(af8, af); unpack8(ab8, ab); unpack8(yf8, ys); unpack8(yb8, yb); unpack8(rg8, rg);
        float bs = 0.f, sm = 0.f;
#pragma unroll
        for (int i = 0; i < 8; ++i) { const float kds = k[i] * (2.f + (af[i] + ab[i] - 2.f) * P.in[12][ch0 + i]); bs += r[i] * kds * P.in[13][ch0 + i]; ys[i] += yb[i]; sm += ys[i]; }
        bs = red8(bs); sm = red8(sm);
        const float mean = sm * (1.f / 64.f);
        float vs = 0.f;
#pragma unroll
        for (int i = 0; i < 8; ++i) { ys[i] -= mean; vs += ys[i] * ys[i]; }
        vs = red8(vs);
        const float rstd = 1.f / sqrtf(vs * (1.f / 64.f) + GN_EPS);
        float o[8];
#pragma unroll
        for (int i = 0; i < 8; ++i) o[i] = (ys[i] * rstd * P.in[18][ch0 + i] + P.in[19][ch0 + i] + bs * v[i]) * rg[i];
        v4u w; w.x = pk2(o[0], o[1]); w.y = pk2(o[2], o[3]); w.z = pk2(o[4], o[5]); w.w = pk2(o[6], o[7]);
        *(v4u*)(YC + (size_t)m * DM + 768 + ch0) = w;
    }
}


constexpr size_t WS_XBAR = 504 * MiB + 832 * 1024;
#define XB_TMO      128
#define XB_XCNT(j)  (256  + 64 * (j))
#define XB_XSUB(j)  (1280 + 64 * (j))
#define XB_XGEN(j)  (2304 + 64 * (j))
#define XB_TOP      3328
#define XB_TOPGEN   3392
#define XCD_BAR_WORDS 3456
#define XB_SPIN_CAP (1u << 18)
__device__ __forceinline__ unsigned xb_ld(unsigned* p)              { return __hip_atomic_load(p, __ATOMIC_RELAXED, __HIP_MEMORY_SCOPE_AGENT); }
__device__ __forceinline__ unsigned xb_add(unsigned* p, unsigned v) { return __hip_atomic_fetch_add(p, v, __ATOMIC_RELAXED, __HIP_MEMORY_SCOPE_AGENT); }
__device__ __forceinline__ unsigned xb_xcc_id() { return (unsigned)__builtin_amdgcn_s_getreg((3 << 11) | 20) & 0xFu; }
#define XB_SPIN(cond, bar) do { unsigned _sp = 0; while (cond) { __builtin_amdgcn_s_sleep(1); \
    if ((++_sp & 255u) == 0u) { if (xb_ld(&(bar)[XB_TMO])) break; if (_sp > XB_SPIN_CAP) { atomicAdd(&(bar)[XB_TMO], 1u); break; } } } } while (0)
__device__ __forceinline__ void xcd_barrier_complete(unsigned* bar, unsigned x, unsigned& nloc, unsigned& nx) {
    const unsigned G = gridDim.x * gridDim.y * gridDim.z;
    unsigned sum, cnt, mine, sp = 0u;
    for (;;) {
        sum = 0u; cnt = 0u; mine = 0u;
#pragma unroll
        for (unsigned j = 0; j < 16; ++j) { const unsigned c = xb_ld(&bar[XB_XCNT(j)]); sum += c; cnt += (c > 0u) ? 1u : 0u; mine = (j == x) ? c : mine; }
        if (sum == G) break;
        __builtin_amdgcn_s_sleep(1);
        if ((++sp & 255u) == 0u) { if (xb_ld(&bar[XB_TMO])) break; if (sp > XB_SPIN_CAP) { atomicAdd(&bar[XB_TMO], 1u); break; } }
    }
    nloc = mine > 0u ? mine : 1u; nx = cnt > 0u ? cnt : 1u;
}
__device__ __forceinline__ void xcd_barrier(unsigned* bar, volatile LAS unsigned* st, LAS unsigned char* lds) {
    asm volatile("s_waitcnt vmcnt(0)" ::: "memory");
    __syncthreads();
    if (pg8::mk_tid(lds) == 0) {
        const unsigned x = xb_xcc_id();
        __builtin_amdgcn_s_waitcnt(0);
        unsigned nloc = st[0], nx = st[1];
        if (nloc == 0u) { xcd_barrier_complete(bar, x, nloc, nx); st[0] = nloc; st[1] = nx; }
        const unsigned old = xb_add(&bar[XB_XSUB(x)], 1u);
        const unsigned gen = old / nloc;
        if (old + 1u == (gen + 1u) * nloc) {
            __builtin_amdgcn_fence(__ATOMIC_RELEASE, "agent");
            asm volatile("s_waitcnt vmcnt(0)" ::: "memory");
            const unsigned og = xb_add(&bar[XB_TOP], 1u);
            const unsigned tg = og / nx;
            if (og + 1u == (tg + 1u) * nx) xb_add(&bar[XB_TOPGEN], 1u);
            else XB_SPIN(xb_ld(&bar[XB_TOPGEN]) == tg, bar);
            __builtin_amdgcn_fence(__ATOMIC_ACQUIRE, "agent");
            xb_add(&bar[XB_XGEN(x)], 1u);
            asm volatile("s_waitcnt vmcnt(0)" ::: "memory");
        } else {
            XB_SPIN(xb_ld(&bar[XB_XGEN(x)]) == gen, bar);
            __builtin_amdgcn_fence(__ATOMIC_ACQUIRE, "agent");
            asm volatile("s_waitcnt vmcnt(0)" ::: "memory");
        }
    }
    __syncthreads();
}

constexpr int N_PHASES = 8;
__global__ void __launch_bounds__(NTHREADS, 2) hybrid_fwd(Params P) {
    extern __shared__ __attribute__((aligned(16))) unsigned char lds_raw[];
    LAS unsigned char* lds = (LAS unsigned char*)lds_raw;
    cg::grid_group grid = cg::this_grid();
    const int lo = P.ph_lo, hi = P.ph_hi, G = gridDim.x;
    if ((threadIdx.x & 63) == 0) *(volatile LAS int*)(lds + pg8::TIDTAB_OFF + 4 * pg8::hw_slot()) = (int)(threadIdx.x >> 6);
    volatile LAS unsigned* xbst = (volatile LAS unsigned*)(lds + pg8::TIDTAB_OFF - 128);
    unsigned* xbar = (unsigned*)(P.ws + WS_XBAR);
    if (threadIdx.x == 0) { xbst[0] = 0u; xbst[1] = 0u; (void)xb_add(&xbar[XB_XCNT(xb_xcc_id())], 1u); }
    __syncthreads();
    unsigned char* ws = P.ws; unsigned char* dob = (unsigned char*)P.out;
#ifdef PHMASK
#define IN(k) (((PHMASK >> (k)) & 1) && lo <= (k) && (k) < hi)
#else
#define IN(k) (lo <= (k) && (k) < hi)
#endif
#define SEAM(k) do { if (IN(k) && IN((k) + 1)) xcd_barrier(xbar, xbst, lds); } while (0)
#ifndef REPEAT_MASK
#define REPEAT_MASK 0
#endif
#define REP(k) for (int rep_ = 0; rep_ < (((REPEAT_MASK >> (k)) & 1) ? 2 : 1); ++rep_)
#define REPSYNC() do { if (rep_) grid.sync(); } while (0)
    if (hi > N_PHASES) grid.sync();
    if (IN(0)) REP(0) { REPSYNC(); p0_prologue(P, lds, P.out); __syncthreads(); }
    SEAM(0);
    if (IN(1)) REP(1) { REPSYNC();
        { pg8::Gemm g{(const bf16*)(dob + DO_H), (const bf16*)(dob + DO_WIN), M_TOK, NIN, DM}; pg8::StaticOrder S; S.init(M_TOK, NIN, G, (int)blockIdx.x);
          EpiProj E{(bf16*)(ws + WS_PRE), (bf16*)(ws + WS_GATES), P.in[5]};
          pg8::gemm_phase<EpiProj, pg8::StaticOrder, true, true>(lds, g, S, E); }
        { pg8::Gemm g{(const bf16*)(ws + WS_MEMN), (const bf16*)(ws + WS_WXKV), MEMROWS, 1024, DM}; pg8::StaticOrder S; S.init(MEMROWS, 1024, G, (int)((blockIdx.x + G - 64) % G));
          EpiPlain E{(bf16*)(ws + WS_MKV), 1024};
          pg8::gemm_phase<EpiPlain, pg8::StaticOrder, true, true>(lds, g, S, E); }
    }
    SEAM(1);
    if (IN(2)) REP(2) { REPSYNC(); p2_lora_in(P, lds); }
    SEAM(2);
    if (IN(3)) REP(3) { REPSYNC();
        int klora = 256; asm volatile("" : "+s"(klora));
        pg8::Gemm g{(const bf16*)(dob + DO_LIN), (const bf16*)(ws + WS_LORAB), M_TOK, NLORA, klora}; pg8::StaticOrder S; S.init(M_TOK, NLORA, G, (int)blockIdx.x);
        EpiLora E{(bf16*)(dob + DO_EA), P.in[14], P.in[16]};
        pg8::gemm_phase<EpiLora, pg8::StaticOrder, true, true>(lds, g, S, E);
    }
    SEAM(3);
    if (IN(4)) REP(4) { REPSYNC();
        const int bid = blockIdx.x;
#ifndef STATIC_ATT
#define STATIC_ATT 0
#endif
#ifndef SCAN2
#define SCAN2 1
#endif
        if (bid < 192) scan_chunked(P, bid, lds);
        if (STATIC_ATT) {
            if (bid >= 192) { for (int it = bid - 192; it < 768; it += G - 192) { if (it < 512) attnA_item(P, it, lds); else attnC_item(P, it - 512, lds); } }
        } else {
            volatile LAS int* slot = (volatile LAS int*)(lds + pg8::TIDTAB_OFF - 64);
            const int tid4 = pg8::mk_tid(lds);
            for (;;) {
                if (tid4 == 0) *slot = (int)__hip_atomic_fetch_add((unsigned*)(ws + WS_CTR), 1u, __ATOMIC_RELAXED, __HIP_MEMORY_SCOPE_AGENT);
                __syncthreads();
                const int it = *slot;
                __syncthreads();
                if (it >= 768) break;
                if (it < 512) attnA_item(P, it, lds); else attnC_item(P, it - 512, lds);
            }
        }
    }
    SEAM(4);
    if (IN(5)) REP(5) { REPSYNC(); p5_rwkv_post(P, lds); }
    SEAM(5);
    if (IN(6)) REP(6) { REPSYNC();
        pg8::Gemm g{(const bf16*)(ws + WS_YCAT), (const bf16*)(ws + WS_WCAT), M_TOK, DM, DM}; pg8::StaticOrder S; S.init(M_TOK, DM, G, (int)blockIdx.x);
        EpiMerged E{(bf16*)(ws + WS_MERGED), (const bf16*)(ws + WS_GATES)};
        pg8::gemm_phase<EpiMerged, pg8::StaticOrder, true, true>(lds, g, S, E);
    }
    SEAM(6);
    if (IN(7)) REP(7) { REPSYNC();
        pg8::Gemm g{(const bf16*)(ws + WS_MERGED), (const bf16*)(ws + WS_WOUT), M_TOK, DM, DM}; pg8::StaticOrder S; S.init(M_TOK, DM, G, (int)blockIdx.x);
        EpiOut E{P.out, P.in[0]};
        pg8::gemm_phase<EpiOut, pg8::StaticOrder, true, true>(lds, g, S, E);
    }
#undef IN
#undef SEAM
}

#ifndef ONE_LAUNCH
#define ONE_LAUNCH 1
#endif
extern "C" void kernel_launch(void* const* d_in, const int* in_sizes, int n_in, void* d_out, int out_size, void* d_ws, size_t ws_size, hipStream_t stream) {
    static int grid = 0;
    if (grid == 0) {
        if (n_in != 26 || out_size != M_TOK * DM || ws_size < WS_END) { fprintf(stderr, "kernel_launch: unexpected shapes (n_in %d, out %d, ws %zu); nothing launched\n", n_in, out_size, ws_size); grid = -1; return; }
        int dev = 0, cus = 0, per_cu = 0;
        hipGetDevice(&dev); hipDeviceGetAttribute(&cus, hipDeviceAttributeMultiprocessorCount, dev);
        if (hipFuncSetAttribute((const void*)hybrid_fwd, hipFuncAttributeMaxDynamicSharedMemorySize, LDS_BYTES) != hipSuccess) { fprintf(stderr, "kernel_launch: hipFuncSetAttribute failed\n"); grid = -1; return; }
        hipOccupancyMaxActiveBlocksPerMultiprocessor(&per_cu, (const void*)hybrid_fwd, NTHREADS, LDS_BYTES);
        (void)hipGetLastError();
        if (per_cu < 1) per_cu = 1;
        grid = cus * per_cu; if (grid > 256) grid = 256;
        if (grid < 200) { fprintf(stderr, "kernel_launch: grid %d too small for the scan/attention split\n", grid); grid = -1; return; }
    }
    if (grid < 0) return;
    Params p{};
    for (int i = 0; i < 26; ++i) p.in[i] = (const float*)d_in[i];
    p.out = (float*)d_out; p.ws = (unsigned char*)d_ws;
#if ONE_LAUNCH
    (void)hipMemsetAsync((unsigned char*)d_ws + WS_XBAR, 0, XCD_BAR_WORDS * 4, stream);
    p.ph_lo = 0; p.ph_hi = N_PHASES;
    void* args[] = {&p};
    hipError_t e = hipLaunchCooperativeKernel((const void*)hybrid_fwd, dim3(grid), dim3(NTHREADS), args, LDS_BYTES, stream);
    if (e != hipSuccess) fprintf(stderr, "cooperative launch failed: %s (grid %d)\n", hipGetErrorString(e), grid);
#else
    for (int ph = 0; ph < N_PHASES; ++ph) {
        p.ph_lo = ph; p.ph_hi = ph + 1;
        hipLaunchKernelGGL(hybrid_fwd, dim3(grid), dim3(NTHREADS), LDS_BYTES, stream, p);
    }
#endif
}
```

```cpp
#include <hip/hip_runtime.h>
#include <hip/hip_cooperative_groups.h>
#include <cstdio>
#include <cstdint>
namespace cg = cooperative_groups;
namespace pg8 {
#define PG8_LAS __attribute__((address_space(3)))
typedef unsigned short bf16_t;
typedef short bf16x8 __attribute__((ext_vector_type(8)));
typedef float f32x4 __attribute__((ext_vector_type(4)));
typedef unsigned u32x4 __attribute__((ext_vector_type(4)));
constexpr int BM = 256, BK = 64, HALF = 128, HTB = HALF * BK * 2  , STAGE_BYTES = 8 * HTB, NXCD = 8, WGM = 2;

__host__ __device__ __forceinline__ int lds_byte(int r, int c) { const int st = (r >> 4) * 2 + (c >> 5), rr = r & 15, cc = c & 31, ob = rr * 64 + cc * 2; return st * 1024 + (ob ^ (((ob >> 9) & 1) << 5)); }
__host__ __device__ __forceinline__ void stage_rc(int b, int& R, int& C) { const int st = b / 1024, sb = b % 1024, swz = sb ^ (((sb >> 9) & 1) << 5); R = (st >> 1) * 16 + swz / 64; C = (st & 1) * 32 + (swz % 64) / 2; }
__host__ __device__ __forceinline__ int perm32(int rho) { const int n = rho >> 4, i = rho & 15; return 8 * (i >> 2) + 4 * n + (i & 3); }


constexpr int TIDTAB_OFF = 147200;
__device__ __forceinline__ int hw_slot() { return (int)(__builtin_amdgcn_s_getreg((5 << 11) | 4) & 63u); }
__device__ __forceinline__ int mk_tid(PG8_LAS unsigned char* lds) {
    const int lane = (int)__builtin_amdgcn_mbcnt_hi(~0u, __builtin_amdgcn_mbcnt_lo(~0u, 0u));
    const int w = __builtin_amdgcn_readfirstlane(*(volatile PG8_LAS int*)(lds + TIDTAB_OFF + 4 * hw_slot()));
    return w * 64 + lane;
}
struct Unit { int pm, pn; };
struct Gemm { const bf16_t* A; const bf16_t* Bt; int M, N, K; };

struct StaticOrder {
    int nM, nN, nwg, G, c;
    __host__ __device__ void init(int M, int N, int G_, int c_) { nM = M / BM; nN = N / BM; nwg = nM * nN; G = G_; c = c_; }
    __host__ __device__ bool next(int i, Unit& u) const {
        const long L = (long)i * G + c; if (L >= nwg) return false;
        int wgid = (int)L; { const int q = nwg / NXCD, r = nwg % NXCD, xcd = wgid % NXCD, off = wgid / NXCD; wgid = (xcd < r ? xcd * (q + 1) : r * (q + 1) + (xcd - r) * q) + off; }
        const int nig = WGM * nN, gid = wgid / nig, fm = gid * WGM, gsz = (nM - fm) < WGM ? (nM - fm) : WGM;
        u.pm = fm + ((wgid % nig) % gsz); u.pn = (wgid % nig) / gsz; return true;
    }
    __device__ __forceinline__ void a_ready(const Unit&) const {}
    __device__ __forceinline__ void done(const Unit&) const {}
};

__device__ __forceinline__ unsigned cvt_pk_bf16(float lo, float hi) { unsigned r; asm volatile("v_cvt_pk_bf16_f32 %0, %1, %2" : "=v"(r) : "v"(lo), "v"(hi)); return r; }
template <class Epi, class Sched, bool ALIGN_EPI = false, bool SP2 = false>
__device__ __forceinline__ void gemm_phase(PG8_LAS unsigned char* lds, const Gemm g, const Sched& S, const Epi& E) {
    const int tid = mk_tid(lds), wid = __builtin_amdgcn_readfirstlane(tid >> 6), lane = tid & 63, wr = wid >> 2, wc = wid & 3, fr = lane & 15, fq = lane >> 4;
    const int K = g.K, nt = K / BK;
    unsigned voffA[2], voffB[2];
#pragma unroll
    for (int i = 0; i < 2; ++i) { int R, C; stage_rc(tid * 16 + i * 8192, R, C); const int Rb = Epi::PERM ? ((R & ~31) + perm32(R & 31)) : R;
        voffA[i] = (unsigned)(R * K + C) * 2u; voffB[i] = (unsigned)(Rb * K + C) * 2u; }
    const size_t kstep = (size_t)(BK * 2);
    const size_t hstep = (size_t)HALF * K * 2;
    const size_t tstep = 2 * hstep;
    const unsigned ldsw = (unsigned)wid * 1024u;
    const int aoff = lds_byte(wr * 64 + fr, fq * 8), boff = lds_byte(wc * 32 + fr, fq * 8);
#define PG8_SA(b, h) (((b) * 2 + (h)) * HTB)
#define PG8_SB(b, h) ((4 + (b) * 2 + (h)) * HTB)
#define PG8_STAGE(bufoff, gbase, voff) do { _Pragma("unroll") for (int _i = 0; _i < 2; ++_i) \
        __builtin_amdgcn_global_load_lds((const unsigned*)((const char*)(gbase) + (voff)[_i]), (PG8_LAS unsigned*)(lds + (bufoff) + ldsw + _i * 8192), 16, 0, 0); } while (0)
#define PG8_LDA(dst, b, h) do { _Pragma("unroll") for (int m = 0; m < 4; ++m) _Pragma("unroll") for (int k = 0; k < 2; ++k) dst[m][k] = *(const PG8_LAS bf16x8*)(lds + PG8_SA(b, h) + aoff + m * 2048 + k * 1024); } while (0)
#define PG8_LDB(dst, b, h) do { _Pragma("unroll") for (int n = 0; n < 2; ++n) _Pragma("unroll") for (int k = 0; k < 2; ++k) dst[n][k] = *(const PG8_LAS bf16x8*)(lds + PG8_SB(b, h) + boff + n * 2048 + k * 1024); } while (0)
#define PG8_MMA(ai, bj, At, Bt) do { __builtin_amdgcn_s_setprio(1); _Pragma("unroll") for (int m = 0; m < 4; ++m) _Pragma("unroll") for (int n = 0; n < 2; ++n) _Pragma("unroll") for (int k = 0; k < 2; ++k) \
        acc[ai][bj][m][n] = __builtin_amdgcn_mfma_f32_16x16x32_bf16(Bt[n][k], At[m][k], acc[ai][bj][m][n], 0, 0, 0); __builtin_amdgcn_s_setprio(0); } while (0)
#define PG8_WAIT_V(n) asm volatile("s_waitcnt vmcnt(" #n ")" ::: "memory")
#define PG8_WAIT_L(n) asm volatile("s_waitcnt lgkmcnt(" #n ")" ::: "memory")
#define PG8_BAR __builtin_amdgcn_s_barrier()
#define PG8_SCHED __builtin_amdgcn_sched_barrier(0)
    Unit cur, nxt; int ui = 0;
    if (!S.next(0, cur)) return;
    f32x4 acc[2][2][4][2];
#pragma unroll
    for (int a = 0; a < 2; ++a)
#pragma unroll
        for (int b = 0; b < 2; ++b)
#pragma unroll
            for (int m = 0; m < 4; ++m)
#pragma unroll
                for (int n = 0; n < 2; ++n) acc[a][b][m][n] = (f32x4){0.f, 0.f, 0.f, 0.f};
    bf16x8 At[4][2], B0[2][2], B1[2][2];
    const char* cA = (const char*)g.A + (size_t)cur.pm * tstep; const char* cB = (const char*)g.Bt + (size_t)cur.pn * tstep;
    S.a_ready(cur);
    if constexpr (SP2) {
        PG8_STAGE(PG8_SB(0, 0), cB, voffB); PG8_STAGE(PG8_SB(0, 1), cB + hstep, voffB); PG8_STAGE(PG8_SA(0, 0), cA, voffA); PG8_STAGE(PG8_SA(0, 1), cA + hstep, voffA);
        if (wr == 1) PG8_BAR;
        PG8_WAIT_V(2); PG8_BAR;
        PG8_STAGE(PG8_SB(1, 0), cB + kstep, voffB); PG8_STAGE(PG8_SA(1, 0), cA + kstep, voffA); PG8_STAGE(PG8_SB(1, 1), cB + hstep + kstep, voffB);
        PG8_WAIT_V(6); PG8_BAR;
    } else {
        PG8_STAGE(PG8_SB(0, 0), cB, voffB); PG8_STAGE(PG8_SA(0, 0), cA, voffA); PG8_STAGE(PG8_SB(0, 1), cB + hstep, voffB); PG8_STAGE(PG8_SA(0, 1), cA + hstep, voffA);
        if (wr == 1) PG8_BAR;
        PG8_WAIT_V(4); PG8_BAR;
        PG8_STAGE(PG8_SB(1, 0), cB + kstep, voffB); PG8_STAGE(PG8_SA(1, 0), cA + kstep, voffA); PG8_STAGE(PG8_SB(1, 1), cB + hstep + kstep, voffB);
        PG8_WAIT_V(6); PG8_BAR;
    }
    for (;;) {
        const bool has_next = S.next(ui + 1, nxt);
        const char* nA = has_next ? (const char*)g.A + (size_t)nxt.pm * tstep : cA; const char* nB = has_next ? (const char*)g.Bt + (size_t)nxt.pn * tstep : cB;
        for (int t = 0; t < nt; t += 2) {
            if constexpr (Epi::KHOOK) { if (t == Epi::HK0 || t == Epi::HK1) E.khook(acc, cur, t, wr, wc, fr, fq); }
            const bool last = (t == nt - 2);
            const char* a1 = cA + (size_t)(t + 1) * kstep;
            const char* a2 = last ? nA : cA + (size_t)(t + 2) * kstep; const char* b2 = last ? nB : cB + (size_t)(t + 2) * kstep;
            const char* a3 = a2 + kstep; const char* b3 = b2 + kstep;
            if (last && has_next) S.a_ready(nxt);
            if constexpr (SP2) {
            PG8_LDB(B0, 0, 0); PG8_LDB(B1, 0, 1); PG8_SCHED; PG8_LDA(At, 0, 0); PG8_STAGE(PG8_SA(1, 1), a1 + hstep, voffA);
            PG8_WAIT_V(8); PG8_WAIT_L(0); PG8_BAR; PG8_MMA(0, 0, At, B0); PG8_MMA(0, 1, At, B1); PG8_BAR; PG8_SCHED;
            PG8_LDA(At, 0, 1); PG8_STAGE(PG8_SB(0, 0), b2, voffB); PG8_STAGE(PG8_SB(0, 1), b2 + hstep, voffB); PG8_STAGE(PG8_SA(0, 0), a2, voffA);
            PG8_WAIT_V(8); PG8_WAIT_L(0); PG8_BAR; PG8_MMA(1, 0, At, B0); PG8_MMA(1, 1, At, B1); PG8_BAR; PG8_SCHED;
            PG8_LDB(B0, 1, 0); PG8_LDB(B1, 1, 1); PG8_SCHED; PG8_LDA(At, 1, 0); PG8_STAGE(PG8_SA(0, 1), a2 + hstep, voffA);
            PG8_WAIT_V(8); PG8_WAIT_L(0); PG8_BAR; PG8_MMA(0, 0, At, B0); PG8_MMA(0, 1, At, B1); PG8_BAR; PG8_SCHED;
            PG8_LDA(At, 1, 1); PG8_STAGE(PG8_SB(1, 0), b3, voffB); PG8_STAGE(PG8_SB(1, 1), b3 + hstep, voffB); PG8_STAGE(PG8_SA(1, 0), a3, voffA);
            PG8_WAIT_V(8); PG8_WAIT_L(0); PG8_BAR; PG8_MMA(1, 0, At, B0); PG8_MMA(1, 1, At, B1); PG8_BAR; PG8_SCHED;
            } else {
            PG8_LDB(B0, 0, 0); PG8_SCHED; PG8_LDA(At, 0, 0); PG8_STAGE(PG8_SA(1, 1), a1 + hstep, voffA);
            PG8_WAIT_L(8); PG8_BAR; PG8_WAIT_L(0); PG8_MMA(0, 0, At, B0); PG8_BAR; PG8_SCHED;
            PG8_LDB(B1, 0, 1); PG8_STAGE(PG8_SB(0, 0), b2, voffB);
            PG8_BAR; PG8_WAIT_L(0); PG8_MMA(0, 1, At, B1); PG8_BAR;
            PG8_LDA(At, 0, 1); PG8_STAGE(PG8_SA(0, 0), a2, voffA);
            PG8_BAR; PG8_WAIT_L(0); PG8_MMA(1, 0, At, B0); PG8_BAR; PG8_SCHED;
            PG8_STAGE(PG8_SB(0, 1), b2 + hstep, voffB);
            PG8_WAIT_V(6); PG8_BAR; PG8_MMA(1, 1, At, B1); PG8_BAR;
            PG8_LDB(B0, 1, 0); PG8_SCHED; PG8_LDA(At, 1, 0); PG8_STAGE(PG8_SA(0, 1), a2 + hstep, voffA);
            PG8_WAIT_L(8); PG8_BAR; PG8_WAIT_L(0); PG8_MMA(0, 0, At, B0); PG8_BAR; PG8_SCHED;
            PG8_LDB(B1, 1, 1); PG8_STAGE(PG8_SB(1, 0), b3, voffB);
            PG8_BAR; PG8_WAIT_L(0); PG8_MMA(0, 1, At, B1); PG8_BAR;
            PG8_LDA(At, 1, 1); PG8_STAGE(PG8_SA(1, 0), a3, voffA);
            PG8_BAR; PG8_WAIT_L(0); PG8_MMA(1, 0, At, B0); PG8_BAR; PG8_SCHED;
            PG8_STAGE(PG8_SB(1, 1), b3 + hstep, voffB);
            PG8_WAIT_V(6); PG8_BAR; PG8_MMA(1, 1, At, B1); PG8_BAR;
            }
        }
        if constexpr (ALIGN_EPI) { if (wr == 0) PG8_BAR; }
        if constexpr (!Epi::AFTER_DRAIN) { E(acc, cur, wr, wc, fr, fq); S.done(cur); }
        if (!has_next) break;
#pragma unroll
        for (int a = 0; a < 2; ++a)
#pragma unroll
            for (int b = 0; b < 2; ++b)
#pragma unroll
                for (int m = 0; m < 4; ++m)
#pragma unroll
                    for (int n = 0; n < 2; ++n) acc[a][b][m][n] = (f32x4){0.f, 0.f, 0.f, 0.f};
        cur = nxt; cA = nA; cB = nB; ++ui;
        if constexpr (ALIGN_EPI) { if (wr == 1) PG8_BAR; }
    }
    PG8_WAIT_V(0);
    if constexpr (!ALIGN_EPI) { if (wr == 0) PG8_BAR; }
    PG8_BAR;
    if constexpr (Epi::AFTER_DRAIN) { E.fused(acc, cur, wr, wc, fr, fq, lds, wid, lane); S.done(cur); }
#undef PG8_SA
#undef PG8_SB
#undef PG8_STAGE
#undef PG8_LDA
#undef PG8_LDB
#undef PG8_MMA
#undef PG8_WAIT_V
#undef PG8_WAIT_L
#undef PG8_BAR
#undef PG8_SCHED
}
}

#define GAS __attribute__((address_space(1)))
#define LAS __attribute__((address_space(3)))
typedef unsigned short bf16;
typedef unsigned v4u __attribute__((ext_vector_type(4)));
typedef unsigned v2u __attribute__((ext_vector_type(2)));
typedef float f32x4 __attribute__((ext_vector_type(4)));
typedef float f32x2 __attribute__((ext_vector_type(2)));
typedef short bf16x8 __attribute__((ext_vector_type(8)));
typedef short s16x4 __attribute__((ext_vector_type(4)));

constexpr int NWAVES = 8, NTHREADS = 512;
constexpr int BATCH = 8, SEQ = 2048, DM = 2048, M_TOK = BATCH * SEQ;
constexpr int NPRE = 6400, NGATE = 6144, NIN = NPRE + NGATE;
constexpr int C_AQ = 0, C_AK = 768, C_AV = 1024, C_AG = 1280, C_RS = 2048, C_RR = 2048, C_RK = 2816, C_RV = 3584, C_LORA = 4352, C_RG = 4608, C_XQ = 5376, C_XG = 5888;
constexpr int NMEM = 256, MEMROWS = BATCH * NMEM;
constexpr int RW = 768, NLORA = 3072;
constexpr float NORM_EPS = 1e-6f, GN_EPS = 64e-5f;
constexpr int LDS_BYTES = 147456;

constexpr size_t MiB = 1u << 20;
constexpr size_t WS_PRE = 0, WS_MERGED = 0, WS_GATES = 200 * MiB, WS_YCAT = 392 * MiB;
constexpr size_t WS_WCAT = 456 * MiB, WS_WOUT = 464 * MiB, WS_WXKV = 472 * MiB, WS_MKV = 476 * MiB, WS_MEMN = 480 * MiB, WS_YB = 480 * MiB;
constexpr size_t WS_ROPE = 504 * MiB, WS_LORAB = 505 * MiB, WS_END = 512 * MiB;
constexpr size_t WS_CTR = 504 * MiB + 768 * 1024;
constexpr size_t DO_H = 0, DO_WIN = 64 * MiB, DO_EA = 0, DO_LIN = 96 * MiB, DO_YF = 104 * MiB;

struct Params { const float* in[26]; float* out; unsigned char* ws; int ph_lo, ph_hi; };

__device__ __forceinline__ float bf_lo(unsigned w) { return __builtin_bit_cast(float, w << 16); }
__device__ __forceinline__ float bf_hi(unsigned w) { return __builtin_bit_cast(float, w & 0xffff0000u); }
__device__ __forceinline__ float bf1(bf16 h) { return __builtin_bit_cast(float, (unsigned)h << 16); }
__device__ __forceinline__ unsigned f2bf(float f) { unsigned u = __builtin_bit_cast(unsigned, f); return (u + 0x7fffu + ((u >> 16) & 1u)) >> 16; }
typedef __bf16 bf16x2_t __attribute__((ext_vector_type(2)));
__device__ __forceinline__ unsigned pk2(float lo, float hi) { const f32x2 v = {lo, hi}; const bf16x2_t b = __builtin_convertvector(v, bf16x2_t); return __builtin_bit_cast(unsigned, b); }
__device__ __forceinline__ float sigmoidf_(float z) { return __builtin_amdgcn_rcpf(1.f + __expf(-z)); }
__device__ __forceinline__ float siluf_(float z) { return z * sigmoidf_(z); }
__device__ __forceinline__ void unpack8(v4u w, float (&x)[8]) { x[0] = bf_lo(w.x); x[1] = bf_hi(w.x); x[2] = bf_lo(w.y); x[3] = bf_hi(w.y); x[4] = bf_lo(w.z); x[5] = bf_hi(w.z); x[6] = bf_lo(w.w); x[7] = bf_hi(w.w); }
__device__ __forceinline__ void unpack4(v2u w, float (&x)[4]) { x[0] = bf_lo(w.x); x[1] = bf_hi(w.x); x[2] = bf_lo(w.y); x[3] = bf_hi(w.y); }
__device__ __forceinline__ float fma_s(float a, float b, float c) { float r; asm("v_fma_f32 %0, %1, %2, %3" : "=v"(r) : "v"(a), "v"(b), "v"(c)); return r; }
__device__ __forceinline__ float mul_s(float a, float b) { float r; asm("v_mul_f32_e32 %0, %1, %2" : "=v"(r) : "v"(a), "v"(b)); return r; }
__device__ __forceinline__ float add_s(float a, float b) { float r; asm("v_add_f32_e32 %0, %1, %2" : "=v"(r) : "v"(a), "v"(b)); return r; }
template <int CTRL> __device__ __forceinline__ float dpp_add(float v) { return v + __builtin_bit_cast(float, __builtin_amdgcn_update_dpp(0, __builtin_bit_cast(int, v), CTRL, 0xF, 0xF, true)); }
__device__ __forceinline__ float red8(float v) { v = dpp_add<0xB1>(v); v = dpp_add<0x4E>(v); v = dpp_add<0x141>(v); return v; }

using pg8::Unit;
struct EpiProj {
    static constexpr bool PERM = true, AFTER_DRAIN = false, KHOOK = false; static constexpr int HK0 = -1, HK1 = -1;
    bf16* pre; bf16* gates; const float* gate_b;
    __device__ __forceinline__ void operator()(const f32x4 (&acc)[2][2][4][2], const Unit& u, int wr, int wc, int fr, int fq) const {
        int row0 = u.pm * 256 + wr * 64 + fr;
        asm volatile("" : "+v"(row0));
        const bool isg = u.pn >= 25;
        const int pn = isg ? u.pn - 25 : u.pn;
        bf16* base = isg ? gates : pre; const int ldc = isg ? NGATE : NPRE;
        const int act = isg ? 2 : (((pn >= 5 && pn <= 7) || (pn >= 18 && pn <= 20) || pn >= 23) ? 1 : 0);
        const int col0 = pn * 256 + wc * 32 + 8 * fq;
        f32x4 bv[2][2];
#pragma unroll
        for (int bj = 0; bj < 2; ++bj) { bv[bj][0] = isg ? *(const f32x4*)(gate_b + col0 + bj * 128) : (f32x4){0.f, 0.f, 0.f, 0.f}; bv[bj][1] = isg ? *(const f32x4*)(gate_b + col0 + bj * 128 + 4) : (f32x4){0.f, 0.f, 0.f, 0.f}; }
#pragma unroll
        for (int ai = 0; ai < 2; ++ai)
#pragma unroll
            for (int m = 0; m < 4; ++m) { bf16* rowp = base + (size_t)(row0 + ai * 128 + m * 16) * ldc + col0;
                __builtin_amdgcn_sched_barrier(0);
#pragma unroll
                for (int bj = 0; bj < 2; ++bj) { f32x4 v0 = acc[ai][bj][m][0] + bv[bj][0], v1 = acc[ai][bj][m][1] + bv[bj][1];
                    if (act == 1) {
#pragma unroll
                        for (int i = 0; i < 4; ++i) { v0[i] = siluf_(v0[i]); v1[i] = siluf_(v1[i]); }
                    } else if (act == 2) {
#pragma unroll
                        for (int i = 0; i < 4; ++i) { v0[i] = sigmoidf_(v0[i]); v1[i] = sigmoidf_(v1[i]); }
                    }
                    v4u w; w.x = pk2(v0[0], v0[1]); w.y = pk2(v0[2], v0[3]); w.z = pk2(v1[0], v1[1]); w.w = pk2(v1[2], v1[3]);
                    *(v4u*)(rowp + bj * 128) = w; } }
    }
};
struct EpiPlain {
    static constexpr bool PERM = true, AFTER_DRAIN = false, KHOOK = false; static constexpr int HK0 = -1, HK1 = -1;
    bf16* O; int ldc;
    __device__ __forceinline__ void operator()(const f32x4 (&acc)[2][2][4][2], const Unit& u, int wr, int wc, int fr, int fq) const {
        int row0 = u.pm * 256 + wr * 64 + fr, col0 = u.pn * 256 + wc * 32 + 8 * fq;
        asm volatile("" : "+v"(row0), "+v"(col0));
#pragma unroll
        for (int ai = 0; ai < 2; ++ai)
#pragma unroll
            for (int m = 0; m < 4; ++m) { bf16* rowp = O + (size_t)(row0 + ai * 128 + m * 16) * ldc + col0;
#pragma unroll
                for (int bj = 0; bj < 2; ++bj) { const f32x4 v0 = acc[ai][bj][m][0], v1 = acc[ai][bj][m][1];
                    v4u w; w.x = pk2(v0[0], v0[1]); w.y = pk2(v0[2], v0[3]); w.z = pk2(v1[0], v1[1]); w.w = pk2(v1[2], v1[3]);
                    *(v4u*)(rowp + bj * 128) = w; } }
    }
};
struct EpiLora {
    static constexpr bool PERM = true, AFTER_DRAIN = false, KHOOK = false; static constexpr int HK0 = -1, HK1 = -1;
    bf16* O; const float* w0; const float* a0;
    __device__ __forceinline__ void operator()(const f32x4 (&acc)[2][2][4][2], const Unit& u, int wr, int wc, int fr, int fq) const {
        int row0 = u.pm * 256 + wr * 64 + fr, col0 = u.pn * 256 + wc * 32 + 8 * fq;
        asm volatile("" : "+v"(row0), "+v"(col0));
        const bool isw = u.pn < 6; const float* bias = isw ? (w0 + col0) : (a0 + col0 - 1536); const float sc = isw ? 0.6065306597126334f : 1.f;
        f32x4 bv[2][2];
#pragma unroll
        for (int bj = 0; bj < 2; ++bj) { bv[bj][0] = *(const f32x4*)(bias + bj * 128); bv[bj][1] = *(const f32x4*)(bias + bj * 128 + 4); }
#pragma unroll
        for (int ai = 0; ai < 2; ++ai)
#pragma unroll
            for (int m = 0; m < 4; ++m) { bf16* rowp = O + (size_t)(row0 + ai * 128 + m * 16) * NLORA + col0;
                __builtin_amdgcn_sched_barrier(0);
#pragma unroll
                for (int bj = 0; bj < 2; ++bj) { f32x4 v0 = acc[ai][bj][m][0] + bv[bj][0], v1 = acc[ai][bj][m][1] + bv[bj][1];
#pragma unroll
                    for (int i = 0; i < 4; ++i) { v0[i] = sc * sigmoidf_(v0[i]); v1[i] = sc * sigmoidf_(v1[i]); }
                    v4u w; w.x = pk2(v0[0], v0[1]); w.y = pk2(v0[2], v0[3]); w.z = pk2(v1[0], v1[1]); w.w = pk2(v1[2], v1[3]);
                    *(v4u*)(rowp + bj * 128) = w; } }
    }
};
struct EpiMerged {
    static constexpr bool PERM = true, AFTER_DRAIN = false, KHOOK = true; static constexpr int HK0 = 12, HK1 = 24;
    bf16* O; const bf16* gates;
    __device__ __forceinline__ void khook(f32x4 (&acc)[2][2][4][2], const Unit& u, int t, int wr, int wc, int fr, int fq) const {
        int row0 = u.pm * 256 + wr * 64 + fr, col0 = u.pn * 256 + wc * 32 + 8 * fq;
        asm volatile("" : "+v"(row0), "+v"(col0));
        const int bo = (t == HK0) ? 0 : DM;
#pragma unroll
        for (int ai = 0; ai < 2; ++ai) {
            v4u ga[4][2], gb[4][2];
#pragma unroll
            for (int m = 0; m < 4; ++m) { const bf16* gp = gates + (size_t)(row0 + ai * 128 + m * 16) * NGATE + bo + col0;
#pragma unroll
                for (int bj = 0; bj < 2; ++bj) { ga[m][bj] = *(const v4u*)(gp + bj * 128); gb[m][bj] = *(const v4u*)(gp + DM + bj * 128); } }
#pragma unroll
            for (int m = 0; m < 4; ++m)
#pragma unroll
                for (int bj = 0; bj < 2; ++bj) { float x[8], y[8]; unpack8(ga[m][bj], x); unpack8(gb[m][bj], y);
#pragma unroll
                    for (int i = 0; i < 4; ++i) { acc[ai][bj][m][0][i] *= x[i] * __builtin_amdgcn_rcpf(y[i]); acc[ai][bj][m][1][i] *= x[4 + i] * __builtin_amdgcn_rcpf(y[4 + i]); } }
            __builtin_amdgcn_sched_barrier(0);
        }
    }
    __device__ __forceinline__ void operator()(const f32x4 (&acc)[2][2][4][2], const Unit& u, int wr, int wc, int fr, int fq) const {
        int row0 = u.pm * 256 + wr * 64 + fr, col0 = u.pn * 256 + wc * 32 + 8 * fq;
        asm volatile("" : "+v"(row0), "+v"(col0));
#pragma unroll
        for (int ai = 0; ai < 2; ++ai) {
            v4u gg[4][2];
#pragma unroll
            for (int m = 0; m < 4; ++m)
#pragma unroll
                for (int bj = 0; bj < 2; ++bj) gg[m][bj] = *(const v4u*)(gates + (size_t)(row0 + ai * 128 + m * 16) * NGATE + 2 * DM + col0 + bj * 128);
#pragma unroll
            for (int m = 0; m < 4; ++m) { const size_t r = (size_t)(row0 + ai * 128 + m * 16);
#pragma unroll
                for (int bj = 0; bj < 2; ++bj) { const v4u g = gg[m][bj]; float x[8]; unpack8(g, x);
                    const f32x4 v0 = acc[ai][bj][m][0], v1 = acc[ai][bj][m][1];
                    v4u w; w.x = pk2(v0[0] * x[0], v0[1] * x[1]); w.y = pk2(v0[2] * x[2], v0[3] * x[3]); w.z = pk2(v1[0] * x[4], v1[1] * x[5]); w.w = pk2(v1[2] * x[6], v1[3] * x[7]);
                    *(v4u*)(O + r * DM + col0 + bj * 128) = w; } }
            __builtin_amdgcn_sched_barrier(0);
        }
    }
};
struct EpiOut {
    static constexpr bool PERM = true, AFTER_DRAIN = false, KHOOK = false; static constexpr int HK0 = -1, HK1 = -1;
    float* O; const float* X;
    __device__ __forceinline__ void operator()(const f32x4 (&acc)[2][2][4][2], const Unit& u, int wr, int wc, int fr, int fq) const {
        int row0 = u.pm * 256 + wr * 64 + fr, col0 = u.pn * 256 + wc * 32 + 8 * fq;
        asm volatile("" : "+v"(row0), "+v"(col0));
#pragma unroll
        for (int ai = 0; ai < 2; ++ai) {
            f32x4 xa[4][2], xb[4][2];
#pragma unroll
            for (int m = 0; m < 4; ++m) { const size_t o = (size_t)(row0 + ai * 128 + m * 16) * DM + col0;
#pragma unroll
                for (int bj = 0; bj < 2; ++bj) { xa[m][bj] = *(const f32x4*)(X + o + bj * 128); xb[m][bj] = *(const f32x4*)(X + o + bj * 128 + 4); } }
#pragma unroll
            for (int m = 0; m < 4; ++m) { const size_t o = (size_t)(row0 + ai * 128 + m * 16) * DM + col0;
#pragma unroll
                for (int bj = 0; bj < 2; ++bj) { *(f32x4*)(O + o + bj * 128) = xa[m][bj] + acc[ai][bj][m][0]; *(f32x4*)(O + o + bj * 128 + 4) = xb[m][bj] + acc[ai][bj][m][1]; } }
            __builtin_amdgcn_sched_barrier(0);
        }
    }
};

__device__ __forceinline__ float wave_sum(float v) {
#pragma unroll
    for (int o = 1; o < 64; o <<= 1) v += __shfl_xor(v, o);
    return v;
}
__device__ __forceinline__ void transpose_item(const float* W, int N, bf16* WT, int ldt, int koff, LAS float* scr, int item, int lane) {
    const int nblk = N / 32, kb = item / nblk, nb = item % nblk, k0 = 64 * kb, n0 = 32 * nb;
    float tv[32];
#pragma unroll
    for (int i = 0; i < 32; ++i) { const int kk = 2 * i + (lane >> 5); tv[i] = W[(size_t)(k0 + kk) * N + n0 + (lane & 31)]; }
#pragma unroll
    for (int i = 0; i < 32; ++i) { const int kk = 2 * i + (lane >> 5); scr[kk * 33 + (lane & 31)] = tv[i]; }
    asm volatile("s_waitcnt lgkmcnt(0)" ::: "memory");
    const int c = lane & 7;
#pragma unroll
    for (int j = 0; j < 4; ++j) { const int n = (lane >> 3) + 8 * j; const LAS float* s = scr + (8 * c) * 33 + n;
        v4u o; o.x = pk2(s[0 * 33], s[1 * 33]); o.y = pk2(s[2 * 33], s[3 * 33]); o.z = pk2(s[4 * 33], s[5 * 33]); o.w = pk2(s[6 * 33], s[7 * 33]);
        *(v4u*)(WT + (size_t)(n0 + n) * ldt + koff + k0 + 8 * c) = o; }
    asm volatile("s_waitcnt lgkmcnt(0)" ::: "memory");
}
__device__ __forceinline__ void rms_row_to_bf16(const float* xrow, const float* g, bf16* orow, int lane) {
    const f32x4* xr = (const f32x4*)xrow + lane; const f32x4* gr = (const f32x4*)g + lane;
    f32x4 v[8]; float s = 0.f;
#pragma unroll
    for (int j = 0; j < 8; ++j) { v[j] = xr[64 * j]; s += (v[j].x * v[j].x + v[j].y * v[j].y) + (v[j].z * v[j].z + v[j].w * v[j].w); }
    const float rstd = 1.f / sqrtf(wave_sum(s) * (1.f / DM) + NORM_EPS);
    v2u* o8 = (v2u*)orow + lane;
#pragma unroll
    for (int j = 0; j < 8; ++j) { const f32x4 gg = gr[64 * j]; v2u o; o.x = pk2(v[j].x * rstd * gg.x, v[j].y * rstd * gg.y); o.y = pk2(v[j].z * rstd * gg.z, v[j].w * rstd * gg.w); o8[64 * j] = o; }
}
__device__ __forceinline__ void p0_prologue(const Params& P, LAS unsigned char* lds, float* dout_scratch) {
    const int tid = pg8::mk_tid(lds), lane = tid & 63, wave = tid >> 6, G = gridDim.x;
    LAS float* scr = (LAS float*)(lds + wave * 16384);
    const int gw = blockIdx.x * NWAVES + wave, NGW = G * NWAVES;
    unsigned char* ws = P.ws; unsigned char* dob = (unsigned char*)P.out;
    bf16* WIN_T = (bf16*)(dob + DO_WIN); bf16* WCAT_T = (bf16*)(ws + WS_WCAT); bf16* WOUT_T = (bf16*)(ws + WS_WOUT); bf16* WXKV_T = (bf16*)(ws + WS_WXKV);
    constexpr int I_IN = 32 * (NIN / 32), I_A = 12 * 64, I_R = 12 * 64, I_X = 8 * 64, I_O = 32 * 64, I_KV = 32 * 32;
    constexpr int NITEMS = I_IN + I_A + I_R + I_X + I_O + I_KV;
    for (int it = gw; it < NITEMS; it += NGW) {
        int r = it;
        if (r < I_IN) { transpose_item(P.in[4], NIN, WIN_T, DM, 0, scr, r, lane); continue; } r -= I_IN;
        if (r < I_A) { transpose_item(P.in[9], DM, WCAT_T, DM, 0, scr, r, lane); continue; } r -= I_A;
        if (r < I_R) { transpose_item(P.in[20], DM, WCAT_T, DM, 768, scr, r, lane); continue; } r -= I_R;
        if (r < I_X) { transpose_item(P.in[24], DM, WCAT_T, DM, 1536, scr, r, lane); continue; } r -= I_X;
        if (r < I_O) { transpose_item(P.in[25], DM, WOUT_T, DM, 0, scr, r, lane); continue; } r -= I_O;
        transpose_item(P.in[21], 1024, WXKV_T, DM, 0, scr, r, lane);
    }
    bf16* H = (bf16*)(dob + DO_H); bf16* MEMN = (bf16*)(ws + WS_MEMN);
    for (int m = gw; m < M_TOK + MEMROWS; m += NGW) {
        if (m < M_TOK) rms_row_to_bf16(P.in[0] + (size_t)m * DM, P.in[2], H + (size_t)m * DM, lane);
        else rms_row_to_bf16(P.in[1] + (size_t)(m - M_TOK) * DM, P.in[3], MEMN + (size_t)(m - M_TOK) * DM, lane);
    }
    if (blockIdx.x == 0 && tid == 0) __hip_atomic_store((unsigned*)(ws + WS_CTR), 0u, __ATOMIC_RELAXED, __HIP_MEMORY_SCOPE_AGENT);
    bf16* LB = (bf16*)(ws + WS_LORAB);
    const int gt = blockIdx.x * NTHREADS + tid, NGT = G * NTHREADS;
    for (int idx = gt; idx < NLORA * 256; idx += NGT) {
        const int n = idx >> 8, k = idx & 255, d = n / RW, ch = n % RW, kb = k >> 6, kk = k & 63;
        float v = 0.f;
        if (kb == d) v = (d < 2) ? P.in[15][(size_t)(d * 64 + kk) * RW + ch] : P.in[17][(size_t)((d - 2) * 64 + kk) * RW + ch];
        LB[idx] = (bf16)f2bf(v);
    }
    float* RC = (float*)(ws + WS_ROPE); float* RS = RC + SEQ * 32;
    for (int idx = gt; idx < SEQ * 32; idx += NGT) {
        const int pos = idx >> 5, i = idx & 31;
        const float inv = __builtin_exp2f(-(float)i * (13.287712379549449f / 32.f));
        const float ang = (float)pos * inv;
        double rv = (double)ang * 0.15915494309189535; rv -= __builtin_floor(rv);
        const float r = (float)rv;
        RC[idx] = __builtin_amdgcn_cosf(r); RS[idx] = __builtin_amdgcn_sinf(r);
    }
}

__device__ __forceinline__ void p2_lora_in(const Params& P, LAS unsigned char* lds) {
    const bf16* PRE = (const bf16*)(P.ws + WS_PRE); bf16* LIN = (bf16*)((unsigned char*)P.out + DO_LIN); const float* mu = P.in[10];
    const int gt = blockIdx.x * NTHREADS + pg8::mk_tid(lds), NGT = gridDim.x * NTHREADS;
    for (int idx = gt; idx < M_TOK * 32; idx += NGT) {
        const int m = idx >> 5, j = (idx & 31) * 8, t = m & (SEQ - 1);
        const bf16* p = PRE + (size_t)m * NPRE + C_LORA + j;
        const v4u z4 = (v4u){0u, 0u, 0u, 0u};
        const v4u c = *(const v4u*)p, pv = (t > 0) ? *(const v4u*)(p - NPRE) : z4, nx = (t < SEQ - 1) ? *(const v4u*)(p + NPRE) : z4;
        const f32x4 m0 = *(const f32x4*)(mu + 2304 + j), m1 = *(const f32x4*)(mu + 2304 + j + 4);
        float xc[8], xp[8], xn[8], s[8]; unpack8(c, xc); unpack8(pv, xp); unpack8(nx, xn);
#pragma unroll
        for (int i = 0; i < 8; ++i) { const float mm = (i < 4) ? m0[i & 3] : m1[i & 3]; s[i] = xc[i] + mm * (0.5f * (xp[i] + xn[i]) - xc[i]);
            if (j < 128) s[i] = 1.f - 2.f * __builtin_amdgcn_rcpf(__expf(2.f * s[i]) + 1.f); }
        v4u o; o.x = pk2(s[0], s[1]); o.y = pk2(s[2], s[3]); o.z = pk2(s[4], s[5]); o.w = pk2(s[6], s[7]);
        *(v4u*)(LIN + (size_t)m * 256 + j) = o;
    }
}

constexpr int SC_CH = 32, SC_REC = 1536, SC_BUF = SC_CH * SC_REC, SC_SCAL = 2 * SC_BUF;
template <int MODE> __device__ __forceinline__ void scan_block(const Params& P, int sid, LAS unsigned char* lds) {
    const int tid = pg8::mk_tid(lds), lane = tid & 63, wave = __builtin_amdgcn_readfirstlane(tid >> 6);
    const int b = sid / 24, rem = sid % 24, h = rem >> 1, dir = rem & 1;
    const bf16* PRE = (const bf16*)(P.ws + WS_PRE); const bf16* EA = (const bf16*)((unsigned char*)P.out + DO_EA);
    bf16* YO = dir ? (bf16*)(P.ws + WS_YB) : (bf16*)((unsigned char*)P.out + DO_YF);
    constexpr int NCH = SEQ / SC_CH;
#define SC_BAR() do { asm volatile("s_waitcnt lgkmcnt(0)" ::: "memory"); __builtin_amdgcn_s_barrier(); asm volatile("" ::: "memory"); } while (0)
    if (wave >= 4) {
        const int pt = tid - 256, sl = pt >> 3, e = pt & 7, ch0 = h * 64 + 8 * e;
        float mur[8], muk[8], muv[8], kkc[8], kac[8];
#pragma unroll
        for (int i = 0; i < 8; ++i) { mur[i] = P.in[10][ch0 + i]; muk[i] = P.in[10][768 + ch0 + i]; muv[i] = P.in[10][1536 + ch0 + i]; kkc[i] = P.in[11][ch0 + i]; kac[i] = P.in[12][ch0 + i]; }
        v4u rc, kc, vc, rp, kp, vp, rn, kn, vn, e8, a8;
        const v4u z4 = (v4u){0u, 0u, 0u, 0u};
#define SC_PLOAD(c_) do { const int step_ = (c_) * SC_CH + sl, t_ = dir ? (SEQ - 1 - step_) : step_; const size_t m_ = (size_t)b * SEQ + t_; \
            const bf16* rowp_ = PRE + m_ * NPRE + C_RS + ch0; \
            rc = *(const v4u*)(rowp_); kc = *(const v4u*)(rowp_ + 768); vc = *(const v4u*)(rowp_ + 1536); \
            rp = (t_ > 0) ? *(const v4u*)(rowp_ - NPRE) : z4; kp = (t_ > 0) ? *(const v4u*)(rowp_ - NPRE + 768) : z4; vp = (t_ > 0) ? *(const v4u*)(rowp_ - NPRE + 1536) : z4; \
            rn = (t_ < SEQ - 1) ? *(const v4u*)(rowp_ + NPRE) : z4; kn = (t_ < SEQ - 1) ? *(const v4u*)(rowp_ + NPRE + 768) : z4; vn = (t_ < SEQ - 1) ? *(const v4u*)(rowp_ + NPRE + 1536) : z4; \
            const bf16* eap_ = EA + m_ * NLORA + dir * RW + ch0; e8 = *(const v4u*)(eap_); a8 = *(const v4u*)(eap_ + 1536); } while (0)
#define SC_PWRITE(c_) do { LAS unsigned char* buf_ = lds + ((c_) & 1) * SC_BUF; LAS float* scal_ = (LAS float*)(lds + SC_SCAL) + ((c_) & 1) * (SC_CH * 2); \
            float r[8], k[8], v[8], x0[8], x1[8], x2[8]; \
            unpack8(rc, x0); unpack8(rp, x1); unpack8(rn, x2); \
            _Pragma("unroll") for (int i = 0; i < 8; ++i) r[i] = x0[i] + mur[i] * (0.5f * (x1[i] + x2[i]) - x0[i]); \
            unpack8(kc, x0); unpack8(kp, x1); unpack8(kn, x2); \
            _Pragma("unroll") for (int i = 0; i < 8; ++i) k[i] = x0[i] + muk[i] * (0.5f * (x1[i] + x2[i]) - x0[i]); \
            unpack8(vc, x0); unpack8(vp, x1); unpack8(vn, x2); \
            _Pragma("unroll") for (int i = 0; i < 8; ++i) v[i] = x0[i] + muv[i] * (0.5f * (x1[i] + x2[i]) - x0[i]); \
            float ee[8], aa[8]; unpack8(e8, ee); unpack8(a8, aa); \
            float kk[8], ss = 0.f; \
            _Pragma("unroll") for (int i = 0; i < 8; ++i) { kk[i] = k[i] * kkc[i]; ss += kk[i] * kk[i]; } \
            ss = red8(ss); \
            const float inv = 1.f / fmaxf(sqrtf(ss), 1e-12f); \
            float nkk[8], dd[8], dr[8], bb[8], kd[8], sbr = 0.f, skr = 0.f; \
            _Pragma("unroll") for (int i = 0; i < 8; ++i) { \
                const float kki = kk[i] * inv; nkk[i] = -kki; dd[i] = __expf(-ee[i]); dr[i] = dd[i] * r[i]; \
                bb[i] = kki * aa[i]; kd[i] = k[i] * (1.f + (aa[i] - 1.f) * kac[i]); sbr += bb[i] * r[i]; skr += kd[i] * r[i]; } \
            sbr = red8(sbr); skr = red8(skr); \
            LAS float* rec = (LAS float*)(buf_ + sl * SC_REC) + 8 * e; \
            *(LAS f32x4*)(rec) = (f32x4){nkk[0], nkk[1], nkk[2], nkk[3]}; *(LAS f32x4*)(rec + 4) = (f32x4){nkk[4], nkk[5], nkk[6], nkk[7]}; \
            *(LAS f32x4*)(rec + 64) = (f32x4){dr[0], dr[1], dr[2], dr[3]}; *(LAS f32x4*)(rec + 68) = (f32x4){dr[4], dr[5], dr[6], dr[7]}; \
            *(LAS f32x4*)(rec + 128) = (f32x4){dd[0], dd[1], dd[2], dd[3]}; *(LAS f32x4*)(rec + 132) = (f32x4){dd[4], dd[5], dd[6], dd[7]}; \
            *(LAS f32x4*)(rec + 192) = (f32x4){bb[0], bb[1], bb[2], bb[3]}; *(LAS f32x4*)(rec + 196) = (f32x4){bb[4], bb[5], bb[6], bb[7]}; \
            *(LAS f32x4*)(rec + 256) = (f32x4){kd[0], kd[1], kd[2], kd[3]}; *(LAS f32x4*)(rec + 260) = (f32x4){kd[4], kd[5], kd[6], kd[7]}; \
            *(LAS f32x4*)(rec + 320) = (f32x4){v[0], v[1], v[2], v[3]}; *(LAS f32x4*)(rec + 324) = (f32x4){v[4], v[5], v[6], v[7]}; \
            if (e == 0) *(LAS f32x2*)(scal_ + 2 * sl) = (f32x2){sbr, skr}; } while (0)
        if (!(MODE & 2)) { SC_PLOAD(0); SC_PWRITE(0); SC_PLOAD(1); }
        SC_BAR();
        for (int c = 0; c < NCH; ++c) {
            if (!(MODE & 2)) { if (c + 1 < NCH) SC_PWRITE(c + 1);
            if (c + 2 < NCH) SC_PLOAD(c + 2); }
            SC_BAR();
        }
#undef SC_PLOAD
#undef SC_PWRITE
    } else {
        const int rp = (wave * 64 + lane) >> 3, cgp = lane & 7;
        f32x2 s0[4], s1[4];
#pragma unroll
        for (int i = 0; i < 4; ++i) { s0[i] = (f32x2){0.f, 0.f}; s1[i] = (f32x2){0.f, 0.f}; }
        bf16* yrow = YO + (size_t)b * SEQ * RW + h * 64 + 2 * rp;
        SC_BAR();
#define SC_LOAD(N0, N1, Q0, Q1, D0, D1, B0, B1, K0, K1, VV, SS, sl_) do { const LAS float* rec_ = (const LAS float*)(buf + (sl_) * SC_REC) + 8 * cgp; \
            N0 = *(const LAS f32x4*)(rec_); N1 = *(const LAS f32x4*)(rec_ + 4); Q0 = *(const LAS f32x4*)(rec_ + 64); Q1 = *(const LAS f32x4*)(rec_ + 68); \
            D0 = *(const LAS f32x4*)(rec_ + 128); D1 = *(const LAS f32x4*)(rec_ + 132); B0 = *(const LAS f32x4*)(rec_ + 192); B1 = *(const LAS f32x4*)(rec_ + 196); \
            K0 = *(const LAS f32x4*)(rec_ + 256); K1 = *(const LAS f32x4*)(rec_ + 260); \
            VV = *(const LAS f32x2*)((const LAS float*)(buf + (sl_) * SC_REC) + 320 + 2 * rp); SS = *(const LAS f32x2*)(scal + 2 * (sl_)); } while (0)
        for (int c = 0; c < NCH; ++c) {
            const LAS unsigned char* buf = lds + (c & 1) * SC_BUF; const LAS float* scal = (const LAS float*)(lds + SC_SCAL) + (c & 1) * (SC_CH * 2);
            f32x4 n0, n1, q0, q1, d0, d1, b0, b1, k0, k1; f32x2 vv, sc;
            SC_LOAD(n0, n1, q0, q1, d0, d1, b0, b1, k0, k1, vv, sc, 0);
#pragma unroll 2
            for (int sl = 0; sl < SC_CH; ++sl) {
                f32x4 xn0, xn1, xq0, xq1, xd0, xd1, xb0, xb1, xk0, xk1; f32x2 xvv, xsc;
                const int sn = (sl + 1 < SC_CH) ? sl + 1 : sl;
                const f32x2 nk[4] = {(f32x2){n0.x, n0.y}, (f32x2){n0.z, n0.w}, (f32x2){n1.x, n1.y}, (f32x2){n1.z, n1.w}};
                const f32x2 qq[4] = {(f32x2){q0.x, q0.y}, (f32x2){q0.z, q0.w}, (f32x2){q1.x, q1.y}, (f32x2){q1.z, q1.w}};
                const f32x2 dv[4] = {(f32x2){d0.x, d0.y}, (f32x2){d0.z, d0.w}, (f32x2){d1.x, d1.y}, (f32x2){d1.z, d1.w}};
                const f32x2 bv[4] = {(f32x2){b0.x, b0.y}, (f32x2){b0.z, b0.w}, (f32x2){b1.x, b1.y}, (f32x2){b1.z, b1.w}};
                const f32x2 kv[4] = {(f32x2){k0.x, k0.y}, (f32x2){k0.z, k0.w}, (f32x2){k1.x, k1.y}, (f32x2){k1.z, k1.w}};
                f32x2 a0 = s0[0] * nk[0], a1 = s1[0] * nk[0], y0 = s0[0] * qq[0], y1 = s1[0] * qq[0];
#pragma unroll
                for (int i = 1; i < 4; ++i) { a0 = s0[i] * nk[i] + a0; a1 = s1[i] * nk[i] + a1; y0 = s0[i] * qq[i] + y0; y1 = s1[i] * qq[i] + y1; }
                float sa0 = a0.x + a0.y, sa1 = a1.x + a1.y, yp0 = y0.x + y0.y, yp1 = y1.x + y1.y;
                SC_LOAD(xn0, xn1, xq0, xq1, xd0, xd1, xb0, xb1, xk0, xk1, xvv, xsc, sn);
                sa0 = red8(sa0); sa1 = red8(sa1); yp0 = red8(yp0); yp1 = red8(yp1);
                const float yo0 = yp0 + sa0 * sc.x + vv.x * sc.y, yo1 = yp1 + sa1 * sc.x + vv.y * sc.y;
                const f32x2 sa0v = (f32x2){sa0, sa0}, sa1v = (f32x2){sa1, sa1}, v0v = (f32x2){vv.x, vv.x}, v1v = (f32x2){vv.y, vv.y};
#pragma unroll
                for (int i = 0; i < 4; ++i) {
                    f32x2 t0 = v0v * kv[i]; t0 = sa0v * bv[i] + t0; s0[i] = s0[i] * dv[i] + t0;
                    f32x2 t1 = v1v * kv[i]; t1 = sa1v * bv[i] + t1; s1[i] = s1[i] * dv[i] + t1;
                }
                const int step = c * SC_CH + sl, t = dir ? (SEQ - 1 - step) : step;
                const unsigned yw = pk2(yo0, yo1);
                if (!(MODE & 1)) { if (cgp == 0) *(unsigned*)(yrow + (size_t)t * RW) = yw; } else { asm volatile("" :: "v"(yw)); }
                n0 = xn0; n1 = xn1; q0 = xq0; q1 = xq1; d0 = xd0; d1 = xd1; b0 = xb0; b1 = xb1; k0 = xk0; k1 = xk1; vv = xvv; sc = xsc;
            }
            SC_BAR();
        }
#undef SC_LOAD
    }
#undef SC_BAR
    __syncthreads();
}

__device__ __forceinline__ bf16x8 pack8(const float (&x)[8]) {
    v4u w; w.x = pk2(x[0], x[1]); w.y = pk2(x[2], x[3]); w.z = pk2(x[4], x[5]); w.w = pk2(x[6], x[7]); return __builtin_bit_cast(bf16x8, w);
}
#define MFMA16(a, b, c) __builtin_amdgcn_mfma_f32_16x16x32_bf16((a), (b), (c), 0, 0, 0)
constexpr int CK = 16, NCK = SEQ / CK;
constexpr int L_QK = 0, L_PR = 4608, L_QKT = 9216, L_VT = 14336, L_VF = 19456, L_GC = 23552, L_OPSZ = 23808;
constexpr int L_E = 2 * L_OPSZ, L_G = L_E + 4096, L_GSZ = 5120, L_W0 = L_G + 2 * L_GSZ, L_VG = L_W0 + 4096, L_SB = L_VG + 2 * 4096, L_CEND = L_SB + 9216;
static_assert(L_CEND + 1280 <= 131072, "chunked scan LDS map");
#ifdef CBAR_FULL
#define CBAR() __syncthreads()
#else
#define CBAR() do { __builtin_amdgcn_s_waitcnt(0xC07F); __builtin_amdgcn_s_barrier(); } while (0)
#endif
__device__ __forceinline__ void scan_chunked(const Params& P, int sid, LAS unsigned char* lds) {
    const int tid = pg8::mk_tid(lds), lane = tid & 63, wave = __builtin_amdgcn_readfirstlane(tid >> 6), l15 = lane & 15, q4 = lane >> 4;
    const int b = sid / 24, rem = sid % 24, h = rem >> 1, dir = rem & 1;
    const bf16* PRE = (const bf16*)(P.ws + WS_PRE); const bf16* EA = (const bf16*)((unsigned char*)P.out + DO_EA);
    bf16* YO = dir ? (bf16*)(P.ws + WS_YB) : (bf16*)((unsigned char*)P.out + DO_YF);
#ifdef YZERO
    for (int it = tid; it < SEQ * 8; it += NTHREADS) *(v4u*)(YO + ((size_t)b * SEQ + (it >> 3)) * RW + h * 64 + (it & 7) * 8) = (v4u){0u, 0u, 0u, 0u};
#endif
    for (int i = tid; i < 9216 / 4; i += NTHREADS) ((LAS unsigned*)(lds + L_SB))[i] = 0u;
    for (int i = tid; i < L_SB / 4; i += NTHREADS) ((LAS unsigned*)(lds))[i] = 0u;
    if (tid < 320) { const int vsel = tid >> 6, chn = h * 64 + (tid & 63);
        ((LAS float*)(lds + L_CEND))[tid] = (vsel < 3) ? P.in[10][vsel * 768 + chn] : ((vsel == 3) ? P.in[11][chn] : P.in[12][chn]); }
    CBAR();
    if (wave >= 4) {
        const int pt = tid - 256, t = pt >> 4, e = pt & 15, ch0 = h * 64 + 4 * e, gsw = 8 * ((e >> 1) & 3);
        const LAS float* cst = (const LAS float*)(lds + L_CEND) + 4 * e;
        v2u rcA, kcA, vcA, rpA, kpA, vpA, rnA, knA, vnA, e8A, a8A, rcB, kcB, vcB, rpB, kpB, vpB, rnB, knB, vnB, e8B, a8B;
        const v2u z2 = (v2u){0u, 0u};
#define CK_PLOAD(X, c_) do { const int step_ = (c_) * CK + t, t_ = dir ? (SEQ - 1 - step_) : step_; const size_t m_ = (size_t)b * SEQ + t_; \
            const bf16* rowp_ = PRE + m_ * NPRE + C_RS + ch0; \
            const bf16* rowq_ = (t_ > 0) ? rowp_ - NPRE : rowp_; const bf16* rown_ = (t_ < SEQ - 1) ? rowp_ + NPRE : rowp_;     \
            rc##X = *(const v2u*)(rowp_); kc##X = *(const v2u*)(rowp_ + 768); vc##X = *(const v2u*)(rowp_ + 1536); \
            rp##X = *(const v2u*)(rowq_); kp##X = *(const v2u*)(rowq_ + 768); vp##X = *(const v2u*)(rowq_ + 1536); \
            rn##X = *(const v2u*)(rown_); kn##X = *(const v2u*)(rown_ + 768); vn##X = *(const v2u*)(rown_ + 1536); \
            const bf16* eap_ = EA + m_ * NLORA + dir * RW + ch0; e8##X = *(const v2u*)(eap_); a8##X = *(const v2u*)(eap_ + 1536); } while (0)
        CK_PLOAD(A, 0); CK_PLOAD(B, 1);
        float r[4], k[4], v[4], kk[4], aa[4], ee[4];
#define CK_PBODY(X, c_) do { const int c = (c_); const int pb = (c & 1) * L_OPSZ; \
            {   \
                float x0[4], x1[4], x2[4]; f32x4 cc; \
                const int stepc_ = ((c < NCK) ? c : NCK - 1) * CK + t, tc_ = dir ? (SEQ - 1 - stepc_) : stepc_; const float fp_ = (tc_ > 0) ? 1.f : 0.f, fn_ = (tc_ < SEQ - 1) ? 1.f : 0.f; \
                unpack4(rc##X, x0); unpack4(rp##X, x1); unpack4(rn##X, x2); cc = *(const LAS f32x4*)(cst); \
                _Pragma("unroll") for (int i = 0; i < 4; ++i) r[i] = x0[i] + cc[i] * (0.5f * (fp_ * x1[i] + fn_ * x2[i]) - x0[i]); \
                unpack4(kc##X, x0); unpack4(kp##X, x1); unpack4(kn##X, x2); cc = *(const LAS f32x4*)(cst + 64); \
                _Pragma("unroll") for (int i = 0; i < 4; ++i) k[i] = x0[i] + cc[i] * (0.5f * (fp_ * x1[i] + fn_ * x2[i]) - x0[i]); \
                unpack4(vc##X, x0); unpack4(vp##X, x1); unpack4(vn##X, x2); cc = *(const LAS f32x4*)(cst + 128); \
                _Pragma("unroll") for (int i = 0; i < 4; ++i) v[i] = x0[i] + cc[i] * (0.5f * (fp_ * x1[i] + fn_ * x2[i]) - x0[i]); \
                unpack4(e8##X, ee); unpack4(a8##X, aa); cc = *(const LAS f32x4*)(cst + 192); \
                float ss = 0.f; \
                _Pragma("unroll") for (int i = 0; i < 4; ++i) { kk[i] = k[i] * cc[i]; ss += kk[i] * kk[i]; } \
                ss = red8(ss); ss = dpp_add<0x140>(ss); \
                const float inv = __builtin_amdgcn_rcpf(fmaxf(__builtin_amdgcn_sqrtf(ss), 1e-12f)); \
                _Pragma("unroll") for (int i = 0; i < 4; ++i) kk[i] *= inv; \
                *(LAS f32x4*)((LAS float*)(lds + L_E) + t * 64 + 4 * e) = (f32x4){ee[0], ee[1], ee[2], ee[3]}; \
                CK_PLOAD(X, (c + 2 < NCK) ? c + 2 : NCK - 1); \
            } \
            CBAR(); \
            { \
                f32x4 gs = (f32x4){0.f, 0.f, 0.f, 0.f}; \
                _Pragma("unroll") for (int u = 0; u < CK; ++u) { \
                    const f32x4 ea = *(const LAS f32x4*)((const LAS float*)(lds + L_E) + u * 64 + 4 * e); \
                    const float m = (u <= t) ? 1.f : 0.f; gs += m * ea; } \
                const f32x4 kac = *(const LAS f32x4*)(cst + 256); \
                float qv[4], kt[4], pv[4], rt[4], gin[4]; \
                _Pragma("unroll") for (int i = 0; i < 4; ++i) { \
                    gin[i] = __expf(-gs[i]); const float gex = __expf(ee[i] - gs[i]), ginv = __expf(gs[i]); \
                    const float kd = k[i] * (1.f + (aa[i] - 1.f) * kac[i]); \
                    qv[i] = kk[i] * aa[i] * ginv; kt[i] = kd * ginv; pv[i] = kk[i] * gex; rt[i] = r[i] * gin[i]; \
                } \
                LAS unsigned char* ob = lds + pb; \
                unsigned wq[4]; v2u o; \
                _Pragma("unroll") for (int i = 0; i < 4; ++i) wq[i] = pk2(qv[i], kt[i]);                        \
                o.x = (wq[0] & 0xffffu) | (wq[1] << 16); o.y = (wq[2] & 0xffffu) | (wq[3] << 16); *(LAS v2u*)(ob + L_QK + (t * 72 + 4 * e) * 2) = o; \
                o.x = (wq[0] >> 16) | (wq[1] & 0xffff0000u); o.y = (wq[2] >> 16) | (wq[3] & 0xffff0000u); *(LAS v2u*)(ob + L_QK + ((16 + t) * 72 + 4 * e) * 2) = o; \
                o.x = pk2(pv[0], pv[1]); o.y = pk2(pv[2], pv[3]); *(LAS v2u*)(ob + L_PR + (t * 72 + 4 * e) * 2) = o; \
                o.x = pk2(rt[0], rt[1]); o.y = pk2(rt[2], rt[3]); *(LAS v2u*)(ob + L_PR + ((16 + t) * 72 + 4 * e) * 2) = o; \
                const unsigned wv01 = pk2(v[0], v[1]), wv23 = pk2(v[2], v[3]); \
                _Pragma("unroll") for (int i = 0; i < 4; ++i) { \
                    *(LAS bf16*)(ob + L_QKT + ((4 * e + i) * 40 + (t ^ gsw)) * 2) = (bf16)(wq[i] & 0xffffu); *(LAS bf16*)(ob + L_QKT + ((4 * e + i) * 40 + ((16 + t) ^ gsw)) * 2) = (bf16)(wq[i] >> 16); \
                    const unsigned wv = (i < 2) ? wv01 : wv23; \
                    *(LAS bf16*)(ob + L_VT + ((4 * e + i) * 40 + ((16 + t) ^ gsw)) * 2) = (bf16)((i & 1) ? (wv >> 16) : (wv & 0xffffu)); \
                } \
                if (t == CK - 1) *(LAS f32x4*)((LAS float*)(ob + L_GC) + 4 * e) = (f32x4){gin[0], gin[1], gin[2], gin[3]}; \
            } \
            CBAR(); \
            CBAR(); } while (0)
        static_assert((NCK + 2) % 2 == 0, "producer loop is unrolled by two");
        for (int c2 = 0; c2 <= NCK + 1; c2 += 2) { CK_PBODY(A, c2); CK_PBODY(B, c2 + 1); }
#undef CK_PBODY
#undef CK_PLOAD
    } else {
        const int w = wave;
        f32x4 acc[4];
#pragma unroll
        for (int nt = 0; nt < 4; ++nt) acc[nt] = (f32x4){0.f, 0.f, 0.f, 0.f};
        bf16* ybase = YO + (size_t)b * SEQ * RW + h * 64 + 16 * w + 4 * q4;
        for (int c = 0; c <= NCK + 1; ++c) {
            const int ck = c - 1; const bool valid = (ck >= 0 && ck < NCK);
            const int pb = (ck & 1) * L_OPSZ, gb = L_G + (ck & 1) * L_GSZ;
            f32x4 r1 = (f32x4){0.f, 0.f, 0.f, 0.f};
            if (valid) {
                f32x4 r0 = (f32x4){0.f, 0.f, 0.f, 0.f};
#pragma unroll
                for (int ks = 0; ks < 2; ++ks) {
                    const bf16x8 S = *(const LAS bf16x8*)(lds + L_SB + ((16 * w + l15) * 72 + ks * 32 + 8 * q4) * 2);
                    const bf16x8 Bp = *(const LAS bf16x8*)(lds + pb + L_PR + ((l15) * 72 + ks * 32 + 8 * q4) * 2);
                    const bf16x8 Br = *(const LAS bf16x8*)(lds + pb + L_PR + ((16 + l15) * 72 + ks * 32 + 8 * q4) * 2);
                    r0 = MFMA16(S, Bp, r0); r1 = MFMA16(S, Br, r1);
                }
                *(LAS f32x4*)(lds + L_W0 + (l15 * 64 + 16 * w + 4 * q4) * 4) = r0;
            }
            if (valid && w == 1) {
#pragma unroll
                for (int x = 0; x < 4; ++x) {
                    const int a = x >> 1, bc = x & 1;
                    f32x4 g = (f32x4){0.f, 0.f, 0.f, 0.f};
#pragma unroll
                    for (int ks = 0; ks < 2; ++ks) {
                        const bf16x8 A = *(const LAS bf16x8*)(lds + pb + L_QK + ((a * 16 + l15) * 72 + ks * 32 + 8 * q4) * 2);
                        const bf16x8 Bm = *(const LAS bf16x8*)(lds + pb + L_PR + ((bc * 16 + l15) * 72 + ks * 32 + 8 * q4) * 2);
                        g = MFMA16(A, Bm, g);
                    }
                    *(LAS f32x4*)(lds + gb + x * 1280 + (l15 * 20 + 4 * q4) * 4) = g;
                }
                __builtin_amdgcn_s_waitcnt(0xC07F);
                float bw[8];
                {
                    const f32x4 ga = *(const LAS f32x4*)(lds + gb + 2 * 1280 + (l15 * 20 + 8 * (q4 & 1)) * 4), gb2 = *(const LAS f32x4*)(lds + gb + 2 * 1280 + (l15 * 20 + 8 * (q4 & 1) + 4) * 4);
#pragma unroll
                    for (int ii = 0; ii < 8; ++ii) { const int s = 8 * (q4 & 1) + ii; const float gv = (ii < 4) ? ga[ii & 3] : gb2[ii & 3]; bw[ii] = (q4 >= 2 && s < l15) ? gv : 0.f; }
                }
                const bf16x8 Bf = pack8(bw);
#pragma unroll
                for (int mt = 0; mt < 4; ++mt) {
                    const bf16x8 Av = *(const LAS bf16x8*)(lds + pb + L_VT + ((mt * 16 + l15) * 40 + 8 * (q4 ^ (((mt * 16 + l15) >> 3) & 3))) * 2);
                    f32x4 r = (f32x4){0.f, 0.f, 0.f, 0.f};
                    r = MFMA16(Av, Bf, r);
                    *(LAS f32x4*)(lds + L_VG + (ck & 1) * 4096 + (l15 * 64 + mt * 16 + 4 * q4) * 4) = r;
                }
            }
            CBAR();
            if (valid && w == 0) {
                const int i = lane;
                float u[16];
#pragma unroll
                for (int s = 0; s < 16; ++s) u[s] = *(const LAS float*)(lds + L_W0 + (s * 64 + i) * 4) + *(const LAS float*)(lds + L_VG + (ck & 1) * 4096 + (s * 64 + i) * 4);
#pragma unroll
                for (int blk = 0; blk < 4; ++blk) {
                    f32x4 gq[4][4];
#pragma unroll
                    for (int tt = 0; tt < 4; ++tt)
#pragma unroll
                        for (int s4 = 0; s4 <= blk; ++s4) gq[tt][s4] = *(const LAS f32x4*)(lds + gb + 0 * 1280 + ((4 * blk + tt) * 20 + 4 * s4) * 4);
#pragma unroll
                    for (int s = 0; s < 4 * blk; ++s)
#pragma unroll
                        for (int tt = 0; tt < 4; ++tt) u[4 * blk + tt] -= gq[tt][s >> 2][s & 3] * u[s];
#pragma unroll
                    for (int tt = 1; tt < 4; ++tt)
#pragma unroll
                        for (int sp = 0; sp < tt; ++sp) u[4 * blk + tt] -= gq[tt][blk][sp] * u[4 * blk + sp];
                    __builtin_amdgcn_sched_barrier(0);
                }
                float n0[8], n1[8];
#pragma unroll
                for (int s = 0; s < 8; ++s) { n0[s] = -u[s]; n1[s] = -u[8 + s]; }
                *(LAS bf16x8*)(lds + pb + L_VT + (i * 40 + 8 * (0 ^ ((i >> 3) & 3))) * 2) = pack8(n0); *(LAS bf16x8*)(lds + pb + L_VT + (i * 40 + 8 * (1 ^ ((i >> 3) & 3))) * 2) = pack8(n1);
            }
            CBAR();
            if (valid) {
                const bf16x8 Bv = *(const LAS bf16x8*)(lds + pb + L_VT + ((16 * w + l15) * 40 + 8 * (q4 ^ (((16 * w + l15) >> 3) & 3))) * 2);
                {
                    const int xo = (q4 < 2) ? 1 : 3;
                    const f32x4 ga = *(const LAS f32x4*)(lds + gb + xo * 1280 + (l15 * 20 + 8 * (q4 & 1)) * 4), gb2 = *(const LAS f32x4*)(lds + gb + xo * 1280 + (l15 * 20 + 8 * (q4 & 1) + 4) * 4);
                    float bw[8];
#pragma unroll
                    for (int ii = 0; ii < 8; ++ii) { const int s = 8 * (q4 & 1) + ii; const float gv = (ii < 4) ? ga[ii & 3] : gb2[ii & 3]; bw[ii] = (s <= l15) ? gv : 0.f; }
                    const f32x4 y = MFMA16(Bv, pack8(bw), r1);
                    const int step = ck * CK + l15, tt = dir ? (SEQ - 1 - step) : step;
                    v2u o; o.x = pk2(y[0], y[1]); o.y = pk2(y[2], y[3]);
                    *(v2u*)(ybase + (size_t)tt * RW) = o;
                }
#pragma unroll
                for (int nt = 0; nt < 4; ++nt) {
                    const bf16x8 Aq = *(const LAS bf16x8*)(lds + pb + L_QKT + ((nt * 16 + l15) * 40 + 8 * (q4 ^ (((nt * 16 + l15) >> 3) & 3))) * 2);
                    acc[nt] = MFMA16(Aq, Bv, acc[nt]);
                    const f32x4 gc = *(const LAS f32x4*)(lds + pb + L_GC + (nt * 16 + 4 * q4) * 4);
                    acc[nt] = acc[nt] * gc;
                    v2u o; o.x = pk2(acc[nt][0], acc[nt][1]); o.y = pk2(acc[nt][2], acc[nt][3]);
                    *(LAS v2u*)(lds + L_SB + ((16 * w + l15) * 72 + nt * 16 + 4 * q4) * 2) = o;
                }
            }
            CBAR();
        }
    }
    __syncthreads();
}
#undef CBAR

constexpr int KA_P = 72, VA_P = 392;
__device__ __forceinline__ void attnA_item(const Params& P, int item, LAS unsigned char* lds) {
    const int tid = pg8::mk_tid(lds), lane = tid & 63, wave = __builtin_amdgcn_readfirstlane(tid >> 6), l15 = lane & 15, q4 = lane >> 4;
    const int b = item >> 6, n = (item >> 2) & 15, hk = item & 3;
    const bf16* PRE = (const bf16*)(P.ws + WS_PRE); bf16* YC = (bf16*)(P.ws + WS_YCAT);
    const float* RC = (const float*)(P.ws + WS_ROPE); const float* RS = RC + SEQ * 32;
    LAS bf16* Ks = (LAS bf16*)lds; LAS bf16* Vt = Ks + 384 * KA_P;
    {
        v2u klo[6], khi[6]; f32x4 kcs[6], ksn[6]; v4u vw[6];
#pragma unroll
        for (int u = 0; u < 6; ++u) {
            const int it = tid + u * NTHREADS, j = it >> 3, c = it & 7, kp = (n - 1) * 128 + j;
            const bool ok = (kp >= 0 && kp < SEQ); const int kpc = ok ? kp : 0;
            const bf16* src = PRE + ((size_t)b * SEQ + kpc) * NPRE + C_AK + hk * 64;
            klo[u] = *(const v2u*)(src + 4 * c); khi[u] = *(const v2u*)(src + 32 + 4 * c);
            kcs[u] = *(const f32x4*)(RC + kpc * 32 + 4 * c); ksn[u] = *(const f32x4*)(RS + kpc * 32 + 4 * c);
            vw[u] = *(const v4u*)(PRE + ((size_t)b * SEQ + kpc) * NPRE + C_AV + hk * 64 + 8 * c);
        }
        const f32x4 g1 = *(const f32x4*)(P.in[7] + 4 * (tid & 7)), g2 = *(const f32x4*)(P.in[7] + 32 + 4 * (tid & 7));
#pragma unroll
        for (int u = 0; u < 6; ++u) {
            const int it = tid + u * NTHREADS, j = it >> 3, c = it & 7, kp = (n - 1) * 128 + j;
            const bool ok = (kp >= 0 && kp < SEQ);
            float x1[4], x2[4]; unpack4(klo[u], x1); unpack4(khi[u], x2);
            float ss = 0.f;
#pragma unroll
            for (int i = 0; i < 4; ++i) ss += x1[i] * x1[i] + x2[i] * x2[i];
            ss = red8(ss);
            const float rstd = ok ? 1.f / sqrtf(ss * (1.f / 64.f) + NORM_EPS) : 0.f;
            float r1[4], r2[4];
#pragma unroll
            for (int i = 0; i < 4; ++i) { const float y1 = x1[i] * rstd * g1[i], y2 = x2[i] * rstd * g2[i]; r1[i] = y1 * kcs[u][i] - y2 * ksn[u][i]; r2[i] = y2 * kcs[u][i] + y1 * ksn[u][i]; }
            v2u o0, o1; o0.x = pk2(r1[0], r1[1]); o0.y = pk2(r1[2], r1[3]); o1.x = pk2(r2[0], r2[1]); o1.y = pk2(r2[2], r2[3]);
            *(LAS v2u*)(Ks + j * KA_P + 4 * c) = o0; *(LAS v2u*)(Ks + j * KA_P + 32 + 4 * c) = o1;
            const v4u w = ok ? vw[u] : (v4u){0u, 0u, 0u, 0u};
            LAS bf16* d = Vt + (8 * c) * VA_P + j;
            d[0] = (bf16)(w.x & 0xffffu); d[VA_P] = (bf16)(w.x >> 16); d[2 * VA_P] = (bf16)(w.y & 0xffffu); d[3 * VA_P] = (bf16)(w.y >> 16);
            d[4 * VA_P] = (bf16)(w.z & 0xffffu); d[5 * VA_P] = (bf16)(w.z >> 16); d[6 * VA_P] = (bf16)(w.w & 0xffffu); d[7 * VA_P] = (bf16)(w.w >> 16);
        }
    }
    v4u qlo, qhi;
    {
        const int R0 = wave * 48, g = R0 >> 7, pos = (R0 & 127) + l15, qp = n * 128 + pos, hq = hk * 3 + g;
        const bf16* src = PRE + ((size_t)b * SEQ + qp) * NPRE + C_AQ + hq * 64;
        qlo = *(const v4u*)(src + 8 * q4); qhi = *(const v4u*)(src + 32 + 8 * q4);
    }
    __syncthreads();
#pragma unroll 1
    for (int mt = 0; mt < 3; ++mt) {
        const int R0 = wave * 48 + mt * 16, g = R0 >> 7, pos = (R0 & 127) + l15, qp = n * 128 + pos, hq = hk * 3 + g;
        const size_t m = (size_t)b * SEQ + qp;
        v2u gat[4];
#pragma unroll
        for (int dt = 0; dt < 4; ++dt) gat[dt] = *(const v2u*)(PRE + m * NPRE + C_AG + hq * 64 + dt * 16 + 4 * q4);
        const v4u cqlo = qlo, cqhi = qhi;
        {
            const int mn = (mt < 2) ? mt + 1 : 2, R1 = wave * 48 + mn * 16, g1_ = R1 >> 7, pos1 = (R1 & 127) + l15, qp1 = n * 128 + pos1, hq1 = hk * 3 + g1_;
            const bf16* src = PRE + ((size_t)b * SEQ + qp1) * NPRE + C_AQ + hq1 * 64;
            qlo = *(const v4u*)(src + 8 * q4); qhi = *(const v4u*)(src + 32 + 8 * q4);
        }
        bf16x8 qf0, qf1;
        {
            float x1[8], x2[8]; unpack8(cqlo, x1); unpack8(cqhi, x2);
            float ss = 0.f;
#pragma unroll
            for (int i = 0; i < 8; ++i) ss += x1[i] * x1[i] + x2[i] * x2[i];
            ss += __shfl_xor(ss, 16); ss += __shfl_xor(ss, 32);
            const float rstd = (0.125f * 1.4426950408889634f) / sqrtf(ss * (1.f / 64.f) + NORM_EPS);
            float r1[8], r2[8];
            const f32x4 ga = *(const f32x4*)(P.in[6] + 8 * q4), gb = *(const f32x4*)(P.in[6] + 8 * q4 + 4), gc = *(const f32x4*)(P.in[6] + 32 + 8 * q4), gd = *(const f32x4*)(P.in[6] + 36 + 8 * q4);
            const f32x4 ca = *(const f32x4*)(RC + qp * 32 + 8 * q4), cb = *(const f32x4*)(RC + qp * 32 + 8 * q4 + 4), sa_ = *(const f32x4*)(RS + qp * 32 + 8 * q4), sb_ = *(const f32x4*)(RS + qp * 32 + 8 * q4 + 4);
#pragma unroll
            for (int i = 0; i < 8; ++i) {
                const float g1 = (i < 4) ? ga[i & 3] : gb[i & 3], g2 = (i < 4) ? gc[i & 3] : gd[i & 3], cs = (i < 4) ? ca[i & 3] : cb[i & 3], sn = (i < 4) ? sa_[i & 3] : sb_[i & 3];
                const float y1 = x1[i] * rstd * g1, y2 = x2[i] * rstd * g2; r1[i] = y1 * cs - y2 * sn; r2[i] = y2 * cs + y1 * sn;
            }
            qf0 = pack8(r1); qf1 = pack8(r2);
        }
        const int kt0 = (R0 & 127) >> 4;
        const int seq_lo = (n == 0) ? 8 : 0, seq_hi = (n == 15) ? 15 : 23;
        f32x4 acc[18];
#pragma unroll
        for (int u = 0; u < 17; ++u) {
            const LAS bf16* kr = Ks + ((kt0 + u) * 16 + l15) * KA_P + 8 * q4;
            const bf16x8 k0 = *(const LAS bf16x8*)(kr), k1 = *(const LAS bf16x8*)(kr + 32);
            f32x4 a = (f32x4){0.f, 0.f, 0.f, 0.f};
            a = MFMA16(k0, qf0, a); a = MFMA16(k1, qf1, a); acc[u] = a;
        }
        acc[17] = (f32x4){-1e30f, -1e30f, -1e30f, -1e30f};
        const float sink = P.in[8][hq] * 1.4426950408889634f;
        float mx = sink;
#pragma unroll
        for (int u = 0; u < 17; ++u) {
            const bool tv = (kt0 + u >= seq_lo) && (kt0 + u <= seq_hi);
#pragma unroll
            for (int i = 0; i < 4; ++i) {
                bool valid = tv;
                if (u == 0) valid = valid && (4 * q4 + i >= l15);
                if (u == 16) valid = valid && (4 * q4 + i <= l15);
                const float sv = valid ? acc[u][i] : -1e30f; acc[u][i] = sv; mx = fmaxf(mx, sv);
            }
        }
        mx = fmaxf(mx, __shfl_xor(mx, 16)); mx = fmaxf(mx, __shfl_xor(mx, 32));
        float sum = 0.f;
#pragma unroll
        for (int u = 0; u < 17; ++u)
#pragma unroll
            for (int i = 0; i < 4; ++i) { const float p = __builtin_amdgcn_exp2f(acc[u][i] - mx); acc[u][i] = p; sum += p; }
        acc[17] = (f32x4){0.f, 0.f, 0.f, 0.f};
        sum += __shfl_xor(sum, 16); sum += __shfl_xor(sum, 32);
        const float inv = 1.f / (sum + __builtin_amdgcn_exp2f(sink - mx));
        f32x4 o[4];
#pragma unroll
        for (int dt = 0; dt < 4; ++dt) o[dt] = (f32x4){0.f, 0.f, 0.f, 0.f};
#pragma unroll
        for (int k2 = 0; k2 < 9; ++k2) {
            float pp[8] = {acc[2 * k2][0], acc[2 * k2][1], acc[2 * k2][2], acc[2 * k2][3], acc[2 * k2 + 1][0], acc[2 * k2 + 1][1], acc[2 * k2 + 1][2], acc[2 * k2 + 1][3]};
            const bf16x8 pf = pack8(pp);
#pragma unroll
            for (int dt = 0; dt < 4; ++dt) {
                const LAS bf16* vr = Vt + (dt * 16 + l15) * VA_P + kt0 * 16 + k2 * 32 + 4 * q4;
                const v2u v0 = *(const LAS v2u*)(vr);
                v2u v1 = (v2u){0u, 0u};
                if (k2 < 8) v1 = *(const LAS v2u*)(vr + 16);
                const v4u vw = (v4u){v0.x, v0.y, v1.x, v1.y};
                o[dt] = MFMA16(__builtin_bit_cast(bf16x8, vw), pf, o[dt]);
            }
        }
#pragma unroll
        for (int dt = 0; dt < 4; ++dt) {
            const int ch = hq * 64 + dt * 16 + 4 * q4;
            float gg[4]; unpack4(gat[dt], gg);
            v2u w; w.x = pk2(o[dt][0] * inv * gg[0], o[dt][1] * inv * gg[1]); w.y = pk2(o[dt][2] * inv * gg[2], o[dt][3] * inv * gg[3]);
            *(v2u*)(YC + m * DM + ch) = w;
        }
    }
    __syncthreads();
}

constexpr int KC_P = 136, VC_P = 264;
__device__ __forceinline__ void attnC_qblock(const Params& P, const LAS bf16* Ks, const LAS bf16* Vt, bf16* YC, const v4u (&qraw)[4], const v2u (&gat)[8], size_t m, int hx, int l15, int q4) {
    {
        bf16x8 qf[4];
        {
            float x[4][8]; float ss = 0.f;
#pragma unroll
            for (int ks = 0; ks < 4; ++ks) { unpack8(qraw[ks], x[ks]);
#pragma unroll
                for (int i = 0; i < 8; ++i) ss += x[ks][i] * x[ks][i]; }
            ss += __shfl_xor(ss, 16); ss += __shfl_xor(ss, 32);
            const float rstd = (0.08838834764831845f * 1.4426950408889634f) / sqrtf(ss * (1.f / 128.f) + NORM_EPS);
#pragma unroll
            for (int ks = 0; ks < 4; ++ks) { float y[8];
                const f32x4 ga = *(const f32x4*)(P.in[22] + ks * 32 + 8 * q4), gb = *(const f32x4*)(P.in[22] + ks * 32 + 8 * q4 + 4);
#pragma unroll
                for (int i = 0; i < 8; ++i) y[i] = x[ks][i] * rstd * ((i < 4) ? ga[i & 3] : gb[i & 3]);
                qf[ks] = pack8(y); }
        }
        f32x4 acc[16];
#pragma unroll
        for (int kt = 0; kt < 16; ++kt) {
            const LAS bf16* kr = Ks + (kt * 16 + l15) * KC_P + 8 * q4;
            f32x4 a = (f32x4){0.f, 0.f, 0.f, 0.f};
#pragma unroll
            for (int ks = 0; ks < 4; ++ks) a = MFMA16(*(const LAS bf16x8*)(kr + ks * 32), qf[ks], a);
            acc[kt] = a;
        }
        float mx = -1e30f;
#pragma unroll
        for (int kt = 0; kt < 16; ++kt)
#pragma unroll
            for (int i = 0; i < 4; ++i) mx = fmaxf(mx, acc[kt][i]);
        mx = fmaxf(mx, __shfl_xor(mx, 16)); mx = fmaxf(mx, __shfl_xor(mx, 32));
        float sum = 0.f;
#pragma unroll
        for (int kt = 0; kt < 16; ++kt)
#pragma unroll
            for (int i = 0; i < 4; ++i) { const float p = __builtin_amdgcn_exp2f(acc[kt][i] - mx); acc[kt][i] = p; sum += p; }
        sum += __shfl_xor(sum, 16); sum += __shfl_xor(sum, 32);
        const float inv = 1.f / sum;
        f32x4 o[8];
#pragma unroll
        for (int dt = 0; dt < 8; ++dt) o[dt] = (f32x4){0.f, 0.f, 0.f, 0.f};
#pragma unroll
        for (int k2 = 0; k2 < 8; ++k2) {
            float pp[8] = {acc[2 * k2][0], acc[2 * k2][1], acc[2 * k2][2], acc[2 * k2][3], acc[2 * k2 + 1][0], acc[2 * k2 + 1][1], acc[2 * k2 + 1][2], acc[2 * k2 + 1][3]};
            const bf16x8 pf = pack8(pp);
#pragma unroll
            for (int dt = 0; dt < 8; ++dt) {
                const LAS bf16* vr = Vt + (dt * 16 + l15) * VC_P + k2 * 32 + 4 * q4;
                const v2u v0 = *(const LAS v2u*)(vr), v1 = *(const LAS v2u*)(vr + 16);
                const v4u vw = (v4u){v0.x, v0.y, v1.x, v1.y};
                o[dt] = MFMA16(__builtin_bit_cast(bf16x8, vw), pf, o[dt]);
            }
        }
#pragma unroll
        for (int dt = 0; dt < 8; ++dt) {
            const int ch = hx * 128 + dt * 16 + 4 * q4;
            float gg[4]; unpack4(gat[dt], gg);
            v2u w; w.x = pk2(o[dt][0] * inv * gg[0], o[dt][1] * inv * gg[1]); w.y = pk2(o[dt][2] * inv * gg[2], o[dt][3] * inv * gg[3]);
            *(v2u*)(YC + m * DM + 1536 + ch) = w;
        }
    }
}
__device__ __forceinline__ void attnC_item(const Params& P, int item, LAS unsigned char* lds) {
    const int tid = pg8::mk_tid(lds), lane = tid & 63, wave = __builtin_amdgcn_readfirstlane(tid >> 6), l15 = lane & 15, q4 = lane >> 4;
    const int b = item >> 5, qb0 = 2 * ((item >> 2) & 7), hx = item & 3;
    const bf16* PRE = (const bf16*)(P.ws + WS_PRE); const bf16* MKV = (const bf16*)(P.ws + WS_MKV); bf16* YC = (bf16*)(P.ws + WS_YCAT);
    LAS bf16* Ks = (LAS bf16*)lds; LAS bf16* Vt = Ks + 256 * KC_P;
    const size_t m = (size_t)b * SEQ + qb0 * 128 + wave * 16 + l15;
    {
        v4u kw[8], vw[8];
#pragma unroll
        for (int u = 0; u < 8; ++u) {
            const int it = tid + u * NTHREADS, j = it >> 4, c = it & 15;
            const bf16* src = MKV + ((size_t)b * NMEM + j) * 1024 + hx * 128 + 8 * c;
            kw[u] = *(const v4u*)(src); vw[u] = *(const v4u*)(src + 512);
        }
        const f32x4 g0 = *(const f32x4*)(P.in[23] + 8 * (tid & 15)), g1 = *(const f32x4*)(P.in[23] + 8 * (tid & 15) + 4);
#pragma unroll
        for (int u = 0; u < 8; ++u) {
            const int it = tid + u * NTHREADS, j = it >> 4, c = it & 15;
            float x[8]; unpack8(kw[u], x);
            float ss = 0.f;
#pragma unroll
            for (int i = 0; i < 8; ++i) ss += x[i] * x[i];
            ss = red8(ss); ss = dpp_add<0x140>(ss);
            const float rstd = 1.f / sqrtf(ss * (1.f / 128.f) + NORM_EPS);
            v4u o; o.x = pk2(x[0] * rstd * g0.x, x[1] * rstd * g0.y); o.y = pk2(x[2] * rstd * g0.z, x[3] * rstd * g0.w);
            o.z = pk2(x[4] * rstd * g1.x, x[5] * rstd * g1.y); o.w = pk2(x[6] * rstd * g1.z, x[7] * rstd * g1.w);
            *(LAS v4u*)(Ks + j * KC_P + 8 * c) = o;
            const v4u w = vw[u];
            LAS bf16* d = Vt + (8 * c) * VC_P + j;
            d[0] = (bf16)(w.x & 0xffffu); d[VC_P] = (bf16)(w.x >> 16); d[2 * VC_P] = (bf16)(w.y & 0xffffu); d[3 * VC_P] = (bf16)(w.y >> 16);
            d[4 * VC_P] = (bf16)(w.z & 0xffffu); d[5 * VC_P] = (bf16)(w.z >> 16); d[6 * VC_P] = (bf16)(w.w & 0xffffu); d[7 * VC_P] = (bf16)(w.w >> 16);
        }
    }
    v4u qraw[4]; v2u gat[8];
    {
        const bf16* src = PRE + m * NPRE + C_XQ + hx * 128 + 8 * q4;
#pragma unroll
        for (int ks = 0; ks < 4; ++ks) qraw[ks] = *(const v4u*)(src + ks * 32);
#pragma unroll
        for (int dt = 0; dt < 8; ++dt) gat[dt] = *(const v2u*)(PRE + m * NPRE + C_XG + hx * 128 + dt * 16 + 4 * q4);
    }
    __syncthreads();
    v4u qraw2[4]; v2u gat2[8];
    {
        const size_t m2 = m + 128; const bf16* src = PRE + m2 * NPRE + C_XQ + hx * 128 + 8 * q4;
#pragma unroll
        for (int ks = 0; ks < 4; ++ks) qraw2[ks] = *(const v4u*)(src + ks * 32);
#pragma unroll
        for (int dt = 0; dt < 8; ++dt) gat2[dt] = *(const v2u*)(PRE + m2 * NPRE + C_XG + hx * 128 + dt * 16 + 4 * q4);
    }
    attnC_qblock(P, Ks, Vt, YC, qraw, gat, m, hx, l15, q4);
    __builtin_amdgcn_sched_barrier(0);
    attnC_qblock(P, Ks, Vt, YC, qraw2, gat2, m + 128, hx, l15, q4);
    __syncthreads();
}

__device__ __forceinline__ void p5_rwkv_post(const Params& P, LAS unsigned char* lds) {
    const bf16* PRE = (const bf16*)(P.ws + WS_PRE); const bf16* EA = (const bf16*)((unsigned char*)P.out + DO_EA);
    const bf16* YF = (const bf16*)((unsigned char*)P.out + DO_YF); const bf16* YB = (const bf16*)(P.ws + WS_YB); bf16* YC = (bf16*)(P.ws + WS_YCAT);
    const float* mu = P.in[10];
    const int gt = blockIdx.x * NTHREADS + pg8::mk_tid(lds), NGT = gridDim.x * NTHREADS;
    for (int idx = gt; idx < M_TOK * 96; idx += NGT) {
        const int m = idx / 96, he = idx - m * 96, ch0 = he * 8, t = m & (SEQ - 1);
        const bf16* p = PRE + (size_t)m * NPRE + C_RS + ch0;
        const v4u z4 = (v4u){0u, 0u, 0u, 0u};
        const bool hp = t > 0, hn = t < SEQ - 1;
        const v4u rc = *(const v4u*)(p), kc = *(const v4u*)(p + 768), vc = *(const v4u*)(p + 1536);
        const v4u rp = hp ? *(const v4u*)(p - NPRE) : z4, kp = hp ? *(const v4u*)(p - NPRE + 768) : z4, vp = hp ? *(const v4u*)(p - NPRE + 1536) : z4;
        const v4u rn = hn ? *(const v4u*)(p + NPRE) : z4, kn = hn ? *(const v4u*)(p + NPRE + 768) : z4, vn = hn ? *(const v4u*)(p + NPRE + 1536) : z4;
        const v4u af8 = *(const v4u*)(EA + (size_t)m * NLORA + 1536 + ch0), ab8 = *(const v4u*)(EA + (size_t)m * NLORA + 2304 + ch0);
        const v4u yf8 = *(const v4u*)(YF + (size_t)m * RW + ch0), yb8 = *(const v4u*)(YB + (size_t)m * RW + ch0);
        const v4u rg8 = *(const v4u*)(PRE + (size_t)m * NPRE + C_RG + ch0);
        float r[8], k[8], v[8], x0[8], x1[8], x2[8];
        unpack8(rc, x0); unpack8(rp, x1); unpack8(rn, x2);
#pragma unroll
        for (int i = 0; i < 8; ++i) r[i] = x0[i] + mu[ch0 + i] * (0.5f * (x1[i] + x2[i]) - x0[i]);
        unpack8(kc, x0); unpack8(kp, x1); unpack8(kn, x2);
#pragma unroll
        for (int i = 0; i < 8; ++i) k[i] = x0[i] + mu[768 + ch0 + i] * (0.5f * (x1[i] + x2[i]) - x0[i]);
        unpack8(vc, x0); unpack8(vp, x1); unpack8(vn, x2);
#pragma unroll
        for (int i = 0; i < 8; ++i) v[i] = x0[i] + mu[1536 + ch0 + i] * (0.5f * (x1[i] + x2[i]) - x0[i]);
        float af[8], ab[8], ys[8], yb[8], rg[8]; unpack8(af8, af); unpack8(ab8, ab); unpack8(yf8, ys); unpack8(yb8, yb); unpack8(rg8, rg);
        float bs = 0.f, sm = 0.f;
#pragma unroll
        for (int i = 0; i < 8; ++i) { const float kds = k[i] * (2.f + (af[i] + ab[i] - 2.f) * P.in[12][ch0 + i]); bs += r[i] * kds * P.in[13][ch0 + i]; ys[i] += yb[i]; sm += ys[i]; }
        bs = red8(bs); sm = red8(sm);
        const float mean = sm * (1.f / 64.f);
        float vs = 0.f;
#pragma unroll
        for (int i = 0; i < 8; ++i) { ys[i] -= mean; vs += ys[i] * ys[i]; }
        vs = red8(vs);
        const float rstd = 1.f / sqrtf(vs * (1.f / 64.f) + GN_EPS);
        float o[8];
#pragma unroll
        for (int i = 0; i < 8; ++i) o[i] = (ys[i] * rstd * P.in[18][ch0 + i] + P.in[19][ch0 + i] + bs * v[i]) * rg[i];
        v4u w; w.x = pk2(o[0], o[1]); w.y = pk2(o[2], o[3]); w.z = pk2(o[4], o[5]); w.w = pk2(o[6], o[7]);
        *(v4u*)(YC + (size_t)m * DM + 768 + ch0) = w;
    }
}


constexpr size_t WS_XBAR = 504 * MiB + 832 * 1024;
#define XB_TMO      128
#define XB_XCNT(j)  (256  + 64 * (j))
#define XB_XSUB(j)  (1280 + 64 * (j))
#define XB_XGEN(j)  (2304 + 64 * (j))
#define XB_TOP      3328
#define XB_TOPGEN   3392
#define XCD_BAR_WORDS 3456
#define XB_SPIN_CAP (1u << 18)
__device__ __forceinline__ unsigned xb_ld(unsigned* p)              { return __hip_atomic_load(p, __ATOMIC_RELAXED, __HIP_MEMORY_SCOPE_AGENT); }
__device__ __forceinline__ unsigned xb_add(unsigned* p, unsigned v) { return __hip_atomic_fetch_add(p, v, __ATOMIC_RELAXED, __HIP_MEMORY_SCOPE_AGENT); }
__device__ __forceinline__ unsigned xb_xcc_id() { return (unsigned)__builtin_amdgcn_s_getreg((3 << 11) | 20) & 0xFu; }
#define XB_SPIN(cond, bar) do { unsigned _sp = 0; while (cond) { __builtin_amdgcn_s_sleep(1); \
    if ((++_sp & 255u) == 0u) { if (xb_ld(&(bar)[XB_TMO])) break; if (_sp > XB_SPIN_CAP) { atomicAdd(&(bar)[XB_TMO], 1u); break; } } } } while (0)
__device__ __forceinline__ void xcd_barrier_complete(unsigned* bar, unsigned x, unsigned& nloc, unsigned& nx) {
    const unsigned G = gridDim.x * gridDim.y * gridDim.z;
    unsigned sum, cnt, mine, sp = 0u;
    for (;;) {
        sum = 0u; cnt = 0u; mine = 0u;
#pragma unroll
        for (unsigned j = 0; j < 16; ++j) { const unsigned c = xb_ld(&bar[XB_XCNT(j)]); sum += c; cnt += (c > 0u) ? 1u : 0u; mine = (j == x) ? c : mine; }
        if (sum == G) break;
        __builtin_amdgcn_s_sleep(1);
        if ((++sp & 255u) == 0u) { if (xb_ld(&bar[XB_TMO])) break; if (sp > XB_SPIN_CAP) { atomicAdd(&bar[XB_TMO], 1u); break; } }
    }
    nloc = mine > 0u ? mine : 1u; nx = cnt > 0u ? cnt : 1u;
}
__device__ __forceinline__ void xcd_barrier(unsigned* bar, volatile LAS unsigned* st, LAS unsigned char* lds) {
    asm volatile("s_waitcnt vmcnt(0)" ::: "memory");
    __syncthreads();
    if (pg8::mk_tid(lds) == 0) {
        const unsigned x = xb_xcc_id();
        __builtin_amdgcn_s_waitcnt(0);
        unsigned nloc = st[0], nx = st[1];
        if (nloc == 0u) { xcd_barrier_complete(bar, x, nloc, nx); st[0] = nloc; st[1] = nx; }
        const unsigned old = xb_add(&bar[XB_XSUB(x)], 1u);
        const unsigned gen = old / nloc;
        if (old + 1u == (gen + 1u) * nloc) {
            __builtin_amdgcn_fence(__ATOMIC_RELEASE, "agent");
            asm volatile("s_waitcnt vmcnt(0)" ::: "memory");
            const unsigned og = xb_add(&bar[XB_TOP], 1u);
            const unsigned tg = og / nx;
            if (og + 1u == (tg + 1u) * nx) xb_add(&bar[XB_TOPGEN], 1u);
            else XB_SPIN(xb_ld(&bar[XB_TOPGEN]) == tg, bar);
            __builtin_amdgcn_fence(__ATOMIC_ACQUIRE, "agent");
            xb_add(&bar[XB_XGEN(x)], 1u);
            asm volatile("s_waitcnt vmcnt(0)" ::: "memory");
        } else {
            XB_SPIN(xb_ld(&bar[XB_XGEN(x)]) == gen, bar);
            __builtin_amdgcn_fence(__ATOMIC_ACQUIRE, "agent");
            asm volatile("s_waitcnt vmcnt(0)" ::: "memory");
        }
    }
    __syncthreads();
}

constexpr int N_PHASES = 8;
__global__ void __launch_bounds__(NTHREADS, 2) hybrid_fwd(Params P) {
    extern __shared__ __attribute__((aligned(16))) unsigned char lds_raw[];
    LAS unsigned char* lds = (LAS unsigned char*)lds_raw;
    cg::grid_group grid = cg::this_grid();
    const int lo = P.ph_lo, hi = P.ph_hi, G = gridDim.x;
    if ((threadIdx.x & 63) == 0) *(volatile LAS int*)(lds + pg8::TIDTAB_OFF + 4 * pg8::hw_slot()) = (int)(threadIdx.x >> 6);
    volatile LAS unsigned* xbst = (volatile LAS unsigned*)(lds + pg8::TIDTAB_OFF - 128);
    unsigned* xbar = (unsigned*)(P.ws + WS_XBAR);
    if (threadIdx.x == 0) { xbst[0] = 0u; xbst[1] = 0u; (void)xb_add(&xbar[XB_XCNT(xb_xcc_id())], 1u); }
    __syncthreads();
    unsigned char* ws = P.ws; unsigned char* dob = (unsigned char*)P.out;
#ifdef PHMASK
#define IN(k) (((PHMASK >> (k)) & 1) && lo <= (k) && (k) < hi)
#else
#define IN(k) (lo <= (k) && (k) < hi)
#endif
#define SEAM(k) do { if (IN(k) && IN((k) + 1)) xcd_barrier(xbar, xbst, lds); } while (0)
#ifndef REPEAT_MASK
#define REPEAT_MASK 0
#endif
#define REP(k) for (int rep_ = 0; rep_ < (((REPEAT_MASK >> (k)) & 1) ? 2 : 1); ++rep_)
#define REPSYNC() do { if (rep_) grid.sync(); } while (0)
    if (hi > N_PHASES) grid.sync();
    if (IN(0)) REP(0) { REPSYNC(); p0_prologue(P, lds, P.out); __syncthreads(); }
    SEAM(0);
    if (IN(1)) REP(1) { REPSYNC();
        { pg8::Gemm g{(const bf16*)(dob + DO_H), (const bf16*)(dob + DO_WIN), M_TOK, NIN, DM}; pg8::StaticOrder S; S.init(M_TOK, NIN, G, (int)blockIdx.x);
          EpiProj E{(bf16*)(ws + WS_PRE), (bf16*)(ws + WS_GATES), P.in[5]};
          pg8::gemm_phase<EpiProj, pg8::StaticOrder, true, true>(lds, g, S, E); }
        { pg8::Gemm g{(const bf16*)(ws + WS_MEMN), (const bf16*)(ws + WS_WXKV), MEMROWS, 1024, DM}; pg8::StaticOrder S; S.init(MEMROWS, 1024, G, (int)((blockIdx.x + G - 64) % G));
          EpiPlain E{(bf16*)(ws + WS_MKV), 1024};
          pg8::gemm_phase<EpiPlain, pg8::StaticOrder, true, true>(lds, g, S, E); }
    }
    SEAM(1);
    if (IN(2)) REP(2) { REPSYNC(); p2_lora_in(P, lds); }
    SEAM(2);
    if (IN(3)) REP(3) { REPSYNC();
        int klora = 256; asm volatile("" : "+s"(klora));
        pg8::Gemm g{(const bf16*)(dob + DO_LIN), (const bf16*)(ws + WS_LORAB), M_TOK, NLORA, klora}; pg8::StaticOrder S; S.init(M_TOK, NLORA, G, (int)blockIdx.x);
        EpiLora E{(bf16*)(dob + DO_EA), P.in[14], P.in[16]};
        pg8::gemm_phase<EpiLora, pg8::StaticOrder, true, true>(lds, g, S, E);
    }
    SEAM(3);
    if (IN(4)) REP(4) { REPSYNC();
        const int bid = blockIdx.x;
#ifndef STATIC_ATT
#define STATIC_ATT 0
#endif
#ifndef SCAN2
#define SCAN2 1
#endif
        if (bid < 192) scan_chunked(P, bid, lds);
        if (STATIC_ATT) {
            if (bid >= 192) { for (int it = bid - 192; it < 768; it += G - 192) { if (it < 512) attnA_item(P, it, lds); else attnC_item(P, it - 512, lds); } }
        } else {
            volatile LAS int* slot = (volatile LAS int*)(lds + pg8::TIDTAB_OFF - 64);
            const int tid4 = pg8::mk_tid(lds);
            for (;;) {
                if (tid4 == 0) *slot = (int)__hip_atomic_fetch_add((unsigned*)(ws + WS_CTR), 1u, __ATOMIC_RELAXED, __HIP_MEMORY_SCOPE_AGENT);
                __syncthreads();
                const int it = *slot;
                __syncthreads();
                if (it >= 768) break;
                if (it < 512) attnA_item(P, it, lds); else attnC_item(P, it - 512, lds);
            }
        }
    }
    SEAM(4);
    if (IN(5)) REP(5) { REPSYNC(); p5_rwkv_post(P, lds); }
    SEAM(5);
    if (IN(6)) REP(6) { REPSYNC();
        pg8::Gemm g{(const bf16*)(ws + WS_YCAT), (const bf16*)(ws + WS_WCAT), M_TOK, DM, DM}; pg8::StaticOrder S; S.init(M_TOK, DM, G, (int)blockIdx.x);
        EpiMerged E{(bf16*)(ws + WS_MERGED), (const bf16*)(ws + WS_GATES)};
        pg8::gemm_phase<EpiMerged, pg8::StaticOrder, true, true>(lds, g, S, E);
    }
    SEAM(6);
    if (IN(7)) REP(7) { REPSYNC();
        pg8::Gemm g{(const bf16*)(ws + WS_MERGED), (const bf16*)(ws + WS_WOUT), M_TOK, DM, DM}; pg8::StaticOrder S; S.init(M_TOK, DM, G, (int)blockIdx.x);
        EpiOut E{P.out, P.in[0]};
        pg8::gemm_phase<EpiOut, pg8::StaticOrder, true, true>(lds, g, S, E);
    }
#undef IN
#undef SEAM
}

#ifndef ONE_LAUNCH
#define ONE_LAUNCH 1
#endif
extern "C" void kernel_launch(void* const* d_in, const int* in_sizes, int n_in, void* d_out, int out_size, void* d_ws, size_t ws_size, hipStream_t stream) {
    static int grid = 0;
    if (grid == 0) {
        if (n_in != 26 || out_size != M_TOK * DM || ws_size < WS_END) { fprintf(stderr, "kernel_launch: unexpected shapes (n_in %d, out %d, ws %zu); nothing launched\n", n_in, out_size, ws_size); grid = -1; return; }
        int dev = 0, cus = 0, per_cu = 0;
        hipGetDevice(&dev); hipDeviceGetAttribute(&cus, hipDeviceAttributeMultiprocessorCount, dev);
        if (hipFuncSetAttribute((const void*)hybrid_fwd, hipFuncAttributeMaxDynamicSharedMemorySize, LDS_BYTES) != hipSuccess) { fprintf(stderr, "kernel_launch: hipFuncSetAttribute failed\n"); grid = -1; return; }
        hipOccupancyMaxActiveBlocksPerMultiprocessor(&per_cu, (const void*)hybrid_fwd, NTHREADS, LDS_BYTES);
        (void)hipGetLastError();
        if (per_cu < 1) per_cu = 1;
        grid = cus * per_cu; if (grid > 256) grid = 256;
        if (grid < 200) { fprintf(stderr, "kernel_launch: grid %d too small for the scan/attention split\n", grid); grid = -1; return; }
    }
    if (grid < 0) return;
    Params p{};
    for (int i = 0; i < 26; ++i) p.in[i] = (const float*)d_in[i];
    p.out = (float*)d_out; p.ws = (unsigned char*)d_ws;
#if ONE_LAUNCH
    (void)hipMemsetAsync((unsigned char*)d_ws + WS_XBAR, 0, XCD_BAR_WORDS * 4, stream);
    p.ph_lo = 0; p.ph_hi = N_PHASES;
    void* args[] = {&p};
    hipError_t e = hipLaunchCooperativeKernel((const void*)hybrid_fwd, dim3(grid), dim3(NTHREADS), args, LDS_BYTES, stream);
    if (e != hipSuccess) fprintf(stderr, "cooperative launch failed: %s (grid %d)\n", hipGetErrorString(e), grid);
#else
    for (int ph = 0; ph < N_PHASES; ++ph) {
        p.ph_lo = ph; p.ph_hi = ph + 1;
        hipLaunchKernelGGL(hybrid_fwd, dim3(grid), dim3(NTHREADS), LDS_BYTES, stream, p);
    }
#endif
}
```

```cpp
#include <hip/hip_runtime.h>
#include <hip/hip_cooperative_groups.h>
#include <cstdio>
#include <cstdint>
namespace cg = cooperative_groups;
namespace pg8 {
#define PG8_LAS __attribute__((address_space(3)))
typedef unsigned short bf16_t;
typedef short bf16x8 __attribute__((ext_vector_type(8)));
typedef float f32x4 __attribute__((ext_vector_type(4)));
typedef unsigned u32x4 __attribute__((ext_vector_type(4)));
constexpr int BM = 256, BK = 64, HALF = 128, HTB = HALF * BK * 2  , STAGE_BYTES = 8 * HTB, NXCD = 8, WGM = 2;

__host__ __device__ __forceinline__ int lds_byte(int r, int c) { const int st = (r >> 4) * 2 + (c >> 5), rr = r & 15, cc = c & 31, ob = rr * 64 + cc * 2; return st * 1024 + (ob ^ (((ob >> 9) & 1) << 5)); }
__host__ __device__ __forceinline__ void stage_rc(int b, int& R, int& C) { const int st = b / 1024, sb = b % 1024, swz = sb ^ (((sb >> 9) & 1) << 5); R = (st >> 1) * 16 + swz / 64; C = (st & 1) * 32 + (swz % 64) / 2; }
__host__ __device__ __forceinline__ int perm32(int rho) { const int n = rho >> 4, i = rho & 15; return 8 * (i >> 2) + 4 * n + (i & 3); }


constexpr int TIDTAB_OFF = 147200;
__device__ __forceinline__ int hw_slot() { return (int)(__builtin_amdgcn_s_getreg((5 << 11) | 4) & 63u); }
__device__ __forceinline__ int mk_tid(PG8_LAS unsigned char* lds) {
    const int lane = (int)__builtin_amdgcn_mbcnt_hi(~0u, __builtin_amdgcn_mbcnt_lo(~0u, 0u));
    const int w = __builtin_amdgcn_readfirstlane(*(volatile PG8_LAS int*)(lds + TIDTAB_OFF + 4 * hw_slot()));
    return w * 64 + lane;
}
struct Unit { int pm, pn; };
struct Gemm { const bf16_t* A; const bf16_t* Bt; int M, N, K; };

struct StaticOrder {
    int nM, nN, nwg, G, c;
    __host__ __device__ void init(int M, int N, int G_, int c_) { nM = M / BM; nN = N / BM; nwg = nM * nN; G = G_; c = c_; }
    __host__ __device__ bool next(int i, Unit& u) const {
        const long L = (long)i * G + c; if (L >= nwg) return false;
        int wgid = (int)L; { const int q = nwg / NXCD, r = nwg % NXCD, xcd = wgid % NXCD, off = wgid / NXCD; wgid = (xcd < r ? xcd * (q + 1) : r * (q + 1) + (xcd - r) * q) + off; }
        const int nig = WGM * nN, gid = wgid / nig, fm = gid * WGM, gsz = (nM - fm) < WGM ? (nM - fm) : WGM;
        u.pm = fm + ((wgid % nig) % gsz); u.pn = (wgid % nig) / gsz; return true;
    }
    __device__ __forceinline__ void a_ready(const Unit&) const {}
    __device__ __forceinline__ void done(const Unit&) const {}
};

__device__ __forceinline__ unsigned cvt_pk_bf16(float lo, float hi) { unsigned r; asm volatile("v_cvt_pk_bf16_f32 %0, %1, %2" : "=v"(r) : "v"(lo), "v"(hi)); return r; }
template <class Epi, class Sched, bool ALIGN_EPI = false, bool SP2 = false>
__device__ __forceinline__ void gemm_phase(PG8_LAS unsigned char* lds, const Gemm g, const Sched& S, const Epi& E) {
    const int tid = mk_tid(lds), wid = __builtin_amdgcn_readfirstlane(tid >> 6), lane = tid & 63, wr = wid >> 2, wc = wid & 3, fr = lane & 15, fq = lane >> 4;
    const int K = g.K, nt = K / BK;
    unsigned voffA[2], voffB[2];
#pragma unroll
    for (int i = 0; i < 2; ++i) { int R, C; stage_rc(tid * 16 + i * 8192, R, C); const int Rb = Epi::PERM ? ((R & ~31) + perm32(R & 31)) : R;
        voffA[i] = (unsigned)(R * K + C) * 2u; voffB[i] = (unsigned)(Rb * K + C) * 2u; }
    const size_t kstep = (size_t)(BK * 2);
    const size_t hstep = (size_t)HALF * K * 2;
    const size_t tstep = 2 * hstep;
    const unsigned ldsw = (unsigned)wid * 1024u;
    const int aoff = lds_byte(wr * 64 + fr, fq * 8), boff = lds_byte(wc * 32 + fr, fq * 8);
#define PG8_SA(b, h) (((b) * 2 + (h)) * HTB)
#define PG8_SB(b, h) ((4 + (b) * 2 + (h)) * HTB)
#define PG8_STAGE(bufoff, gbase, voff) do { _Pragma("unroll") for (int _i = 0; _i < 2; ++_i) \
        __builtin_amdgcn_global_load_lds((const unsigned*)((const char*)(gbase) + (voff)[_i]), (PG8_LAS unsigned*)(lds + (bufoff) + ldsw + _i * 8192), 16, 0, 0); } while (0)
#define PG8_LDA(dst, b, h) do { _Pragma("unroll") for (int m = 0; m < 4; ++m) _Pragma("unroll") for (int k = 0; k < 2; ++k) dst[m][k] = *(const PG8_LAS bf16x8*)(lds + PG8_SA(b, h) + aoff + m * 2048 + k * 1024); } while (0)
#define PG8_LDB(dst, b, h) do { _Pragma("unroll") for (int n = 0; n < 2; ++n) _Pragma("unroll") for (int k = 0; k < 2; ++k) dst[n][k] = *(const PG8_LAS bf16x8*)(lds + PG8_SB(b, h) + boff + n * 2048 + k * 1024); } while (0)
#define PG8_MMA(ai, bj, At, Bt) do { __builtin_amdgcn_s_setprio(1); _Pragma("unroll") for (int m = 0; m < 4; ++m) _Pragma("unroll") for (int n = 0; n < 2; ++n) _Pragma("unroll") for (int k = 0; k < 2; ++k) \
        acc[ai][bj][m][n] = __builtin_amdgcn_mfma_f32_16x16x32_bf16(Bt[n][k], At[m][k], acc[ai][bj][m][n], 0, 0, 0); __builtin_amdgcn_s_setprio(0); } while (0)
#define PG8_WAIT_V(n) asm volatile("s_waitcnt vmcnt(" #n ")" ::: "memory")
#define PG8_WAIT_L(n) asm volatile("s_waitcnt lgkmcnt(" #n ")" ::: "memory")
#define PG8_BAR __builtin_amdgcn_s_barrier()
#define PG8_SCHED __builtin_amdgcn_sched_barrier(0)
    Unit cur, nxt; int ui = 0;
    if (!S.next(0, cur)) return;
    f32x4 acc[2][2][4][2];
#pragma unroll
    for (int a = 0; a < 2; ++a)
#pragma unroll
        for (int b = 0; b < 2; ++b)
#pragma unroll
            for (int m = 0; m < 4; ++m)
#pragma unroll
                for (int n = 0; n < 2; ++n) acc[a][b][m][n] = (f32x4){0.f, 0.f, 0.f, 0.f};
    bf16x8 At[4][2], B0[2][2], B1[2][2];
    const char* cA = (const char*)g.A + (size_t)cur.pm * tstep; const char* cB = (const char*)g.Bt + (size_t)cur.pn * tstep;
    S.a_ready(cur);
    if constexpr (SP2) {
        PG8_STAGE(PG8_SB(0, 0), cB, voffB); PG8_STAGE(PG8_SB(0, 1), cB + hstep, voffB); PG8_STAGE(PG8_SA(0, 0), cA, voffA); PG8_STAGE(PG8_SA(0, 1), cA + hstep, voffA);
        if (wr == 1) PG8_BAR;
        PG8_WAIT_V(2); PG8_BAR;
        PG8_STAGE(PG8_SB(1, 0), cB + kstep, voffB); PG8_STAGE(PG8_SA(1, 0), cA + kstep, voffA); PG8_STAGE(PG8_SB(1, 1), cB + hstep + kstep, voffB);
        PG8_WAIT_V(6); PG8_BAR;
    } else {
        PG8_STAGE(PG8_SB(0, 0), cB, voffB); PG8_STAGE(PG8_SA(0, 0), cA, voffA); PG8_STAGE(PG8_SB(0, 1), cB + hstep, voffB); PG8_STAGE(PG8_SA(0, 1), cA + hstep, voffA);
        if (wr == 1) PG8_BAR;
        PG8_WAIT_V(4); PG8_BAR;
        PG8_STAGE(PG8_SB(1, 0), cB + kstep, voffB); PG8_STAGE(PG8_SA(1, 0), cA + kstep, voffA); PG8_STAGE(PG8_SB(1, 1), cB + hstep + kstep, voffB);
        PG8_WAIT_V(6); PG8_BAR;
    }
    for (;;) {
        const bool has_next = S.next(ui + 1, nxt);
        const char* nA = has_next ? (const char*)g.A + (size_t)nxt.pm * tstep : cA; const char* nB = has_next ? (const char*)g.Bt + (size_t)nxt.pn * tstep : cB;
        for (int t = 0; t < nt; t += 2) {
            if constexpr (Epi::KHOOK) { if (t == Epi::HK0 || t == Epi::HK1) E.khook(acc, cur, t, wr, wc, fr, fq); }
            const bool last = (t == nt - 2);
            const char* a1 = cA + (size_t)(t + 1) * kstep;
            const char* a2 = last ? nA : cA + (size_t)(t + 2) * kstep; const char* b2 = last ? nB : cB + (size_t)(t + 2) * kstep;
            const char* a3 = a2 + kstep; const char* b3 = b2 + kstep;
            if (last && has_next) S.a_ready(nxt);
            if constexpr (SP2) {
            PG8_LDB(B0, 0, 0); PG8_LDB(B1, 0, 1); PG8_SCHED; PG8_LDA(At, 0, 0); PG8_STAGE(PG8_SA(1, 1), a1 + hstep, voffA);
            PG8_WAIT_V(8); PG8_WAIT_L(0); PG8_BAR; PG8_MMA(0, 0, At, B0); PG8_MMA(0, 1, At, B1); PG8_BAR; PG8_SCHED;
            PG8_LDA(At, 0, 1); PG8_STAGE(PG8_SB(0, 0), b2, voffB); PG8_STAGE(PG8_SB(0, 1), b2 + hstep, voffB); PG8_STAGE(PG8_SA(0, 0), a2, voffA);
            PG8_WAIT_V(8); PG8_WAIT_L(0); PG8_BAR; PG8_MMA(1, 0, At, B0); PG8_MMA(1, 1, At, B1); PG8_BAR; PG8_SCHED;
            PG8_LDB(B0, 1, 0); PG8_LDB(B1, 1, 1); PG8_SCHED; PG8_LDA(At, 1, 0); PG8_STAGE(PG8_SA(0, 1), a2 + hstep, voffA);
            PG8_WAIT_V(8); PG8_WAIT_L(0); PG8_BAR; PG8_MMA(0, 0, At, B0); PG8_MMA(0, 1, At, B1); PG8_BAR; PG8_SCHED;
            PG8_LDA(At, 1, 1); PG8_STAGE(PG8_SB(1, 0), b3, voffB); PG8_STAGE(PG8_SB(1, 1), b3 + hstep, voffB); PG8_STAGE(PG8_SA(1, 0), a3, voffA);
            PG8_WAIT_V(8); PG8_WAIT_L(0); PG8_BAR; PG8_MMA(1, 0, At, B0); PG8_MMA(1, 1, At, B1); PG8_BAR; PG8_SCHED;
            } else {
            PG8_LDB(B0, 0, 0); PG8_SCHED; PG8_LDA(At, 0, 0); PG8_STAGE(PG8_SA(1, 1), a1 + hstep, voffA);
            PG8_WAIT_L(8); PG8_BAR; PG8_WAIT_L(0); PG8_MMA(0, 0, At, B0); PG8_BAR; PG8_SCHED;
            PG8_LDB(B1, 0, 1); PG8_STAGE(PG8_SB(0, 0), b2, voffB);
            PG8_BAR; PG8_WAIT_L(0); PG8_MMA(0, 1, At, B1); PG8_BAR;
            PG8_LDA(At, 0, 1); PG8_STAGE(PG8_SA(0, 0), a2, voffA);
            PG8_BAR; PG8_WAIT_L(0); PG8_MMA(1, 0, At, B0); PG8_BAR; PG8_SCHED;
            PG8_STAGE(PG8_SB(0, 1), b2 + hstep, voffB);
            PG8_WAIT_V(6); PG8_BAR; PG8_MMA(1, 1, At, B1); PG8_BAR;
            PG8_LDB(B0, 1, 0); PG8_SCHED; PG8_LDA(At, 1, 0); PG8_STAGE(PG8_SA(0, 1), a2 + hstep, voffA);
            PG8_WAIT_L(8); PG8_BAR; PG8_WAIT_L(0); PG8_MMA(0, 0, At, B0); PG8_BAR; PG8_SCHED;
            PG8_LDB(B1, 1, 1); PG8_STAGE(PG8_SB(1, 0), b3, voffB);
            PG8_BAR; PG8_WAIT_L(0); PG8_MMA(0, 1, At, B1); PG8_BAR;
            PG8_LDA(At, 1, 1); PG8_STAGE(PG8_SA(1, 0), a3, voffA);
            PG8_BAR; PG8_WAIT_L(0); PG8_MMA(1, 0, At, B0); PG8_BAR; PG8_SCHED;
            PG8_STAGE(PG8_SB(1, 1), b3 + hstep, voffB);
            PG8_WAIT_V(6); PG8_BAR; PG8_MMA(1, 1, At, B1); PG8_BAR;
            }
        }
        if constexpr (ALIGN_EPI) { if (wr == 0) PG8_BAR; }
        if constexpr (!Epi::AFTER_DRAIN) { E(acc, cur, wr, wc, fr, fq); S.done(cur); }
        if (!has_next) break;
#pragma unroll
        for (int a = 0; a < 2; ++a)
#pragma unroll
            for (int b = 0; b < 2; ++b)
#pragma unroll
                for (int m = 0; m < 4; ++m)
#pragma unroll
                    for (int n = 0; n < 2; ++n) acc[a][b][m][n] = (f32x4){0.f, 0.f, 0.f, 0.f};
        cur = nxt; cA = nA; cB = nB; ++ui;
        if constexpr (ALIGN_EPI) { if (wr == 1) PG8_BAR; }
    }
    PG8_WAIT_V(0);
    if constexpr (!ALIGN_EPI) { if (wr == 0) PG8_BAR; }
    PG8_BAR;
    if constexpr (Epi::AFTER_DRAIN) { E.fused(acc, cur, wr, wc, fr, fq, lds, wid, lane); S.done(cur); }
#undef PG8_SA
#undef PG8_SB
#undef PG8_STAGE
#undef PG8_LDA
#undef PG8_LDB
#undef PG8_MMA
#undef PG8_WAIT_V
#undef PG8_WAIT_L
#undef PG8_BAR
#undef PG8_SCHED
}
}

#define GAS __attribute__((address_space(1)))
#define LAS __attribute__((address_space(3)))
typedef unsigned short bf16;
typedef unsigned v4u __attribute__((ext_vector_type(4)));
typedef unsigned v2u __attribute__((ext_vector_type(2)));
typedef float f32x4 __attribute__((ext_vector_type(4)));
typedef float f32x2 __attribute__((ext_vector_type(2)));
typedef short bf16x8 __attribute__((ext_vector_type(8)));
typedef short s16x4 __attribute__((ext_vector_type(4)));

constexpr int NWAVES = 8, NTHREADS = 512;
constexpr int BATCH = 8, SEQ = 2048, DM = 2048, M_TOK = BATCH * SEQ;
constexpr int NPRE = 6400, NGATE = 6144, NIN = NPRE + NGATE;
constexpr int C_AQ = 0, C_AK = 768, C_AV = 1024, C_AG = 1280, C_RS = 2048, C_RR = 2048, C_RK = 2816, C_RV = 3584, C_LORA = 4352, C_RG = 4608, C_XQ = 5376, C_XG = 5888;
constexpr int NMEM = 256, MEMROWS = BATCH * NMEM;
constexpr int RW = 768, NLORA = 3072;
constexpr float NORM_EPS = 1e-6f, GN_EPS = 64e-5f;
constexpr int LDS_BYTES = 147456;

constexpr size_t MiB = 1u << 20;
constexpr size_t WS_PRE = 0, WS_MERGED = 0, WS_GATES = 200 * MiB, WS_YCAT = 392 * MiB;
constexpr size_t WS_WCAT = 456 * MiB, WS_WOUT = 464 * MiB, WS_WXKV = 472 * MiB, WS_MKV = 476 * MiB, WS_MEMN = 480 * MiB, WS_YB = 480 * MiB;
constexpr size_t WS_ROPE = 504 * MiB, WS_LORAB = 505 * MiB, WS_END = 512 * MiB;
constexpr size_t WS_CTR = 504 * MiB + 768 * 1024;
constexpr size_t DO_H = 0, DO_WIN = 64 * MiB, DO_EA = 0, DO_LIN = 96 * MiB, DO_YF = 104 * MiB;

struct Params { const float* in[26]; float* out; unsigned char* ws; int ph_lo, ph_hi; };

__device__ __forceinline__ float bf_lo(unsigned w) { return __builtin_bit_cast(float, w << 16); }
__device__ __forceinline__ float bf_hi(unsigned w) { return __builtin_bit_cast(float, w & 0xffff0000u); }
__device__ __forceinline__ float bf1(bf16 h) { return __builtin_bit_cast(float, (unsigned)h << 16); }
__device__ __forceinline__ unsigned f2bf(float f) { unsigned u = __builtin_bit_cast(unsigned, f); return (u + 0x7fffu + ((u >> 16) & 1u)) >> 16; }
typedef __bf16 bf16x2_t __attribute__((ext_vector_type(2)));
__device__ __forceinline__ unsigned pk2(float lo, float hi) { const f32x2 v = {lo, hi}; const bf16x2_t b = __builtin_convertvector(v, bf16x2_t); return __builtin_bit_cast(unsigned, b); }
__device__ __forceinline__ float sigmoidf_(float z) { return __builtin_amdgcn_rcpf(1.f + __expf(-z)); }
__device__ __forceinline__ float siluf_(float z) { return z * sigmoidf_(z); }
__device__ __forceinline__ void unpack8(v4u w, float (&x)[8]) { x[0] = bf_lo(w.x); x[1] = bf_hi(w.x); x[2] = bf_lo(w.y); x[3] = bf_hi(w.y); x[4] = bf_lo(w.z); x[5] = bf_hi(w.z); x[6] = bf_lo(w.w); x[7] = bf_hi(w.w); }
__device__ __forceinline__ void unpack4(v2u w, float (&x)[4]) { x[0] = bf_lo(w.x); x[1] = bf_hi(w.x); x[2] = bf_lo(w.y); x[3] = bf_hi(w.y); }
__device__ __forceinline__ float fma_s(float a, float b, float c) { float r; asm("v_fma_f32 %0, %1, %2, %3" : "=v"(r) : "v"(a), "v"(b), "v"(c)); return r; }
__device__ __forceinline__ float mul_s(float a, float b) { float r; asm("v_mul_f32_e32 %0, %1, %2" : "=v"(r) : "v"(a), "v"(b)); return r; }
__device__ __forceinline__ float add_s(float a, float b) { float r; asm("v_add_f32_e32 %0, %1, %2" : "=v"(r) : "v"(a), "v"(b)); return r; }
template <int CTRL> __device__ __forceinline__ float dpp_add(float v) { return v + __builtin_bit_cast(float, __builtin_amdgcn_update_dpp(0, __builtin_bit_cast(int, v), CTRL, 0xF, 0xF, true)); }
__device__ __forceinline__ float red8(float v) { v = dpp_add<0xB1>(v); v = dpp_add<0x4E>(v); v = dpp_add<0x141>(v); return v; }

using pg8::Unit;
struct EpiProj {
    static constexpr bool PERM = true, AFTER_DRAIN = false, KHOOK = false; static constexpr int HK0 = -1, HK1 = -1;
    bf16* pre; bf16* gates; const float* gate_b;
    __device__ __forceinline__ void operator()(const f32x4 (&acc)[2][2][4][2], const Unit& u, int wr, int wc, int fr, int fq) const {
        int row0 = u.pm * 256 + wr * 64 + fr;
        asm volatile("" : "+v"(row0));
        const bool isg = u.pn >= 25;
        const int pn = isg ? u.pn - 25 : u.pn;
        bf16* base = isg ? gates : pre; const int ldc = isg ? NGATE : NPRE;
        const int act = isg ? 2 : (((pn >= 5 && pn <= 7) || (pn >= 18 && pn <= 20) || pn >= 23) ? 1 : 0);
        const int col0 = pn * 256 + wc * 32 + 8 * fq;
        f32x4 bv[2][2];
#pragma unroll
        for (int bj = 0; bj < 2; ++bj) { bv[bj][0] = isg ? *(const f32x4*)(gate_b + col0 + bj * 128) : (f32x4){0.f, 0.f, 0.f, 0.f}; bv[bj][1] = isg ? *(const f32x4*)(gate_b + col0 + bj * 128 + 4) : (f32x4){0.f, 0.f, 0.f, 0.f}; }
#pragma unroll
        for (int ai = 0; ai < 2; ++ai)
#pragma unroll
            for (int m = 0; m < 4; ++m) { bf16* rowp = base + (size_t)(row0 + ai * 128 + m * 16) * ldc + col0;
                __builtin_amdgcn_sched_barrier(0);
#pragma unroll
                for (int bj = 0; bj < 2; ++bj) { f32x4 v0 = acc[ai][bj][m][0] + bv[bj][0], v1 = acc[ai][bj][m][1] + bv[bj][1];
                    if (act == 1) {
#pragma unroll
                        for (int i = 0; i < 4; ++i) { v0[i] = siluf_(v0[i]); v1[i] = siluf_(v1[i]); }
                    } else if (act == 2) {
#pragma unroll
                        for (int i = 0; i < 4; ++i) { v0[i] = sigmoidf_(v0[i]); v1[i] = sigmoidf_(v1[i]); }
                    }
                    v4u w; w.x = pk2(v0[0], v0[1]); w.y = pk2(v0[2], v0[3]); w.z = pk2(v1[0], v1[1]); w.w = pk2(v1[2], v1[3]);
                    *(v4u*)(rowp + bj * 128) = w; } }
    }
};
struct EpiPlain {
    static constexpr bool PERM = true, AFTER_DRAIN = false, KHOOK = false; static constexpr int HK0 = -1, HK1 = -1;
    bf16* O; int ldc;
    __device__ __forceinline__ void operator()(const f32x4 (&acc)[2][2][4][2], const Unit& u, int wr, int wc, int fr, int fq) const {
        int row0 = u.pm * 256 + wr * 64 + fr, col0 = u.pn * 256 + wc * 32 + 8 * fq;
        asm volatile("" : "+v"(row0), "+v"(col0));
#pragma unroll
        for (int ai = 0; ai < 2; ++ai)
#pragma unroll
            for (int m = 0; m < 4; ++m) { bf16* rowp = O + (size_t)(row0 + ai * 128 + m * 16) * ldc + col0;
#pragma unroll
                for (int bj = 0; bj < 2; ++bj) { const f32x4 v0 = acc[ai][bj][m][0], v1 = acc[ai][bj][m][1];
                    v4u w; w.x = pk2(v0[0], v0[1]); w.y = pk2(v0[2], v0[3]); w.z = pk2(v1[0], v1[1]); w.w = pk2(v1[2], v1[3]);
                    *(v4u*)(rowp + bj * 128) = w; } }
    }
};
struct EpiLora {
    static constexpr bool PERM = true, AFTER_DRAIN = false, KHOOK = false; static constexpr int HK0 = -1, HK1 = -1;
    bf16* O; const float* w0; const float* a0;
    __device__ __forceinline__ void operator()(const f32x4 (&acc)[2][2][4][2], const Unit& u, int wr, int wc, int fr, int fq) const {
        int row0 = u.pm * 256 + wr * 64 + fr, col0 = u.pn * 256 + wc * 32 + 8 * fq;
        asm volatile("" : "+v"(row0), "+v"(col0));
        const bool isw = u.pn < 6; const float* bias = isw ? (w0 + col0) : (a0 + col0 - 1536); const float sc = isw ? 0.6065306597126334f : 1.f;
        f32x4 bv[2][2];
#pragma unroll
        for (int bj = 0; bj < 2; ++bj) { bv[bj][0] = *(const f32x4*)(bias + bj * 128); bv[bj][1] = *(const f32x4*)(bias + bj * 128 + 4); }
#pragma unroll
        for (int ai = 0; ai < 2; ++ai)
#pragma unroll
            for (int m = 0; m < 4; ++m) { bf16* rowp = O + (size_t)(row0 + ai * 128 + m * 16) * NLORA + col0;
                __builtin_amdgcn_sched_barrier(0);
#pragma unroll
                for (int bj = 0; bj < 2; ++bj) { f32x4 v0 = acc[ai][bj][m][0] + bv[bj][0], v1 = acc[ai][bj][m][1] + bv[bj][1];
#pragma unroll
                    for (int i = 0; i < 4; ++i) { v0[i] = sc * sigmoidf_(v0[i]); v1[i] = sc * sigmoidf_(v1[i]); }
                    v4u w; w.x = pk2(v0[0], v0[1]); w.y = pk2(v0[2], v0[3]); w.z = pk2(v1[0], v1[1]); w.w = pk2(v1[2], v1[3]);
                    *(v4u*)(rowp + bj * 128) = w; } }
    }
};
struct EpiMerged {
    static constexpr bool PERM = true, AFTER_DRAIN = false, KHOOK = true; static constexpr int HK0 = 12, HK1 = 24;
    bf16* O; const bf16* gates;
    __device__ __forceinline__ void khook(f32x4 (&acc)[2][2][4][2], const Unit& u, int t, int wr, int wc, int fr, int fq) const {
        int row0 = u.pm * 256 + wr * 64 + fr, col0 = u.pn * 256 + wc * 32 + 8 * fq;
        asm volatile("" : "+v"(row0), "+v"(col0));
        const int bo = (t == HK0) ? 0 : DM;
#pragma unroll
        for (int ai = 0; ai < 2; ++ai) {
            v4u ga[4][2], gb[4][2];
#pragma unroll
            for (int m = 0; m < 4; ++m) { const bf16* gp = gates + (size_t)(row0 + ai * 128 + m * 16) * NGATE + bo + col0;
#pragma unroll
                for (int bj = 0; bj < 2; ++bj) { ga[m][bj] = *(const v4u*)(gp + bj * 128); gb[m][bj] = *(const v4u*)(gp + DM + bj * 128); } }
#pragma unroll
            for (int m = 0; m < 4; ++m)
#pragma unroll
                for (int bj = 0; bj < 2; ++bj) { float x[8], y[8]; unpack8(ga[m][bj], x); unpack8(gb[m][bj], y);
#pragma unroll
                    for (int i = 0; i < 4; ++i) { acc[ai][bj][m][0][i] *= x[i] * __builtin_amdgcn_rcpf(y[i]); acc[ai][bj][m][1][i] *= x[4 + i] * __builtin_amdgcn_rcpf(y[4 + i]); } }
            __builtin_amdgcn_sched_barrier(0);
        }
    }
    __device__ __forceinline__ void operator()(const f32x4 (&acc)[2][2][4][2], const Unit& u, int wr, int wc, int fr, int fq) const {
        int row0 = u.pm * 256 + wr * 64 + fr, col0 = u.pn * 256 + wc * 32 + 8 * fq;
        asm volatile("" : "+v"(row0), "+v"(col0));
#pragma unroll
        for (int ai = 0; ai < 2; ++ai) {
            v4u gg[4][2];
#pragma unroll
            for (int m = 0; m < 4; ++m)
#pragma unroll
                for (int bj = 0; bj < 2; ++bj) gg[m][bj] = *(const v4u*)(gates + (size_t)(row0 + ai * 128 + m * 16) * NGATE + 2 * DM + col0 + bj * 128);
#pragma unroll
            for (int m = 0; m < 4; ++m) { const size_t r = (size_t)(row0 + ai * 128 + m * 16);
#pragma unroll
                for (int bj = 0; bj < 2; ++bj) { const v4u g = gg[m][bj]; float x[8]; unpack8(g, x);
                    const f32x4 v0 = acc[ai][bj][m][0], v1 = acc[ai][bj][m][1];
                    v4u w; w.x = pk2(v0[0] * x[0], v0[1] * x[1]); w.y = pk2(v0[2] * x[2], v0[3] * x[3]); w.z = pk2(v1[0] * x[4], v1[1] * x[5]); w.w = pk2(v1[2] * x[6], v1[3] * x[7]);
                    *(v4u*)(O + r * DM + col0 + bj * 128) = w; } }
            __builtin_amdgcn_sched_barrier(0);
        }
    }
};
struct EpiOut {
    static constexpr bool PERM = true, AFTER_DRAIN = false, KHOOK = false; static constexpr int HK0 = -1, HK1 = -1;
    float* O; const float* X;
    __device__ __forceinline__ void operator()(const f32x4 (&acc)[2][2][4][2], const Unit& u, int wr, int wc, int fr, int fq) const {
        int row0 = u.pm * 256 + wr * 64 + fr, col0 = u.pn * 256 + wc * 32 + 8 * fq;
        asm volatile("" : "+v"(row0), "+v"(col0));
#pragma unroll
        for (int ai = 0; ai < 2; ++ai) {
            f32x4 xa[4][2], xb[4][2];
#pragma unroll
            for (int m = 0; m < 4; ++m) { const size_t o = (size_t)(row0 + ai * 128 + m * 16) * DM + col0;
#pragma unroll
                for (int bj = 0; bj < 2; ++bj) { xa[m][bj] = *(const f32x4*)(X + o + bj * 128); xb[m][bj] = *(const f32x4*)(X + o + bj * 128 + 4); } }
#pragma unroll
            for (int m = 0; m < 4; ++m) { const size_t o = (size_t)(row0 + ai * 128 + m * 16) * DM + col0;
#pragma unroll
                for (int bj = 0; bj < 2; ++bj) { *(f32x4*)(O + o + bj * 128) = xa[m][bj] + acc[ai][bj][m][0]; *(f32x4*)(O + o + bj * 128 + 4) = xb[m][bj] + acc[ai][bj][m][1]; } }
            __builtin_amdgcn_sched_barrier(0);
        }
    }
};

__device__ __forceinline__ float wave_sum(float v) {
#pragma unroll
    for (int o = 1; o < 64; o <<= 1) v += __shfl_xor(v, o);
    return v;
}
__device__ __forceinline__ void transpose_item(const float* W, int N, bf16* WT, int ldt, int koff, LAS float* scr, int item, int lane) {
    const int nblk = N / 32, kb = item / nblk, nb = item % nblk, k0 = 64 * kb, n0 = 32 * nb;
    float tv[32];
#pragma unroll
    for (int i = 0; i < 32; ++i) { const int kk = 2 * i + (lane >> 5); tv[i] = W[(size_t)(k0 + kk) * N + n0 + (lane & 31)]; }
#pragma unroll
    for (int i = 0; i < 32; ++i) { const int kk = 2 * i + (lane >> 5); scr[kk * 33 + (lane & 31)] = tv[i]; }
    asm volatile("s_waitcnt lgkmcnt(0)" ::: "memory");
    const int c = lane & 7;
#pragma unroll
    for (int j = 0; j < 4; ++j) { const int n = (lane >> 3) + 8 * j; const LAS float* s = scr + (8 * c) * 33 + n;
        v4u o; o.x = pk2(s[0 * 33], s[1 * 33]); o.y = pk2(s[2 * 33], s[3 * 33]); o.z = pk2(s[4 * 33], s[5 * 33]); o.w = pk2(s[6 * 33], s[7 * 33]);
        *(v4u*)(WT + (size_t)(n0 + n) * ldt + koff + k0 + 8 * c) = o; }
    asm volatile("s_waitcnt lgkmcnt(0)" ::: "memory");
}
__device__ __forceinline__ void rms_row_to_bf16(const float* xrow, const float* g, bf16* orow, int lane) {
    const f32x4* xr = (const f32x4*)xrow + lane; const f32x4* gr = (const f32x4*)g + lane;
    f32x4 v[8]; float s = 0.f;
#pragma unroll
    for (int j = 0; j < 8; ++j) { v[j] = xr[64 * j]; s += (v[j].x * v[j].x + v[j].y * v[j].y) + (v[j].z * v[j].z + v[j].w * v[j].w); }
    const float rstd = 1.f / sqrtf(wave_sum(s) * (1.f / DM) + NORM_EPS);
    v2u* o8 = (v2u*)orow + lane;
#pragma unroll
    for (int j = 0; j < 8; ++j) { const f32x4 gg = gr[64 * j]; v2u o; o.x = pk2(v[j].x * rstd * gg.x, v[j].y * rstd * gg.y); o.y = pk2(v[j].z * rstd * gg.z, v[j].w * rstd * gg.w); o8[64 * j] = o; }
}
__device__ __forceinline__ void p0_prologue(const Params& P, LAS unsigned char* lds, float* dout_scratch) {
    const int tid = pg8::mk_tid(lds), lane = tid & 63, wave = tid >> 6, G = gridDim.x;
    LAS float* scr = (LAS float*)(lds + wave * 16384);
    const int gw = blockIdx.x * NWAVES + wave, NGW = G * NWAVES;
    unsigned char* ws = P.ws; unsigned char* dob = (unsigned char*)P.out;
    bf16* WIN_T = (bf16*)(dob + DO_WIN); bf16* WCAT_T = (bf16*)(ws + WS_WCAT); bf16* WOUT_T = (bf16*)(ws + WS_WOUT); bf16* WXKV_T = (bf16*)(ws + WS_WXKV);
    constexpr int I_IN = 32 * (NIN / 32), I_A = 12 * 64, I_R = 12 * 64, I_X = 8 * 64, I_O = 32 * 64, I_KV = 32 * 32;
    constexpr int NITEMS = I_IN + I_A + I_R + I_X + I_O + I_KV;
    for (int it = gw; it < NITEMS; it += NGW) {
        int r = it;
        if (r < I_IN) { transpose_item(P.in[4], NIN, WIN_T, DM, 0, scr, r, lane); continue; } r -= I_IN;
        if (r < I_A) { transpose_item(P.in[9], DM, WCAT_T, DM, 0, scr, r, lane); continue; } r -= I_A;
        if (r < I_R) { transpose_item(P.in[20], DM, WCAT_T, DM, 768, scr, r, lane); continue; } r -= I_R;
        if (r < I_X) { transpose_item(P.in[24], DM, WCAT_T, DM, 1536, scr, r, lane); continue; } r -= I_X;
        if (r < I_O) { transpose_item(P.in[25], DM, WOUT_T, DM, 0, scr, r, lane); continue; } r -= I_O;
        transpose_item(P.in[21], 1024, WXKV_T, DM, 0, scr, r, lane);
    }
    bf16* H = (bf16*)(dob + DO_H); bf16* MEMN = (bf16*)(ws + WS_MEMN);
    for (int m = gw; m < M_TOK + MEMROWS; m += NGW) {
        if (m < M_TOK) rms_row_to_bf16(P.in[0] + (size_t)m * DM, P.in[2], H + (size_t)m * DM, lane);
        else rms_row_to_bf16(P.in[1] + (size_t)(m - M_TOK) * DM, P.in[3], MEMN + (size_t)(m - M_TOK) * DM, lane);
    }
    if (blockIdx.x == 0 && tid == 0) __hip_atomic_store((unsigned*)(ws + WS_CTR), 0u, __ATOMIC_RELAXED, __HIP_MEMORY_SCOPE_AGENT);
    bf16* LB = (bf16*)(ws + WS_LORAB);
    const int gt = blockIdx.x * NTHREADS + tid, NGT = G * NTHREADS;
    for (int idx = gt; idx < NLORA * 256; idx += NGT) {
        const int n = idx >> 8, k = idx & 255, d = n / RW, ch = n % RW, kb = k >> 6, kk = k & 63;
        float v = 0.f;
        if (kb == d) v = (d < 2) ? P.in[15][(size_t)(d * 64 + kk) * RW + ch] : P.in[17][(size_t)((d - 2) * 64 + kk) * RW + ch];
        LB[idx] = (bf16)f2bf(v);
    }
    float* RC = (float*)(ws + WS_ROPE); float* RS = RC + SEQ * 32;
    for (int idx = gt; idx < SEQ * 32; idx += NGT) {
        const int pos = idx >> 5, i = idx & 31;
        const float inv = __builtin_exp2f(-(float)i * (13.287712379549449f / 32.f));
        const float ang = (float)pos * inv;
        double rv = (double)ang * 0.15915494309189535; rv -= __builtin_floor(rv);
        const float r = (float)rv;
        RC[idx] = __builtin_amdgcn_cosf(r); RS[idx] = __builtin_amdgcn_sinf(r);
    }
}

__device__ __forceinline__ void p2_lora_in(const Params& P, LAS unsigned char* lds) {
    const bf16* PRE = (const bf16*)(P.ws + WS_PRE); bf16* LIN = (bf16*)((unsigned char*)P.out + DO_LIN); const float* mu = P.in[10];
    const int gt = blockIdx.x * NTHREADS + pg8::mk_tid(lds), NGT = gridDim.x * NTHREADS;
    for (int idx = gt; idx < M_TOK * 32; idx += NGT) {
        const int m = idx >> 5, j = (idx & 31) * 8, t = m & (SEQ - 1);
        const bf16* p = PRE + (size_t)m * NPRE + C_LORA + j;
        const v4u z4 = (v4u){0u, 0u, 0u, 0u};
        const v4u c = *(const v4u*)p, pv = (t > 0) ? *(const v4u*)(p - NPRE) : z4, nx = (t < SEQ - 1) ? *(const v4u*)(p + NPRE) : z4;
        const f32x4 m0 = *(const f32x4*)(mu + 2304 + j), m1 = *(const f32x4*)(mu + 2304 + j + 4);
        float xc[8], xp[8], xn[8], s[8]; unpack8(c, xc); unpack8(pv, xp); unpack8(nx, xn);
#pragma unroll
        for (int i = 0; i < 8; ++i) { const float mm = (i < 4) ? m0[i & 3] : m1[i & 3]; s[i] = xc[i] + mm * (0.5f * (xp[i] + xn[i]) - xc[i]);
            if (j < 128) s[i] = 1.f - 2.f * __builtin_amdgcn_rcpf(__expf(2.f * s[i]) + 1.f); }
        v4u o; o.x = pk2(s[0], s[1]); o.y = pk2(s[2], s[3]); o.z = pk2(s[4], s[5]); o.w = pk2(s[6], s[7]);
        *(v4u*)(LIN + (size_t)m * 256 + j) = o;
    }
}

constexpr int SC_CH = 32, SC_REC = 1536, SC_BUF = SC_CH * SC_REC, SC_SCAL = 2 * SC_BUF;
template <int MODE> __device__ __forceinline__ void scan_block(const Params& P, int sid, LAS unsigned char* lds) {
    const int tid = pg8::mk_tid(lds), lane = tid & 63, wave = __builtin_amdgcn_readfirstlane(tid >> 6);
    const int b = sid / 24, rem = sid % 24, h = rem >> 1, dir = rem & 1;
    const bf16* PRE = (const bf16*)(P.ws + WS_PRE); const bf16* EA = (const bf16*)((unsigned char*)P.out + DO_EA);
    bf16* YO = dir ? (bf16*)(P.ws + WS_YB) : (bf16*)((unsigned char*)P.out + DO_YF);
    constexpr int NCH = SEQ / SC_CH;
#define SC_BAR() do { asm volatile("s_waitcnt lgkmcnt(0)" ::: "memory"); __builtin_amdgcn_s_barrier(); asm volatile("" ::: "memory"); } while (0)
    if (wave >= 4) {
        const int pt = tid - 256, sl = pt >> 3, e = pt & 7, ch0 = h * 64 + 8 * e;
        float mur[8], muk[8], muv[8], kkc[8], kac[8];
#pragma unroll
        for (int i = 0; i < 8; ++i) { mur[i] = P.in[10][ch0 + i]; muk[i] = P.in[10][768 + ch0 + i]; muv[i] = P.in[10][1536 + ch0 + i]; kkc[i] = P.in[11][ch0 + i]; kac[i] = P.in[12][ch0 + i]; }
        v4u rc, kc, vc, rp, kp, vp, rn, kn, vn, e8, a8;
        const v4u z4 = (v4u){0u, 0u, 0u, 0u};
#define SC_PLOAD(c_) do { const int step_ = (c_) * SC_CH + sl, t_ = dir ? (SEQ - 1 - step_) : step_; const size_t m_ = (size_t)b * SEQ + t_; \
            const bf16* rowp_ = PRE + m_ * NPRE + C_RS + ch0; \
            rc = *(const v4u*)(rowp_); kc = *(const v4u*)(rowp_ + 768); vc = *(const v4u*)(rowp_ + 1536); \
            rp = (t_ > 0) ? *(const v4u*)(rowp_ - NPRE) : z4; kp = (t_ > 0) ? *(const v4u*)(rowp_ - NPRE + 768) : z4; vp = (t_ > 0) ? *(const v4u*)(rowp_ - NPRE + 1536) : z4; \
            rn = (t_ < SEQ - 1) ? *(const v4u*)(rowp_ + NPRE) : z4; kn = (t_ < SEQ - 1) ? *(const v4u*)(rowp_ + NPRE + 768) : z4; vn = (t_ < SEQ - 1) ? *(const v4u*)(rowp_ + NPRE + 1536) : z4; \
            const bf16* eap_ = EA + m_ * NLORA + dir * RW + ch0; e8 = *(const v4u*)(eap_); a8 = *(const v4u*)(eap_ + 1536); } while (0)
#define SC_PWRITE(c_) do { LAS unsigned char* buf_ = lds + ((c_) & 1) * SC_BUF; LAS float* scal_ = (LAS float*)(lds + SC_SCAL) + ((c_) & 1) * (SC_CH * 2); \
            float r[8], k[8], v[8], x0[8], x1[8], x2[8]; \
            unpack8(rc, x0); unpack8(rp, x1); unpack8(rn, x2); \
            _Pragma("unroll") for (int i = 0; i < 8; ++i) r[i] = x0[i] + mur[i] * (0.5f * (x1[i] + x2[i]) - x0[i]); \
            unpack8(kc, x0); unpack8(kp, x1); unpack8(kn, x2); \
            _Pragma("unroll") for (int i = 0; i < 8; ++i) k[i] = x0[i] + muk[i] * (0.5f * (x1[i] + x2[i]) - x0[i]); \
            unpack8(vc, x0); unpack8(vp, x1); unpack8(vn, x2); \
            _Pragma("unroll") for (int i = 0; i < 8; ++i) v[i] = x0[i] + muv[i] * (0.5f * (x1[i] + x2[i]) - x0[i]); \
            float ee[8], aa[8]; unpack8(e8, ee); unpack8(a8, aa); \
            float kk[8], ss = 0.f; \
            _Pragma("unroll") for (int i = 0; i < 8; ++i) { kk[i] = k[i] * kkc[i]; ss += kk[i] * kk[i]; } \
            ss = red8(ss); \
            const float inv = 1.f / fmaxf(sqrtf(ss), 1e-12f); \
            float nkk[8], dd[8], dr[8], bb[8], kd[8], sbr = 0.f, skr = 0.f; \
            _Pragma("unroll") for (int i = 0; i < 8; ++i) { \
                const float kki = kk[i] * inv; nkk[i] = -kki; dd[i] = __expf(-ee[i]); dr[i] = dd[i] * r[i]; \
                bb[i] = kki * aa[i]; kd[i] = k[i] * (1.f + (aa[i] - 1.f) * kac[i]); sbr += bb[i] * r[i]; skr += kd[i] * r[i]; } \
            sbr = red8(sbr); skr = red8(skr); \
            LAS float* rec = (LAS float*)(buf_ + sl * SC_REC) + 8 * e; \
            *(LAS f32x4*)(rec) = (f32x4){nkk[0], nkk[1], nkk[2], nkk[3]}; *(LAS f32x4*)(rec + 4) = (f32x4){nkk[4], nkk[5], nkk[6], nkk[7]}; \
            *(LAS f32x4*)(rec + 64) = (f32x4){dr[0], dr[1], dr[2], dr[3]}; *(LAS f32x4*)(rec + 68) = (f32x4){dr[4], dr[5], dr[6], dr[7]}; \
            *(LAS f32x4*)(rec + 128) = (f32x4){dd[0], dd[1], dd[2], dd[3]}; *(LAS f32x4*)(rec + 132) = (f32x4){dd[4], dd[5], dd[6], dd[7]}; \
            *(LAS f32x4*)(rec + 192) = (f32x4){bb[0], bb[1], bb[2], bb[3]}; *(LAS f32x4*)(rec + 196) = (f32x4){bb[4], bb[5], bb[6], bb[7]}; \
            *(LAS f32x4*)(rec + 256) = (f32x4){kd[0], kd[1], kd[2], kd[3]}; *(LAS f32x4*)(rec + 260) = (f32x4){kd[4], kd[5], kd[6], kd[7]}; \
            *(LAS f32x4*)(rec + 320) = (f32x4){v[0], v[1], v[2], v[3]}; *(LAS f32x4*)(rec + 324) = (f32x4){v[4], v[5], v[6], v[7]}; \
            if (e == 0) *(LAS f32x2*)(scal_ + 2 * sl) = (f32x2){sbr, skr}; } while (0)
        if (!(MODE & 2)) { SC_PLOAD(0); SC_PWRITE(0); SC_PLOAD(1); }
        SC_BAR();
        for (int c = 0; c < NCH; ++c) {
            if (!(MODE & 2)) { if (c + 1 < NCH) SC_PWRITE(c + 1);
            if (c + 2 < NCH) SC_PLOAD(c + 2); }
            SC_BAR();
        }
#undef SC_PLOAD
#undef SC_PWRITE
    } else {
        const int rp = (wave * 64 + lane) >> 3, cgp = lane & 7;
        f32x2 s0[4], s1[4];
#pragma unroll
        for (int i = 0; i < 4; ++i) { s0[i] = (f32x2){0.f, 0.f}; s1[i] = (f32x2){0.f, 0.f}; }
        bf16* yrow = YO + (size_t)b * SEQ * RW + h * 64 + 2 * rp;
        SC_BAR();
#define SC_LOAD(N0, N1, Q0, Q1, D0, D1, B0, B1, K0, K1, VV, SS, sl_) do { const LAS float* rec_ = (const LAS float*)(buf + (sl_) * SC_REC) + 8 * cgp; \
            N0 = *(const LAS f32x4*)(rec_); N1 = *(const LAS f32x4*)(rec_ + 4); Q0 = *(const LAS f32x4*)(rec_ + 64); Q1 = *(const LAS f32x4*)(rec_ + 68); \
            D0 = *(const LAS f32x4*)(rec_ + 128); D1 = *(const LAS f32x4*)(rec_ + 132); B0 = *(const LAS f32x4*)(rec_ + 192); B1 = *(const LAS f32x4*)(rec_ + 196); \
            K0 = *(const LAS f32x4*)(rec_ + 256); K1 = *(const LAS f32x4*)(rec_ + 260); \
            VV = *(const LAS f32x2*)((const LAS float*)(buf + (sl_) * SC_REC) + 320 + 2 * rp); SS = *(const LAS f32x2*)(scal + 2 * (sl_)); } while (0)
        for (int c = 0; c < NCH; ++c) {
            const LAS unsigned char* buf = lds + (c & 1) * SC_BUF; const LAS float* scal = (const LAS float*)(lds + SC_SCAL) + (c & 1) * (SC_CH * 2);
            f32x4 n0, n1, q0, q1, d0, d1, b0, b1, k0, k1; f32x2 vv, sc;
            SC_LOAD(n0, n1, q0, q1, d0, d1, b0, b1, k0, k1, vv, sc, 0);
#pragma unroll 2
            for (int sl = 0; sl < SC_CH; ++sl) {
                f32x4 xn0, xn1, xq0, xq1, xd0, xd1, xb0, xb1, xk0, xk1; f32x2 xvv, xsc;
                const int sn = (sl + 1 < SC_CH) ? sl + 1 : sl;
                const f32x2 nk[4] = {(f32x2){n0.x, n0.y}, (f32x2){n0.z, n0.w}, (f32x2){n1.x, n1.y}, (f32x2){n1.z, n1.w}};
                const f32x2 qq[4] = {(f32x2){q0.x, q0.y}, (f32x2){q0.z, q0.w}, (f32x2){q1.x, q1.y}, (f32x2){q1.z, q1.w}};
                const f32x2 dv[4] = {(f32x2){d0.x, d0.y}, (f32x2){d0.z, d0.w}, (f32x2){d1.x, d1.y}, (f32x2){d1.z, d1.w}};
                const f32x2 bv[4] = {(f32x2){b0.x, b0.y}, (f32x2){b0.z, b0.w}, (f32x2){b1.x, b1.y}, (f32x2){b1.z, b1.w}};
                const f32x2 kv[4] = {(f32x2){k0.x, k0.y}, (f32x2){k0.z, k0.w}, (f32x2){k1.x, k1.y}, (f32x2){k1.z, k1.w}};
                f32x2 a0 = s0[0] * nk[0], a1 = s1[0] * nk[0], y0 = s0[0] * qq[0], y1 = s1[0] * qq[0];
#pragma unroll
                for (int i = 1; i < 4; ++i) { a0 = s0[i] * nk[i] + a0; a1 = s1[i] * nk[i] + a1; y0 = s0[i] * qq[i] + y0; y1 = s1[i] * qq[i] + y1; }
                float sa0 = a0.x + a0.y, sa1 = a1.x + a1.y, yp0 = y0.x + y0.y, yp1 = y1.x + y1.y;
                SC_LOAD(xn0, xn1, xq0, xq1, xd0, xd1, xb0, xb1, xk0, xk1, xvv, xsc, sn);
                sa0 = red8(sa0); sa1 = red8(sa1); yp0 = red8(yp0); yp1 = red8(yp1);
                const float yo0 = yp0 + sa0 * sc.x + vv.x * sc.y, yo1 = yp1 + sa1 * sc.x + vv.y * sc.y;
                const f32x2 sa0v = (f32x2){sa0, sa0}, sa1v = (f32x2){sa1, sa1}, v0v = (f32x2){vv.x, vv.x}, v1v = (f32x2){vv.y, vv.y};
#pragma unroll
                for (int i = 0; i < 4; ++i) {
                    f32x2 t0 = v0v * kv[i]; t0 = sa0v * bv[i] + t0; s0[i] = s0[i] * dv[i] + t0;
                    f32x2 t1 = v1v * kv[i]; t1 = sa1v * bv[i] + t1; s1[i] = s1[i] * dv[i] + t1;
                }
                const int step = c * SC_CH + sl, t = dir ? (SEQ - 1 - step) : step;
                const unsigned yw = pk2(yo0, yo1);
                if (!(MODE & 1)) { if (cgp == 0) *(unsigned*)(yrow + (size_t)t * RW) = yw; } else { asm volatile("" :: "v"(yw)); }
                n0 = xn0; n1 = xn1; q0 = xq0; q1 = xq1; d0 = xd0; d1 = xd1; b0 = xb0; b1 = xb1; k0 = xk0; k1 = xk1; vv = xvv; sc = xsc;
            }
            SC_BAR();
        }
#undef SC_LOAD
    }
#undef SC_BAR
    __syncthreads();
}

__device__ __forceinline__ bf16x8 pack8(const float (&x)[8]) {
    v4u w; w.x = pk2(x[0], x[1]); w.y = pk2(x[2], x[3]); w.z = pk2(x[4], x[5]); w.w = pk2(x[6], x[7]); return __builtin_bit_cast(bf16x8, w);
}
#define MFMA16(a, b, c) __builtin_amdgcn_mfma_f32_16x16x32_bf16((a), (b), (c), 0, 0, 0)
constexpr int CK = 16, NCK = SEQ / CK;
constexpr int L_QK = 0, L_PR = 4608, L_QKT = 9216, L_VT = 14336, L_VF = 19456, L_GC = 23552, L_OPSZ = 23808;
constexpr int WP = 68, L_WSZ = 16 * WP * 4;
constexpr int L_E = 2 * L_OPSZ, L_G = L_E + 4096, L_GSZ = 5120, L_W0 = L_G + 2 * L_GSZ, L_VG = L_W0 + L_WSZ, L_SB = L_VG + 2 * L_WSZ, L_CEND = L_SB + 9216;
static_assert(L_CEND + 1280 <= 131072, "chunked scan LDS map");
#ifdef CBAR_FULL
#define CBAR() __syncthreads()
#else
#define CBAR() do { __builtin_amdgcn_s_waitcnt(0xC07F); __builtin_amdgcn_s_barrier(); } while (0)
#endif
__device__ __forceinline__ void scan_chunked(const Params& P, int sid, LAS unsigned char* lds) {
    const int tid = pg8::mk_tid(lds), lane = tid & 63, wave = __builtin_amdgcn_readfirstlane(tid >> 6), l15 = lane & 15, q4 = lane >> 4;
    const int b = sid / 24, rem = sid % 24, h = rem >> 1, dir = rem & 1;
    const bf16* PRE = (const bf16*)(P.ws + WS_PRE); const bf16* EA = (const bf16*)((unsigned char*)P.out + DO_EA);
    bf16* YO = dir ? (bf16*)(P.ws + WS_YB) : (bf16*)((unsigned char*)P.out + DO_YF);
#ifdef YZERO
    for (int it = tid; it < SEQ * 8; it += NTHREADS) *(v4u*)(YO + ((size_t)b * SEQ + (it >> 3)) * RW + h * 64 + (it & 7) * 8) = (v4u){0u, 0u, 0u, 0u};
#endif
    for (int i = tid; i < 9216 / 4; i += NTHREADS) ((LAS unsigned*)(lds + L_SB))[i] = 0u;
    for (int i = tid; i < L_SB / 4; i += NTHREADS) ((LAS unsigned*)(lds))[i] = 0u;
    if (tid < 320) { const int vsel = tid >> 6, chn = h * 64 + (tid & 63);
        ((LAS float*)(lds + L_CEND))[tid] = (vsel < 3) ? P.in[10][vsel * 768 + chn] : ((vsel == 3) ? P.in[11][chn] : P.in[12][chn]); }
    CBAR();
    if (wave >= 4) {
        const int pt = tid - 256, t = pt >> 4, e = pt & 15, ch0 = h * 64 + 4 * e, gsw = 8 * ((e >> 1) & 3);
        const LAS float* cst = (const LAS float*)(lds + L_CEND) + 4 * e;
        v2u rcA, kcA, vcA, rpA, kpA, vpA, rnA, knA, vnA, e8A, a8A, rcB, kcB, vcB, rpB, kpB, vpB, rnB, knB, vnB, e8B, a8B;
        const v2u z2 = (v2u){0u, 0u};
#define CK_PLOAD(X, c_) do { const int step_ = (c_) * CK + t, t_ = dir ? (SEQ - 1 - step_) : step_; const size_t m_ = (size_t)b * SEQ + t_; \
            const bf16* rowp_ = PRE + m_ * NPRE + C_RS + ch0; \
            const bf16* rowq_ = (t_ > 0) ? rowp_ - NPRE : rowp_; const bf16* rown_ = (t_ < SEQ - 1) ? rowp_ + NPRE : rowp_;     \
            rc##X = *(const v2u*)(rowp_); kc##X = *(const v2u*)(rowp_ + 768); vc##X = *(const v2u*)(rowp_ + 1536); \
            rp##X = *(const v2u*)(rowq_); kp##X = *(const v2u*)(rowq_ + 768); vp##X = *(const v2u*)(rowq_ + 1536); \
            rn##X = *(const v2u*)(rown_); kn##X = *(const v2u*)(rown_ + 768); vn##X = *(const v2u*)(rown_ + 1536); \
            const bf16* eap_ = EA + m_ * NLORA + dir * RW + ch0; e8##X = *(const v2u*)(eap_); a8##X = *(const v2u*)(eap_ + 1536); } while (0)
        CK_PLOAD(A, 0); CK_PLOAD(B, 1);
        float r[4], k[4], v[4], kk[4], aa[4], ee[4];
#define CK_PBODY(X, c_) do { const int c = (c_); const int pb = (c & 1) * L_OPSZ; \
            {   \
                float x0[4], x1[4], x2[4]; f32x4 cc; \
                const int stepc_ = ((c < NCK) ? c : NCK - 1) * CK + t, tc_ = dir ? (SEQ - 1 - stepc_) : stepc_; const float fp_ = (tc_ > 0) ? 1.f : 0.f, fn_ = (tc_ < SEQ - 1) ? 1.f : 0.f; \
                unpack4(rc##X, x0); unpack4(rp##X, x1); unpack4(rn##X, x2); cc = *(const LAS f32x4*)(cst); \
                _Pragma("unroll") for (int i = 0; i < 4; ++i) r[i] = x0[i] + cc[i] * (0.5f * (fp_ * x1[i] + fn_ * x2[i]) - x0[i]); \
                unpack4(kc##X, x0); unpack4(kp##X, x1); unpack4(kn##X, x2); cc = *(const LAS f32x4*)(cst + 64); \
                _Pragma("unroll") for (int i = 0; i < 4; ++i) k[i] = x0[i] + cc[i] * (0.5f * (fp_ * x1[i] + fn_ * x2[i]) - x0[i]); \
                unpack4(vc##X, x0); unpack4(vp##X, x1); unpack4(vn##X, x2); cc = *(const LAS f32x4*)(cst + 128); \
                _Pragma("unroll") for (int i = 0; i < 4; ++i) v[i] = x0[i] + cc[i] * (0.5f * (fp_ * x1[i] + fn_ * x2[i]) - x0[i]); \
                unpack4(e8##X, ee); unpack4(a8##X, aa); cc = *(const LAS f32x4*)(cst + 192); \
                float ss = 0.f; \
                _Pragma("unroll") for (int i = 0; i < 4; ++i) { kk[i] = k[i] * cc[i]; ss += kk[i] * kk[i]; } \
                ss = red8(ss); ss = dpp_add<0x140>(ss); \
                const float inv = __builtin_amdgcn_rcpf(fmaxf(__builtin_amdgcn_sqrtf(ss), 1e-12f)); \
                _Pragma("unroll") for (int i = 0; i < 4; ++i) kk[i] *= inv; \
                *(LAS f32x4*)((LAS float*)(lds + L_E) + t * 64 + 4 * e) = (f32x4){ee[0], ee[1], ee[2], ee[3]}; \
                CK_PLOAD(X, (c + 2 < NCK) ? c + 2 : NCK - 1); \
            } \
            CBAR(); \
            { \
                f32x4 gs = (f32x4){0.f, 0.f, 0.f, 0.f}; \
                _Pragma("unroll") for (int u = 0; u < CK; ++u) { \
                    const f32x4 ea = *(const LAS f32x4*)((const LAS float*)(lds + L_E) + u * 64 + 4 * e); \
                    const float m = (u <= t) ? 1.f : 0.f; gs += m * ea; } \
                const f32x4 kac = *(const LAS f32x4*)(cst + 256); \
                float qv[4], kt[4], pv[4], rt[4], gin[4]; \
                _Pragma("unroll") for (int i = 0; i < 4; ++i) { \
                    gin[i] = __expf(-gs[i]); const float gex = __expf(ee[i] - gs[i]), ginv = __expf(gs[i]); \
                    const float kd = k[i] * (1.f + (aa[i] - 1.f) * kac[i]); \
                    qv[i] = kk[i] * aa[i] * ginv; kt[i] = kd * ginv; pv[i] = kk[i] * gex; rt[i] = r[i] * gin[i]; \
                } \
                LAS unsigned char* ob = lds + pb; \
                unsigned wq[4]; v2u o; \
                _Pragma("unroll") for (int i = 0; i < 4; ++i) wq[i] = pk2(qv[i], kt[i]);                        \
                o.x = (wq[0] & 0xffffu) | (wq[1] << 16); o.y = (wq[2] & 0xffffu) | (wq[3] << 16); *(LAS v2u*)(ob + L_QK + (t * 72 + 4 * e) * 2) = o; \
                o.x = (wq[0] >> 16) | (wq[1] & 0xffff0000u); o.y = (wq[2] >> 16) | (wq[3] & 0xffff0000u); *(LAS v2u*)(ob + L_QK + ((16 + t) * 72 + 4 * e) * 2) = o; \
                o.x = pk2(pv[0], pv[1]); o.y = pk2(pv[2], pv[3]); *(LAS v2u*)(ob + L_PR + (t * 72 + 4 * e) * 2) = o; \
                o.x = pk2(rt[0], rt[1]); o.y = pk2(rt[2], rt[3]); *(LAS v2u*)(ob + L_PR + ((16 + t) * 72 + 4 * e) * 2) = o; \
                const unsigned wv01 = pk2(v[0], v[1]), wv23 = pk2(v[2], v[3]); \
                _Pragma("unroll") for (int i = 0; i < 4; ++i) { \
                    *(LAS bf16*)(ob + L_QKT + ((4 * e + i) * 40 + (t ^ gsw)) * 2) = (bf16)(wq[i] & 0xffffu); *(LAS bf16*)(ob + L_QKT + ((4 * e + i) * 40 + ((16 + t) ^ gsw)) * 2) = (bf16)(wq[i] >> 16); \
                    const unsigned wv = (i < 2) ? wv01 : wv23; \
                    *(LAS bf16*)(ob + L_VT + ((4 * e + i) * 40 + ((16 + t) ^ gsw)) * 2) = (bf16)((i & 1) ? (wv >> 16) : (wv & 0xffffu)); \
                } \
                if (t == CK - 1) *(LAS f32x4*)((LAS float*)(ob + L_GC) + 4 * e) = (f32x4){gin[0], gin[1], gin[2], gin[3]}; \
            } \
            CBAR(); \
            CBAR(); } while (0)
        static_assert((NCK + 2) % 2 == 0, "producer loop is unrolled by two");
        for (int c2 = 0; c2 <= NCK + 1; c2 += 2) { CK_PBODY(A, c2); CK_PBODY(B, c2 + 1); }
#undef CK_PBODY
#undef CK_PLOAD
    } else {
        const int w = wave;
        f32x4 acc[4];
#pragma unroll
        for (int nt = 0; nt < 4; ++nt) acc[nt] = (f32x4){0.f, 0.f, 0.f, 0.f};
        bf16* ybase = YO + (size_t)b * SEQ * RW + h * 64 + 16 * w + 4 * q4;
        for (int c = 0; c <= NCK + 1; ++c) {
            const int ck = c - 1; const bool valid = (ck >= 0 && ck < NCK);
            const int pb = (ck & 1) * L_OPSZ, gb = L_G + (ck & 1) * L_GSZ;
            f32x4 r1 = (f32x4){0.f, 0.f, 0.f, 0.f};
            if (valid) {
                f32x4 r0 = (f32x4){0.f, 0.f, 0.f, 0.f};
#pragma unroll
                for (int ks = 0; ks < 2; ++ks) {
                    const bf16x8 S = *(const LAS bf16x8*)(lds + L_SB + ((16 * w + l15) * 72 + ks * 32 + 8 * q4) * 2);
                    const bf16x8 Bp = *(const LAS bf16x8*)(lds + pb + L_PR + ((l15) * 72 + ks * 32 + 8 * q4) * 2);
                    const bf16x8 Br = *(const LAS bf16x8*)(lds + pb + L_PR + ((16 + l15) * 72 + ks * 32 + 8 * q4) * 2);
                    r0 = MFMA16(S, Bp, r0); r1 = MFMA16(S, Br, r1);
                }
                *(LAS f32x4*)(lds + L_W0 + (l15 * WP + 16 * w + 4 * q4) * 4) = r0;
            }
            if (valid && w == 1) {
#pragma unroll
                for (int x = 0; x < 4; ++x) {
                    const int a = x >> 1, bc = x & 1;
                    f32x4 g = (f32x4){0.f, 0.f, 0.f, 0.f};
#pragma unroll
                    for (int ks = 0; ks < 2; ++ks) {
                        const bf16x8 A = *(const LAS bf16x8*)(lds + pb + L_QK + ((a * 16 + l15) * 72 + ks * 32 + 8 * q4) * 2);
                        const bf16x8 Bm = *(const LAS bf16x8*)(lds + pb + L_PR + ((bc * 16 + l15) * 72 + ks * 32 + 8 * q4) * 2);
                        g = MFMA16(A, Bm, g);
                    }
                    *(LAS f32x4*)(lds + gb + x * 1280 + (l15 * 20 + 4 * q4) * 4) = g;
                }
                __builtin_amdgcn_s_waitcnt(0xC07F);
                float bw[8];
                {
                    const f32x4 ga = *(const LAS f32x4*)(lds + gb + 2 * 1280 + (l15 * 20 + 8 * (q4 & 1)) * 4), gb2 = *(const LAS f32x4*)(lds + gb + 2 * 1280 + (l15 * 20 + 8 * (q4 & 1) + 4) * 4);
#pragma unroll
                    for (int ii = 0; ii < 8; ++ii) { const int s = 8 * (q4 & 1) + ii; const float gv = (ii < 4) ? ga[ii & 3] : gb2[ii & 3]; bw[ii] = (q4 >= 2 && s < l15) ? gv : 0.f; }
                }
                const bf16x8 Bf = pack8(bw);
#pragma unroll
                for (int mt = 0; mt < 4; ++mt) {
                    const bf16x8 Av = *(const LAS bf16x8*)(lds + pb + L_VT + ((mt * 16 + l15) * 40 + 8 * (q4 ^ (((mt * 16 + l15) >> 3) & 3))) * 2);
                    f32x4 r = (f32x4){0.f, 0.f, 0.f, 0.f};
                    r = MFMA16(Av, Bf, r);
                    *(LAS f32x4*)(lds + L_VG + (ck & 1) * L_WSZ + (l15 * WP + mt * 16 + 4 * q4) * 4) = r;
                }
            }
            CBAR();
            if (valid && w == 0) {
                const int i = lane;
                float u[16];
#pragma unroll
                for (int s = 0; s < 16; ++s) u[s] = *(const LAS float*)(lds + L_W0 + (s * WP + i) * 4) + *(const LAS float*)(lds + L_VG + (ck & 1) * L_WSZ + (s * WP + i) * 4);
#pragma unroll
                for (int blk = 0; blk < 4; ++blk) {
                    f32x4 gq[4][4];
#pragma unroll
                    for (int tt = 0; tt < 4; ++tt)
#pragma unroll
                        for (int s4 = 0; s4 <= blk; ++s4) gq[tt][s4] = *(const LAS f32x4*)(lds + gb + 0 * 1280 + ((4 * blk + tt) * 20 + 4 * s4) * 4);
#pragma unroll
                    for (int s = 0; s < 4 * blk; ++s)
#pragma unroll
                        for (int tt = 0; tt < 4; ++tt) u[4 * blk + tt] -= gq[tt][s >> 2][s & 3] * u[s];
#pragma unroll
                    for (int tt = 1; tt < 4; ++tt)
#pragma unroll
                        for (int sp = 0; sp < tt; ++sp) u[4 * blk + tt] -= gq[tt][blk][sp] * u[4 * blk + sp];
                    __builtin_amdgcn_sched_barrier(0);
                }
                float n0[8], n1[8];
#pragma unroll
                for (int s = 0; s < 8; ++s) { n0[s] = -u[s]; n1[s] = -u[8 + s]; }
                *(LAS bf16x8*)(lds + pb + L_VT + (i * 40 + 8 * (0 ^ ((i >> 3) & 3))) * 2) = pack8(n0); *(LAS bf16x8*)(lds + pb + L_VT + (i * 40 + 8 * (1 ^ ((i >> 3) & 3))) * 2) = pack8(n1);
            }
            CBAR();
            if (valid) {
                const bf16x8 Bv = *(const LAS bf16x8*)(lds + pb + L_VT + ((16 * w + l15) * 40 + 8 * (q4 ^ (((16 * w + l15) >> 3) & 3))) * 2);
                {
                    const int xo = (q4 < 2) ? 1 : 3;
                    const f32x4 ga = *(const LAS f32x4*)(lds + gb + xo * 1280 + (l15 * 20 + 8 * (q4 & 1)) * 4), gb2 = *(const LAS f32x4*)(lds + gb + xo * 1280 + (l15 * 20 + 8 * (q4 & 1) + 4) * 4);
                    float bw[8];
#pragma unroll
                    for (int ii = 0; ii < 8; ++ii) { const int s = 8 * (q4 & 1) + ii; const float gv = (ii < 4) ? ga[ii & 3] : gb2[ii & 3]; bw[ii] = (s <= l15) ? gv : 0.f; }
                    const f32x4 y = MFMA16(Bv, pack8(bw), r1);
                    const int step = ck * CK + l15, tt = dir ? (SEQ - 1 - step) : step;
                    v2u o; o.x = pk2(y[0], y[1]); o.y = pk2(y[2], y[3]);
                    *(v2u*)(ybase + (size_t)tt * RW) = o;
                }
#pragma unroll
                for (int nt = 0; nt < 4; ++nt) {
                    const bf16x8 Aq = *(const LAS bf16x8*)(lds + pb + L_QKT + ((nt * 16 + l15) * 40 + 8 * (q4 ^ (((nt * 16 + l15) >> 3) & 3))) * 2);
                    acc[nt] = MFMA16(Aq, Bv, acc[nt]);
                    const f32x4 gc = *(const LAS f32x4*)(lds + pb + L_GC + (nt * 16 + 4 * q4) * 4);
                    acc[nt] = acc[nt] * gc;
                    v2u o; o.x = pk2(acc[nt][0], acc[nt][1]); o.y = pk2(acc[nt][2], acc[nt][3]);
                    *(LAS v2u*)(lds + L_SB + ((16 * w + l15) * 72 + nt * 16 + 4 * q4) * 2) = o;
                }
            }
            CBAR();
        }
    }
    __syncthreads();
}
#undef CBAR

constexpr int KA_P = 72, VA_P = 392;
__device__ __forceinline__ void attnA_item(const Params& P, int item, LAS unsigned char* lds) {
    const int tid = pg8::mk_tid(lds), lane = tid & 63, wave = __builtin_amdgcn_readfirstlane(tid >> 6), l15 = lane & 15, q4 = lane >> 4;
    const int b = item >> 6, n = (item >> 2) & 15, hk = item & 3;
    const bf16* PRE = (const bf16*)(P.ws + WS_PRE); bf16* YC = (bf16*)(P.ws + WS_YCAT);
    const float* RC = (const float*)(P.ws + WS_ROPE); const float* RS = RC + SEQ * 32;
    LAS bf16* Ks = (LAS bf16*)lds; LAS bf16* Vt = Ks + 384 * KA_P;
    {
        v2u klo[6], khi[6]; f32x4 kcs[6], ksn[6]; v4u vw[6];
#pragma unroll
        for (int u = 0; u < 6; ++u) {
            const int it = tid + u * NTHREADS, j = it >> 3, c = it & 7, kp = (n - 1) * 128 + j;
            const bool ok = (kp >= 0 && kp < SEQ); const int kpc = ok ? kp : 0;
            const bf16* src = PRE + ((size_t)b * SEQ + kpc) * NPRE + C_AK + hk * 64;
            klo[u] = *(const v2u*)(src + 4 * c); khi[u] = *(const v2u*)(src + 32 + 4 * c);
            kcs[u] = *(const f32x4*)(RC + kpc * 32 + 4 * c); ksn[u] = *(const f32x4*)(RS + kpc * 32 + 4 * c);
            vw[u] = *(const v4u*)(PRE + ((size_t)b * SEQ + kpc) * NPRE + C_AV + hk * 64 + 8 * c);
        }
        const f32x4 g1 = *(const f32x4*)(P.in[7] + 4 * (tid & 7)), g2 = *(const f32x4*)(P.in[7] + 32 + 4 * (tid & 7));
#pragma unroll
        for (int u = 0; u < 6; ++u) {
            const int it = tid + u * NTHREADS, j = it >> 3, c = it & 7, kp = (n - 1) * 128 + j;
            const bool ok = (kp >= 0 && kp < SEQ);
            float x1[4], x2[4]; unpack4(klo[u], x1); unpack4(khi[u], x2);
            float ss = 0.f;
#pragma unroll
            for (int i = 0; i < 4; ++i) ss += x1[i] * x1[i] + x2[i] * x2[i];
            ss = red8(ss);
            const float rstd = ok ? 1.f / sqrtf(ss * (1.f / 64.f) + NORM_EPS) : 0.f;
            float r1[4], r2[4];
#pragma unroll
            for (int i = 0; i < 4; ++i) { const float y1 = x1[i] * rstd * g1[i], y2 = x2[i] * rstd * g2[i]; r1[i] = y1 * kcs[u][i] - y2 * ksn[u][i]; r2[i] = y2 * kcs[u][i] + y1 * ksn[u][i]; }
            v2u o0, o1; o0.x = pk2(r1[0], r1[1]); o0.y = pk2(r1[2], r1[3]); o1.x = pk2(r2[0], r2[1]); o1.y = pk2(r2[2], r2[3]);
            *(LAS v2u*)(Ks + j * KA_P + 4 * c) = o0; *(LAS v2u*)(Ks + j * KA_P + 32 + 4 * c) = o1;
            const v4u w = ok ? vw[u] : (v4u){0u, 0u, 0u, 0u};
            LAS bf16* d = Vt + (8 * c) * VA_P + j;
            d[0] = (bf16)(w.x & 0xffffu); d[VA_P] = (bf16)(w.x >> 16); d[2 * VA_P] = (bf16)(w.y & 0xffffu); d[3 * VA_P] = (bf16)(w.y >> 16);
            d[4 * VA_P] = (bf16)(w.z & 0xffffu); d[5 * VA_P] = (bf16)(w.z >> 16); d[6 * VA_P] = (bf16)(w.w & 0xffffu); d[7 * VA_P] = (bf16)(w.w >> 16);
        }
    }
    v4u qlo, qhi;
    {
        const int R0 = wave * 48, g = R0 >> 7, pos = (R0 & 127) + l15, qp = n * 128 + pos, hq = hk * 3 + g;
        const bf16* src = PRE + ((size_t)b * SEQ + qp) * NPRE + C_AQ + hq * 64;
        qlo = *(const v4u*)(src + 8 * q4); qhi = *(const v4u*)(src + 32 + 8 * q4);
    }
    __syncthreads();
#pragma unroll 1
    for (int mt = 0; mt < 3; ++mt) {
        const int R0 = wave * 48 + mt * 16, g = R0 >> 7, pos = (R0 & 127) + l15, qp = n * 128 + pos, hq = hk * 3 + g;
        const size_t m = (size_t)b * SEQ + qp;
        v2u gat[4];
#pragma unroll
        for (int dt = 0; dt < 4; ++dt) gat[dt] = *(const v2u*)(PRE + m * NPRE + C_AG + hq * 64 + dt * 16 + 4 * q4);
        const v4u cqlo = qlo, cqhi = qhi;
        {
            const int mn = (mt < 2) ? mt + 1 : 2, R1 = wave * 48 + mn * 16, g1_ = R1 >> 7, pos1 = (R1 & 127) + l15, qp1 = n * 128 + pos1, hq1 = hk * 3 + g1_;
            const bf16* src = PRE + ((size_t)b * SEQ + qp1) * NPRE + C_AQ + hq1 * 64;
            qlo = *(const v4u*)(src + 8 * q4); qhi = *(const v4u*)(src + 32 + 8 * q4);
        }
        bf16x8 qf0, qf1;
        {
            float x1[8], x2[8]; unpack8(cqlo, x1); unpack8(cqhi, x2);
            float ss = 0.f;
#pragma unroll
            for (int i = 0; i < 8; ++i) ss += x1[i] * x1[i] + x2[i] * x2[i];
            ss += __shfl_xor(ss, 16); ss += __shfl_xor(ss, 32);
            const float rstd = (0.125f * 1.4426950408889634f) / sqrtf(ss * (1.f / 64.f) + NORM_EPS);
            float r1[8], r2[8];
            const f32x4 ga = *(const f32x4*)(P.in[6] + 8 * q4), gb = *(const f32x4*)(P.in[6] + 8 * q4 + 4), gc = *(const f32x4*)(P.in[6] + 32 + 8 * q4), gd = *(const f32x4*)(P.in[6] + 36 + 8 * q4);
            const f32x4 ca = *(const f32x4*)(RC + qp * 32 + 8 * q4), cb = *(const f32x4*)(RC + qp * 32 + 8 * q4 + 4), sa_ = *(const f32x4*)(RS + qp * 32 + 8 * q4), sb_ = *(const f32x4*)(RS + qp * 32 + 8 * q4 + 4);
#pragma unroll
            for (int i = 0; i < 8; ++i) {
                const float g1 = (i < 4) ? ga[i & 3] : gb[i & 3], g2 = (i < 4) ? gc[i & 3] : gd[i & 3], cs = (i < 4) ? ca[i & 3] : cb[i & 3], sn = (i < 4) ? sa_[i & 3] : sb_[i & 3];
                const float y1 = x1[i] * rstd * g1, y2 = x2[i] * rstd * g2; r1[i] = y1 * cs - y2 * sn; r2[i] = y2 * cs + y1 * sn;
            }
            qf0 = pack8(r1); qf1 = pack8(r2);
        }
        const int kt0 = (R0 & 127) >> 4;
        const int seq_lo = (n == 0) ? 8 : 0, seq_hi = (n == 15) ? 15 : 23;
        f32x4 acc[18];
#pragma unroll
        for (int u = 0; u < 17; ++u) {
            const LAS bf16* kr = Ks + ((kt0 + u) * 16 + l15) * KA_P + 8 * q4;
            const bf16x8 k0 = *(const LAS bf16x8*)(kr), k1 = *(const LAS bf16x8*)(kr + 32);
            f32x4 a = (f32x4){0.f, 0.f, 0.f, 0.f};
            a = MFMA16(k0, qf0, a); a = MFMA16(k1, qf1, a); acc[u] = a;
        }
        acc[17] = (f32x4){-1e30f, -1e30f, -1e30f, -1e30f};
        const float sink = P.in[8][hq] * 1.4426950408889634f;
        float mx = sink;
#pragma unroll
        for (int u = 0; u < 17; ++u) {
            const bool tv = (kt0 + u >= seq_lo) && (kt0 + u <= seq_hi);
#pragma unroll
            for (int i = 0; i < 4; ++i) {
                bool valid = tv;
                if (u == 0) valid = valid && (4 * q4 + i >= l15);
                if (u == 16) valid = valid && (4 * q4 + i <= l15);
                const float sv = valid ? acc[u][i] : -1e30f; acc[u][i] = sv; mx = fmaxf(mx, sv);
            }
        }
        mx = fmaxf(mx, __shfl_xor(mx, 16)); mx = fmaxf(mx, __shfl_xor(mx, 32));
        float sum = 0.f;
#pragma unroll
        for (int u = 0; u < 17; ++u)
#pragma unroll
            for (int i = 0; i < 4; ++i) { const float p = __builtin_amdgcn_exp2f(acc[u][i] - mx); acc[u][i] = p; sum += p; }
        acc[17] = (f32x4){0.f, 0.f, 0.f, 0.f};
        sum += __shfl_xor(sum, 16); sum += __shfl_xor(sum, 32);
        const float inv = 1.f / (sum + __builtin_amdgcn_exp2f(sink - mx));
        f32x4 o[4];
#pragma unroll
        for (int dt = 0; dt < 4; ++dt) o[dt] = (f32x4){0.f, 0.f, 0.f, 0.f};
#pragma unroll
        for (int k2 = 0; k2 < 9; ++k2) {
            float pp[8] = {acc[2 * k2][0], acc[2 * k2][1], acc[2 * k2][2], acc[2 * k2][3], acc[2 * k2 + 1][0], acc[2 * k2 + 1][1], acc[2 * k2 + 1][2], acc[2 * k2 + 1][3]};
            const bf16x8 pf = pack8(pp);
#pragma unroll
            for (int dt = 0; dt < 4; ++dt) {
                const LAS bf16* vr = Vt + (dt * 16 + l15) * VA_P + kt0 * 16 + k2 * 32 + 4 * q4;
                const v2u v0 = *(const LAS v2u*)(vr);
                v2u v1 = (v2u){0u, 0u};
                if (k2 < 8) v1 = *(const LAS v2u*)(vr + 16);
                const v4u vw = (v4u){v0.x, v0.y, v1.x, v1.y};
                o[dt] = MFMA16(__builtin_bit_cast(bf16x8, vw), pf, o[dt]);
            }
        }
#pragma unroll
        for (int dt = 0; dt < 4; ++dt) {
            const int ch = hq * 64 + dt * 16 + 4 * q4;
            float gg[4]; unpack4(gat[dt], gg);
            v2u w; w.x = pk2(o[dt][0] * inv * gg[0], o[dt][1] * inv * gg[1]); w.y = pk2(o[dt][2] * inv * gg[2], o[dt][3] * inv * gg[3]);
            *(v2u*)(YC + m * DM + ch) = w;
        }
    }
    __syncthreads();
}

constexpr int KC_P = 136, VC_P = 264;
__device__ __forceinline__ void attnC_qblock(const Params& P, const LAS bf16* Ks, const LAS bf16* Vt, bf16* YC, const v4u (&qraw)[4], const v2u (&gat)[8], size_t m, int hx, int l15, int q4) {
    {
        bf16x8 qf[4];
        {
            float x[4][8]; float ss = 0.f;
#pragma unroll
            for (int ks = 0; ks < 4; ++ks) { unpack8(qraw[ks], x[ks]);
#pragma unroll
                for (int i = 0; i < 8; ++i) ss += x[ks][i] * x[ks][i]; }
            ss += __shfl_xor(ss, 16); ss += __shfl_xor(ss, 32);
            const float rstd = (0.08838834764831845f * 1.4426950408889634f) / sqrtf(ss * (1.f / 128.f) + NORM_EPS);
#pragma unroll
            for (int ks = 0; ks < 4; ++ks) { float y[8];
                const f32x4 ga = *(const f32x4*)(P.in[22] + ks * 32 + 8 * q4), gb = *(const f32x4*)(P.in[22] + ks * 32 + 8 * q4 + 4);
#pragma unroll
                for (int i = 0; i < 8; ++i) y[i] = x[ks][i] * rstd * ((i < 4) ? ga[i & 3] : gb[i & 3]);
                qf[ks] = pack8(y); }
        }
        f32x4 acc[16];
#pragma unroll
        for (int kt = 0; kt < 16; ++kt) {
            const LAS bf16* kr = Ks + (kt * 16 + l15) * KC_P + 8 * q4;
            f32x4 a = (f32x4){0.f, 0.f, 0.f, 0.f};
#pragma unroll
            for (int ks = 0; ks < 4; ++ks) a = MFMA16(*(const LAS bf16x8*)(kr + ks * 32), qf[ks], a);
            acc[kt] = a;
        }
        float mx = -1e30f;
#pragma unroll
        for (int kt = 0; kt < 16; ++kt)
#pragma unroll
            for (int i = 0; i < 4; ++i) mx = fmaxf(mx, acc[kt][i]);
        mx = fmaxf(mx, __shfl_xor(mx, 16)); mx = fmaxf(mx, __shfl_xor(mx, 32));
        float sum = 0.f;
#pragma unroll
        for (int kt = 0; kt < 16; ++kt)
#pragma unroll
            for (int i = 0; i < 4; ++i) { const float p = __builtin_amdgcn_exp2f(acc[kt][i] - mx); acc[kt][i] = p; sum += p; }
        sum += __shfl_xor(sum, 16); sum += __shfl_xor(sum, 32);
        const float inv = 1.f / sum;
        f32x4 o[8];
#pragma unroll
        for (int dt = 0; dt < 8; ++dt) o[dt] = (f32x4){0.f, 0.f, 0.f, 0.f};
#pragma unroll
        for (int k2 = 0; k2 < 8; ++k2) {
            float pp[8] = {acc[2 * k2][0], acc[2 * k2][1], acc[2 * k2][2], acc[2 * k2][3], acc[2 * k2 + 1][0], acc[2 * k2 + 1][1], acc[2 * k2 + 1][2], acc[2 * k2 + 1][3]};
            const bf16x8 pf = pack8(pp);
#pragma unroll
            for (int dt = 0; dt < 8; ++dt) {
                const LAS bf16* vr = Vt + (dt * 16 + l15) * VC_P + k2 * 32 + 4 * q4;
                const v2u v0 = *(const LAS v2u*)(vr), v1 = *(const LAS v2u*)(vr + 16);
                const v4u vw = (v4u){v0.x, v0.y, v1.x, v1.y};
                o[dt] = MFMA16(__builtin_bit_cast(bf16x8, vw), pf, o[dt]);
            }
        }
#pragma unroll
        for (int dt = 0; dt < 8; ++dt) {
            const int ch = hx * 128 + dt * 16 + 4 * q4;
            float gg[4]; unpack4(gat[dt], gg);
            v2u w; w.x = pk2(o[dt][0] * inv * gg[0], o[dt][1] * inv * gg[1]); w.y = pk2(o[dt][2] * inv * gg[2], o[dt][3] * inv * gg[3]);
            *(v2u*)(YC + m * DM + 1536 + ch) = w;
        }
    }
}
__device__ __forceinline__ void attnC_item(const Params& P, int item, LAS unsigned char* lds) {
    const int tid = pg8::mk_tid(lds), lane = tid & 63, wave = __builtin_amdgcn_readfirstlane(tid >> 6), l15 = lane & 15, q4 = lane >> 4;
    const int b = item >> 5, qb0 = 2 * ((item >> 2) & 7), hx = item & 3;
    const bf16* PRE = (const bf16*)(P.ws + WS_PRE); const bf16* MKV = (const bf16*)(P.ws + WS_MKV); bf16* YC = (bf16*)(P.ws + WS_YCAT);
    LAS bf16* Ks = (LAS bf16*)lds; LAS bf16* Vt = Ks + 256 * KC_P;
    const size_t m = (size_t)b * SEQ + qb0 * 128 + wave * 16 + l15;
    {
        v4u kw[8], vw[8];
#pragma unroll
        for (int u = 0; u < 8; ++u) {
            const int it = tid + u * NTHREADS, j = it >> 4, c = it & 15;
            const bf16* src = MKV + ((size_t)b * NMEM + j) * 1024 + hx * 128 + 8 * c;
            kw[u] = *(const v4u*)(src); vw[u] = *(const v4u*)(src + 512);
        }
        const f32x4 g0 = *(const f32x4*)(P.in[23] + 8 * (tid & 15)), g1 = *(const f32x4*)(P.in[23] + 8 * (tid & 15) + 4);
#pragma unroll
        for (int u = 0; u < 8; ++u) {
            const int it = tid + u * NTHREADS, j = it >> 4, c = it & 15;
            float x[8]; unpack8(kw[u], x);
            float ss = 0.f;
#pragma unroll
            for (int i = 0; i < 8; ++i) ss += x[i] * x[i];
            ss = red8(ss); ss = dpp_add<0x140>(ss);
            const float rstd = 1.f / sqrtf(ss * (1.f / 128.f) + NORM_EPS);
            v4u o; o.x = pk2(x[0] * rstd * g0.x, x[1] * rstd * g0.y); o.y = pk2(x[2] * rstd * g0.z, x[3] * rstd * g0.w);
            o.z = pk2(x[4] * rstd * g1.x, x[5] * rstd * g1.y); o.w = pk2(x[6] * rstd * g1.z, x[7] * rstd * g1.w);
            *(LAS v4u*)(Ks + j * KC_P + 8 * c) = o;
            const v4u w = vw[u];
            LAS bf16* d = Vt + (8 * c) * VC_P + j;
            d[0] = (bf16)(w.x & 0xffffu); d[VC_P] = (bf16)(w.x >> 16); d[2 * VC_P] = (bf16)(w.y & 0xffffu); d[3 * VC_P] = (bf16)(w.y >> 16);
            d[4 * VC_P] = (bf16)(w.z & 0xffffu); d[5 * VC_P] = (bf16)(w.z >> 16); d[6 * VC_P] = (bf16)(w.w & 0xffffu); d[7 * VC_P] = (bf16)(w.w >> 16);
        }
    }
    v4u qraw[4]; v2u gat[8];
    {
        const bf16* src = PRE + m * NPRE + C_XQ + hx * 128 + 8 * q4;
#pragma unroll
        for (int ks = 0; ks < 4; ++ks) qraw[ks] = *(const v4u*)(src + ks * 32);
#pragma unroll
        for (int dt = 0; dt < 8; ++dt) gat[dt] = *(const v2u*)(PRE + m * NPRE + C_XG + hx * 128 + dt * 16 + 4 * q4);
    }
    __syncthreads();
    v4u qraw2[4]; v2u gat2[8];
    {
        const size_t m2 = m + 128; const bf16* src = PRE + m2 * NPRE + C_XQ + hx * 128 + 8 * q4;
#pragma unroll
        for (int ks = 0; ks < 4; ++ks) qraw2[ks] = *(const v4u*)(src + ks * 32);
#pragma unroll
        for (int dt = 0; dt < 8; ++dt) gat2[dt] = *(const v2u*)(PRE + m2 * NPRE + C_XG + hx * 128 + dt * 16 + 4 * q4);
    }
    attnC_qblock(P, Ks, Vt, YC, qraw, gat, m, hx, l15, q4);
    __builtin_amdgcn_sched_barrier(0);
    attnC_qblock(P, Ks, Vt, YC, qraw2, gat2, m + 128, hx, l15, q4);
    __syncthreads();
}

__device__ __forceinline__ void p5_rwkv_post(const Params& P, LAS unsigned char* lds) {
    const bf16* PRE = (const bf16*)(P.ws + WS_PRE); const bf16* EA = (const bf16*)((unsigned char*)P.out + DO_EA);
    const bf16* YF = (const bf16*)((unsigned char*)P.out + DO_YF); const bf16* YB = (const bf16*)(P.ws + WS_YB); bf16* YC = (bf16*)(P.ws + WS_YCAT);
    const float* mu = P.in[10];
    const int gt = blockIdx.x * NTHREADS + pg8::mk_tid(lds), NGT = gridDim.x * NTHREADS;
    for (int idx = gt; idx < M_TOK * 96; idx += NGT) {
        const int m = idx / 96, he = idx - m * 96, ch0 = he * 8, t = m & (SEQ - 1);
        const bf16* p = PRE + (size_t)m * NPRE + C_RS + ch0;
        const v4u z4 = (v4u){0u, 0u, 0u, 0u};
        const bool hp = t > 0, hn = t < SEQ - 1;
        const v4u rc = *(const v4u*)(p), kc = *(const v4u*)(p + 768), vc = *(const v4u*)(p + 1536);
        const v4u rp = hp ? *(const v4u*)(p - NPRE) : z4, kp = hp ? *(const v4u*)(p - NPRE + 768) : z4, vp = hp ? *(const v4u*)(p - NPRE + 1536) : z4;
        const v4u rn = hn ? *(const v4u*)(p + NPRE) : z4, kn = hn ? *(const v4u*)(p + NPRE + 768) : z4, vn = hn ? *(const v4u*)(p + NPRE + 1536) : z4;
        const v4u af8 = *(const v4u*)(EA + (size_t)m * NLORA + 1536 + ch0), ab8 = *(const v4u*)(EA + (size_t)m * NLORA + 2304 + ch0);
        const v4u yf8 = *(const v4u*)(YF + (size_t)m * RW + ch0), yb8 = *(const v4u*)(YB + (size_t)m * RW + ch0);
        const v4u rg8 = *(const v4u*)(PRE + (size_t)m * NPRE + C_RG + ch0);
        float r[8], k[8], v[8], x0[8], x1[8], x2[8];
        unpack8(rc, x0); unpack8(rp, x1); unpack8(rn, x2);
#pragma unroll
        for (int i = 0; i < 8; ++i) r[i] = x0[i] + mu[ch0 + i] * (0.5f * (x1[i] + x2[i]) - x0[i]);
        unpack8(kc, x0); unpack8(kp, x1); unpack8(kn, x2);
#pragma unroll
        for (int i = 0; i < 8; ++i) k[i] = x0[i] + mu[768 + ch0 + i] * (0.5f * (x1[i] + x2[i]) - x0[i]);
        unpack8(vc, x0); unpack8(vp, x1); unpack8(vn, x2);
#pragma unroll
        for (int i = 0; i < 8; ++i) v[i] = x0[i] + mu[1536 + ch0 + i] * (0.5f * (x1[i] + x2[i]) - x0[i]);
        float af[8], ab[8], ys[8], yb[8], rg[8]; unpack8(af8, af); unpack8(ab8, ab); unpack8(yf8, ys); unpack8(yb8, yb); unpack8(rg8, rg);
        float bs = 0.f, sm = 0.f;
#pragma unroll
        for (int i = 0; i < 8; ++i) { const float kds = k[i] * (2.f + (af[i] + ab[i] - 2.f) * P.in[12][ch0 + i]); bs += r[i] * kds * P.in[13][ch0 + i]; ys[i] += yb[i]; sm += ys[i]; }
        bs = red8(bs); sm = red8(sm);
        const float mean = sm * (1.f / 64.f);
        float vs = 0.f;
#pragma unroll
        for (int i = 0; i < 8; ++i) { ys[i] -= mean; vs += ys[i] * ys[i]; }
        vs = red8(vs);
        const float rstd = 1.f / sqrtf(vs * (1.f / 64.f) + GN_EPS);
        float o[8];
#pragma unroll
        for (int i = 0; i < 8; ++i) o[i] = (ys[i] * rstd * P.in[18][ch0 + i] + P.in[19][ch0 + i] + bs * v[i]) * rg[i];
        v4u w; w.x = pk2(o[0], o[1]); w.y = pk2(o[2], o[3]); w.z = pk2(o[4], o[5]); w.w = pk2(o[6], o[7]);
        *(v4u*)(YC + (size_t)m * DM + 768 + ch0) = w;
    }
}


constexpr size_t WS_XBAR = 504 * MiB + 832 * 1024;
#define XB_TMO      128
#define XB_XCNT(j)  (256  + 64 * (j))
#define XB_XSUB(j)  (1280 + 64 * (j))
#define XB_XGEN(j)  (2304 + 64 * (j))
#define XB_TOP      3328
#define XB_TOPGEN   3392
#define XCD_BAR_WORDS 3456
#define XB_SPIN_CAP (1u << 18)
__device__ __forceinline__ unsigned xb_ld(unsigned* p)              { return __hip_atomic_load(p, __ATOMIC_RELAXED, __HIP_MEMORY_SCOPE_AGENT); }
__device__ __forceinline__ unsigned xb_add(unsigned* p, unsigned v) { return __hip_atomic_fetch_add(p, v, __ATOMIC_RELAXED, __HIP_MEMORY_SCOPE_AGENT); }
__device__ __forceinline__ unsigned xb_xcc_id() { return (unsigned)__builtin_amdgcn_s_getreg((3 << 11) | 20) & 0xFu; }
#define XB_SPIN(cond, bar) do { unsigned _sp = 0; while (cond) { __builtin_amdgcn_s_sleep(1); \
    if ((++_sp & 255u) == 0u) { if (xb_ld(&(bar)[XB_TMO])) break; if (_sp > XB_SPIN_CAP) { atomicAdd(&(bar)[XB_TMO], 1u); break; } } } } while (0)
__device__ __forceinline__ void xcd_barrier_complete(unsigned* bar, unsigned x, unsigned& nloc, unsigned& nx) {
    const unsigned G = gridDim.x * gridDim.y * gridDim.z;
    unsigned sum, cnt, mine, sp = 0u;
    for (;;) {
        sum = 0u; cnt = 0u; mine = 0u;
#pragma unroll
        for (unsigned j = 0; j < 16; ++j) { const unsigned c = xb_ld(&bar[XB_XCNT(j)]); sum += c; cnt += (c > 0u) ? 1u : 0u; mine = (j == x) ? c : mine; }
        if (sum == G) break;
        __builtin_amdgcn_s_sleep(1);
        if ((++sp & 255u) == 0u) { if (xb_ld(&bar[XB_TMO])) break; if (sp > XB_SPIN_CAP) { atomicAdd(&bar[XB_TMO], 1u); break; } }
    }
    nloc = mine > 0u ? mine : 1u; nx = cnt > 0u ? cnt : 1u;
}
__device__ __forceinline__ void xcd_barrier(unsigned* bar, volatile LAS unsigned* st, LAS unsigned char* lds) {
    asm volatile("s_waitcnt vmcnt(0)" ::: "memory");
    __syncthreads();
    if (pg8::mk_tid(lds) == 0) {
        const unsigned x = xb_xcc_id();
        __builtin_amdgcn_s_waitcnt(0);
        unsigned nloc = st[0], nx = st[1];
        if (nloc == 0u) { xcd_barrier_complete(bar, x, nloc, nx); st[0] = nloc; st[1] = nx; }
        const unsigned old = xb_add(&bar[XB_XSUB(x)], 1u);
        const unsigned gen = old / nloc;
        if (old + 1u == (gen + 1u) * nloc) {
            __builtin_amdgcn_fence(__ATOMIC_RELEASE, "agent");
            asm volatile("s_waitcnt vmcnt(0)" ::: "memory");
            const unsigned og = xb_add(&bar[XB_TOP], 1u);
            const unsigned tg = og / nx;
            if (og + 1u == (tg + 1u) * nx) xb_add(&bar[XB_TOPGEN], 1u);
            else XB_SPIN(xb_ld(&bar[XB_TOPGEN]) == tg, bar);
            __builtin_amdgcn_fence(__ATOMIC_ACQUIRE, "agent");
            xb_add(&bar[XB_XGEN(x)], 1u);
            asm volatile("s_waitcnt vmcnt(0)" ::: "memory");
        } else {
            XB_SPIN(xb_ld(&bar[XB_XGEN(x)]) == gen, bar);
            __builtin_amdgcn_fence(__ATOMIC_ACQUIRE, "agent");
            asm volatile("s_waitcnt vmcnt(0)" ::: "memory");
        }
    }
    __syncthreads();
}

constexpr int N_PHASES = 8;
__global__ void __launch_bounds__(NTHREADS, 2) hybrid_fwd(Params P) {
    extern __shared__ __attribute__((aligned(16))) unsigned char lds_raw[];
    LAS unsigned char* lds = (LAS unsigned char*)lds_raw;
    cg::grid_group grid = cg::this_grid();
    const int lo = P.ph_lo, hi = P.ph_hi, G = gridDim.x;
    if ((threadIdx.x & 63) == 0) *(volatile LAS int*)(lds + pg8::TIDTAB_OFF + 4 * pg8::hw_slot()) = (int)(threadIdx.x >> 6);
    volatile LAS unsigned* xbst = (volatile LAS unsigned*)(lds + pg8::TIDTAB_OFF - 128);
    unsigned* xbar = (unsigned*)(P.ws + WS_XBAR);
    if (threadIdx.x == 0) { xbst[0] = 0u; xbst[1] = 0u; (void)xb_add(&xbar[XB_XCNT(xb_xcc_id())], 1u); }
    __syncthreads();
    unsigned char* ws = P.ws; unsigned char* dob = (unsigned char*)P.out;
#ifdef PHMASK
#define IN(k) (((PHMASK >> (k)) & 1) && lo <= (k) && (k) < hi)
#else
#define IN(k) (lo <= (k) && (k) < hi)
#endif
#define SEAM(k) do { if (IN(k) && IN((k) + 1)) xcd_barrier(xbar, xbst, lds); } while (0)
#ifndef REPEAT_MASK
#define REPEAT_MASK 0
#endif
#define REP(k) for (int rep_ = 0; rep_ < (((REPEAT_MASK >> (k)) & 1) ? 2 : 1); ++rep_)
#define REPSYNC() do { if (rep_) grid.sync(); } while (0)
    if (hi > N_PHASES) grid.sync();
    if (IN(0)) REP(0) { REPSYNC(); p0_prologue(P, lds, P.out); __syncthreads(); }
    SEAM(0);
    if (IN(1)) REP(1) { REPSYNC();
        { pg8::Gemm g{(const bf16*)(dob + DO_H), (const bf16*)(dob + DO_WIN), M_TOK, NIN, DM}; pg8::StaticOrder S; S.init(M_TOK, NIN, G, (int)blockIdx.x);
          EpiProj E{(bf16*)(ws + WS_PRE), (bf16*)(ws + WS_GATES), P.in[5]};
          pg8::gemm_phase<EpiProj, pg8::StaticOrder, true, true>(lds, g, S, E); }
        { pg8::Gemm g{(const bf16*)(ws + WS_MEMN), (const bf16*)(ws + WS_WXKV), MEMROWS, 1024, DM}; pg8::StaticOrder S; S.init(MEMROWS, 1024, G, (int)((blockIdx.x + G - 64) % G));
          EpiPlain E{(bf16*)(ws + WS_MKV), 1024};
          pg8::gemm_phase<EpiPlain, pg8::StaticOrder, true, true>(lds, g, S, E); }
    }
    SEAM(1);
    if (IN(2)) REP(2) { REPSYNC(); p2_lora_in(P, lds); }
    SEAM(2);
    if (IN(3)) REP(3) { REPSYNC();
        int klora = 256; asm volatile("" : "+s"(klora));
        pg8::Gemm g{(const bf16*)(dob + DO_LIN), (const bf16*)(ws + WS_LORAB), M_TOK, NLORA, klora}; pg8::StaticOrder S; S.init(M_TOK, NLORA, G, (int)blockIdx.x);
        EpiLora E{(bf16*)(dob + DO_EA), P.in[14], P.in[16]};
        pg8::gemm_phase<EpiLora, pg8::StaticOrder, true, true>(lds, g, S, E);
    }
    SEAM(3);
    if (IN(4)) REP(4) { REPSYNC();
        const int bid = blockIdx.x;
#ifndef STATIC_ATT
#define STATIC_ATT 0
#endif
#ifndef SCAN2
#define SCAN2 1
#endif
        if (bid < 192) scan_chunked(P, bid, lds);
        if (STATIC_ATT) {
            if (bid >= 192) { for (int it = bid - 192; it < 768; it += G - 192) { if (it < 512) attnA_item(P, it, lds); else attnC_item(P, it - 512, lds); } }
        } else {
            volatile LAS int* slot = (volatile LAS int*)(lds + pg8::TIDTAB_OFF - 64);
            const int tid4 = pg8::mk_tid(lds);
            for (;;) {
                if (tid4 == 0) *slot = (int)__hip_atomic_fetch_add((unsigned*)(ws + WS_CTR), 1u, __ATOMIC_RELAXED, __HIP_MEMORY_SCOPE_AGENT);
                __syncthreads();
                const int it = *slot;
                __syncthreads();
                if (it >= 768) break;
                if (it < 512) attnA_item(P, it, lds); else attnC_item(P, it - 512, lds);
            }
        }
    }
    SEAM(4);
    if (IN(5)) REP(5) { REPSYNC(); p5_rwkv_post(P, lds); }
    SEAM(5);
    if (IN(6)) REP(6) { REPSYNC();
        pg8::Gemm g{(const bf16*)(ws + WS_YCAT), (const bf16*)(ws + WS_WCAT), M_TOK, DM, DM}; pg8::StaticOrder S; S.init(M_TOK, DM, G, (int)blockIdx.x);
        EpiMerged E{(bf16*)(ws + WS_MERGED), (const bf16*)(ws + WS_GATES)};
        pg8::gemm_phase<EpiMerged, pg8::StaticOrder, true, true>(lds, g, S, E);
    }
    SEAM(6);
    if (IN(7)) REP(7) { REPSYNC();
        pg8::Gemm g{(const bf16*)(ws + WS_MERGED), (const bf16*)(ws + WS_WOUT), M_TOK, DM, DM}; pg8::StaticOrder S; S.init(M_TOK, DM, G, (int)blockIdx.x);
        EpiOut E{P.out, P.in[0]};
        pg8::gemm_phase<EpiOut, pg8::StaticOrder, true, true>(lds, g, S, E);
    }
#undef IN
#undef SEAM
}

#ifndef ONE_LAUNCH
#define ONE_LAUNCH 1
#endif
extern "C" void kernel_launch(void* const* d_in, const int* in_sizes, int n_in, void* d_out, int out_size, void* d_ws, size_t ws_size, hipStream_t stream) {
    static int grid = 0;
    if (grid == 0) {
        if (n_in != 26 || out_size != M_TOK * DM || ws_size < WS_END) { fprintf(stderr, "kernel_launch: unexpected shapes (n_in %d, out %d, ws %zu); nothing launched\n", n_in, out_size, ws_size); grid = -1; return; }
        int dev = 0, cus = 0, per_cu = 0;
        hipGetDevice(&dev); hipDeviceGetAttribute(&cus, hipDeviceAttributeMultiprocessorCount, dev);
        if (hipFuncSetAttribute((const void*)hybrid_fwd, hipFuncAttributeMaxDynamicSharedMemorySize, LDS_BYTES) != hipSuccess) { fprintf(stderr, "kernel_launch: hipFuncSetAttribute failed\n"); grid = -1; return; }
        hipOccupancyMaxActiveBlocksPerMultiprocessor(&per_cu, (const void*)hybrid_fwd, NTHREADS, LDS_BYTES);
        (void)hipGetLastError();
        if (per_cu < 1) per_cu = 1;
        grid = cus * per_cu; if (grid > 256) grid = 256;
        if (grid < 200) { fprintf(stderr, "kernel_launch: grid %d too small for the scan/attention split\n", grid); grid = -1; return; }
    }
    if (grid < 0) return;
    Params p{};
    for (int i = 0; i < 26; ++i) p.in[i] = (const float*)d_in[i];
    p.out = (float*)d_out; p.ws = (unsigned char*)d_ws;
#if ONE_LAUNCH
    (void)hipMemsetAsync((unsigned char*)d_ws + WS_XBAR, 0, XCD_BAR_WORDS * 4, stream);
    p.ph_lo = 0; p.ph_hi = N_PHASES;
    void* args[] = {&p};
    hipError_t e = hipLaunchCooperativeKernel((const void*)hybrid_fwd, dim3(grid), dim3(NTHREADS), args, LDS_BYTES, stream);
    if (e != hipSuccess) fprintf(stderr, "cooperative launch failed: %s (grid %d)\n", hipGetErrorString(e), grid);
#else
    for (int ph = 0; ph < N_PHASES; ++ph) {
        p.ph_lo = ph; p.ph_hi = ph + 1;
        hipLaunchKernelGGL(hybrid_fwd, dim3(grid), dim3(NTHREADS), LDS_BYTES, stream, p);
    }
#endif
}
```

```cpp
#include <hip/hip_runtime.h>
#include <hip/hip_cooperative_groups.h>
#include <cstdio>
#include <cstdint>
namespace cg = cooperative_groups;
namespace pg8 {
#define PG8_LAS __attribute__((address_space(3)))
typedef unsigned short bf16_t;
typedef short bf16x8 __attribute__((ext_vector_type(8)));
typedef float f32x4 __attribute__((ext_vector_type(4)));
typedef unsigned u32x4 __attribute__((ext_vector_type(4)));
constexpr int BM = 256, BK = 64, HALF = 128, HTB = HALF * BK * 2  , STAGE_BYTES = 8 * HTB, NXCD = 8, WGM = 2;

__host__ __device__ __forceinline__ int lds_byte(int r, int c) { const int st = (r >> 4) * 2 + (c >> 5), rr = r & 15, cc = c & 31, ob = rr * 64 + cc * 2; return st * 1024 + (ob ^ (((ob >> 9) & 1) << 5)); }
__host__ __device__ __forceinline__ void stage_rc(int b, int& R, int& C) { const int st = b / 1024, sb = b % 1024, swz = sb ^ (((sb >> 9) & 1) << 5); R = (st >> 1) * 16 + swz / 64; C = (st & 1) * 32 + (swz % 64) / 2; }
__host__ __device__ __forceinline__ int perm32(int rho) { const int n = rho >> 4, i = rho & 15; return 8 * (i >> 2) + 4 * n + (i & 3); }


constexpr int TIDTAB_OFF = 147200;
__device__ __forceinline__ int hw_slot() { return (int)(__builtin_amdgcn_s_getreg((5 << 11) | 4) & 63u); }
__device__ __forceinline__ int mk_tid(PG8_LAS unsigned char* lds) {
    const int lane = (int)__builtin_amdgcn_mbcnt_hi(~0u, __builtin_amdgcn_mbcnt_lo(~0u, 0u));
    const int w = __builtin_amdgcn_readfirstlane(*(volatile PG8_LAS int*)(lds + TIDTAB_OFF + 4 * hw_slot()));
    return w * 64 + lane;
}
struct Unit { int pm, pn; };
struct Gemm { const bf16_t* A; const bf16_t* Bt; int M, N, K; };

struct StaticOrder {
    int nM, nN, nwg, G, c;
    __host__ __device__ void init(int M, int N, int G_, int c_) { nM = M / BM; nN = N / BM; nwg = nM * nN; G = G_; c = c_; }
    __host__ __device__ bool next(int i, Unit& u) const {
        const long L = (long)i * G + c; if (L >= nwg) return false;
        int wgid = (int)L; { const int q = nwg / NXCD, r = nwg % NXCD, xcd = wgid % NXCD, off = wgid / NXCD; wgid = (xcd < r ? xcd * (q + 1) : r * (q + 1) + (xcd - r) * q) + off; }
        const int nig = WGM * nN, gid = wgid / nig, fm = gid * WGM, gsz = (nM - fm) < WGM ? (nM - fm) : WGM;
        u.pm = fm + ((wgid % nig) % gsz); u.pn = (wgid % nig) / gsz; return true;
    }
    __device__ __forceinline__ void a_ready(const Unit&) const {}
    __device__ __forceinline__ void done(const Unit&) const {}
};

__device__ __forceinline__ unsigned cvt_pk_bf16(float lo, float hi) { unsigned r; asm volatile("v_cvt_pk_bf16_f32 %0, %1, %2" : "=v"(r) : "v"(lo), "v"(hi)); return r; }
template <class Epi, class Sched, bool ALIGN_EPI = false, bool SP2 = false>
__device__ __forceinline__ void gemm_phase(PG8_LAS unsigned char* lds, const Gemm g, const Sched& S, const Epi& E) {
    const int tid = mk_tid(lds), wid = __builtin_amdgcn_readfirstlane(tid >> 6), lane = tid & 63, wr = wid >> 2, wc = wid & 3, fr = lane & 15, fq = lane >> 4;
    const int K = g.K, nt = K / BK;
    unsigned voffA[2], voffB[2];
#pragma unroll
    for (int i = 0; i < 2; ++i) { int R, C; stage_rc(tid * 16 + i * 8192, R, C); const int Rb = Epi::PERM ? ((R & ~31) + perm32(R & 31)) : R;
        voffA[i] = (unsigned)(R * K + C) * 2u; voffB[i] = (unsigned)(Rb * K + C) * 2u; }
    const size_t kstep = (size_t)(BK * 2);
    const size_t hstep = (size_t)HALF * K * 2;
    const size_t tstep = 2 * hstep;
    const unsigned ldsw = (unsigned)wid * 1024u;
    const int aoff = lds_byte(wr * 64 + fr, fq * 8), boff = lds_byte(wc * 32 + fr, fq * 8);
#define PG8_SA(b, h) (((b) * 2 + (h)) * HTB)
#define PG8_SB(b, h) ((4 + (b) * 2 + (h)) * HTB)
#define PG8_STAGE(bufoff, gbase, voff) do { _Pragma("unroll") for (int _i = 0; _i < 2; ++_i) \
        __builtin_amdgcn_global_load_lds((const unsigned*)((const char*)(gbase) + (voff)[_i]), (PG8_LAS unsigned*)(lds + (bufoff) + ldsw + _i * 8192), 16, 0, 0); } while (0)
#define PG8_LDA(dst, b, h) do { _Pragma("unroll") for (int m = 0; m < 4; ++m) _Pragma("unroll") for (int k = 0; k < 2; ++k) dst[m][k] = *(const PG8_LAS bf16x8*)(lds + PG8_SA(b, h) + aoff + m * 2048 + k * 1024); } while (0)
#define PG8_LDB(dst, b, h) do { _Pragma("unroll") for (int n = 0; n < 2; ++n) _Pragma("unroll") for (int k = 0; k < 2; ++k) dst[n][k] = *(const PG8_LAS bf16x8*)(lds + PG8_SB(b, h) + boff + n * 2048 + k * 1024); } while (0)
#define PG8_MMA(ai, bj, At, Bt) do { __builtin_amdgcn_s_setprio(1); _Pragma("unroll") for (int m = 0; m < 4; ++m) _Pragma("unroll") for (int n = 0; n < 2; ++n) _Pragma("unroll") for (int k = 0; k < 2; ++k) \
        acc[ai][bj][m][n] = __builtin_amdgcn_mfma_f32_16x16x32_bf16(Bt[n][k], At[m][k], acc[ai][bj][m][n], 0, 0, 0); __builtin_amdgcn_s_setprio(0); } while (0)
#define PG8_WAIT_V(n) asm volatile("s_waitcnt vmcnt(" #n ")" ::: "memory")
#define PG8_WAIT_L(n) asm volatile("s_waitcnt lgkmcnt(" #n ")" ::: "memory")
#define PG8_BAR __builtin_amdgcn_s_barrier()
#define PG8_SCHED __builtin_amdgcn_sched_barrier(0)
    Unit cur, nxt; int ui = 0;
    if (!S.next(0, cur)) return;
    f32x4 acc[2][2][4][2];
#pragma unroll
    for (int a = 0; a < 2; ++a)
#pragma unroll
        for (int b = 0; b < 2; ++b)
#pragma unroll
            for (int m = 0; m < 4; ++m)
#pragma unroll
                for (int n = 0; n < 2; ++n) acc[a][b][m][n] = (f32x4){0.f, 0.f, 0.f, 0.f};
    bf16x8 At[4][2], B0[2][2], B1[2][2];
    const char* cA = (const char*)g.A + (size_t)cur.pm * tstep; const char* cB = (const char*)g.Bt + (size_t)cur.pn * tstep;
    S.a_ready(cur);
    if constexpr (SP2) {
        PG8_STAGE(PG8_SB(0, 0), cB, voffB); PG8_STAGE(PG8_SB(0, 1), cB + hstep, voffB); PG8_STAGE(PG8_SA(0, 0), cA, voffA); PG8_STAGE(PG8_SA(0, 1), cA + hstep, voffA);
        if (wr == 1) PG8_BAR;
        PG8_WAIT_V(2); PG8_BAR;
        PG8_STAGE(PG8_SB(1, 0), cB + kstep, voffB); PG8_STAGE(PG8_SA(1, 0), cA + kstep, voffA); PG8_STAGE(PG8_SB(1, 1), cB + hstep + kstep, voffB);
        PG8_WAIT_V(6); PG8_BAR;
    } else {
        PG8_STAGE(PG8_SB(0, 0), cB, voffB); PG8_STAGE(PG8_SA(0, 0), cA, voffA); PG8_STAGE(PG8_SB(0, 1), cB + hstep, voffB); PG8_STAGE(PG8_SA(0, 1), cA + hstep, voffA);
        if (wr == 1) PG8_BAR;
        PG8_WAIT_V(4); PG8_BAR;
        PG8_STAGE(PG8_SB(1, 0), cB + kstep, voffB); PG8_STAGE(PG8_SA(1, 0), cA + kstep, voffA); PG8_STAGE(PG8_SB(1, 1), cB + hstep + kstep, voffB);
        PG8_WAIT_V(6); PG8_BAR;
    }
    for (;;) {
        const bool has_next = S.next(ui + 1, nxt);
        const char* nA = has_next ? (const char*)g.A + (size_t)nxt.pm * tstep : cA; const char* nB = has_next ? (const char*)g.Bt + (size_t)nxt.pn * tstep : cB;
        for (int t = 0; t < nt; t += 2) {
            if constexpr (Epi::KHOOK) { if (t == Epi::HK0 || t == Epi::HK1) E.khook(acc, cur, t, wr, wc, fr, fq); }
            const bool last = (t == nt - 2);
            const char* a1 = cA + (size_t)(t + 1) * kstep;
            const char* a2 = last ? nA : cA + (size_t)(t + 2) * kstep; const char* b2 = last ? nB : cB + (size_t)(t + 2) * kstep;
            const char* a3 = a2 + kstep; const char* b3 = b2 + kstep;
            if (last && has_next) S.a_ready(nxt);
            if constexpr (SP2) {
            PG8_LDB(B0, 0, 0); PG8_LDB(B1, 0, 1); PG8_SCHED; PG8_LDA(At, 0, 0); PG8_STAGE(PG8_SA(1, 1), a1 + hstep, voffA);
            PG8_WAIT_V(8); PG8_WAIT_L(0); PG8_BAR; PG8_MMA(0, 0, At, B0); PG8_MMA(0, 1, At, B1); PG8_BAR; PG8_SCHED;
            PG8_LDA(At, 0, 1); PG8_STAGE(PG8_SB(0, 0), b2, voffB); PG8_STAGE(PG8_SB(0, 1), b2 + hstep, voffB); PG8_STAGE(PG8_SA(0, 0), a2, voffA);
            PG8_WAIT_V(8); PG8_WAIT_L(0); PG8_BAR; PG8_MMA(1, 0, At, B0); PG8_MMA(1, 1, At, B1); PG8_BAR; PG8_SCHED;
            PG8_LDB(B0, 1, 0); PG8_LDB(B1, 1, 1); PG8_SCHED; PG8_LDA(At, 1, 0); PG8_STAGE(PG8_SA(0, 1), a2 + hstep, voffA);
            PG8_WAIT_V(8); PG8_WAIT_L(0); PG8_BAR; PG8_MMA(0, 0, At, B0); PG8_MMA(0, 1, At, B1); PG8_BAR; PG8_SCHED;
            PG8_LDA(At, 1, 1); PG8_STAGE(PG8_SB(1, 0), b3, voffB); PG8_STAGE(PG8_SB(1, 1), b3 + hstep, voffB); PG8_STAGE(PG8_SA(1, 0), a3, voffA);
            PG8_WAIT_V(8); PG8_WAIT_L(0); PG8_BAR; PG8_MMA(1, 0, At, B0); PG8_MMA(1, 1, At, B1); PG8_BAR; PG8_SCHED;
            } else {
            PG8_LDB(B0, 0, 0); PG8_SCHED; PG8_LDA(At, 0, 0); PG8_STAGE(PG8_SA(1, 1), a1 + hstep, voffA);
            PG8_WAIT_L(8); PG8_BAR; PG8_WAIT_L(0); PG8_MMA(0, 0, At, B0); PG8_BAR; PG8_SCHED;
            PG8_LDB(B1, 0, 1); PG8_STAGE(PG8_SB(0, 0), b2, voffB);
            PG8_BAR; PG8_WAIT_L(0); PG8_MMA(0, 1, At, B1); PG8_BAR;
            PG8_LDA(At, 0, 1); PG8_STAGE(PG8_SA(0, 0), a2, voffA);
            PG8_BAR; PG8_WAIT_L(0); PG8_MMA(1, 0, At, B0); PG8_BAR; PG8_SCHED;
            PG8_STAGE(PG8_SB(0, 1), b2 + hstep, voffB);
            PG8_WAIT_V(6); PG8_BAR; PG8_MMA(1, 1, At, B1); PG8_BAR;
            PG8_LDB(B0, 1, 0); PG8_SCHED; PG8_LDA(At, 1, 0); PG8_STAGE(PG8_SA(0, 1), a2 + hstep, voffA);
            PG8_WAIT_L(8); PG8_BAR; PG8_WAIT_L(0); PG8_MMA(0, 0, At, B0); PG8_BAR; PG8_SCHED;
            PG8_LDB(B1, 1, 1); PG8_STAGE(PG8_SB(1, 0), b3, voffB);
            PG8_BAR; PG8_WAIT_L(0); PG8_MMA(0, 1, At, B1); PG8_BAR;
            PG8_LDA(At, 1, 1); PG8_STAGE(PG8_SA(1, 0), a3, voffA);
            PG8_BAR; PG8_WAIT_L(0); PG8_MMA(1, 0, At, B0); PG8_BAR; PG8_SCHED;
            PG8_STAGE(PG8_SB(1, 1), b3 + hstep, voffB);
            PG8_WAIT_V(6); PG8_BAR; PG8_MMA(1, 1, At, B1); PG8_BAR;
            }
        }
        if constexpr (ALIGN_EPI) { if (wr == 0) PG8_BAR; }
        if constexpr (!Epi::AFTER_DRAIN) { E(acc, cur, wr, wc, fr, fq); S.done(cur); }
        if (!has_next) break;
#pragma unroll
        for (int a = 0; a < 2; ++a)
#pragma unroll
            for (int b = 0; b < 2; ++b)
#pragma unroll
                for (int m = 0; m < 4; ++m)
#pragma unroll
                    for (int n = 0; n < 2; ++n) acc[a][b][m][n] = (f32x4){0.f, 0.f, 0.f, 0.f};
        cur = nxt; cA = nA; cB = nB; ++ui;
        if constexpr (ALIGN_EPI) { if (wr == 1) PG8_BAR; }
    }
    PG8_WAIT_V(0);
    if constexpr (!ALIGN_EPI) { if (wr == 0) PG8_BAR; }
    PG8_BAR;
    if constexpr (Epi::AFTER_DRAIN) { E.fused(acc, cur, wr, wc, fr, fq, lds, wid, lane); S.done(cur); }
#undef PG8_SA
#undef PG8_SB
#undef PG8_STAGE
#undef PG8_LDA
#undef PG8_LDB
#undef PG8_MMA
#undef PG8_WAIT_V
#undef PG8_WAIT_L
#undef PG8_BAR
#undef PG8_SCHED
}
}

#define GAS __attribute__((address_space(1)))
#define LAS __attribute__((address_space(3)))
typedef unsigned short bf16;
typedef unsigned v4u __attribute__((ext_vector_type(4)));
typedef unsigned v2u __attribute__((ext_vector_type(2)));
typedef float f32x4 __attribute__((ext_vector_type(4)));
typedef float f32x2 __attribute__((ext_vector_type(2)));
typedef short bf16x8 __attribute__((ext_vector_type(8)));
typedef short s16x4 __attribute__((ext_vector_type(4)));

constexpr int NWAVES = 8, NTHREADS = 512;
constexpr int BATCH = 8, SEQ = 2048, DM = 2048, M_TOK = BATCH * SEQ;
constexpr int NPRE = 6400, NGATE = 6144, NIN = NPRE + NGATE;
constexpr int C_AQ = 0, C_AK = 768, C_AV = 1024, C_AG = 1280, C_RS = 2048, C_RR = 2048, C_RK = 2816, C_RV = 3584, C_LORA = 4352, C_RG = 4608, C_XQ = 5376, C_XG = 5888;
constexpr int NMEM = 256, MEMROWS = BATCH * NMEM;
constexpr int RW = 768, NLORA = 3072;
constexpr float NORM_EPS = 1e-6f, GN_EPS = 64e-5f;
constexpr int LDS_BYTES = 147456;

constexpr size_t MiB = 1u << 20;
constexpr size_t WS_PRE = 0, WS_MERGED = 0, WS_GATES = 200 * MiB, WS_YCAT = 392 * MiB;
constexpr size_t WS_WCAT = 456 * MiB, WS_WOUT = 464 * MiB, WS_WXKV = 472 * MiB, WS_MKV = 476 * MiB, WS_MEMN = 480 * MiB, WS_YB = 480 * MiB;
constexpr size_t WS_ROPE = 504 * MiB, WS_LORAB = 505 * MiB, WS_END = 512 * MiB;
constexpr size_t WS_CTR = 504 * MiB + 768 * 1024;
constexpr size_t DO_H = 0, DO_WIN = 64 * MiB, DO_EA = 0, DO_LIN = 96 * MiB, DO_YF = 104 * MiB;

struct Params { const float* in[26]; float* out; unsigned char* ws; int ph_lo, ph_hi; };

__device__ __forceinline__ float bf_lo(unsigned w) { return __builtin_bit_cast(float, w << 16); }
__device__ __forceinline__ float bf_hi(unsigned w) { return __builtin_bit_cast(float, w & 0xffff0000u); }
__device__ __forceinline__ float bf1(bf16 h) { return __builtin_bit_cast(float, (unsigned)h << 16); }
__device__ __forceinline__ unsigned f2bf(float f) { unsigned u = __builtin_bit_cast(unsigned, f); return (u + 0x7fffu + ((u >> 16) & 1u)) >> 16; }
typedef __bf16 bf16x2_t __attribute__((ext_vector_type(2)));
__device__ __forceinline__ unsigned pk2(float lo, float hi) { const f32x2 v = {lo, hi}; const bf16x2_t b = __builtin_convertvector(v, bf16x2_t); return __builtin_bit_cast(unsigned, b); }
__device__ __forceinline__ float sigmoidf_(float z) { return __builtin_amdgcn_rcpf(1.f + __expf(-z)); }
__device__ __forceinline__ float siluf_(float z) { return z * sigmoidf_(z); }
__device__ __forceinline__ void unpack8(v4u w, float (&x)[8]) { x[0] = bf_lo(w.x); x[1] = bf_hi(w.x); x[2] = bf_lo(w.y); x[3] = bf_hi(w.y); x[4] = bf_lo(w.z); x[5] = bf_hi(w.z); x[6] = bf_lo(w.w); x[7] = bf_hi(w.w); }
__device__ __forceinline__ void unpack4(v2u w, float (&x)[4]) { x[0] = bf_lo(w.x); x[1] = bf_hi(w.x); x[2] = bf_lo(w.y); x[3] = bf_hi(w.y); }
__device__ __forceinline__ float fma_s(float a, float b, float c) { float r; asm("v_fma_f32 %0, %1, %2, %3" : "=v"(r) : "v"(a), "v"(b), "v"(c)); return r; }
__device__ __forceinline__ float mul_s(float a, float b) { float r; asm("v_mul_f32_e32 %0, %1, %2" : "=v"(r) : "v"(a), "v"(b)); return r; }
__device__ __forceinline__ float add_s(float a, float b) { float r; asm("v_add_f32_e32 %0, %1, %2" : "=v"(r) : "v"(a), "v"(b)); return r; }
template <int CTRL> __device__ __forceinline__ float dpp_add(float v) { return v + __builtin_bit_cast(float, __builtin_amdgcn_update_dpp(0, __builtin_bit_cast(int, v), CTRL, 0xF, 0xF, true)); }
__device__ __forceinline__ float red8(float v) { v = dpp_add<0xB1>(v); v = dpp_add<0x4E>(v); v = dpp_add<0x141>(v); return v; }

using pg8::Unit;
struct EpiProj {
    static constexpr bool PERM = true, AFTER_DRAIN = false, KHOOK = false; static constexpr int HK0 = -1, HK1 = -1;
    bf16* pre; bf16* gates; const float* gate_b;
    __device__ __forceinline__ void operator()(const f32x4 (&acc)[2][2][4][2], const Unit& u, int wr, int wc, int fr, int fq) const {
        int row0 = u.pm * 256 + wr * 64 + fr;
        asm volatile("" : "+v"(row0));
        const bool isg = u.pn >= 25;
        const int pn = isg ? u.pn - 25 : u.pn;
        bf16* base = isg ? gates : pre; const int ldc = isg ? NGATE : NPRE;
        const int act = isg ? 2 : (((pn >= 5 && pn <= 7) || (pn >= 18 && pn <= 20) || pn >= 23) ? 1 : 0);
        const int col0 = pn * 256 + wc * 32 + 8 * fq;
        f32x4 bv[2][2];
#pragma unroll
        for (int bj = 0; bj < 2; ++bj) { bv[bj][0] = isg ? *(const f32x4*)(gate_b + col0 + bj * 128) : (f32x4){0.f, 0.f, 0.f, 0.f}; bv[bj][1] = isg ? *(const f32x4*)(gate_b + col0 + bj * 128 + 4) : (f32x4){0.f, 0.f, 0.f, 0.f}; }
#pragma unroll
        for (int ai = 0; ai < 2; ++ai)
#pragma unroll
            for (int m = 0; m < 4; ++m) { bf16* rowp = base + (size_t)(row0 + ai * 128 + m * 16) * ldc + col0;
                __builtin_amdgcn_sched_barrier(0);
#pragma unroll
                for (int bj = 0; bj < 2; ++bj) { f32x4 v0 = acc[ai][bj][m][0] + bv[bj][0], v1 = acc[ai][bj][m][1] + bv[bj][1];
                    if (act == 1) {
#pragma unroll
                        for (int i = 0; i < 4; ++i) { v0[i] = siluf_(v0[i]); v1[i] = siluf_(v1[i]); }
                    } else if (act == 2) {
#pragma unroll
                        for (int i = 0; i < 4; ++i) { v0[i] = sigmoidf_(v0[i]); v1[i] = sigmoidf_(v1[i]); }
                    }
                    v4u w; w.x = pk2(v0[0], v0[1]); w.y = pk2(v0[2], v0[3]); w.z = pk2(v1[0], v1[1]); w.w = pk2(v1[2], v1[3]);
                    *(v4u*)(rowp + bj * 128) = w; } }
    }
};
struct EpiPlain {
    static constexpr bool PERM = true, AFTER_DRAIN = false, KHOOK = false; static constexpr int HK0 = -1, HK1 = -1;
    bf16* O; int ldc;
    __device__ __forceinline__ void operator()(const f32x4 (&acc)[2][2][4][2], const Unit& u, int wr, int wc, int fr, int fq) const {
        int row0 = u.pm * 256 + wr * 64 + fr, col0 = u.pn * 256 + wc * 32 + 8 * fq;
        asm volatile("" : "+v"(row0), "+v"(col0));
#pragma unroll
        for (int ai = 0; ai < 2; ++ai)
#pragma unroll
            for (int m = 0; m < 4; ++m) { bf16* rowp = O + (size_t)(row0 + ai * 128 + m * 16) * ldc + col0;
#pragma unroll
                for (int bj = 0; bj < 2; ++bj) { const f32x4 v0 = acc[ai][bj][m][0], v1 = acc[ai][bj][m][1];
                    v4u w; w.x = pk2(v0[0], v0[1]); w.y = pk2(v0[2], v0[3]); w.z = pk2(v1[0], v1[1]); w.w = pk2(v1[2], v1[3]);
                    *(v4u*)(rowp + bj * 128) = w; } }
    }
};
struct EpiLora {
    static constexpr bool PERM = true, AFTER_DRAIN = false, KHOOK = false; static constexpr int HK0 = -1, HK1 = -1;
    bf16* O; const float* w0; const float* a0;
    __device__ __forceinline__ void operator()(const f32x4 (&acc)[2][2][4][2], const Unit& u, int wr, int wc, int fr, int fq) const {
        int row0 = u.pm * 256 + wr * 64 + fr, col0 = u.pn * 256 + wc * 32 + 8 * fq;
        asm volatile("" : "+v"(row0), "+v"(col0));
        const bool isw = u.pn < 6; const float* bias = isw ? (w0 + col0) : (a0 + col0 - 1536); const float sc = isw ? 0.6065306597126334f : 1.f;
        f32x4 bv[2][2];
#pragma unroll
        for (int bj = 0; bj < 2; ++bj) { bv[bj][0] = *(const f32x4*)(bias + bj * 128); bv[bj][1] = *(const f32x4*)(bias + bj * 128 + 4); }
#pragma unroll
        for (int ai = 0; ai < 2; ++ai)
#pragma unroll
            for (int m = 0; m < 4; ++m) { bf16* rowp = O + (size_t)(row0 + ai * 128 + m * 16) * NLORA + col0;
                __builtin_amdgcn_sched_barrier(0);
#pragma unroll
                for (int bj = 0; bj < 2; ++bj) { f32x4 v0 = acc[ai][bj][m][0] + bv[bj][0], v1 = acc[ai][bj][m][1] + bv[bj][1];
#pragma unroll
                    for (int i = 0; i < 4; ++i) { v0[i] = sc * sigmoidf_(v0[i]); v1[i] = sc * sigmoidf_(v1[i]); }
                    v4u w; w.x = pk2(v0[0], v0[1]); w.y = pk2(v0[2], v0[3]); w.z = pk2(v1[0], v1[1]); w.w = pk2(v1[2], v1[3]);
                    *(v4u*)(rowp + bj * 128) = w; } }
    }
};
struct EpiMerged {
    static constexpr bool PERM = true, AFTER_DRAIN = false, KHOOK = true; static constexpr int HK0 = 12, HK1 = 24;
    bf16* O; const bf16* gates;
    __device__ __forceinline__ void khook(f32x4 (&acc)[2][2][4][2], const Unit& u, int t, int wr, int wc, int fr, int fq) const {
        int row0 = u.pm * 256 + wr * 64 + fr, col0 = u.pn * 256 + wc * 32 + 8 * fq;
        asm volatile("" : "+v"(row0), "+v"(col0));
        const int bo = (t == HK0) ? 0 : DM;
#pragma unroll
        for (int ai = 0; ai < 2; ++ai) {
            v4u ga[4][2], gb[4][2];
#pragma unroll
            for (int m = 0; m < 4; ++m) { const bf16* gp = gates + (size_t)(row0 + ai * 128 + m * 16) * NGATE + bo + col0;
#pragma unroll
                for (int bj = 0; bj < 2; ++bj) { ga[m][bj] = *(const v4u*)(gp + bj * 128); gb[m][bj] = *(const v4u*)(gp + DM + bj * 128); } }
#pragma unroll
            for (int m = 0; m < 4; ++m)
#pragma unroll
                for (int bj = 0; bj < 2; ++bj) { float x[8], y[8]; unpack8(ga[m][bj], x); unpack8(gb[m][bj], y);
#pragma unroll
                    for (int i = 0; i < 4; ++i) { acc[ai][bj][m][0][i] *= x[i] * __builtin_amdgcn_rcpf(y[i]); acc[ai][bj][m][1][i] *= x[4 + i] * __builtin_amdgcn_rcpf(y[4 + i]); } }
            __builtin_amdgcn_sched_barrier(0);
        }
    }
    __device__ __forceinline__ void operator()(const f32x4 (&acc)[2][2][4][2], const Unit& u, int wr, int wc, int fr, int fq) const {
        int row0 = u.pm * 256 + wr * 64 + fr, col0 = u.pn * 256 + wc * 32 + 8 * fq;
        asm volatile("" : "+v"(row0), "+v"(col0));
#pragma unroll
        for (int ai = 0; ai < 2; ++ai) {
            v4u gg[4][2];
#pragma unroll
            for (int m = 0; m < 4; ++m)
#pragma unroll
                for (int bj = 0; bj < 2; ++bj) gg[m][bj] = *(const v4u*)(gates + (size_t)(row0 + ai * 128 + m * 16) * NGATE + 2 * DM + col0 + bj * 128);
#pragma unroll
            for (int m = 0; m < 4; ++m) { const size_t r = (size_t)(row0 + ai * 128 + m * 16);
#pragma unroll
                for (int bj = 0; bj < 2; ++bj) { const v4u g = gg[m][bj]; float x[8]; unpack8(g, x);
                    const f32x4 v0 = acc[ai][bj][m][0], v1 = acc[ai][bj][m][1];
                    v4u w; w.x = pk2(v0[0] * x[0], v0[1] * x[1]); w.y = pk2(v0[2] * x[2], v0[3] * x[3]); w.z = pk2(v1[0] * x[4], v1[1] * x[5]); w.w = pk2(v1[2] * x[6], v1[3] * x[7]);
                    *(v4u*)(O + r * DM + col0 + bj * 128) = w; } }
            __builtin_amdgcn_sched_barrier(0);
        }
    }
};
struct EpiOut {
    static constexpr bool PERM = true, AFTER_DRAIN = false, KHOOK = false; static constexpr int HK0 = -1, HK1 = -1;
    float* O; const float* X;
    __device__ __forceinline__ void operator()(const f32x4 (&acc)[2][2][4][2], const Unit& u, int wr, int wc, int fr, int fq) const {
        int row0 = u.pm * 256 + wr * 64 + fr, col0 = u.pn * 256 + wc * 32 + 8 * fq;
        asm volatile("" : "+v"(row0), "+v"(col0));
#pragma unroll
        for (int ai = 0; ai < 2; ++ai) {
            f32x4 xa[4][2], xb[4][2];
#pragma unroll
            for (int m = 0; m < 4; ++m) { const size_t o = (size_t)(row0 + ai * 128 + m * 16) * DM + col0;
#pragma unroll
                for (int bj = 0; bj < 2; ++bj) { xa[m][bj] = *(const f32x4*)(X + o + bj * 128); xb[m][bj] = *(const f32x4*)(X + o + bj * 128 + 4); } }
#pragma unroll
            for (int m = 0; m < 4; ++m) { const size_t o = (size_t)(row0 + ai * 128 + m * 16) * DM + col0;
#pragma unroll
                for (int bj = 0; bj < 2; ++bj) { *(f32x4*)(O + o + bj * 128) = xa[m][bj] + acc[ai][bj][m][0]; *(f32x4*)(O + o + bj * 128 + 4) = xb[m][bj] + acc[ai][bj][m][1]; } }
            __builtin_amdgcn_sched_barrier(0);
        }
    }
};

__device__ __forceinline__ float wave_sum(float v) {
#pragma unroll
    for (int o = 1; o < 64; o <<= 1) v += __shfl_xor(v, o);
    return v;
}
__device__ __forceinline__ void transpose_item(const float* W, int N, bf16* WT, int ldt, int koff, LAS float* scr, int item, int lane) {
    const int nblk = N / 32, kb = item / nblk, nb = item % nblk, k0 = 64 * kb, n0 = 32 * nb;
    float tv[32];
#pragma unroll
    for (int i = 0; i < 32; ++i) { const int kk = 2 * i + (lane >> 5); tv[i] = W[(size_t)(k0 + kk) * N + n0 + (lane & 31)]; }
#pragma unroll
    for (int i = 0; i < 32; ++i) { const int kk = 2 * i + (lane >> 5); scr[kk * 33 + (lane & 31)] = tv[i]; }
    asm volatile("s_waitcnt lgkmcnt(0)" ::: "memory");
    const int c = lane & 7;
#pragma unroll
    for (int j = 0; j < 4; ++j) { const int n = (lane >> 3) + 8 * j; const LAS float* s = scr + (8 * c) * 33 + n;
        v4u o; o.x = pk2(s[0 * 33], s[1 * 33]); o.y = pk2(s[2 * 33], s[3 * 33]); o.z = pk2(s[4 * 33], s[5 * 33]); o.w = pk2(s[6 * 33], s[7 * 33]);
        *(v4u*)(WT + (size_t)(n0 + n) * ldt + koff + k0 + 8 * c) = o; }
    asm volatile("s_waitcnt lgkmcnt(0)" ::: "memory");
}
__device__ __forceinline__ void rms_row_to_bf16(const float* xrow, const float* g, bf16* orow, int lane) {
    const f32x4* xr = (const f32x4*)xrow + lane; const f32x4* gr = (const f32x4*)g + lane;
    f32x4 v[8]; float s = 0.f;
#pragma unroll
    for (int j = 0; j < 8; ++j) { v[j] = xr[64 * j]; s += (v[j].x * v[j].x + v[j].y * v[j].y) + (v[j].z * v[j].z + v[j].w * v[j].w); }
    const float rstd = 1.f / sqrtf(wave_sum(s) * (1.f / DM) + NORM_EPS);
    v2u* o8 = (v2u*)orow + lane;
#pragma unroll
    for (int j = 0; j < 8; ++j) { const f32x4 gg = gr[64 * j]; v2u o; o.x = pk2(v[j].x * rstd * gg.x, v[j].y * rstd * gg.y); o.y = pk2(v[j].z * rstd * gg.z, v[j].w * rstd * gg.w); o8[64 * j] = o; }
}
__device__ __forceinline__ void p0_prologue(const Params& P, LAS unsigned char* lds, float* dout_scratch) {
    const int tid = pg8::mk_tid(lds), lane = tid & 63, wave = tid >> 6, G = gridDim.x;
    LAS float* scr = (LAS float*)(lds + wave * 16384);
    const int gw = blockIdx.x * NWAVES + wave, NGW = G * NWAVES;
    unsigned char* ws = P.ws; unsigned char* dob = (unsigned char*)P.out;
    bf16* WIN_T = (bf16*)(dob + DO_WIN); bf16* WCAT_T = (bf16*)(ws + WS_WCAT); bf16* WOUT_T = (bf16*)(ws + WS_WOUT); bf16* WXKV_T = (bf16*)(ws + WS_WXKV);
    constexpr int I_IN = 32 * (NIN / 32), I_A = 12 * 64, I_R = 12 * 64, I_X = 8 * 64, I_O = 32 * 64, I_KV = 32 * 32;
    constexpr int NITEMS = I_IN + I_A + I_R + I_X + I_O + I_KV;
    for (int it = gw; it < NITEMS; it += NGW) {
        int r = it;
        if (r < I_IN) { transpose_item(P.in[4], NIN, WIN_T, DM, 0, scr, r, lane); continue; } r -= I_IN;
        if (r < I_A) { transpose_item(P.in[9], DM, WCAT_T, DM, 0, scr, r, lane); continue; } r -= I_A;
        if (r < I_R) { transpose_item(P.in[20], DM, WCAT_T, DM, 768, scr, r, lane); continue; } r -= I_R;
        if (r < I_X) { transpose_item(P.in[24], DM, WCAT_T, DM, 1536, scr, r, lane); continue; } r -= I_X;
        if (r < I_O) { transpose_item(P.in[25], DM, WOUT_T, DM, 0, scr, r, lane); continue; } r -= I_O;
        transpose_item(P.in[21], 1024, WXKV_T, DM, 0, scr, r, lane);
    }
    bf16* H = (bf16*)(dob + DO_H); bf16* MEMN = (bf16*)(ws + WS_MEMN);
    for (int m = gw; m < M_TOK + MEMROWS; m += NGW) {
        if (m < M_TOK) rms_row_to_bf16(P.in[0] + (size_t)m * DM, P.in[2], H + (size_t)m * DM, lane);
        else rms_row_to_bf16(P.in[1] + (size_t)(m - M_TOK) * DM, P.in[3], MEMN + (size_t)(m - M_TOK) * DM, lane);
    }
    if (blockIdx.x == 0 && tid == 0) __hip_atomic_store((unsigned*)(ws + WS_CTR), 0u, __ATOMIC_RELAXED, __HIP_MEMORY_SCOPE_AGENT);
    bf16* LB = (bf16*)(ws + WS_LORAB);
    const int gt = blockIdx.x * NTHREADS + tid, NGT = G * NTHREADS;
    for (int idx = gt; idx < NLORA * 256; idx += NGT) {
        const int n = idx >> 8, k = idx & 255, d = n / RW, ch = n % RW, kb = k >> 6, kk = k & 63;
        float v = 0.f;
        if (kb == d) v = (d < 2) ? P.in[15][(size_t)(d * 64 + kk) * RW + ch] : P.in[17][(size_t)((d - 2) * 64 + kk) * RW + ch];
        LB[idx] = (bf16)f2bf(v);
    }
    float* RC = (float*)(ws + WS_ROPE); float* RS = RC + SEQ * 32;
    for (int idx = gt; idx < SEQ * 32; idx += NGT) {
        const int pos = idx >> 5, i = idx & 31;
        const float inv = __builtin_exp2f(-(float)i * (13.287712379549449f / 32.f));
        const float ang = (float)pos * inv;
        double rv = (double)ang * 0.15915494309189535; rv -= __builtin_floor(rv);
        const float r = (float)rv;
        RC[idx] = __builtin_amdgcn_cosf(r); RS[idx] = __builtin_amdgcn_sinf(r);
    }
}

__device__ __forceinline__ void p2_lora_in(const Params& P, LAS unsigned char* lds) {
    const bf16* PRE = (const bf16*)(P.ws + WS_PRE); bf16* LIN = (bf16*)((unsigned char*)P.out + DO_LIN); const float* mu = P.in[10];
    const int gt = blockIdx.x * NTHREADS + pg8::mk_tid(lds), NGT = gridDim.x * NTHREADS;
    for (int idx = gt; idx < M_TOK * 32; idx += NGT) {
        const int m = idx >> 5, j = (idx & 31) * 8, t = m & (SEQ - 1);
        const bf16* p = PRE + (size_t)m * NPRE + C_LORA + j;
        const v4u z4 = (v4u){0u, 0u, 0u, 0u};
        const v4u c = *(const v4u*)p, pv = (t > 0) ? *(const v4u*)(p - NPRE) : z4, nx = (t < SEQ - 1) ? *(const v4u*)(p + NPRE) : z4;
        const f32x4 m0 = *(const f32x4*)(mu + 2304 + j), m1 = *(const f32x4*)(mu + 2304 + j + 4);
        float xc[8], xp[8], xn[8], s[8]; unpack8(c, xc); unpack8(pv, xp); unpack8(nx, xn);
#pragma unroll
        for (int i = 0; i < 8; ++i) { const float mm = (i < 4) ? m0[i & 3] : m1[i & 3]; s[i] = xc[i] + mm * (0.5f * (xp[i] + xn[i]) - xc[i]);
            if (j < 128) s[i] = 1.f - 2.f * __builtin_amdgcn_rcpf(__expf(2.f * s[i]) + 1.f); }
        v4u o; o.x = pk2(s[0], s[1]); o.y = pk2(s[2], s[3]); o.z = pk2(s[4], s[5]); o.w = pk2(s[6], s[7]);
        *(v4u*)(LIN + (size_t)m * 256 + j) = o;
    }
}

constexpr int SC_CH = 32, SC_REC = 1536, SC_BUF = SC_CH * SC_REC, SC_SCAL = 2 * SC_BUF;
template <int MODE> __device__ __forceinline__ void scan_block(const Params& P, int sid, LAS unsigned char* lds) {
    const int tid = pg8::mk_tid(lds), lane = tid & 63, wave = __builtin_amdgcn_readfirstlane(tid >> 6);
    const int b = sid / 24, rem = sid % 24, h = rem >> 1, dir = rem & 1;
    const bf16* PRE = (const bf16*)(P.ws + WS_PRE); const bf16* EA = (const bf16*)((unsigned char*)P.out + DO_EA);
    bf16* YO = dir ? (bf16*)(P.ws + WS_YB) : (bf16*)((unsigned char*)P.out + DO_YF);
    constexpr int NCH = SEQ / SC_CH;
#define SC_BAR() do { asm volatile("s_waitcnt lgkmcnt(0)" ::: "memory"); __builtin_amdgcn_s_barrier(); asm volatile("" ::: "memory"); } while (0)
    if (wave >= 4) {
        const int pt = tid - 256, sl = pt >> 3, e = pt & 7, ch0 = h * 64 + 8 * e;
        float mur[8], muk[8], muv[8], kkc[8], kac[8];
#pragma unroll
        for (int i = 0; i < 8; ++i) { mur[i] = P.in[10][ch0 + i]; muk[i] = P.in[10][768 + ch0 + i]; muv[i] = P.in[10][1536 + ch0 + i]; kkc[i] = P.in[11][ch0 + i]; kac[i] = P.in[12][ch0 + i]; }
        v4u rc, kc, vc, rp, kp, vp, rn, kn, vn, e8, a8;
        const v4u z4 = (v4u){0u, 0u, 0u, 0u};
#define SC_PLOAD(c_) do { const int step_ = (c_) * SC_CH + sl, t_ = dir ? (SEQ - 1 - step_) : step_; const size_t m_ = (size_t)b * SEQ + t_; \
            const bf16* rowp_ = PRE + m_ * NPRE + C_RS + ch0; \
            rc = *(const v4u*)(rowp_); kc = *(const v4u*)(rowp_ + 768); vc = *(const v4u*)(rowp_ + 1536); \
            rp = (t_ > 0) ? *(const v4u*)(rowp_ - NPRE) : z4; kp = (t_ > 0) ? *(const v4u*)(rowp_ - NPRE + 768) : z4; vp = (t_ > 0) ? *(const v4u*)(rowp_ - NPRE + 1536) : z4; \
            rn = (t_ < SEQ - 1) ? *(const v4u*)(rowp_ + NPRE) : z4; kn = (t_ < SEQ - 1) ? *(const v4u*)(rowp_ + NPRE + 768) : z4; vn = (t_ < SEQ - 1) ? *(const v4u*)(rowp_ + NPRE + 1536) : z4; \
            const bf16* eap_ = EA + m_ * NLORA + dir * RW + ch0; e8 = *(const v4u*)(eap_); a8 = *(const v4u*)(eap_ + 1536); } while (0)
#define SC_PWRITE(c_) do { LAS unsigned char* buf_ = lds + ((c_) & 1) * SC_BUF; LAS float* scal_ = (LAS float*)(lds + SC_SCAL) + ((c_) & 1) * (SC_CH * 2); \
            float r[8], k[8], v[8], x0[8], x1[8], x2[8]; \
            unpack8(rc, x0); unpack8(rp, x1); unpack8(rn, x2); \
            _Pragma("unroll") for (int i = 0; i < 8; ++i) r[i] = x0[i] + mur[i] * (0.5f * (x1[i] + x2[i]) - x0[i]); \
            unpack8(kc, x0); unpack8(kp, x1); unpack8(kn, x2); \
            _Pragma("unroll") for (int i = 0; i < 8; ++i) k[i] = x0[i] + muk[i] * (0.5f * (x1[i] + x2[i]) - x0[i]); \
            unpack8(vc, x0); unpack8(vp, x1); unpack8(vn, x2); \
            _Pragma("unroll") for (int i = 0; i < 8; ++i) v[i] = x0[i] + muv[i] * (0.5f * (x1[i] + x2[i]) - x0[i]); \
            float ee[8], aa[8]; unpack8(e8, ee); unpack8(a8, aa); \
            float kk[8], ss = 0.f; \
            _Pragma("unroll") for (int i = 0; i < 8; ++i) { kk[i] = k[i] * kkc[i]; ss += kk[i] * kk[i]; } \
            ss = red8(ss); \
            const float inv = 1.f / fmaxf(sqrtf(ss), 1e-12f); \
            float nkk[8], dd[8], dr[8], bb[8], kd[8], sbr = 0.f, skr = 0.f; \
            _Pragma("unroll") for (int i = 0; i < 8; ++i) { \
                const float kki = kk[i] * inv; nkk[i] = -kki; dd[i] = __expf(-ee[i]); dr[i] = dd[i] * r[i]; \
                bb[i] = kki * aa[i]; kd[i] = k[i] * (1.f + (aa[i] - 1.f) * kac[i]); sbr += bb[i] * r[i]; skr += kd[i] * r[i]; } \
            sbr = red8(sbr); skr = red8(skr); \
            LAS float* rec = (LAS float*)(buf_ + sl * SC_REC) + 8 * e; \
            *(LAS f32x4*)(rec) = (f32x4){nkk[0], nkk[1], nkk[2], nkk[3]}; *(LAS f32x4*)(rec + 4) = (f32x4){nkk[4], nkk[5], nkk[6], nkk[7]}; \
            *(LAS f32x4*)(rec + 64) = (f32x4){dr[0], dr[1], dr[2], dr[3]}; *(LAS f32x4*)(rec + 68) = (f32x4){dr[4], dr[5], dr[6], dr[7]}; \
            *(LAS f32x4*)(rec + 128) = (f32x4){dd[0], dd[1], dd[2], dd[3]}; *(LAS f32x4*)(rec + 132) = (f32x4){dd[4], dd[5], dd[6], dd[7]}; \
            *(LAS f32x4*)(rec + 192) = (f32x4){bb[0], bb[1], bb[2], bb[3]}; *(LAS f32x4*)(rec + 196) = (f32x4){bb[4], bb[5], bb[6], bb[7]}; \
            *(LAS f32x4*)(rec + 256) = (f32x4){kd[0], kd[1], kd[2], kd[3]}; *(LAS f32x4*)(rec + 260) = (f32x4){kd[4], kd[5], kd[6], kd[7]}; \
            *(LAS f32x4*)(rec + 320) = (f32x4){v[0], v[1], v[2], v[3]}; *(LAS f32x4*)(rec + 324) = (f32x4){v[4], v[5], v[6], v[7]}; \
            if (e == 0) *(LAS f32x2*)(scal_ + 2 * sl) = (f32x2){sbr, skr}; } while (0)
        if (!(MODE & 2)) { SC_PLOAD(0); SC_PWRITE(0); SC_PLOAD(1); }
        SC_BAR();
        for (int c = 0; c < NCH; ++c) {
            if (!(MODE & 2)) { if (c + 1 < NCH) SC_PWRITE(c + 1);
            if (c + 2 < NCH) SC_PLOAD(c + 2); }
            SC_BAR();
        }
#undef SC_PLOAD
#undef SC_PWRITE
    } else {
        const int rp = (wave * 64 + lane) >> 3, cgp = lane & 7;
        f32x2 s0[4], s1[4];
#pragma unroll
        for (int i = 0; i < 4; ++i) { s0[i] = (f32x2){0.f, 0.f}; s1[i] = (f32x2){0.f, 0.f}; }
        bf16* yrow = YO + (size_t)b * SEQ * RW + h * 64 + 2 * rp;
        SC_BAR();
#define SC_LOAD(N0, N1, Q0, Q1, D0, D1, B0, B1, K0, K1, VV, SS, sl_) do { const LAS float* rec_ = (const LAS float*)(buf + (sl_) * SC_REC) + 8 * cgp; \
            N0 = *(const LAS f32x4*)(rec_); N1 = *(const LAS f32x4*)(rec_ + 4); Q0 = *(const LAS f32x4*)(rec_ + 64); Q1 = *(const LAS f32x4*)(rec_ + 68); \
            D0 = *(const LAS f32x4*)(rec_ + 128); D1 = *(const LAS f32x4*)(rec_ + 132); B0 = *(const LAS f32x4*)(rec_ + 192); B1 = *(const LAS f32x4*)(rec_ + 196); \
            K0 = *(const LAS f32x4*)(rec_ + 256); K1 = *(const LAS f32x4*)(rec_ + 260); \
            VV = *(const LAS f32x2*)((const LAS float*)(buf + (sl_) * SC_REC) + 320 + 2 * rp); SS = *(const LAS f32x2*)(scal + 2 * (sl_)); } while (0)
        for (int c = 0; c < NCH; ++c) {
            const LAS unsigned char* buf = lds + (c & 1) * SC_BUF; const LAS float* scal = (const LAS float*)(lds + SC_SCAL) + (c & 1) * (SC_CH * 2);
            f32x4 n0, n1, q0, q1, d0, d1, b0, b1, k0, k1; f32x2 vv, sc;
            SC_LOAD(n0, n1, q0, q1, d0, d1, b0, b1, k0, k1, vv, sc, 0);
#pragma unroll 2
            for (int sl = 0; sl < SC_CH; ++sl) {
                f32x4 xn0, xn1, xq0, xq1, xd0, xd1, xb0, xb1, xk0, xk1; f32x2 xvv, xsc;
                const int sn = (sl + 1 < SC_CH) ? sl + 1 : sl;
                const f32x2 nk[4] = {(f32x2){n0.x, n0.y}, (f32x2){n0.z, n0.w}, (f32x2){n1.x, n1.y}, (f32x2){n1.z, n1.w}};
                const f32x2 qq[4] = {(f32x2){q0.x, q0.y}, (f32x2){q0.z, q0.w}, (f32x2){q1.x, q1.y}, (f32x2){q1.z, q1.w}};
                const f32x2 dv[4] = {(f32x2){d0.x, d0.y}, (f32x2){d0.z, d0.w}, (f32x2){d1.x, d1.y}, (f32x2){d1.z, d1.w}};
                const f32x2 bv[4] = {(f32x2){b0.x, b0.y}, (f32x2){b0.z, b0.w}, (f32x2){b1.x, b1.y}, (f32x2){b1.z, b1.w}};
                const f32x2 kv[4] = {(f32x2){k0.x, k0.y}, (f32x2){k0.z, k0.w}, (f32x2){k1.x, k1.y}, (f32x2){k1.z, k1.w}};
                f32x2 a0 = s0[0] * nk[0], a1 = s1[0] * nk[0], y0 = s0[0] * qq[0], y1 = s1[0] * qq[0];
#pragma unroll
                for (int i = 1; i < 4; ++i) { a0 = s0[i] * nk[i] + a0; a1 = s1[i] * nk[i] + a1; y0 = s0[i] * qq[i] + y0; y1 = s1[i] * qq[i] + y1; }
                float sa0 = a0.x + a0.y, sa1 = a1.x + a1.y, yp0 = y0.x + y0.y, yp1 = y1.x + y1.y;
                SC_LOAD(xn0, xn1, xq0, xq1, xd0, xd1, xb0, xb1, xk0, xk1, xvv, xsc, sn);
                sa0 = red8(sa0); sa1 = red8(sa1); yp0 = red8(yp0); yp1 = red8(yp1);
                const float yo0 = yp0 + sa0 * sc.x + vv.x * sc.y, yo1 = yp1 + sa1 * sc.x + vv.y * sc.y;
                const f32x2 sa0v = (f32x2){sa0, sa0}, sa1v = (f32x2){sa1, sa1}, v0v = (f32x2){vv.x, vv.x}, v1v = (f32x2){vv.y, vv.y};
#pragma unroll
                for (int i = 0; i < 4; ++i) {
                    f32x2 t0 = v0v * kv[i]; t0 = sa0v * bv[i] + t0; s0[i] = s0[i] * dv[i] + t0;
                    f32x2 t1 = v1v * kv[i]; t1 = sa1v * bv[i] + t1; s1[i] = s1[i] * dv[i] + t1;
                }
                const int step = c * SC_CH + sl, t = dir ? (SEQ - 1 - step) : step;
                const unsigned yw = pk2(yo0, yo1);
                if (!(MODE & 1)) { if (cgp == 0) *(unsigned*)(yrow + (size_t)t * RW) = yw; } else { asm volatile("" :: "v"(yw)); }
                n0 = xn0; n1 = xn1; q0 = xq0; q1 = xq1; d0 = xd0; d1 = xd1; b0 = xb0; b1 = xb1; k0 = xk0; k1 = xk1; vv = xvv; sc = xsc;
            }
            SC_BAR();
        }
#undef SC_LOAD
    }
#undef SC_BAR
    __syncthreads();
}

__device__ __forceinline__ bf16x8 pack8(const float (&x)[8]) {
    v4u w; w.x = pk2(x[0], x[1]); w.y = pk2(x[2], x[3]); w.z = pk2(x[4], x[5]); w.w = pk2(x[6], x[7]); return __builtin_bit_cast(bf16x8, w);
}
#define MFMA16(a, b, c) __builtin_amdgcn_mfma_f32_16x16x32_bf16((a), (b), (c), 0, 0, 0)
constexpr int CK = 16, NCK = SEQ / CK;
constexpr int L_QK = 0, L_PR = 4608, L_QKT = 9216, L_VT = 14336, L_VF = 19456, L_GC = 23552, L_OPSZ = 23808;
constexpr int WP = 68, L_WSZ = 16 * WP * 4;
constexpr int L_E = 2 * L_OPSZ, L_G = L_E + 4096, L_GSZ = 5120, L_W0 = L_G + 2 * L_GSZ, L_VG = L_W0 + L_WSZ, L_SB = L_VG + 2 * L_WSZ, L_CEND = L_SB + 9216;
constexpr int L_GTP = L_CEND + 1280;
static_assert(L_GTP + 2048 <= 131072, "chunked scan LDS map");
#ifdef CBAR_FULL
#define CBAR() __syncthreads()
#else
#define CBAR() do { __builtin_amdgcn_s_waitcnt(0xC07F); __builtin_amdgcn_s_barrier(); } while (0)
#endif
__device__ __forceinline__ void scan_chunked(const Params& P, int sid, LAS unsigned char* lds) {
    const int tid = pg8::mk_tid(lds), lane = tid & 63, wave = __builtin_amdgcn_readfirstlane(tid >> 6), l15 = lane & 15, q4 = lane >> 4;
    const int b = sid / 24, rem = sid % 24, h = rem >> 1, dir = rem & 1;
    const bf16* PRE = (const bf16*)(P.ws + WS_PRE); const bf16* EA = (const bf16*)((unsigned char*)P.out + DO_EA);
    bf16* YO = dir ? (bf16*)(P.ws + WS_YB) : (bf16*)((unsigned char*)P.out + DO_YF);
#ifdef YZERO
    for (int it = tid; it < SEQ * 8; it += NTHREADS) *(v4u*)(YO + ((size_t)b * SEQ + (it >> 3)) * RW + h * 64 + (it & 7) * 8) = (v4u){0u, 0u, 0u, 0u};
#endif
    for (int i = tid; i < 9216 / 4; i += NTHREADS) ((LAS unsigned*)(lds + L_SB))[i] = 0u;
    for (int i = tid; i < L_SB / 4; i += NTHREADS) ((LAS unsigned*)(lds))[i] = 0u;
    if (tid < 320) { const int vsel = tid >> 6, chn = h * 64 + (tid & 63);
        ((LAS float*)(lds + L_CEND))[tid] = (vsel < 3) ? P.in[10][vsel * 768 + chn] : ((vsel == 3) ? P.in[11][chn] : P.in[12][chn]); }
    CBAR();
    if (wave >= 4) {
        const int pt = tid - 256, t = pt >> 4, e = pt & 15, ch0 = h * 64 + 4 * e, gsw = 8 * ((e >> 1) & 3);
        const LAS float* cst = (const LAS float*)(lds + L_CEND) + 4 * e;
        v2u rcA, kcA, vcA, rpA, kpA, vpA, rnA, knA, vnA, e8A, a8A, rcB, kcB, vcB, rpB, kpB, vpB, rnB, knB, vnB, e8B, a8B;
        const v2u z2 = (v2u){0u, 0u};
#define CK_PLOAD(X, c_) do { const int step_ = (c_) * CK + t, t_ = dir ? (SEQ - 1 - step_) : step_; const size_t m_ = (size_t)b * SEQ + t_; \
            const bf16* rowp_ = PRE + m_ * NPRE + C_RS + ch0; \
            const bf16* rowq_ = (t_ > 0) ? rowp_ - NPRE : rowp_; const bf16* rown_ = (t_ < SEQ - 1) ? rowp_ + NPRE : rowp_;     \
            rc##X = *(const v2u*)(rowp_); kc##X = *(const v2u*)(rowp_ + 768); vc##X = *(const v2u*)(rowp_ + 1536); \
            rp##X = *(const v2u*)(rowq_); kp##X = *(const v2u*)(rowq_ + 768); vp##X = *(const v2u*)(rowq_ + 1536); \
            rn##X = *(const v2u*)(rown_); kn##X = *(const v2u*)(rown_ + 768); vn##X = *(const v2u*)(rown_ + 1536); \
            const bf16* eap_ = EA + m_ * NLORA + dir * RW + ch0; e8##X = *(const v2u*)(eap_); a8##X = *(const v2u*)(eap_ + 1536); } while (0)
        CK_PLOAD(A, 0); CK_PLOAD(B, 1);
        float r[4], k[4], v[4], kk[4], aa[4], ee[4];
#define CK_PBODY(X, c_) do { const int c = (c_); const int pb = (c & 1) * L_OPSZ; \
            {   \
                float x0[4], x1[4], x2[4]; f32x4 cc; \
                const int stepc_ = ((c < NCK) ? c : NCK - 1) * CK + t, tc_ = dir ? (SEQ - 1 - stepc_) : stepc_; const float fp_ = (tc_ > 0) ? 1.f : 0.f, fn_ = (tc_ < SEQ - 1) ? 1.f : 0.f; \
                unpack4(rc##X, x0); unpack4(rp##X, x1); unpack4(rn##X, x2); cc = *(const LAS f32x4*)(cst); \
                _Pragma("unroll") for (int i = 0; i < 4; ++i) r[i] = x0[i] + cc[i] * (0.5f * (fp_ * x1[i] + fn_ * x2[i]) - x0[i]); \
                unpack4(kc##X, x0); unpack4(kp##X, x1); unpack4(kn##X, x2); cc = *(const LAS f32x4*)(cst + 64); \
                _Pragma("unroll") for (int i = 0; i < 4; ++i) k[i] = x0[i] + cc[i] * (0.5f * (fp_ * x1[i] + fn_ * x2[i]) - x0[i]); \
                unpack4(vc##X, x0); unpack4(vp##X, x1); unpack4(vn##X, x2); cc = *(const LAS f32x4*)(cst + 128); \
                _Pragma("unroll") for (int i = 0; i < 4; ++i) v[i] = x0[i] + cc[i] * (0.5f * (fp_ * x1[i] + fn_ * x2[i]) - x0[i]); \
                unpack4(e8##X, ee); unpack4(a8##X, aa); cc = *(const LAS f32x4*)(cst + 192); \
                float ss = 0.f; \
                _Pragma("unroll") for (int i = 0; i < 4; ++i) { kk[i] = k[i] * cc[i]; ss += kk[i] * kk[i]; } \
                ss = red8(ss); ss = dpp_add<0x140>(ss); \
                const float inv = __builtin_amdgcn_rcpf(fmaxf(__builtin_amdgcn_sqrtf(ss), 1e-12f)); \
                _Pragma("unroll") for (int i = 0; i < 4; ++i) kk[i] *= inv; \
                *(LAS f32x4*)((LAS float*)(lds + L_E) + t * 64 + 4 * e) = (f32x4){ee[0], ee[1], ee[2], ee[3]}; \
                CK_PLOAD(X, (c + 2 < NCK) ? c + 2 : NCK - 1); \
            } \
            CBAR(); \
            { \
                f32x4 gs = (f32x4){0.f, 0.f, 0.f, 0.f}; \
                _Pragma("unroll") for (int u = 0; u < CK; ++u) { \
                    const f32x4 ea = *(const LAS f32x4*)((const LAS float*)(lds + L_E) + u * 64 + 4 * e); \
                    const float m = (u <= t) ? 1.f : 0.f; gs += m * ea; } \
                const f32x4 kac = *(const LAS f32x4*)(cst + 256); \
                float qv[4], kt[4], pv[4], rt[4], gin[4]; \
                _Pragma("unroll") for (int i = 0; i < 4; ++i) { \
                    gin[i] = __expf(-gs[i]); const float gex = __expf(ee[i] - gs[i]), ginv = __expf(gs[i]); \
                    const float kd = k[i] * (1.f + (aa[i] - 1.f) * kac[i]); \
                    qv[i] = kk[i] * aa[i] * ginv; kt[i] = kd * ginv; pv[i] = kk[i] * gex; rt[i] = r[i] * gin[i]; \
                } \
                LAS unsigned char* ob = lds + pb; \
                unsigned wq[4]; v2u o; \
                _Pragma("unroll") for (int i = 0; i < 4; ++i) wq[i] = pk2(qv[i], kt[i]);                        \
                o.x = (wq[0] & 0xffffu) | (wq[1] << 16); o.y = (wq[2] & 0xffffu) | (wq[3] << 16); *(LAS v2u*)(ob + L_QK + (t * 72 + 4 * e) * 2) = o; \
                o.x = (wq[0] >> 16) | (wq[1] & 0xffff0000u); o.y = (wq[2] >> 16) | (wq[3] & 0xffff0000u); *(LAS v2u*)(ob + L_QK + ((16 + t) * 72 + 4 * e) * 2) = o; \
                o.x = pk2(pv[0], pv[1]); o.y = pk2(pv[2], pv[3]); *(LAS v2u*)(ob + L_PR + (t * 72 + 4 * e) * 2) = o; \
                o.x = pk2(rt[0], rt[1]); o.y = pk2(rt[2], rt[3]); *(LAS v2u*)(ob + L_PR + ((16 + t) * 72 + 4 * e) * 2) = o; \
                const unsigned wv01 = pk2(v[0], v[1]), wv23 = pk2(v[2], v[3]); \
                _Pragma("unroll") for (int i = 0; i < 4; ++i) { \
                    *(LAS bf16*)(ob + L_QKT + ((4 * e + i) * 40 + (t ^ gsw)) * 2) = (bf16)(wq[i] & 0xffffu); *(LAS bf16*)(ob + L_QKT + ((4 * e + i) * 40 + ((16 + t) ^ gsw)) * 2) = (bf16)(wq[i] >> 16); \
                    const unsigned wv = (i < 2) ? wv01 : wv23; \
                    *(LAS bf16*)(ob + L_VT + ((4 * e + i) * 40 + ((16 + t) ^ gsw)) * 2) = (bf16)((i & 1) ? (wv >> 16) : (wv & 0xffffu)); \
                } \
                if (t == CK - 1) *(LAS f32x4*)((LAS float*)(ob + L_GC) + 4 * e) = (f32x4){gin[0], gin[1], gin[2], gin[3]}; \
            } \
            CBAR(); \
            CBAR(); } while (0)
        static_assert((NCK + 2) % 2 == 0, "producer loop is unrolled by two");
        for (int c2 = 0; c2 <= NCK + 1; c2 += 2) { CK_PBODY(A, c2); CK_PBODY(B, c2 + 1); }
#undef CK_PBODY
#undef CK_PLOAD
    } else {
        const int w = wave;
        f32x4 acc[4];
#pragma unroll
        for (int nt = 0; nt < 4; ++nt) acc[nt] = (f32x4){0.f, 0.f, 0.f, 0.f};
        bf16* ybase = YO + (size_t)b * SEQ * RW + h * 64 + 16 * w + 4 * q4;
        for (int c = 0; c <= NCK + 1; ++c) {
            const int ck = c - 1; const bool valid = (ck >= 0 && ck < NCK);
            const int pb = (ck & 1) * L_OPSZ, gb = L_G + (ck & 1) * L_GSZ;
            f32x4 r1 = (f32x4){0.f, 0.f, 0.f, 0.f};
            if (valid) {
                f32x4 r0 = (f32x4){0.f, 0.f, 0.f, 0.f};
#pragma unroll
                for (int ks = 0; ks < 2; ++ks) {
                    const bf16x8 S = *(const LAS bf16x8*)(lds + L_SB + ((16 * w + l15) * 72 + ks * 32 + 8 * q4) * 2);
                    const bf16x8 Bp = *(const LAS bf16x8*)(lds + pb + L_PR + ((l15) * 72 + ks * 32 + 8 * q4) * 2);
                    const bf16x8 Br = *(const LAS bf16x8*)(lds + pb + L_PR + ((16 + l15) * 72 + ks * 32 + 8 * q4) * 2);
                    r0 = MFMA16(S, Bp, r0); r1 = MFMA16(S, Br, r1);
                }
                *(LAS f32x4*)(lds + L_W0 + (l15 * WP + 16 * w + 4 * q4) * 4) = r0;
            }
            if (valid && w == 1) {
#pragma unroll
                for (int x = 0; x < 4; ++x) {
                    const int a = x >> 1, bc = x & 1;
                    f32x4 g = (f32x4){0.f, 0.f, 0.f, 0.f};
#pragma unroll
                    for (int ks = 0; ks < 2; ++ks) {
                        const bf16x8 A = *(const LAS bf16x8*)(lds + pb + L_QK + ((a * 16 + l15) * 72 + ks * 32 + 8 * q4) * 2);
                        const bf16x8 Bm = *(const LAS bf16x8*)(lds + pb + L_PR + ((bc * 16 + l15) * 72 + ks * 32 + 8 * q4) * 2);
                        g = MFMA16(A, Bm, g);
                    }
                    *(LAS f32x4*)(lds + gb + x * 1280 + (l15 * 20 + 4 * q4) * 4) = g;
                    if (x == 0) {
#pragma unroll
                        for (int ii = 0; ii < 4; ++ii) *(LAS float*)(lds + L_GTP + (ck & 1) * 1024 + (l15 * 16 + ii * 4 + q4) * 4) = (4 * q4 + ii < l15) ? g[ii] : 0.f;
                    }
                }
                __builtin_amdgcn_s_waitcnt(0xC07F);
                float bw[8];
                {
                    const f32x4 ga = *(const LAS f32x4*)(lds + gb + 2 * 1280 + (l15 * 20 + 8 * (q4 & 1)) * 4), gb2 = *(const LAS f32x4*)(lds + gb + 2 * 1280 + (l15 * 20 + 8 * (q4 & 1) + 4) * 4);
#pragma unroll
                    for (int ii = 0; ii < 8; ++ii) { const int s = 8 * (q4 & 1) + ii; const float gv = (ii < 4) ? ga[ii & 3] : gb2[ii & 3]; bw[ii] = (q4 >= 2 && s < l15) ? gv : 0.f; }
                }
                const bf16x8 Bf = pack8(bw);
#pragma unroll
                for (int mt = 0; mt < 4; ++mt) {
                    const bf16x8 Av = *(const LAS bf16x8*)(lds + pb + L_VT + ((mt * 16 + l15) * 40 + 8 * (q4 ^ (((mt * 16 + l15) >> 3) & 3))) * 2);
                    f32x4 r = (f32x4){0.f, 0.f, 0.f, 0.f};
                    r = MFMA16(Av, Bf, r);
                    *(LAS f32x4*)(lds + L_VG + (ck & 1) * L_WSZ + (l15 * WP + mt * 16 + 4 * q4) * 4) = r;
                }
            }
            CBAR();
            if (valid) {
                const int rr = lane >> 2, qq = lane & 3, i = 16 * w + rr;
                float cown[4], uown[4];
#pragma unroll
                for (int k = 0; k < 4; ++k) { const int t = 4 * k + qq; uown[k] = 0.f;
                    cown[k] = *(const LAS float*)(lds + L_W0 + (t * WP + i) * 4) + *(const LAS float*)(lds + L_VG + (ck & 1) * L_WSZ + (t * WP + i) * 4); }
                const LAS float* gtp = (const LAS float*)(lds + L_GTP + (ck & 1) * 1024) + qq * 4;
#pragma unroll
                for (int t = 0; t < 16; ++t) {
                    const f32x4 g4 = *(const LAS f32x4*)(gtp + t * 16);
                    float part = (g4[0] * uown[0] + g4[1] * uown[1]) + (g4[2] * uown[2] + g4[3] * uown[3]);
                    part = dpp_add<0xB1>(part); part = dpp_add<0x4E>(part);
                    const float cand = cown[t >> 2] - part;
                    uown[t >> 2] = (qq == (t & 3)) ? cand : uown[t >> 2];
                }
                const int gsw = 8 * ((i >> 3) & 3);
#pragma unroll
                for (int k = 0; k < 4; ++k) { const int t = 4 * k + qq;
                    *(LAS bf16*)(lds + pb + L_VT + (i * 40 + (t ^ gsw)) * 2) = (bf16)(pk2(-uown[k], 0.f) & 0xffffu); }
            }
            CBAR();
            if (valid) {
                const bf16x8 Bv = *(const LAS bf16x8*)(lds + pb + L_VT + ((16 * w + l15) * 40 + 8 * (q4 ^ (((16 * w + l15) >> 3) & 3))) * 2);
                {
                    const int xo = (q4 < 2) ? 1 : 3;
                    const f32x4 ga = *(const LAS f32x4*)(lds + gb + xo * 1280 + (l15 * 20 + 8 * (q4 & 1)) * 4), gb2 = *(const LAS f32x4*)(lds + gb + xo * 1280 + (l15 * 20 + 8 * (q4 & 1) + 4) * 4);
                    float bw[8];
#pragma unroll
                    for (int ii = 0; ii < 8; ++ii) { const int s = 8 * (q4 & 1) + ii; const float gv = (ii < 4) ? ga[ii & 3] : gb2[ii & 3]; bw[ii] = (s <= l15) ? gv : 0.f; }
                    const f32x4 y = MFMA16(Bv, pack8(bw), r1);
                    const int step = ck * CK + l15, tt = dir ? (SEQ - 1 - step) : step;
                    v2u o; o.x = pk2(y[0], y[1]); o.y = pk2(y[2], y[3]);
                    *(v2u*)(ybase + (size_t)tt * RW) = o;
                }
#pragma unroll
                for (int nt = 0; nt < 4; ++nt) {
                    const bf16x8 Aq = *(const LAS bf16x8*)(lds + pb + L_QKT + ((nt * 16 + l15) * 40 + 8 * (q4 ^ (((nt * 16 + l15) >> 3) & 3))) * 2);
                    acc[nt] = MFMA16(Aq, Bv, acc[nt]);
                    const f32x4 gc = *(const LAS f32x4*)(lds + pb + L_GC + (nt * 16 + 4 * q4) * 4);
                    acc[nt] = acc[nt] * gc;
                    v2u o; o.x = pk2(acc[nt][0], acc[nt][1]); o.y = pk2(acc[nt][2], acc[nt][3]);
                    *(LAS v2u*)(lds + L_SB + ((16 * w + l15) * 72 + nt * 16 + 4 * q4) * 2) = o;
                }
            }
            CBAR();
        }
    }
    __syncthreads();
}
#undef CBAR

constexpr int KA_P = 72, VA_P = 392;
__device__ __forceinline__ void attnA_item(const Params& P, int item, LAS unsigned char* lds) {
    const int tid = pg8::mk_tid(lds), lane = tid & 63, wave = __builtin_amdgcn_readfirstlane(tid >> 6), l15 = lane & 15, q4 = lane >> 4;
    const int b = item >> 6, n = (item >> 2) & 15, hk = item & 3;
    const bf16* PRE = (const bf16*)(P.ws + WS_PRE); bf16* YC = (bf16*)(P.ws + WS_YCAT);
    const float* RC = (const float*)(P.ws + WS_ROPE); const float* RS = RC + SEQ * 32;
    LAS bf16* Ks = (LAS bf16*)lds; LAS bf16* Vt = Ks + 384 * KA_P;
    {
        v2u klo[6], khi[6]; f32x4 kcs[6], ksn[6]; v4u vw[6];
#pragma unroll
        for (int u = 0; u < 6; ++u) {
            const int it = tid + u * NTHREADS, j = it >> 3, c = it & 7, kp = (n - 1) * 128 + j;
            const bool ok = (kp >= 0 && kp < SEQ); const int kpc = ok ? kp : 0;
            const bf16* src = PRE + ((size_t)b * SEQ + kpc) * NPRE + C_AK + hk * 64;
            klo[u] = *(const v2u*)(src + 4 * c); khi[u] = *(const v2u*)(src + 32 + 4 * c);
            kcs[u] = *(const f32x4*)(RC + kpc * 32 + 4 * c); ksn[u] = *(const f32x4*)(RS + kpc * 32 + 4 * c);
            vw[u] = *(const v4u*)(PRE + ((size_t)b * SEQ + kpc) * NPRE + C_AV + hk * 64 + 8 * c);
        }
        const f32x4 g1 = *(const f32x4*)(P.in[7] + 4 * (tid & 7)), g2 = *(const f32x4*)(P.in[7] + 32 + 4 * (tid & 7));
#pragma unroll
        for (int u = 0; u < 6; ++u) {
            const int it = tid + u * NTHREADS, j = it >> 3, c = it & 7, kp = (n - 1) * 128 + j;
            const bool ok = (kp >= 0 && kp < SEQ);
            float x1[4], x2[4]; unpack4(klo[u], x1); unpack4(khi[u], x2);
            float ss = 0.f;
#pragma unroll
            for (int i = 0; i < 4; ++i) ss += x1[i] * x1[i] + x2[i] * x2[i];
            ss = red8(ss);
            const float rstd = ok ? 1.f / sqrtf(ss * (1.f / 64.f) + NORM_EPS) : 0.f;
            float r1[4], r2[4];
#pragma unroll
            for (int i = 0; i < 4; ++i) { const float y1 = x1[i] * rstd * g1[i], y2 = x2[i] * rstd * g2[i]; r1[i] = y1 * kcs[u][i] - y2 * ksn[u][i]; r2[i] = y2 * kcs[u][i] + y1 * ksn[u][i]; }
            v2u o0, o1; o0.x = pk2(r1[0], r1[1]); o0.y = pk2(r1[2], r1[3]); o1.x = pk2(r2[0], r2[1]); o1.y = pk2(r2[2], r2[3]);
            *(LAS v2u*)(Ks + j * KA_P + 4 * c) = o0; *(LAS v2u*)(Ks + j * KA_P + 32 + 4 * c) = o1;
            const v4u w = ok ? vw[u] : (v4u){0u, 0u, 0u, 0u};
            LAS bf16* d = Vt + (8 * c) * VA_P + j;
            d[0] = (bf16)(w.x & 0xffffu); d[VA_P] = (bf16)(w.x >> 16); d[2 * VA_P] = (bf16)(w.y & 0xffffu); d[3 * VA_P] = (bf16)(w.y >> 16);
            d[4 * VA_P] = (bf16)(w.z & 0xffffu); d[5 * VA_P] = (bf16)(w.z >> 16); d[6 * VA_P] = (bf16)(w.w & 0xffffu); d[7 * VA_P] = (bf16)(w.w >> 16);
        }
    }
    v4u qlo, qhi;
    {
        const int R0 = wave * 48, g = R0 >> 7, pos = (R0 & 127) + l15, qp = n * 128 + pos, hq = hk * 3 + g;
        const bf16* src = PRE + ((size_t)b * SEQ + qp) * NPRE + C_AQ + hq * 64;
        qlo = *(const v4u*)(src + 8 * q4); qhi = *(const v4u*)(src + 32 + 8 * q4);
    }
    __syncthreads();
#pragma unroll 1
    for (int mt = 0; mt < 3; ++mt) {
        const int R0 = wave * 48 + mt * 16, g = R0 >> 7, pos = (R0 & 127) + l15, qp = n * 128 + pos, hq = hk * 3 + g;
        const size_t m = (size_t)b * SEQ + qp;
        v2u gat[4];
#pragma unroll
        for (int dt = 0; dt < 4; ++dt) gat[dt] = *(const v2u*)(PRE + m * NPRE + C_AG + hq * 64 + dt * 16 + 4 * q4);
        const v4u cqlo = qlo, cqhi = qhi;
        {
            const int mn = (mt < 2) ? mt + 1 : 2, R1 = wave * 48 + mn * 16, g1_ = R1 >> 7, pos1 = (R1 & 127) + l15, qp1 = n * 128 + pos1, hq1 = hk * 3 + g1_;
            const bf16* src = PRE + ((size_t)b * SEQ + qp1) * NPRE + C_AQ + hq1 * 64;
            qlo = *(const v4u*)(src + 8 * q4); qhi = *(const v4u*)(src + 32 + 8 * q4);
        }
        bf16x8 qf0, qf1;
        {
            float x1[8], x2[8]; unpack8(cqlo, x1); unpack8(cqhi, x2);
            float ss = 0.f;
#pragma unroll
            for (int i = 0; i < 8; ++i) ss += x1[i] * x1[i] + x2[i] * x2[i];
            ss += __shfl_xor(ss, 16); ss += __shfl_xor(ss, 32);
            const float rstd = (0.125f * 1.4426950408889634f) / sqrtf(ss * (1.f / 64.f) + NORM_EPS);
            float r1[8], r2[8];
            const f32x4 ga = *(const f32x4*)(P.in[6] + 8 * q4), gb = *(const f32x4*)(P.in[6] + 8 * q4 + 4), gc = *(const f32x4*)(P.in[6] + 32 + 8 * q4), gd = *(const f32x4*)(P.in[6] + 36 + 8 * q4);
            const f32x4 ca = *(const f32x4*)(RC + qp * 32 + 8 * q4), cb = *(const f32x4*)(RC + qp * 32 + 8 * q4 + 4), sa_ = *(const f32x4*)(RS + qp * 32 + 8 * q4), sb_ = *(const f32x4*)(RS + qp * 32 + 8 * q4 + 4);
#pragma unroll
            for (int i = 0; i < 8; ++i) {
                const float g1 = (i < 4) ? ga[i & 3] : gb[i & 3], g2 = (i < 4) ? gc[i & 3] : gd[i & 3], cs = (i < 4) ? ca[i & 3] : cb[i & 3], sn = (i < 4) ? sa_[i & 3] : sb_[i & 3];
                const float y1 = x1[i] * rstd * g1, y2 = x2[i] * rstd * g2; r1[i] = y1 * cs - y2 * sn; r2[i] = y2 * cs + y1 * sn;
            }
            qf0 = pack8(r1); qf1 = pack8(r2);
        }
        const int kt0 = (R0 & 127) >> 4;
        const int seq_lo = (n == 0) ? 8 : 0, seq_hi = (n == 15) ? 15 : 23;
        f32x4 acc[18];
#pragma unroll
        for (int u = 0; u < 17; ++u) {
            const LAS bf16* kr = Ks + ((kt0 + u) * 16 + l15) * KA_P + 8 * q4;
            const bf16x8 k0 = *(const LAS bf16x8*)(kr), k1 = *(const LAS bf16x8*)(kr + 32);
            f32x4 a = (f32x4){0.f, 0.f, 0.f, 0.f};
            a = MFMA16(k0, qf0, a); a = MFMA16(k1, qf1, a); acc[u] = a;
        }
        acc[17] = (f32x4){-1e30f, -1e30f, -1e30f, -1e30f};
        const float sink = P.in[8][hq] * 1.4426950408889634f;
        float mx = sink;
#pragma unroll
        for (int u = 0; u < 17; ++u) {
            const bool tv = (kt0 + u >= seq_lo) && (kt0 + u <= seq_hi);
#pragma unroll
            for (int i = 0; i < 4; ++i) {
                bool valid = tv;
                if (u == 0) valid = valid && (4 * q4 + i >= l15);
                if (u == 16) valid = valid && (4 * q4 + i <= l15);
                const float sv = valid ? acc[u][i] : -1e30f; acc[u][i] = sv; mx = fmaxf(mx, sv);
            }
        }
        mx = fmaxf(mx, __shfl_xor(mx, 16)); mx = fmaxf(mx, __shfl_xor(mx, 32));
        float sum = 0.f;
#pragma unroll
        for (int u = 0; u < 17; ++u)
#pragma unroll
            for (int i = 0; i < 4; ++i) { const float p = __builtin_amdgcn_exp2f(acc[u][i] - mx); acc[u][i] = p; sum += p; }
        acc[17] = (f32x4){0.f, 0.f, 0.f, 0.f};
        sum += __shfl_xor(sum, 16); sum += __shfl_xor(sum, 32);
        const float inv = 1.f / (sum + __builtin_amdgcn_exp2f(sink - mx));
        f32x4 o[4];
#pragma unroll
        for (int dt = 0; dt < 4; ++dt) o[dt] = (f32x4){0.f, 0.f, 0.f, 0.f};
#pragma unroll
        for (int k2 = 0; k2 < 9; ++k2) {
            float pp[8] = {acc[2 * k2][0], acc[2 * k2][1], acc[2 * k2][2], acc[2 * k2][3], acc[2 * k2 + 1][0], acc[2 * k2 + 1][1], acc[2 * k2 + 1][2], acc[2 * k2 + 1][3]};
            const bf16x8 pf = pack8(pp);
#pragma unroll
            for (int dt = 0; dt < 4; ++dt) {
                const LAS bf16* vr = Vt + (dt * 16 + l15) * VA_P + kt0 * 16 + k2 * 32 + 4 * q4;
                const v2u v0 = *(const LAS v2u*)(vr);
                v2u v1 = (v2u){0u, 0u};
                if (k2 < 8) v1 = *(const LAS v2u*)(vr + 16);
                const v4u vw = (v4u){v0.x, v0.y, v1.x, v1.y};
                o[dt] = MFMA16(__builtin_bit_cast(bf16x8, vw), pf, o[dt]);
            }
        }
#pragma unroll
        for (int dt = 0; dt < 4; ++dt) {
            const int ch = hq * 64 + dt * 16 + 4 * q4;
            float gg[4]; unpack4(gat[dt], gg);
            v2u w; w.x = pk2(o[dt][0] * inv * gg[0], o[dt][1] * inv * gg[1]); w.y = pk2(o[dt][2] * inv * gg[2], o[dt][3] * inv * gg[3]);
            *(v2u*)(YC + m * DM + ch) = w;
        }
    }
    __syncthreads();
}

constexpr int KC_P = 136, VC_P = 264;
__device__ __forceinline__ void attnC_qblock(const Params& P, const LAS bf16* Ks, const LAS bf16* Vt, bf16* YC, const v4u (&qraw)[4], const v2u (&gat)[8], size_t m, int hx, int l15, int q4) {
    {
        bf16x8 qf[4];
        {
            float x[4][8]; float ss = 0.f;
#pragma unroll
            for (int ks = 0; ks < 4; ++ks) { unpack8(qraw[ks], x[ks]);
#pragma unroll
                for (int i = 0; i < 8; ++i) ss += x[ks][i] * x[ks][i]; }
            ss += __shfl_xor(ss, 16); ss += __shfl_xor(ss, 32);
            const float rstd = (0.08838834764831845f * 1.4426950408889634f) / sqrtf(ss * (1.f / 128.f) + NORM_EPS);
#pragma unroll
            for (int ks = 0; ks < 4; ++ks) { float y[8];
                const f32x4 ga = *(const f32x4*)(P.in[22] + ks * 32 + 8 * q4), gb = *(const f32x4*)(P.in[22] + ks * 32 + 8 * q4 + 4);
#pragma unroll
                for (int i = 0; i < 8; ++i) y[i] = x[ks][i] * rstd * ((i < 4) ? ga[i & 3] : gb[i & 3]);
                qf[ks] = pack8(y); }
        }
        f32x4 acc[16];
#pragma unroll
        for (int kt = 0; kt < 16; ++kt) {
            const LAS bf16* kr = Ks + (kt * 16 + l15) * KC_P + 8 * q4;
            f32x4 a = (f32x4){0.f, 0.f, 0.f, 0.f};
#pragma unroll
            for (int ks = 0; ks < 4; ++ks) a = MFMA16(*(const LAS bf16x8*)(kr + ks * 32), qf[ks], a);
            acc[kt] = a;
        }
        float mx = -1e30f;
#pragma unroll
        for (int kt = 0; kt < 16; ++kt)
#pragma unroll
            for (int i = 0; i < 4; ++i) mx = fmaxf(mx, acc[kt][i]);
        mx = fmaxf(mx, __shfl_xor(mx, 16)); mx = fmaxf(mx, __shfl_xor(mx, 32));
        float sum = 0.f;
#pragma unroll
        for (int kt = 0; kt < 16; ++kt)
#pragma unroll
            for (int i = 0; i < 4; ++i) { const float p = __builtin_amdgcn_exp2f(acc[kt][i] - mx); acc[kt][i] = p; sum += p; }
        sum += __shfl_xor(sum, 16); sum += __shfl_xor(sum, 32);
        const float inv = 1.f / sum;
        f32x4 o[8];
#pragma unroll
        for (int dt = 0; dt < 8; ++dt) o[dt] = (f32x4){0.f, 0.f, 0.f, 0.f};
#pragma unroll
        for (int k2 = 0; k2 < 8; ++k2) {
            float pp[8] = {acc[2 * k2][0], acc[2 * k2][1], acc[2 * k2][2], acc[2 * k2][3], acc[2 * k2 + 1][0], acc[2 * k2 + 1][1], acc[2 * k2 + 1][2], acc[2 * k2 + 1][3]};
            const bf16x8 pf = pack8(pp);
#pragma unroll
            for (int dt = 0; dt < 8; ++dt) {
                const LAS bf16* vr = Vt + (dt * 16 + l15) * VC_P + k2 * 32 + 4 * q4;
                const v2u v0 = *(const LAS v2u*)(vr), v1 = *(const LAS v2u*)(vr + 16);
                const v4u vw = (v4u){v0.x, v0.y, v1.x, v1.y};
                o[dt] = MFMA16(__builtin_bit_cast(bf16x8, vw), pf, o[dt]);
            }
        }
#pragma unroll
        for (int dt = 0; dt < 8; ++dt) {
            const int ch = hx * 128 + dt * 16 + 4 * q4;
            float gg[4]; unpack4(gat[dt], gg);
            v2u w; w.x = pk2(o[dt][0] * inv * gg[0], o[dt][1] * inv * gg[1]); w.y = pk2(o[dt][2] * inv * gg[2], o[dt][3] * inv * gg[3]);
            *(v2u*)(YC + m * DM + 1536 + ch) = w;
        }
    }
}
__device__ __forceinline__ void attnC_item(const Params& P, int item, LAS unsigned char* lds) {
    const int tid = pg8::mk_tid(lds), lane = tid & 63, wave = __builtin_amdgcn_readfirstlane(tid >> 6), l15 = lane & 15, q4 = lane >> 4;
    const int b = item >> 5, qb0 = 2 * ((item >> 2) & 7), hx = item & 3;
    const bf16* PRE = (const bf16*)(P.ws + WS_PRE); const bf16* MKV = (const bf16*)(P.ws + WS_MKV); bf16* YC = (bf16*)(P.ws + WS_YCAT);
    LAS bf16* Ks = (LAS bf16*)lds; LAS bf16* Vt = Ks + 256 * KC_P;
    const size_t m = (size_t)b * SEQ + qb0 * 128 + wave * 16 + l15;
    {
        v4u kw[8], vw[8];
#pragma unroll
        for (int u = 0; u < 8; ++u) {
            const int it = tid + u * NTHREADS, j = it >> 4, c = it & 15;
            const bf16* src = MKV + ((size_t)b * NMEM + j) * 1024 + hx * 128 + 8 * c;
            kw[u] = *(const v4u*)(src); vw[u] = *(const v4u*)(src + 512);
        }
        const f32x4 g0 = *(const f32x4*)(P.in[23] + 8 * (tid & 15)), g1 = *(const f32x4*)(P.in[23] + 8 * (tid & 15) + 4);
#pragma unroll
        for (int u = 0; u < 8; ++u) {
            const int it = tid + u * NTHREADS, j = it >> 4, c = it & 15;
            float x[8]; unpack8(kw[u], x);
            float ss = 0.f;
#pragma unroll
            for (int i = 0; i < 8; ++i) ss += x[i] * x[i];
            ss = red8(ss); ss = dpp_add<0x140>(ss);
            const float rstd = 1.f / sqrtf(ss * (1.f / 128.f) + NORM_EPS);
            v4u o; o.x = pk2(x[0] * rstd * g0.x, x[1] * rstd * g0.y); o.y = pk2(x[2] * rstd * g0.z, x[3] * rstd * g0.w);
            o.z = pk2(x[4] * rstd * g1.x, x[5] * rstd * g1.y); o.w = pk2(x[6] * rstd * g1.z, x[7] * rstd * g1.w);
            *(LAS v4u*)(Ks + j * KC_P + 8 * c) = o;
            const v4u w = vw[u];
            LAS bf16* d = Vt + (8 * c) * VC_P + j;
            d[0] = (bf16)(w.x & 0xffffu); d[VC_P] = (bf16)(w.x >> 16); d[2 * VC_P] = (bf16)(w.y & 0xffffu); d[3 * VC_P] = (bf16)(w.y >> 16);
            d[4 * VC_P] = (bf16)(w.z & 0xffffu); d[5 * VC_P] = (bf16)(w.z >> 16); d[6 * VC_P] = (bf16)(w.w & 0xffffu); d[7 * VC_P] = (bf16)(w.w >> 16);
        }
    }
    v4u qraw[4]; v2u gat[8];
    {
        const bf16* src = PRE + m * NPRE + C_XQ + hx * 128 + 8 * q4;
#pragma unroll
        for (int ks = 0; ks < 4; ++ks) qraw[ks] = *(const v4u*)(src + ks * 32);
#pragma unroll
        for (int dt = 0; dt < 8; ++dt) gat[dt] = *(const v2u*)(PRE + m * NPRE + C_XG + hx * 128 + dt * 16 + 4 * q4);
    }
    __syncthreads();
    v4u qraw2[4]; v2u gat2[8];
    {
        const size_t m2 = m + 128; const bf16* src = PRE + m2 * NPRE + C_XQ + hx * 128 + 8 * q4;
#pragma unroll
        for (int ks = 0; ks < 4; ++ks) qraw2[ks] = *(const v4u*)(src + ks * 32);
#pragma unroll
        for (int dt = 0; dt < 8; ++dt) gat2[dt] = *(const v2u*)(PRE + m2 * NPRE + C_XG + hx * 128 + dt * 16 + 4 * q4);
    }
    attnC_qblock(P, Ks, Vt, YC, qraw, gat, m, hx, l15, q4);
    __builtin_amdgcn_sched_barrier(0);
    attnC_qblock(P, Ks, Vt, YC, qraw2, gat2, m + 128, hx, l15, q4);
    __syncthreads();
}

__device__ __forceinline__ void p5_rwkv_post(const Params& P, LAS unsigned char* lds) {
    const bf16* PRE = (const bf16*)(P.ws + WS_PRE); const bf16* EA = (const bf16*)((unsigned char*)P.out + DO_EA);
    const bf16* YF = (const bf16*)((unsigned char*)P.out + DO_YF); const bf16* YB = (const bf16*)(P.ws + WS_YB); bf16* YC = (bf16*)(P.ws + WS_YCAT);
    const float* mu = P.in[10];
    const int gt = blockIdx.x * NTHREADS + pg8::mk_tid(lds), NGT = gridDim.x * NTHREADS;
    for (int idx = gt; idx < M_TOK * 96; idx += NGT) {
        const int m = idx / 96, he = idx - m * 96, ch0 = he * 8, t = m & (SEQ - 1);
        const bf16* p = PRE + (size_t)m * NPRE + C_RS + ch0;
        const v4u z4 = (v4u){0u, 0u, 0u, 0u};
        const bool hp = t > 0, hn = t < SEQ - 1;
        const v4u rc = *(const v4u*)(p), kc = *(const v4u*)(p + 768), vc = *(const v4u*)(p + 1536);
        const v4u rp = hp ? *(const v4u*)(p - NPRE) : z4, kp = hp ? *(const v4u*)(p - NPRE + 768) : z4, vp = hp ? *(const v4u*)(p - NPRE + 1536) : z4;
        const v4u rn = hn ? *(const v4u*)(p + NPRE) : z4, kn = hn ? *(const v4u*)(p + NPRE + 768) : z4, vn = hn ? *(const v4u*)(p + NPRE + 1536) : z4;
        const v4u af8 = *(const v4u*)(EA + (size_t)m * NLORA + 1536 + ch0), ab8 = *(const v4u*)(EA + (size_t)m * NLORA + 2304 + ch0);
        const v4u yf8 = *(const v4u*)(YF + (size_t)m * RW + ch0), yb8 = *(const v4u*)(YB + (size_t)m * RW + ch0);
        const v4u rg8 = *(const v4u*)(PRE + (size_t)m * NPRE + C_RG + ch0);
        float r[8], k[8], v[8], x0[8], x1[8], x2[8];
        unpack8(rc, x0); unpack8(rp, x1); unpack8(rn, x2);
#pragma unroll
        for (int i = 0; i < 8; ++i) r[i] = x0[i] + mu[ch0 + i] * (0.5f * (x1[i] + x2[i]) - x0[i]);
        unpack8(kc, x0); unpack8(kp, x1); unpack8(kn, x2);
#pragma unroll
        for (int i = 0; i < 8; ++i) k[i] = x0[i] + mu[768 + ch0 + i] * (0.5f * (x1[i] + x2[i]) - x0[i]);
        unpack8(vc, x0); unpack8(vp, x1); unpack8(vn, x2);
#pragma unroll
        for (int i = 0; i < 8; ++i) v[i] = x0[i] + mu[1536 + ch0 + i] * (0.5f * (x1[i] + x2[i]) - x0[i]);
        float af[8], ab[8], ys[8], yb[8], rg[8]; unpack8(af8, af); unpack8(ab8, ab); unpack8(yf8, ys); unpack8(yb8, yb); unpack8(rg8, rg);
        float bs = 0.f, sm = 0.f;
#pragma unroll
        for (int i = 0; i < 8; ++i) { const float kds = k[i] * (2.f + (af[i] + ab[i] - 2.f) * P.in[12][ch0 + i]); bs += r[i] * kds * P.in[13][ch0 + i]; ys[i] += yb[i]; sm += ys[i]; }
        bs = red8(bs); sm = red8(sm);
        const float mean = sm * (1.f / 64.f);
        float vs = 0.f;
#pragma unroll
        for (int i = 0; i < 8; ++i) { ys[i] -= mean; vs += ys[i] * ys[i]; }
        vs = red8(vs);
        const float rstd = 1.f / sqrtf(vs * (1.f / 64.f) + GN_EPS);
        float o[8];
#pragma unroll
        for (int i = 0; i < 8; ++i) o[i] = (ys[i] * rstd * P.in[18][ch0 + i] + P.in[19][ch0 + i] + bs * v[i]) * rg[i];
        v4u w; w.x = pk2(o[0], o[1]); w.y = pk2(o[2], o[3]); w.z = pk2(o[4], o[5]); w.w = pk2(o[6], o[7]);
        *(v4u*)(YC + (size_t)m * DM + 768 + ch0) = w;
    }
}


constexpr size_t WS_XBAR = 504 * MiB + 832 * 1024;
#define XB_TMO      128
#define XB_XCNT(j)  (256  + 64 * (j))
#define XB_XSUB(j)  (1280 + 64 * (j))
#define XB_XGEN(j)  (2304 + 64 * (j))
#define XB_TOP      3328
#define XB_TOPGEN   3392
#define XCD_BAR_WORDS 3456
#define XB_SPIN_CAP (1u << 18)
__device__ __forceinline__ unsigned xb_ld(unsigned* p)              { return __hip_atomic_load(p, __ATOMIC_RELAXED, __HIP_MEMORY_SCOPE_AGENT); }
__device__ __forceinline__ unsigned xb_add(unsigned* p, unsigned v) { return __hip_atomic_fetch_add(p, v, __ATOMIC_RELAXED, __HIP_MEMORY_SCOPE_AGENT); }
__device__ __forceinline__ unsigned xb_xcc_id() { return (unsigned)__builtin_amdgcn_s_getreg((3 << 11) | 20) & 0xFu; }
#define XB_SPIN(cond, bar) do { unsigned _sp = 0; while (cond) { __builtin_amdgcn_s_sleep(1); \
    if ((++_sp & 255u) == 0u) { if (xb_ld(&(bar)[XB_TMO])) break; if (_sp > XB_SPIN_CAP) { atomicAdd(&(bar)[XB_TMO], 1u); break; } } } } while (0)
__device__ __forceinline__ void xcd_barrier_complete(unsigned* bar, unsigned x, unsigned& nloc, unsigned& nx) {
    const unsigned G = gridDim.x * gridDim.y * gridDim.z;
    unsigned sum, cnt, mine, sp = 0u;
    for (;;) {
        sum = 0u; cnt = 0u; mine = 0u;
#pragma unroll
        for (unsigned j = 0; j < 16; ++j) { const unsigned c = xb_ld(&bar[XB_XCNT(j)]); sum += c; cnt += (c > 0u) ? 1u : 0u; mine = (j == x) ? c : mine; }
        if (sum == G) break;
        __builtin_amdgcn_s_sleep(1);
        if ((++sp & 255u) == 0u) { if (xb_ld(&bar[XB_TMO])) break; if (sp > XB_SPIN_CAP) { atomicAdd(&bar[XB_TMO], 1u); break; } }
    }
    nloc = mine > 0u ? mine : 1u; nx = cnt > 0u ? cnt : 1u;
}
__device__ __forceinline__ void xcd_barrier(unsigned* bar, volatile LAS unsigned* st, LAS unsigned char* lds) {
    asm volatile("s_waitcnt vmcnt(0)" ::: "memory");
    __syncthreads();
    if (pg8::mk_tid(lds) == 0) {
        const unsigned x = xb_xcc_id();
        __builtin_amdgcn_s_waitcnt(0);
        unsigned nloc = st[0], nx = st[1];
        if (nloc == 0u) { xcd_barrier_complete(bar, x, nloc, nx); st[0] = nloc; st[1] = nx; }
        const unsigned old = xb_add(&bar[XB_XSUB(x)], 1u);
        const unsigned gen = old / nloc;
        if (old + 1u == (gen + 1u) * nloc) {
            __builtin_amdgcn_fence(__ATOMIC_RELEASE, "agent");
            asm volatile("s_waitcnt vmcnt(0)" ::: "memory");
            const unsigned og = xb_add(&bar[XB_TOP], 1u);
            const unsigned tg = og / nx;
            if (og + 1u == (tg + 1u) * nx) xb_add(&bar[XB_TOPGEN], 1u);
            else XB_SPIN(xb_ld(&bar[XB_TOPGEN]) == tg, bar);
            __builtin_amdgcn_fence(__ATOMIC_ACQUIRE, "agent");
            xb_add(&bar[XB_XGEN(x)], 1u);
            asm volatile("s_waitcnt vmcnt(0)" ::: "memory");
        } else {
            XB_SPIN(xb_ld(&bar[XB_XGEN(x)]) == gen, bar);
            __builtin_amdgcn_fence(__ATOMIC_ACQUIRE, "agent");
            asm volatile("s_waitcnt vmcnt(0)" ::: "memory");
        }
    }
    __syncthreads();
}

constexpr int N_PHASES = 8;
__global__ void __launch_bounds__(NTHREADS, 2) hybrid_fwd(Params P) {
    extern __shared__ __attribute__((aligned(16))) unsigned char lds_raw[];
    LAS unsigned char* lds = (LAS unsigned char*)lds_raw;
    cg::grid_group grid = cg::this_grid();
    const int lo = P.ph_lo, hi = P.ph_hi, G = gridDim.x;
    if ((threadIdx.x & 63) == 0) *(volatile LAS int*)(lds + pg8::TIDTAB_OFF + 4 * pg8::hw_slot()) = (int)(threadIdx.x >> 6);
    volatile LAS unsigned* xbst = (volatile LAS unsigned*)(lds + pg8::TIDTAB_OFF - 128);
    unsigned* xbar = (unsigned*)(P.ws + WS_XBAR);
    if (threadIdx.x == 0) { xbst[0] = 0u; xbst[1] = 0u; (void)xb_add(&xbar[XB_XCNT(xb_xcc_id())], 1u); }
    __syncthreads();
    unsigned char* ws = P.ws; unsigned char* dob = (unsigned char*)P.out;
#ifdef PHMASK
#define IN(k) (((PHMASK >> (k)) & 1) && lo <= (k) && (k) < hi)
#else
#define IN(k) (lo <= (k) && (k) < hi)
#endif
#define SEAM(k) do { if (IN(k) && IN((k) + 1)) xcd_barrier(xbar, xbst, lds); } while (0)
#ifndef REPEAT_MASK
#define REPEAT_MASK 0
#endif
#define REP(k) for (int rep_ = 0; rep_ < (((REPEAT_MASK >> (k)) & 1) ? 2 : 1); ++rep_)
#define REPSYNC() do { if (rep_) grid.sync(); } while (0)
    if (hi > N_PHASES) grid.sync();
    if (IN(0)) REP(0) { REPSYNC(); p0_prologue(P, lds, P.out); __syncthreads(); }
    SEAM(0);
    if (IN(1)) REP(1) { REPSYNC();
        { pg8::Gemm g{(const bf16*)(dob + DO_H), (const bf16*)(dob + DO_WIN), M_TOK, NIN, DM}; pg8::StaticOrder S; S.init(M_TOK, NIN, G, (int)blockIdx.x);
          EpiProj E{(bf16*)(ws + WS_PRE), (bf16*)(ws + WS_GATES), P.in[5]};
          pg8::gemm_phase<EpiProj, pg8::StaticOrder, true, true>(lds, g, S, E); }
        { pg8::Gemm g{(const bf16*)(ws + WS_MEMN), (const bf16*)(ws + WS_WXKV), MEMROWS, 1024, DM}; pg8::StaticOrder S; S.init(MEMROWS, 1024, G, (int)((blockIdx.x + G - 64) % G));
          EpiPlain E{(bf16*)(ws + WS_MKV), 1024};
          pg8::gemm_phase<EpiPlain, pg8::StaticOrder, true, true>(lds, g, S, E); }
    }
    SEAM(1);
    if (IN(2)) REP(2) { REPSYNC(); p2_lora_in(P, lds); }
    SEAM(2);
    if (IN(3)) REP(3) { REPSYNC();
        int klora = 256; asm volatile("" : "+s"(klora));
        pg8::Gemm g{(const bf16*)(dob + DO_LIN), (const bf16*)(ws + WS_LORAB), M_TOK, NLORA, klora}; pg8::StaticOrder S; S.init(M_TOK, NLORA, G, (int)blockIdx.x);
        EpiLora E{(bf16*)(dob + DO_EA), P.in[14], P.in[16]};
        pg8::gemm_phase<EpiLora, pg8::StaticOrder, true, true>(lds, g, S, E);
    }
    SEAM(3);
    if (IN(4)) REP(4) { REPSYNC();
        const int bid = blockIdx.x;
#ifndef STATIC_ATT
#define STATIC_ATT 0
#endif
#ifndef SCAN2
#define SCAN2 1
#endif
        if (bid < 192) scan_chunked(P, bid, lds);
        if (STATIC_ATT) {
            if (bid >= 192) { for (int it = bid - 192; it < 768; it += G - 192) { if (it < 512) attnA_item(P, it, lds); else attnC_item(P, it - 512, lds); } }
        } else {
            volatile LAS int* slot = (volatile LAS int*)(lds + pg8::TIDTAB_OFF - 64);
            const int tid4 = pg8::mk_tid(lds);
            for (;;) {
                if (tid4 == 0) *slot = (int)__hip_atomic_fetch_add((unsigned*)(ws + WS_CTR), 1u, __ATOMIC_RELAXED, __HIP_MEMORY_SCOPE_AGENT);
                __syncthreads();
                const int it = *slot;
                __syncthreads();
                if (it >= 768) break;
                if (it < 512) attnA_item(P, it, lds); else attnC_item(P, it - 512, lds);
            }
        }
    }
    SEAM(4);
    if (IN(5)) REP(5) { REPSYNC(); p5_rwkv_post(P, lds); }
    SEAM(5);
    if (IN(6)) REP(6) { REPSYNC();
        pg8::Gemm g{(const bf16*)(ws + WS_YCAT), (const bf16*)(ws + WS_WCAT), M_TOK, DM, DM}; pg8::StaticOrder S; S.init(M_TOK, DM, G, (int)blockIdx.x);
        EpiMerged E{(bf16*)(ws + WS_MERGED), (const bf16*)(ws + WS_GATES)};
        pg8::gemm_phase<EpiMerged, pg8::StaticOrder, true, true>(lds, g, S, E);
    }
    SEAM(6);
    if (IN(7)) REP(7) { REPSYNC();
        pg8::Gemm g{(const bf16*)(ws + WS_MERGED), (const bf16*)(ws + WS_WOUT), M_TOK, DM, DM}; pg8::StaticOrder S; S.init(M_TOK, DM, G, (int)blockIdx.x);
        EpiOut E{P.out, P.in[0]};
        pg8::gemm_phase<EpiOut, pg8::StaticOrder, true, true>(lds, g, S, E);
    }
#undef IN
#undef SEAM
}

#ifndef ONE_LAUNCH
#define ONE_LAUNCH 1
#endif
extern "C" void kernel_launch(void* const* d_in, const int* in_sizes, int n_in, void* d_out, int out_size, void* d_ws, size_t ws_size, hipStream_t stream) {
    static int grid = 0;
    if (grid == 0) {
        if (n_in != 26 || out_size != M_TOK * DM || ws_size < WS_END) { fprintf(stderr, "kernel_launch: unexpected shapes (n_in %d, out %d, ws %zu); nothing launched\n", n_in, out_size, ws_size); grid = -1; return; }
        int dev = 0, cus = 0, per_cu = 0;
        hipGetDevice(&dev); hipDeviceGetAttribute(&cus, hipDeviceAttributeMultiprocessorCount, dev);
        if (hipFuncSetAttribute((const void*)hybrid_fwd, hipFuncAttributeMaxDynamicSharedMemorySize, LDS_BYTES) != hipSuccess) { fprintf(stderr, "kernel_launch: hipFuncSetAttribute failed\n"); grid = -1; return; }
        hipOccupancyMaxActiveBlocksPerMultiprocessor(&per_cu, (const void*)hybrid_fwd, NTHREADS, LDS_BYTES);
        (void)hipGetLastError();
        if (per_cu < 1) per_cu = 1;
        grid = cus * per_cu; if (grid > 256) grid = 256;
        if (grid < 200) { fprintf(stderr, "kernel_launch: grid %d too small for the scan/attention split\n", grid); grid = -1; return; }
    }
    if (grid < 0) return;
    Params p{};
    for (int i = 0; i < 26; ++i) p.in[i] = (const float*)d_in[i];
    p.out = (float*)d_out; p.ws = (unsigned char*)d_ws;
#if ONE_LAUNCH
    (void)hipMemsetAsync((unsigned char*)d_ws + WS_XBAR, 0, XCD_BAR_WORDS * 4, stream);
    p.ph_lo = 0; p.ph_hi = N_PHASES;
    void* args[] = {&p};
    hipError_t e = hipLaunchCooperativeKernel((const void*)hybrid_fwd, dim3(grid), dim3(NTHREADS), args, LDS_BYTES, stream);
    if (e != hipSuccess) fprintf(stderr, "cooperative launch failed: %s (grid %d)\n", hipGetErrorString(e), grid);
#else
    for (int ph = 0; ph < N_PHASES; ++ph) {
        p.ph_lo = ph; p.ph_hi = ph + 1;
        hipLaunchKernelGGL(hybrid_fwd, dim3(grid), dim3(NTHREADS), LDS_BYTES, stream, p);
    }
#endif
}
```

```cpp
#include <hip/hip_runtime.h>
#include <hip/hip_cooperative_groups.h>
#include <cstdio>
#include <cstdint>
namespace cg = cooperative_groups;
namespace pg8 {
#define PG8_LAS __attribute__((address_space(3)))
typedef unsigned short bf16_t;
typedef short bf16x8 __attribute__((ext_vector_type(8)));
typedef float f32x4 __attribute__((ext_vector_type(4)));
typedef unsigned u32x4 __attribute__((ext_vector_type(4)));
constexpr int BM = 256, BK = 64, HALF = 128, HTB = HALF * BK * 2  , STAGE_BYTES = 8 * HTB, NXCD = 8, WGM = 2;

__host__ __device__ __forceinline__ int lds_byte(int r, int c) { const int st = (r >> 4) * 2 + (c >> 5), rr = r & 15, cc = c & 31, ob = rr * 64 + cc * 2; return st * 1024 + (ob ^ (((ob >> 9) & 1) << 5)); }
__host__ __device__ __forceinline__ void stage_rc(int b, int& R, int& C) { const int st = b / 1024, sb = b % 1024, swz = sb ^ (((sb >> 9) & 1) << 5); R = (st >> 1) * 16 + swz / 64; C = (st & 1) * 32 + (swz % 64) / 2; }
__host__ __device__ __forceinline__ int perm32(int rho) { const int n = rho >> 4, i = rho & 15; return 8 * (i >> 2) + 4 * n + (i & 3); }


constexpr int TIDTAB_OFF = 147200;
__device__ __forceinline__ int hw_slot() { return (int)(__builtin_amdgcn_s_getreg((5 << 11) | 4) & 63u); }
__device__ __forceinline__ int mk_tid(PG8_LAS unsigned char* lds) {
    const int lane = (int)__builtin_amdgcn_mbcnt_hi(~0u, __builtin_amdgcn_mbcnt_lo(~0u, 0u));
    const int w = __builtin_amdgcn_readfirstlane(*(volatile PG8_LAS int*)(lds + TIDTAB_OFF + 4 * hw_slot()));
    return w * 64 + lane;
}
struct Unit { int pm, pn; };
struct Gemm { const bf16_t* A; const bf16_t* Bt; int M, N, K; };

struct StaticOrder {
    int nM, nN, nwg, G, c;
    __host__ __device__ void init(int M, int N, int G_, int c_) { nM = M / BM; nN = N / BM; nwg = nM * nN; G = G_; c = c_; }
    __host__ __device__ bool next(int i, Unit& u) const {
        const long L = (long)i * G + c; if (L >= nwg) return false;
        int wgid = (int)L; { const int q = nwg / NXCD, r = nwg % NXCD, xcd = wgid % NXCD, off = wgid / NXCD; wgid = (xcd < r ? xcd * (q + 1) : r * (q + 1) + (xcd - r) * q) + off; }
        const int nig = WGM * nN, gid = wgid / nig, fm = gid * WGM, gsz = (nM - fm) < WGM ? (nM - fm) : WGM;
        u.pm = fm + ((wgid % nig) % gsz); u.pn = (wgid % nig) / gsz; return true;
    }
    __device__ __forceinline__ void a_ready(const Unit&) const {}
    __device__ __forceinline__ void done(const Unit&) const {}
};

__device__ __forceinline__ unsigned cvt_pk_bf16(float lo, float hi) { unsigned r; asm volatile("v_cvt_pk_bf16_f32 %0, %1, %2" : "=v"(r) : "v"(lo), "v"(hi)); return r; }
template <class Epi, class Sched, bool ALIGN_EPI = false, bool SP2 = false>
__device__ __forceinline__ void gemm_phase(PG8_LAS unsigned char* lds, const Gemm g, const Sched& S, const Epi& E) {
    const int tid = mk_tid(lds), wid = __builtin_amdgcn_readfirstlane(tid >> 6), lane = tid & 63, wr = wid >> 2, wc = wid & 3, fr = lane & 15, fq = lane >> 4;
    const int K = g.K, nt = K / BK;
    unsigned voffA[2], voffB[2];
#pragma unroll
    for (int i = 0; i < 2; ++i) { int R, C; stage_rc(tid * 16 + i * 8192, R, C); const int Rb = Epi::PERM ? ((R & ~31) + perm32(R & 31)) : R;
        voffA[i] = (unsigned)(R * K + C) * 2u; voffB[i] = (unsigned)(Rb * K + C) * 2u; }
    const size_t kstep = (size_t)(BK * 2);
    const size_t hstep = (size_t)HALF * K * 2;
    const size_t tstep = 2 * hstep;
    const unsigned ldsw = (unsigned)wid * 1024u;
    const int aoff = lds_byte(wr * 64 + fr, fq * 8), boff = lds_byte(wc * 32 + fr, fq * 8);
#define PG8_SA(b, h) (((b) * 2 + (h)) * HTB)
#define PG8_SB(b, h) ((4 + (b) * 2 + (h)) * HTB)
#define PG8_STAGE(bufoff, gbase, voff) do { _Pragma("unroll") for (int _i = 0; _i < 2; ++_i) \
        __builtin_amdgcn_global_load_lds((const unsigned*)((const char*)(gbase) + (voff)[_i]), (PG8_LAS unsigned*)(lds + (bufoff) + ldsw + _i * 8192), 16, 0, 0); } while (0)
#define PG8_LDA(dst, b, h) do { _Pragma("unroll") for (int m = 0; m < 4; ++m) _Pragma("unroll") for (int k = 0; k < 2; ++k) dst[m][k] = *(const PG8_LAS bf16x8*)(lds + PG8_SA(b, h) + aoff + m * 2048 + k * 1024); } while (0)
#define PG8_LDB(dst, b, h) do { _Pragma("unroll") for (int n = 0; n < 2; ++n) _Pragma("unroll") for (int k = 0; k < 2; ++k) dst[n][k] = *(const PG8_LAS bf16x8*)(lds + PG8_SB(b, h) + boff + n * 2048 + k * 1024); } while (0)
#define PG8_MMA(ai, bj, At, Bt) do { __builtin_amdgcn_s_setprio(1); _Pragma("unroll") for (int m = 0; m < 4; ++m) _Pragma("unroll") for (int n = 0; n < 2; ++n) _Pragma("unroll") for (int k = 0; k < 2; ++k) \
        acc[ai][bj][m][n] = __builtin_amdgcn_mfma_f32_16x16x32_bf16(Bt[n][k], At[m][k], acc[ai][bj][m][n], 0, 0, 0); __builtin_amdgcn_s_setprio(0); } while (0)
#define PG8_WAIT_V(n) asm volatile("s_waitcnt vmcnt(" #n ")" ::: "memory")
#define PG8_WAIT_L(n) asm volatile("s_waitcnt lgkmcnt(" #n ")" ::: "memory")
#define PG8_BAR __builtin_amdgcn_s_barrier()
#define PG8_SCHED __builtin_amdgcn_sched_barrier(0)
    Unit cur, nxt; int ui = 0;
    if (!S.next(0, cur)) return;
    f32x4 acc[2][2][4][2];
#pragma unroll
    for (int a = 0; a < 2; ++a)
#pragma unroll
        for (int b = 0; b < 2; ++b)
#pragma unroll
            for (int m = 0; m < 4; ++m)
#pragma unroll
                for (int n = 0; n < 2; ++n) acc[a][b][m][n] = (f32x4){0.f, 0.f, 0.f, 0.f};
    bf16x8 At[4][2], B0[2][2], B1[2][2];
    const char* cA = (const char*)g.A + (size_t)cur.pm * tstep; const char* cB = (const char*)g.Bt + (size_t)cur.pn * tstep;
    S.a_ready(cur);
    if constexpr (SP2) {
        PG8_STAGE(PG8_SB(0, 0), cB, voffB); PG8_STAGE(PG8_SB(0, 1), cB + hstep, voffB); PG8_STAGE(PG8_SA(0, 0), cA, voffA); PG8_STAGE(PG8_SA(0, 1), cA + hstep, voffA);
        if (wr == 1) PG8_BAR;
        PG8_WAIT_V(2); PG8_BAR;
        PG8_STAGE(PG8_SB(1, 0), cB + kstep, voffB); PG8_STAGE(PG8_SA(1, 0), cA + kstep, voffA); PG8_STAGE(PG8_SB(1, 1), cB + hstep + kstep, voffB);
        PG8_WAIT_V(6); PG8_BAR;
    } else {
        PG8_STAGE(PG8_SB(0, 0), cB, voffB); PG8_STAGE(PG8_SA(0, 0), cA, voffA); PG8_STAGE(PG8_SB(0, 1), cB + hstep, voffB); PG8_STAGE(PG8_SA(0, 1), cA + hstep, voffA);
        if (wr == 1) PG8_BAR;
        PG8_WAIT_V(4); PG8_BAR;
        PG8_STAGE(PG8_SB(1, 0), cB + kstep, voffB); PG8_STAGE(PG8_SA(1, 0), cA + kstep, voffA); PG8_STAGE(PG8_SB(1, 1), cB + hstep + kstep, voffB);
        PG8_WAIT_V(6); PG8_BAR;
    }
    for (;;) {
        const bool has_next = S.next(ui + 1, nxt);
        const char* nA = has_next ? (const char*)g.A + (size_t)nxt.pm * tstep : cA; const char* nB = has_next ? (const char*)g.Bt + (size_t)nxt.pn * tstep : cB;
        for (int t = 0; t < nt; t += 2) {
            if constexpr (Epi::KHOOK) { if (t == Epi::HK0 || t == Epi::HK1) E.khook(acc, cur, t, wr, wc, fr, fq); }
            const bool last = (t == nt - 2);
            const char* a1 = cA + (size_t)(t + 1) * kstep;
            const char* a2 = last ? nA : cA + (size_t)(t + 2) * kstep; const char* b2 = last ? nB : cB + (size_t)(t + 2) * kstep;
            const char* a3 = a2 + kstep; const char* b3 = b2 + kstep;
            if (last && has_next) S.a_ready(nxt);
            if constexpr (SP2) {
            PG8_LDB(B0, 0, 0); PG8_LDB(B1, 0, 1); PG8_SCHED; PG8_LDA(At, 0, 0); PG8_STAGE(PG8_SA(1, 1), a1 + hstep, voffA);
            PG8_WAIT_V(8); PG8_WAIT_L(0); PG8_BAR; PG8_MMA(0, 0, At, B0); PG8_MMA(0, 1, At, B1); PG8_BAR; PG8_SCHED;
            PG8_LDA(At, 0, 1); PG8_STAGE(PG8_SB(0, 0), b2, voffB); PG8_STAGE(PG8_SB(0, 1), b2 + hstep, voffB); PG8_STAGE(PG8_SA(0, 0), a2, voffA);
            PG8_WAIT_V(8); PG8_WAIT_L(0); PG8_BAR; PG8_MMA(1, 0, At, B0); PG8_MMA(1, 1, At, B1); PG8_BAR; PG8_SCHED;
            PG8_LDB(B0, 1, 0); PG8_LDB(B1, 1, 1); PG8_SCHED; PG8_LDA(At, 1, 0); PG8_STAGE(PG8_SA(0, 1), a2 + hstep, voffA);
            PG8_WAIT_V(8); PG8_WAIT_L(0); PG8_BAR; PG8_MMA(0, 0, At, B0); PG8_MMA(0, 1, At, B1); PG8_BAR; PG8_SCHED;
            PG8_LDA(At, 1, 1); PG8_STAGE(PG8_SB(1, 0), b3, voffB); PG8_STAGE(PG8_SB(1, 1), b3 + hstep, voffB); PG8_STAGE(PG8_SA(1, 0), a3, voffA);
            PG8_WAIT_V(8); PG8_WAIT_L(0); PG8_BAR; PG8_MMA(1, 0, At, B0); PG8_MMA(1, 1, At, B1); PG8_BAR; PG8_SCHED;
            } else {
            PG8_LDB(B0, 0, 0); PG8_SCHED; PG8_LDA(At, 0, 0); PG8_STAGE(PG8_SA(1, 1), a1 + hstep, voffA);
            PG8_WAIT_L(8); PG8_BAR; PG8_WAIT_L(0); PG8_MMA(0, 0, At, B0); PG8_BAR; PG8_SCHED;
            PG8_LDB(B1, 0, 1); PG8_STAGE(PG8_SB(0, 0), b2, voffB);
            PG8_BAR; PG8_WAIT_L(0); PG8_MMA(0, 1, At, B1); PG8_BAR;
            PG8_LDA(At, 0, 1); PG8_STAGE(PG8_SA(0, 0), a2, voffA);
            PG8_BAR; PG8_WAIT_L(0); PG8_MMA(1, 0, At, B0); PG8_BAR; PG8_SCHED;
            PG8_STAGE(PG8_SB(0, 1), b2 + hstep, voffB);
            PG8_WAIT_V(6); PG8_BAR; PG8_MMA(1, 1, At, B1); PG8_BAR;
            PG8_LDB(B0, 1, 0); PG8_SCHED; PG8_LDA(At, 1, 0); PG8_STAGE(PG8_SA(0, 1), a2 + hstep, voffA);
            PG8_WAIT_L(8); PG8_BAR; PG8_WAIT_L(0); PG8_MMA(0, 0, At, B0); PG8_BAR; PG8_SCHED;
            PG8_LDB(B1, 1, 1); PG8_STAGE(PG8_SB(1, 0), b3, voffB);
            PG8_BAR; PG8_WAIT_L(0); PG8_MMA(0, 1, At, B1); PG8_BAR;
            PG8_LDA(At, 1, 1); PG8_STAGE(PG8_SA(1, 0), a3, voffA);
            PG8_BAR; PG8_WAIT_L(0); PG8_MMA(1, 0, At, B0); PG8_BAR; PG8_SCHED;
            PG8_STAGE(PG8_SB(1, 1), b3 + hstep, voffB);
            PG8_WAIT_V(6); PG8_BAR; PG8_MMA(1, 1, At, B1); PG8_BAR;
            }
        }
        if constexpr (ALIGN_EPI) { if (wr == 0) PG8_BAR; }
        if constexpr (!Epi::AFTER_DRAIN) { E(acc, cur, wr, wc, fr, fq); S.done(cur); }
        if (!has_next) break;
#pragma unroll
        for (int a = 0; a < 2; ++a)
#pragma unroll
            for (int b = 0; b < 2; ++b)
#pragma unroll
                for (int m = 0; m < 4; ++m)
#pragma unroll
                    for (int n = 0; n < 2; ++n) acc[a][b][m][n] = (f32x4){0.f, 0.f, 0.f, 0.f};
        cur = nxt; cA = nA; cB = nB; ++ui;
        if constexpr (ALIGN_EPI) { if (wr == 1) PG8_BAR; }
    }
    PG8_WAIT_V(0);
    if constexpr (!ALIGN_EPI) { if (wr == 0) PG8_BAR; }
    PG8_BAR;
    if constexpr (Epi::AFTER_DRAIN) { E.fused(acc, cur, wr, wc, fr, fq, lds, wid, lane); S.done(cur); }
#undef PG8_SA
#undef PG8_SB
#undef PG8_STAGE
#undef PG8_LDA
#undef PG8_LDB
#undef PG8_MMA
#undef PG8_WAIT_V
#undef PG8_WAIT_L
#undef PG8_BAR
#undef PG8_SCHED
}
}

#define GAS __attribute__((address_space(1)))
#define LAS __attribute__((address_space(3)))
typedef unsigned short bf16;
typedef unsigned v4u __attribute__((ext_vector_type(4)));
typedef unsigned v2u __attribute__((ext_vector_type(2)));
typedef float f32x4 __attribute__((ext_vector_type(4)));
typedef float f32x2 __attribute__((ext_vector_type(2)));
typedef short bf16x8 __attribute__((ext_vector_type(8)));
typedef short s16x4 __attribute__((ext_vector_type(4)));

constexpr int NWAVES = 8, NTHREADS = 512;
constexpr int BATCH = 8, SEQ = 2048, DM = 2048, M_TOK = BATCH * SEQ;
constexpr int NPRE = 6400, NGATE = 6144, NIN = NPRE + NGATE;
constexpr int C_AQ = 0, C_AK = 768, C_AV = 1024, C_AG = 1280, C_RS = 2048, C_RR = 2048, C_RK = 2816, C_RV = 3584, C_LORA = 4352, C_RG = 4608, C_XQ = 5376, C_XG = 5888;
constexpr int NMEM = 256, MEMROWS = BATCH * NMEM;
constexpr int RW = 768, NLORA = 3072;
constexpr float NORM_EPS = 1e-6f, GN_EPS = 64e-5f;
constexpr int LDS_BYTES = 147456;

constexpr size_t MiB = 1u << 20;
constexpr size_t WS_PRE = 0, WS_MERGED = 0, WS_GATES = 200 * MiB, WS_YCAT = 392 * MiB;
constexpr size_t WS_WCAT = 456 * MiB, WS_WOUT = 464 * MiB, WS_WXKV = 472 * MiB, WS_MKV = 476 * MiB, WS_MEMN = 480 * MiB, WS_YB = 480 * MiB;
constexpr size_t WS_ROPE = 504 * MiB, WS_LORAB = 505 * MiB, WS_END = 512 * MiB;
constexpr size_t WS_BON = 507 * MiB;
constexpr size_t WS_CTR = 504 * MiB + 768 * 1024;
constexpr size_t DO_H = 0, DO_WIN = 64 * MiB, DO_EA = 0, DO_LIN = 96 * MiB, DO_YF = 104 * MiB;

struct Params { const float* in[26]; float* out; unsigned char* ws; int ph_lo, ph_hi; };

__device__ __forceinline__ float bf_lo(unsigned w) { return __builtin_bit_cast(float, w << 16); }
__device__ __forceinline__ float bf_hi(unsigned w) { return __builtin_bit_cast(float, w & 0xffff0000u); }
__device__ __forceinline__ float bf1(bf16 h) { return __builtin_bit_cast(float, (unsigned)h << 16); }
__device__ __forceinline__ unsigned f2bf(float f) { unsigned u = __builtin_bit_cast(unsigned, f); return (u + 0x7fffu + ((u >> 16) & 1u)) >> 16; }
typedef __bf16 bf16x2_t __attribute__((ext_vector_type(2)));
__device__ __forceinline__ unsigned pk2(float lo, float hi) { const f32x2 v = {lo, hi}; const bf16x2_t b = __builtin_convertvector(v, bf16x2_t); return __builtin_bit_cast(unsigned, b); }
__device__ __forceinline__ float sigmoidf_(float z) { return __builtin_amdgcn_rcpf(1.f + __expf(-z)); }
__device__ __forceinline__ float siluf_(float z) { return z * sigmoidf_(z); }
__device__ __forceinline__ void unpack8(v4u w, float (&x)[8]) { x[0] = bf_lo(w.x); x[1] = bf_hi(w.x); x[2] = bf_lo(w.y); x[3] = bf_hi(w.y); x[4] = bf_lo(w.z); x[5] = bf_hi(w.z); x[6] = bf_lo(w.w); x[7] = bf_hi(w.w); }
__device__ __forceinline__ void unpack4(v2u w, float (&x)[4]) { x[0] = bf_lo(w.x); x[1] = bf_hi(w.x); x[2] = bf_lo(w.y); x[3] = bf_hi(w.y); }
__device__ __forceinline__ float fma_s(float a, float b, float c) { float r; asm("v_fma_f32 %0, %1, %2, %3" : "=v"(r) : "v"(a), "v"(b), "v"(c)); return r; }
__device__ __forceinline__ float mul_s(float a, float b) { float r; asm("v_mul_f32_e32 %0, %1, %2" : "=v"(r) : "v"(a), "v"(b)); return r; }
__device__ __forceinline__ float add_s(float a, float b) { float r; asm("v_add_f32_e32 %0, %1, %2" : "=v"(r) : "v"(a), "v"(b)); return r; }
template <int CTRL> __device__ __forceinline__ float dpp_add(float v) { return v + __builtin_bit_cast(float, __builtin_amdgcn_update_dpp(0, __builtin_bit_cast(int, v), CTRL, 0xF, 0xF, true)); }
__device__ __forceinline__ float red8(float v) { v = dpp_add<0xB1>(v); v = dpp_add<0x4E>(v); v = dpp_add<0x141>(v); return v; }

using pg8::Unit;
struct EpiProj {
    static constexpr bool PERM = true, AFTER_DRAIN = false, KHOOK = false; static constexpr int HK0 = -1, HK1 = -1;
    bf16* pre; bf16* gates; const float* gate_b;
    __device__ __forceinline__ void operator()(const f32x4 (&acc)[2][2][4][2], const Unit& u, int wr, int wc, int fr, int fq) const {
        int row0 = u.pm * 256 + wr * 64 + fr;
        asm volatile("" : "+v"(row0));
        const bool isg = u.pn >= 25;
        const int pn = isg ? u.pn - 25 : u.pn;
        bf16* base = isg ? gates : pre; const int ldc = isg ? NGATE : NPRE;
        const int act = isg ? 2 : (((pn >= 5 && pn <= 7) || (pn >= 18 && pn <= 20) || pn >= 23) ? 1 : 0);
        const int col0 = pn * 256 + wc * 32 + 8 * fq;
        f32x4 bv[2][2];
#pragma unroll
        for (int bj = 0; bj < 2; ++bj) { bv[bj][0] = isg ? *(const f32x4*)(gate_b + col0 + bj * 128) : (f32x4){0.f, 0.f, 0.f, 0.f}; bv[bj][1] = isg ? *(const f32x4*)(gate_b + col0 + bj * 128 + 4) : (f32x4){0.f, 0.f, 0.f, 0.f}; }
#pragma unroll
        for (int ai = 0; ai < 2; ++ai)
#pragma unroll
            for (int m = 0; m < 4; ++m) { bf16* rowp = base + (size_t)(row0 + ai * 128 + m * 16) * ldc + col0;
                __builtin_amdgcn_sched_barrier(0);
#pragma unroll
                for (int bj = 0; bj < 2; ++bj) { f32x4 v0 = acc[ai][bj][m][0] + bv[bj][0], v1 = acc[ai][bj][m][1] + bv[bj][1];
                    if (act == 1) {
#pragma unroll
                        for (int i = 0; i < 4; ++i) { v0[i] = siluf_(v0[i]); v1[i] = siluf_(v1[i]); }
                    } else if (act == 2) {
#pragma unroll
                        for (int i = 0; i < 4; ++i) { v0[i] = sigmoidf_(v0[i]); v1[i] = sigmoidf_(v1[i]); }
                    }
                    v4u w; w.x = pk2(v0[0], v0[1]); w.y = pk2(v0[2], v0[3]); w.z = pk2(v1[0], v1[1]); w.w = pk2(v1[2], v1[3]);
                    *(v4u*)(rowp + bj * 128) = w; } }
    }
};
struct EpiPlain {
    static constexpr bool PERM = true, AFTER_DRAIN = false, KHOOK = false; static constexpr int HK0 = -1, HK1 = -1;
    bf16* O; int ldc;
    __device__ __forceinline__ void operator()(const f32x4 (&acc)[2][2][4][2], const Unit& u, int wr, int wc, int fr, int fq) const {
        int row0 = u.pm * 256 + wr * 64 + fr, col0 = u.pn * 256 + wc * 32 + 8 * fq;
        asm volatile("" : "+v"(row0), "+v"(col0));
#pragma unroll
        for (int ai = 0; ai < 2; ++ai)
#pragma unroll
            for (int m = 0; m < 4; ++m) { bf16* rowp = O + (size_t)(row0 + ai * 128 + m * 16) * ldc + col0;
#pragma unroll
                for (int bj = 0; bj < 2; ++bj) { const f32x4 v0 = acc[ai][bj][m][0], v1 = acc[ai][bj][m][1];
                    v4u w; w.x = pk2(v0[0], v0[1]); w.y = pk2(v0[2], v0[3]); w.z = pk2(v1[0], v1[1]); w.w = pk2(v1[2], v1[3]);
                    *(v4u*)(rowp + bj * 128) = w; } }
    }
};
struct EpiLora {
    static constexpr bool PERM = true, AFTER_DRAIN = false, KHOOK = false; static constexpr int HK0 = -1, HK1 = -1;
    bf16* O; const float* w0; const float* a0;
    __device__ __forceinline__ void operator()(const f32x4 (&acc)[2][2][4][2], const Unit& u, int wr, int wc, int fr, int fq) const {
        int row0 = u.pm * 256 + wr * 64 + fr, col0 = u.pn * 256 + wc * 32 + 8 * fq;
        asm volatile("" : "+v"(row0), "+v"(col0));
        const bool isw = u.pn < 6; const float* bias = isw ? (w0 + col0) : (a0 + col0 - 1536); const float sc = isw ? 0.6065306597126334f : 1.f;
        f32x4 bv[2][2];
#pragma unroll
        for (int bj = 0; bj < 2; ++bj) { bv[bj][0] = *(const f32x4*)(bias + bj * 128); bv[bj][1] = *(const f32x4*)(bias + bj * 128 + 4); }
#pragma unroll
        for (int ai = 0; ai < 2; ++ai)
#pragma unroll
            for (int m = 0; m < 4; ++m) { bf16* rowp = O + (size_t)(row0 + ai * 128 + m * 16) * NLORA + col0;
                __builtin_amdgcn_sched_barrier(0);
#pragma unroll
                for (int bj = 0; bj < 2; ++bj) { f32x4 v0 = acc[ai][bj][m][0] + bv[bj][0], v1 = acc[ai][bj][m][1] + bv[bj][1];
#pragma unroll
                    for (int i = 0; i < 4; ++i) { v0[i] = sc * sigmoidf_(v0[i]); v1[i] = sc * sigmoidf_(v1[i]); }
                    v4u w; w.x = pk2(v0[0], v0[1]); w.y = pk2(v0[2], v0[3]); w.z = pk2(v1[0], v1[1]); w.w = pk2(v1[2], v1[3]);
                    *(v4u*)(rowp + bj * 128) = w; } }
    }
};
struct EpiMerged {
    static constexpr bool PERM = true, AFTER_DRAIN = false, KHOOK = true; static constexpr int HK0 = 12, HK1 = 24;
    bf16* O; const bf16* gates;
    __device__ __forceinline__ void khook(f32x4 (&acc)[2][2][4][2], const Unit& u, int t, int wr, int wc, int fr, int fq) const {
        int row0 = u.pm * 256 + wr * 64 + fr, col0 = u.pn * 256 + wc * 32 + 8 * fq;
        asm volatile("" : "+v"(row0), "+v"(col0));
        const int bo = (t == HK0) ? 0 : DM;
#pragma unroll
        for (int ai = 0; ai < 2; ++ai) {
            v4u ga[4][2], gb[4][2];
#pragma unroll
            for (int m = 0; m < 4; ++m) { const bf16* gp = gates + (size_t)(row0 + ai * 128 + m * 16) * NGATE + bo + col0;
#pragma unroll
                for (int bj = 0; bj < 2; ++bj) { ga[m][bj] = *(const v4u*)(gp + bj * 128); gb[m][bj] = *(const v4u*)(gp + DM + bj * 128); } }
#pragma unroll
            for (int m = 0; m < 4; ++m)
#pragma unroll
                for (int bj = 0; bj < 2; ++bj) { float x[8], y[8]; unpack8(ga[m][bj], x); unpack8(gb[m][bj], y);
#pragma unroll
                    for (int i = 0; i < 4; ++i) { acc[ai][bj][m][0][i] *= x[i] * __builtin_amdgcn_rcpf(y[i]); acc[ai][bj][m][1][i] *= x[4 + i] * __builtin_amdgcn_rcpf(y[4 + i]); } }
            __builtin_amdgcn_sched_barrier(0);
        }
    }
    __device__ __forceinline__ void operator()(const f32x4 (&acc)[2][2][4][2], const Unit& u, int wr, int wc, int fr, int fq) const {
        int row0 = u.pm * 256 + wr * 64 + fr, col0 = u.pn * 256 + wc * 32 + 8 * fq;
        asm volatile("" : "+v"(row0), "+v"(col0));
#pragma unroll
        for (int ai = 0; ai < 2; ++ai) {
            v4u gg[4][2];
#pragma unroll
            for (int m = 0; m < 4; ++m)
#pragma unroll
                for (int bj = 0; bj < 2; ++bj) gg[m][bj] = *(const v4u*)(gates + (size_t)(row0 + ai * 128 + m * 16) * NGATE + 2 * DM + col0 + bj * 128);
#pragma unroll
            for (int m = 0; m < 4; ++m) { const size_t r = (size_t)(row0 + ai * 128 + m * 16);
#pragma unroll
                for (int bj = 0; bj < 2; ++bj) { const v4u g = gg[m][bj]; float x[8]; unpack8(g, x);
                    const f32x4 v0 = acc[ai][bj][m][0], v1 = acc[ai][bj][m][1];
                    v4u w; w.x = pk2(v0[0] * x[0], v0[1] * x[1]); w.y = pk2(v0[2] * x[2], v0[3] * x[3]); w.z = pk2(v1[0] * x[4], v1[1] * x[5]); w.w = pk2(v1[2] * x[6], v1[3] * x[7]);
                    *(v4u*)(O + r * DM + col0 + bj * 128) = w; } }
            __builtin_amdgcn_sched_barrier(0);
        }
    }
};
struct EpiOut {
    static constexpr bool PERM = true, AFTER_DRAIN = false, KHOOK = false; static constexpr int HK0 = -1, HK1 = -1;
    float* O; const float* X;
    __device__ __forceinline__ void operator()(const f32x4 (&acc)[2][2][4][2], const Unit& u, int wr, int wc, int fr, int fq) const {
        int row0 = u.pm * 256 + wr * 64 + fr, col0 = u.pn * 256 + wc * 32 + 8 * fq;
        asm volatile("" : "+v"(row0), "+v"(col0));
#pragma unroll
        for (int ai = 0; ai < 2; ++ai) {
            f32x4 xa[4][2], xb[4][2];
#pragma unroll
            for (int m = 0; m < 4; ++m) { const size_t o = (size_t)(row0 + ai * 128 + m * 16) * DM + col0;
#pragma unroll
                for (int bj = 0; bj < 2; ++bj) { xa[m][bj] = *(const f32x4*)(X + o + bj * 128); xb[m][bj] = *(const f32x4*)(X + o + bj * 128 + 4); } }
#pragma unroll
            for (int m = 0; m < 4; ++m) { const size_t o = (size_t)(row0 + ai * 128 + m * 16) * DM + col0;
#pragma unroll
                for (int bj = 0; bj < 2; ++bj) { *(f32x4*)(O + o + bj * 128) = xa[m][bj] + acc[ai][bj][m][0]; *(f32x4*)(O + o + bj * 128 + 4) = xb[m][bj] + acc[ai][bj][m][1]; } }
            __builtin_amdgcn_sched_barrier(0);
        }
    }
};

__device__ __forceinline__ float wave_sum(float v) {
#pragma unroll
    for (int o = 1; o < 64; o <<= 1) v += __shfl_xor(v, o);
    return v;
}
__device__ __forceinline__ void transpose_item(const float* W, int N, bf16* WT, int ldt, int koff, LAS float* scr, int item, int lane) {
    const int nblk = N / 32, kb = item / nblk, nb = item % nblk, k0 = 64 * kb, n0 = 32 * nb;
    float tv[32];
#pragma unroll
    for (int i = 0; i < 32; ++i) { const int kk = 2 * i + (lane >> 5); tv[i] = W[(size_t)(k0 + kk) * N + n0 + (lane & 31)]; }
#pragma unroll
    for (int i = 0; i < 32; ++i) { const int kk = 2 * i + (lane >> 5); scr[kk * 33 + (lane & 31)] = tv[i]; }
    asm volatile("s_waitcnt lgkmcnt(0)" ::: "memory");
    const int c = lane & 7;
#pragma unroll
    for (int j = 0; j < 4; ++j) { const int n = (lane >> 3) + 8 * j; const LAS float* s = scr + (8 * c) * 33 + n;
        v4u o; o.x = pk2(s[0 * 33], s[1 * 33]); o.y = pk2(s[2 * 33], s[3 * 33]); o.z = pk2(s[4 * 33], s[5 * 33]); o.w = pk2(s[6 * 33], s[7 * 33]);
        *(v4u*)(WT + (size_t)(n0 + n) * ldt + koff + k0 + 8 * c) = o; }
    asm volatile("s_waitcnt lgkmcnt(0)" ::: "memory");
}
__device__ __forceinline__ void rms_row_to_bf16(const float* xrow, const float* g, bf16* orow, int lane) {
    const f32x4* xr = (const f32x4*)xrow + lane; const f32x4* gr = (const f32x4*)g + lane;
    f32x4 v[8]; float s = 0.f;
#pragma unroll
    for (int j = 0; j < 8; ++j) { v[j] = xr[64 * j]; s += (v[j].x * v[j].x + v[j].y * v[j].y) + (v[j].z * v[j].z + v[j].w * v[j].w); }
    const float rstd = 1.f / sqrtf(wave_sum(s) * (1.f / DM) + NORM_EPS);
    v2u* o8 = (v2u*)orow + lane;
#pragma unroll
    for (int j = 0; j < 8; ++j) { const f32x4 gg = gr[64 * j]; v2u o; o.x = pk2(v[j].x * rstd * gg.x, v[j].y * rstd * gg.y); o.y = pk2(v[j].z * rstd * gg.z, v[j].w * rstd * gg.w); o8[64 * j] = o; }
}
__device__ __forceinline__ void p0_prologue(const Params& P, LAS unsigned char* lds, float* dout_scratch) {
    const int tid = pg8::mk_tid(lds), lane = tid & 63, wave = tid >> 6, G = gridDim.x;
    LAS float* scr = (LAS float*)(lds + wave * 16384);
    const int gw = blockIdx.x * NWAVES + wave, NGW = G * NWAVES;
    unsigned char* ws = P.ws; unsigned char* dob = (unsigned char*)P.out;
    bf16* WIN_T = (bf16*)(dob + DO_WIN); bf16* WCAT_T = (bf16*)(ws + WS_WCAT); bf16* WOUT_T = (bf16*)(ws + WS_WOUT); bf16* WXKV_T = (bf16*)(ws + WS_WXKV);
    constexpr int I_IN = 32 * (NIN / 32), I_A = 12 * 64, I_R = 12 * 64, I_X = 8 * 64, I_O = 32 * 64, I_KV = 32 * 32;
    constexpr int NITEMS = I_IN + I_A + I_R + I_X + I_O + I_KV;
    for (int it = gw; it < NITEMS; it += NGW) {
        int r = it;
        if (r < I_IN) { transpose_item(P.in[4], NIN, WIN_T, DM, 0, scr, r, lane); continue; } r -= I_IN;
        if (r < I_A) { transpose_item(P.in[9], DM, WCAT_T, DM, 0, scr, r, lane); continue; } r -= I_A;
        if (r < I_R) { transpose_item(P.in[20], DM, WCAT_T, DM, 768, scr, r, lane); continue; } r -= I_R;
        if (r < I_X) { transpose_item(P.in[24], DM, WCAT_T, DM, 1536, scr, r, lane); continue; } r -= I_X;
        if (r < I_O) { transpose_item(P.in[25], DM, WOUT_T, DM, 0, scr, r, lane); continue; } r -= I_O;
        transpose_item(P.in[21], 1024, WXKV_T, DM, 0, scr, r, lane);
    }
    bf16* H = (bf16*)(dob + DO_H); bf16* MEMN = (bf16*)(ws + WS_MEMN);
    for (int m = gw; m < M_TOK + MEMROWS; m += NGW) {
        if (m < M_TOK) rms_row_to_bf16(P.in[0] + (size_t)m * DM, P.in[2], H + (size_t)m * DM, lane);
        else rms_row_to_bf16(P.in[1] + (size_t)(m - M_TOK) * DM, P.in[3], MEMN + (size_t)(m - M_TOK) * DM, lane);
    }
    if (blockIdx.x == 0 && tid == 0) __hip_atomic_store((unsigned*)(ws + WS_CTR), 0u, __ATOMIC_RELAXED, __HIP_MEMORY_SCOPE_AGENT);
    bf16* LB = (bf16*)(ws + WS_LORAB);
    const int gt = blockIdx.x * NTHREADS + tid, NGT = G * NTHREADS;
    for (int idx = gt; idx < NLORA * 256; idx += NGT) {
        const int n = idx >> 8, k = idx & 255, d = n / RW, ch = n % RW, kb = k >> 6, kk = k & 63;
        float v = 0.f;
        if (kb == d) v = (d < 2) ? P.in[15][(size_t)(d * 64 + kk) * RW + ch] : P.in[17][(size_t)((d - 2) * 64 + kk) * RW + ch];
        LB[idx] = (bf16)f2bf(v);
    }
    float* RC = (float*)(ws + WS_ROPE); float* RS = RC + SEQ * 32;
    for (int idx = gt; idx < SEQ * 32; idx += NGT) {
        const int pos = idx >> 5, i = idx & 31;
        const float inv = __builtin_exp2f(-(float)i * (13.287712379549449f / 32.f));
        const float ang = (float)pos * inv;
        double rv = (double)ang * 0.15915494309189535; rv -= __builtin_floor(rv);
        const float r = (float)rv;
        RC[idx] = __builtin_amdgcn_cosf(r); RS[idx] = __builtin_amdgcn_sinf(r);
    }
}

__device__ __forceinline__ void p2_lora_in(const Params& P, LAS unsigned char* lds) {
    const bf16* PRE = (const bf16*)(P.ws + WS_PRE); bf16* LIN = (bf16*)((unsigned char*)P.out + DO_LIN); const float* mu = P.in[10];
    const int gt = blockIdx.x * NTHREADS + pg8::mk_tid(lds), NGT = gridDim.x * NTHREADS;
    for (int idx = gt; idx < M_TOK * 32; idx += NGT) {
        const int m = idx >> 5, j = (idx & 31) * 8, t = m & (SEQ - 1);
        const bf16* p = PRE + (size_t)m * NPRE + C_LORA + j;
        const v4u z4 = (v4u){0u, 0u, 0u, 0u};
        const v4u c = *(const v4u*)p, pv = (t > 0) ? *(const v4u*)(p - NPRE) : z4, nx = (t < SEQ - 1) ? *(const v4u*)(p + NPRE) : z4;
        const f32x4 m0 = *(const f32x4*)(mu + 2304 + j), m1 = *(const f32x4*)(mu + 2304 + j + 4);
        float xc[8], xp[8], xn[8], s[8]; unpack8(c, xc); unpack8(pv, xp); unpack8(nx, xn);
#pragma unroll
        for (int i = 0; i < 8; ++i) { const float mm = (i < 4) ? m0[i & 3] : m1[i & 3]; s[i] = xc[i] + mm * (0.5f * (xp[i] + xn[i]) - xc[i]);
            if (j < 128) s[i] = 1.f - 2.f * __builtin_amdgcn_rcpf(__expf(2.f * s[i]) + 1.f); }
        v4u o; o.x = pk2(s[0], s[1]); o.y = pk2(s[2], s[3]); o.z = pk2(s[4], s[5]); o.w = pk2(s[6], s[7]);
        *(v4u*)(LIN + (size_t)m * 256 + j) = o;
    }
}

constexpr int SC_CH = 32, SC_REC = 1536, SC_BUF = SC_CH * SC_REC, SC_SCAL = 2 * SC_BUF;
template <int MODE> __device__ __forceinline__ void scan_block(const Params& P, int sid, LAS unsigned char* lds) {
    const int tid = pg8::mk_tid(lds), lane = tid & 63, wave = __builtin_amdgcn_readfirstlane(tid >> 6);
    const int b = sid / 24, rem = sid % 24, h = rem >> 1, dir = rem & 1;
    const bf16* PRE = (const bf16*)(P.ws + WS_PRE); const bf16* EA = (const bf16*)((unsigned char*)P.out + DO_EA);
    bf16* YO = dir ? (bf16*)(P.ws + WS_YB) : (bf16*)((unsigned char*)P.out + DO_YF);
    constexpr int NCH = SEQ / SC_CH;
#define SC_BAR() do { asm volatile("s_waitcnt lgkmcnt(0)" ::: "memory"); __builtin_amdgcn_s_barrier(); asm volatile("" ::: "memory"); } while (0)
    if (wave >= 4) {
        const int pt = tid - 256, sl = pt >> 3, e = pt & 7, ch0 = h * 64 + 8 * e;
        float mur[8], muk[8], muv[8], kkc[8], kac[8];
#pragma unroll
        for (int i = 0; i < 8; ++i) { mur[i] = P.in[10][ch0 + i]; muk[i] = P.in[10][768 + ch0 + i]; muv[i] = P.in[10][1536 + ch0 + i]; kkc[i] = P.in[11][ch0 + i]; kac[i] = P.in[12][ch0 + i]; }
        v4u rc, kc, vc, rp, kp, vp, rn, kn, vn, e8, a8;
        const v4u z4 = (v4u){0u, 0u, 0u, 0u};
#define SC_PLOAD(c_) do { const int step_ = (c_) * SC_CH + sl, t_ = dir ? (SEQ - 1 - step_) : step_; const size_t m_ = (size_t)b * SEQ + t_; \
            const bf16* rowp_ = PRE + m_ * NPRE + C_RS + ch0; \
            rc = *(const v4u*)(rowp_); kc = *(const v4u*)(rowp_ + 768); vc = *(const v4u*)(rowp_ + 1536); \
            rp = (t_ > 0) ? *(const v4u*)(rowp_ - NPRE) : z4; kp = (t_ > 0) ? *(const v4u*)(rowp_ - NPRE + 768) : z4; vp = (t_ > 0) ? *(const v4u*)(rowp_ - NPRE + 1536) : z4; \
            rn = (t_ < SEQ - 1) ? *(const v4u*)(rowp_ + NPRE) : z4; kn = (t_ < SEQ - 1) ? *(const v4u*)(rowp_ + NPRE + 768) : z4; vn = (t_ < SEQ - 1) ? *(const v4u*)(rowp_ + NPRE + 1536) : z4; \
            const bf16* eap_ = EA + m_ * NLORA + dir * RW + ch0; e8 = *(const v4u*)(eap_); a8 = *(const v4u*)(eap_ + 1536); } while (0)
#define SC_PWRITE(c_) do { LAS unsigned char* buf_ = lds + ((c_) & 1) * SC_BUF; LAS float* scal_ = (LAS float*)(lds + SC_SCAL) + ((c_) & 1) * (SC_CH * 2); \
            float r[8], k[8], v[8], x0[8], x1[8], x2[8]; \
            unpack8(rc, x0); unpack8(rp, x1); unpack8(rn, x2); \
            _Pragma("unroll") for (int i = 0; i < 8; ++i) r[i] = x0[i] + mur[i] * (0.5f * (x1[i] + x2[i]) - x0[i]); \
            unpack8(kc, x0); unpack8(kp, x1); unpack8(kn, x2); \
            _Pragma("unroll") for (int i = 0; i < 8; ++i) k[i] = x0[i] + muk[i] * (0.5f * (x1[i] + x2[i]) - x0[i]); \
            unpack8(vc, x0); unpack8(vp, x1); unpack8(vn, x2); \
            _Pragma("unroll") for (int i = 0; i < 8; ++i) v[i] = x0[i] + muv[i] * (0.5f * (x1[i] + x2[i]) - x0[i]); \
            float ee[8], aa[8]; unpack8(e8, ee); unpack8(a8, aa); \
            float kk[8], ss = 0.f; \
            _Pragma("unroll") for (int i = 0; i < 8; ++i) { kk[i] = k[i] * kkc[i]; ss += kk[i] * kk[i]; } \
            ss = red8(ss); \
            const float inv = 1.f / fmaxf(sqrtf(ss), 1e-12f); \
            float nkk[8], dd[8], dr[8], bb[8], kd[8], sbr = 0.f, skr = 0.f; \
            _Pragma("unroll") for (int i = 0; i < 8; ++i) { \
                const float kki = kk[i] * inv; nkk[i] = -kki; dd[i] = __expf(-ee[i]); dr[i] = dd[i] * r[i]; \
                bb[i] = kki * aa[i]; kd[i] = k[i] * (1.f + (aa[i] - 1.f) * kac[i]); sbr += bb[i] * r[i]; skr += kd[i] * r[i]; } \
            sbr = red8(sbr); skr = red8(skr); \
            LAS float* rec = (LAS float*)(buf_ + sl * SC_REC) + 8 * e; \
            *(LAS f32x4*)(rec) = (f32x4){nkk[0], nkk[1], nkk[2], nkk[3]}; *(LAS f32x4*)(rec + 4) = (f32x4){nkk[4], nkk[5], nkk[6], nkk[7]}; \
            *(LAS f32x4*)(rec + 64) = (f32x4){dr[0], dr[1], dr[2], dr[3]}; *(LAS f32x4*)(rec + 68) = (f32x4){dr[4], dr[5], dr[6], dr[7]}; \
            *(LAS f32x4*)(rec + 128) = (f32x4){dd[0], dd[1], dd[2], dd[3]}; *(LAS f32x4*)(rec + 132) = (f32x4){dd[4], dd[5], dd[6], dd[7]}; \
            *(LAS f32x4*)(rec + 192) = (f32x4){bb[0], bb[1], bb[2], bb[3]}; *(LAS f32x4*)(rec + 196) = (f32x4){bb[4], bb[5], bb[6], bb[7]}; \
            *(LAS f32x4*)(rec + 256) = (f32x4){kd[0], kd[1], kd[2], kd[3]}; *(LAS f32x4*)(rec + 260) = (f32x4){kd[4], kd[5], kd[6], kd[7]}; \
            *(LAS f32x4*)(rec + 320) = (f32x4){v[0], v[1], v[2], v[3]}; *(LAS f32x4*)(rec + 324) = (f32x4){v[4], v[5], v[6], v[7]}; \
            if (e == 0) *(LAS f32x2*)(scal_ + 2 * sl) = (f32x2){sbr, skr}; } while (0)
        if (!(MODE & 2)) { SC_PLOAD(0); SC_PWRITE(0); SC_PLOAD(1); }
        SC_BAR();
        for (int c = 0; c < NCH; ++c) {
            if (!(MODE & 2)) { if (c + 1 < NCH) SC_PWRITE(c + 1);
            if (c + 2 < NCH) SC_PLOAD(c + 2); }
            SC_BAR();
        }
#undef SC_PLOAD
#undef SC_PWRITE
    } else {
        const int rp = (wave * 64 + lane) >> 3, cgp = lane & 7;
        f32x2 s0[4], s1[4];
#pragma unroll
        for (int i = 0; i < 4; ++i) { s0[i] = (f32x2){0.f, 0.f}; s1[i] = (f32x2){0.f, 0.f}; }
        bf16* yrow = YO + (size_t)b * SEQ * RW + h * 64 + 2 * rp;
        SC_BAR();
#define SC_LOAD(N0, N1, Q0, Q1, D0, D1, B0, B1, K0, K1, VV, SS, sl_) do { const LAS float* rec_ = (const LAS float*)(buf + (sl_) * SC_REC) + 8 * cgp; \
            N0 = *(const LAS f32x4*)(rec_); N1 = *(const LAS f32x4*)(rec_ + 4); Q0 = *(const LAS f32x4*)(rec_ + 64); Q1 = *(const LAS f32x4*)(rec_ + 68); \
            D0 = *(const LAS f32x4*)(rec_ + 128); D1 = *(const LAS f32x4*)(rec_ + 132); B0 = *(const LAS f32x4*)(rec_ + 192); B1 = *(const LAS f32x4*)(rec_ + 196); \
            K0 = *(const LAS f32x4*)(rec_ + 256); K1 = *(const LAS f32x4*)(rec_ + 260); \
            VV = *(const LAS f32x2*)((const LAS float*)(buf + (sl_) * SC_REC) + 320 + 2 * rp); SS = *(const LAS f32x2*)(scal + 2 * (sl_)); } while (0)
        for (int c = 0; c < NCH; ++c) {
            const LAS unsigned char* buf = lds + (c & 1) * SC_BUF; const LAS float* scal = (const LAS float*)(lds + SC_SCAL) + (c & 1) * (SC_CH * 2);
            f32x4 n0, n1, q0, q1, d0, d1, b0, b1, k0, k1; f32x2 vv, sc;
            SC_LOAD(n0, n1, q0, q1, d0, d1, b0, b1, k0, k1, vv, sc, 0);
#pragma unroll 2
            for (int sl = 0; sl < SC_CH; ++sl) {
                f32x4 xn0, xn1, xq0, xq1, xd0, xd1, xb0, xb1, xk0, xk1; f32x2 xvv, xsc;
                const int sn = (sl + 1 < SC_CH) ? sl + 1 : sl;
                const f32x2 nk[4] = {(f32x2){n0.x, n0.y}, (f32x2){n0.z, n0.w}, (f32x2){n1.x, n1.y}, (f32x2){n1.z, n1.w}};
                const f32x2 qq[4] = {(f32x2){q0.x, q0.y}, (f32x2){q0.z, q0.w}, (f32x2){q1.x, q1.y}, (f32x2){q1.z, q1.w}};
                const f32x2 dv[4] = {(f32x2){d0.x, d0.y}, (f32x2){d0.z, d0.w}, (f32x2){d1.x, d1.y}, (f32x2){d1.z, d1.w}};
                const f32x2 bv[4] = {(f32x2){b0.x, b0.y}, (f32x2){b0.z, b0.w}, (f32x2){b1.x, b1.y}, (f32x2){b1.z, b1.w}};
                const f32x2 kv[4] = {(f32x2){k0.x, k0.y}, (f32x2){k0.z, k0.w}, (f32x2){k1.x, k1.y}, (f32x2){k1.z, k1.w}};
                f32x2 a0 = s0[0] * nk[0], a1 = s1[0] * nk[0], y0 = s0[0] * qq[0], y1 = s1[0] * qq[0];
#pragma unroll
                for (int i = 1; i < 4; ++i) { a0 = s0[i] * nk[i] + a0; a1 = s1[i] * nk[i] + a1; y0 = s0[i] * qq[i] + y0; y1 = s1[i] * qq[i] + y1; }
                float sa0 = a0.x + a0.y, sa1 = a1.x + a1.y, yp0 = y0.x + y0.y, yp1 = y1.x + y1.y;
                SC_LOAD(xn0, xn1, xq0, xq1, xd0, xd1, xb0, xb1, xk0, xk1, xvv, xsc, sn);
                sa0 = red8(sa0); sa1 = red8(sa1); yp0 = red8(yp0); yp1 = red8(yp1);
                const float yo0 = yp0 + sa0 * sc.x + vv.x * sc.y, yo1 = yp1 + sa1 * sc.x + vv.y * sc.y;
                const f32x2 sa0v = (f32x2){sa0, sa0}, sa1v = (f32x2){sa1, sa1}, v0v = (f32x2){vv.x, vv.x}, v1v = (f32x2){vv.y, vv.y};
#pragma unroll
                for (int i = 0; i < 4; ++i) {
                    f32x2 t0 = v0v * kv[i]; t0 = sa0v * bv[i] + t0; s0[i] = s0[i] * dv[i] + t0;
                    f32x2 t1 = v1v * kv[i]; t1 = sa1v * bv[i] + t1; s1[i] = s1[i] * dv[i] + t1;
                }
                const int step = c * SC_CH + sl, t = dir ? (SEQ - 1 - step) : step;
                const unsigned yw = pk2(yo0, yo1);
                if (!(MODE & 1)) { if (cgp == 0) *(unsigned*)(yrow + (size_t)t * RW) = yw; } else { asm volatile("" :: "v"(yw)); }
                n0 = xn0; n1 = xn1; q0 = xq0; q1 = xq1; d0 = xd0; d1 = xd1; b0 = xb0; b1 = xb1; k0 = xk0; k1 = xk1; vv = xvv; sc = xsc;
            }
            SC_BAR();
        }
#undef SC_LOAD
    }
#undef SC_BAR
    __syncthreads();
}

__device__ __forceinline__ bf16x8 pack8(const float (&x)[8]) {
    v4u w; w.x = pk2(x[0], x[1]); w.y = pk2(x[2], x[3]); w.z = pk2(x[4], x[5]); w.w = pk2(x[6], x[7]); return __builtin_bit_cast(bf16x8, w);
}
#define MFMA16(a, b, c) __builtin_amdgcn_mfma_f32_16x16x32_bf16((a), (b), (c), 0, 0, 0)
constexpr int CK = 16, NCK = SEQ / CK;
constexpr int L_QK = 0, L_PR = 4608, L_QKT = 9216, L_VT = 14336, L_VF = 19456, L_GC = 23552, L_OPSZ = 23808;
constexpr int WP = 68, L_WSZ = 16 * WP * 4;
constexpr int L_E = 2 * L_OPSZ, L_G = L_E + 4096, L_GSZ = 5120, L_W0 = L_G + 2 * L_GSZ, L_VG = L_W0 + L_WSZ, L_SB = L_VG + 2 * L_WSZ, L_CEND = L_SB + 9216;
constexpr int L_GTP = L_CEND + 1536;
static_assert(L_GTP + 2048 <= 131072, "chunked scan LDS map");
#ifdef CBAR_FULL
#define CBAR() __syncthreads()
#else
#define CBAR() do { __builtin_amdgcn_s_waitcnt(0xC07F); __builtin_amdgcn_s_barrier(); } while (0)
#endif
__device__ __forceinline__ void scan_chunked(const Params& P, int sid, LAS unsigned char* lds) {
    const int tid = pg8::mk_tid(lds), lane = tid & 63, wave = __builtin_amdgcn_readfirstlane(tid >> 6), l15 = lane & 15, q4 = lane >> 4;
    const int b = sid / 24, rem = sid % 24, h = rem >> 1, dir = rem & 1;
    const bf16* PRE = (const bf16*)(P.ws + WS_PRE); const bf16* EA = (const bf16*)((unsigned char*)P.out + DO_EA);
    bf16* YO = dir ? (bf16*)(P.ws + WS_YB) : (bf16*)((unsigned char*)P.out + DO_YF);
#ifdef YZERO
    for (int it = tid; it < SEQ * 8; it += NTHREADS) *(v4u*)(YO + ((size_t)b * SEQ + (it >> 3)) * RW + h * 64 + (it & 7) * 8) = (v4u){0u, 0u, 0u, 0u};
#endif
    for (int i = tid; i < 9216 / 4; i += NTHREADS) ((LAS unsigned*)(lds + L_SB))[i] = 0u;
    for (int i = tid; i < L_SB / 4; i += NTHREADS) ((LAS unsigned*)(lds))[i] = 0u;
    if (tid < 384) { const int vsel = tid >> 6, chn = h * 64 + (tid & 63);
        ((LAS float*)(lds + L_CEND))[tid] = (vsel < 3) ? P.in[10][vsel * 768 + chn] : ((vsel == 3) ? P.in[11][chn] : ((vsel == 4) ? P.in[12][chn] : P.in[13][chn])); }
    CBAR();
    if (wave >= 4) {
        const int pt = tid - 256, t = pt >> 4, e = pt & 15, ch0 = h * 64 + 4 * e, gsw = 8 * ((e >> 1) & 3);
        float* BON = (float*)(P.ws + WS_BON);
        const LAS float* cst = (const LAS float*)(lds + L_CEND) + 4 * e;
        v2u rcA, kcA, vcA, rpA, kpA, vpA, rnA, knA, vnA, e8A, a8A, rcB, kcB, vcB, rpB, kpB, vpB, rnB, knB, vnB, e8B, a8B;
        const v2u z2 = (v2u){0u, 0u};
#define CK_PLOAD(X, c_) do { const int step_ = (c_) * CK + t, t_ = dir ? (SEQ - 1 - step_) : step_; const size_t m_ = (size_t)b * SEQ + t_; \
            const bf16* rowp_ = PRE + m_ * NPRE + C_RS + ch0; \
            const bf16* rowq_ = (t_ > 0) ? rowp_ - NPRE : rowp_; const bf16* rown_ = (t_ < SEQ - 1) ? rowp_ + NPRE : rowp_;     \
            rc##X = *(const v2u*)(rowp_); kc##X = *(const v2u*)(rowp_ + 768); vc##X = *(const v2u*)(rowp_ + 1536); \
            rp##X = *(const v2u*)(rowq_); kp##X = *(const v2u*)(rowq_ + 768); vp##X = *(const v2u*)(rowq_ + 1536); \
            rn##X = *(const v2u*)(rown_); kn##X = *(const v2u*)(rown_ + 768); vn##X = *(const v2u*)(rown_ + 1536); \
            const bf16* eap_ = EA + m_ * NLORA + dir * RW + ch0; e8##X = *(const v2u*)(eap_); a8##X = *(const v2u*)(eap_ + 1536); } while (0)
        CK_PLOAD(A, 0); CK_PLOAD(B, 1);
        float r[4], k[4], v[4], kk[4], aa[4], ee[4];
#define CK_PBODY(X, c_) do { const int c = (c_); const int pb = (c & 1) * L_OPSZ; \
            {   \
                float x0[4], x1[4], x2[4]; f32x4 cc; \
                const int stepc_ = ((c < NCK) ? c : NCK - 1) * CK + t, tc_ = dir ? (SEQ - 1 - stepc_) : stepc_; const float fp_ = (tc_ > 0) ? 1.f : 0.f, fn_ = (tc_ < SEQ - 1) ? 1.f : 0.f; \
                unpack4(rc##X, x0); unpack4(rp##X, x1); unpack4(rn##X, x2); cc = *(const LAS f32x4*)(cst); \
                _Pragma("unroll") for (int i = 0; i < 4; ++i) r[i] = x0[i] + cc[i] * (0.5f * (fp_ * x1[i] + fn_ * x2[i]) - x0[i]); \
                unpack4(kc##X, x0); unpack4(kp##X, x1); unpack4(kn##X, x2); cc = *(const LAS f32x4*)(cst + 64); \
                _Pragma("unroll") for (int i = 0; i < 4; ++i) k[i] = x0[i] + cc[i] * (0.5f * (fp_ * x1[i] + fn_ * x2[i]) - x0[i]); \
                unpack4(vc##X, x0); unpack4(vp##X, x1); unpack4(vn##X, x2); cc = *(const LAS f32x4*)(cst + 128); \
                _Pragma("unroll") for (int i = 0; i < 4; ++i) v[i] = x0[i] + cc[i] * (0.5f * (fp_ * x1[i] + fn_ * x2[i]) - x0[i]); \
                unpack4(e8##X, ee); unpack4(a8##X, aa); cc = *(const LAS f32x4*)(cst + 192); \
                float ss = 0.f; \
                _Pragma("unroll") for (int i = 0; i < 4; ++i) { kk[i] = k[i] * cc[i]; ss += kk[i] * kk[i]; } \
                ss = red8(ss); ss = dpp_add<0x140>(ss); \
                const float inv = __builtin_amdgcn_rcpf(fmaxf(__builtin_amdgcn_sqrtf(ss), 1e-12f)); \
                _Pragma("unroll") for (int i = 0; i < 4; ++i) kk[i] *= inv; \
                *(LAS f32x4*)((LAS float*)(lds + L_E) + t * 64 + 4 * e) = (f32x4){ee[0], ee[1], ee[2], ee[3]}; \
                CK_PLOAD(X, (c + 2 < NCK) ? c + 2 : NCK - 1); \
            } \
            CBAR(); \
            { \
                f32x4 gs = (f32x4){0.f, 0.f, 0.f, 0.f}; \
                _Pragma("unroll") for (int u = 0; u < CK; ++u) { \
                    const f32x4 ea = *(const LAS f32x4*)((const LAS float*)(lds + L_E) + u * 64 + 4 * e); \
                    const float m = (u <= t) ? 1.f : 0.f; gs += m * ea; } \
                const f32x4 kac = *(const LAS f32x4*)(cst + 256), rkc = *(const LAS f32x4*)(cst + 320); float bpart = 0.f; \
                float qv[4], kt[4], pv[4], rt[4], gin[4]; \
                _Pragma("unroll") for (int i = 0; i < 4; ++i) { \
                    gin[i] = __expf(-gs[i]); const float gex = __expf(ee[i] - gs[i]), ginv = __expf(gs[i]); \
                    const float kd = k[i] * (1.f + (aa[i] - 1.f) * kac[i]); \
                    qv[i] = kk[i] * aa[i] * ginv; kt[i] = kd * ginv; pv[i] = kk[i] * gex; rt[i] = r[i] * gin[i]; bpart += r[i] * kd * rkc[i]; \
                } \
                LAS unsigned char* ob = lds + pb; \
                unsigned wq[4]; v2u o; \
                _Pragma("unroll") for (int i = 0; i < 4; ++i) wq[i] = pk2(qv[i], kt[i]);                        \
                o.x = (wq[0] & 0xffffu) | (wq[1] << 16); o.y = (wq[2] & 0xffffu) | (wq[3] << 16); *(LAS v2u*)(ob + L_QK + (t * 72 + 4 * e) * 2) = o; \
                o.x = (wq[0] >> 16) | (wq[1] & 0xffff0000u); o.y = (wq[2] >> 16) | (wq[3] & 0xffff0000u); *(LAS v2u*)(ob + L_QK + ((16 + t) * 72 + 4 * e) * 2) = o; \
                o.x = pk2(pv[0], pv[1]); o.y = pk2(pv[2], pv[3]); *(LAS v2u*)(ob + L_PR + (t * 72 + 4 * e) * 2) = o; \
                o.x = pk2(rt[0], rt[1]); o.y = pk2(rt[2], rt[3]); *(LAS v2u*)(ob + L_PR + ((16 + t) * 72 + 4 * e) * 2) = o; \
                const unsigned wv01 = pk2(v[0], v[1]), wv23 = pk2(v[2], v[3]); \
                _Pragma("unroll") for (int i = 0; i < 4; ++i) { \
                    *(LAS bf16*)(ob + L_QKT + ((4 * e + i) * 40 + (t ^ gsw)) * 2) = (bf16)(wq[i] & 0xffffu); *(LAS bf16*)(ob + L_QKT + ((4 * e + i) * 40 + ((16 + t) ^ gsw)) * 2) = (bf16)(wq[i] >> 16); \
                    const unsigned wv = (i < 2) ? wv01 : wv23; \
                    *(LAS bf16*)(ob + L_VT + ((4 * e + i) * 40 + ((16 + t) ^ gsw)) * 2) = (bf16)((i & 1) ? (wv >> 16) : (wv & 0xffffu)); \
                } \
                if (t == CK - 1) *(LAS f32x4*)((LAS float*)(ob + L_GC) + 4 * e) = (f32x4){gin[0], gin[1], gin[2], gin[3]}; \
                bpart = red8(bpart); bpart = dpp_add<0x140>(bpart); \
                if (e == 0) { const int stb_ = ((c < NCK) ? c : NCK - 1) * CK + t, tb_ = dir ? (SEQ - 1 - stb_) : stb_; BON[((size_t)dir * M_TOK + (size_t)b * SEQ + tb_) * 12 + h] = bpart; } \
            } \
            CBAR(); \
            CBAR(); } while (0)
        static_assert((NCK + 2) % 2 == 0, "producer loop is unrolled by two");
        for (int c2 = 0; c2 <= NCK + 1; c2 += 2) { CK_PBODY(A, c2); CK_PBODY(B, c2 + 1); }
#undef CK_PBODY
#undef CK_PLOAD
    } else {
        const int w = wave;
        f32x4 acc[4];
#pragma unroll
        for (int nt = 0; nt < 4; ++nt) acc[nt] = (f32x4){0.f, 0.f, 0.f, 0.f};
        bf16* ybase = YO + (size_t)b * SEQ * RW + h * 64 + 16 * w + 4 * q4;
        for (int c = 0; c <= NCK + 1; ++c) {
            const int ck = c - 1; const bool valid = (ck >= 0 && ck < NCK);
            const int pb = (ck & 1) * L_OPSZ, gb = L_G + (ck & 1) * L_GSZ;
            f32x4 r1 = (f32x4){0.f, 0.f, 0.f, 0.f};
            if (valid) {
                f32x4 r0 = (f32x4){0.f, 0.f, 0.f, 0.f};
#pragma unroll
                for (int ks = 0; ks < 2; ++ks) {
                    const bf16x8 S = *(const LAS bf16x8*)(lds + L_SB + ((16 * w + l15) * 72 + ks * 32 + 8 * q4) * 2);
                    const bf16x8 Bp = *(const LAS bf16x8*)(lds + pb + L_PR + ((l15) * 72 + ks * 32 + 8 * q4) * 2);
                    const bf16x8 Br = *(const LAS bf16x8*)(lds + pb + L_PR + ((16 + l15) * 72 + ks * 32 + 8 * q4) * 2);
                    r0 = MFMA16(S, Bp, r0); r1 = MFMA16(S, Br, r1);
                }
                *(LAS f32x4*)(lds + L_W0 + (l15 * WP + 16 * w + 4 * q4) * 4) = r0;
            }
            if (valid && w == 1) {
#pragma unroll
                for (int x = 0; x < 4; ++x) {
                    const int a = x >> 1, bc = x & 1;
                    f32x4 g = (f32x4){0.f, 0.f, 0.f, 0.f};
#pragma unroll
                    for (int ks = 0; ks < 2; ++ks) {
                        const bf16x8 A = *(const LAS bf16x8*)(lds + pb + L_QK + ((a * 16 + l15) * 72 + ks * 32 + 8 * q4) * 2);
                        const bf16x8 Bm = *(const LAS bf16x8*)(lds + pb + L_PR + ((bc * 16 + l15) * 72 + ks * 32 + 8 * q4) * 2);
                        g = MFMA16(A, Bm, g);
                    }
                    *(LAS f32x4*)(lds + gb + x * 1280 + (l15 * 20 + 4 * q4) * 4) = g;
                    if (x == 0) {
#pragma unroll
                        for (int ii = 0; ii < 4; ++ii) *(LAS float*)(lds + L_GTP + (ck & 1) * 1024 + (l15 * 16 + ii * 4 + q4) * 4) = (4 * q4 + ii < l15) ? g[ii] : 0.f;
                    }
                }
                __builtin_amdgcn_s_waitcnt(0xC07F);
                float bw[8];
                {
                    const f32x4 ga = *(const LAS f32x4*)(lds + gb + 2 * 1280 + (l15 * 20 + 8 * (q4 & 1)) * 4), gb2 = *(const LAS f32x4*)(lds + gb + 2 * 1280 + (l15 * 20 + 8 * (q4 & 1) + 4) * 4);
#pragma unroll
                    for (int ii = 0; ii < 8; ++ii) { const int s = 8 * (q4 & 1) + ii; const float gv = (ii < 4) ? ga[ii & 3] : gb2[ii & 3]; bw[ii] = (q4 >= 2 && s < l15) ? gv : 0.f; }
                }
                const bf16x8 Bf = pack8(bw);
#pragma unroll
                for (int mt = 0; mt < 4; ++mt) {
                    const bf16x8 Av = *(const LAS bf16x8*)(lds + pb + L_VT + ((mt * 16 + l15) * 40 + 8 * (q4 ^ (((mt * 16 + l15) >> 3) & 3))) * 2);
                    f32x4 r = (f32x4){0.f, 0.f, 0.f, 0.f};
                    r = MFMA16(Av, Bf, r);
                    *(LAS f32x4*)(lds + L_VG + (ck & 1) * L_WSZ + (l15 * WP + mt * 16 + 4 * q4) * 4) = r;
                }
            }
            CBAR();
            if (valid) {
                const int rr = lane >> 2, qq = lane & 3, i = 16 * w + rr;
                float cown[4], uown[4];
#pragma unroll
                for (int k = 0; k < 4; ++k) { const int t = 4 * k + qq; uown[k] = 0.f;
                    cown[k] = *(const LAS float*)(lds + L_W0 + (t * WP + i) * 4) + *(const LAS float*)(lds + L_VG + (ck & 1) * L_WSZ + (t * WP + i) * 4); }
                const LAS float* gtp = (const LAS float*)(lds + L_GTP + (ck & 1) * 1024) + qq * 4;
#pragma unroll
                for (int t = 0; t < 16; ++t) {
                    const f32x4 g4 = *(const LAS f32x4*)(gtp + t * 16);
                    float part = (g4[0] * uown[0] + g4[1] * uown[1]) + (g4[2] * uown[2] + g4[3] * uown[3]);
                    part = dpp_add<0xB1>(part); part = dpp_add<0x4E>(part);
                    const float cand = cown[t >> 2] - part;
                    uown[t >> 2] = (qq == (t & 3)) ? cand : uown[t >> 2];
                }
                const int gsw = 8 * ((i >> 3) & 3);
#pragma unroll
                for (int k = 0; k < 4; ++k) { const int t = 4 * k + qq;
                    *(LAS bf16*)(lds + pb + L_VT + (i * 40 + (t ^ gsw)) * 2) = (bf16)(pk2(-uown[k], 0.f) & 0xffffu); }
            }
            CBAR();
            if (valid) {
                const bf16x8 Bv = *(const LAS bf16x8*)(lds + pb + L_VT + ((16 * w + l15) * 40 + 8 * (q4 ^ (((16 * w + l15) >> 3) & 3))) * 2);
                {
                    const int xo = (q4 < 2) ? 1 : 3;
                    const f32x4 ga = *(const LAS f32x4*)(lds + gb + xo * 1280 + (l15 * 20 + 8 * (q4 & 1)) * 4), gb2 = *(const LAS f32x4*)(lds + gb + xo * 1280 + (l15 * 20 + 8 * (q4 & 1) + 4) * 4);
                    float bw[8];
#pragma unroll
                    for (int ii = 0; ii < 8; ++ii) { const int s = 8 * (q4 & 1) + ii; const float gv = (ii < 4) ? ga[ii & 3] : gb2[ii & 3]; bw[ii] = (s <= l15) ? gv : 0.f; }
                    const f32x4 y = MFMA16(Bv, pack8(bw), r1);
                    const int step = ck * CK + l15, tt = dir ? (SEQ - 1 - step) : step;
                    v2u o; o.x = pk2(y[0], y[1]); o.y = pk2(y[2], y[3]);
                    *(v2u*)(ybase + (size_t)tt * RW) = o;
                }
#pragma unroll
                for (int nt = 0; nt < 4; ++nt) {
                    const bf16x8 Aq = *(const LAS bf16x8*)(lds + pb + L_QKT + ((nt * 16 + l15) * 40 + 8 * (q4 ^ (((nt * 16 + l15) >> 3) & 3))) * 2);
                    acc[nt] = MFMA16(Aq, Bv, acc[nt]);
                    const f32x4 gc = *(const LAS f32x4*)(lds + pb + L_GC + (nt * 16 + 4 * q4) * 4);
                    acc[nt] = acc[nt] * gc;
                    v2u o; o.x = pk2(acc[nt][0], acc[nt][1]); o.y = pk2(acc[nt][2], acc[nt][3]);
                    *(LAS v2u*)(lds + L_SB + ((16 * w + l15) * 72 + nt * 16 + 4 * q4) * 2) = o;
                }
            }
            CBAR();
        }
    }
    __syncthreads();
}
#undef CBAR

constexpr int KA_P = 72, VA_P = 392;
__device__ __forceinline__ void attnA_item(const Params& P, int item, LAS unsigned char* lds) {
    const int tid = pg8::mk_tid(lds), lane = tid & 63, wave = __builtin_amdgcn_readfirstlane(tid >> 6), l15 = lane & 15, q4 = lane >> 4;
    const int b = item >> 6, n = (item >> 2) & 15, hk = item & 3;
    const bf16* PRE = (const bf16*)(P.ws + WS_PRE); bf16* YC = (bf16*)(P.ws + WS_YCAT);
    const float* RC = (const float*)(P.ws + WS_ROPE); const float* RS = RC + SEQ * 32;
    LAS bf16* Ks = (LAS bf16*)lds; LAS bf16* Vt = Ks + 384 * KA_P;
    {
        v2u klo[6], khi[6]; f32x4 kcs[6], ksn[6]; v4u vw[6];
#pragma unroll
        for (int u = 0; u < 6; ++u) {
            const int it = tid + u * NTHREADS, j = it >> 3, c = it & 7, kp = (n - 1) * 128 + j;
            const bool ok = (kp >= 0 && kp < SEQ); const int kpc = ok ? kp : 0;
            const bf16* src = PRE + ((size_t)b * SEQ + kpc) * NPRE + C_AK + hk * 64;
            klo[u] = *(const v2u*)(src + 4 * c); khi[u] = *(const v2u*)(src + 32 + 4 * c);
            kcs[u] = *(const f32x4*)(RC + kpc * 32 + 4 * c); ksn[u] = *(const f32x4*)(RS + kpc * 32 + 4 * c);
            vw[u] = *(const v4u*)(PRE + ((size_t)b * SEQ + kpc) * NPRE + C_AV + hk * 64 + 8 * c);
        }
        const f32x4 g1 = *(const f32x4*)(P.in[7] + 4 * (tid & 7)), g2 = *(const f32x4*)(P.in[7] + 32 + 4 * (tid & 7));
#pragma unroll
        for (int u = 0; u < 6; ++u) {
            const int it = tid + u * NTHREADS, j = it >> 3, c = it & 7, kp = (n - 1) * 128 + j;
            const bool ok = (kp >= 0 && kp < SEQ);
            float x1[4], x2[4]; unpack4(klo[u], x1); unpack4(khi[u], x2);
            float ss = 0.f;
#pragma unroll
            for (int i = 0; i < 4; ++i) ss += x1[i] * x1[i] + x2[i] * x2[i];
            ss = red8(ss);
            const float rstd = ok ? 1.f / sqrtf(ss * (1.f / 64.f) + NORM_EPS) : 0.f;
            float r1[4], r2[4];
#pragma unroll
            for (int i = 0; i < 4; ++i) { const float y1 = x1[i] * rstd * g1[i], y2 = x2[i] * rstd * g2[i]; r1[i] = y1 * kcs[u][i] - y2 * ksn[u][i]; r2[i] = y2 * kcs[u][i] + y1 * ksn[u][i]; }
            v2u o0, o1; o0.x = pk2(r1[0], r1[1]); o0.y = pk2(r1[2], r1[3]); o1.x = pk2(r2[0], r2[1]); o1.y = pk2(r2[2], r2[3]);
            *(LAS v2u*)(Ks + j * KA_P + 4 * c) = o0; *(LAS v2u*)(Ks + j * KA_P + 32 + 4 * c) = o1;
            const v4u w = ok ? vw[u] : (v4u){0u, 0u, 0u, 0u};
            LAS bf16* d = Vt + (8 * c) * VA_P + j;
            d[0] = (bf16)(w.x & 0xffffu); d[VA_P] = (bf16)(w.x >> 16); d[2 * VA_P] = (bf16)(w.y & 0xffffu); d[3 * VA_P] = (bf16)(w.y >> 16);
            d[4 * VA_P] = (bf16)(w.z & 0xffffu); d[5 * VA_P] = (bf16)(w.z >> 16); d[6 * VA_P] = (bf16)(w.w & 0xffffu); d[7 * VA_P] = (bf16)(w.w >> 16);
        }
    }
    v4u qlo, qhi;
    {
        const int R0 = wave * 48, g = R0 >> 7, pos = (R0 & 127) + l15, qp = n * 128 + pos, hq = hk * 3 + g;
        const bf16* src = PRE + ((size_t)b * SEQ + qp) * NPRE + C_AQ + hq * 64;
        qlo = *(const v4u*)(src + 8 * q4); qhi = *(const v4u*)(src + 32 + 8 * q4);
    }
    __syncthreads();
#pragma unroll 1
    for (int mt = 0; mt < 3; ++mt) {
        const int R0 = wave * 48 + mt * 16, g = R0 >> 7, pos = (R0 & 127) + l15, qp = n * 128 + pos, hq = hk * 3 + g;
        const size_t m = (size_t)b * SEQ + qp;
        v2u gat[4];
#pragma unroll
        for (int dt = 0; dt < 4; ++dt) gat[dt] = *(const v2u*)(PRE + m * NPRE + C_AG + hq * 64 + dt * 16 + 4 * q4);
        const v4u cqlo = qlo, cqhi = qhi;
        {
            const int mn = (mt < 2) ? mt + 1 : 2, R1 = wave * 48 + mn * 16, g1_ = R1 >> 7, pos1 = (R1 & 127) + l15, qp1 = n * 128 + pos1, hq1 = hk * 3 + g1_;
            const bf16* src = PRE + ((size_t)b * SEQ + qp1) * NPRE + C_AQ + hq1 * 64;
            qlo = *(const v4u*)(src + 8 * q4); qhi = *(const v4u*)(src + 32 + 8 * q4);
        }
        bf16x8 qf0, qf1;
        {
            float x1[8], x2[8]; unpack8(cqlo, x1); unpack8(cqhi, x2);
            float ss = 0.f;
#pragma unroll
            for (int i = 0; i < 8; ++i) ss += x1[i] * x1[i] + x2[i] * x2[i];
            ss += __shfl_xor(ss, 16); ss += __shfl_xor(ss, 32);
            const float rstd = (0.125f * 1.4426950408889634f) / sqrtf(ss * (1.f / 64.f) + NORM_EPS);
            float r1[8], r2[8];
            const f32x4 ga = *(const f32x4*)(P.in[6] + 8 * q4), gb = *(const f32x4*)(P.in[6] + 8 * q4 + 4), gc = *(const f32x4*)(P.in[6] + 32 + 8 * q4), gd = *(const f32x4*)(P.in[6] + 36 + 8 * q4);
            const f32x4 ca = *(const f32x4*)(RC + qp * 32 + 8 * q4), cb = *(const f32x4*)(RC + qp * 32 + 8 * q4 + 4), sa_ = *(const f32x4*)(RS + qp * 32 + 8 * q4), sb_ = *(const f32x4*)(RS + qp * 32 + 8 * q4 + 4);
#pragma unroll
            for (int i = 0; i < 8; ++i) {
                const float g1 = (i < 4) ? ga[i & 3] : gb[i & 3], g2 = (i < 4) ? gc[i & 3] : gd[i & 3], cs = (i < 4) ? ca[i & 3] : cb[i & 3], sn = (i < 4) ? sa_[i & 3] : sb_[i & 3];
                const float y1 = x1[i] * rstd * g1, y2 = x2[i] * rstd * g2; r1[i] = y1 * cs - y2 * sn; r2[i] = y2 * cs + y1 * sn;
            }
            qf0 = pack8(r1); qf1 = pack8(r2);
        }
        const int kt0 = (R0 & 127) >> 4;
        const int seq_lo = (n == 0) ? 8 : 0, seq_hi = (n == 15) ? 15 : 23;
        f32x4 acc[18];
#pragma unroll
        for (int u = 0; u < 17; ++u) {
            const LAS bf16* kr = Ks + ((kt0 + u) * 16 + l15) * KA_P + 8 * q4;
            const bf16x8 k0 = *(const LAS bf16x8*)(kr), k1 = *(const LAS bf16x8*)(kr + 32);
            f32x4 a = (f32x4){0.f, 0.f, 0.f, 0.f};
            a = MFMA16(k0, qf0, a); a = MFMA16(k1, qf1, a); acc[u] = a;
        }
        acc[17] = (f32x4){-1e30f, -1e30f, -1e30f, -1e30f};
        const float sink = P.in[8][hq] * 1.4426950408889634f;
        float mx = sink;
#pragma unroll
        for (int u = 0; u < 17; ++u) {
            const bool tv = (kt0 + u >= seq_lo) && (kt0 + u <= seq_hi);
#pragma unroll
            for (int i = 0; i < 4; ++i) {
                bool valid = tv;
                if (u == 0) valid = valid && (4 * q4 + i >= l15);
                if (u == 16) valid = valid && (4 * q4 + i <= l15);
                const float sv = valid ? acc[u][i] : -1e30f; acc[u][i] = sv; mx = fmaxf(mx, sv);
            }
        }
        mx = fmaxf(mx, __shfl_xor(mx, 16)); mx = fmaxf(mx, __shfl_xor(mx, 32));
        float sum = 0.f;
#pragma unroll
        for (int u = 0; u < 17; ++u)
#pragma unroll
            for (int i = 0; i < 4; ++i) { const float p = __builtin_amdgcn_exp2f(acc[u][i] - mx); acc[u][i] = p; sum += p; }
        acc[17] = (f32x4){0.f, 0.f, 0.f, 0.f};
        sum += __shfl_xor(sum, 16); sum += __shfl_xor(sum, 32);
        const float inv = 1.f / (sum + __builtin_amdgcn_exp2f(sink - mx));
        f32x4 o[4];
#pragma unroll
        for (int dt = 0; dt < 4; ++dt) o[dt] = (f32x4){0.f, 0.f, 0.f, 0.f};
#pragma unroll
        for (int k2 = 0; k2 < 9; ++k2) {
            float pp[8] = {acc[2 * k2][0], acc[2 * k2][1], acc[2 * k2][2], acc[2 * k2][3], acc[2 * k2 + 1][0], acc[2 * k2 + 1][1], acc[2 * k2 + 1][2], acc[2 * k2 + 1][3]};
            const bf16x8 pf = pack8(pp);
#pragma unroll
            for (int dt = 0; dt < 4; ++dt) {
                const LAS bf16* vr = Vt + (dt * 16 + l15) * VA_P + kt0 * 16 + k2 * 32 + 4 * q4;
                const v2u v0 = *(const LAS v2u*)(vr);
                v2u v1 = (v2u){0u, 0u};
                if (k2 < 8) v1 = *(const LAS v2u*)(vr + 16);
                const v4u vw = (v4u){v0.x, v0.y, v1.x, v1.y};
                o[dt] = MFMA16(__builtin_bit_cast(bf16x8, vw), pf, o[dt]);
            }
        }
#pragma unroll
        for (int dt = 0; dt < 4; ++dt) {
            const int ch = hq * 64 + dt * 16 + 4 * q4;
            float gg[4]; unpack4(gat[dt], gg);
            v2u w; w.x = pk2(o[dt][0] * inv * gg[0], o[dt][1] * inv * gg[1]); w.y = pk2(o[dt][2] * inv * gg[2], o[dt][3] * inv * gg[3]);
            *(v2u*)(YC + m * DM + ch) = w;
        }
    }
    __syncthreads();
}

constexpr int KC_P = 136, VC_P = 264;
__device__ __forceinline__ void attnC_qblock(const Params& P, const LAS bf16* Ks, const LAS bf16* Vt, bf16* YC, const v4u (&qraw)[4], const v2u (&gat)[8], size_t m, int hx, int l15, int q4) {
    {
        bf16x8 qf[4];
        {
            float x[4][8]; float ss = 0.f;
#pragma unroll
            for (int ks = 0; ks < 4; ++ks) { unpack8(qraw[ks], x[ks]);
#pragma unroll
                for (int i = 0; i < 8; ++i) ss += x[ks][i] * x[ks][i]; }
            ss += __shfl_xor(ss, 16); ss += __shfl_xor(ss, 32);
            const float rstd = (0.08838834764831845f * 1.4426950408889634f) / sqrtf(ss * (1.f / 128.f) + NORM_EPS);
#pragma unroll
            for (int ks = 0; ks < 4; ++ks) { float y[8];
                const f32x4 ga = *(const f32x4*)(P.in[22] + ks * 32 + 8 * q4), gb = *(const f32x4*)(P.in[22] + ks * 32 + 8 * q4 + 4);
#pragma unroll
                for (int i = 0; i < 8; ++i) y[i] = x[ks][i] * rstd * ((i < 4) ? ga[i & 3] : gb[i & 3]);
                qf[ks] = pack8(y); }
        }
        f32x4 acc[16];
#pragma unroll
        for (int kt = 0; kt < 16; ++kt) {
            const LAS bf16* kr = Ks + (kt * 16 + l15) * KC_P + 8 * q4;
            f32x4 a = (f32x4){0.f, 0.f, 0.f, 0.f};
#pragma unroll
            for (int ks = 0; ks < 4; ++ks) a = MFMA16(*(const LAS bf16x8*)(kr + ks * 32), qf[ks], a);
            acc[kt] = a;
        }
        float mx = -1e30f;
#pragma unroll
        for (int kt = 0; kt < 16; ++kt)
#pragma unroll
            for (int i = 0; i < 4; ++i) mx = fmaxf(mx, acc[kt][i]);
        mx = fmaxf(mx, __shfl_xor(mx, 16)); mx = fmaxf(mx, __shfl_xor(mx, 32));
        float sum = 0.f;
#pragma unroll
        for (int kt = 0; kt < 16; ++kt)
#pragma unroll
            for (int i = 0; i < 4; ++i) { const float p = __builtin_amdgcn_exp2f(acc[kt][i] - mx); acc[kt][i] = p; sum += p; }
        sum += __shfl_xor(sum, 16); sum += __shfl_xor(sum, 32);
        const float inv = 1.f / sum;
        f32x4 o[8];
#pragma unroll
        for (int dt = 0; dt < 8; ++dt) o[dt] = (f32x4){0.f, 0.f, 0.f, 0.f};
#pragma unroll
        for (int k2 = 0; k2 < 8; ++k2) {
            float pp[8] = {acc[2 * k2][0], acc[2 * k2][1], acc[2 * k2][2], acc[2 * k2][3], acc[2 * k2 + 1][0], acc[2 * k2 + 1][1], acc[2 * k2 + 1][2], acc[2 * k2 + 1][3]};
            const bf16x8 pf = pack8(pp);
#pragma unroll
            for (int dt = 0; dt < 8; ++dt) {
                const LAS bf16* vr = Vt + (dt * 16 + l15) * VC_P + k2 * 32 + 4 * q4;
                const v2u v0 = *(const LAS v2u*)(vr), v1 = *(const LAS v2u*)(vr + 16);
                const v4u vw = (v4u){v0.x, v0.y, v1.x, v1.y};
                o[dt] = MFMA16(__builtin_bit_cast(bf16x8, vw), pf, o[dt]);
            }
        }
#pragma unroll
        for (int dt = 0; dt < 8; ++dt) {
            const int ch = hx * 128 + dt * 16 + 4 * q4;
            float gg[4]; unpack4(gat[dt], gg);
            v2u w; w.x = pk2(o[dt][0] * inv * gg[0], o[dt][1] * inv * gg[1]); w.y = pk2(o[dt][2] * inv * gg[2], o[dt][3] * inv * gg[3]);
            *(v2u*)(YC + m * DM + 1536 + ch) = w;
        }
    }
}
__device__ __forceinline__ void attnC_item(const Params& P, int item, LAS unsigned char* lds) {
    const int tid = pg8::mk_tid(lds), lane = tid & 63, wave = __builtin_amdgcn_readfirstlane(tid >> 6), l15 = lane & 15, q4 = lane >> 4;
    const int b = item >> 5, qb0 = 2 * ((item >> 2) & 7), hx = item & 3;
    const bf16* PRE = (const bf16*)(P.ws + WS_PRE); const bf16* MKV = (const bf16*)(P.ws + WS_MKV); bf16* YC = (bf16*)(P.ws + WS_YCAT);
    LAS bf16* Ks = (LAS bf16*)lds; LAS bf16* Vt = Ks + 256 * KC_P;
    const size_t m = (size_t)b * SEQ + qb0 * 128 + wave * 16 + l15;
    {
        v4u kw[8], vw[8];
#pragma unroll
        for (int u = 0; u < 8; ++u) {
            const int it = tid + u * NTHREADS, j = it >> 4, c = it & 15;
            const bf16* src = MKV + ((size_t)b * NMEM + j) * 1024 + hx * 128 + 8 * c;
            kw[u] = *(const v4u*)(src); vw[u] = *(const v4u*)(src + 512);
        }
        const f32x4 g0 = *(const f32x4*)(P.in[23] + 8 * (tid & 15)), g1 = *(const f32x4*)(P.in[23] + 8 * (tid & 15) + 4);
#pragma unroll
        for (int u = 0; u < 8; ++u) {
            const int it = tid + u * NTHREADS, j = it >> 4, c = it & 15;
            float x[8]; unpack8(kw[u], x);
            float ss = 0.f;
#pragma unroll
            for (int i = 0; i < 8; ++i) ss += x[i] * x[i];
            ss = red8(ss); ss = dpp_add<0x140>(ss);
            const float rstd = 1.f / sqrtf(ss * (1.f / 128.f) + NORM_EPS);
            v4u o; o.x = pk2(x[0] * rstd * g0.x, x[1] * rstd * g0.y); o.y = pk2(x[2] * rstd * g0.z, x[3] * rstd * g0.w);
            o.z = pk2(x[4] * rstd * g1.x, x[5] * rstd * g1.y); o.w = pk2(x[6] * rstd * g1.z, x[7] * rstd * g1.w);
            *(LAS v4u*)(Ks + j * KC_P + 8 * c) = o;
            const v4u w = vw[u];
            LAS bf16* d = Vt + (8 * c) * VC_P + j;
            d[0] = (bf16)(w.x & 0xffffu); d[VC_P] = (bf16)(w.x >> 16); d[2 * VC_P] = (bf16)(w.y & 0xffffu); d[3 * VC_P] = (bf16)(w.y >> 16);
            d[4 * VC_P] = (bf16)(w.z & 0xffffu); d[5 * VC_P] = (bf16)(w.z >> 16); d[6 * VC_P] = (bf16)(w.w & 0xffffu); d[7 * VC_P] = (bf16)(w.w >> 16);
        }
    }
    v4u qraw[4]; v2u gat[8];
    {
        const bf16* src = PRE + m * NPRE + C_XQ + hx * 128 + 8 * q4;
#pragma unroll
        for (int ks = 0; ks < 4; ++ks) qraw[ks] = *(const v4u*)(src + ks * 32);
#pragma unroll
        for (int dt = 0; dt < 8; ++dt) gat[dt] = *(const v2u*)(PRE + m * NPRE + C_XG + hx * 128 + dt * 16 + 4 * q4);
    }
    __syncthreads();
    v4u qraw2[4]; v2u gat2[8];
    {
        const size_t m2 = m + 128; const bf16* src = PRE + m2 * NPRE + C_XQ + hx * 128 + 8 * q4;
#pragma unroll
        for (int ks = 0; ks < 4; ++ks) qraw2[ks] = *(const v4u*)(src + ks * 32);
#pragma unroll
        for (int dt = 0; dt < 8; ++dt) gat2[dt] = *(const v2u*)(PRE + m2 * NPRE + C_XG + hx * 128 + dt * 16 + 4 * q4);
    }
    attnC_qblock(P, Ks, Vt, YC, qraw, gat, m, hx, l15, q4);
    __builtin_amdgcn_sched_barrier(0);
    attnC_qblock(P, Ks, Vt, YC, qraw2, gat2, m + 128, hx, l15, q4);
    __syncthreads();
}

__device__ __forceinline__ void p5_rwkv_post(const Params& P, LAS unsigned char* lds) {
    const bf16* PRE = (const bf16*)(P.ws + WS_PRE);
    const bf16* YF = (const bf16*)((unsigned char*)P.out + DO_YF); const bf16* YB = (const bf16*)(P.ws + WS_YB); bf16* YC = (bf16*)(P.ws + WS_YCAT);
    const float* BON = (const float*)(P.ws + WS_BON);
    const float* mu = P.in[10];
    const int gt = blockIdx.x * NTHREADS + pg8::mk_tid(lds), NGT = gridDim.x * NTHREADS;
    for (int idx = gt; idx < M_TOK * 96; idx += NGT) {
        const int m = idx / 96, he = idx - m * 96, ch0 = he * 8, t = m & (SEQ - 1);
        const bf16* p = PRE + (size_t)m * NPRE + C_RS + ch0;
        const v4u z4 = (v4u){0u, 0u, 0u, 0u};
        const bool hp = t > 0, hn = t < SEQ - 1;
        const v4u vc = *(const v4u*)(p + 1536);
        const v4u vp = hp ? *(const v4u*)(p - NPRE + 1536) : z4, vn = hn ? *(const v4u*)(p + NPRE + 1536) : z4;
        const v4u yf8 = *(const v4u*)(YF + (size_t)m * RW + ch0), yb8 = *(const v4u*)(YB + (size_t)m * RW + ch0);
        const v4u rg8 = *(const v4u*)(PRE + (size_t)m * NPRE + C_RG + ch0);
        const float bs = BON[(size_t)m * 12 + (he >> 3)] + BON[((size_t)M_TOK + m) * 12 + (he >> 3)];
        float v[8], x0[8], x1[8], x2[8];
        unpack8(vc, x0); unpack8(vp, x1); unpack8(vn, x2);
#pragma unroll
        for (int i = 0; i < 8; ++i) v[i] = x0[i] + mu[1536 + ch0 + i] * (0.5f * (x1[i] + x2[i]) - x0[i]);
        float ys[8], yb[8], rg[8]; unpack8(yf8, ys); unpack8(yb8, yb); unpack8(rg8, rg);
        float sm = 0.f;
#pragma unroll
        for (int i = 0; i < 8; ++i) { ys[i] += yb[i]; sm += ys[i]; }
        sm = red8(sm);
        const float mean = sm * (1.f / 64.f);
        float vs = 0.f;
#pragma unroll
        for (int i = 0; i < 8; ++i) { ys[i] -= mean; vs += ys[i] * ys[i]; }
        vs = red8(vs);
        const float rstd = 1.f / sqrtf(vs * (1.f / 64.f) + GN_EPS);
        float o[8];
#pragma unroll
        for (int i = 0; i < 8; ++i) o[i] = (ys[i] * rstd * P.in[18][ch0 + i] + P.in[19][ch0 + i] + bs * v[i]) * rg[i];
        v4u w; w.x = pk2(o[0], o[1]); w.y = pk2(o[2], o[3]); w.z = pk2(o[4], o[5]); w.w = pk2(o[6], o[7]);
        *(v4u*)(YC + (size_t)m * DM + 768 + ch0) = w;
    }
}

constexpr size_t WS_XBAR = 504 * MiB + 832 * 1024;
#define XB_TMO      128
#define XB_XCNT(j)  (256  + 64 * (j))
#define XB_XSUB(j)  (1280 + 64 * (j))
#define XB_XGEN(j)  (2304 + 64 * (j))
#define XB_TOP      3328
#define XB_TOPGEN   3392
#define XCD_BAR_WORDS 3456
#define XB_SPIN_CAP (1u << 18)
__device__ __forceinline__ unsigned xb_ld(unsigned* p)              { return __hip_atomic_load(p, __ATOMIC_RELAXED, __HIP_MEMORY_SCOPE_AGENT); }
__device__ __forceinline__ unsigned xb_add(unsigned* p, unsigned v) { return __hip_atomic_fetch_add(p, v, __ATOMIC_RELAXED, __HIP_MEMORY_SCOPE_AGENT); }
__device__ __forceinline__ unsigned xb_xcc_id() { return (unsigned)__builtin_amdgcn_s_getreg((3 << 11) | 20) & 0xFu; }
#define XB_SPIN(cond, bar) do { unsigned _sp = 0; while (cond) { __builtin_amdgcn_s_sleep(1); \
    if ((++_sp & 255u) == 0u) { if (xb_ld(&(bar)[XB_TMO])) break; if (_sp > XB_SPIN_CAP) { atomicAdd(&(bar)[XB_TMO], 1u); break; } } } } while (0)
__device__ __forceinline__ void xcd_barrier_complete(unsigned* bar, unsigned x, unsigned& nloc, unsigned& nx) {
    const unsigned G = gridDim.x * gridDim.y * gridDim.z;
    unsigned sum, cnt, mine, sp = 0u;
    for (;;) {
        sum = 0u; cnt = 0u; mine = 0u;
#pragma unroll
        for (unsigned j = 0; j < 16; ++j) { const unsigned c = xb_ld(&bar[XB_XCNT(j)]); sum += c; cnt += (c > 0u) ? 1u : 0u; mine = (j == x) ? c : mine; }
        if (sum == G) break;
        __builtin_amdgcn_s_sleep(1);
        if ((++sp & 255u) == 0u) { if (xb_ld(&bar[XB_TMO])) break; if (sp > XB_SPIN_CAP) { atomicAdd(&bar[XB_TMO], 1u); break; } }
    }
    nloc = mine > 0u ? mine : 1u; nx = cnt > 0u ? cnt : 1u;
}
__device__ __forceinline__ void xcd_barrier(unsigned* bar, volatile LAS unsigned* st, LAS unsigned char* lds) {
    asm volatile("s_waitcnt vmcnt(0)" ::: "memory");
    __syncthreads();
    if (pg8::mk_tid(lds) == 0) {
        const unsigned x = xb_xcc_id();
        __builtin_amdgcn_s_waitcnt(0);
        unsigned nloc = st[0], nx = st[1];
        if (nloc == 0u) { xcd_barrier_complete(bar, x, nloc, nx); st[0] = nloc; st[1] = nx; }
        const unsigned old = xb_add(&bar[XB_XSUB(x)], 1u);
        const unsigned gen = old / nloc;
        if (old + 1u == (gen + 1u) * nloc) {
            __builtin_amdgcn_fence(__ATOMIC_RELEASE, "agent");
            asm volatile("s_waitcnt vmcnt(0)" ::: "memory");
            const unsigned og = xb_add(&bar[XB_TOP], 1u);
            const unsigned tg = og / nx;
            if (og + 1u == (tg + 1u) * nx) xb_add(&bar[XB_TOPGEN], 1u);
            else XB_SPIN(xb_ld(&bar[XB_TOPGEN]) == tg, bar);
            __builtin_amdgcn_fence(__ATOMIC_ACQUIRE, "agent");
            xb_add(&bar[XB_XGEN(x)], 1u);
            asm volatile("s_waitcnt vmcnt(0)" ::: "memory");
        } else {
            XB_SPIN(xb_ld(&bar[XB_XGEN(x)]) == gen, bar);
            __builtin_amdgcn_fence(__ATOMIC_ACQUIRE, "agent");
            asm volatile("s_waitcnt vmcnt(0)" ::: "memory");
        }
    }
    __syncthreads();
}

constexpr int N_PHASES = 8;
__global__ void __launch_bounds__(NTHREADS, 2) hybrid_fwd(Params P) {
    extern __shared__ __attribute__((aligned(16))) unsigned char lds_raw[];
    LAS unsigned char* lds = (LAS unsigned char*)lds_raw;
    cg::grid_group grid = cg::this_grid();
    const int lo = P.ph_lo, hi = P.ph_hi, G = gridDim.x;
    if ((threadIdx.x & 63) == 0) *(volatile LAS int*)(lds + pg8::TIDTAB_OFF + 4 * pg8::hw_slot()) = (int)(threadIdx.x >> 6);
    volatile LAS unsigned* xbst = (volatile LAS unsigned*)(lds + pg8::TIDTAB_OFF - 128);
    unsigned* xbar = (unsigned*)(P.ws + WS_XBAR);
    if (threadIdx.x == 0) { xbst[0] = 0u; xbst[1] = 0u; (void)xb_add(&xbar[XB_XCNT(xb_xcc_id())], 1u); }
    __syncthreads();
    unsigned char* ws = P.ws; unsigned char* dob = (unsigned char*)P.out;
#ifdef PHMASK
#define IN(k) (((PHMASK >> (k)) & 1) && lo <= (k) && (k) < hi)
#else
#define IN(k) (lo <= (k) && (k) < hi)
#endif
#define SEAM(k) do { if (IN(k) && IN((k) + 1)) xcd_barrier(xbar, xbst, lds); } while (0)
#ifndef REPEAT_MASK
#define REPEAT_MASK 0
#endif
#define REP(k) for (int rep_ = 0; rep_ < (((REPEAT_MASK >> (k)) & 1) ? 2 : 1); ++rep_)
#define REPSYNC() do { if (rep_) grid.sync(); } while (0)
    if (hi > N_PHASES) grid.sync();
    if (IN(0)) REP(0) { REPSYNC(); p0_prologue(P, lds, P.out); __syncthreads(); }
    SEAM(0);
    if (IN(1)) REP(1) { REPSYNC();
        { pg8::Gemm g{(const bf16*)(dob + DO_H), (const bf16*)(dob + DO_WIN), M_TOK, NIN, DM}; pg8::StaticOrder S; S.init(M_TOK, NIN, G, (int)blockIdx.x);
          EpiProj E{(bf16*)(ws + WS_PRE), (bf16*)(ws + WS_GATES), P.in[5]};
          pg8::gemm_phase<EpiProj, pg8::StaticOrder, true, true>(lds, g, S, E); }
        { pg8::Gemm g{(const bf16*)(ws + WS_MEMN), (const bf16*)(ws + WS_WXKV), MEMROWS, 1024, DM}; pg8::StaticOrder S; S.init(MEMROWS, 1024, G, (int)((blockIdx.x + G - 64) % G));
          EpiPlain E{(bf16*)(ws + WS_MKV), 1024};
          pg8::gemm_phase<EpiPlain, pg8::StaticOrder, true, true>(lds, g, S, E); }
    }
    SEAM(1);
    if (IN(2)) REP(2) { REPSYNC(); p2_lora_in(P, lds); }
    SEAM(2);
    if (IN(3)) REP(3) { REPSYNC();
        int klora = 256; asm volatile("" : "+s"(klora));
        pg8::Gemm g{(const bf16*)(dob + DO_LIN), (const bf16*)(ws + WS_LORAB), M_TOK, NLORA, klora}; pg8::StaticOrder S; S.init(M_TOK, NLORA, G, (int)blockIdx.x);
        EpiLora E{(bf16*)(dob + DO_EA), P.in[14], P.in[16]};
        pg8::gemm_phase<EpiLora, pg8::StaticOrder, true, true>(lds, g, S, E);
    }
    SEAM(3);
    if (IN(4)) REP(4) { REPSYNC();
        const int bid = blockIdx.x;
#ifndef STATIC_ATT
#define STATIC_ATT 0
#endif
#ifndef SCAN2
#define SCAN2 1
#endif
        if (bid < 192) scan_chunked(P, bid, lds);
        if (STATIC_ATT) {
            if (bid >= 192) { for (int it = bid - 192; it < 768; it += G - 192) { if (it < 512) attnA_item(P, it, lds); else attnC_item(P, it - 512, lds); } }
        } else {
            volatile LAS int* slot = (volatile LAS int*)(lds + pg8::TIDTAB_OFF - 64);
            const int tid4 = pg8::mk_tid(lds);
            for (;;) {
                if (tid4 == 0) *slot = (int)__hip_atomic_fetch_add((unsigned*)(ws + WS_CTR), 1u, __ATOMIC_RELAXED, __HIP_MEMORY_SCOPE_AGENT);
                __syncthreads();
                const int it = *slot;
                __syncthreads();
                if (it >= 768) break;
                if (it < 512) attnA_item(P, it, lds); else attnC_item(P, it - 512, lds);
            }
        }
    }
    SEAM(4);
    if (IN(5)) REP(5) { REPSYNC(); p5_rwkv_post(P, lds); }
    SEAM(5);
    if (IN(6)) REP(6) { REPSYNC();
        pg8::Gemm g{(const bf16*)(ws + WS_YCAT), (const bf16*)(ws + WS_WCAT), M_TOK, DM, DM}; pg8::StaticOrder S; S.init(M_TOK, DM, G, (int)blockIdx.x);
        EpiMerged E{(bf16*)(ws + WS_MERGED), (const bf16*)(ws + WS_GATES)};
        pg8::gemm_phase<EpiMerged, pg8::StaticOrder, true, true>(lds, g, S, E);
    }
    SEAM(6);
    if (IN(7)) REP(7) { REPSYNC();
        pg8::Gemm g{(const bf16*)(ws + WS_MERGED), (const bf16*)(ws + WS_WOUT), M_TOK, DM, DM}; pg8::StaticOrder S; S.init(M_TOK, DM, G, (int)blockIdx.x);
        EpiOut E{P.out, P.in[0]};
        pg8::gemm_phase<EpiOut, pg8::StaticOrder, true, true>(lds, g, S, E);
    }
#undef IN
#undef SEAM
}

#ifndef ONE_LAUNCH
#define ONE_LAUNCH 1
#endif
extern "C" void kernel_launch(void* const* d_in, const int* in_sizes, int n_in, void* d_out, int out_size, void* d_ws, size_t ws_size, hipStream_t stream) {
    static int grid = 0;
    if (grid == 0) {
        if (n_in != 26 || out_size != M_TOK * DM || ws_size < WS_END) { fprintf(stderr, "kernel_launch: unexpected shapes (n_in %d, out %d, ws %zu); nothing launched\n", n_in, out_size, ws_size); grid = -1; return; }
        int dev = 0, cus = 0, per_cu = 0;
        hipGetDevice(&dev); hipDeviceGetAttribute(&cus, hipDeviceAttributeMultiprocessorCount, dev);
        if (hipFuncSetAttribute((const void*)hybrid_fwd, hipFuncAttributeMaxDynamicSharedMemorySize, LDS_BYTES) != hipSuccess) { fprintf(stderr, "kernel_launch: hipFuncSetAttribute failed\n"); grid = -1; return; }
        hipOccupancyMaxActiveBlocksPerMultiprocessor(&per_cu, (const void*)hybrid_fwd, NTHREADS, LDS_BYTES);
        (void)hipGetLastError();
        if (per_cu < 1) per_cu = 1;
        grid = cus * per_cu; if (grid > 256) grid = 256;
        if (grid < 200) { fprintf(stderr, "kernel_launch: grid %d too small for the scan/attention split\n", grid); grid = -1; return; }
    }
    if (grid < 0) return;
    Params p{};
    for (int i = 0; i < 26; ++i) p.in[i] = (const float*)d_in[i];
    p.out = (float*)d_out; p.ws = (unsigned char*)d_ws;
#if ONE_LAUNCH
    (void)hipMemsetAsync((unsigned char*)d_ws + WS_XBAR, 0, XCD_BAR_WORDS * 4, stream);
    p.ph_lo = 0; p.ph_hi = N_PHASES;
    void* args[] = {&p};
    hipError_t e = hipLaunchCooperativeKernel((const void*)hybrid_fwd, dim3(grid), dim3(NTHREADS), args, LDS_BYTES, stream);
    if (e != hipSuccess) fprintf(stderr, "cooperative launch failed: %s (grid %d)\n", hipGetErrorString(e), grid);
#else
    for (int ph = 0; ph < N_PHASES; ++ph) {
        p.ph_lo = ph; p.ph_hi = ph + 1;
        hipLaunchKernelGGL(hybrid_fwd, dim3(grid), dim3(NTHREADS), LDS_BYTES, stream, p);
    }
#endif
}
```

```cpp
#include <hip/hip_runtime.h>
#include <hip/hip_cooperative_groups.h>
#include <cstdio>
#include <cstdint>
namespace cg = cooperative_groups;
namespace pg8 {
#define PG8_LAS __attribute__((address_space(3)))
typedef unsigned short bf16_t;
typedef short bf16x8 __attribute__((ext_vector_type(8)));
typedef float f32x4 __attribute__((ext_vector_type(4)));
typedef unsigned u32x4 __attribute__((ext_vector_type(4)));
constexpr int BM = 256, BK = 64, HALF = 128, HTB = HALF * BK * 2  , STAGE_BYTES = 8 * HTB, NXCD = 8, WGM = 3;

__host__ __device__ __forceinline__ int lds_byte(int r, int c) { const int st = (r >> 4) * 2 + (c >> 5), rr = r & 15, cc = c & 31, ob = rr * 64 + cc * 2; return st * 1024 + (ob ^ (((ob >> 9) & 1) << 5)); }
__host__ __device__ __forceinline__ void stage_rc(int b, int& R, int& C) { const int st = b / 1024, sb = b % 1024, swz = sb ^ (((sb >> 9) & 1) << 5); R = (st >> 1) * 16 + swz / 64; C = (st & 1) * 32 + (swz % 64) / 2; }
__host__ __device__ __forceinline__ int perm32(int rho) { const int n = rho >> 4, i = rho & 15; return 8 * (i >> 2) + 4 * n + (i & 3); }


constexpr int TIDTAB_OFF = 147200;
__device__ __forceinline__ int hw_slot() { return (int)(__builtin_amdgcn_s_getreg((5 << 11) | 4) & 63u); }
__device__ __forceinline__ int mk_tid(PG8_LAS unsigned char* lds) {
    const int lane = (int)__builtin_amdgcn_mbcnt_hi(~0u, __builtin_amdgcn_mbcnt_lo(~0u, 0u));
    const int w = __builtin_amdgcn_readfirstlane(*(volatile PG8_LAS int*)(lds + TIDTAB_OFF + 4 * hw_slot()));
    return w * 64 + lane;
}
struct Unit { int pm, pn; };
struct Gemm { const bf16_t* A; const bf16_t* Bt; int M, N, K; };

struct StaticOrder {
    int nM, nN, nwg, G, c;
    __host__ __device__ void init(int M, int N, int G_, int c_) { nM = M / BM; nN = N / BM; nwg = nM * nN; G = G_; c = c_; }
    __host__ __device__ bool next(int i, Unit& u) const {
        const long L = (long)i * G + c; if (L >= nwg) return false;
        int wgid = (int)L; { const int q = nwg / NXCD, r = nwg % NXCD, xcd = wgid % NXCD, off = wgid / NXCD; wgid = (xcd < r ? xcd * (q + 1) : r * (q + 1) + (xcd - r) * q) + off; }
        const int nig = WGM * nN, gid = wgid / nig, fm = gid * WGM, gsz = (nM - fm) < WGM ? (nM - fm) : WGM;
        u.pm = fm + ((wgid % nig) % gsz); u.pn = (wgid % nig) / gsz; return true;
    }
    __device__ __forceinline__ void a_ready(const Unit&) const {}
    __device__ __forceinline__ void done(const Unit&) const {}
};

__device__ __forceinline__ unsigned cvt_pk_bf16(float lo, float hi) { unsigned r; asm volatile("v_cvt_pk_bf16_f32 %0, %1, %2" : "=v"(r) : "v"(lo), "v"(hi)); return r; }
template <class Epi, class Sched, bool ALIGN_EPI = false, bool SP2 = false>
__device__ __forceinline__ void gemm_phase(PG8_LAS unsigned char* lds, const Gemm g, const Sched& S, const Epi& E) {
    const int tid = mk_tid(lds), wid = __builtin_amdgcn_readfirstlane(tid >> 6), lane = tid & 63, wr = wid >> 2, wc = wid & 3, fr = lane & 15, fq = lane >> 4;
    const int K = g.K, nt = K / BK;
    unsigned voffA[2], voffB[2];
#pragma unroll
    for (int i = 0; i < 2; ++i) { int R, C; stage_rc(tid * 16 + i * 8192, R, C); const int Rb = Epi::PERM ? ((R & ~31) + perm32(R & 31)) : R;
        voffA[i] = (unsigned)(R * K + C) * 2u; voffB[i] = (unsigned)(Rb * K + C) * 2u; }
    const size_t kstep = (size_t)(BK * 2);
    const size_t hstep = (size_t)HALF * K * 2;
    const size_t tstep = 2 * hstep;
    const unsigned ldsw = (unsigned)wid * 1024u;
    const int aoff = lds_byte(wr * 64 + fr, fq * 8), boff = lds_byte(wc * 32 + fr, fq * 8);
#define PG8_SA(b, h) (((b) * 2 + (h)) * HTB)
#define PG8_SB(b, h) ((4 + (b) * 2 + (h)) * HTB)
#define PG8_STAGE(bufoff, gbase, voff) do { _Pragma("unroll") for (int _i = 0; _i < 2; ++_i) \
        __builtin_amdgcn_global_load_lds((const unsigned*)((const char*)(gbase) + (voff)[_i]), (PG8_LAS unsigned*)(lds + (bufoff) + ldsw + _i * 8192), 16, 0, 0); } while (0)
#define PG8_LDA(dst, b, h) do { _Pragma("unroll") for (int m = 0; m < 4; ++m) _Pragma("unroll") for (int k = 0; k < 2; ++k) dst[m][k] = *(const PG8_LAS bf16x8*)(lds + PG8_SA(b, h) + aoff + m * 2048 + k * 1024); } while (0)
#define PG8_LDB(dst, b, h) do { _Pragma("unroll") for (int n = 0; n < 2; ++n) _Pragma("unroll") for (int k = 0; k < 2; ++k) dst[n][k] = *(const PG8_LAS bf16x8*)(lds + PG8_SB(b, h) + boff + n * 2048 + k * 1024); } while (0)
#define PG8_MMA(ai, bj, At, Bt) do { __builtin_amdgcn_s_setprio(1); _Pragma("unroll") for (int m = 0; m < 4; ++m) _Pragma("unroll") for (int n = 0; n < 2; ++n) _Pragma("unroll") for (int k = 0; k < 2; ++k) \
        acc[ai][bj][m][n] = __builtin_amdgcn_mfma_f32_16x16x32_bf16(Bt[n][k], At[m][k], acc[ai][bj][m][n], 0, 0, 0); __builtin_amdgcn_s_setprio(0); } while (0)
#define PG8_WAIT_V(n) asm volatile("s_waitcnt vmcnt(" #n ")" ::: "memory")
#define PG8_WAIT_L(n) asm volatile("s_waitcnt lgkmcnt(" #n ")" ::: "memory")
#define PG8_BAR __builtin_amdgcn_s_barrier()
#define PG8_SCHED __builtin_amdgcn_sched_barrier(0)
    Unit cur, nxt; int ui = 0;
    if (!S.next(0, cur)) return;
    f32x4 acc[2][2][4][2];
#pragma unroll
    for (int a = 0; a < 2; ++a)
#pragma unroll
        for (int b = 0; b < 2; ++b)
#pragma unroll
            for (int m = 0; m < 4; ++m)
#pragma unroll
                for (int n = 0; n < 2; ++n) acc[a][b][m][n] = (f32x4){0.f, 0.f, 0.f, 0.f};
    bf16x8 At[4][2], B0[2][2], B1[2][2];
    const char* cA = (const char*)g.A + (size_t)cur.pm * tstep; const char* cB = (const char*)g.Bt + (size_t)cur.pn * tstep;
    S.a_ready(cur);
    if constexpr (SP2) {
        PG8_STAGE(PG8_SB(0, 0), cB, voffB); PG8_STAGE(PG8_SB(0, 1), cB + hstep, voffB); PG8_STAGE(PG8_SA(0, 0), cA, voffA); PG8_STAGE(PG8_SA(0, 1), cA + hstep, voffA);
        if (wr == 1) PG8_BAR;
        PG8_WAIT_V(2); PG8_BAR;
        PG8_STAGE(PG8_SB(1, 0), cB + kstep, voffB); PG8_STAGE(PG8_SA(1, 0), cA + kstep, voffA); PG8_STAGE(PG8_SB(1, 1), cB + hstep + kstep, voffB);
        PG8_WAIT_V(6); PG8_BAR;
    } else {
        PG8_STAGE(PG8_SB(0, 0), cB, voffB); PG8_STAGE(PG8_SA(0, 0), cA, voffA); PG8_STAGE(PG8_SB(0, 1), cB + hstep, voffB); PG8_STAGE(PG8_SA(0, 1), cA + hstep, voffA);
        if (wr == 1) PG8_BAR;
        PG8_WAIT_V(4); PG8_BAR;
        PG8_STAGE(PG8_SB(1, 0), cB + kstep, voffB); PG8_STAGE(PG8_SA(1, 0), cA + kstep, voffA); PG8_STAGE(PG8_SB(1, 1), cB + hstep + kstep, voffB);
        PG8_WAIT_V(6); PG8_BAR;
    }
    for (;;) {
        const bool has_next = S.next(ui + 1, nxt);
        const char* nA = has_next ? (const char*)g.A + (size_t)nxt.pm * tstep : cA; const char* nB = has_next ? (const char*)g.Bt + (size_t)nxt.pn * tstep : cB;
        for (int t = 0; t < nt; t += 2) {
            if constexpr (Epi::KHOOK) { if (t == Epi::HK0 || t == Epi::HK1) E.khook(acc, cur, t, wr, wc, fr, fq); }
            const bool last = (t == nt - 2);
            const char* a1 = cA + (size_t)(t + 1) * kstep;
            const char* a2 = last ? nA : cA + (size_t)(t + 2) * kstep; const char* b2 = last ? nB : cB + (size_t)(t + 2) * kstep;
            const char* a3 = a2 + kstep; const char* b3 = b2 + kstep;
            if (last && has_next) S.a_ready(nxt);
            if constexpr (SP2) {
            PG8_LDB(B0, 0, 0); PG8_LDB(B1, 0, 1); PG8_SCHED; PG8_LDA(At, 0, 0); PG8_STAGE(PG8_SA(1, 1), a1 + hstep, voffA);
            PG8_WAIT_V(8); PG8_WAIT_L(0); PG8_BAR; PG8_MMA(0, 0, At, B0); PG8_MMA(0, 1, At, B1); PG8_BAR; PG8_SCHED;
            PG8_LDA(At, 0, 1); PG8_STAGE(PG8_SB(0, 0), b2, voffB); PG8_STAGE(PG8_SB(0, 1), b2 + hstep, voffB); PG8_STAGE(PG8_SA(0, 0), a2, voffA);
            PG8_WAIT_V(8); PG8_WAIT_L(0); PG8_BAR; PG8_MMA(1, 0, At, B0); PG8_MMA(1, 1, At, B1); PG8_BAR; PG8_SCHED;
            PG8_LDB(B0, 1, 0); PG8_LDB(B1, 1, 1); PG8_SCHED; PG8_LDA(At, 1, 0); PG8_STAGE(PG8_SA(0, 1), a2 + hstep, voffA);
            PG8_WAIT_V(8); PG8_WAIT_L(0); PG8_BAR; PG8_MMA(0, 0, At, B0); PG8_MMA(0, 1, At, B1); PG8_BAR; PG8_SCHED;
            PG8_LDA(At, 1, 1); PG8_STAGE(PG8_SB(1, 0), b3, voffB); PG8_STAGE(PG8_SB(1, 1), b3 + hstep, voffB); PG8_STAGE(PG8_SA(1, 0), a3, voffA);
            PG8_WAIT_V(8); PG8_WAIT_L(0); PG8_BAR; PG8_MMA(1, 0, At, B0); PG8_MMA(1, 1, At, B1); PG8_BAR; PG8_SCHED;
            } else {
            PG8_LDB(B0, 0, 0); PG8_SCHED; PG8_LDA(At, 0, 0); PG8_STAGE(PG8_SA(1, 1), a1 + hstep, voffA);
            PG8_WAIT_L(8); PG8_BAR; PG8_WAIT_L(0); PG8_MMA(0, 0, At, B0); PG8_BAR; PG8_SCHED;
            PG8_LDB(B1, 0, 1); PG8_STAGE(PG8_SB(0, 0), b2, voffB);
            PG8_BAR; PG8_WAIT_L(0); PG8_MMA(0, 1, At, B1); PG8_BAR;
            PG8_LDA(At, 0, 1); PG8_STAGE(PG8_SA(0, 0), a2, voffA);
            PG8_BAR; PG8_WAIT_L(0); PG8_MMA(1, 0, At, B0); PG8_BAR; PG8_SCHED;
            PG8_STAGE(PG8_SB(0, 1), b2 + hstep, voffB);
            PG8_WAIT_V(6); PG8_BAR; PG8_MMA(1, 1, At, B1); PG8_BAR;
            PG8_LDB(B0, 1, 0); PG8_SCHED; PG8_LDA(At, 1, 0); PG8_STAGE(PG8_SA(0, 1), a2 + hstep, voffA);
            PG8_WAIT_L(8); PG8_BAR; PG8_WAIT_L(0); PG8_MMA(0, 0, At, B0); PG8_BAR; PG8_SCHED;
            PG8_LDB(B1, 1, 1); PG8_STAGE(PG8_SB(1, 0), b3, voffB);
            PG8_BAR; PG8_WAIT_L(0); PG8_MMA(0, 1, At, B1); PG8_BAR;
            PG8_LDA(At, 1, 1); PG8_STAGE(PG8_SA(1, 0), a3, voffA);
            PG8_BAR; PG8_WAIT_L(0); PG8_MMA(1, 0, At, B0); PG8_BAR; PG8_SCHED;
            PG8_STAGE(PG8_SB(1, 1), b3 + hstep, voffB);
            PG8_WAIT_V(6); PG8_BAR; PG8_MMA(1, 1, At, B1); PG8_BAR;
            }
        }
        if constexpr (ALIGN_EPI) { if (wr == 0) PG8_BAR; }
        if constexpr (!Epi::AFTER_DRAIN) { E(acc, cur, wr, wc, fr, fq); S.done(cur); }
        if (!has_next) break;
#pragma unroll
        for (int a = 0; a < 2; ++a)
#pragma unroll
            for (int b = 0; b < 2; ++b)
#pragma unroll
                for (int m = 0; m < 4; ++m)
#pragma unroll
                    for (int n = 0; n < 2; ++n) acc[a][b][m][n] = (f32x4){0.f, 0.f, 0.f, 0.f};
        cur = nxt; cA = nA; cB = nB; ++ui;
        if constexpr (ALIGN_EPI) { if (wr == 1) PG8_BAR; }
    }
    PG8_WAIT_V(0);
    if constexpr (!ALIGN_EPI) { if (wr == 0) PG8_BAR; }
    PG8_BAR;
    if constexpr (Epi::AFTER_DRAIN) { E.fused(acc, cur, wr, wc, fr, fq, lds, wid, lane); S.done(cur); }
#undef PG8_SA
#undef PG8_SB
#undef PG8_STAGE
#undef PG8_LDA
#undef PG8_LDB
#undef PG8_MMA
#undef PG8_WAIT_V
#undef PG8_WAIT_L
#undef PG8_BAR
#undef PG8_SCHED
}
}

#define GAS __attribute__((address_space(1)))
#define LAS __attribute__((address_space(3)))
typedef unsigned short bf16;
typedef unsigned v4u __attribute__((ext_vector_type(4)));
typedef unsigned v2u __attribute__((ext_vector_type(2)));
typedef float f32x4 __attribute__((ext_vector_type(4)));
typedef float f32x2 __attribute__((ext_vector_type(2)));
typedef short bf16x8 __attribute__((ext_vector_type(8)));
typedef short s16x4 __attribute__((ext_vector_type(4)));

constexpr int NWAVES = 8, NTHREADS = 512;
constexpr int BATCH = 8, SEQ = 2048, DM = 2048, M_TOK = BATCH * SEQ;
constexpr int NPRE = 6400, NGATE = 6144, NIN = NPRE + NGATE;
constexpr int C_AQ = 0, C_AK = 768, C_AV = 1024, C_AG = 1280, C_RS = 2048, C_RR = 2048, C_RK = 2816, C_RV = 3584, C_LORA = 4352, C_RG = 4608, C_XQ = 5376, C_XG = 5888;
constexpr int NMEM = 256, MEMROWS = BATCH * NMEM;
constexpr int RW = 768, NLORA = 3072;
constexpr float NORM_EPS = 1e-6f, GN_EPS = 64e-5f;
constexpr int LDS_BYTES = 147456;

constexpr size_t MiB = 1u << 20;
constexpr size_t WS_PRE = 0, WS_MERGED = 0, WS_GATES = 200 * MiB, WS_YCAT = 392 * MiB;
constexpr size_t WS_WCAT = 456 * MiB, WS_WOUT = 464 * MiB, WS_WXKV = 472 * MiB, WS_MKV = 476 * MiB, WS_MEMN = 480 * MiB, WS_YB = 480 * MiB;
constexpr size_t WS_ROPE = 504 * MiB, WS_LORAB = 505 * MiB, WS_END = 512 * MiB;
constexpr size_t WS_BON = 507 * MiB;
constexpr size_t WS_CTR = 504 * MiB + 768 * 1024;
constexpr size_t DO_H = 0, DO_WIN = 64 * MiB, DO_EA = 0, DO_LIN = 96 * MiB, DO_YF = 104 * MiB;

struct Params { const float* in[26]; float* out; unsigned char* ws; int ph_lo, ph_hi; };

__device__ __forceinline__ float bf_lo(unsigned w) { return __builtin_bit_cast(float, w << 16); }
__device__ __forceinline__ float bf_hi(unsigned w) { return __builtin_bit_cast(float, w & 0xffff0000u); }
__device__ __forceinline__ float bf1(bf16 h) { return __builtin_bit_cast(float, (unsigned)h << 16); }
__device__ __forceinline__ unsigned f2bf(float f) { unsigned u = __builtin_bit_cast(unsigned, f); return (u + 0x7fffu + ((u >> 16) & 1u)) >> 16; }
typedef __bf16 bf16x2_t __attribute__((ext_vector_type(2)));
__device__ __forceinline__ unsigned pk2(float lo, float hi) { const f32x2 v = {lo, hi}; const bf16x2_t b = __builtin_convertvector(v, bf16x2_t); return __builtin_bit_cast(unsigned, b); }
__device__ __forceinline__ float sigmoidf_(float z) { return __builtin_amdgcn_rcpf(1.f + __expf(-z)); }
__device__ __forceinline__ float siluf_(float z) { return z * sigmoidf_(z); }
__device__ __forceinline__ void unpack8(v4u w, float (&x)[8]) { x[0] = bf_lo(w.x); x[1] = bf_hi(w.x); x[2] = bf_lo(w.y); x[3] = bf_hi(w.y); x[4] = bf_lo(w.z); x[5] = bf_hi(w.z); x[6] = bf_lo(w.w); x[7] = bf_hi(w.w); }
__device__ __forceinline__ void unpack4(v2u w, float (&x)[4]) { x[0] = bf_lo(w.x); x[1] = bf_hi(w.x); x[2] = bf_lo(w.y); x[3] = bf_hi(w.y); }
__device__ __forceinline__ float fma_s(float a, float b, float c) { float r; asm("v_fma_f32 %0, %1, %2, %3" : "=v"(r) : "v"(a), "v"(b), "v"(c)); return r; }
__device__ __forceinline__ float mul_s(float a, float b) { float r; asm("v_mul_f32_e32 %0, %1, %2" : "=v"(r) : "v"(a), "v"(b)); return r; }
__device__ __forceinline__ float add_s(float a, float b) { float r; asm("v_add_f32_e32 %0, %1, %2" : "=v"(r) : "v"(a), "v"(b)); return r; }
template <int CTRL> __device__ __forceinline__ float dpp_add(float v) { return v + __builtin_bit_cast(float, __builtin_amdgcn_update_dpp(0, __builtin_bit_cast(int, v), CTRL, 0xF, 0xF, true)); }
__device__ __forceinline__ float red8(float v) { v = dpp_add<0xB1>(v); v = dpp_add<0x4E>(v); v = dpp_add<0x141>(v); return v; }

using pg8::Unit;
struct EpiProj {
    static constexpr bool PERM = true, AFTER_DRAIN = false, KHOOK = false; static constexpr int HK0 = -1, HK1 = -1;
    bf16* pre; bf16* gates; const float* gate_b;
    __device__ __forceinline__ void operator()(const f32x4 (&acc)[2][2][4][2], const Unit& u, int wr, int wc, int fr, int fq) const {
        int row0 = u.pm * 256 + wr * 64 + fr;
        asm volatile("" : "+v"(row0));
        const bool isg = u.pn >= 25;
        const int pn = isg ? u.pn - 25 : u.pn;
        bf16* base = isg ? gates : pre; const int ldc = isg ? NGATE : NPRE;
        const int act = isg ? 2 : (((pn >= 5 && pn <= 7) || (pn >= 18 && pn <= 20) || pn >= 23) ? 1 : 0);
        const int col0 = pn * 256 + wc * 32 + 8 * fq;
        f32x4 bv[2][2];
#pragma unroll
        for (int bj = 0; bj < 2; ++bj) { bv[bj][0] = isg ? *(const f32x4*)(gate_b + col0 + bj * 128) : (f32x4){0.f, 0.f, 0.f, 0.f}; bv[bj][1] = isg ? *(const f32x4*)(gate_b + col0 + bj * 128 + 4) : (f32x4){0.f, 0.f, 0.f, 0.f}; }
#pragma unroll
        for (int ai = 0; ai < 2; ++ai)
#pragma unroll
            for (int m = 0; m < 4; ++m) { bf16* rowp = base + (size_t)(row0 + ai * 128 + m * 16) * ldc + col0;
                __builtin_amdgcn_sched_barrier(0);
#pragma unroll
                for (int bj = 0; bj < 2; ++bj) { f32x4 v0 = acc[ai][bj][m][0] + bv[bj][0], v1 = acc[ai][bj][m][1] + bv[bj][1];
                    if (act == 1) {
#pragma unroll
                        for (int i = 0; i < 4; ++i) { v0[i] = siluf_(v0[i]); v1[i] = siluf_(v1[i]); }
                    } else if (act == 2) {
#pragma unroll
                        for (int i = 0; i < 4; ++i) { v0[i] = sigmoidf_(v0[i]); v1[i] = sigmoidf_(v1[i]); }
                    }
                    v4u w; w.x = pk2(v0[0], v0[1]); w.y = pk2(v0[2], v0[3]); w.z = pk2(v1[0], v1[1]); w.w = pk2(v1[2], v1[3]);
                    *(v4u*)(rowp + bj * 128) = w; } }
    }
};
struct EpiPlain {
    static constexpr bool PERM = true, AFTER_DRAIN = false, KHOOK = false; static constexpr int HK0 = -1, HK1 = -1;
    bf16* O; int ldc;
    __device__ __forceinline__ void operator()(const f32x4 (&acc)[2][2][4][2], const Unit& u, int wr, int wc, int fr, int fq) const {
        int row0 = u.pm * 256 + wr * 64 + fr, col0 = u.pn * 256 + wc * 32 + 8 * fq;
        asm volatile("" : "+v"(row0), "+v"(col0));
#pragma unroll
        for (int ai = 0; ai < 2; ++ai)
#pragma unroll
            for (int m = 0; m < 4; ++m) { bf16* rowp = O + (size_t)(row0 + ai * 128 + m * 16) * ldc + col0;
#pragma unroll
                for (int bj = 0; bj < 2; ++bj) { const f32x4 v0 = acc[ai][bj][m][0], v1 = acc[ai][bj][m][1];
                    v4u w; w.x = pk2(v0[0], v0[1]); w.y = pk2(v0[2], v0[3]); w.z = pk2(v1[0], v1[1]); w.w = pk2(v1[2], v1[3]);
                    *(v4u*)(rowp + bj * 128) = w; } }
    }
};
struct EpiLora {
    static constexpr bool PERM = true, AFTER_DRAIN = false, KHOOK = false; static constexpr int HK0 = -1, HK1 = -1;
    bf16* O; const float* w0; const float* a0;
    __device__ __forceinline__ void operator()(const f32x4 (&acc)[2][2][4][2], const Unit& u, int wr, int wc, int fr, int fq) const {
        int row0 = u.pm * 256 + wr * 64 + fr, col0 = u.pn * 256 + wc * 32 + 8 * fq;
        asm volatile("" : "+v"(row0), "+v"(col0));
        const bool isw = u.pn < 6; const float* bias = isw ? (w0 + col0) : (a0 + col0 - 1536); const float sc = isw ? 0.6065306597126334f : 1.f;
        f32x4 bv[2][2];
#pragma unroll
        for (int bj = 0; bj < 2; ++bj) { bv[bj][0] = *(const f32x4*)(bias + bj * 128); bv[bj][1] = *(const f32x4*)(bias + bj * 128 + 4); }
#pragma unroll
        for (int ai = 0; ai < 2; ++ai)
#pragma unroll
            for (int m = 0; m < 4; ++m) { bf16* rowp = O + (size_t)(row0 + ai * 128 + m * 16) * NLORA + col0;
                __builtin_amdgcn_sched_barrier(0);
#pragma unroll
                for (int bj = 0; bj < 2; ++bj) { f32x4 v0 = acc[ai][bj][m][0] + bv[bj][0], v1 = acc[ai][bj][m][1] + bv[bj][1];
#pragma unroll
                    for (int i = 0; i < 4; ++i) { v0[i] = sc * sigmoidf_(v0[i]); v1[i] = sc * sigmoidf_(v1[i]); }
                    v4u w; w.x = pk2(v0[0], v0[1]); w.y = pk2(v0[2], v0[3]); w.z = pk2(v1[0], v1[1]); w.w = pk2(v1[2], v1[3]);
                    *(v4u*)(rowp + bj * 128) = w; } }
    }
};
struct EpiMerged {
    static constexpr bool PERM = true, AFTER_DRAIN = false, KHOOK = true; static constexpr int HK0 = 12, HK1 = 24;
    bf16* O; const bf16* gates;
    __device__ __forceinline__ void khook(f32x4 (&acc)[2][2][4][2], const Unit& u, int t, int wr, int wc, int fr, int fq) const {
        int row0 = u.pm * 256 + wr * 64 + fr, col0 = u.pn * 256 + wc * 32 + 8 * fq;
        asm volatile("" : "+v"(row0), "+v"(col0));
        const int bo = (t == HK0) ? 0 : DM;
#pragma unroll
        for (int ai = 0; ai < 2; ++ai) {
            v4u ga[4][2], gb[4][2];
#pragma unroll
            for (int m = 0; m < 4; ++m) { const bf16* gp = gates + (size_t)(row0 + ai * 128 + m * 16) * NGATE + bo + col0;
#pragma unroll
                for (int bj = 0; bj < 2; ++bj) { ga[m][bj] = *(const v4u*)(gp + bj * 128); gb[m][bj] = *(const v4u*)(gp + DM + bj * 128); } }
#pragma unroll
            for (int m = 0; m < 4; ++m)
#pragma unroll
                for (int bj = 0; bj < 2; ++bj) { float x[8], y[8]; unpack8(ga[m][bj], x); unpack8(gb[m][bj], y);
#pragma unroll
                    for (int i = 0; i < 4; ++i) { acc[ai][bj][m][0][i] *= x[i] * __builtin_amdgcn_rcpf(y[i]); acc[ai][bj][m][1][i] *= x[4 + i] * __builtin_amdgcn_rcpf(y[4 + i]); } }
            __builtin_amdgcn_sched_barrier(0);
        }
    }
    __device__ __forceinline__ void operator()(const f32x4 (&acc)[2][2][4][2], const Unit& u, int wr, int wc, int fr, int fq) const {
        int row0 = u.pm * 256 + wr * 64 + fr, col0 = u.pn * 256 + wc * 32 + 8 * fq;
        asm volatile("" : "+v"(row0), "+v"(col0));
#pragma unroll
        for (int ai = 0; ai < 2; ++ai) {
            v4u gg[4][2];
#pragma unroll
            for (int m = 0; m < 4; ++m)
#pragma unroll
                for (int bj = 0; bj < 2; ++bj) gg[m][bj] = *(const v4u*)(gates + (size_t)(row0 + ai * 128 + m * 16) * NGATE + 2 * DM + col0 + bj * 128);
#pragma unroll
            for (int m = 0; m < 4; ++m) { const size_t r = (size_t)(row0 + ai * 128 + m * 16);
#pragma unroll
                for (int bj = 0; bj < 2; ++bj) { const v4u g = gg[m][bj]; float x[8]; unpack8(g, x);
                    const f32x4 v0 = acc[ai][bj][m][0], v1 = acc[ai][bj][m][1];
                    v4u w; w.x = pk2(v0[0] * x[0], v0[1] * x[1]); w.y = pk2(v0[2] * x[2], v0[3] * x[3]); w.z = pk2(v1[0] * x[4], v1[1] * x[5]); w.w = pk2(v1[2] * x[6], v1[3] * x[7]);
                    *(v4u*)(O + r * DM + col0 + bj * 128) = w; } }
            __builtin_amdgcn_sched_barrier(0);
        }
    }
};
struct EpiOut {
    static constexpr bool PERM = true, AFTER_DRAIN = false, KHOOK = false; static constexpr int HK0 = -1, HK1 = -1;
    float* O; const float* X;
    __device__ __forceinline__ void operator()(const f32x4 (&acc)[2][2][4][2], const Unit& u, int wr, int wc, int fr, int fq) const {
        int row0 = u.pm * 256 + wr * 64 + fr, col0 = u.pn * 256 + wc * 32 + 8 * fq;
        asm volatile("" : "+v"(row0), "+v"(col0));
#pragma unroll
        for (int ai = 0; ai < 2; ++ai) {
            f32x4 xa[4][2], xb[4][2];
#pragma unroll
            for (int m = 0; m < 4; ++m) { const size_t o = (size_t)(row0 + ai * 128 + m * 16) * DM + col0;
#pragma unroll
                for (int bj = 0; bj < 2; ++bj) { xa[m][bj] = *(const f32x4*)(X + o + bj * 128); xb[m][bj] = *(const f32x4*)(X + o + bj * 128 + 4); } }
#pragma unroll
            for (int m = 0; m < 4; ++m) { const size_t o = (size_t)(row0 + ai * 128 + m * 16) * DM + col0;
#pragma unroll
                for (int bj = 0; bj < 2; ++bj) { *(f32x4*)(O + o + bj * 128) = xa[m][bj] + acc[ai][bj][m][0]; *(f32x4*)(O + o + bj * 128 + 4) = xb[m][bj] + acc[ai][bj][m][1]; } }
            __builtin_amdgcn_sched_barrier(0);
        }
    }
};

__device__ __forceinline__ float wave_sum(float v) {
#pragma unroll
    for (int o = 1; o < 64; o <<= 1) v += __shfl_xor(v, o);
    return v;
}
__device__ __forceinline__ void transpose_item(const float* W, int N, bf16* WT, int ldt, int koff, LAS float* scr, int item, int lane) {
    const int nblk = N / 32, kb = item / nblk, nb = item % nblk, k0 = 64 * kb, n0 = 32 * nb;
    float tv[32];
#pragma unroll
    for (int i = 0; i < 32; ++i) { const int kk = 2 * i + (lane >> 5); tv[i] = W[(size_t)(k0 + kk) * N + n0 + (lane & 31)]; }
#pragma unroll
    for (int i = 0; i < 32; ++i) { const int kk = 2 * i + (lane >> 5); scr[kk * 33 + (lane & 31)] = tv[i]; }
    asm volatile("s_waitcnt lgkmcnt(0)" ::: "memory");
    const int c = lane & 7;
#pragma unroll
    for (int j = 0; j < 4; ++j) { const int n = (lane >> 3) + 8 * j; const LAS float* s = scr + (8 * c) * 33 + n;
        v4u o; o.x = pk2(s[0 * 33], s[1 * 33]); o.y = pk2(s[2 * 33], s[3 * 33]); o.z = pk2(s[4 * 33], s[5 * 33]); o.w = pk2(s[6 * 33], s[7 * 33]);
        *(v4u*)(WT + (size_t)(n0 + n) * ldt + koff + k0 + 8 * c) = o; }
    asm volatile("s_waitcnt lgkmcnt(0)" ::: "memory");
}
__device__ __forceinline__ void rms_row_to_bf16(const float* xrow, const float* g, bf16* orow, int lane) {
    const f32x4* xr = (const f32x4*)xrow + lane; const f32x4* gr = (const f32x4*)g + lane;
    f32x4 v[8]; float s = 0.f;
#pragma unroll
    for (int j = 0; j < 8; ++j) { v[j] = xr[64 * j]; s += (v[j].x * v[j].x + v[j].y * v[j].y) + (v[j].z * v[j].z + v[j].w * v[j].w); }
    const float rstd = 1.f / sqrtf(wave_sum(s) * (1.f / DM) + NORM_EPS);
    v2u* o8 = (v2u*)orow + lane;
#pragma unroll
    for (int j = 0; j < 8; ++j) { const f32x4 gg = gr[64 * j]; v2u o; o.x = pk2(v[j].x * rstd * gg.x, v[j].y * rstd * gg.y); o.y = pk2(v[j].z * rstd * gg.z, v[j].w * rstd * gg.w); o8[64 * j] = o; }
}
__device__ __forceinline__ void p0_prologue(const Params& P, LAS unsigned char* lds, float* dout_scratch) {
    const int tid = pg8::mk_tid(lds), lane = tid & 63, wave = tid >> 6, G = gridDim.x;
    LAS float* scr = (LAS float*)(lds + wave * 16384);
    const int gw = blockIdx.x * NWAVES + wave, NGW = G * NWAVES;
    unsigned char* ws = P.ws; unsigned char* dob = (unsigned char*)P.out;
    bf16* WIN_T = (bf16*)(dob + DO_WIN); bf16* WCAT_T = (bf16*)(ws + WS_WCAT); bf16* WOUT_T = (bf16*)(ws + WS_WOUT); bf16* WXKV_T = (bf16*)(ws + WS_WXKV);
    constexpr int I_IN = 32 * (NIN / 32), I_A = 12 * 64, I_R = 12 * 64, I_X = 8 * 64, I_O = 32 * 64, I_KV = 32 * 32;
    constexpr int NITEMS = I_IN + I_A + I_R + I_X + I_O + I_KV;
    for (int it = gw; it < NITEMS; it += NGW) {
        int r = it;
        if (r < I_IN) { transpose_item(P.in[4], NIN, WIN_T, DM, 0, scr, r, lane); continue; } r -= I_IN;
        if (r < I_A) { transpose_item(P.in[9], DM, WCAT_T, DM, 0, scr, r, lane); continue; } r -= I_A;
        if (r < I_R) { transpose_item(P.in[20], DM, WCAT_T, DM, 768, scr, r, lane); continue; } r -= I_R;
        if (r < I_X) { transpose_item(P.in[24], DM, WCAT_T, DM, 1536, scr, r, lane); continue; } r -= I_X;
        if (r < I_O) { transpose_item(P.in[25], DM, WOUT_T, DM, 0, scr, r, lane); continue; } r -= I_O;
        transpose_item(P.in[21], 1024, WXKV_T, DM, 0, scr, r, lane);
    }
    bf16* H = (bf16*)(dob + DO_H); bf16* MEMN = (bf16*)(ws + WS_MEMN);
    for (int m = gw; m < M_TOK + MEMROWS; m += NGW) {
        if (m < M_TOK) rms_row_to_bf16(P.in[0] + (size_t)m * DM, P.in[2], H + (size_t)m * DM, lane);
        else rms_row_to_bf16(P.in[1] + (size_t)(m - M_TOK) * DM, P.in[3], MEMN + (size_t)(m - M_TOK) * DM, lane);
    }
    if (blockIdx.x == 0 && tid == 0) __hip_atomic_store((unsigned*)(ws + WS_CTR), 0u, __ATOMIC_RELAXED, __HIP_MEMORY_SCOPE_AGENT);
    bf16* LB = (bf16*)(ws + WS_LORAB);
    const int gt = blockIdx.x * NTHREADS + tid, NGT = G * NTHREADS;
    for (int idx = gt; idx < NLORA * 256; idx += NGT) {
        const int n = idx >> 8, k = idx & 255, d = n / RW, ch = n % RW, kb = k >> 6, kk = k & 63;
        float v = 0.f;
        if (kb == d) v = (d < 2) ? P.in[15][(size_t)(d * 64 + kk) * RW + ch] : P.in[17][(size_t)((d - 2) * 64 + kk) * RW + ch];
        LB[idx] = (bf16)f2bf(v);
    }
    float* RC = (float*)(ws + WS_ROPE); float* RS = RC + SEQ * 32;
    for (int idx = gt; idx < SEQ * 32; idx += NGT) {
        const int pos = idx >> 5, i = idx & 31;
        const float inv = __builtin_exp2f(-(float)i * (13.287712379549449f / 32.f));
        const float ang = (float)pos * inv;
        double rv = (double)ang * 0.15915494309189535; rv -= __builtin_floor(rv);
        const float r = (float)rv;
        RC[idx] = __builtin_amdgcn_cosf(r); RS[idx] = __builtin_amdgcn_sinf(r);
    }
}

__device__ __forceinline__ void p2_lora_in(const Params& P, LAS unsigned char* lds) {
    const bf16* PRE = (const bf16*)(P.ws + WS_PRE); bf16* LIN = (bf16*)((unsigned char*)P.out + DO_LIN); const float* mu = P.in[10];
    const int gt = blockIdx.x * NTHREADS + pg8::mk_tid(lds), NGT = gridDim.x * NTHREADS;
    for (int idx = gt; idx < M_TOK * 32; idx += NGT) {
        const int m = idx >> 5, j = (idx & 31) * 8, t = m & (SEQ - 1);
        const bf16* p = PRE + (size_t)m * NPRE + C_LORA + j;
        const v4u z4 = (v4u){0u, 0u, 0u, 0u};
        const v4u c = *(const v4u*)p, pv = (t > 0) ? *(const v4u*)(p - NPRE) : z4, nx = (t < SEQ - 1) ? *(const v4u*)(p + NPRE) : z4;
        const f32x4 m0 = *(const f32x4*)(mu + 2304 + j), m1 = *(const f32x4*)(mu + 2304 + j + 4);
        float xc[8], xp[8], xn[8], s[8]; unpack8(c, xc); unpack8(pv, xp); unpack8(nx, xn);
#pragma unroll
        for (int i = 0; i < 8; ++i) { const float mm = (i < 4) ? m0[i & 3] : m1[i & 3]; s[i] = xc[i] + mm * (0.5f * (xp[i] + xn[i]) - xc[i]);
            if (j < 128) s[i] = 1.f - 2.f * __builtin_amdgcn_rcpf(__expf(2.f * s[i]) + 1.f); }
        v4u o; o.x = pk2(s[0], s[1]); o.y = pk2(s[2], s[3]); o.z = pk2(s[4], s[5]); o.w = pk2(s[6], s[7]);
        *(v4u*)(LIN + (size_t)m * 256 + j) = o;
    }
}

constexpr int SC_CH = 32, SC_REC = 1536, SC_BUF = SC_CH * SC_REC, SC_SCAL = 2 * SC_BUF;
template <int MODE> __device__ __forceinline__ void scan_block(const Params& P, int sid, LAS unsigned char* lds) {
    const int tid = pg8::mk_tid(lds), lane = tid & 63, wave = __builtin_amdgcn_readfirstlane(tid >> 6);
    const int b = sid / 24, rem = sid % 24, h = rem >> 1, dir = rem & 1;
    const bf16* PRE = (const bf16*)(P.ws + WS_PRE); const bf16* EA = (const bf16*)((unsigned char*)P.out + DO_EA);
    bf16* YO = dir ? (bf16*)(P.ws + WS_YB) : (bf16*)((unsigned char*)P.out + DO_YF);
    constexpr int NCH = SEQ / SC_CH;
#define SC_BAR() do { asm volatile("s_waitcnt lgkmcnt(0)" ::: "memory"); __builtin_amdgcn_s_barrier(); asm volatile("" ::: "memory"); } while (0)
    if (wave >= 4) {
        const int pt = tid - 256, sl = pt >> 3, e = pt & 7, ch0 = h * 64 + 8 * e;
        float mur[8], muk[8], muv[8], kkc[8], kac[8];
#pragma unroll
        for (int i = 0; i < 8; ++i) { mur[i] = P.in[10][ch0 + i]; muk[i] = P.in[10][768 + ch0 + i]; muv[i] = P.in[10][1536 + ch0 + i]; kkc[i] = P.in[11][ch0 + i]; kac[i] = P.in[12][ch0 + i]; }
        v4u rc, kc, vc, rp, kp, vp, rn, kn, vn, e8, a8;
        const v4u z4 = (v4u){0u, 0u, 0u, 0u};
#define SC_PLOAD(c_) do { const int step_ = (c_) * SC_CH + sl, t_ = dir ? (SEQ - 1 - step_) : step_; const size_t m_ = (size_t)b * SEQ + t_; \
            const bf16* rowp_ = PRE + m_ * NPRE + C_RS + ch0; \
            rc = *(const v4u*)(rowp_); kc = *(const v4u*)(rowp_ + 768); vc = *(const v4u*)(rowp_ + 1536); \
            rp = (t_ > 0) ? *(const v4u*)(rowp_ - NPRE) : z4; kp = (t_ > 0) ? *(const v4u*)(rowp_ - NPRE + 768) : z4; vp = (t_ > 0) ? *(const v4u*)(rowp_ - NPRE + 1536) : z4; \
            rn = (t_ < SEQ - 1) ? *(const v4u*)(rowp_ + NPRE) : z4; kn = (t_ < SEQ - 1) ? *(const v4u*)(rowp_ + NPRE + 768) : z4; vn = (t_ < SEQ - 1) ? *(const v4u*)(rowp_ + NPRE + 1536) : z4; \
            const bf16* eap_ = EA + m_ * NLORA + dir * RW + ch0; e8 = *(const v4u*)(eap_); a8 = *(const v4u*)(eap_ + 1536); } while (0)
#define SC_PWRITE(c_) do { LAS unsigned char* buf_ = lds + ((c_) & 1) * SC_BUF; LAS float* scal_ = (LAS float*)(lds + SC_SCAL) + ((c_) & 1) * (SC_CH * 2); \
            float r[8], k[8], v[8], x0[8], x1[8], x2[8]; \
            unpack8(rc, x0); unpack8(rp, x1); unpack8(rn, x2); \
            _Pragma("unroll") for (int i = 0; i < 8; ++i) r[i] = x0[i] + mur[i] * (0.5f * (x1[i] + x2[i]) - x0[i]); \
            unpack8(kc, x0); unpack8(kp, x1); unpack8(kn, x2); \
            _Pragma("unroll") for (int i = 0; i < 8; ++i) k[i] = x0[i] + muk[i] * (0.5f * (x1[i] + x2[i]) - x0[i]); \
            unpack8(vc, x0); unpack8(vp, x1); unpack8(vn, x2); \
            _Pragma("unroll") for (int i = 0; i < 8; ++i) v[i] = x0[i] + muv[i] * (0.5f * (x1[i] + x2[i]) - x0[i]); \
            float ee[8], aa[8]; unpack8(e8, ee); unpack8(a8, aa); \
            float kk[8], ss = 0.f; \
            _Pragma("unroll") for (int i = 0; i < 8; ++i) { kk[i] = k[i] * kkc[i]; ss += kk[i] * kk[i]; } \
            ss = red8(ss); \
            const float inv = 1.f / fmaxf(sqrtf(ss), 1e-12f); \
            float nkk[8], dd[8], dr[8], bb[8], kd[8], sbr = 0.f, skr = 0.f; \
            _Pragma("unroll") for (int i = 0; i < 8; ++i) { \
                const float kki = kk[i] * inv; nkk[i] = -kki; dd[i] = __expf(-ee[i]); dr[i] = dd[i] * r[i]; \
                bb[i] = kki * aa[i]; kd[i] = k[i] * (1.f + (aa[i] - 1.f) * kac[i]); sbr += bb[i] * r[i]; skr += kd[i] * r[i]; } \
            sbr = red8(sbr); skr = red8(skr); \
            LAS float* rec = (LAS float*)(buf_ + sl * SC_REC) + 8 * e; \
            *(LAS f32x4*)(rec) = (f32x4){nkk[0], nkk[1], nkk[2], nkk[3]}; *(LAS f32x4*)(rec + 4) = (f32x4){nkk[4], nkk[5], nkk[6], nkk[7]}; \
            *(LAS f32x4*)(rec + 64) = (f32x4){dr[0], dr[1], dr[2], dr[3]}; *(LAS f32x4*)(rec + 68) = (f32x4){dr[4], dr[5], dr[6], dr[7]}; \
            *(LAS f32x4*)(rec + 128) = (f32x4){dd[0], dd[1], dd[2], dd[3]}; *(LAS f32x4*)(rec + 132) = (f32x4){dd[4], dd[5], dd[6], dd[7]}; \
            *(LAS f32x4*)(rec + 192) = (f32x4){bb[0], bb[1], bb[2], bb[3]}; *(LAS f32x4*)(rec + 196) = (f32x4){bb[4], bb[5], bb[6], bb[7]}; \
            *(LAS f32x4*)(rec + 256) = (f32x4){kd[0], kd[1], kd[2], kd[3]}; *(LAS f32x4*)(rec + 260) = (f32x4){kd[4], kd[5], kd[6], kd[7]}; \
            *(LAS f32x4*)(rec + 320) = (f32x4){v[0], v[1], v[2], v[3]}; *(LAS f32x4*)(rec + 324) = (f32x4){v[4], v[5], v[6], v[7]}; \
            if (e == 0) *(LAS f32x2*)(scal_ + 2 * sl) = (f32x2){sbr, skr}; } while (0)
        if (!(MODE & 2)) { SC_PLOAD(0); SC_PWRITE(0); SC_PLOAD(1); }
        SC_BAR();
        for (int c = 0; c < NCH; ++c) {
            if (!(MODE & 2)) { if (c + 1 < NCH) SC_PWRITE(c + 1);
            if (c + 2 < NCH) SC_PLOAD(c + 2); }
            SC_BAR();
        }
#undef SC_PLOAD
#undef SC_PWRITE
    } else {
        const int rp = (wave * 64 + lane) >> 3, cgp = lane & 7;
        f32x2 s0[4], s1[4];
#pragma unroll
        for (int i = 0; i < 4; ++i) { s0[i] = (f32x2){0.f, 0.f}; s1[i] = (f32x2){0.f, 0.f}; }
        bf16* yrow = YO + (size_t)b * SEQ * RW + h * 64 + 2 * rp;
        SC_BAR();
#define SC_LOAD(N0, N1, Q0, Q1, D0, D1, B0, B1, K0, K1, VV, SS, sl_) do { const LAS float* rec_ = (const LAS float*)(buf + (sl_) * SC_REC) + 8 * cgp; \
            N0 = *(const LAS f32x4*)(rec_); N1 = *(const LAS f32x4*)(rec_ + 4); Q0 = *(const LAS f32x4*)(rec_ + 64); Q1 = *(const LAS f32x4*)(rec_ + 68); \
            D0 = *(const LAS f32x4*)(rec_ + 128); D1 = *(const LAS f32x4*)(rec_ + 132); B0 = *(const LAS f32x4*)(rec_ + 192); B1 = *(const LAS f32x4*)(rec_ + 196); \
            K0 = *(const LAS f32x4*)(rec_ + 256); K1 = *(const LAS f32x4*)(rec_ + 260); \
            VV = *(const LAS f32x2*)((const LAS float*)(buf + (sl_) * SC_REC) + 320 + 2 * rp); SS = *(const LAS f32x2*)(scal + 2 * (sl_)); } while (0)
        for (int c = 0; c < NCH; ++c) {
            const LAS unsigned char* buf = lds + (c & 1) * SC_BUF; const LAS float* scal = (const LAS float*)(lds + SC_SCAL) + (c & 1) * (SC_CH * 2);
            f32x4 n0, n1, q0, q1, d0, d1, b0, b1, k0, k1; f32x2 vv, sc;
            SC_LOAD(n0, n1, q0, q1, d0, d1, b0, b1, k0, k1, vv, sc, 0);
#pragma unroll 2
            for (int sl = 0; sl < SC_CH; ++sl) {
                f32x4 xn0, xn1, xq0, xq1, xd0, xd1, xb0, xb1, xk0, xk1; f32x2 xvv, xsc;
                const int sn = (sl + 1 < SC_CH) ? sl + 1 : sl;
                const f32x2 nk[4] = {(f32x2){n0.x, n0.y}, (f32x2){n0.z, n0.w}, (f32x2){n1.x, n1.y}, (f32x2){n1.z, n1.w}};
                const f32x2 qq[4] = {(f32x2){q0.x, q0.y}, (f32x2){q0.z, q0.w}, (f32x2){q1.x, q1.y}, (f32x2){q1.z, q1.w}};
                const f32x2 dv[4] = {(f32x2){d0.x, d0.y}, (f32x2){d0.z, d0.w}, (f32x2){d1.x, d1.y}, (f32x2){d1.z, d1.w}};
                const f32x2 bv[4] = {(f32x2){b0.x, b0.y}, (f32x2){b0.z, b0.w}, (f32x2){b1.x, b1.y}, (f32x2){b1.z, b1.w}};
                const f32x2 kv[4] = {(f32x2){k0.x, k0.y}, (f32x2){k0.z, k0.w}, (f32x2){k1.x, k1.y}, (f32x2){k1.z, k1.w}};
                f32x2 a0 = s0[0] * nk[0], a1 = s1[0] * nk[0], y0 = s0[0] * qq[0], y1 = s1[0] * qq[0];
#pragma unroll
                for (int i = 1; i < 4; ++i) { a0 = s0[i] * nk[i] + a0; a1 = s1[i] * nk[i] + a1; y0 = s0[i] * qq[i] + y0; y1 = s1[i] * qq[i] + y1; }
                float sa0 = a0.x + a0.y, sa1 = a1.x + a1.y, yp0 = y0.x + y0.y, yp1 = y1.x + y1.y;
                SC_LOAD(xn0, xn1, xq0, xq1, xd0, xd1, xb0, xb1, xk0, xk1, xvv, xsc, sn);
                sa0 = red8(sa0); sa1 = red8(sa1); yp0 = red8(yp0); yp1 = red8(yp1);
                const float yo0 = yp0 + sa0 * sc.x + vv.x * sc.y, yo1 = yp1 + sa1 * sc.x + vv.y * sc.y;
                const f32x2 sa0v = (f32x2){sa0, sa0}, sa1v = (f32x2){sa1, sa1}, v0v = (f32x2){vv.x, vv.x}, v1v = (f32x2){vv.y, vv.y};
#pragma unroll
                for (int i = 0; i < 4; ++i) {
                    f32x2 t0 = v0v * kv[i]; t0 = sa0v * bv[i] + t0; s0[i] = s0[i] * dv[i] + t0;
                    f32x2 t1 = v1v * kv[i]; t1 = sa1v * bv[i] + t1; s1[i] = s1[i] * dv[i] + t1;
                }
                const int step = c * SC_CH + sl, t = dir ? (SEQ - 1 - step) : step;
                const unsigned yw = pk2(yo0, yo1);
                if (!(MODE & 1)) { if (cgp == 0) *(unsigned*)(yrow + (size_t)t * RW) = yw; } else { asm volatile("" :: "v"(yw)); }
                n0 = xn0; n1 = xn1; q0 = xq0; q1 = xq1; d0 = xd0; d1 = xd1; b0 = xb0; b1 = xb1; k0 = xk0; k1 = xk1; vv = xvv; sc = xsc;
            }
            SC_BAR();
        }
#undef SC_LOAD
    }
#undef SC_BAR
    __syncthreads();
}

__device__ __forceinline__ bf16x8 pack8(const float (&x)[8]) {
    v4u w; w.x = pk2(x[0], x[1]); w.y = pk2(x[2], x[3]); w.z = pk2(x[4], x[5]); w.w = pk2(x[6], x[7]); return __builtin_bit_cast(bf16x8, w);
}
#define MFMA16(a, b, c) __builtin_amdgcn_mfma_f32_16x16x32_bf16((a), (b), (c), 0, 0, 0)
constexpr int CK = 16, NCK = SEQ / CK;
constexpr int L_QK = 0, L_PR = 4608, L_QKT = 9216, L_VT = 14336, L_VF = 19456, L_GC = 23552, L_OPSZ = 23808;
constexpr int WP = 68, L_WSZ = 16 * WP * 4;
constexpr int L_E = 2 * L_OPSZ, L_G = L_E + 4096, L_GSZ = 5120, L_W0 = L_G + 2 * L_GSZ, L_VG = L_W0 + L_WSZ, L_SB = L_VG + 2 * L_WSZ, L_CEND = L_SB + 9216;
constexpr int L_GTP = L_CEND + 1536;
static_assert(L_GTP + 2048 <= 131072, "chunked scan LDS map");
#ifdef CBAR_FULL
#define CBAR() __syncthreads()
#else
#define CBAR() do { __builtin_amdgcn_s_waitcnt(0xC07F); __builtin_amdgcn_s_barrier(); } while (0)
#endif
__device__ __forceinline__ void scan_chunked(const Params& P, int sid, LAS unsigned char* lds) {
    const int tid = pg8::mk_tid(lds), lane = tid & 63, wave = __builtin_amdgcn_readfirstlane(tid >> 6), l15 = lane & 15, q4 = lane >> 4;
    const int b = sid / 24, rem = sid % 24, h = rem >> 1, dir = rem & 1;
    const bf16* PRE = (const bf16*)(P.ws + WS_PRE); const bf16* EA = (const bf16*)((unsigned char*)P.out + DO_EA);
    bf16* YO = dir ? (bf16*)(P.ws + WS_YB) : (bf16*)((unsigned char*)P.out + DO_YF);
#ifdef YZERO
    for (int it = tid; it < SEQ * 8; it += NTHREADS) *(v4u*)(YO + ((size_t)b * SEQ + (it >> 3)) * RW + h * 64 + (it & 7) * 8) = (v4u){0u, 0u, 0u, 0u};
#endif
    for (int i = tid; i < 9216 / 4; i += NTHREADS) ((LAS unsigned*)(lds + L_SB))[i] = 0u;
    for (int i = tid; i < L_SB / 4; i += NTHREADS) ((LAS unsigned*)(lds))[i] = 0u;
    if (tid < 384) { const int vsel = tid >> 6, chn = h * 64 + (tid & 63);
        ((LAS float*)(lds + L_CEND))[tid] = (vsel < 3) ? P.in[10][vsel * 768 + chn] : ((vsel == 3) ? P.in[11][chn] : ((vsel == 4) ? P.in[12][chn] : P.in[13][chn])); }
    CBAR();
    if (wave >= 4) {
        const int pt = tid - 256, t = pt >> 4, e = pt & 15, ch0 = h * 64 + 4 * e, gsw = 8 * ((e >> 1) & 3);
        float* BON = (float*)(P.ws + WS_BON);
        const LAS float* cst = (const LAS float*)(lds + L_CEND) + 4 * e;
        v2u rcA, kcA, vcA, rpA, kpA, vpA, rnA, knA, vnA, e8A, a8A, rcB, kcB, vcB, rpB, kpB, vpB, rnB, knB, vnB, e8B, a8B;
        const v2u z2 = (v2u){0u, 0u};
#define CK_PLOAD(X, c_) do { const int step_ = (c_) * CK + t, t_ = dir ? (SEQ - 1 - step_) : step_; const size_t m_ = (size_t)b * SEQ + t_; \
            const bf16* rowp_ = PRE + m_ * NPRE + C_RS + ch0; \
            const bf16* rowq_ = (t_ > 0) ? rowp_ - NPRE : rowp_; const bf16* rown_ = (t_ < SEQ - 1) ? rowp_ + NPRE : rowp_;     \
            rc##X = *(const v2u*)(rowp_); kc##X = *(const v2u*)(rowp_ + 768); vc##X = *(const v2u*)(rowp_ + 1536); \
            rp##X = *(const v2u*)(rowq_); kp##X = *(const v2u*)(rowq_ + 768); vp##X = *(const v2u*)(rowq_ + 1536); \
            rn##X = *(const v2u*)(rown_); kn##X = *(const v2u*)(rown_ + 768); vn##X = *(const v2u*)(rown_ + 1536); \
            const bf16* eap_ = EA + m_ * NLORA + dir * RW + ch0; e8##X = *(const v2u*)(eap_); a8##X = *(const v2u*)(eap_ + 1536); } while (0)
        CK_PLOAD(A, 0); CK_PLOAD(B, 1);
        float r[4], k[4], v[4], kk[4], aa[4], ee[4];
#define CK_PBODY(X, c_) do { const int c = (c_); const int pb = (c & 1) * L_OPSZ; \
            {   \
                float x0[4], x1[4], x2[4]; f32x4 cc; \
                const int stepc_ = ((c < NCK) ? c : NCK - 1) * CK + t, tc_ = dir ? (SEQ - 1 - stepc_) : stepc_; const float fp_ = (tc_ > 0) ? 1.f : 0.f, fn_ = (tc_ < SEQ - 1) ? 1.f : 0.f; \
                unpack4(rc##X, x0); unpack4(rp##X, x1); unpack4(rn##X, x2); cc = *(const LAS f32x4*)(cst); \
                _Pragma("unroll") for (int i = 0; i < 4; ++i) r[i] = x0[i] + cc[i] * (0.5f * (fp_ * x1[i] + fn_ * x2[i]) - x0[i]); \
                unpack4(kc##X, x0); unpack4(kp##X, x1); unpack4(kn##X, x2); cc = *(const LAS f32x4*)(cst + 64); \
                _Pragma("unroll") for (int i = 0; i < 4; ++i) k[i] = x0[i] + cc[i] * (0.5f * (fp_ * x1[i] + fn_ * x2[i]) - x0[i]); \
                unpack4(vc##X, x0); unpack4(vp##X, x1); unpack4(vn##X, x2); cc = *(const LAS f32x4*)(cst + 128); \
                _Pragma("unroll") for (int i = 0; i < 4; ++i) v[i] = x0[i] + cc[i] * (0.5f * (fp_ * x1[i] + fn_ * x2[i]) - x0[i]); \
                unpack4(e8##X, ee); unpack4(a8##X, aa); cc = *(const LAS f32x4*)(cst + 192); \
                float ss = 0.f; \
                _Pragma("unroll") for (int i = 0; i < 4; ++i) { kk[i] = k[i] * cc[i]; ss += kk[i] * kk[i]; } \
                ss = red8(ss); ss = dpp_add<0x140>(ss); \
                const float inv = __builtin_amdgcn_rcpf(fmaxf(__builtin_amdgcn_sqrtf(ss), 1e-12f)); \
                _Pragma("unroll") for (int i = 0; i < 4; ++i) kk[i] *= inv; \
                *(LAS f32x4*)((LAS float*)(lds + L_E) + t * 64 + 4 * e) = (f32x4){ee[0], ee[1], ee[2], ee[3]}; \
                CK_PLOAD(X, (c + 2 < NCK) ? c + 2 : NCK - 1); \
            } \
            CBAR(); \
            { \
                f32x4 gs = (f32x4){0.f, 0.f, 0.f, 0.f}; \
                _Pragma("unroll") for (int u = 0; u < CK; ++u) { \
                    const f32x4 ea = *(const LAS f32x4*)((const LAS float*)(lds + L_E) + u * 64 + 4 * e); \
                    const float m = (u <= t) ? 1.f : 0.f; gs += m * ea; } \
                const f32x4 kac = *(const LAS f32x4*)(cst + 256), rkc = *(const LAS f32x4*)(cst + 320); float bpart = 0.f; \
                float qv[4], kt[4], pv[4], rt[4], gin[4]; \
                _Pragma("unroll") for (int i = 0; i < 4; ++i) { \
                    gin[i] = __expf(-gs[i]); const float gex = __expf(ee[i] - gs[i]), ginv = __expf(gs[i]); \
                    const float kd = k[i] * (1.f + (aa[i] - 1.f) * kac[i]); \
                    qv[i] = kk[i] * aa[i] * ginv; kt[i] = kd * ginv; pv[i] = kk[i] * gex; rt[i] = r[i] * gin[i]; bpart += r[i] * kd * rkc[i]; \
                } \
                LAS unsigned char* ob = lds + pb; \
                unsigned wq[4]; v2u o; \
                _Pragma("unroll") for (int i = 0; i < 4; ++i) wq[i] = pk2(qv[i], kt[i]);                        \
                o.x = (wq[0] & 0xffffu) | (wq[1] << 16); o.y = (wq[2] & 0xffffu) | (wq[3] << 16); *(LAS v2u*)(ob + L_QK + (t * 72 + 4 * e) * 2) = o; \
                o.x = (wq[0] >> 16) | (wq[1] & 0xffff0000u); o.y = (wq[2] >> 16) | (wq[3] & 0xffff0000u); *(LAS v2u*)(ob + L_QK + ((16 + t) * 72 + 4 * e) * 2) = o; \
                o.x = pk2(pv[0], pv[1]); o.y = pk2(pv[2], pv[3]); *(LAS v2u*)(ob + L_PR + (t * 72 + 4 * e) * 2) = o; \
                o.x = pk2(rt[0], rt[1]); o.y = pk2(rt[2], rt[3]); *(LAS v2u*)(ob + L_PR + ((16 + t) * 72 + 4 * e) * 2) = o; \
                const unsigned wv01 = pk2(v[0], v[1]), wv23 = pk2(v[2], v[3]); \
                _Pragma("unroll") for (int i = 0; i < 4; ++i) { \
                    *(LAS bf16*)(ob + L_QKT + ((4 * e + i) * 40 + (t ^ gsw)) * 2) = (bf16)(wq[i] & 0xffffu); *(LAS bf16*)(ob + L_QKT + ((4 * e + i) * 40 + ((16 + t) ^ gsw)) * 2) = (bf16)(wq[i] >> 16); \
                    const unsigned wv = (i < 2) ? wv01 : wv23; \
                    *(LAS bf16*)(ob + L_VT + ((4 * e + i) * 40 + ((16 + t) ^ gsw)) * 2) = (bf16)((i & 1) ? (wv >> 16) : (wv & 0xffffu)); \
                } \
                if (t == CK - 1) *(LAS f32x4*)((LAS float*)(ob + L_GC) + 4 * e) = (f32x4){gin[0], gin[1], gin[2], gin[3]}; \
                bpart = red8(bpart); bpart = dpp_add<0x140>(bpart); \
                if (e == 0) { const int stb_ = ((c < NCK) ? c : NCK - 1) * CK + t, tb_ = dir ? (SEQ - 1 - stb_) : stb_; BON[((size_t)dir * M_TOK + (size_t)b * SEQ + tb_) * 12 + h] = bpart; } \
            } \
            CBAR(); \
            CBAR(); } while (0)
        static_assert((NCK + 2) % 2 == 0, "producer loop is unrolled by two");
        for (int c2 = 0; c2 <= NCK + 1; c2 += 2) { CK_PBODY(A, c2); CK_PBODY(B, c2 + 1); }
#undef CK_PBODY
#undef CK_PLOAD
    } else {
        const int w = wave;
        f32x4 acc[4];
#pragma unroll
        for (int nt = 0; nt < 4; ++nt) acc[nt] = (f32x4){0.f, 0.f, 0.f, 0.f};
        bf16* ybase = YO + (size_t)b * SEQ * RW + h * 64 + 16 * w + 4 * q4;
        for (int c = 0; c <= NCK + 1; ++c) {
            const int ck = c - 1; const bool valid = (ck >= 0 && ck < NCK);
            const int pb = (ck & 1) * L_OPSZ, gb = L_G + (ck & 1) * L_GSZ;
            f32x4 r1 = (f32x4){0.f, 0.f, 0.f, 0.f};
            if (valid) {
                f32x4 r0 = (f32x4){0.f, 0.f, 0.f, 0.f};
#pragma unroll
                for (int ks = 0; ks < 2; ++ks) {
                    const bf16x8 S = *(const LAS bf16x8*)(lds + L_SB + ((16 * w + l15) * 72 + ks * 32 + 8 * q4) * 2);
                    const bf16x8 Bp = *(const LAS bf16x8*)(lds + pb + L_PR + ((l15) * 72 + ks * 32 + 8 * q4) * 2);
                    const bf16x8 Br = *(const LAS bf16x8*)(lds + pb + L_PR + ((16 + l15) * 72 + ks * 32 + 8 * q4) * 2);
                    r0 = MFMA16(S, Bp, r0); r1 = MFMA16(S, Br, r1);
                }
                *(LAS f32x4*)(lds + L_W0 + (l15 * WP + 16 * w + 4 * q4) * 4) = r0;
            }
            if (valid && w == 1) {
#pragma unroll
                for (int x = 0; x < 4; ++x) {
                    const int a = x >> 1, bc = x & 1;
                    f32x4 g = (f32x4){0.f, 0.f, 0.f, 0.f};
#pragma unroll
                    for (int ks = 0; ks < 2; ++ks) {
                        const bf16x8 A = *(const LAS bf16x8*)(lds + pb + L_QK + ((a * 16 + l15) * 72 + ks * 32 + 8 * q4) * 2);
                        const bf16x8 Bm = *(const LAS bf16x8*)(lds + pb + L_PR + ((bc * 16 + l15) * 72 + ks * 32 + 8 * q4) * 2);
                        g = MFMA16(A, Bm, g);
                    }
                    *(LAS f32x4*)(lds + gb + x * 1280 + (l15 * 20 + 4 * q4) * 4) = g;
                    if (x == 0) {
#pragma unroll
                        for (int ii = 0; ii < 4; ++ii) *(LAS float*)(lds + L_GTP + (ck & 1) * 1024 + (l15 * 16 + ii * 4 + q4) * 4) = (4 * q4 + ii < l15) ? g[ii] : 0.f;
                    }
                }
                __builtin_amdgcn_s_waitcnt(0xC07F);
                float bw[8];
                {
                    const f32x4 ga = *(const LAS f32x4*)(lds + gb + 2 * 1280 + (l15 * 20 + 8 * (q4 & 1)) * 4), gb2 = *(const LAS f32x4*)(lds + gb + 2 * 1280 + (l15 * 20 + 8 * (q4 & 1) + 4) * 4);
#pragma unroll
                    for (int ii = 0; ii < 8; ++ii) { const int s = 8 * (q4 & 1) + ii; const float gv = (ii < 4) ? ga[ii & 3] : gb2[ii & 3]; bw[ii] = (q4 >= 2 && s < l15) ? gv : 0.f; }
                }
                const bf16x8 Bf = pack8(bw);
#pragma unroll
                for (int mt = 0; mt < 4; ++mt) {
                    const bf16x8 Av = *(const LAS bf16x8*)(lds + pb + L_VT + ((mt * 16 + l15) * 40 + 8 * (q4 ^ (((mt * 16 + l15) >> 3) & 3))) * 2);
                    f32x4 r = (f32x4){0.f, 0.f, 0.f, 0.f};
                    r = MFMA16(Av, Bf, r);
                    *(LAS f32x4*)(lds + L_VG + (ck & 1) * L_WSZ + (l15 * WP + mt * 16 + 4 * q4) * 4) = r;
                }
            }
            CBAR();
            if (valid) {
                const int rr = lane >> 2, qq = lane & 3, i = 16 * w + rr;
                float cown[4], uown[4];
#pragma unroll
                for (int k = 0; k < 4; ++k) { const int t = 4 * k + qq; uown[k] = 0.f;
                    cown[k] = *(const LAS float*)(lds + L_W0 + (t * WP + i) * 4) + *(const LAS float*)(lds + L_VG + (ck & 1) * L_WSZ + (t * WP + i) * 4); }
                const LAS float* gtp = (const LAS float*)(lds + L_GTP + (ck & 1) * 1024) + qq * 4;
#pragma unroll
                for (int t = 0; t < 16; ++t) {
                    const f32x4 g4 = *(const LAS f32x4*)(gtp + t * 16);
                    float part = (g4[0] * uown[0] + g4[1] * uown[1]) + (g4[2] * uown[2] + g4[3] * uown[3]);
                    part = dpp_add<0xB1>(part); part = dpp_add<0x4E>(part);
                    const float cand = cown[t >> 2] - part;
                    uown[t >> 2] = (qq == (t & 3)) ? cand : uown[t >> 2];
                }
                const int gsw = 8 * ((i >> 3) & 3);
#pragma unroll
                for (int k = 0; k < 4; ++k) { const int t = 4 * k + qq;
                    *(LAS bf16*)(lds + pb + L_VT + (i * 40 + (t ^ gsw)) * 2) = (bf16)(pk2(-uown[k], 0.f) & 0xffffu); }
            }
            CBAR();
            if (valid) {
                const bf16x8 Bv = *(const LAS bf16x8*)(lds + pb + L_VT + ((16 * w + l15) * 40 + 8 * (q4 ^ (((16 * w + l15) >> 3) & 3))) * 2);
                {
                    const int xo = (q4 < 2) ? 1 : 3;
                    const f32x4 ga = *(const LAS f32x4*)(lds + gb + xo * 1280 + (l15 * 20 + 8 * (q4 & 1)) * 4), gb2 = *(const LAS f32x4*)(lds + gb + xo * 1280 + (l15 * 20 + 8 * (q4 & 1) + 4) * 4);
                    float bw[8];
#pragma unroll
                    for (int ii = 0; ii < 8; ++ii) { const int s = 8 * (q4 & 1) + ii; const float gv = (ii < 4) ? ga[ii & 3] : gb2[ii & 3]; bw[ii] = (s <= l15) ? gv : 0.f; }
                    const f32x4 y = MFMA16(Bv, pack8(bw), r1);
                    const int step = ck * CK + l15, tt = dir ? (SEQ - 1 - step) : step;
                    v2u o; o.x = pk2(y[0], y[1]); o.y = pk2(y[2], y[3]);
                    *(v2u*)(ybase + (size_t)tt * RW) = o;
                }
#pragma unroll
                for (int nt = 0; nt < 4; ++nt) {
                    const bf16x8 Aq = *(const LAS bf16x8*)(lds + pb + L_QKT + ((nt * 16 + l15) * 40 + 8 * (q4 ^ (((nt * 16 + l15) >> 3) & 3))) * 2);
                    acc[nt] = MFMA16(Aq, Bv, acc[nt]);
                    const f32x4 gc = *(const LAS f32x4*)(lds + pb + L_GC + (nt * 16 + 4 * q4) * 4);
                    acc[nt] = acc[nt] * gc;
                    v2u o; o.x = pk2(acc[nt][0], acc[nt][1]); o.y = pk2(acc[nt][2], acc[nt][3]);
                    *(LAS v2u*)(lds + L_SB + ((16 * w + l15) * 72 + nt * 16 + 4 * q4) * 2) = o;
                }
            }
            CBAR();
        }
    }
    __syncthreads();
}
#undef CBAR

constexpr int KA_P = 72, VA_P = 392;
__device__ __forceinline__ void attnA_item(const Params& P, int item, LAS unsigned char* lds) {
    const int tid = pg8::mk_tid(lds), lane = tid & 63, wave = __builtin_amdgcn_readfirstlane(tid >> 6), l15 = lane & 15, q4 = lane >> 4;
    const int b = item >> 6, n = (item >> 2) & 15, hk = item & 3;
    const bf16* PRE = (const bf16*)(P.ws + WS_PRE); bf16* YC = (bf16*)(P.ws + WS_YCAT);
    const float* RC = (const float*)(P.ws + WS_ROPE); const float* RS = RC + SEQ * 32;
    LAS bf16* Ks = (LAS bf16*)lds; LAS bf16* Vt = Ks + 384 * KA_P;
    {
        v2u klo[6], khi[6]; f32x4 kcs[6], ksn[6]; v4u vw[6];
#pragma unroll
        for (int u = 0; u < 6; ++u) {
            const int it = tid + u * NTHREADS, j = it >> 3, c = it & 7, kp = (n - 1) * 128 + j;
            const bool ok = (kp >= 0 && kp < SEQ); const int kpc = ok ? kp : 0;
            const bf16* src = PRE + ((size_t)b * SEQ + kpc) * NPRE + C_AK + hk * 64;
            klo[u] = *(const v2u*)(src + 4 * c); khi[u] = *(const v2u*)(src + 32 + 4 * c);
            kcs[u] = *(const f32x4*)(RC + kpc * 32 + 4 * c); ksn[u] = *(const f32x4*)(RS + kpc * 32 + 4 * c);
            vw[u] = *(const v4u*)(PRE + ((size_t)b * SEQ + kpc) * NPRE + C_AV + hk * 64 + 8 * c);
        }
        const f32x4 g1 = *(const f32x4*)(P.in[7] + 4 * (tid & 7)), g2 = *(const f32x4*)(P.in[7] + 32 + 4 * (tid & 7));
#pragma unroll
        for (int u = 0; u < 6; ++u) {
            const int it = tid + u * NTHREADS, j = it >> 3, c = it & 7, kp = (n - 1) * 128 + j;
            const bool ok = (kp >= 0 && kp < SEQ);
            float x1[4], x2[4]; unpack4(klo[u], x1); unpack4(khi[u], x2);
            float ss = 0.f;
#pragma unroll
            for (int i = 0; i < 4; ++i) ss += x1[i] * x1[i] + x2[i] * x2[i];
            ss = red8(ss);
            const float rstd = ok ? 1.f / sqrtf(ss * (1.f / 64.f) + NORM_EPS) : 0.f;
            float r1[4], r2[4];
#pragma unroll
            for (int i = 0; i < 4; ++i) { const float y1 = x1[i] * rstd * g1[i], y2 = x2[i] * rstd * g2[i]; r1[i] = y1 * kcs[u][i] - y2 * ksn[u][i]; r2[i] = y2 * kcs[u][i] + y1 * ksn[u][i]; }
            v2u o0, o1; o0.x = pk2(r1[0], r1[1]); o0.y = pk2(r1[2], r1[3]); o1.x = pk2(r2[0], r2[1]); o1.y = pk2(r2[2], r2[3]);
            *(LAS v2u*)(Ks + j * KA_P + 4 * c) = o0; *(LAS v2u*)(Ks + j * KA_P + 32 + 4 * c) = o1;
            const v4u w = ok ? vw[u] : (v4u){0u, 0u, 0u, 0u};
            LAS bf16* d = Vt + (8 * c) * VA_P + j;
            d[0] = (bf16)(w.x & 0xffffu); d[VA_P] = (bf16)(w.x >> 16); d[2 * VA_P] = (bf16)(w.y & 0xffffu); d[3 * VA_P] = (bf16)(w.y >> 16);
            d[4 * VA_P] = (bf16)(w.z & 0xffffu); d[5 * VA_P] = (bf16)(w.z >> 16); d[6 * VA_P] = (bf16)(w.w & 0xffffu); d[7 * VA_P] = (bf16)(w.w >> 16);
        }
    }
    v4u qlo, qhi;
    {
        const int R0 = wave * 48, g = R0 >> 7, pos = (R0 & 127) + l15, qp = n * 128 + pos, hq = hk * 3 + g;
        const bf16* src = PRE + ((size_t)b * SEQ + qp) * NPRE + C_AQ + hq * 64;
        qlo = *(const v4u*)(src + 8 * q4); qhi = *(const v4u*)(src + 32 + 8 * q4);
    }
    __syncthreads();
#pragma unroll 1
    for (int mt = 0; mt < 3; ++mt) {
        const int R0 = wave * 48 + mt * 16, g = R0 >> 7, pos = (R0 & 127) + l15, qp = n * 128 + pos, hq = hk * 3 + g;
        const size_t m = (size_t)b * SEQ + qp;
        v2u gat[4];
#pragma unroll
        for (int dt = 0; dt < 4; ++dt) gat[dt] = *(const v2u*)(PRE + m * NPRE + C_AG + hq * 64 + dt * 16 + 4 * q4);
        const v4u cqlo = qlo, cqhi = qhi;
        {
            const int mn = (mt < 2) ? mt + 1 : 2, R1 = wave * 48 + mn * 16, g1_ = R1 >> 7, pos1 = (R1 & 127) + l15, qp1 = n * 128 + pos1, hq1 = hk * 3 + g1_;
            const bf16* src = PRE + ((size_t)b * SEQ + qp1) * NPRE + C_AQ + hq1 * 64;
            qlo = *(const v4u*)(src + 8 * q4); qhi = *(const v4u*)(src + 32 + 8 * q4);
        }
        bf16x8 qf0, qf1;
        {
            float x1[8], x2[8]; unpack8(cqlo, x1); unpack8(cqhi, x2);
            float ss = 0.f;
#pragma unroll
            for (int i = 0; i < 8; ++i) ss += x1[i] * x1[i] + x2[i] * x2[i];
            ss += __shfl_xor(ss, 16); ss += __shfl_xor(ss, 32);
            const float rstd = (0.125f * 1.4426950408889634f) / sqrtf(ss * (1.f / 64.f) + NORM_EPS);
            float r1[8], r2[8];
            const f32x4 ga = *(const f32x4*)(P.in[6] + 8 * q4), gb = *(const f32x4*)(P.in[6] + 8 * q4 + 4), gc = *(const f32x4*)(P.in[6] + 32 + 8 * q4), gd = *(const f32x4*)(P.in[6] + 36 + 8 * q4);
            const f32x4 ca = *(const f32x4*)(RC + qp * 32 + 8 * q4), cb = *(const f32x4*)(RC + qp * 32 + 8 * q4 + 4), sa_ = *(const f32x4*)(RS + qp * 32 + 8 * q4), sb_ = *(const f32x4*)(RS + qp * 32 + 8 * q4 + 4);
#pragma unroll
            for (int i = 0; i < 8; ++i) {
                const float g1 = (i < 4) ? ga[i & 3] : gb[i & 3], g2 = (i < 4) ? gc[i & 3] : gd[i & 3], cs = (i < 4) ? ca[i & 3] : cb[i & 3], sn = (i < 4) ? sa_[i & 3] : sb_[i & 3];
                const float y1 = x1[i] * rstd * g1, y2 = x2[i] * rstd * g2; r1[i] = y1 * cs - y2 * sn; r2[i] = y2 * cs + y1 * sn;
            }
            qf0 = pack8(r1); qf1 = pack8(r2);
        }
        const int kt0 = (R0 & 127) >> 4;
        const int seq_lo = (n == 0) ? 8 : 0, seq_hi = (n == 15) ? 15 : 23;
        f32x4 acc[18];
#pragma unroll
        for (int u = 0; u < 17; ++u) {
            const LAS bf16* kr = Ks + ((kt0 + u) * 16 + l15) * KA_P + 8 * q4;
            const bf16x8 k0 = *(const LAS bf16x8*)(kr), k1 = *(const LAS bf16x8*)(kr + 32);
            f32x4 a = (f32x4){0.f, 0.f, 0.f, 0.f};
            a = MFMA16(k0, qf0, a); a = MFMA16(k1, qf1, a); acc[u] = a;
        }
        acc[17] = (f32x4){-1e30f, -1e30f, -1e30f, -1e30f};
        const float sink = P.in[8][hq] * 1.4426950408889634f;
        float mx = sink;
#pragma unroll
        for (int u = 0; u < 17; ++u) {
            const bool tv = (kt0 + u >= seq_lo) && (kt0 + u <= seq_hi);
#pragma unroll
            for (int i = 0; i < 4; ++i) {
                bool valid = tv;
                if (u == 0) valid = valid && (4 * q4 + i >= l15);
                if (u == 16) valid = valid && (4 * q4 + i <= l15);
                const float sv = valid ? acc[u][i] : -1e30f; acc[u][i] = sv; mx = fmaxf(mx, sv);
            }
        }
        mx = fmaxf(mx, __shfl_xor(mx, 16)); mx = fmaxf(mx, __shfl_xor(mx, 32));
        float sum = 0.f;
#pragma unroll
        for (int u = 0; u < 17; ++u)
#pragma unroll
            for (int i = 0; i < 4; ++i) { const float p = __builtin_amdgcn_exp2f(acc[u][i] - mx); acc[u][i] = p; sum += p; }
        acc[17] = (f32x4){0.f, 0.f, 0.f, 0.f};
        sum += __shfl_xor(sum, 16); sum += __shfl_xor(sum, 32);
        const float inv = 1.f / (sum + __builtin_amdgcn_exp2f(sink - mx));
        f32x4 o[4];
#pragma unroll
        for (int dt = 0; dt < 4; ++dt) o[dt] = (f32x4){0.f, 0.f, 0.f, 0.f};
#pragma unroll
        for (int k2 = 0; k2 < 9; ++k2) {
            float pp[8] = {acc[2 * k2][0], acc[2 * k2][1], acc[2 * k2][2], acc[2 * k2][3], acc[2 * k2 + 1][0], acc[2 * k2 + 1][1], acc[2 * k2 + 1][2], acc[2 * k2 + 1][3]};
            const bf16x8 pf = pack8(pp);
#pragma unroll
            for (int dt = 0; dt < 4; ++dt) {
                const LAS bf16* vr = Vt + (dt * 16 + l15) * VA_P + kt0 * 16 + k2 * 32 + 4 * q4;
                const v2u v0 = *(const LAS v2u*)(vr);
                v2u v1 = (v2u){0u, 0u};
                if (k2 < 8) v1 = *(const LAS v2u*)(vr + 16);
                const v4u vw = (v4u){v0.x, v0.y, v1.x, v1.y};
                o[dt] = MFMA16(__builtin_bit_cast(bf16x8, vw), pf, o[dt]);
            }
        }
#pragma unroll
        for (int dt = 0; dt < 4; ++dt) {
            const int ch = hq * 64 + dt * 16 + 4 * q4;
            float gg[4]; unpack4(gat[dt], gg);
            v2u w; w.x = pk2(o[dt][0] * inv * gg[0], o[dt][1] * inv * gg[1]); w.y = pk2(o[dt][2] * inv * gg[2], o[dt][3] * inv * gg[3]);
            *(v2u*)(YC + m * DM + ch) = w;
        }
    }
    __syncthreads();
}

constexpr int KC_P = 136, VC_P = 264;
__device__ __forceinline__ void attnC_qblock(const Params& P, const LAS bf16* Ks, const LAS bf16* Vt, bf16* YC, const v4u (&qraw)[4], const v2u (&gat)[8], size_t m, int hx, int l15, int q4) {
    {
        bf16x8 qf[4];
        {
            float x[4][8]; float ss = 0.f;
#pragma unroll
            for (int ks = 0; ks < 4; ++ks) { unpack8(qraw[ks], x[ks]);
#pragma unroll
                for (int i = 0; i < 8; ++i) ss += x[ks][i] * x[ks][i]; }
            ss += __shfl_xor(ss, 16); ss += __shfl_xor(ss, 32);
            const float rstd = (0.08838834764831845f * 1.4426950408889634f) / sqrtf(ss * (1.f / 128.f) + NORM_EPS);
#pragma unroll
            for (int ks = 0; ks < 4; ++ks) { float y[8];
                const f32x4 ga = *(const f32x4*)(P.in[22] + ks * 32 + 8 * q4), gb = *(const f32x4*)(P.in[22] + ks * 32 + 8 * q4 + 4);
#pragma unroll
                for (int i = 0; i < 8; ++i) y[i] = x[ks][i] * rstd * ((i < 4) ? ga[i & 3] : gb[i & 3]);
                qf[ks] = pack8(y); }
        }
        f32x4 acc[16];
#pragma unroll
        for (int kt = 0; kt < 16; ++kt) {
            const LAS bf16* kr = Ks + (kt * 16 + l15) * KC_P + 8 * q4;
            f32x4 a = (f32x4){0.f, 0.f, 0.f, 0.f};
#pragma unroll
            for (int ks = 0; ks < 4; ++ks) a = MFMA16(*(const LAS bf16x8*)(kr + ks * 32), qf[ks], a);
            acc[kt] = a;
        }
        float mx = -1e30f;
#pragma unroll
        for (int kt = 0; kt < 16; ++kt)
#pragma unroll
            for (int i = 0; i < 4; ++i) mx = fmaxf(mx, acc[kt][i]);
        mx = fmaxf(mx, __shfl_xor(mx, 16)); mx = fmaxf(mx, __shfl_xor(mx, 32));
        float sum = 0.f;
#pragma unroll
        for (int kt = 0; kt < 16; ++kt)
#pragma unroll
            for (int i = 0; i < 4; ++i) { const float p = __builtin_amdgcn_exp2f(acc[kt][i] - mx); acc[kt][i] = p; sum += p; }
        sum += __shfl_xor(sum, 16); sum += __shfl_xor(sum, 32);
        const float inv = 1.f / sum;
        f32x4 o[8];
#pragma unroll
        for (int dt = 0; dt < 8; ++dt) o[dt] = (f32x4){0.f, 0.f, 0.f, 0.f};
#pragma unroll
        for (int k2 = 0; k2 < 8; ++k2) {
            float pp[8] = {acc[2 * k2][0], acc[2 * k2][1], acc[2 * k2][2], acc[2 * k2][3], acc[2 * k2 + 1][0], acc[2 * k2 + 1][1], acc[2 * k2 + 1][2], acc[2 * k2 + 1][3]};
            const bf16x8 pf = pack8(pp);
#pragma unroll
            for (int dt = 0; dt < 8; ++dt) {
                const LAS bf16* vr = Vt + (dt * 16 + l15) * VC_P + k2 * 32 + 4 * q4;
                const v2u v0 = *(const LAS v2u*)(vr), v1 = *(const LAS v2u*)(vr + 16);
                const v4u vw = (v4u){v0.x, v0.y, v1.x, v1.y};
                o[dt] = MFMA16(__builtin_bit_cast(bf16x8, vw), pf, o[dt]);
            }
        }
#pragma unroll
        for (int dt = 0; dt < 8; ++dt) {
            const int ch = hx * 128 + dt * 16 + 4 * q4;
            float gg[4]; unpack4(gat[dt], gg);
            v2u w; w.x = pk2(o[dt][0] * inv * gg[0], o[dt][1] * inv * gg[1]); w.y = pk2(o[dt][2] * inv * gg[2], o[dt][3] * inv * gg[3]);
            *(v2u*)(YC + m * DM + 1536 + ch) = w;
        }
    }
}
__device__ __forceinline__ void attnC_item(const Params& P, int item, LAS unsigned char* lds) {
    const int tid = pg8::mk_tid(lds), lane = tid & 63, wave = __builtin_amdgcn_readfirstlane(tid >> 6), l15 = lane & 15, q4 = lane >> 4;
    const int b = item >> 5, qb0 = 2 * ((item >> 2) & 7), hx = item & 3;
    const bf16* PRE = (const bf16*)(P.ws + WS_PRE); const bf16* MKV = (const bf16*)(P.ws + WS_MKV); bf16* YC = (bf16*)(P.ws + WS_YCAT);
    LAS bf16* Ks = (LAS bf16*)lds; LAS bf16* Vt = Ks + 256 * KC_P;
    const size_t m = (size_t)b * SEQ + qb0 * 128 + wave * 16 + l15;
    {
        v4u kw[8], vw[8];
#pragma unroll
        for (int u = 0; u < 8; ++u) {
            const int it = tid + u * NTHREADS, j = it >> 4, c = it & 15;
            const bf16* src = MKV + ((size_t)b * NMEM + j) * 1024 + hx * 128 + 8 * c;
            kw[u] = *(const v4u*)(src); vw[u] = *(const v4u*)(src + 512);
        }
        const f32x4 g0 = *(const f32x4*)(P.in[23] + 8 * (tid & 15)), g1 = *(const f32x4*)(P.in[23] + 8 * (tid & 15) + 4);
#pragma unroll
        for (int u = 0; u < 8; ++u) {
            const int it = tid + u * NTHREADS, j = it >> 4, c = it & 15;
            float x[8]; unpack8(kw[u], x);
            float ss = 0.f;
#pragma unroll
            for (int i = 0; i < 8; ++i) ss += x[i] * x[i];
            ss = red8(ss); ss = dpp_add<0x140>(ss);
            const float rstd = 1.f / sqrtf(ss * (1.f / 128.f) + NORM_EPS);
            v4u o; o.x = pk2(x[0] * rstd * g0.x, x[1] * rstd * g0.y); o.y = pk2(x[2] * rstd * g0.z, x[3] * rstd * g0.w);
            o.z = pk2(x[4] * rstd * g1.x, x[5] * rstd * g1.y); o.w = pk2(x[6] * rstd * g1.z, x[7] * rstd * g1.w);
            *(LAS v4u*)(Ks + j * KC_P + 8 * c) = o;
            const v4u w = vw[u];
            LAS bf16* d = Vt + (8 * c) * VC_P + j;
            d[0] = (bf16)(w.x & 0xffffu); d[VC_P] = (bf16)(w.x >> 16); d[2 * VC_P] = (bf16)(w.y & 0xffffu); d[3 * VC_P] = (bf16)(w.y >> 16);
            d[4 * VC_P] = (bf16)(w.z & 0xffffu); d[5 * VC_P] = (bf16)(w.z >> 16); d[6 * VC_P] = (bf16)(w.w & 0xffffu); d[7 * VC_P] = (bf16)(w.w >> 16);
        }
    }
    v4u qraw[4]; v2u gat[8];
    {
        const bf16* src = PRE + m * NPRE + C_XQ + hx * 128 + 8 * q4;
#pragma unroll
        for (int ks = 0; ks < 4; ++ks) qraw[ks] = *(const v4u*)(src + ks * 32);
#pragma unroll
        for (int dt = 0; dt < 8; ++dt) gat[dt] = *(const v2u*)(PRE + m * NPRE + C_XG + hx * 128 + dt * 16 + 4 * q4);
    }
    __syncthreads();
    v4u qraw2[4]; v2u gat2[8];
    {
        const size_t m2 = m + 128; const bf16* src = PRE + m2 * NPRE + C_XQ + hx * 128 + 8 * q4;
#pragma unroll
        for (int ks = 0; ks < 4; ++ks) qraw2[ks] = *(const v4u*)(src + ks * 32);
#pragma unroll
        for (int dt = 0; dt < 8; ++dt) gat2[dt] = *(const v2u*)(PRE + m2 * NPRE + C_XG + hx * 128 + dt * 16 + 4 * q4);
    }
    attnC_qblock(P, Ks, Vt, YC, qraw, gat, m, hx, l15, q4);
    __builtin_amdgcn_sched_barrier(0);
    attnC_qblock(P, Ks, Vt, YC, qraw2, gat2, m + 128, hx, l15, q4);
    __syncthreads();
}

__device__ __forceinline__ void p5_rwkv_post(const Params& P, LAS unsigned char* lds) {
    const bf16* PRE = (const bf16*)(P.ws + WS_PRE);
    const bf16* YF = (const bf16*)((unsigned char*)P.out + DO_YF); const bf16* YB = (const bf16*)(P.ws + WS_YB); bf16* YC = (bf16*)(P.ws + WS_YCAT);
    const float* BON = (const float*)(P.ws + WS_BON);
    const float* mu = P.in[10];
    const int gt = blockIdx.x * NTHREADS + pg8::mk_tid(lds), NGT = gridDim.x * NTHREADS;
    for (int idx = gt; idx < M_TOK * 96; idx += NGT) {
        const int m = idx / 96, he = idx - m * 96, ch0 = he * 8, t = m & (SEQ - 1);
        const bf16* p = PRE + (size_t)m * NPRE + C_RS + ch0;
        const v4u z4 = (v4u){0u, 0u, 0u, 0u};
        const bool hp = t > 0, hn = t < SEQ - 1;
        const v4u vc = *(const v4u*)(p + 1536);
        const v4u vp = hp ? *(const v4u*)(p - NPRE + 1536) : z4, vn = hn ? *(const v4u*)(p + NPRE + 1536) : z4;
        const v4u yf8 = *(const v4u*)(YF + (size_t)m * RW + ch0), yb8 = *(const v4u*)(YB + (size_t)m * RW + ch0);
        const v4u rg8 = *(const v4u*)(PRE + (size_t)m * NPRE + C_RG + ch0);
        const float bs = BON[(size_t)m * 12 + (he >> 3)] + BON[((size_t)M_TOK + m) * 12 + (he >> 3)];
        float v[8], x0[8], x1[8], x2[8];
        unpack8(vc, x0); unpack8(vp, x1); unpack8(vn, x2);
#pragma unroll
        for (int i = 0; i < 8; ++i) v[i] = x0[i] + mu[1536 + ch0 + i] * (0.5f * (x1[i] + x2[i]) - x0[i]);
        float ys[8], yb[8], rg[8]; unpack8(yf8, ys); unpack8(yb8, yb); unpack8(rg8, rg);
        float sm = 0.f;
#pragma unroll
        for (int i = 0; i < 8; ++i) { ys[i] += yb[i]; sm += ys[i]; }
        sm = red8(sm);
        const float mean = sm * (1.f / 64.f);
        float vs = 0.f;
#pragma unroll
        for (int i = 0; i < 8; ++i) { ys[i] -= mean; vs += ys[i] * ys[i]; }
        vs = red8(vs);
        const float rstd = 1.f / sqrtf(vs * (1.f / 64.f) + GN_EPS);
        float o[8];
#pragma unroll
        for (int i = 0; i < 8; ++i) o[i] = (ys[i] * rstd * P.in[18][ch0 + i] + P.in[19][ch0 + i] + bs * v[i]) * rg[i];
        v4u w; w.x = pk2(o[0], o[1]); w.y = pk2(o[2], o[3]); w.z = pk2(o[4], o[5]); w.w = pk2(o[6], o[7]);
        *(v4u*)(YC + (size_t)m * DM + 768 + ch0) = w;
    }
}

constexpr size_t WS_XBAR = 504 * MiB + 832 * 1024;
#define XB_TMO      128
#define XB_XCNT(j)  (256  + 64 * (j))
#define XB_XSUB(j)  (1280 + 64 * (j))
#define XB_XGEN(j)  (2304 + 64 * (j))
#define XB_TOP      3328
#define XB_TOPGEN   3392
#define XCD_BAR_WORDS 3456
#define XB_SPIN_CAP (1u << 18)
__device__ __forceinline__ unsigned xb_ld(unsigned* p)              { return __hip_atomic_load(p, __ATOMIC_RELAXED, __HIP_MEMORY_SCOPE_AGENT); }
__device__ __forceinline__ unsigned xb_add(unsigned* p, unsigned v) { return __hip_atomic_fetch_add(p, v, __ATOMIC_RELAXED, __HIP_MEMORY_SCOPE_AGENT); }
__device__ __forceinline__ unsigned xb_xcc_id() { return (unsigned)__builtin_amdgcn_s_getreg((3 << 11) | 20) & 0xFu; }
#define XB_SPIN(cond, bar) do { unsigned _sp = 0; while (cond) { __builtin_amdgcn_s_sleep(1); \
    if ((++_sp & 255u) == 0u) { if (xb_ld(&(bar)[XB_TMO])) break; if (_sp > XB_SPIN_CAP) { atomicAdd(&(bar)[XB_TMO], 1u); break; } } } } while (0)
__device__ __forceinline__ void xcd_barrier_complete(unsigned* bar, unsigned x, unsigned& nloc, unsigned& nx) {
    const unsigned G = gridDim.x * gridDim.y * gridDim.z;
    unsigned sum, cnt, mine, sp = 0u;
    for (;;) {
        sum = 0u; cnt = 0u; mine = 0u;
#pragma unroll
        for (unsigned j = 0; j < 16; ++j) { const unsigned c = xb_ld(&bar[XB_XCNT(j)]); sum += c; cnt += (c > 0u) ? 1u : 0u; mine = (j == x) ? c : mine; }
        if (sum == G) break;
        __builtin_amdgcn_s_sleep(1);
        if ((++sp & 255u) == 0u) { if (xb_ld(&bar[XB_TMO])) break; if (sp > XB_SPIN_CAP) { atomicAdd(&bar[XB_TMO], 1u); break; } }
    }
    nloc = mine > 0u ? mine : 1u; nx = cnt > 0u ? cnt : 1u;
}
__device__ __forceinline__ void xcd_barrier(unsigned* bar, volatile LAS unsigned* st, LAS unsigned char* lds) {
    asm volatile("s_waitcnt vmcnt(0)" ::: "memory");
    __syncthreads();
    if (pg8::mk_tid(lds) == 0) {
        const unsigned x = xb_xcc_id();
        __builtin_amdgcn_s_waitcnt(0);
        unsigned nloc = st[0], nx = st[1];
        if (nloc == 0u) { xcd_barrier_complete(bar, x, nloc, nx); st[0] = nloc; st[1] = nx; }
        const unsigned old = xb_add(&bar[XB_XSUB(x)], 1u);
        const unsigned gen = old / nloc;
        if (old + 1u == (gen + 1u) * nloc) {
            __builtin_amdgcn_fence(__ATOMIC_RELEASE, "agent");
            asm volatile("s_waitcnt vmcnt(0)" ::: "memory");
            const unsigned og = xb_add(&bar[XB_TOP], 1u);
            const unsigned tg = og / nx;
            if (og + 1u == (tg + 1u) * nx) xb_add(&bar[XB_TOPGEN], 1u);
            else XB_SPIN(xb_ld(&bar[XB_TOPGEN]) == tg, bar);
            __builtin_amdgcn_fence(__ATOMIC_ACQUIRE, "agent");
            xb_add(&bar[XB_XGEN(x)], 1u);
            asm volatile("s_waitcnt vmcnt(0)" ::: "memory");
        } else {
            XB_SPIN(xb_ld(&bar[XB_XGEN(x)]) == gen, bar);
            __builtin_amdgcn_fence(__ATOMIC_ACQUIRE, "agent");
            asm volatile("s_waitcnt vmcnt(0)" ::: "memory");
        }
    }
    __syncthreads();
}

constexpr int N_PHASES = 8;
__global__ void __launch_bounds__(NTHREADS, 2) hybrid_fwd(Params P) {
    extern __shared__ __attribute__((aligned(16))) unsigned char lds_raw[];
    LAS unsigned char* lds = (LAS unsigned char*)lds_raw;
    cg::grid_group grid = cg::this_grid();
    const int lo = P.ph_lo, hi = P.ph_hi, G = gridDim.x;
    if ((threadIdx.x & 63) == 0) *(volatile LAS int*)(lds + pg8::TIDTAB_OFF + 4 * pg8::hw_slot()) = (int)(threadIdx.x >> 6);
    volatile LAS unsigned* xbst = (volatile LAS unsigned*)(lds + pg8::TIDTAB_OFF - 128);
    unsigned* xbar = (unsigned*)(P.ws + WS_XBAR);
    if (threadIdx.x == 0) { xbst[0] = 0u; xbst[1] = 0u; (void)xb_add(&xbar[XB_XCNT(xb_xcc_id())], 1u); }
    __syncthreads();
    unsigned char* ws = P.ws; unsigned char* dob = (unsigned char*)P.out;
#ifdef PHMASK
#define IN(k) (((PHMASK >> (k)) & 1) && lo <= (k) && (k) < hi)
#else
#define IN(k) (lo <= (k) && (k) < hi)
#endif
#define SEAM(k) do { if (IN(k) && IN((k) + 1)) xcd_barrier(xbar, xbst, lds); } while (0)
#ifndef REPEAT_MASK
#define REPEAT_MASK 0
#endif
#define REP(k) for (int rep_ = 0; rep_ < (((REPEAT_MASK >> (k)) & 1) ? 2 : 1); ++rep_)
#define REPSYNC() do { if (rep_) grid.sync(); } while (0)
    if (hi > N_PHASES) grid.sync();
    if (IN(0)) REP(0) { REPSYNC(); p0_prologue(P, lds, P.out); __syncthreads(); }
    SEAM(0);
    if (IN(1)) REP(1) { REPSYNC();
        { pg8::Gemm g{(const bf16*)(dob + DO_H), (const bf16*)(dob + DO_WIN), M_TOK, NIN, DM}; pg8::StaticOrder S; S.init(M_TOK, NIN, G, (int)blockIdx.x);
          EpiProj E{(bf16*)(ws + WS_PRE), (bf16*)(ws + WS_GATES), P.in[5]};
          pg8::gemm_phase<EpiProj, pg8::StaticOrder, true, true>(lds, g, S, E); }
        { pg8::Gemm g{(const bf16*)(ws + WS_MEMN), (const bf16*)(ws + WS_WXKV), MEMROWS, 1024, DM}; pg8::StaticOrder S; S.init(MEMROWS, 1024, G, (int)((blockIdx.x + G - 64) % G));
          EpiPlain E{(bf16*)(ws + WS_MKV), 1024};
          pg8::gemm_phase<EpiPlain, pg8::StaticOrder, true, true>(lds, g, S, E); }
    }
    SEAM(1);
    if (IN(2)) REP(2) { REPSYNC(); p2_lora_in(P, lds); }
    SEAM(2);
    if (IN(3)) REP(3) { REPSYNC();
        int klora = 256; asm volatile("" : "+s"(klora));
        pg8::Gemm g{(const bf16*)(dob + DO_LIN), (const bf16*)(ws + WS_LORAB), M_TOK, NLORA, klora}; pg8::StaticOrder S; S.init(M_TOK, NLORA, G, (int)blockIdx.x);
        EpiLora E{(bf16*)(dob + DO_EA), P.in[14], P.in[16]};
        pg8::gemm_phase<EpiLora, pg8::StaticOrder, true, true>(lds, g, S, E);
    }
    SEAM(3);
    if (IN(4)) REP(4) { REPSYNC();
        const int bid = blockIdx.x;
#ifndef STATIC_ATT
#define STATIC_ATT 0
#endif
#ifndef SCAN2
#define SCAN2 1
#endif
        if (bid < 192) scan_chunked(P, bid, lds);
        if (STATIC_ATT) {
            if (bid >= 192) { for (int it = bid - 192; it < 768; it += G - 192) { if (it < 512) attnA_item(P, it, lds); else attnC_item(P, it - 512, lds); } }
        } else {
            volatile LAS int* slot = (volatile LAS int*)(lds + pg8::TIDTAB_OFF - 64);
            const int tid4 = pg8::mk_tid(lds);
            for (;;) {
                if (tid4 == 0) *slot = (int)__hip_atomic_fetch_add((unsigned*)(ws + WS_CTR), 1u, __ATOMIC_RELAXED, __HIP_MEMORY_SCOPE_AGENT);
                __syncthreads();
                const int it = *slot;
                __syncthreads();
                if (it >= 768) break;
                if (it < 512) attnA_item(P, it, lds); else attnC_item(P, it - 512, lds);
            }
        }
    }
    SEAM(4);
    if (IN(5)) REP(5) { REPSYNC(); p5_rwkv_post(P, lds); }
    SEAM(5);
    if (IN(6)) REP(6) { REPSYNC();
        pg8::Gemm g{(const bf16*)(ws + WS_YCAT), (const bf16*)(ws + WS_WCAT), M_TOK, DM, DM}; pg8::StaticOrder S; S.init(M_TOK, DM, G, (int)blockIdx.x);
        EpiMerged E{(bf16*)(ws + WS_MERGED), (const bf16*)(ws + WS_GATES)};
        pg8::gemm_phase<EpiMerged, pg8::StaticOrder, true, true>(lds, g, S, E);
    }
    SEAM(6);
    if (IN(7)) REP(7) { REPSYNC();
        pg8::Gemm g{(const bf16*)(ws + WS_MERGED), (const bf16*)(ws + WS_WOUT), M_TOK, DM, DM}; pg8::StaticOrder S; S.init(M_TOK, DM, G, (int)blockIdx.x);
        EpiOut E{P.out, P.in[0]};
        pg8::gemm_phase<EpiOut, pg8::StaticOrder, true, true>(lds, g, S, E);
    }
#undef IN
#undef SEAM
}

#ifndef ONE_LAUNCH
#define ONE_LAUNCH 1
#endif
extern "C" void kernel_launch(void* const* d_in, const int* in_sizes, int n_in, void* d_out, int out_size, void* d_ws, size_t ws_size, hipStream_t stream) {
    static int grid = 0;
    if (grid == 0) {
        if (n_in != 26 || out_size != M_TOK * DM || ws_size < WS_END) { fprintf(stderr, "kernel_launch: unexpected shapes (n_in %d, out %d, ws %zu); nothing launched\n", n_in, out_size, ws_size); grid = -1; return; }
        int dev = 0, cus = 0, per_cu = 0;
        hipGetDevice(&dev); hipDeviceGetAttribute(&cus, hipDeviceAttributeMultiprocessorCount, dev);
        if (hipFuncSetAttribute((const void*)hybrid_fwd, hipFuncAttributeMaxDynamicSharedMemorySize, LDS_BYTES) != hipSuccess) { fprintf(stderr, "kernel_launch: hipFuncSetAttribute failed\n"); grid = -1; return; }
        hipOccupancyMaxActiveBlocksPerMultiprocessor(&per_cu, (const void*)hybrid_fwd, NTHREADS, LDS_BYTES);
        (void)hipGetLastError();
        if (per_cu < 1) per_cu = 1;
        grid = cus * per_cu; if (grid > 256) grid = 256;
        if (grid < 200) { fprintf(stderr, "kernel_launch: grid %d too small for the scan/attention split\n", grid); grid = -1; return; }
    }
    if (grid < 0) return;
    Params p{};
    for (int i = 0; i < 26; ++i) p.in[i] = (const float*)d_in[i];
    p.out = (float*)d_out; p.ws = (unsigned char*)d_ws;
#if ONE_LAUNCH
    (void)hipMemsetAsync((unsigned char*)d_ws + WS_XBAR, 0, XCD_BAR_WORDS * 4, stream);
    p.ph_lo = 0; p.ph_hi = N_PHASES;
    void* args[] = {&p};
    hipError_t e = hipLaunchCooperativeKernel((const void*)hybrid_fwd, dim3(grid), dim3(NTHREADS), args, LDS_BYTES, stream);
    if (e != hipSuccess) fprintf(stderr, "cooperative launch failed: %s (grid %d)\n", hipGetErrorString(e), grid);
#else
    for (int ph = 0; ph < N_PHASES; ++ph) {
        p.ph_lo = ph; p.ph_hi = ph + 1;
        hipLaunchKernelGGL(hybrid_fwd, dim3(grid), dim3(NTHREADS), LDS_BYTES, stream, p);
    }
#endif
}
```
